# Optimizing an MI355X kernel written in HIP

```python
import math
import jax
import jax.numpy as jnp
from jax import lax
import numpy as np

D_MODEL = 1024
BATCH = 16
SEQ = 2048
DEPTH = 2

ROPE_THETA = 500000.0
NORM_EPS = 1e-6
Q_BLOCK = 128

MLA_HEADS = 8
MLA_NOPE = 64
MLA_ROPE = 32
MLA_V = 64
MLA_Q_LORA = 256
MLA_KV_LORA = 128
CONV_DIM = 512
CONV_WIDTH = 3
DSA_HEADS = 8
DSA_HEAD_DIM = 64
DSA_ROT = DSA_HEAD_DIM // 4
IDX_HEADS = 8
IDX_DIM = 64
IDX_ROT = IDX_DIM // 4
TOPK_MAX = 256
N_BRANCH = 3
BRANCH_WIDTH = 512
IN_SIZES = (MLA_Q_LORA, MLA_KV_LORA + MLA_ROPE, 3 * CONV_DIM, DSA_HEADS * DSA_HEAD_DIM,
            2 * DSA_HEAD_DIM, IDX_HEADS * IDX_DIM, IDX_DIM, IDX_HEADS, N_BRANCH * D_MODEL)
IN_COLS = sum(IN_SIZES)
N_EXPERTS = 32
TOP_K = 4
D_EXPERT = D_MODEL
SWIGLU_ALPHA = 1.702
SWIGLU_LIMIT = 7.0
MOE_BLOCK = 512

kernel_name = "hybrid_mla_conv_dsa_moe_adaln"


def rmsnorm(x, g):
    xf = x.astype(jnp.float32)
    y = xf * lax.rsqrt(jnp.mean(xf * xf, axis=-1, keepdims=True) + NORM_EPS)
    return (y * g.astype(jnp.float32)).astype(x.dtype)


def rope(x, pos, n_rot):
    half = n_rot // 2
    inv_freq = jnp.exp(-math.log(ROPE_THETA) * jnp.arange(half, dtype=jnp.float32) * (2.0 / n_rot))
    ang = pos.astype(jnp.float32)[..., None] * inv_freq
    if x.ndim == 4:
        ang = ang[:, :, None, :]
    cos = jnp.cos(ang).astype(x.dtype)
    sin = jnp.sin(ang).astype(x.dtype)
    x1 = x[..., :half]
    x2 = x[..., half:n_rot]
    return jnp.concatenate([x1 * cos - x2 * sin, x2 * cos + x1 * sin, x[..., n_rot:]], axis=-1)


def split_cols(a, sizes):
    out, start = [], 0
    for n in sizes:
        out.append(a[..., start:start + n])
        start += n
    return out


def to_blocks(a, nb):
    return a.reshape((a.shape[0], nb, Q_BLOCK) + a.shape[2:]).swapaxes(0, 1)


def from_blocks(a):
    a = a.swapaxes(0, 1)
    return a.reshape((a.shape[0], a.shape[1] * a.shape[2]) + a.shape[3:])


def blocked_causal_attention(q, k, v, scale):
    S = q.shape[1]
    nb = S // Q_BLOCK
    kpos = jnp.arange(S)

    def one(args):
        q_b, start = args
        qpos = start + jnp.arange(Q_BLOCK)
        s = jnp.einsum('bqhd,bkhd->bhqk', q_b, k).astype(jnp.float32) * scale
        s = jnp.where((kpos[None, :] <= qpos[:, None])[None, None], s, -jnp.inf)
        p = jax.nn.softmax(s, axis=-1).astype(v.dtype)
        return jnp.einsum('bhqk,bkhd->bqhd', p, v)

    out = lax.map(one, (to_blocks(q, nb), jnp.arange(nb) * Q_BLOCK))
    return from_blocks(out)


def indexer_sparse_attention(q, k, v, qi, ki, wi):
    S = q.shape[1]
    nb = S // Q_BLOCK
    topk = min(TOPK_MAX, S // 4)
    kpos = jnp.arange(S)
    gather = jax.vmap(lambda kb, ib: kb[ib])
    scale = DSA_HEAD_DIM ** -0.5

    def one(args):
        q_b, qi_b, wi_b, start = args
        qpos = start + jnp.arange(Q_BLOCK)
        logits = jnp.einsum('bqhd,bkd->bqhk', qi_b, ki).astype(jnp.float32) * (IDX_DIM ** -0.5)
        score = jnp.einsum('bqhk,bqh->bqk', jax.nn.relu(logits), wi_b.astype(jnp.float32)) * (IDX_HEADS ** -0.5)
        score = jnp.where((kpos[None, :] <= qpos[:, None])[None], score, -jnp.inf)
        _, sel = lax.top_k(score, topk)
        valid = sel <= qpos[None, :, None]
        ks = gather(k, sel)
        vs = gather(v, sel)
        s = jnp.einsum('bqhd,bqkd->bqhk', q_b, ks).astype(jnp.float32) * scale
        s = jnp.where(valid[:, :, None, :], s, -jnp.inf)
        p = jax.nn.softmax(s, axis=-1).astype(v.dtype)
        return jnp.einsum('bqhk,bqkd->bqhd', p, vs)

    out = lax.map(one, (to_blocks(q, nb), to_blocks(qi, nb), to_blocks(wi, nb), jnp.arange(nb) * Q_BLOCK))
    return from_blocks(out)


def causal_depthwise_conv(u, w):
    return lax.conv_general_dilated(u, w[:, None, :].astype(u.dtype), window_strides=(1,),
                                    padding=[(CONV_WIDTH - 1, 0)],
                                    dimension_numbers=('NWC', 'WIO', 'NWC'),
                                    feature_group_count=u.shape[-1])


def token_mixer(h, pos, w_in, b_gate, q_norm_g, w_uq, kv_norm_g, w_ukv, conv_w, w_branch, w_out):
    B, S, D = h.shape
    proj = h @ w_in
    q_lat, kv_lat, conv_in, dq, dkv, iq, ik, iw, gate_logits = split_cols(proj, IN_SIZES)

    cq = rmsnorm(q_lat, q_norm_g)
    qa = rope((cq @ w_uq).reshape(B, S, MLA_HEADS, MLA_ROPE + MLA_NOPE), pos, MLA_ROPE)
    ckv = rmsnorm(kv_lat[..., :MLA_KV_LORA], kv_norm_g)
    k_pe = rope(kv_lat[..., MLA_KV_LORA:], pos, MLA_ROPE)
    kv = (ckv @ w_ukv).reshape(B, S, MLA_HEADS, MLA_NOPE + MLA_V)
    ka = jnp.concatenate([jnp.broadcast_to(k_pe[:, :, None, :], (B, S, MLA_HEADS, MLA_ROPE)),
                          kv[..., :MLA_NOPE]], axis=-1)
    o_a = blocked_causal_attention(qa, ka, kv[..., MLA_NOPE:], (MLA_NOPE + MLA_ROPE) ** -0.5)
    o_a = o_a.reshape(B, S, BRANCH_WIDTH)

    g_b, g_c, hc = split_cols(conv_in, (CONV_DIM, CONV_DIM, CONV_DIM))
    o_b = g_b * causal_depthwise_conv(g_c * hc, conv_w)

    qc = rope(dq.reshape(B, S, DSA_HEADS, DSA_HEAD_DIM), pos, DSA_ROT)
    kc = rope(dkv[..., :DSA_HEAD_DIM], pos, DSA_ROT)
    vc = dkv[..., DSA_HEAD_DIM:]
    qi = rope(iq.reshape(B, S, IDX_HEADS, IDX_DIM), pos, IDX_ROT)
    ki = rope(ik, pos, IDX_ROT)
    o_c = indexer_sparse_attention(qc, kc, vc, qi, ki, iw).reshape(B, S, BRANCH_WIDTH)

    o = jnp.stack([o_a, o_b, o_c], axis=2)
    y = jnp.einsum('bsnw,nwd->bsnd', o, w_branch)
    g = jax.nn.sigmoid(gate_logits + b_gate).reshape(B, S, N_BRANCH, D)
    return jnp.sum(g * y, axis=2) @ w_out


def moe(xf, router_w, router_b, w1, b1, w2, b2):
    T, D = xf.shape
    logits = (xf @ router_w + router_b).astype(jnp.float32)
    top_vals, top_idx = lax.top_k(logits, TOP_K)
    gates = jax.nn.softmax(top_vals, axis=-1)
    N = T * TOP_K
    n_blocks = (N + N_EXPERTS * (MOE_BLOCK - 1) + MOE_BLOCK - 1) // MOE_BLOCK
    P = n_blocks * MOE_BLOCK
    slot_expert = top_idx.reshape(N)
    slot_token = jnp.arange(N, dtype=jnp.int32) // TOP_K
    order = jnp.argsort(slot_expert)
    e_sorted = slot_expert[order]
    counts = jnp.bincount(slot_expert, length=N_EXPERTS)
    padded = (counts + MOE_BLOCK - 1) // MOE_BLOCK * MOE_BLOCK
    starts = jnp.cumsum(counts) - counts
    pends = jnp.cumsum(padded)
    pstarts = pends - padded
    dest = pstarts[e_sorted] + (jnp.arange(N, dtype=jnp.int32) - starts[e_sorted])
    tok_pad = jnp.full((P,), T, dtype=jnp.int32).at[dest].set(slot_token[order])
    gate_pad = jnp.zeros((P,), jnp.float32).at[dest].set(gates.reshape(N)[order])
    block_expert = jnp.minimum(jnp.searchsorted(pends, jnp.arange(n_blocks) * MOE_BLOCK, side='right'),
                               N_EXPERTS - 1)
    x_pad = jnp.concatenate([xf, jnp.zeros((1, D), xf.dtype)], axis=0)
    xb = x_pad[tok_pad].reshape(n_blocks, MOE_BLOCK, D)

    def expert_block(args):
        xblk, e = args
        hgu = xblk @ w1[e] + b1[e]
        gate = jnp.minimum(hgu[..., 0::2], SWIGLU_LIMIT)
        up = jnp.clip(hgu[..., 1::2], -SWIGLU_LIMIT, SWIGLU_LIMIT)
        glu = gate * jax.nn.sigmoid(gate * SWIGLU_ALPHA)
        return ((up + 1.0) * glu) @ w2[e] + b2[e]

    yb = lax.map(expert_block, (xb, block_expert)).reshape(P, D)
    out = jnp.zeros((T + 1, D), xf.dtype).at[tok_pad].add(yb * gate_pad[:, None].astype(xf.dtype))
    return out[:T]


def setup_inputs(seed: int = 0) -> dict:
    key = jax.random.key(seed)
    ks = jax.random.split(key, 32)
    L, D, E, F = DEPTH, D_MODEL, N_EXPERTS, D_EXPERT

    def nrm(k, shape, scale):
        return jax.random.normal(k, shape, jnp.float32) * scale

    x = nrm(ks[0], (BATCH, SEQ, D), 1.0)
    c = nrm(ks[1], (BATCH, D), 1.0)
    positions = (jnp.arange(SEQ, dtype=jnp.int32)[None, :]
                 + jax.random.randint(ks[2], (BATCH, 1), 0, 4096, dtype=jnp.int32))
    return {
        "x": x,
        "c": c,
        "positions": positions,
        "norm1_g": 1.0 + nrm(ks[3], (L, D), 0.05),
        "norm2_g": 1.0 + nrm(ks[4], (L, D), 0.05),
        "w_ada": nrm(ks[5], (L, D, 6 * D), 0.5 * D ** -0.5),
        "b_ada": nrm(ks[6], (L, 6 * D), 0.02),
        "w_in": nrm(ks[7], (L, D, IN_COLS), D ** -0.5),
        "b_gate": nrm(ks[8], (L, N_BRANCH * D), 0.02),
        "mla_q_norm": 1.0 + nrm(ks[9], (L, MLA_Q_LORA), 0.05),
        "mla_w_uq": nrm(ks[10], (L, MLA_Q_LORA, MLA_HEADS * (MLA_ROPE + MLA_NOPE)), MLA_Q_LORA ** -0.5),
        "mla_kv_norm": 1.0 + nrm(ks[11], (L, MLA_KV_LORA), 0.05),
        "mla_w_ukv": nrm(ks[12], (L, MLA_KV_LORA, MLA_HEADS * (MLA_NOPE + MLA_V)), MLA_KV_LORA ** -0.5),
        "conv_w": nrm(ks[13], (L, CONV_WIDTH, CONV_DIM), CONV_WIDTH ** -0.5),
        "w_branch": nrm(ks[14], (L, N_BRANCH, BRANCH_WIDTH, D), BRANCH_WIDTH ** -0.5),
        "w_out": nrm(ks[15], (L, D, D), D ** -0.5),
        "router_w": nrm(ks[16], (L, D, E), D ** -0.5),
        "router_b": nrm(ks[17], (L, E), 0.01),
        "exp_w1": nrm(ks[18], (L, E, D, 2 * F), D ** -0.5),
        "exp_b1": nrm(ks[19], (L, E, 2 * F), 0.01),
        "exp_w2": nrm(ks[20], (L, E, F, D), F ** -0.5),
        "exp_b2": nrm(ks[21], (L, E, D), 0.01),
        "final_g": 1.0 + nrm(ks[22], (D,), 0.05),
    }


def reference(x, c, positions, norm1_g, norm2_g, w_ada, b_ada, w_in, b_gate, mla_q_norm, mla_w_uq,
              mla_kv_norm, mla_w_ukv, conv_w, w_branch, w_out, router_w, router_b, exp_w1, exp_b1,
              exp_w2, exp_b2, final_g):
    B, S, D = x.shape
    c_act = jax.nn.silu(c)
    for l in range(DEPTH):
        mod = (c_act @ w_ada[l] + b_ada[l])[:, None, :]
        sh1, sc1, g1, sh2, sc2, g2 = jnp.split(mod, 6, axis=-1)
        h = rmsnorm(x, norm1_g[l]) * (1.0 + sc1) + sh1
        x = x + g1 * token_mixer(h, positions, w_in[l], b_gate[l], mla_q_norm[l], mla_w_uq[l],
                                 mla_kv_norm[l], mla_w_ukv[l], conv_w[l], w_branch[l], w_out[l])
        h = rmsnorm(x, norm2_g[l]) * (1.0 + sc2) + sh2
        y = moe(h.reshape(B * S, D), router_w[l], router_b[l], exp_w1[l], exp_b1[l], exp_w2[l], exp_b2[l])
        x = x + g2 * y.reshape(B, S, D)
    return rmsnorm(x, final_g)
```

```cpp
#include <hip/hip_runtime.h>
#include <cstdio>
#include <cstdint>

#define LAS __attribute__((address_space(3)))
#define GAS __attribute__((address_space(1)))
typedef unsigned short bf16_t;
typedef short bf16x8 __attribute__((ext_vector_type(8)));
typedef short s16x4 __attribute__((ext_vector_type(4)));
typedef float f32x2 __attribute__((ext_vector_type(2)));
typedef float f32x4 __attribute__((ext_vector_type(4)));
typedef float f32x16 __attribute__((ext_vector_type(16)));
typedef unsigned u32x2 __attribute__((ext_vector_type(2)));
typedef unsigned u32x4 __attribute__((ext_vector_type(4)));
#define DI __device__ __forceinline__

constexpr int D_MODEL = 1024, BATCH = 16, SEQ = 2048, T_TOK = BATCH * SEQ, DEPTH = 2;
constexpr float NORM_EPS = 1e-6f;
constexpr int IN_COLS = 6248, NP = 6400;
constexpr int N_EXP = 32, TOP_K = 4, D_EXP = 1024;
constexpr int NSLOT_MAX = T_TOK * TOP_K + N_EXP * 256;
constexpr int PC_GATE = 0, PC_CONV = 3072, PC_DQ = 4608, PC_IQ = 5120, PC_QLAT = 5632, PC_KVLAT = 5888, PC_DKV = 6048, PC_IK = 6176, PC_IW = 6240;
constexpr int OC_QLAT = 0, OC_KVLAT = 256, OC_CONV = 416, OC_DQ = 1952, OC_DKV = 2464, OC_IQ = 2592, OC_IK = 3104, OC_IW = 3168, OC_GATE = 3176;

DI unsigned pk2(float lo, float hi) { typedef __bf16 bf16x2_t __attribute__((ext_vector_type(2))); f32x2 v = {lo, hi}; bf16x2_t b = __builtin_convertvector(v, bf16x2_t); return __builtin_bit_cast(unsigned, b); }
DI float bf_lo(unsigned w) { return __uint_as_float(w << 16); }
DI float bf_hi(unsigned w) { return __uint_as_float(w & 0xffff0000u); }
DI float bf2f(bf16_t h) { return __uint_as_float((unsigned)h << 16); }
DI float wave_sum(float v) {
#pragma unroll
    for (int o = 1; o < 64; o <<= 1) v += __shfl_xor(v, o);
    return v;
}
DI float fast_sigmoid(float x) { return __builtin_amdgcn_rcpf(1.0f + __builtin_amdgcn_exp2f(-1.4426950408889634f * x)); }
#define LDS_WAIT() asm volatile("s_waitcnt lgkmcnt(0)" ::: "memory")
#define VM_WAIT() asm volatile("s_waitcnt vmcnt(0)" ::: "memory")

namespace pg8 {
constexpr int BM = 256, BK = 64, HALF = 128, HTB = HALF * BK * 2, STAGE_BYTES = 8 * HTB, NXCD = 8, WGM = 8;
__host__ __device__ __forceinline__ int lds_byte(int r, int c) { const int st = (r >> 4) * 2 + (c >> 5), rr = r & 15, cc = c & 31, ob = rr * 64 + cc * 2; return st * 1024 + (ob ^ (((ob >> 9) & 1) << 5)); }
__host__ __device__ __forceinline__ void stage_rc(int b, int& R, int& C) { const int st = b / 1024, sb = b % 1024, swz = sb ^ (((sb >> 9) & 1) << 5); R = (st >> 1) * 16 + swz / 64; C = (st & 1) * 32 + (swz % 64) / 2; }
__host__ __device__ __forceinline__ int perm32(int rho) { const int n = rho >> 4, i = rho & 15; return 8 * (i >> 2) + 4 * n + (i & 3); }
struct Unit { int pm, pn; };
struct StaticOrder {
    int nM, nN, nwg, G, c;
    DI void init(int nM_, int nN_, int G_, int c_) { nM = nM_; nN = nN_; nwg = nM * nN; G = G_; c = c_; }
    DI bool next(int i, Unit& u) const {
        const long L = (long)i * G + c; if (L >= nwg) return false;
        int wgid = (int)L; { const int q = nwg / NXCD, r = nwg % NXCD, xcd = wgid % NXCD, off = wgid / NXCD; wgid = (xcd < r ? xcd * (q + 1) : r * (q + 1) + (xcd - r) * q) + off; }
        const int nig = WGM * nN, gid = wgid / nig, fm = gid * WGM, gsz = (nM - fm) < WGM ? (nM - fm) : WGM;
        u.pm = fm + ((wgid % nig) % gsz); u.pn = (wgid % nig) / gsz; return true;
    }
};

template <class Epi, class Sched, bool ALIGN_EPI = true, bool SP2 = true>
DI void gemm_phase(LAS unsigned char* lds, const int tid, const int K, const Sched& S, const Epi& E) {
    const int wid = __builtin_amdgcn_readfirstlane(tid >> 6), lane = tid & 63, wr = wid >> 2, wc = wid & 3, fr = lane & 15, fq = lane >> 4;
    const int nt = K / BK;
    unsigned voffA[2], voffB[2];
#pragma unroll
    for (int i = 0; i < 2; ++i) { int R, C; stage_rc(tid * 16 + i * 8192, R, C); const int Rb = Epi::PERM ? ((R & ~31) + perm32(R & 31)) : R;
        voffA[i] = (unsigned)(R * K + C) * 2u; voffB[i] = (unsigned)(Rb * K + C) * 2u; }
    const size_t kstep = (size_t)(BK * 2);
    const size_t hstep = (size_t)HALF * K * 2;
    const unsigned ldsw = (unsigned)wid * 1024u;
    const int aoff = lds_byte(wr * 64 + fr, fq * 8), boff = lds_byte(wc * 32 + fr, fq * 8);
#define PG8_SA(b, h) (((b) * 2 + (h)) * HTB)
#define PG8_SB(b, h) ((4 + (b) * 2 + (h)) * HTB)
#define PG8_STAGE(bufoff, gbase, voff) do { _Pragma("unroll") for (int _i = 0; _i < 2; ++_i) \
        __builtin_amdgcn_global_load_lds((const unsigned*)((const char*)(gbase) + (voff)[_i]), (LAS unsigned*)(lds + (bufoff) + ldsw + _i * 8192), 16, 0, 0); } while (0)
#define PG8_LDA(dst, b, h) do { _Pragma("unroll") for (int m = 0; m < 4; ++m) _Pragma("unroll") for (int k = 0; k < 2; ++k) dst[m][k] = *(const LAS bf16x8*)(lds + PG8_SA(b, h) + aoff + m * 2048 + k * 1024); } while (0)
#define PG8_LDB(dst, b, h) do { _Pragma("unroll") for (int n = 0; n < 2; ++n) _Pragma("unroll") for (int k = 0; k < 2; ++k) dst[n][k] = *(const LAS bf16x8*)(lds + PG8_SB(b, h) + boff + n * 2048 + k * 1024); } while (0)
#define PG8_MMA(ai, bj, At, Bt) do { __builtin_amdgcn_s_setprio(1); _Pragma("unroll") for (int m = 0; m < 4; ++m) _Pragma("unroll") for (int n = 0; n < 2; ++n) _Pragma("unroll") for (int k = 0; k < 2; ++k) \
        acc[ai][bj][m][n] = __builtin_amdgcn_mfma_f32_16x16x32_bf16(Bt[n][k], At[m][k], acc[ai][bj][m][n], 0, 0, 0); __builtin_amdgcn_s_setprio(0); } while (0)
#define PG8_WAIT_V(n) asm volatile("s_waitcnt vmcnt(" #n ")" ::: "memory")
#define PG8_WAIT_L(n) asm volatile("s_waitcnt lgkmcnt(" #n ")" ::: "memory")
#define PG8_BAR __builtin_amdgcn_s_barrier()
#define PG8_SCHED __builtin_amdgcn_sched_barrier(0)
    Unit cur, nxt; int ui = 0;
    if (!S.next(0, cur)) return;
    f32x4 acc[2][2][4][2];
#pragma unroll
    for (int a = 0; a < 2; ++a)
#pragma unroll
        for (int b = 0; b < 2; ++b)
#pragma unroll
            for (int m = 0; m < 4; ++m)
#pragma unroll
                for (int n = 0; n < 2; ++n) acc[a][b][m][n] = (f32x4){0.f, 0.f, 0.f, 0.f};
    bf16x8 At[4][2], B0[2][2], B1[2][2];
    const char* cA = S.abase(cur); const char* cB = S.bbase(cur);
    if constexpr (SP2) {
        PG8_STAGE(PG8_SB(0, 0), cB, voffB); PG8_STAGE(PG8_SB(0, 1), cB + hstep, voffB); PG8_STAGE(PG8_SA(0, 0), cA, voffA); PG8_STAGE(PG8_SA(0, 1), cA + hstep, voffA);
        if (wr == 1) PG8_BAR;
        PG8_WAIT_V(2); PG8_BAR;
        PG8_STAGE(PG8_SB(1, 0), cB + kstep, voffB); PG8_STAGE(PG8_SA(1, 0), cA + kstep, voffA); PG8_STAGE(PG8_SB(1, 1), cB + hstep + kstep, voffB);
        PG8_WAIT_V(6); PG8_BAR;
    } else {
        PG8_STAGE(PG8_SB(0, 0), cB, voffB); PG8_STAGE(PG8_SA(0, 0), cA, voffA); PG8_STAGE(PG8_SB(0, 1), cB + hstep, voffB); PG8_STAGE(PG8_SA(0, 1), cA + hstep, voffA);
        if (wr == 1) PG8_BAR;
        PG8_WAIT_V(4); PG8_BAR;
        PG8_STAGE(PG8_SB(1, 0), cB + kstep, voffB); PG8_STAGE(PG8_SA(1, 0), cA + kstep, voffA); PG8_STAGE(PG8_SB(1, 1), cB + hstep + kstep, voffB);
        PG8_WAIT_V(6); PG8_BAR;
    }
    for (;;) {
        const bool has_next = S.next(ui + 1, nxt);
        const char* nA = has_next ? S.abase(nxt) : cA; const char* nB = has_next ? S.bbase(nxt) : cB;
        for (int t = 0; t < nt; t += 2) {
            const bool last = (t == nt - 2);
            const char* a1 = cA + (size_t)(t + 1) * kstep;
            const char* a2 = last ? nA : cA + (size_t)(t + 2) * kstep; const char* b2 = last ? nB : cB + (size_t)(t + 2) * kstep;
            const char* a3 = a2 + kstep; const char* b3 = b2 + kstep;
            if constexpr (SP2) {
            PG8_LDB(B0, 0, 0); PG8_LDB(B1, 0, 1); PG8_SCHED; PG8_LDA(At, 0, 0); PG8_STAGE(PG8_SA(1, 1), a1 + hstep, voffA);
            PG8_WAIT_V(8); PG8_WAIT_L(0); PG8_BAR; PG8_MMA(0, 0, At, B0); PG8_MMA(0, 1, At, B1); PG8_BAR; PG8_SCHED;
            PG8_LDA(At, 0, 1); PG8_STAGE(PG8_SB(0, 0), b2, voffB); PG8_STAGE(PG8_SB(0, 1), b2 + hstep, voffB); PG8_STAGE(PG8_SA(0, 0), a2, voffA);
            PG8_WAIT_V(8); PG8_WAIT_L(0); PG8_BAR; PG8_MMA(1, 0, At, B0); PG8_MMA(1, 1, At, B1); PG8_BAR; PG8_SCHED;
            PG8_LDB(B0, 1, 0); PG8_LDB(B1, 1, 1); PG8_SCHED; PG8_LDA(At, 1, 0); PG8_STAGE(PG8_SA(0, 1), a2 + hstep, voffA);
            PG8_WAIT_V(8); PG8_WAIT_L(0); PG8_BAR; PG8_MMA(0, 0, At, B0); PG8_MMA(0, 1, At, B1); PG8_BAR; PG8_SCHED;
            PG8_LDA(At, 1, 1); PG8_STAGE(PG8_SB(1, 0), b3, voffB); PG8_STAGE(PG8_SB(1, 1), b3 + hstep, voffB); PG8_STAGE(PG8_SA(1, 0), a3, voffA);
            PG8_WAIT_V(8); PG8_WAIT_L(0); PG8_BAR; PG8_MMA(1, 0, At, B0); PG8_MMA(1, 1, At, B1); PG8_BAR; PG8_SCHED;
            } else {
            PG8_LDB(B0, 0, 0); PG8_SCHED; PG8_LDA(At, 0, 0); PG8_STAGE(PG8_SA(1, 1), a1 + hstep, voffA);
            PG8_WAIT_L(8); PG8_BAR; PG8_WAIT_L(0); PG8_MMA(0, 0, At, B0); PG8_BAR; PG8_SCHED;
            PG8_LDB(B1, 0, 1); PG8_STAGE(PG8_SB(0, 0), b2, voffB);
            PG8_BAR; PG8_WAIT_L(0); PG8_MMA(0, 1, At, B1); PG8_BAR;
            PG8_LDA(At, 0, 1); PG8_STAGE(PG8_SA(0, 0), a2, voffA);
            PG8_BAR; PG8_WAIT_L(0); PG8_MMA(1, 0, At, B0); PG8_BAR; PG8_SCHED;
            PG8_STAGE(PG8_SB(0, 1), b2 + hstep, voffB);
            PG8_WAIT_V(6); PG8_BAR; PG8_MMA(1, 1, At, B1); PG8_BAR;
            PG8_LDB(B0, 1, 0); PG8_SCHED; PG8_LDA(At, 1, 0); PG8_STAGE(PG8_SA(0, 1), a2 + hstep, voffA);
            PG8_WAIT_L(8); PG8_BAR; PG8_WAIT_L(0); PG8_MMA(0, 0, At, B0); PG8_BAR; PG8_SCHED;
            PG8_LDB(B1, 1, 1); PG8_STAGE(PG8_SB(1, 0), b3, voffB);
            PG8_BAR; PG8_WAIT_L(0); PG8_MMA(0, 1, At, B1); PG8_BAR;
            PG8_LDA(At, 1, 1); PG8_STAGE(PG8_SA(1, 0), a3, voffA);
            PG8_BAR; PG8_WAIT_L(0); PG8_MMA(1, 0, At, B0); PG8_BAR; PG8_SCHED;
            PG8_STAGE(PG8_SB(1, 1), b3 + hstep, voffB);
            PG8_WAIT_V(6); PG8_BAR; PG8_MMA(1, 1, At, B1); PG8_BAR;
            }
        }
        if constexpr (ALIGN_EPI) { if (wr == 0) PG8_BAR; }
        E(acc, cur, wr, wc, fr, fq);
        if (!has_next) break;
#pragma unroll
        for (int a = 0; a < 2; ++a)
#pragma unroll
            for (int b = 0; b < 2; ++b)
#pragma unroll
                for (int m = 0; m < 4; ++m)
#pragma unroll
                    for (int n = 0; n < 2; ++n) acc[a][b][m][n] = (f32x4){0.f, 0.f, 0.f, 0.f};
        cur = nxt; cA = nA; cB = nB; ++ui;
        if constexpr (ALIGN_EPI) { if (wr == 1) PG8_BAR; }
    }
    PG8_WAIT_V(0);
    if constexpr (!ALIGN_EPI) { if (wr == 0) PG8_BAR; }
    PG8_BAR;
#undef PG8_SA
#undef PG8_SB
#undef PG8_STAGE
#undef PG8_LDA
#undef PG8_LDB
#undef PG8_MMA
#undef PG8_WAIT_V
#undef PG8_WAIT_L
#undef PG8_BAR
#undef PG8_SCHED
}
}

struct SchedPlain {
    pg8::StaticOrder o; const char* A; const char* B; size_t tstep;
    DI bool next(int i, pg8::Unit& u) const { return o.next(i, u); }
    DI const char* abase(const pg8::Unit& u) const { return A + (size_t)u.pm * tstep; }
    DI const char* bbase(const pg8::Unit& u) const { return B + (size_t)u.pn * tstep; }
};
struct SchedBranch {
    pg8::StaticOrder o; const char* A; const char* B; size_t tstep, aslab;
    DI bool next(int i, pg8::Unit& u) const { return o.next(i, u); }
    DI const char* abase(const pg8::Unit& u) const { return A + (size_t)(u.pn >> 2) * aslab + (size_t)u.pm * tstep; }
    DI const char* bbase(const pg8::Unit& u) const { return B + (size_t)u.pn * tstep; }
};
struct SchedMoe {
    pg8::StaticOrder o; const char* A; const char* B; size_t tstepA, tstepB, eslab; const LAS int* texp;
    DI bool next(int i, pg8::Unit& u) const { return o.next(i, u); }
    DI const char* abase(const pg8::Unit& u) const { return A + (size_t)u.pm * tstepA; }
    DI const char* bbase(const pg8::Unit& u) const { return B + (size_t)texp[u.pm] * eslab + (size_t)u.pn * tstepB; }
};

struct EpiStoreBf16 {
    static constexpr bool PERM = true;
    bf16_t* O; int ldc;
    DI void operator()(const f32x4 (&acc)[2][2][4][2], const pg8::Unit& u, int wr, int wc, int fr, int fq) const {
        const int row0 = u.pm * 256 + wr * 64 + fr, col0 = u.pn * 256 + wc * 32 + 8 * fq;
#pragma unroll
        for (int ai = 0; ai < 2; ++ai)
#pragma unroll
            for (int m = 0; m < 4; ++m) { bf16_t* rowp = O + (size_t)(row0 + ai * 128 + m * 16) * ldc + col0;
#pragma unroll
                for (int bj = 0; bj < 2; ++bj) { const f32x4 v0 = acc[ai][bj][m][0], v1 = acc[ai][bj][m][1];
                    u32x4 w; w.x = pk2(v0[0], v0[1]); w.y = pk2(v0[2], v0[3]); w.z = pk2(v1[0], v1[1]); w.w = pk2(v1[2], v1[3]);
                    *(u32x4*)(rowp + bj * 128) = w; } }
    }
};
struct EpiQaRope {
    static constexpr bool PERM = true;
    bf16_t* O; const float* rope;
    DI void operator()(const f32x4 (&acc)[2][2][4][2], const pg8::Unit& u, int wr, int wc, int fr, int fq) const {
        const int row0 = u.pm * 256 + wr * 64 + fr, col0 = u.pn * 256 + wc * 32 + 8 * fq;
#pragma unroll
        for (int ai = 0; ai < 2; ++ai)
#pragma unroll
            for (int m = 0; m < 4; ++m) { const int row = row0 + ai * 128 + m * 16; bf16_t* rowp = O + (size_t)row * 768 + col0;
#pragma unroll
                for (int bj = 0; bj < 2; ++bj) { f32x4 v0 = acc[ai][bj][m][0], v1 = acc[ai][bj][m][1];
                    const int c8 = col0 + bj * 128, p0 = c8 % 96;
                    if (p0 < 32) { const f32x4* cs = (const f32x4*)(rope + (size_t)row * 48 + p0); const f32x4 a = cs[0], b = cs[1];
                        const f32x4 r0 = {v0[0] * a[0] - v0[1] * a[1], v0[1] * a[0] + v0[0] * a[1], v0[2] * a[2] - v0[3] * a[3], v0[3] * a[2] + v0[2] * a[3]};
                        const f32x4 r1 = {v1[0] * b[0] - v1[1] * b[1], v1[1] * b[0] + v1[0] * b[1], v1[2] * b[2] - v1[3] * b[3], v1[3] * b[2] + v1[2] * b[3]};
                        v0 = r0; v1 = r1; }
                    u32x4 w; w.x = pk2(v0[0], v0[1]); w.y = pk2(v0[2], v0[3]); w.z = pk2(v1[0], v1[1]); w.w = pk2(v1[2], v1[3]);
                    *(u32x4*)(rowp + bj * 128) = w; } }
    }
};
struct EpiBranchGate {
    static constexpr bool PERM = true;
    bf16_t* GY; const bf16_t* P; const float* bgate;
    DI void operator()(const f32x4 (&acc)[2][2][4][2], const pg8::Unit& u, int wr, int wc, int fr, int fq) const {
        const int row0 = u.pm * 256 + wr * 64 + fr, col0 = u.pn * 256 + wc * 32 + 8 * fq;
        f32x4 bg[2][2];
#pragma unroll
        for (int bj = 0; bj < 2; ++bj) { bg[bj][0] = *(const f32x4*)(bgate + col0 + bj * 128); bg[bj][1] = *(const f32x4*)(bgate + col0 + bj * 128 + 4); }
#pragma unroll
        for (int ai = 0; ai < 2; ++ai)
#pragma unroll
            for (int m = 0; m < 4; ++m) { const size_t row = (size_t)(row0 + ai * 128 + m * 16);
#pragma unroll
                for (int bj = 0; bj < 2; ++bj) { const f32x4 v0 = acc[ai][bj][m][0], v1 = acc[ai][bj][m][1];
                    const u32x4 gl = *(const u32x4*)(P + row * NP + col0 + bj * 128);
                    const float s0 = fast_sigmoid(bf_lo(gl.x) + bg[bj][0][0]), s1 = fast_sigmoid(bf_hi(gl.x) + bg[bj][0][1]), s2 = fast_sigmoid(bf_lo(gl.y) + bg[bj][0][2]), s3 = fast_sigmoid(bf_hi(gl.y) + bg[bj][0][3]);
                    const float s4 = fast_sigmoid(bf_lo(gl.z) + bg[bj][1][0]), s5 = fast_sigmoid(bf_hi(gl.z) + bg[bj][1][1]), s6 = fast_sigmoid(bf_lo(gl.w) + bg[bj][1][2]), s7 = fast_sigmoid(bf_hi(gl.w) + bg[bj][1][3]);
                    u32x4 w; w.x = pk2(v0[0] * s0, v0[1] * s1); w.y = pk2(v0[2] * s2, v0[3] * s3); w.z = pk2(v1[0] * s4, v1[1] * s5); w.w = pk2(v1[2] * s6, v1[3] * s7);
                    *(u32x4*)(GY + row * 3072 + col0 + bj * 128) = w; } }
    }
};
struct EpiResidual {
    static constexpr bool PERM = false;
    const float* xin; float* xout; const float* gmod;
    DI void operator()(const f32x4 (&acc)[2][2][4][2], const pg8::Unit& u, int wr, int wc, int fr, int fq) const {
        const int row0 = u.pm * 256 + wr * 64 + fr, col0 = u.pn * 256 + wc * 32 + 4 * fq;
        const float* gm = gmod + (size_t)(u.pm >> 3) * 6144 + col0;
        f32x4 gv[2][2];
#pragma unroll
        for (int bj = 0; bj < 2; ++bj)
#pragma unroll
            for (int n = 0; n < 2; ++n) gv[bj][n] = *(const f32x4*)(gm + bj * 128 + n * 16);
#pragma unroll
        for (int ai = 0; ai < 2; ++ai)
#pragma unroll
            for (int m = 0; m < 4; ++m) { const size_t off = (size_t)(row0 + ai * 128 + m * 16) * D_MODEL + col0;
#pragma unroll
                for (int bj = 0; bj < 2; ++bj)
#pragma unroll
                    for (int n = 0; n < 2; ++n) { const f32x4 xv = *(const f32x4*)(xin + off + bj * 128 + n * 16);
                        *(f32x4*)(xout + off + bj * 128 + n * 16) = xv + gv[bj][n] * acc[ai][bj][m][n]; } }
    }
};
struct EpiSwiglu {
    static constexpr bool PERM = false;
    bf16_t* ACT; const float* b1; const LAS int* texp;
    DI void operator()(const f32x4 (&acc)[2][2][4][2], const pg8::Unit& u, int wr, int wc, int fr, int fq) const {
        const int row0 = u.pm * 256 + wr * 64 + fr, e = texp[u.pm];
        const float* bb = b1 + (size_t)e * 2048;
#pragma unroll
        for (int bj = 0; bj < 2; ++bj) { const int j0 = u.pn * 128 + bj * 64 + wc * 16 + 4 * fq;
            const f32x4 ba = *(const f32x4*)(bb + 2 * j0), bc = *(const f32x4*)(bb + 2 * j0 + 4);
            const f32x4 bgt = {ba[0], ba[2], bc[0], bc[2]}, bup = {ba[1], ba[3], bc[1], bc[3]};
#pragma unroll
            for (int ai = 0; ai < 2; ++ai)
#pragma unroll
                for (int m = 0; m < 4; ++m) { const f32x4 g = acc[ai][bj][m][0] + bgt, up = acc[ai][bj][m][1] + bup; float o[4];
#pragma unroll
                    for (int i = 0; i < 4; ++i) { const float gg = fminf(g[i], 7.0f), uu = fminf(fmaxf(up[i], -7.0f), 7.0f);
                        o[i] = (uu + 1.0f) * gg * fast_sigmoid(1.702f * gg); }
                    u32x2 w; w.x = pk2(o[0], o[1]); w.y = pk2(o[2], o[3]);
                    *(u32x2*)(ACT + (size_t)(row0 + ai * 128 + m * 16) * D_EXP + j0) = w; } }
    }
};
struct EpiMoeOut {
    static constexpr bool PERM = true;
    bf16_t* Y; const float* b2; const float* gate; const LAS int* texp;
    DI void operator()(const f32x4 (&acc)[2][2][4][2], const pg8::Unit& u, int wr, int wc, int fr, int fq) const {
        const int row0 = u.pm * 256 + wr * 64 + fr, col0 = u.pn * 256 + wc * 32 + 8 * fq, e = texp[u.pm];
        const float* bb = b2 + (size_t)e * D_MODEL + col0;
        f32x4 bv[2][2];
#pragma unroll
        for (int bj = 0; bj < 2; ++bj) { bv[bj][0] = *(const f32x4*)(bb + bj * 128); bv[bj][1] = *(const f32x4*)(bb + bj * 128 + 4); }
#pragma unroll
        for (int ai = 0; ai < 2; ++ai)
#pragma unroll
            for (int m = 0; m < 4; ++m) { const int row = row0 + ai * 128 + m * 16; const float gt = gate[row];
#pragma unroll
                for (int bj = 0; bj < 2; ++bj) { const f32x4 v0 = (acc[ai][bj][m][0] + bv[bj][0]) * gt, v1 = (acc[ai][bj][m][1] + bv[bj][1]) * gt;
                    u32x4 w; w.x = pk2(v0[0], v0[1]); w.y = pk2(v0[2], v0[3]); w.z = pk2(v1[0], v1[1]); w.w = pk2(v1[2], v1[3]);
                    *(u32x4*)(Y + (size_t)row * D_MODEL + col0 + bj * 128) = w; } }
    }
};

constexpr size_t MiB = 1u << 20;
constexpr size_t WS_CTL = 0, CTL_ZERO_BYTES = 1 * MiB;
constexpr size_t WS_MOD = 1 * MiB, WS_ROPE = 2 * MiB, WS_WIN = 8 * MiB, WS_WUQ = 33 * MiB, WS_WUKV = 34 * MiB, WS_WB = 35 * MiB, WS_WOUT = 41 * MiB, WS_W1 = 53 * MiB, WS_W2 = 309 * MiB,
                 WS_X1 = 437 * MiB, WS_H = 565 * MiB, WS_CQ = 629 * MiB, WS_CKV = 645 * MiB, WS_KPE = 661 * MiB, WS_QA = 663 * MiB, WS_KV = 711 * MiB, WS_O3 = 775 * MiB, WS_QC = 871 * MiB,
                 WS_KC = 903 * MiB, WS_VC = 907 * MiB, WS_QI = 911 * MiB, WS_KI = 943 * MiB, WS_IW = 947 * MiB, WS_ROUTE = 948 * MiB, WS_P = 952 * MiB, WS_GY = 1352 * MiB, WS_END = 1544 * MiB;
constexpr size_t WS_XB = WS_P, WS_ACT = WS_P + 272 * MiB, WS_Y = WS_XB;
constexpr size_t RT_TOPE = 0, RT_TOPG = 512 * 1024, RT_RANK = 1 * MiB, RT_SLOTOF = 1 * MiB + 512 * 1024, RT_TOKOF = 2 * MiB, RT_GATEOF = 3 * MiB;
static_assert((size_t)NSLOT_MAX * 1024 * 2 <= 272 * MiB && WS_ACT + 272 * MiB <= WS_END, "MoE overlay");
static_assert((size_t)T_TOK * NP * 2 == 400 * MiB, "P size");
constexpr int CW_BAR = 4096, CW_CNT = 16384;
constexpr int LDS_BYTES = 163840, LDS_X = 131072, MISC_OFF = LDS_BYTES - 512;

struct Frame {
    LAS unsigned char* lds; int tid, lane, wave, G, bid;
    float* out; unsigned char* ws; unsigned* ctl;
};
extern __shared__ __attribute__((aligned(16))) unsigned char lds_raw[];
typedef __attribute__((address_space(4))) const char* kptr_t;
DI const void* kin(int i) {
#if defined(__HIP_DEVICE_COMPILE__)
    kptr_t ka = (kptr_t)__builtin_amdgcn_kernarg_segment_ptr(); asm volatile("" : "+s"(ka)); return (const void*)(GAS const void*)*(__attribute__((address_space(4))) const unsigned long long*)(ka + 8 * i);
#else
    (void)i; return nullptr;
#endif
}
#define KIN_x ((const float*)kin(0))
#define KIN_c ((const float*)kin(1))
#define KIN_pos ((const int*)kin(2))
#define KIN_norm1_g ((const float*)kin(3))
#define KIN_norm2_g ((const float*)kin(4))
#define KIN_w_ada ((const float*)kin(5))
#define KIN_b_ada ((const float*)kin(6))
#define KIN_w_in ((const float*)kin(7))
#define KIN_b_gate ((const float*)kin(8))
#define KIN_q_norm ((const float*)kin(9))
#define KIN_w_uq ((const float*)kin(10))
#define KIN_kv_norm ((const float*)kin(11))
#define KIN_w_ukv ((const float*)kin(12))
#define KIN_conv_w ((const float*)kin(13))
#define KIN_w_branch ((const float*)kin(14))
#define KIN_w_out ((const float*)kin(15))
#define KIN_router_w ((const float*)kin(16))
#define KIN_router_b ((const float*)kin(17))
#define KIN_w1 ((const float*)kin(18))
#define KIN_b1 ((const float*)kin(19))
#define KIN_w2 ((const float*)kin(20))
#define KIN_b2 ((const float*)kin(21))
#define KIN_final_g ((const float*)kin(22))
DI Frame make_frame() {
    Frame F;
    F.lds = (LAS unsigned char*)lds_raw; F.tid = threadIdx.x; asm volatile("" : "+v"(F.tid)); F.lane = F.tid & 63; F.wave = __builtin_amdgcn_readfirstlane(F.tid >> 6); F.G = gridDim.x; F.bid = blockIdx.x;
    F.out = (float*)kin(23); F.ws = (unsigned char*)kin(24); F.ctl = (unsigned*)F.ws;
    return F;
}
#define WSP(T, off) ((T*)(F.ws + (off)))

#define XB_TMO      128
#define XB_XCNT(j)  (256  + 64 * (j))
#define XB_XSUB(j)  (1280 + 64 * (j))
#define XB_XGEN(j)  (2304 + 64 * (j))
#define XB_TOP      3328
#define XB_TOPGEN   3392
#define XCD_BAR_WORDS 3456
#define XB_SPIN_CAP (1u << 18)
DI unsigned xb_ld(unsigned* p)              { return __hip_atomic_load(p, __ATOMIC_RELAXED, __HIP_MEMORY_SCOPE_AGENT); }
DI unsigned xb_add(unsigned* p, unsigned v) { return __hip_atomic_fetch_add(p, v, __ATOMIC_RELAXED, __HIP_MEMORY_SCOPE_AGENT); }
DI unsigned xb_xcc_id() { return (unsigned)__builtin_amdgcn_s_getreg((3 << 11) | 20) & 0xFu; }
#define XB_SPIN(cond, bar) do { unsigned _sp = 0; while (cond) { __builtin_amdgcn_s_sleep(1); \
    if ((++_sp & 255u) == 0u) { if (xb_ld(&(bar)[XB_TMO])) break; if (_sp > XB_SPIN_CAP) { atomicAdd(&(bar)[XB_TMO], 1u); break; } } } } while (0)
struct XcdBarrier { unsigned* bar; unsigned x; volatile LAS unsigned* st; };
DI XcdBarrier xcd_barrier_post(unsigned* bar, volatile LAS unsigned* st) {
    XcdBarrier b; b.bar = bar; b.x = xb_xcc_id(); b.st = st;
    if (threadIdx.x == 0) (void)xb_add(&bar[XB_XCNT(b.x)], 1u);
    return b;
}
DI void xcd_barrier_complete(unsigned* bar, unsigned x, unsigned& nloc, unsigned& nx) {
    const unsigned G = gridDim.x * gridDim.y * gridDim.z;
    unsigned sum, cnt, mine, sp = 0u;
    for (;;) {
        sum = 0u; cnt = 0u; mine = 0u;
#pragma unroll
        for (unsigned j = 0; j < 16; ++j) { const unsigned c = xb_ld(&bar[XB_XCNT(j)]); sum += c; cnt += (c > 0u) ? 1u : 0u; mine = (j == x) ? c : mine; }
        if (sum == G) break;
        __builtin_amdgcn_s_sleep(1);
        if ((++sp & 255u) == 0u) { if (xb_ld(&bar[XB_TMO])) break; if (sp > XB_SPIN_CAP) { atomicAdd(&bar[XB_TMO], 1u); break; } }
    }
    nloc = mine > 0u ? mine : 1u; nx = cnt > 0u ? cnt : 1u;
}
DI void xcd_barrier(const XcdBarrier& b) {
    asm volatile("s_waitcnt vmcnt(0)" ::: "memory");
    __syncthreads();
    if (threadIdx.x == 0) {
        unsigned* bar = b.bar;
        __builtin_amdgcn_s_waitcnt(0);
        unsigned nloc = b.st[0], nx = b.st[1];
        if (nloc == 0u) { xcd_barrier_complete(bar, b.x, nloc, nx); b.st[0] = nloc; b.st[1] = nx; }
        const unsigned old = xb_add(&bar[XB_XSUB(b.x)], 1u);
        const unsigned gen = old / nloc;
        if (old + 1u == (gen + 1u) * nloc) {
            __builtin_amdgcn_fence(__ATOMIC_RELEASE, "agent");
            asm volatile("s_waitcnt vmcnt(0)" ::: "memory");
            const unsigned og = xb_add(&bar[XB_TOP], 1u);
            const unsigned tg = og / nx;
            if (og + 1u == (tg + 1u) * nx) xb_add(&bar[XB_TOPGEN], 1u);
            else XB_SPIN(xb_ld(&bar[XB_TOPGEN]) == tg, bar);
            __builtin_amdgcn_fence(__ATOMIC_ACQUIRE, "agent");
            xb_add(&bar[XB_XGEN(b.x)], 1u);
            asm volatile("s_waitcnt vmcnt(0)" ::: "memory");
        } else {
            XB_SPIN(xb_ld(&bar[XB_XGEN(b.x)]) == gen, bar);
            __builtin_amdgcn_fence(__ATOMIC_ACQUIRE, "agent");
            asm volatile("s_waitcnt vmcnt(0)" ::: "memory");
        }
    }
    __syncthreads();
}

DI int rope_perm(int p, int half) { return (p < 2 * half) ? (p >> 1) + half * (p & 1) : p; }
DI int cmap_in(int r) {
    if (r < PC_CONV) return OC_GATE + r;
    if (r < PC_DQ) return OC_CONV + (r - PC_CONV);
    if (r < PC_IQ) { const int j = r - PC_DQ; return OC_DQ + (j & ~63) + rope_perm(j & 63, 8); }
    if (r < PC_QLAT) { const int j = r - PC_IQ; return OC_IQ + (j & ~63) + rope_perm(j & 63, 8); }
    if (r < PC_KVLAT) return OC_QLAT + (r - PC_QLAT);
    if (r < PC_DKV) { const int j = r - PC_KVLAT; return j < 128 ? OC_KVLAT + j : OC_KVLAT + 128 + rope_perm(j - 128, 16); }
    if (r < PC_IK) { const int j = r - PC_DKV; return j < 64 ? OC_DKV + rope_perm(j, 8) : OC_DKV + j; }
    if (r < PC_IW) return OC_IK + rope_perm(r - PC_IK, 8);
    if (r < IN_COLS) return OC_IW + (r - PC_IW);
    return -1;
}
DI int cmap_uq(int r) { const int h = r / 96, p = r % 96; return h * 96 + rope_perm(p, 16); }
DI int cmap_w1(int R) { const int pn = R >> 8, rem = R & 255, bj = rem >> 7, wc = (rem >> 5) & 3, n = (rem >> 4) & 1, f = rem & 15; return 2 * (pn * 128 + bj * 64 + wc * 16 + f) + n; }
DI void transpose_item(const float* W, int K, int N, bf16_t* WT, int ldk, int koff, LAS float* scr, int k0, int n0, int csrc, int lane) {
#pragma unroll 8
    for (int i = 0; i < 32; ++i) { const int kk = 2 * i + (lane >> 5); float v = 0.f; if (csrc >= 0 && k0 + kk < K) v = W[(size_t)(k0 + kk) * N + csrc]; scr[kk * 33 + (lane & 31)] = v; }
    LDS_WAIT(); asm volatile("" ::: "memory");
    const int c = lane & 7;
#pragma unroll
    for (int j = 0; j < 4; ++j) { const int n = (lane >> 3) + 8 * j; const LAS float* s = scr + (8 * c) * 33 + n;
        u32x4 o; o.x = pk2(s[0 * 33], s[1 * 33]); o.y = pk2(s[2 * 33], s[3 * 33]); o.z = pk2(s[4 * 33], s[5 * 33]); o.w = pk2(s[6 * 33], s[7 * 33]);
        *(u32x4*)(WT + (size_t)(n0 + n) * ldk + koff + k0 + 8 * c) = o; }
    LDS_WAIT(); asm volatile("" ::: "memory");
}
DI void sincos_d(double x, float& s, float& c) {
    const double kd = __builtin_rint(x * 0.6366197723675814); const int k = (int)kd;
    double r = __builtin_fma(-kd, 1.5707963267948966, x); r = __builtin_fma(-kd, 6.123233995736766e-17, r);
    const double r2 = r * r;
    const double sp = r * (1.0 + r2 * (-1.0 / 6 + r2 * (1.0 / 120 + r2 * (-1.0 / 5040 + r2 * (1.0 / 362880 + r2 * (-1.0 / 39916800 + r2 * (1.0 / 6227020800.0)))))));
    const double cp = 1.0 + r2 * (-0.5 + r2 * (1.0 / 24 + r2 * (-1.0 / 720 + r2 * (1.0 / 40320 + r2 * (-1.0 / 3628800 + r2 * (1.0 / 479001600.0 + r2 * (-1.0 / 87178291200.0)))))));
    const int q = k & 3;
    const double ss = (q == 0) ? sp : (q == 1) ? cp : (q == 2) ? -sp : -cp;
    const double cc = (q == 0) ? cp : (q == 1) ? -sp : (q == 2) ? -cp : sp;
    s = (float)ss; c = (float)cc;
}
DI void phase_prologue(const Frame& F) {
    const int tid = F.tid, lane = F.lane, wave = F.wave;
    const float* in_c = KIN_c; const float* in_wada = KIN_w_ada; const float* in_bada = KIN_b_ada; const int* in_pos = KIN_pos;
    if (F.bid < 192) {
        LAS float* cact = (LAS float*)F.lds;
        LAS float* red = (LAS float*)(F.lds + 65536);
        for (int idx = tid; idx < 16 * 1024; idx += 512) { const int b = idx >> 10, k = idx & 1023; const float cv = in_c[idx]; cact[k * 16 + b] = cv * fast_sigmoid(cv); }
        __syncthreads();
        float* MOD = WSP(float, WS_MOD);
        for (int it = F.bid; it < 192; it += F.G) {
            const int l = it / 96, cb = it % 96, col = cb * 64 + lane;
            float acc[16];
#pragma unroll
            for (int b = 0; b < 16; ++b) acc[b] = 0.f;
            const float* wp = in_wada + ((size_t)l * 1024 + wave * 128) * 6144 + col;
#pragma unroll 4
            for (int kk = 0; kk < 128; ++kk) { const float wv = wp[(size_t)kk * 6144]; const LAS f32x4* cp = (const LAS f32x4*)(cact + (wave * 128 + kk) * 16);
#pragma unroll
                for (int q = 0; q < 4; ++q) { const f32x4 cv = cp[q]; acc[4 * q] += cv[0] * wv; acc[4 * q + 1] += cv[1] * wv; acc[4 * q + 2] += cv[2] * wv; acc[4 * q + 3] += cv[3] * wv; } }
#pragma unroll
            for (int b = 0; b < 16; ++b) red[(wave * 16 + b) * 64 + lane] = acc[b];
            __syncthreads();
            for (int o = tid; o < 1024; o += 512) { const int b = o >> 6, ln = o & 63; float s = in_bada[l * 6144 + cb * 64 + ln];
#pragma unroll
                for (int w = 0; w < 8; ++w) s += red[(w * 16 + b) * 64 + ln];
                MOD[((size_t)l * 16 + b) * 6144 + cb * 64 + ln] = s; }
            __syncthreads();
        }
    }
    __syncthreads();
    {
        float* ROPE = WSP(float, WS_ROPE);
        const double r16 = 0.44036660267178046;
        for (int idx = F.bid * 512 + tid; idx < T_TOK * 24; idx += F.G * 512) {
            const int t = idx / 24, i = idx % 24; const int e = (i < 16) ? i : 2 * (i - 16);
            double f = 1.0; for (int j = 0; j < e; ++j) f *= r16;
            float s, c; sincos_d((double)in_pos[t] * f, s, c);
            ROPE[(size_t)t * 48 + 2 * i] = c; ROPE[(size_t)t * 48 + 2 * i + 1] = s;
        }
    }
    {
        LAS float* scr = (LAS float*)(F.lds + wave * 16384);
        const int gw = F.bid * 8 + wave, NGW = F.G * 8;
        constexpr int I_IN = 16 * 200, I_UQ = 4 * 24, I_UKV = 4 * 32, I_WB = 8 * 32, I_WO = 16 * 32, I_W1 = 16 * 64, I_W2 = 16 * 32;
        constexpr int N_IN = 2 * I_IN, N_UQ = 2 * I_UQ, N_UKV = 2 * I_UKV, N_WB = 6 * I_WB, N_WO = 6 * I_WO, N_W1 = 64 * I_W1, N_W2 = 64 * I_W2;
        constexpr int NITEMS = N_IN + N_UQ + N_UKV + N_WB + N_WO + N_W1 + N_W2;
        for (int it = gw; it < NITEMS; it += NGW) {
            int r = it;
            if (r < N_IN) { const int l = r / I_IN, q = r % I_IN, kb = q / 200, nb = q % 200;
                transpose_item(KIN_w_in + (size_t)l * 1024 * IN_COLS, 1024, IN_COLS, WSP(bf16_t, WS_WIN) + (size_t)l * NP * 1024, 1024, 0, scr, 64 * kb, 32 * nb, cmap_in(32 * nb + (lane & 31)), lane); continue; } r -= N_IN;
            if (r < N_UQ) { const int l = r / I_UQ, q = r % I_UQ, kb = q / 24, nb = q % 24;
                transpose_item(KIN_w_uq + (size_t)l * 256 * 768, 256, 768, WSP(bf16_t, WS_WUQ) + (size_t)l * 768 * 256, 256, 0, scr, 64 * kb, 32 * nb, cmap_uq(32 * nb + (lane & 31)), lane); continue; } r -= N_UQ;
            if (r < N_UKV) { const int l = r / I_UKV, q = r % I_UKV, kb = q / 32, nb = q % 32;
                transpose_item(KIN_w_ukv + (size_t)l * 128 * 1024, 128, 1024, WSP(bf16_t, WS_WUKV) + (size_t)l * 1024 * 256, 256, 0, scr, 64 * kb, 32 * nb, 32 * nb + (lane & 31), lane); continue; } r -= N_UKV;
            if (r < N_WB) { const int j = r / I_WB, q = r % I_WB, kb = q / 32, nb = q % 32;
                transpose_item(KIN_w_branch + (size_t)j * 512 * 1024, 512, 1024, WSP(bf16_t, WS_WB) + (size_t)j * 1024 * 512, 512, 0, scr, 64 * kb, 32 * nb, 32 * nb + (lane & 31), lane); continue; } r -= N_WB;
            if (r < N_WO) { const int j = r / I_WO, q = r % I_WO, kb = q / 32, nb = q % 32; const int l = j / 3, cp = j % 3;
                transpose_item(KIN_w_out + (size_t)l * 1024 * 1024, 1024, 1024, WSP(bf16_t, WS_WOUT) + (size_t)l * 1024 * 3072, 3072, cp * 1024, scr, 64 * kb, 32 * nb, 32 * nb + (lane & 31), lane); continue; } r -= N_WO;
            if (r < N_W1) { const int j = r / I_W1, q = r % I_W1, kb = q / 64, nb = q % 64;
                transpose_item(KIN_w1 + (size_t)j * 1024 * 2048, 1024, 2048, WSP(bf16_t, WS_W1) + (size_t)j * 2048 * 1024, 1024, 0, scr, 64 * kb, 32 * nb, cmap_w1(32 * nb + (lane & 31)), lane); continue; } r -= N_W1;
            { const int j = r / I_W2, q = r % I_W2, kb = q / 32, nb = q % 32;
                transpose_item(KIN_w2 + (size_t)j * 1024 * 1024, 1024, 1024, WSP(bf16_t, WS_W2) + (size_t)j * 1024 * 1024, 1024, 0, scr, 64 * kb, 32 * nb, 32 * nb + (lane & 31), lane); }
        }
    }
}

DI void phase_norm(const Frame& F, const float* xin, float* xout, bool combine, bool write_x, bool final_, int lnext, int lcomb) {
    const int lane = F.lane, gw = F.bid * 8 + F.wave, NGW = F.G * 8;
    const float* in_fg = KIN_final_g; const float* in_n1 = KIN_norm1_g;
    const float* MOD = WSP(float, WS_MOD); const bf16_t* Y = WSP(bf16_t, WS_Y); const int* SLOTOF = (const int*)(F.ws + WS_ROUTE + RT_SLOTOF); bf16_t* H = WSP(bf16_t, WS_H);
    for (int t = gw; t < T_TOK; t += NGW) {
        const int b = t >> 11; f32x4 v[4];
#pragma unroll
        for (int i = 0; i < 4; ++i) v[i] = *(const f32x4*)(xin + (size_t)t * 1024 + 4 * lane + 256 * i);
        if (combine) {
            const int s0 = SLOTOF[t * 4], s1 = SLOTOF[t * 4 + 1], s2 = SLOTOF[t * 4 + 2], s3 = SLOTOF[t * 4 + 3];
            const float* g2 = MOD + ((size_t)lcomb * 16 + b) * 6144 + 5 * 1024;
#pragma unroll
            for (int i = 0; i < 4; ++i) { const int co = 4 * lane + 256 * i;
                const u32x2 a = *(const u32x2*)(Y + (size_t)s0 * 1024 + co), bq = *(const u32x2*)(Y + (size_t)s1 * 1024 + co), cq = *(const u32x2*)(Y + (size_t)s2 * 1024 + co), dq = *(const u32x2*)(Y + (size_t)s3 * 1024 + co);
                f32x4 sum = {bf_lo(a.x) + bf_lo(bq.x) + bf_lo(cq.x) + bf_lo(dq.x), bf_hi(a.x) + bf_hi(bq.x) + bf_hi(cq.x) + bf_hi(dq.x),
                             bf_lo(a.y) + bf_lo(bq.y) + bf_lo(cq.y) + bf_lo(dq.y), bf_hi(a.y) + bf_hi(bq.y) + bf_hi(cq.y) + bf_hi(dq.y)};
                v[i] += *(const f32x4*)(g2 + co) * sum; }
            if (write_x) {
#pragma unroll
                for (int i = 0; i < 4; ++i) *(f32x4*)(xout + (size_t)t * 1024 + 4 * lane + 256 * i) = v[i]; }
        }
        float ss = 0.f;
#pragma unroll
        for (int i = 0; i < 4; ++i) ss += (v[i][0] * v[i][0] + v[i][1] * v[i][1]) + (v[i][2] * v[i][2] + v[i][3] * v[i][3]);
        ss = wave_sum(ss); const float r = 1.0f / sqrtf(ss * (1.0f / 1024.0f) + NORM_EPS);
        if (final_) {
#pragma unroll
            for (int i = 0; i < 4; ++i) { const int co = 4 * lane + 256 * i; *(f32x4*)(F.out + (size_t)t * 1024 + co) = v[i] * r * *(const f32x4*)(in_fg + co); }
        } else {
            const float* md = MOD + ((size_t)lnext * 16 + b) * 6144;
#pragma unroll
            for (int i = 0; i < 4; ++i) { const int co = 4 * lane + 256 * i;
                const f32x4 g = *(const f32x4*)(in_n1 + lnext * 1024 + co), sc = *(const f32x4*)(md + 1024 + co), sh = *(const f32x4*)(md + co);
                const f32x4 h = v[i] * r * g * (sc + 1.0f) + sh; u32x2 w; w.x = pk2(h[0], h[1]); w.y = pk2(h[2], h[3]);
                *(u32x2*)(H + (size_t)t * 1024 + co) = w; }
        }
    }
}
DI u32x4 rope8(u32x4 a, const float* cs) {
    const f32x4 c0 = *(const f32x4*)cs, c1 = *(const f32x4*)(cs + 4); u32x4 o;
    { const float x1 = bf_lo(a.x), x2 = bf_hi(a.x); o.x = pk2(x1 * c0[0] - x2 * c0[1], x2 * c0[0] + x1 * c0[1]); }
    { const float x1 = bf_lo(a.y), x2 = bf_hi(a.y); o.y = pk2(x1 * c0[2] - x2 * c0[3], x2 * c0[2] + x1 * c0[3]); }
    { const float x1 = bf_lo(a.z), x2 = bf_hi(a.z); o.z = pk2(x1 * c1[0] - x2 * c1[1], x2 * c1[0] + x1 * c1[1]); }
    { const float x1 = bf_lo(a.w), x2 = bf_hi(a.w); o.w = pk2(x1 * c1[2] - x2 * c1[3], x2 * c1[2] + x1 * c1[3]); }
    return o;
}
DI void unpack8(u32x4 a, float (&v)[8]) { v[0] = bf_lo(a.x); v[1] = bf_hi(a.x); v[2] = bf_lo(a.y); v[3] = bf_hi(a.y); v[4] = bf_lo(a.z); v[5] = bf_hi(a.z); v[6] = bf_lo(a.w); v[7] = bf_hi(a.w); }
DI void phase_post(const Frame& F, int l) {
    const int lane = F.lane, gw = F.bid * 8 + F.wave, NGW = F.G * 8;
    const bf16_t* P = WSP(bf16_t, WS_P); const float* ROPE = WSP(float, WS_ROPE);
    bf16_t *CQ = WSP(bf16_t, WS_CQ), *CKV = WSP(bf16_t, WS_CKV), *KPE = WSP(bf16_t, WS_KPE), *OB = WSP(bf16_t, WS_O3) + (size_t)T_TOK * 512, *QC = WSP(bf16_t, WS_QC), *KC = WSP(bf16_t, WS_KC),
           *VC = WSP(bf16_t, WS_VC), *QI = WSP(bf16_t, WS_QI), *KI = WSP(bf16_t, WS_KI); float* IW = WSP(float, WS_IW);
    const float* cw = KIN_conv_w + (size_t)l * 3 * 512; const float* in_qn = KIN_q_norm + l * 256; const float* in_kn = KIN_kv_norm + l * 128;
    for (int t = gw; t < T_TOK; t += NGW) {
        const bf16_t* pr = P + (size_t)t * NP; const float* rp = ROPE + (size_t)t * 48; const int s = t & (SEQ - 1);
        {
            float gb[8], acc[8]; unpack8(*(const u32x4*)(pr + PC_CONV + 8 * lane), gb);
#pragma unroll
            for (int i = 0; i < 8; ++i) acc[i] = 0.f;
#pragma unroll
            for (int d = 0; d < 3; ++d) { if (s - 2 + d >= 0) { const bf16_t* q = pr - (size_t)(2 - d) * NP + PC_CONV + 8 * lane; float gc[8], hc[8]; unpack8(*(const u32x4*)(q + 512), gc); unpack8(*(const u32x4*)(q + 1024), hc);
                    const f32x4 w0 = *(const f32x4*)(cw + d * 512 + 8 * lane), w1 = *(const f32x4*)(cw + d * 512 + 8 * lane + 4);
#pragma unroll
                    for (int i = 0; i < 4; ++i) { acc[i] += w0[i] * (gc[i] * hc[i]); acc[4 + i] += w1[i] * (gc[4 + i] * hc[4 + i]); } } }
            u32x4 o; o.x = pk2(gb[0] * acc[0], gb[1] * acc[1]); o.y = pk2(gb[2] * acc[2], gb[3] * acc[3]); o.z = pk2(gb[4] * acc[4], gb[5] * acc[5]); o.w = pk2(gb[6] * acc[6], gb[7] * acc[7]);
            *(u32x4*)(OB + (size_t)t * 512 + 8 * lane) = o;
        }
        {
            u32x4 a = *(const u32x4*)(pr + PC_DQ + 8 * lane), b = *(const u32x4*)(pr + PC_IQ + 8 * lane);
            if ((lane & 7) < 2) { a = rope8(a, rp + 32 + 8 * (lane & 7)); b = rope8(b, rp + 32 + 8 * (lane & 7)); }
            *(u32x4*)(QC + (size_t)t * 512 + 8 * lane) = a; *(u32x4*)(QI + (size_t)t * 512 + 8 * lane) = b;
        }
        {
            float v[8]; u32x4 a = {0u, 0u, 0u, 0u}; if (lane < 32) a = *(const u32x4*)(pr + PC_QLAT + 8 * lane); unpack8(a, v);
            float ss = 0.f;
#pragma unroll
            for (int i = 0; i < 8; ++i) ss += v[i] * v[i];
            ss = wave_sum(ss); const float r = 1.0f / sqrtf(ss * (1.0f / 256.0f) + NORM_EPS);
            if (lane < 32) { const f32x4 g0 = *(const f32x4*)(in_qn + 8 * lane), g1 = *(const f32x4*)(in_qn + 8 * lane + 4);
                u32x4 o; o.x = pk2(v[0] * r * g0[0], v[1] * r * g0[1]); o.y = pk2(v[2] * r * g0[2], v[3] * r * g0[3]); o.z = pk2(v[4] * r * g1[0], v[5] * r * g1[1]); o.w = pk2(v[6] * r * g1[2], v[7] * r * g1[3]);
                *(u32x4*)(CQ + (size_t)t * 256 + 8 * lane) = o; }
        }
        {
            float v[8]; u32x4 a = {0u, 0u, 0u, 0u}; if (lane < 20) a = *(const u32x4*)(pr + PC_KVLAT + 8 * lane); unpack8(a, v);
            float ss = 0.f;
            if (lane < 16) {
#pragma unroll
                for (int i = 0; i < 8; ++i) ss += v[i] * v[i]; }
            ss = wave_sum(ss); const float r = 1.0f / sqrtf(ss * (1.0f / 128.0f) + NORM_EPS);
            if (lane < 16) { const f32x4 g0 = *(const f32x4*)(in_kn + 8 * lane), g1 = *(const f32x4*)(in_kn + 8 * lane + 4);
                u32x4 o; o.x = pk2(v[0] * r * g0[0], v[1] * r * g0[1]); o.y = pk2(v[2] * r * g0[2], v[3] * r * g0[3]); o.z = pk2(v[4] * r * g1[0], v[5] * r * g1[1]); o.w = pk2(v[6] * r * g1[2], v[7] * r * g1[3]);
                *(u32x4*)(CKV + (size_t)t * 256 + 8 * lane) = o; }
            else if (lane < 32) { *(u32x4*)(CKV + (size_t)t * 256 + 8 * lane) = (u32x4){0u, 0u, 0u, 0u}; }
            if (lane >= 16 && lane < 20) *(u32x4*)(KPE + (size_t)t * 32 + 8 * (lane - 16)) = rope8(a, rp + 8 * (lane - 16));
        }
        if (lane < 16) {
            u32x4 a = *(const u32x4*)(pr + PC_DKV + 8 * lane); if (lane < 2) a = rope8(a, rp + 32 + 8 * lane);
            if (lane < 8) *(u32x4*)(KC + (size_t)t * 64 + 8 * lane) = a; else *(u32x4*)(VC + (size_t)t * 64 + 8 * (lane - 8)) = a;
        }
        if (lane >= 16 && lane < 24) {
            const int c = lane - 16; u32x4 a = *(const u32x4*)(pr + PC_IK + 8 * c); if (c < 2) a = rope8(a, rp + 32 + 8 * c);
            *(u32x4*)(KI + (size_t)t * 64 + 8 * c) = a;
        }
        if (lane == 32) { float v[8]; unpack8(*(const u32x4*)(pr + PC_IW), v); *(f32x4*)(IW + (size_t)t * 8) = (f32x4){v[0], v[1], v[2], v[3]}; *(f32x4*)(IW + (size_t)t * 8 + 4) = (f32x4){v[4], v[5], v[6], v[7]}; }
    }
}

DI int crow(int r, int hi) { return (r & 3) + 8 * (r >> 2) + 4 * hi; }
#define MFMA32(a, b, c) __builtin_amdgcn_mfma_f32_32x32x16_bf16((a), (b), (c), 0, 0, 0)
#define MFMA16(a, b, c) __builtin_amdgcn_mfma_f32_16x16x32_bf16((a), (b), (c), 0, 0, 0)
#define GLDS16(src, dst) __builtin_amdgcn_global_load_lds((const unsigned*)(src), (LAS unsigned*)(dst), 16, 0, 0)
typedef short v4i16_t __attribute__((ext_vector_type(4)));
DI s16x4 tr_read(const LAS unsigned char* p) { return __builtin_bit_cast(s16x4, __builtin_amdgcn_ds_read_tr16_b64_v4i16((LAS v4i16_t*)p)); }
DI bf16x8 pack8(float a0, float a1, float a2, float a3, float a4, float a5, float a6, float a7) { u32x4 w; w.x = pk2(a0, a1); w.y = pk2(a2, a3); w.z = pk2(a4, a5); w.w = pk2(a6, a7); return __builtin_bit_cast(bf16x8, w); }
DI bf16x8 cat4(s16x4 lo, s16x4 hi) { return (bf16x8){lo[0], lo[1], lo[2], lo[3], hi[0], hi[1], hi[2], hi[3]}; }

constexpr int MLA_K0 = 0, MLA_V0 = 24576, MLA_WS = 40960;
DI void mla_unit(const Frame& F, int b, int h, int qb) {
    const int lane = F.lane, wid = F.wave, r32 = lane & 31, hi = lane >> 5;
    const bf16_t* QA = WSP(bf16_t, WS_QA); const bf16_t* KPE = WSP(bf16_t, WS_KPE); const bf16_t* KV = WSP(bf16_t, WS_KV); bf16_t* OA = WSP(bf16_t, WS_O3);
    const size_t tb = (size_t)b * SEQ; const int q0 = qb * 256, qrow = q0 + 32 * wid + r32;
    const float C2 = 0.10206207261596577f * 1.4426950408889634f;
    LAS unsigned char* lds = F.lds; LAS float* wsf = (LAS float*)(lds + MLA_WS) + wid * 128;
    bf16x8 qr[6];
#pragma unroll
    for (int d0 = 0; d0 < 6; ++d0) qr[d0] = *(const bf16x8*)(QA + (tb + qrow) * 768 + h * 96 + d0 * 16 + hi * 8);
    {
        const float* rp = WSP(float, WS_ROPE) + (tb + qrow) * 48;
        qr[0] = __builtin_bit_cast(bf16x8, rope8(__builtin_bit_cast(u32x4, qr[0]), rp + 8 * hi));
        qr[1] = __builtin_bit_cast(bf16x8, rope8(__builtin_bit_cast(u32x4, qr[1]), rp + 16 + 8 * hi)); }
    const int NT = 4 * (qb + 1);
#define MLA_STAGE(kt, buf) do { const size_t krow_ = tb + (size_t)(kt) * 64 + lane; \
        const bf16_t* s0_ = (wid < 4) ? KPE + krow_ * 32 + 8 * wid : KV + krow_ * 1024 + 128 * h + 8 * (wid - 4); \
        GLDS16(s0_, lds + MLA_K0 + (buf) * 12288 + wid * 1024); \
        if (wid < 4) { const bf16_t* s1_ = KV + krow_ * 1024 + 128 * h + 8 * (wid + 4); GLDS16(s1_, lds + MLA_K0 + (buf) * 12288 + (wid + 8) * 1024); } \
        const bf16_t* v_ = KV + (tb + (size_t)(kt) * 64 + 16 * (wid & 3) + (lane >> 2)) * 1024 + 128 * h + 64 + 32 * (wid >> 2) + 8 * (lane & 3); \
        GLDS16(v_, lds + MLA_V0 + (buf) * 8192 + wid * 1024); } while (0)
    MLA_STAGE(0, 0);
    float m = -1e30f, l = 0.f; f32x16 o[2];
#pragma unroll
    for (int r = 0; r < 16; ++r) { o[0][r] = 0.f; o[1][r] = 0.f; }
    const int vboff = ((lane >> 4) & 1) * 32 + (lane & 3) * 8 + (4 * hi + ((lane & 15) >> 2)) * 64;
    for (int kt = 0; kt < NT; ++kt) {
        const int buf = kt & 1;
        VM_WAIT(); __syncthreads();
        if (kt + 1 < NT) MLA_STAGE(kt + 1, buf ^ 1);
        if (64 * kt <= q0 + 32 * wid + 31) {
            f32x16 p0, p1;
#pragma unroll
            for (int r = 0; r < 16; ++r) { p0[r] = 0.f; p1[r] = 0.f; }
            const LAS unsigned char* kb = lds + MLA_K0 + buf * 12288 + hi * 1024 + r32 * 16;
#pragma unroll
            for (int d0 = 0; d0 < 6; ++d0) { const bf16x8 b0 = *(const LAS bf16x8*)(kb + d0 * 2048), b1 = *(const LAS bf16x8*)(kb + d0 * 2048 + 512);
                p0 = MFMA32(b0, qr[d0], p0); p1 = MFMA32(b1, qr[d0], p1); }
            if (64 * kt + 63 > q0 + 32 * wid) {
#pragma unroll
                for (int r = 0; r < 16; ++r) { const int kv = 64 * kt + crow(r, hi); if (kv > qrow) p0[r] = -INFINITY; if (kv + 32 > qrow) p1[r] = -INFINITY; } }
            float rm = fmaxf(p0[0], p1[0]);
#pragma unroll
            for (int r = 1; r < 16; ++r) rm = fmaxf(rm, fmaxf(p0[r], p1[r]));
            rm = fmaxf(rm, __shfl_xor(rm, 32));
            const float mn = fmaxf(m, rm);
            if (__any(mn > m)) {
                const float alpha = __builtin_amdgcn_exp2f((m - mn) * C2); l *= alpha; m = mn;
                if (hi == 0) wsf[r32] = alpha;
                LDS_WAIT();
#pragma unroll
                for (int q = 0; q < 4; ++q) { const f32x4 a = *(const LAS f32x4*)(wsf + 8 * q + 4 * hi);
#pragma unroll
                    for (int j = 0; j < 4; ++j) { o[0][4 * q + j] *= a[j]; o[1][4 * q + j] *= a[j]; } }
            }
            const float mc = m * C2; float ls = 0.f;
#pragma unroll
            for (int r = 0; r < 16; ++r) { p0[r] = __builtin_amdgcn_exp2f(__builtin_fmaf(p0[r], C2, -mc)); p1[r] = __builtin_amdgcn_exp2f(__builtin_fmaf(p1[r], C2, -mc)); ls += p0[r] + p1[r]; }
            l += ls;
            bf16x8 pa[4];
            pa[0] = pack8(p0[0], p0[1], p0[2], p0[3], p0[4], p0[5], p0[6], p0[7]); pa[1] = pack8(p0[8], p0[9], p0[10], p0[11], p0[12], p0[13], p0[14], p0[15]);
            pa[2] = pack8(p1[0], p1[1], p1[2], p1[3], p1[4], p1[5], p1[6], p1[7]); pa[3] = pack8(p1[8], p1[9], p1[10], p1[11], p1[12], p1[13], p1[14], p1[15]);
            const LAS unsigned char* vb = lds + MLA_V0 + buf * 8192 + vboff;
#pragma unroll
            for (int d0 = 0; d0 < 2; ++d0)
#pragma unroll
                for (int ks = 0; ks < 4; ++ks) { const s16x4 lo = tr_read(vb + d0 * 4096 + ks * 1024), hh = tr_read(vb + d0 * 4096 + ks * 1024 + 512);
                    o[d0] = MFMA32(pa[ks], cat4(lo, hh), o[d0]); }
        }
    }
#undef MLA_STAGE
    l += __shfl_xor(l, 32);
    if (hi == 0) wsf[64 + r32] = 1.0f / l;
    LDS_WAIT();
    bf16_t* orow = OA + (tb + q0 + 32 * wid) * 512 + h * 64 + r32;
#pragma unroll
    for (int q = 0; q < 4; ++q) { const f32x4 a = *(const LAS f32x4*)(wsf + 64 + 8 * q + 4 * hi);
#pragma unroll
        for (int j = 0; j < 4; ++j) { const int r = 4 * q + j, rr = crow(r, hi);
            orow[(size_t)rr * 512] = (bf16_t)(pk2(o[0][r] * a[j], 0.f) & 0xffffu); orow[(size_t)rr * 512 + 32] = (bf16_t)(pk2(o[1][r] * a[j], 0.f) & 0xffffu); } }
    __syncthreads();
}

constexpr int DSA_SCW = 2052;
constexpr int DSA_SEL = 16 * DSA_SCW * 4;
constexpr int DSA_OW = 65536, DSA_ML = 81920;
DI int mbcnt64(unsigned long long m) { return (int)__builtin_amdgcn_mbcnt_hi((unsigned)(m >> 32), __builtin_amdgcn_mbcnt_lo((unsigned)m, 0u)); }
DI void dsa_unit(const Frame& F, int b, int qt) {
    const int tid = F.tid, lane = F.lane, wid = F.wave, fr = lane & 15, g = lane >> 4;
    const bf16_t *QI = WSP(bf16_t, WS_QI), *KI = WSP(bf16_t, WS_KI), *QC = WSP(bf16_t, WS_QC), *KC = WSP(bf16_t, WS_KC), *VC = WSP(bf16_t, WS_VC); const float* IW = WSP(float, WS_IW);
    bf16_t* OC = WSP(bf16_t, WS_O3) + (size_t)2 * T_TOK * 512;
    const size_t tb = (size_t)b * SEQ; const int t0 = 16 * qt;
    LAS unsigned char* lds = F.lds; LAS float* SC = (LAS float*)lds; LAS unsigned short* SEL = (LAS unsigned short*)(lds + DSA_SEL);
    {
        bf16x8 qf[8][2]; float wv[8];
        const bf16_t* qp = QI + (tb + t0 + fr) * 512 + 8 * g;
#pragma unroll
        for (int h = 0; h < 8; ++h) { qf[h][0] = *(const bf16x8*)(qp + h * 64); qf[h][1] = *(const bf16x8*)(qp + h * 64 + 32); }
        { const f32x4 w0 = *(const f32x4*)(IW + (tb + t0 + fr) * 8), w1 = *(const f32x4*)(IW + (tb + t0 + fr) * 8 + 4); wv[0] = w0[0]; wv[1] = w0[1]; wv[2] = w0[2]; wv[3] = w0[3]; wv[4] = w1[0]; wv[5] = w1[1]; wv[6] = w1[2]; wv[7] = w1[3]; }
        for (int kt = wid; kt <= qt; kt += 8) {
            const bf16_t* kp = KI + (tb + 16 * kt + fr) * 64 + 8 * g;
            const bf16x8 a0 = *(const bf16x8*)kp, a1 = *(const bf16x8*)(kp + 32);
            f32x4 s = {0.f, 0.f, 0.f, 0.f};
#pragma unroll
            for (int h = 0; h < 8; ++h) { f32x4 acc = {0.f, 0.f, 0.f, 0.f}; acc = MFMA16(a0, qf[h][0], acc); acc = MFMA16(a1, qf[h][1], acc);
#pragma unroll
                for (int r = 0; r < 4; ++r) s[r] += fmaxf(acc[r], 0.f) * wv[h]; }
#pragma unroll
            for (int r = 0; r < 4; ++r) if (16 * kt + 4 * g + r > t0 + fr) s[r] = -INFINITY;
            *(LAS f32x4*)(SC + fr * DSA_SCW + 16 * kt + 4 * g) = s;
        }
    }
    __syncthreads();
    for (int qi2 = 0; qi2 < 2; ++qi2) {
        const int qq = 2 * wid + qi2, t = t0 + qq, nvalid = t + 1;
        LAS unsigned short* sel = SEL + qq * 256;
        if (nvalid <= 256) { for (int j = lane; j < 256; j += 64) sel[j] = (unsigned short)((j < nvalid) ? j : 0); }
        else {
            unsigned v[32];
#pragma unroll
            for (int i = 0; i < 32; ++i) { const int key = i * 64 + lane; unsigned u = __float_as_uint(SC[qq * DSA_SCW + key]); u = (u & 0x80000000u) ? ~u : (u | 0x80000000u); v[i] = (key <= t) ? u : 0u; }
            unsigned K = 0u;
            for (int bit = 31; bit >= 0; --bit) {
                const unsigned cand = K | (1u << bit); int cnt = 0;
#pragma unroll
                for (int i = 0; i < 32; ++i) cnt += __builtin_popcountll(__ballot(v[i] >= cand));
                if (cnt >= 256) K = cand;
                if (cnt == 256) break;
            }
            int cgt = 0;
#pragma unroll
            for (int i = 0; i < 32; ++i) cgt += __builtin_popcountll(__ballot(v[i] > K));
            const int need = 256 - cgt; int base = 0, eqb = 0;
#pragma unroll
            for (int i = 0; i < 32; ++i) { const bool gt = v[i] > K, eq = v[i] == K; const unsigned long long me = __ballot(eq); const int erank = eqb + mbcnt64(me);
                const bool take = gt || (eq && erank < need); const unsigned long long mt = __ballot(take);
                if (take) sel[base + mbcnt64(mt)] = (unsigned short)(i * 64 + lane);
                base += __builtin_popcountll(mt); eqb += __builtin_popcountll(me); }
        }
    }
    __syncthreads();
    const float C2S = 0.125f * 1.4426950408889634f;
    LAS unsigned char* VST = lds + wid * 8192; LAS float* OW = (LAS float*)(lds + DSA_OW); LAS float* ML = (LAS float*)(lds + DSA_ML);
    for (int step = 0; step < 8; ++step) {
        const int qq = 2 * step + (wid >> 2), part = wid & 3, t = t0 + qq, nsel = (t + 1 < 256) ? t + 1 : 256;
        const LAS unsigned short* sel = SEL + qq * 256 + 64 * part;
#pragma unroll
        for (int i = 0; i < 8; ++i) { const int row = 8 * i + (lane >> 3); const int idx = (64 * part + row < nsel) ? (int)sel[row] : 0;
            GLDS16(VC + (tb + idx) * 64 + 8 * ((lane & 7) ^ (row & 7)), VST + i * 1024); }
        const bf16_t* qp = QC + (tb + t) * 512 + (fr & 7) * 64 + 8 * g;
        const bf16x8 q0 = *(const bf16x8*)qp, q1 = *(const bf16x8*)(qp + 32);
        f32x4 sc[4];
#pragma unroll
        for (int kt = 0; kt < 4; ++kt) { const int idx = (64 * part + 16 * kt + fr < nsel) ? (int)sel[16 * kt + fr] : 0; const bf16_t* kp = KC + (tb + idx) * 64 + 8 * g;
            const bf16x8 a0 = *(const bf16x8*)kp, a1 = *(const bf16x8*)(kp + 32); f32x4 acc = {0.f, 0.f, 0.f, 0.f}; acc = MFMA16(a0, q0, acc); acc = MFMA16(a1, q1, acc); sc[kt] = acc; }
        float mx = -INFINITY;
#pragma unroll
        for (int kt = 0; kt < 4; ++kt)
#pragma unroll
            for (int r = 0; r < 4; ++r) { const float s = (64 * part + 16 * kt + 4 * g + r < nsel) ? sc[kt][r] : -INFINITY; sc[kt][r] = s; mx = fmaxf(mx, s); }
        mx = fmaxf(mx, __shfl_xor(mx, 16)); mx = fmaxf(mx, __shfl_xor(mx, 32));
        const float ms = fmaxf(mx, -1e30f); float ls = 0.f;
#pragma unroll
        for (int kt = 0; kt < 4; ++kt)
#pragma unroll
            for (int r = 0; r < 4; ++r) { const float p = __builtin_amdgcn_exp2f((sc[kt][r] - ms) * C2S); sc[kt][r] = p; ls += p; }
        ls += __shfl_xor(ls, 16); ls += __shfl_xor(ls, 32);
        const bf16x8 pa0 = pack8(sc[0][0], sc[0][1], sc[0][2], sc[0][3], sc[1][0], sc[1][1], sc[1][2], sc[1][3]);
        const bf16x8 pa1 = pack8(sc[2][0], sc[2][1], sc[2][2], sc[2][3], sc[3][0], sc[3][1], sc[3][2], sc[3][3]);
        VM_WAIT();
        f32x4 o[4];
#pragma unroll
        for (int dt = 0; dt < 4; ++dt) { o[dt] = (f32x4){0.f, 0.f, 0.f, 0.f};
#pragma unroll
            for (int ks = 0; ks < 2; ++ks) { const int row = 32 * ks + 4 * g + ((lane & 15) >> 2), p = lane & 3, chunk = dt * 2 + (p >> 1);
                const LAS unsigned char* ad = VST + row * 128 + ((chunk ^ (row & 7)) * 16) + (p & 1) * 8;
                const s16x4 lo = tr_read(ad), hh = tr_read(ad + 2048);
                o[dt] = MFMA16(ks == 0 ? pa0 : pa1, cat4(lo, hh), o[dt]); } }
        if (g < 2) {
#pragma unroll
            for (int dt = 0; dt < 4; ++dt)
#pragma unroll
                for (int r = 0; r < 4; ++r) OW[(wid * 8 + 4 * g + r) * 64 + 16 * dt + fr] = o[dt][r]; }
        if (g == 0 && fr < 8) { ML[wid * 16 + fr] = ms; ML[wid * 16 + 8 + fr] = ls; }
        __syncthreads();
        {
            const int qh = tid >> 8, head = (tid >> 5) & 7, d = 2 * (tid & 31), tq = t0 + 2 * step + qh;
            float M = -1e30f;
#pragma unroll
            for (int w4 = 0; w4 < 4; ++w4) M = fmaxf(M, ML[(4 * qh + w4) * 16 + head]);
            float den = 0.f, n0 = 0.f, n1 = 0.f;
#pragma unroll
            for (int w4 = 0; w4 < 4; ++w4) { const int w = 4 * qh + w4; const float e = __builtin_amdgcn_exp2f((ML[w * 16 + head] - M) * C2S); den += e * ML[w * 16 + 8 + head];
                const f32x2 ov = *(const LAS f32x2*)(OW + (w * 8 + head) * 64 + d); n0 += e * ov[0]; n1 += e * ov[1]; }
            const float inv = 1.0f / den;
            *(unsigned*)(OC + (tb + tq) * 512 + head * 64 + d) = pk2(n0 * inv, n1 * inv);
        }
        __syncthreads();
    }
}
DI void phase_attention(const Frame& F) {
    for (int U = F.bid; U < 1024; U += F.G) { const int i = U >> 8, cp = U & 255, half = cp >> 7, rem = cp & 127; mla_unit(F, rem & 15, rem >> 4, 2 * i + (half ^ (i & 1))); }
    __syncthreads();
    for (int U = F.bid; U < 2048; U += F.G) { const int i = U >> 8, cp = U & 255; dsa_unit(F, cp & 15, 16 * i + (cp >> 4)); }
}

constexpr int N2_LG = LDS_X, N2_CNT = LDS_X + 1024, N2_BASE = LDS_X + 1152, N2_TOK = LDS_X + 1280;
DI void phase_router(const Frame& F, int l) {
    const int tid = F.tid, lane = F.lane, wave = F.wave;
    LAS float* RW = (LAS float*)F.lds;
    LAS float* LG = (LAS float*)(F.lds + N2_LG) + wave * 32;
    LAS int* CNT = (LAS int*)(F.lds + N2_CNT); LAS int* BASE = (LAS int*)(F.lds + N2_BASE); LAS int* TOKR = (LAS int*)(F.lds + N2_TOK);
    const float* X1 = WSP(float, WS_X1); const float* MOD = WSP(float, WS_MOD); bf16_t* H = WSP(bf16_t, WS_H);
    const float* in_n2 = KIN_norm2_g + l * 1024; const float* in_rb = KIN_router_b + l * 32; const float* in_rw = KIN_router_w + (size_t)l * 32768;
    int* TOPE = (int*)(F.ws + WS_ROUTE + RT_TOPE); float* TOPG = (float*)(F.ws + WS_ROUTE + RT_TOPG); int* RANK = (int*)(F.ws + WS_ROUTE + RT_RANK);
    for (int idx = tid; idx < 32 * 1024; idx += 512) RW[(idx & 31) * 1024 + (idx >> 5)] = in_rw[idx];
    __syncthreads();
    for (int chunk = F.bid; chunk < T_TOK / 128; chunk += F.G) {
        if (tid < 32) CNT[tid] = 0;
        __syncthreads();
        for (int j = 0; j < 16; ++j) {
            const int tl = wave * 16 + j, t = chunk * 128 + tl, b = t >> 11;
            const float* md = MOD + ((size_t)l * 16 + b) * 6144;
            f32x4 hv[4]; float ss = 0.f;
#pragma unroll
            for (int i = 0; i < 4; ++i) { hv[i] = *(const f32x4*)(X1 + (size_t)t * 1024 + 4 * lane + 256 * i); ss += (hv[i][0] * hv[i][0] + hv[i][1] * hv[i][1]) + (hv[i][2] * hv[i][2] + hv[i][3] * hv[i][3]); }
            ss = wave_sum(ss); const float r = 1.0f / sqrtf(ss * (1.0f / 1024.0f) + NORM_EPS);
#pragma unroll
            for (int i = 0; i < 4; ++i) { const int co = 4 * lane + 256 * i;
                const f32x4 g = *(const f32x4*)(in_n2 + co), sc = *(const f32x4*)(md + 4 * 1024 + co), sh = *(const f32x4*)(md + 3 * 1024 + co);
                hv[i] = hv[i] * r * g * (sc + 1.0f) + sh; u32x2 w; w.x = pk2(hv[i][0], hv[i][1]); w.y = pk2(hv[i][2], hv[i][3]);
                *(u32x2*)(H + (size_t)t * 1024 + co) = w; }
            float acc[32];
#pragma unroll
            for (int e = 0; e < 32; ++e) { float a = 0.f;
#pragma unroll
                for (int i = 0; i < 4; ++i) { const f32x4 w = *(const LAS f32x4*)(RW + e * 1024 + 4 * lane + 256 * i); a += (hv[i][0] * w[0] + hv[i][1] * w[1]) + (hv[i][2] * w[2] + hv[i][3] * w[3]); }
                acc[e] = a; }
#define RED_STEP(N, XR) do { const bool hb_ = (lane & (XR)) != 0; _Pragma("unroll") for (int q_ = 0; q_ < (N) / 2; ++q_) { const float keep_ = hb_ ? acc[q_ + (N) / 2] : acc[q_]; const float send_ = hb_ ? acc[q_] : acc[q_ + (N) / 2]; acc[q_] = keep_ + __shfl_xor(send_, (XR)); } } while (0)
            RED_STEP(32, 32); RED_STEP(16, 16); RED_STEP(8, 8); RED_STEP(4, 4); RED_STEP(2, 2);
#undef RED_STEP
            float lg = acc[0] + __shfl_xor(acc[0], 1);
            lg += in_rb[lane >> 1];
            if ((lane & 1) == 0) LG[lane >> 1] = lg;
            LDS_WAIT();
            float a[32];
#pragma unroll
            for (int q = 0; q < 8; ++q) { const f32x4 w = *(const LAS f32x4*)(LG + 4 * q); a[4 * q] = w[0]; a[4 * q + 1] = w[1]; a[4 * q + 2] = w[2]; a[4 * q + 3] = w[3]; }
            float tv[4]; int te[4];
#pragma unroll
            for (int k = 0; k < 4; ++k) { float best = a[0]; int bi = 0;
#pragma unroll
                for (int e = 1; e < 32; ++e) if (a[e] > best) { best = a[e]; bi = e; }
                tv[k] = best; te[k] = bi;
#pragma unroll
                for (int e = 0; e < 32; ++e) if (e == bi) a[e] = -INFINITY; }
            const float e1 = __expf(tv[1] - tv[0]), e2 = __expf(tv[2] - tv[0]), e3 = __expf(tv[3] - tv[0]); const float inv = 1.0f / (1.0f + e1 + e2 + e3);
            if (lane < 4) { const int ek = (lane == 0) ? te[0] : (lane == 1) ? te[1] : (lane == 2) ? te[2] : te[3]; const float gk = ((lane == 0) ? 1.0f : (lane == 1) ? e1 : (lane == 2) ? e2 : e3) * inv;
                const int loc = __hip_atomic_fetch_add(&CNT[ek], 1, __ATOMIC_RELAXED, __HIP_MEMORY_SCOPE_WORKGROUP); TOKR[tl * 4 + lane] = ek | (loc << 8); TOPG[(size_t)t * 4 + lane] = gk; }
        }
        __syncthreads();
        if (tid < 32) BASE[tid] = (int)__hip_atomic_fetch_add(F.ctl + CW_CNT + (l * 32 + tid) * 64, (unsigned)CNT[tid], __ATOMIC_RELAXED, __HIP_MEMORY_SCOPE_AGENT);
        __syncthreads();
        { const int pr = TOKR[tid], e = pr & 255, loc = pr >> 8; const size_t o = (size_t)(chunk * 128) * 4 + tid; TOPE[o] = e; RANK[o] = BASE[e] + loc; }
        __syncthreads();
    }
}
constexpr int MOE_OFF = LDS_X, MOE_CNTL = LDS_X + 256, MOE_TEXP = LDS_X + 512;
DI int moe_offsets(const Frame& F, int l) {
    LAS int* OFF = (LAS int*)(F.lds + MOE_OFF); LAS int* CNTL = (LAS int*)(F.lds + MOE_CNTL); LAS int* TEXP = (LAS int*)(F.lds + MOE_TEXP);
    __syncthreads();
    if (F.tid < 32) CNTL[F.tid] = (int)__hip_atomic_load(F.ctl + CW_CNT + (l * 32 + F.tid) * 64, __ATOMIC_RELAXED, __HIP_MEMORY_SCOPE_AGENT);
    __syncthreads();
    if (F.tid == 0) { int off = 0; for (int e = 0; e < 32; ++e) { OFF[e] = off; off += (CNTL[e] + 255) & ~255; } OFF[32] = off; }
    __syncthreads();
    const int ntiles = OFF[32] >> 8;
    for (int tl = F.tid; tl < ntiles; tl += 512) { int e = 0; for (int q = 0; q < 32; ++q) if (OFF[q] <= tl * 256 && tl * 256 < OFF[q + 1]) e = q; TEXP[tl] = e; }
    __syncthreads();
    return ntiles;
}
DI void phase_scatter(const Frame& F, int l) {
    const int lane = F.lane, wave = F.wave;
    (void)moe_offsets(F, l);
    const LAS int* OFF = (const LAS int*)(F.lds + MOE_OFF); const LAS int* CNTL = (const LAS int*)(F.lds + MOE_CNTL);
    const int* TOPE = (const int*)(F.ws + WS_ROUTE + RT_TOPE); const float* TOPG = (const float*)(F.ws + WS_ROUTE + RT_TOPG); const int* RANK = (const int*)(F.ws + WS_ROUTE + RT_RANK);
    int* SLOTOF = (int*)(F.ws + WS_ROUTE + RT_SLOTOF); int* TOKOF = (int*)(F.ws + WS_ROUTE + RT_TOKOF); float* GATEOF = (float*)(F.ws + WS_ROUTE + RT_GATEOF);
    const bf16_t* H = WSP(bf16_t, WS_H); bf16_t* XB = WSP(bf16_t, WS_XB);
    for (int chunk = F.bid; chunk < T_TOK / 128; chunk += F.G) {
        for (int p = 0; p < 64; ++p) {
            const int pair = wave * 64 + p, t = chunk * 128 + (pair >> 2); const size_t o = (size_t)t * 4 + (pair & 3);
            const int e = TOPE[o], slot = OFF[e] + RANK[o];
            if (lane == 0) { SLOTOF[o] = slot; TOKOF[slot] = t; GATEOF[slot] = TOPG[o]; }
            const u32x4 v0 = *(const u32x4*)(H + (size_t)t * 1024 + 8 * lane), v1 = *(const u32x4*)(H + (size_t)t * 1024 + 512 + 8 * lane);
            *(u32x4*)(XB + (size_t)slot * 1024 + 8 * lane) = v0; *(u32x4*)(XB + (size_t)slot * 1024 + 512 + 8 * lane) = v1;
        }
    }
    for (int e = F.bid; e < 32; e += F.G) {
        const int s0 = OFF[e] + CNTL[e], s1 = OFF[e + 1];
        for (int s = s0 + wave; s < s1; s += 8) { if (lane == 0) { TOKOF[s] = 0; GATEOF[s] = 0.f; }
            *(u32x4*)(XB + (size_t)s * 1024 + 8 * lane) = (u32x4){0u, 0u, 0u, 0u}; *(u32x4*)(XB + (size_t)s * 1024 + 512 + 8 * lane) = (u32x4){0u, 0u, 0u, 0u}; }
    }
}

#ifndef MK_SPLIT
#define MK_SPLIT 0
#endif
constexpr int NPHASE = 2 + 11 * DEPTH;
struct Args { const void* in[23]; float* out; unsigned char* ws; int ph_lo, ph_hi; };
static_assert(sizeof(Args) == 25 * 8 + 8, "Args has no padding");

__global__ void __launch_bounds__(512, 2) fwd_kernel(Args args) {
    {
        volatile LAS unsigned* MISC = (volatile LAS unsigned*)((LAS unsigned char*)lds_raw + MISC_OFF);
        if (threadIdx.x < 32) MISC[threadIdx.x] = 0u;
        __syncthreads();
        if (!MK_SPLIT) { const Frame F = make_frame(); (void)xcd_barrier_post(F.ctl + CW_BAR, MISC + 8); }
    }
    const int lo = args.ph_lo, hi = args.ph_hi;
#ifndef PH_ENABLE
#define PH_ENABLE 0xFFFF
#endif
#define IN(k) (lo <= (k) && (k) < hi)
#define EN(j) (((PH_ENABLE) >> (j)) & 1)
#define SEAM(k) do { if (!MK_SPLIT && (k) + 1 < hi) { XcdBarrier bar_; bar_.bar = F.ctl + CW_BAR; bar_.x = xb_xcc_id(); bar_.st = (volatile LAS unsigned*)((LAS unsigned char*)lds_raw + MISC_OFF) + 8; xcd_barrier(bar_); } } while (0)
    if (EN(0) && IN(0)) { const Frame F = make_frame(); phase_prologue(F); SEAM(0); }
    if (EN(1) && IN(1)) { const Frame F = make_frame(); phase_norm(F, KIN_x, nullptr, false, false, false, 0, 0); SEAM(1); }
    for (int l = 0; l < DEPTH; ++l) {
        const int pb = 2 + 11 * l;
        if (EN(2) && IN(pb + 0)) { const Frame F = make_frame();
            SchedPlain S; S.o.init(T_TOK / 256, NP / 256, F.G, F.bid); S.A = (const char*)WSP(bf16_t, WS_H); S.B = (const char*)(WSP(bf16_t, WS_WIN) + (size_t)l * NP * 1024); S.tstep = (size_t)256 * 1024 * 2;
            EpiStoreBf16 E{WSP(bf16_t, WS_P), NP};
            pg8::gemm_phase<EpiStoreBf16, SchedPlain>(F.lds, F.tid, 1024, S, E);
            SEAM(pb + 0);
        }
        if (EN(3) && IN(pb + 1)) { const Frame F = make_frame(); phase_post(F, l); SEAM(pb + 1); }
        if (EN(4) && IN(pb + 2)) { const Frame F = make_frame();
            int k256 = 256; asm volatile("" : "+s"(k256));
            { SchedPlain S; S.o.init(T_TOK / 256, 3, F.G, F.bid); S.A = (const char*)WSP(bf16_t, WS_CQ); S.B = (const char*)(WSP(bf16_t, WS_WUQ) + (size_t)l * 768 * 256); S.tstep = (size_t)256 * 256 * 2;
              EpiStoreBf16 E{WSP(bf16_t, WS_QA), 768};
              pg8::gemm_phase<EpiStoreBf16, SchedPlain>(F.lds, F.tid, k256, S, E); }
            { SchedPlain S; S.o.init(T_TOK / 256, 4, F.G, F.bid); S.A = (const char*)WSP(bf16_t, WS_CKV); S.B = (const char*)(WSP(bf16_t, WS_WUKV) + (size_t)l * 1024 * 256); S.tstep = (size_t)256 * 256 * 2;
              EpiStoreBf16 E{WSP(bf16_t, WS_KV), 1024};
              pg8::gemm_phase<EpiStoreBf16, SchedPlain>(F.lds, F.tid, k256, S, E); }
            SEAM(pb + 2);
        }
        if (EN(5) && IN(pb + 3)) { const Frame F = make_frame(); phase_attention(F); SEAM(pb + 3); }
        if (EN(6) && IN(pb + 4)) { const Frame F = make_frame();
            SchedBranch S; S.o.init(T_TOK / 256, 12, F.G, F.bid); S.A = (const char*)WSP(bf16_t, WS_O3); S.B = (const char*)(WSP(bf16_t, WS_WB) + (size_t)l * 3 * 1024 * 512); S.tstep = (size_t)256 * 512 * 2; S.aslab = (size_t)T_TOK * 512 * 2;
            EpiBranchGate E{WSP(bf16_t, WS_GY), WSP(bf16_t, WS_P), KIN_b_gate + l * 3072};
            pg8::gemm_phase<EpiBranchGate, SchedBranch>(F.lds, F.tid, 512, S, E);
            SEAM(pb + 4);
        }
        if (EN(7) && IN(pb + 5)) { const Frame F = make_frame();
            SchedPlain S; S.o.init(T_TOK / 256, 4, F.G, F.bid); S.A = (const char*)WSP(bf16_t, WS_GY); S.B = (const char*)(WSP(bf16_t, WS_WOUT) + (size_t)l * 1024 * 3072); S.tstep = (size_t)256 * 3072 * 2;
            EpiResidual E{l == 0 ? KIN_x : WSP(float, WS_X1), WSP(float, WS_X1), WSP(float, WS_MOD) + (size_t)l * 16 * 6144 + 2 * 1024};
            pg8::gemm_phase<EpiResidual, SchedPlain>(F.lds, F.tid, 3072, S, E);
            SEAM(pb + 5);
        }
        if (EN(8) && IN(pb + 6)) { const Frame F = make_frame(); phase_router(F, l); SEAM(pb + 6); }
        if (EN(9) && IN(pb + 7)) { const Frame F = make_frame(); phase_scatter(F, l); SEAM(pb + 7); }
        if (EN(10) && IN(pb + 8)) { const Frame F = make_frame();
            const int ntiles = moe_offsets(F, l);
            SchedMoe S; S.o.init(ntiles, 8, F.G, F.bid); S.A = (const char*)WSP(bf16_t, WS_XB); S.B = (const char*)(WSP(bf16_t, WS_W1) + (size_t)l * 32 * 2048 * 1024); S.tstepA = (size_t)256 * 1024 * 2; S.tstepB = (size_t)256 * 1024 * 2; S.eslab = (size_t)2048 * 1024 * 2;
            S.texp = (const LAS int*)(F.lds + MOE_TEXP);
            EpiSwiglu E{WSP(bf16_t, WS_ACT), KIN_b1 + (size_t)l * 32 * 2048, (const LAS int*)(F.lds + MOE_TEXP)};
            pg8::gemm_phase<EpiSwiglu, SchedMoe>(F.lds, F.tid, 1024, S, E);
            SEAM(pb + 8);
        }
        if (EN(11) && IN(pb + 9)) { const Frame F = make_frame();
            const int ntiles = moe_offsets(F, l);
            SchedMoe S; S.o.init(ntiles, 4, F.G, F.bid); S.A = (const char*)WSP(bf16_t, WS_ACT); S.B = (const char*)(WSP(bf16_t, WS_W2) + (size_t)l * 32 * 1024 * 1024); S.tstepA = (size_t)256 * 1024 * 2; S.tstepB = (size_t)256 * 1024 * 2; S.eslab = (size_t)1024 * 1024 * 2;
            S.texp = (const LAS int*)(F.lds + MOE_TEXP);
            EpiMoeOut E{WSP(bf16_t, WS_Y), KIN_b2 + (size_t)l * 32 * 1024, (const float*)(F.ws + WS_ROUTE + RT_GATEOF), (const LAS int*)(F.lds + MOE_TEXP)};
            pg8::gemm_phase<EpiMoeOut, SchedMoe>(F.lds, F.tid, 1024, S, E);
            SEAM(pb + 9);
        }
        if (EN(12) && IN(pb + 10)) { const Frame F = make_frame();
            const bool last = (l == DEPTH - 1);
            phase_norm(F, WSP(float, WS_X1), WSP(float, WS_X1), true, !last, last, l + 1 < DEPTH ? l + 1 : 0, l);
            SEAM(pb + 10);
        }
    }
#undef IN
#undef SEAM
}

extern "C" void kernel_launch(void* const* d_in, const int* in_sizes, int n_in, void* d_out, int out_size, void* d_ws, size_t ws_size, hipStream_t stream) {
    static int grid = 0;
    if (grid == 0) {
        if (n_in != 23 || out_size != T_TOK * D_MODEL || ws_size < WS_END) { fprintf(stderr, "kernel_launch: unexpected problem (n_in %d, out %d, ws %zu)\n", n_in, out_size, ws_size); grid = -1; return; }
        int dev = 0, cus = 0;
        if (hipGetDevice(&dev) != hipSuccess || hipDeviceGetAttribute(&cus, hipDeviceAttributeMultiprocessorCount, dev) != hipSuccess) { grid = -1; return; }
        if (hipFuncSetAttribute((const void*)fwd_kernel, hipFuncAttributeMaxDynamicSharedMemorySize, LDS_BYTES) != hipSuccess) { fprintf(stderr, "kernel_launch: hipFuncSetAttribute failed\n"); grid = -1; return; }
        int per_cu = 0;
        if (hipOccupancyMaxActiveBlocksPerMultiprocessor(&per_cu, (const void*)fwd_kernel, 512, LDS_BYTES) != hipSuccess || per_cu < 1) fprintf(stderr, "kernel_launch: occupancy query says %d\n", per_cu);
        (void)hipGetLastError();
        grid = cus > 256 ? 256 : cus;
    }
    if (grid < 0) return;
    (void)in_sizes;
    if (hipMemsetAsync((char*)d_ws + WS_CTL, 0, CTL_ZERO_BYTES, stream) != hipSuccess) return;
    Args a{};
    for (int i = 0; i < 23; ++i) a.in[i] = d_in[i];
    a.out = (float*)d_out; a.ws = (unsigned char*)d_ws;
#if MK_SPLIT
    for (int p = 0; p < NPHASE; ++p) { a.ph_lo = p; a.ph_hi = p + 1; hipLaunchKernelGGL(fwd_kernel, dim3(grid), dim3(512), LDS_BYTES, stream, a); }
#else
    a.ph_lo = 0; a.ph_hi = NPHASE;
    hipLaunchKernelGGL(fwd_kernel, dim3(grid), dim3(512), LDS_BYTES, stream, a);
#endif
}
```

```cpp
#include <hip/hip_runtime.h>
#include <cstdio>
#include <cstdint>

#ifndef M2_F8
#define M2_F8 1
#endif
#define LAS __attribute__((address_space(3)))
#define GAS __attribute__((address_space(1)))
typedef unsigned short bf16_t;
typedef short bf16x8 __attribute__((ext_vector_type(8)));
typedef short s16x4 __attribute__((ext_vector_type(4)));
typedef float f32x2 __attribute__((ext_vector_type(2)));
typedef float f32x4 __attribute__((ext_vector_type(4)));
typedef float f32x16 __attribute__((ext_vector_type(16)));
typedef unsigned u32x2 __attribute__((ext_vector_type(2)));
typedef unsigned u32x4 __attribute__((ext_vector_type(4)));
#define DI __device__ __forceinline__

constexpr int D_MODEL = 1024, BATCH = 16, SEQ = 2048, T_TOK = BATCH * SEQ, DEPTH = 2;
constexpr float NORM_EPS = 1e-6f;
constexpr int IN_COLS = 6248, NP = 6400;
constexpr int N_EXP = 32, TOP_K = 4, D_EXP = 1024;
constexpr int NSLOT_MAX = T_TOK * TOP_K + N_EXP * 256;
constexpr int PC_GATE = 0, PC_CONV = 3072, PC_DQ = 4608, PC_IQ = 5120, PC_QLAT = 5632, PC_KVLAT = 5888, PC_DKV = 6048, PC_IK = 6176, PC_IW = 6240;
constexpr int OC_QLAT = 0, OC_KVLAT = 256, OC_CONV = 416, OC_DQ = 1952, OC_DKV = 2464, OC_IQ = 2592, OC_IK = 3104, OC_IW = 3168, OC_GATE = 3176;

DI unsigned pk2(float lo, float hi) { typedef __bf16 bf16x2_t __attribute__((ext_vector_type(2))); f32x2 v = {lo, hi}; bf16x2_t b = __builtin_convertvector(v, bf16x2_t); return __builtin_bit_cast(unsigned, b); }
DI float bf_lo(unsigned w) { return __uint_as_float(w << 16); }
DI float bf_hi(unsigned w) { return __uint_as_float(w & 0xffff0000u); }
DI float bf2f(bf16_t h) { return __uint_as_float((unsigned)h << 16); }
DI float wave_sum(float v) {
#pragma unroll
    for (int o = 1; o < 64; o <<= 1) v += __shfl_xor(v, o);
    return v;
}
DI float fast_sigmoid(float x) { return __builtin_amdgcn_rcpf(1.0f + __builtin_amdgcn_exp2f(-1.4426950408889634f * x)); }
DI unsigned pk4_fp8(float a, float b, float c, float d) { int w = __builtin_amdgcn_cvt_pk_fp8_f32(a, b, 0, false); w = __builtin_amdgcn_cvt_pk_fp8_f32(c, d, w, true); return (unsigned)w; }
#define LDS_WAIT() asm volatile("s_waitcnt lgkmcnt(0)" ::: "memory")
#define VM_WAIT() asm volatile("s_waitcnt vmcnt(0)" ::: "memory")

namespace pg8 {
DI void glds16_s(unsigned voff, const char* sbase, unsigned lds_dst) { unsigned keep; asm volatile("s_nop 4\n\ts_mov_b32 %0, m0\n\ts_mov_b32 m0, %3\n\ts_nop 0\n\tglobal_load_lds_dwordx4 %1, %2\n\ts_mov_b32 m0, %0" : "=&s"(keep) : "v"(voff), "s"(sbase), "s"(lds_dst) : "memory"); }
DI const char* uni_ptr(const char* p) { const unsigned long long v = (unsigned long long)p; const unsigned lo = __builtin_amdgcn_readfirstlane((unsigned)v), hi = __builtin_amdgcn_readfirstlane((unsigned)(v >> 32)); return (const char*)(GAS const char*)(((unsigned long long)hi << 32) | lo); }
constexpr int BM = 256, BK = 64, HALF = 128, HTB = HALF * BK * 2, STAGE_BYTES = 8 * HTB, NXCD = 8, WGM = 8;
__host__ __device__ __forceinline__ int lds_byte(int r, int c) { const int st = (r >> 4) * 2 + (c >> 5), rr = r & 15, cc = c & 31, ob = rr * 64 + cc * 2; return st * 1024 + (ob ^ (((ob >> 9) & 1) << 5)); }
__host__ __device__ __forceinline__ void stage_rc(int b, int& R, int& C) { const int st = b / 1024, sb = b % 1024, swz = sb ^ (((sb >> 9) & 1) << 5); R = (st >> 1) * 16 + swz / 64; C = (st & 1) * 32 + (swz % 64) / 2; }
__host__ __device__ __forceinline__ int perm32(int rho) { const int n = rho >> 4, i = rho & 15; return 8 * (i >> 2) + 4 * n + (i & 3); }
struct Unit { int pm, pn; };
struct StaticOrder {
    int nM, nN, nwg, G, c;
    DI void init(int nM_, int nN_, int G_, int c_) { nM = nM_; nN = nN_; nwg = nM * nN; G = G_; c = c_; }
    DI bool next(int i, Unit& u) const {
        const long L = (long)i * G + c; if (L >= nwg) return false;
        int wgid = (int)L; { const int q = nwg / NXCD, r = nwg % NXCD, xcd = wgid % NXCD, off = wgid / NXCD; wgid = (xcd < r ? xcd * (q + 1) : r * (q + 1) + (xcd - r) * q) + off; }
        const int nig = WGM * nN, gid = wgid / nig, fm = gid * WGM, gsz = (nM - fm) < WGM ? (nM - fm) : WGM;
        u.pm = fm + ((wgid % nig) % gsz); u.pn = (wgid % nig) / gsz; return true;
    }
};

template <class Epi, class Sched, bool ALIGN_EPI = true, bool SP2 = true>
DI void gemm_phase(LAS unsigned char* lds, const int tid, const int K, const Sched& S, const Epi& E) {
    const int wid = __builtin_amdgcn_readfirstlane(tid >> 6), lane = tid & 63, wr = wid >> 2, wc = wid & 3, fr = lane & 15, fq = lane >> 4;
    const int nt = K / BK;
    unsigned voffA[2], voffB[2];
#pragma unroll
    for (int i = 0; i < 2; ++i) { int R, C; stage_rc(tid * 16 + i * 8192, R, C); const int Rb = Epi::PERM ? ((R & ~31) + perm32(R & 31)) : R;
        voffA[i] = (unsigned)(R * K + C) * 2u; voffB[i] = (unsigned)(Rb * K + C) * 2u; }
    const size_t kstep = (size_t)(BK * 2);
    const size_t hstep = (size_t)HALF * K * 2;
    const unsigned ldsw = (unsigned)wid * 1024u; const unsigned ldsb = (unsigned)(unsigned long long)(lds);
    const int aoff = lds_byte(wr * 64 + fr, fq * 8), boff = lds_byte(wc * 32 + fr, fq * 8);
#define PG8_SA(b, h) (((b) * 2 + (h)) * HTB)
#define PG8_SB(b, h) ((4 + (b) * 2 + (h)) * HTB)
#define PG8_STAGE(bufoff, gbase, voff) do { _Pragma("unroll") for (int _i = 0; _i < 2; ++_i) \
        glds16_s((voff)[_i], (const char*)(gbase), ldsb + (unsigned)(bufoff) + ldsw + (unsigned)(_i * 8192)); } while (0)
#define PG8_LDA(dst, b, h) do { int a_ = aoff; asm volatile("" : "+v"(a_)); _Pragma("unroll") for (int m = 0; m < 4; ++m) _Pragma("unroll") for (int k = 0; k < 2; ++k) dst[m][k] = *(const LAS bf16x8*)(lds + PG8_SA(b, h) + a_ + m * 2048 + k * 1024); } while (0)
#define PG8_LDB(dst, b, h) do { int b_ = boff; asm volatile("" : "+v"(b_)); _Pragma("unroll") for (int n = 0; n < 2; ++n) _Pragma("unroll") for (int k = 0; k < 2; ++k) dst[n][k] = *(const LAS bf16x8*)(lds + PG8_SB(b, h) + b_ + n * 2048 + k * 1024); } while (0)
#define PG8_MMA(ai, bj, At, Bt) do { __builtin_amdgcn_s_setprio(1); _Pragma("unroll") for (int m = 0; m < 4; ++m) _Pragma("unroll") for (int n = 0; n < 2; ++n) _Pragma("unroll") for (int k = 0; k < 2; ++k) \
        acc[ai][bj][m][n] = __builtin_amdgcn_mfma_f32_16x16x32_bf16(Bt[n][k], At[m][k], acc[ai][bj][m][n], 0, 0, 0); __builtin_amdgcn_s_setprio(0); } while (0)
#define PG8_WAIT_V(n) asm volatile("s_waitcnt vmcnt(" #n ")" ::: "memory")
#define PG8_WAIT_L(n) asm volatile("s_waitcnt lgkmcnt(" #n ")" ::: "memory")
#define PG8_BAR __builtin_amdgcn_s_barrier()
#define PG8_SCHED __builtin_amdgcn_sched_barrier(0)
    Unit cur, nxt; int ui = 0;
    if (!S.next(0, cur)) return;
    float zf_ = 0.f; asm volatile("" : "+v"(zf_));
    f32x4 acc[2][2][4][2];
#pragma unroll
    for (int a = 0; a < 2; ++a)
#pragma unroll
        for (int b = 0; b < 2; ++b)
#pragma unroll
            for (int m = 0; m < 4; ++m)
#pragma unroll
                for (int n = 0; n < 2; ++n) acc[a][b][m][n] = (f32x4){zf_, zf_, zf_, zf_};
    bf16x8 At[4][2], B0[2][2], B1[2][2];
    const char* cA = uni_ptr(S.abase(cur)); const char* cB = uni_ptr(S.bbase(cur));
    if constexpr (SP2) {
        PG8_STAGE(PG8_SB(0, 0), cB, voffB); PG8_STAGE(PG8_SB(0, 1), cB + hstep, voffB); PG8_STAGE(PG8_SA(0, 0), cA, voffA); PG8_STAGE(PG8_SA(0, 1), cA + hstep, voffA);
        if (wr == 1) PG8_BAR;
        PG8_WAIT_V(2); PG8_BAR;
        PG8_STAGE(PG8_SB(1, 0), cB + kstep, voffB); PG8_STAGE(PG8_SA(1, 0), cA + kstep, voffA); PG8_STAGE(PG8_SB(1, 1), cB + hstep + kstep, voffB);
        PG8_WAIT_V(6); PG8_BAR;
    } else {
        PG8_STAGE(PG8_SB(0, 0), cB, voffB); PG8_STAGE(PG8_SA(0, 0), cA, voffA); PG8_STAGE(PG8_SB(0, 1), cB + hstep, voffB); PG8_STAGE(PG8_SA(0, 1), cA + hstep, voffA);
        if (wr == 1) PG8_BAR;
        PG8_WAIT_V(4); PG8_BAR;
        PG8_STAGE(PG8_SB(1, 0), cB + kstep, voffB); PG8_STAGE(PG8_SA(1, 0), cA + kstep, voffA); PG8_STAGE(PG8_SB(1, 1), cB + hstep + kstep, voffB);
        PG8_WAIT_V(6); PG8_BAR;
    }
    for (;;) {
        const bool has_next = S.next(ui + 1, nxt);
        const char* nA = has_next ? uni_ptr(S.abase(nxt)) : cA; const char* nB = has_next ? uni_ptr(S.bbase(nxt)) : cB;
        for (int t = 0; t < nt; t += 2) {
            const bool last = (t == nt - 2);
            const char* a1 = cA + (size_t)(t + 1) * kstep;
            const char* a2 = last ? nA : cA + (size_t)(t + 2) * kstep; const char* b2 = last ? nB : cB + (size_t)(t + 2) * kstep;
            const char* a3 = a2 + kstep; const char* b3 = b2 + kstep;
            if constexpr (SP2) {
            PG8_LDB(B0, 0, 0); PG8_LDB(B1, 0, 1); PG8_SCHED; PG8_LDA(At, 0, 0); PG8_STAGE(PG8_SA(1, 1), a1 + hstep, voffA);
            PG8_WAIT_V(8); PG8_WAIT_L(0); PG8_BAR; PG8_MMA(0, 0, At, B0); PG8_MMA(0, 1, At, B1); PG8_BAR; PG8_SCHED;
            PG8_LDA(At, 0, 1); PG8_STAGE(PG8_SB(0, 0), b2, voffB); PG8_STAGE(PG8_SB(0, 1), b2 + hstep, voffB); PG8_STAGE(PG8_SA(0, 0), a2, voffA);
            PG8_WAIT_V(8); PG8_WAIT_L(0); PG8_BAR; PG8_MMA(1, 0, At, B0); PG8_MMA(1, 1, At, B1); PG8_BAR; PG8_SCHED;
            PG8_LDB(B0, 1, 0); PG8_LDB(B1, 1, 1); PG8_SCHED; PG8_LDA(At, 1, 0); PG8_STAGE(PG8_SA(0, 1), a2 + hstep, voffA);
            PG8_WAIT_V(8); PG8_WAIT_L(0); PG8_BAR; PG8_MMA(0, 0, At, B0); PG8_MMA(0, 1, At, B1); PG8_BAR; PG8_SCHED;
            PG8_LDA(At, 1, 1); PG8_STAGE(PG8_SB(1, 0), b3, voffB); PG8_STAGE(PG8_SB(1, 1), b3 + hstep, voffB); PG8_STAGE(PG8_SA(1, 0), a3, voffA);
            PG8_WAIT_V(8); PG8_WAIT_L(0); PG8_BAR; PG8_MMA(1, 0, At, B0); PG8_MMA(1, 1, At, B1); PG8_BAR; PG8_SCHED;
            } else {
            PG8_LDB(B0, 0, 0); PG8_SCHED; PG8_LDA(At, 0, 0); PG8_STAGE(PG8_SA(1, 1), a1 + hstep, voffA);
            PG8_WAIT_L(8); PG8_BAR; PG8_WAIT_L(0); PG8_MMA(0, 0, At, B0); PG8_BAR; PG8_SCHED;
            PG8_LDB(B1, 0, 1); PG8_STAGE(PG8_SB(0, 0), b2, voffB);
            PG8_BAR; PG8_WAIT_L(0); PG8_MMA(0, 1, At, B1); PG8_BAR;
            PG8_LDA(At, 0, 1); PG8_STAGE(PG8_SA(0, 0), a2, voffA);
            PG8_BAR; PG8_WAIT_L(0); PG8_MMA(1, 0, At, B0); PG8_BAR; PG8_SCHED;
            PG8_STAGE(PG8_SB(0, 1), b2 + hstep, voffB);
            PG8_WAIT_V(6); PG8_BAR; PG8_MMA(1, 1, At, B1); PG8_BAR;
            PG8_LDB(B0, 1, 0); PG8_SCHED; PG8_LDA(At, 1, 0); PG8_STAGE(PG8_SA(0, 1), a2 + hstep, voffA);
            PG8_WAIT_L(8); PG8_BAR; PG8_WAIT_L(0); PG8_MMA(0, 0, At, B0); PG8_BAR; PG8_SCHED;
            PG8_LDB(B1, 1, 1); PG8_STAGE(PG8_SB(1, 0), b3, voffB);
            PG8_BAR; PG8_WAIT_L(0); PG8_MMA(0, 1, At, B1); PG8_BAR;
            PG8_LDA(At, 1, 1); PG8_STAGE(PG8_SA(1, 0), a3, voffA);
            PG8_BAR; PG8_WAIT_L(0); PG8_MMA(1, 0, At, B0); PG8_BAR; PG8_SCHED;
            PG8_STAGE(PG8_SB(1, 1), b3 + hstep, voffB);
            PG8_WAIT_V(6); PG8_BAR; PG8_MMA(1, 1, At, B1); PG8_BAR;
            }
        }
        if constexpr (ALIGN_EPI) { if (wr == 0) PG8_BAR; }
        E(acc, cur, wr, wc, fr, fq);
        if (!has_next) break;
#pragma unroll
        for (int a = 0; a < 2; ++a)
#pragma unroll
            for (int b = 0; b < 2; ++b)
#pragma unroll
                for (int m = 0; m < 4; ++m)
#pragma unroll
                    for (int n = 0; n < 2; ++n) acc[a][b][m][n] = (f32x4){zf_, zf_, zf_, zf_};
        cur = nxt; cA = nA; cB = nB; ++ui;
        if constexpr (ALIGN_EPI) { if (wr == 1) PG8_BAR; }
    }
    PG8_WAIT_V(0);
    if constexpr (!ALIGN_EPI) { if (wr == 0) PG8_BAR; }
    PG8_BAR;
#undef PG8_SA
#undef PG8_SB
#undef PG8_STAGE
#undef PG8_LDA
#undef PG8_LDB
#undef PG8_MMA
#undef PG8_WAIT_V
#undef PG8_WAIT_L
#undef PG8_BAR
#undef PG8_SCHED
}
typedef int v8i __attribute__((ext_vector_type(8)));
template <class Epi, class Sched, bool ALIGN_EPI = true, bool SP2 = true>
DI void gemm_phase_f8(LAS unsigned char* lds, const int tid, const int KB, const Sched& S, const Epi& E) {
    const int wid = __builtin_amdgcn_readfirstlane(tid >> 6), lane = tid & 63, wr = wid >> 2, wc = wid & 3, fr = lane & 15, fq = lane >> 4;
    const int nt = KB / 128;
    unsigned voffA[2], voffB[2];
#pragma unroll
    for (int i = 0; i < 2; ++i) { int R, C; stage_rc(tid * 16 + i * 8192, R, C); const int Rb = Epi::PERM ? ((R & ~31) + perm32(R & 31)) : R;
        voffA[i] = (unsigned)(R * KB + 2 * C); voffB[i] = (unsigned)(Rb * KB + 2 * C); }
    const size_t kstep = (size_t)(BK * 2);
    const size_t hstep = (size_t)HALF * KB;
    const unsigned ldsw = (unsigned)wid * 1024u; const unsigned ldsb = (unsigned)(unsigned long long)(lds);
    const int aoff = lds_byte(wr * 64 + fr, fq * 16), boff = lds_byte(wc * 32 + fr, fq * 16);
#define PG8_SA(b, h) (((b) * 2 + (h)) * HTB)
#define PG8_SB(b, h) ((4 + (b) * 2 + (h)) * HTB)
#define PG8_STAGE(bufoff, gbase, voff) do { _Pragma("unroll") for (int _i = 0; _i < 2; ++_i) \
        glds16_s((voff)[_i], (const char*)(gbase), ldsb + (unsigned)(bufoff) + ldsw + (unsigned)(_i * 8192)); } while (0)
#define PG8_LDA(dst, b, h) do { int a_ = aoff; asm volatile("" : "+v"(a_)); _Pragma("unroll") for (int m = 0; m < 4; ++m) dst[m] = *(const LAS v8i*)(lds + PG8_SA(b, h) + a_ + m * 2048); } while (0)
#define PG8_LDB(dst, b, h) do { int b_ = boff; asm volatile("" : "+v"(b_)); _Pragma("unroll") for (int n = 0; n < 2; ++n) dst[n] = *(const LAS v8i*)(lds + PG8_SB(b, h) + b_ + n * 2048); } while (0)
#define PG8_MMA(ai, bj, At, Bt) do { __builtin_amdgcn_s_setprio(1); _Pragma("unroll") for (int m = 0; m < 4; ++m) _Pragma("unroll") for (int n = 0; n < 2; ++n) \
        acc[ai][bj][m][n] = __builtin_amdgcn_mfma_scale_f32_16x16x128_f8f6f4(Bt[n], At[m], acc[ai][bj][m][n], 0, 0, 0, sc8, 0, sc8); __builtin_amdgcn_s_setprio(0); } while (0)
#define PG8_WAIT_V(n) asm volatile("s_waitcnt vmcnt(" #n ")" ::: "memory")
#define PG8_WAIT_L(n) asm volatile("s_waitcnt lgkmcnt(" #n ")" ::: "memory")
#define PG8_BAR __builtin_amdgcn_s_barrier()
#define PG8_SCHED __builtin_amdgcn_sched_barrier(0)
    Unit cur, nxt; int ui = 0;
    if (!S.next(0, cur)) return;
    int sc8 = 0x7c7c7c7c; asm volatile("" : "+v"(sc8));
    float zf_ = 0.f; asm volatile("" : "+v"(zf_));
    f32x4 acc[2][2][4][2];
#pragma unroll
    for (int a = 0; a < 2; ++a)
#pragma unroll
        for (int b = 0; b < 2; ++b)
#pragma unroll
            for (int m = 0; m < 4; ++m)
#pragma unroll
                for (int n = 0; n < 2; ++n) acc[a][b][m][n] = (f32x4){zf_, zf_, zf_, zf_};
    v8i At[4], B0[2], B1[2];
    const char* cA = uni_ptr(S.abase(cur)); const char* cB = uni_ptr(S.bbase(cur));
    if constexpr (SP2) {
        PG8_STAGE(PG8_SB(0, 0), cB, voffB); PG8_STAGE(PG8_SB(0, 1), cB + hstep, voffB); PG8_STAGE(PG8_SA(0, 0), cA, voffA); PG8_STAGE(PG8_SA(0, 1), cA + hstep, voffA);
        if (wr == 1) PG8_BAR;
        PG8_WAIT_V(2); PG8_BAR;
        PG8_STAGE(PG8_SB(1, 0), cB + kstep, voffB); PG8_STAGE(PG8_SA(1, 0), cA + kstep, voffA); PG8_STAGE(PG8_SB(1, 1), cB + hstep + kstep, voffB);
        PG8_WAIT_V(6); PG8_BAR;
    } else {
        PG8_STAGE(PG8_SB(0, 0), cB, voffB); PG8_STAGE(PG8_SA(0, 0), cA, voffA); PG8_STAGE(PG8_SB(0, 1), cB + hstep, voffB); PG8_STAGE(PG8_SA(0, 1), cA + hstep, voffA);
        if (wr == 1) PG8_BAR;
        PG8_WAIT_V(4); PG8_BAR;
        PG8_STAGE(PG8_SB(1, 0), cB + kstep, voffB); PG8_STAGE(PG8_SA(1, 0), cA + kstep, voffA); PG8_STAGE(PG8_SB(1, 1), cB + hstep + kstep, voffB);
        PG8_WAIT_V(6); PG8_BAR;
    }
    for (;;) {
        const bool has_next = S.next(ui + 1, nxt);
        const char* nA = has_next ? uni_ptr(S.abase(nxt)) : cA; const char* nB = has_next ? uni_ptr(S.bbase(nxt)) : cB;
        for (int t = 0; t < nt; t += 2) {
            const bool last = (t == nt - 2);
            const char* a1 = cA + (size_t)(t + 1) * kstep;
            const char* a2 = last ? nA : cA + (size_t)(t + 2) * kstep; const char* b2 = last ? nB : cB + (size_t)(t + 2) * kstep;
            const char* a3 = a2 + kstep; const char* b3 = b2 + kstep;
            if constexpr (SP2) {
            PG8_LDB(B0, 0, 0); PG8_LDB(B1, 0, 1); PG8_SCHED; PG8_LDA(At, 0, 0); PG8_STAGE(PG8_SA(1, 1), a1 + hstep, voffA);
            PG8_WAIT_V(8); PG8_WAIT_L(0); PG8_BAR; PG8_MMA(0, 0, At, B0); PG8_MMA(0, 1, At, B1); PG8_BAR; PG8_SCHED;
            PG8_LDA(At, 0, 1); PG8_STAGE(PG8_SB(0, 0), b2, voffB); PG8_STAGE(PG8_SB(0, 1), b2 + hstep, voffB); PG8_STAGE(PG8_SA(0, 0), a2, voffA);
            PG8_WAIT_V(8); PG8_WAIT_L(0); PG8_BAR; PG8_MMA(1, 0, At, B0); PG8_MMA(1, 1, At, B1); PG8_BAR; PG8_SCHED;
            PG8_LDB(B0, 1, 0); PG8_LDB(B1, 1, 1); PG8_SCHED; PG8_LDA(At, 1, 0); PG8_STAGE(PG8_SA(0, 1), a2 + hstep, voffA);
            PG8_WAIT_V(8); PG8_WAIT_L(0); PG8_BAR; PG8_MMA(0, 0, At, B0); PG8_MMA(0, 1, At, B1); PG8_BAR; PG8_SCHED;
            PG8_LDA(At, 1, 1); PG8_STAGE(PG8_SB(1, 0), b3, voffB); PG8_STAGE(PG8_SB(1, 1), b3 + hstep, voffB); PG8_STAGE(PG8_SA(1, 0), a3, voffA);
            PG8_WAIT_V(8); PG8_WAIT_L(0); PG8_BAR; PG8_MMA(1, 0, At, B0); PG8_MMA(1, 1, At, B1); PG8_BAR; PG8_SCHED;
            } else {
            PG8_LDB(B0, 0, 0); PG8_SCHED; PG8_LDA(At, 0, 0); PG8_STAGE(PG8_SA(1, 1), a1 + hstep, voffA);
            PG8_WAIT_L(8); PG8_BAR; PG8_WAIT_L(0); PG8_MMA(0, 0, At, B0); PG8_BAR; PG8_SCHED;
            PG8_LDB(B1, 0, 1); PG8_STAGE(PG8_SB(0, 0), b2, voffB);
            PG8_BAR; PG8_WAIT_L(0); PG8_MMA(0, 1, At, B1); PG8_BAR;
            PG8_LDA(At, 0, 1); PG8_STAGE(PG8_SA(0, 0), a2, voffA);
            PG8_BAR; PG8_WAIT_L(0); PG8_MMA(1, 0, At, B0); PG8_BAR; PG8_SCHED;
            PG8_STAGE(PG8_SB(0, 1), b2 + hstep, voffB);
            PG8_WAIT_V(6); PG8_BAR; PG8_MMA(1, 1, At, B1); PG8_BAR;
            PG8_LDB(B0, 1, 0); PG8_SCHED; PG8_LDA(At, 1, 0); PG8_STAGE(PG8_SA(0, 1), a2 + hstep, voffA);
            PG8_WAIT_L(8); PG8_BAR; PG8_WAIT_L(0); PG8_MMA(0, 0, At, B0); PG8_BAR; PG8_SCHED;
            PG8_LDB(B1, 1, 1); PG8_STAGE(PG8_SB(1, 0), b3, voffB);
            PG8_BAR; PG8_WAIT_L(0); PG8_MMA(0, 1, At, B1); PG8_BAR;
            PG8_LDA(At, 1, 1); PG8_STAGE(PG8_SA(1, 0), a3, voffA);
            PG8_BAR; PG8_WAIT_L(0); PG8_MMA(1, 0, At, B0); PG8_BAR; PG8_SCHED;
            PG8_STAGE(PG8_SB(1, 1), b3 + hstep, voffB);
            PG8_WAIT_V(6); PG8_BAR; PG8_MMA(1, 1, At, B1); PG8_BAR;
            }
        }
        if constexpr (ALIGN_EPI) { if (wr == 0) PG8_BAR; }
        asm volatile("" ::: "memory"); __builtin_amdgcn_sched_barrier(0);
        { int t2_ = tid; asm volatile("" : "+v"(t2_)); const int w2_ = __builtin_amdgcn_readfirstlane(t2_ >> 6), l2_ = t2_ & 63; E(acc, cur, w2_ >> 2, w2_ & 3, l2_ & 15, l2_ >> 4); }
        if (!has_next) break;
#pragma unroll
        for (int a = 0; a < 2; ++a)
#pragma unroll
            for (int b = 0; b < 2; ++b)
#pragma unroll
                for (int m = 0; m < 4; ++m)
#pragma unroll
                    for (int n = 0; n < 2; ++n) acc[a][b][m][n] = (f32x4){zf_, zf_, zf_, zf_};
        cur = nxt; cA = nA; cB = nB; ++ui;
        if constexpr (ALIGN_EPI) { if (wr == 1) PG8_BAR; }
    }
    PG8_WAIT_V(0);
    if constexpr (!ALIGN_EPI) { if (wr == 0) PG8_BAR; }
    PG8_BAR;
#undef PG8_SA
#undef PG8_SB
#undef PG8_STAGE
#undef PG8_LDA
#undef PG8_LDB
#undef PG8_MMA
#undef PG8_WAIT_V
#undef PG8_WAIT_L
#undef PG8_BAR
#undef PG8_SCHED
}
}

struct SchedPlain {
    pg8::StaticOrder o; const char* A; const char* B; size_t tstep;
    DI bool next(int i, pg8::Unit& u) const { return o.next(i, u); }
    DI const char* abase(const pg8::Unit& u) const { return A + (size_t)u.pm * tstep; }
    DI const char* bbase(const pg8::Unit& u) const { return B + (size_t)u.pn * tstep; }
};
struct SchedBranch {
    pg8::StaticOrder o; const char* A; const char* B; size_t tstep, aslab;
    DI bool next(int i, pg8::Unit& u) const { pg8::Unit t; if (!o.next(i / 3, t)) return false; u.pm = t.pm; u.pn = t.pn + 4 * (i % 3); return true; }
    DI const char* abase(const pg8::Unit& u) const { return A + (size_t)(u.pn >> 2) * aslab + (size_t)u.pm * tstep; }
    DI const char* bbase(const pg8::Unit& u) const { return B + (size_t)u.pn * tstep; }
};
struct SchedMoe {
    pg8::StaticOrder o; const char* A; const char* B; unsigned eslab; const LAS int* texp;
    DI bool next(int i, pg8::Unit& u) const { return o.next(i, u); }
    DI const char* abase(const pg8::Unit& u) const { return A + (size_t)u.pm * (256u * 1024u); }
    DI const char* bbase(const pg8::Unit& u) const { return B + (size_t)((unsigned)texp[u.pm] * eslab) + (size_t)u.pn * (256u * 1024u); }
};

struct SchedMoeB {
    pg8::StaticOrder o; const char* A; const char* B; unsigned eslab; const LAS int* texp;
    DI bool next(int i, pg8::Unit& u) const { return o.next(i, u); }
    DI const char* abase(const pg8::Unit& u) const { return A + (size_t)u.pm * (256u * 2048u); }
    DI const char* bbase(const pg8::Unit& u) const { return B + (size_t)((unsigned)texp[u.pm] * eslab) + (size_t)u.pn * (256u * 2048u); }
};

struct EpiStoreBf16 {
    static constexpr bool PERM = true;
    bf16_t* O; int ldc; int coff = 0;
    DI void operator()(const f32x4 (&acc)[2][2][4][2], const pg8::Unit& u, int wr, int wc, int fr, int fq) const {
        const int row0 = u.pm * 256 + wr * 64 + fr, col0 = coff + u.pn * 256 + wc * 32 + 8 * fq;
#pragma unroll
        for (int ai = 0; ai < 2; ++ai)
#pragma unroll
            for (int m = 0; m < 4; ++m) { bf16_t* rowp = O + (size_t)(row0 + ai * 128 + m * 16) * ldc + col0;
#pragma unroll
                for (int bj = 0; bj < 2; ++bj) { const f32x4 v0 = acc[ai][bj][m][0], v1 = acc[ai][bj][m][1];
                    u32x4 w; w.x = pk2(v0[0], v0[1]); w.y = pk2(v0[2], v0[3]); w.z = pk2(v1[0], v1[1]); w.w = pk2(v1[2], v1[3]);
                    *(u32x4*)(rowp + bj * 128) = w; } }
    }
};
struct EpiStoreBf16N {
    static constexpr bool PERM = false;
    bf16_t* O; int ldc; int coff = 0;
    DI void operator()(const f32x4 (&acc)[2][2][4][2], const pg8::Unit& u, int wr, int wc, int fr, int fq) const {
        const int row0 = u.pm * 256 + wr * 64 + fr, col0 = coff + u.pn * 256 + wc * 32 + 4 * fq;
#pragma unroll
        for (int ai = 0; ai < 2; ++ai)
#pragma unroll
            for (int m = 0; m < 4; ++m) { bf16_t* rowp = O + (size_t)(row0 + ai * 128 + m * 16) * ldc + col0;
#pragma unroll
                for (int bj = 0; bj < 2; ++bj)
#pragma unroll
                    for (int n = 0; n < 2; ++n) { const f32x4 v = acc[ai][bj][m][n]; u32x2 w; w.x = pk2(v[0], v[1]); w.y = pk2(v[2], v[3]); *(u32x2*)(rowp + bj * 128 + n * 16) = w; } }
    }
};
struct EpiQaRope {
    static constexpr bool PERM = true;
    bf16_t* O; const float* rope;
    DI void operator()(const f32x4 (&acc)[2][2][4][2], const pg8::Unit& u, int wr, int wc, int fr, int fq) const {
        const int row0 = u.pm * 256 + wr * 64 + fr, col0 = u.pn * 256 + wc * 32 + 8 * fq;
#pragma unroll
        for (int ai = 0; ai < 2; ++ai)
#pragma unroll
            for (int m = 0; m < 4; ++m) { const int row = row0 + ai * 128 + m * 16; bf16_t* rowp = O + (size_t)row * 768 + col0;
#pragma unroll
                for (int bj = 0; bj < 2; ++bj) { f32x4 v0 = acc[ai][bj][m][0], v1 = acc[ai][bj][m][1];
                    const int c8 = col0 + bj * 128, p0 = c8 % 96;
                    if (p0 < 32) { const f32x4* cs = (const f32x4*)(rope + (size_t)row * 48 + p0); const f32x4 a = cs[0], b = cs[1];
                        const f32x4 r0 = {v0[0] * a[0] - v0[1] * a[1], v0[1] * a[0] + v0[0] * a[1], v0[2] * a[2] - v0[3] * a[3], v0[3] * a[2] + v0[2] * a[3]};
                        const f32x4 r1 = {v1[0] * b[0] - v1[1] * b[1], v1[1] * b[0] + v1[0] * b[1], v1[2] * b[2] - v1[3] * b[3], v1[3] * b[2] + v1[2] * b[3]};
                        v0 = r0; v1 = r1; }
                    u32x4 w; w.x = pk2(v0[0], v0[1]); w.y = pk2(v0[2], v0[3]); w.z = pk2(v1[0], v1[1]); w.w = pk2(v1[2], v1[3]);
                    *(u32x4*)(rowp + bj * 128) = w; } }
    }
};
struct EpiBranchGate {
    static constexpr bool PERM = true;
    bf16_t* MG; const bf16_t* P; const float* bgate;
    DI void operator()(const f32x4 (&acc)[2][2][4][2], const pg8::Unit& u, int wr, int wc, int fr, int fq) const {
        const int n = u.pn >> 2, row0 = u.pm * 256 + wr * 64 + fr, colg = u.pn * 256 + wc * 32 + 8 * fq, col0 = colg - n * 1024;
        f32x4 bg[2][2];
#pragma unroll
        for (int bj = 0; bj < 2; ++bj) { bg[bj][0] = *(const f32x4*)(bgate + colg + bj * 128); bg[bj][1] = *(const f32x4*)(bgate + colg + bj * 128 + 4); }
        u32x4 gl[2][2][2], pv[2][2][2];
#define EBG_LOAD(slot, grp) do { _Pragma("unroll") for (int m2 = 0; m2 < 2; ++m2) _Pragma("unroll") for (int bj = 0; bj < 2; ++bj) { const size_t row = (size_t)(row0 + ((grp) >> 1) * 128 + (2 * ((grp) & 1) + m2) * 16); \
            gl[slot][m2][bj] = *(const u32x4*)(P + row * NP + colg + bj * 128); pv[slot][m2][bj] = (n > 0) ? *(const u32x4*)(MG + row * D_MODEL + col0 + bj * 128) : (u32x4){0u, 0u, 0u, 0u}; } } while (0)
        EBG_LOAD(0, 0);
#pragma unroll
        for (int grp = 0; grp < 4; ++grp) {
            const int slot = grp & 1, ai = grp >> 1, mh = grp & 1;
            if (grp + 1 < 4) { if (slot == 0) EBG_LOAD(1, grp + 1); else EBG_LOAD(0, grp + 1); }
            asm volatile("" ::: "memory");
#pragma unroll
            for (int m2 = 0; m2 < 2; ++m2)
#pragma unroll
                for (int bj = 0; bj < 2; ++bj) { const int m = 2 * mh + m2; const size_t row = (size_t)(row0 + ai * 128 + m * 16); const f32x4 v0 = acc[ai][bj][m][0], v1 = acc[ai][bj][m][1]; const u32x4 g = gl[slot][m2][bj], q = pv[slot][m2][bj];
                    float o[8];
                    o[0] = v0[0] * fast_sigmoid(bf_lo(g.x) + bg[bj][0][0]) + bf_lo(q.x); o[1] = v0[1] * fast_sigmoid(bf_hi(g.x) + bg[bj][0][1]) + bf_hi(q.x);
                    o[2] = v0[2] * fast_sigmoid(bf_lo(g.y) + bg[bj][0][2]) + bf_lo(q.y); o[3] = v0[3] * fast_sigmoid(bf_hi(g.y) + bg[bj][0][3]) + bf_hi(q.y);
                    o[4] = v1[0] * fast_sigmoid(bf_lo(g.z) + bg[bj][1][0]) + bf_lo(q.z); o[5] = v1[1] * fast_sigmoid(bf_hi(g.z) + bg[bj][1][1]) + bf_hi(q.z);
                    o[6] = v1[2] * fast_sigmoid(bf_lo(g.w) + bg[bj][1][2]) + bf_lo(q.w); o[7] = v1[3] * fast_sigmoid(bf_hi(g.w) + bg[bj][1][3]) + bf_hi(q.w);
                    u32x4 w; w.x = pk2(o[0], o[1]); w.y = pk2(o[2], o[3]); w.z = pk2(o[4], o[5]); w.w = pk2(o[6], o[7]);
                    *(u32x4*)(MG + row * D_MODEL + col0 + bj * 128) = w; }
        }
#undef EBG_LOAD
    }
};
struct EpiResidual {
    static constexpr bool PERM = false;
    const float* xin; float* xout; const float* gmod;
    DI void operator()(const f32x4 (&acc)[2][2][4][2], const pg8::Unit& u, int wr, int wc, int fr, int fq) const {
        const int row0 = u.pm * 256 + wr * 64 + fr, col0 = u.pn * 256 + wc * 32 + 4 * fq;
        const float* gm = gmod + (size_t)(u.pm >> 3) * 6144 + col0;
        f32x4 gv[2][2];
#pragma unroll
        for (int bj = 0; bj < 2; ++bj)
#pragma unroll
            for (int n = 0; n < 2; ++n) gv[bj][n] = *(const f32x4*)(gm + bj * 128 + n * 16);
        f32x4 xv[2][2][2][2];
#define ERS_LOAD(slot, grp) do { _Pragma("unroll") for (int m2 = 0; m2 < 2; ++m2) { const size_t off = (size_t)(row0 + ((grp) >> 1) * 128 + (2 * ((grp) & 1) + m2) * 16) * D_MODEL + col0; \
            _Pragma("unroll") for (int bj = 0; bj < 2; ++bj) _Pragma("unroll") for (int n = 0; n < 2; ++n) xv[slot][m2][bj][n] = *(const f32x4*)(xin + off + bj * 128 + n * 16); } } while (0)
        ERS_LOAD(0, 0);
#pragma unroll
        for (int grp = 0; grp < 4; ++grp) {
            const int slot = grp & 1, ai = grp >> 1, mh = grp & 1;
            if (grp + 1 < 4) { if (slot == 0) ERS_LOAD(1, grp + 1); else ERS_LOAD(0, grp + 1); }
            asm volatile("" ::: "memory");
#pragma unroll
            for (int m2 = 0; m2 < 2; ++m2) { const size_t off = (size_t)(row0 + ai * 128 + (2 * mh + m2) * 16) * D_MODEL + col0;
#pragma unroll
                for (int bj = 0; bj < 2; ++bj)
#pragma unroll
                    for (int n = 0; n < 2; ++n) *(f32x4*)(xout + off + bj * 128 + n * 16) = xv[slot][m2][bj][n] + gv[bj][n] * acc[ai][bj][2 * mh + m2][n]; }
        }
#undef ERS_LOAD
    }
};
struct EpiSwiglu {
    static constexpr bool PERM = false;
    bf16_t* ACT; const float* b1; const LAS int* texp;
    DI void operator()(const f32x4 (&acc)[2][2][4][2], const pg8::Unit& u, int wr, int wc, int fr, int fq) const {
        const int row0 = u.pm * 256 + wr * 64 + fr, e = texp[u.pm];
        const float* bb = b1 + (size_t)e * 2048;
#pragma unroll
        for (int bj = 0; bj < 2; ++bj) { const int j0 = u.pn * 128 + bj * 64 + wc * 16 + 4 * fq;
            const f32x4 ba = *(const f32x4*)(bb + 2 * j0), bc = *(const f32x4*)(bb + 2 * j0 + 4);
            const f32x4 bgt = {ba[0], ba[2], bc[0], bc[2]}, bup = {ba[1], ba[3], bc[1], bc[3]};
#pragma unroll
            for (int ai = 0; ai < 2; ++ai)
#pragma unroll
                for (int m = 0; m < 4; ++m) { const f32x4 g = acc[ai][bj][m][0] + bgt, up = acc[ai][bj][m][1] + bup; float o[4];
#pragma unroll
                    for (int i = 0; i < 4; ++i) { const float gg = fminf(g[i], 7.0f), uu = fminf(fmaxf(up[i], -7.0f), 7.0f);
                        o[i] = (uu + 1.0f) * gg * fast_sigmoid(1.702f * gg);
                    }
                    u32x2 w; w.x = pk2(o[0], o[1]); w.y = pk2(o[2], o[3]);
                    *(u32x2*)(ACT + (size_t)(row0 + ai * 128 + m * 16) * D_EXP + j0) = w; } }
    }
};
struct EpiSwiglu8 {
    static constexpr bool PERM = false;
    unsigned char* ACT; const float* b1; const LAS int* texp;
    DI void operator()(const f32x4 (&acc)[2][2][4][2], const pg8::Unit& u, int wr, int wc, int fr, int fq) const {
        const int row0 = u.pm * 256 + wr * 64 + fr, e = texp[u.pm];
        const float* bb = b1 + (size_t)e * 2048;
#pragma unroll
        for (int bj = 0; bj < 2; ++bj) { const int j0 = u.pn * 128 + bj * 64 + wc * 16 + 4 * fq;
            const f32x4 ba = *(const f32x4*)(bb + 2 * j0), bc = *(const f32x4*)(bb + 2 * j0 + 4);
            const f32x4 bgt = {ba[0], ba[2], bc[0], bc[2]}, bup = {ba[1], ba[3], bc[1], bc[3]};
#pragma unroll
            for (int ai = 0; ai < 2; ++ai)
#pragma unroll
                for (int m = 0; m < 4; ++m) { const f32x4 g = acc[ai][bj][m][0] + bgt, up = acc[ai][bj][m][1] + bup; float o[4];
#pragma unroll
                    for (int i = 0; i < 4; ++i) { const float gg = fminf(g[i], 7.0f), uu = fminf(fmaxf(up[i], -7.0f), 7.0f);
                        o[i] = (uu + 1.0f) * gg * fast_sigmoid(1.702f * gg);
                    }
                    *(unsigned*)(ACT + (size_t)(row0 + ai * 128 + m * 16) * D_EXP + j0) = pk4_fp8(o[0], o[1], o[2], o[3]); } }
    }
};
struct EpiMoeOut {
    static constexpr bool PERM = true;
    bf16_t* Y; const float* b2; const float* gate; const LAS int* texp;
    DI void operator()(const f32x4 (&acc)[2][2][4][2], const pg8::Unit& u, int wr, int wc, int fr, int fq) const {
        const int row0 = u.pm * 256 + wr * 64 + fr, col0 = u.pn * 256 + wc * 32 + 8 * fq, e = texp[u.pm];
        const float* bb = b2 + (size_t)e * D_MODEL + col0;
        f32x4 bv[2][2];
#pragma unroll
        for (int bj = 0; bj < 2; ++bj) { bv[bj][0] = *(const f32x4*)(bb + bj * 128); bv[bj][1] = *(const f32x4*)(bb + bj * 128 + 4); }
#pragma unroll
        for (int ai = 0; ai < 2; ++ai) {
            float gt[4];
#pragma unroll
            for (int m = 0; m < 4; ++m) gt[m] = gate[row0 + ai * 128 + m * 16];
            asm volatile("" ::: "memory");
#pragma unroll
            for (int m = 0; m < 4; ++m) { const int row = row0 + ai * 128 + m * 16; const float g = gt[m];
#pragma unroll
                for (int bj = 0; bj < 2; ++bj) { const f32x4 v0 = (acc[ai][bj][m][0] + bv[bj][0]) * g, v1 = (acc[ai][bj][m][1] + bv[bj][1]) * g;
                    u32x4 w; w.x = pk2(v0[0], v0[1]); w.y = pk2(v0[2], v0[3]); w.z = pk2(v1[0], v1[1]); w.w = pk2(v1[2], v1[3]);
                    *(u32x4*)(Y + (size_t)row * D_MODEL + col0 + bj * 128) = w; } }
            asm volatile("" ::: "memory");
        }
    }
};

constexpr size_t MiB = 1u << 20;
constexpr size_t WS_CTL = 0, CTL_ZERO_BYTES = 1 * MiB;
constexpr size_t WS_MOD = 1 * MiB, WS_ROPE = 2 * MiB, WS_WIN = 8 * MiB, WS_WUQ = 33 * MiB, WS_WUKV = 34 * MiB, WS_WB = 35 * MiB, WS_WOUT = 41 * MiB, WS_W1 = 53 * MiB, WS_W2 = 309 * MiB,
                 WS_X1 = 437 * MiB, WS_H = 565 * MiB, WS_CQ = 629 * MiB, WS_CKV = 645 * MiB, WS_KPE = 661 * MiB, WS_QA = 663 * MiB, WS_KV = 711 * MiB, WS_O3 = 775 * MiB, WS_QC = 871 * MiB,
                 WS_KC = 903 * MiB, WS_VC = 907 * MiB, WS_QI = 911 * MiB, WS_KI = 943 * MiB, WS_IW = 947 * MiB, WS_ROUTE = 948 * MiB, WS_P = 952 * MiB, WS_GY = 1352 * MiB, WS_END = 1544 * MiB;
constexpr size_t WS_HG8 = WS_QA;
constexpr size_t WS_XB = WS_P, WS_ACT = WS_P + 272 * MiB, WS_Y = WS_P, WS_H8 = WS_H;
constexpr size_t RT_TOPE = 0, RT_TOPG = 512 * 1024, RT_RANK = 1 * MiB, RT_SLOTOF = 1 * MiB + 512 * 1024, RT_TOKOF = 2 * MiB, RT_GATEOF = 3 * MiB;
static_assert((size_t)NSLOT_MAX * 1024 * 2 <= 272 * MiB && WS_ACT + 272 * MiB <= WS_END, "MoE overlay: XB (fp8) and Y (bf16) share [P, P+272M) (XB is dead when Y is written); ACT in [P+272M, P+544M)");
static_assert((size_t)T_TOK * NP * 2 == 400 * MiB, "P size");
constexpr int CW_BAR = 4096, CW_CNT = 16384;
constexpr int LDS_BYTES = 163840, LDS_X = 131072, MISC_OFF = LDS_BYTES - 512;

struct Frame {
    LAS unsigned char* lds; int tid, lane, wave, G, bid; float zf;
    float* out; unsigned char* ws; unsigned* ctl;
};
extern __shared__ __attribute__((aligned(16))) unsigned char lds_raw[];
typedef __attribute__((address_space(4))) const char* kptr_t;
DI const void* kin(int i) {
#if defined(__HIP_DEVICE_COMPILE__)
    kptr_t ka = (kptr_t)__builtin_amdgcn_kernarg_segment_ptr(); asm volatile("" : "+s"(ka)); return (const void*)(GAS const void*)*(__attribute__((address_space(4))) const unsigned long long*)(ka + 8 * i);
#else
    (void)i; return nullptr;
#endif
}
#define KIN_x ((const float*)kin(0))
#define KIN_c ((const float*)kin(1))
#define KIN_pos ((const int*)kin(2))
#define KIN_norm1_g ((const float*)kin(3))
#define KIN_norm2_g ((const float*)kin(4))
#define KIN_w_ada ((const float*)kin(5))
#define KIN_b_ada ((const float*)kin(6))
#define KIN_w_in ((const float*)kin(7))
#define KIN_b_gate ((const float*)kin(8))
#define KIN_q_norm ((const float*)kin(9))
#define KIN_w_uq ((const float*)kin(10))
#define KIN_kv_norm ((const float*)kin(11))
#define KIN_w_ukv ((const float*)kin(12))
#define KIN_conv_w ((const float*)kin(13))
#define KIN_w_branch ((const float*)kin(14))
#define KIN_w_out ((const float*)kin(15))
#define KIN_router_w ((const float*)kin(16))
#define KIN_router_b ((const float*)kin(17))
#define KIN_w1 ((const float*)kin(18))
#define KIN_b1 ((const float*)kin(19))
#define KIN_w2 ((const float*)kin(20))
#define KIN_b2 ((const float*)kin(21))
#define KIN_final_g ((const float*)kin(22))
DI Frame make_frame(int wave0) {
    Frame F; unsigned z_ = 0u; asm volatile("" : "+v"(z_));
    F.lds = (LAS unsigned char*)lds_raw; F.lane = (int)__builtin_amdgcn_mbcnt_hi(~0u, __builtin_amdgcn_mbcnt_lo(~0u, z_)); F.wave = wave0; F.tid = wave0 * 64 + F.lane; F.G = gridDim.x; F.bid = blockIdx.x; F.zf = __uint_as_float(z_);
    F.out = (float*)kin(23); F.ws = (unsigned char*)kin(24); F.ctl = (unsigned*)F.ws;
    return F;
}
#define WSP(T, off) ((T*)(F.ws + (off)))


#define XB_TMO      128
#define XB_XCNT(j)  (256  + 64 * (j))
#define XB_XSUB(j)  (1280 + 64 * (j))
#define XB_XGEN(j)  (2304 + 64 * (j))
#define XB_TOP      3328
#define XB_TOPGEN   3392
#define XCD_BAR_WORDS 3456
#define XB_SPIN_CAP (1u << 18)
DI unsigned xb_ld(unsigned* p)              { return __hip_atomic_load(p, __ATOMIC_RELAXED, __HIP_MEMORY_SCOPE_AGENT); }
DI unsigned xb_add(unsigned* p, unsigned v) { return __hip_atomic_fetch_add(p, v, __ATOMIC_RELAXED, __HIP_MEMORY_SCOPE_AGENT); }
DI unsigned xb_xcc_id() { return (unsigned)__builtin_amdgcn_s_getreg((3 << 11) | 20) & 0xFu; }
#define XB_SPIN(cond, bar) do { unsigned _sp = 0; while (cond) { __builtin_amdgcn_s_sleep(1); \
    if ((++_sp & 255u) == 0u) { if (xb_ld(&(bar)[XB_TMO])) break; if (_sp > XB_SPIN_CAP) { atomicAdd(&(bar)[XB_TMO], 1u); break; } } } } while (0)
struct XcdBarrier { unsigned* bar; unsigned x; volatile LAS unsigned* st; };
DI XcdBarrier xcd_barrier_post(unsigned* bar, volatile LAS unsigned* st, int tid) {
    XcdBarrier b; b.bar = bar; b.x = xb_xcc_id(); b.st = st;
    if (tid == 0) (void)xb_add(&bar[XB_XCNT(b.x)], 1u);
    return b;
}
DI void xcd_barrier_complete(unsigned* bar, unsigned x, unsigned& nloc, unsigned& nx) {
    const unsigned G = gridDim.x * gridDim.y * gridDim.z;
    unsigned sum, cnt, mine, sp = 0u;
    for (;;) {
        sum = 0u; cnt = 0u; mine = 0u;
#pragma unroll
        for (unsigned j = 0; j < 16; ++j) { const unsigned c = xb_ld(&bar[XB_XCNT(j)]); sum += c; cnt += (c > 0u) ? 1u : 0u; mine = (j == x) ? c : mine; }
        if (sum == G) break;
        __builtin_amdgcn_s_sleep(1);
        if ((++sp & 255u) == 0u) { if (xb_ld(&bar[XB_TMO])) break; if (sp > XB_SPIN_CAP) { atomicAdd(&bar[XB_TMO], 1u); break; } }
    }
    nloc = mine > 0u ? mine : 1u; nx = cnt > 0u ? cnt : 1u;
}
DI void xcd_barrier(const XcdBarrier& b, int tid) {
    asm volatile("s_waitcnt vmcnt(0)" ::: "memory");
    __syncthreads();
    if (tid == 0) {
        unsigned* bar = b.bar;
        __builtin_amdgcn_s_waitcnt(0);
        unsigned nloc = b.st[0], nx = b.st[1];
        if (nloc == 0u) { xcd_barrier_complete(bar, b.x, nloc, nx); b.st[0] = nloc; b.st[1] = nx; }
        const unsigned old = xb_add(&bar[XB_XSUB(b.x)], 1u);
        const unsigned gen = old / nloc;
        if (old + 1u == (gen + 1u) * nloc) {
            __builtin_amdgcn_fence(__ATOMIC_RELEASE, "agent");
            asm volatile("s_waitcnt vmcnt(0)" ::: "memory");
            const unsigned og = xb_add(&bar[XB_TOP], 1u);
            const unsigned tg = og / nx;
            if (og + 1u == (tg + 1u) * nx) xb_add(&bar[XB_TOPGEN], 1u);
            else XB_SPIN(xb_ld(&bar[XB_TOPGEN]) == tg, bar);
            __builtin_amdgcn_fence(__ATOMIC_ACQUIRE, "agent");
            xb_add(&bar[XB_XGEN(b.x)], 1u);
            asm volatile("s_waitcnt vmcnt(0)" ::: "memory");
        } else {
            XB_SPIN(xb_ld(&bar[XB_XGEN(b.x)]) == gen, bar);
            __builtin_amdgcn_fence(__ATOMIC_ACQUIRE, "agent");
            asm volatile("s_waitcnt vmcnt(0)" ::: "memory");
        }
    }
    __syncthreads();
}

#ifndef G1_F8_COLS
#define G1_F8_COLS 3072
#endif
DI int rope_perm(int p, int half) { return (p < 2 * half) ? (p >> 1) + half * (p & 1) : p; }
DI int cmap_in(int r) {
    if (r < PC_CONV) return OC_GATE + r;
    if (r < PC_DQ) return OC_CONV + (r - PC_CONV);
    if (r < PC_IQ) { const int j = r - PC_DQ; return OC_DQ + (j & ~63) + rope_perm(j & 63, 8); }
    if (r < PC_QLAT) { const int j = r - PC_IQ; return OC_IQ + (j & ~63) + rope_perm(j & 63, 8); }
    if (r < PC_KVLAT) return OC_QLAT + (r - PC_QLAT);
    if (r < PC_DKV) { const int j = r - PC_KVLAT; return j < 128 ? OC_KVLAT + j : OC_KVLAT + 128 + rope_perm(j - 128, 16); }
    if (r < PC_IK) { const int j = r - PC_DKV; return j < 64 ? OC_DKV + rope_perm(j, 8) : OC_DKV + j; }
    if (r < PC_IW) return OC_IK + rope_perm(r - PC_IK, 8);
    if (r < IN_COLS) return OC_IW + (r - PC_IW);
    return -1;
}
DI int cmap_uq(int r) { const int h = r / 96, p = r % 96; return h * 96 + rope_perm(p, 16); }
DI int cmap_w1(int R) { const int pn = R >> 8, rem = R & 255, bj = rem >> 7, wc = (rem >> 5) & 3, n = (rem >> 4) & 1, f = rem & 15; return 2 * (pn * 128 + bj * 64 + wc * 16 + f) + n; }
DI void transpose_item(const float* W, int K, int N, bf16_t* WT, int ldk, int koff, LAS float* scr, int k0, int n0, int csrc, int lane) {
#pragma unroll 8
    for (int i = 0; i < 32; ++i) { const int kk = 2 * i + (lane >> 5); float v = 0.f; if (csrc >= 0 && k0 + kk < K) v = W[(size_t)(k0 + kk) * N + csrc]; scr[kk * 33 + (lane & 31)] = v; }
    LDS_WAIT(); asm volatile("" ::: "memory");
    const int c = lane & 7;
#pragma unroll
    for (int j = 0; j < 4; ++j) { const int n = (lane >> 3) + 8 * j; const LAS float* s = scr + (8 * c) * 33 + n;
        u32x4 o; o.x = pk2(s[0 * 33], s[1 * 33]); o.y = pk2(s[2 * 33], s[3 * 33]); o.z = pk2(s[4 * 33], s[5 * 33]); o.w = pk2(s[6 * 33], s[7 * 33]);
        *(u32x4*)(WT + (size_t)(n0 + n) * ldk + koff + k0 + 8 * c) = o; }
    LDS_WAIT(); asm volatile("" ::: "memory");
}
DI void transpose_item_f8(const float* W, int K, int N, unsigned char* WT, int ldk, LAS float* scr, int k0, int n0, int csrc, int lane, float qs) {
#pragma unroll 8
    for (int i = 0; i < 32; ++i) { const int kk = 2 * i + (lane >> 5); scr[kk * 33 + (lane & 31)] = W[(size_t)(k0 + kk) * N + csrc] * qs; }
    LDS_WAIT(); asm volatile("" ::: "memory");
    const int c = lane & 7;
#pragma unroll
    for (int j = 0; j < 4; ++j) { const int n = (lane >> 3) + 8 * j; const LAS float* s = scr + (8 * c) * 33 + n;
        u32x2 o; o.x = pk4_fp8(s[0 * 33], s[1 * 33], s[2 * 33], s[3 * 33]); o.y = pk4_fp8(s[4 * 33], s[5 * 33], s[6 * 33], s[7 * 33]);
        *(u32x2*)(WT + (size_t)(n0 + n) * ldk + k0 + 8 * c) = o; }
    LDS_WAIT(); asm volatile("" ::: "memory");
}
DI void titem_load(const float* W, int N, int k0, int csrc, int lane, float (&v)[32]) {
#pragma unroll
    for (int i = 0; i < 32; ++i) v[i] = W[(size_t)(k0 + 2 * i + (lane >> 5)) * N + csrc];
}
DI void titem_store_f8(const float (&v)[32], unsigned char* WT, int ldk, LAS float* scr, int k0, int n0, int lane, float qs) {
#pragma unroll
    for (int i = 0; i < 32; ++i) scr[(2 * i + (lane >> 5)) * 33 + (lane & 31)] = v[i] * qs;
    LDS_WAIT(); asm volatile("" ::: "memory");
    const int c = lane & 7;
#pragma unroll
    for (int j = 0; j < 4; ++j) { const int n = (lane >> 3) + 8 * j; const LAS float* s = scr + (8 * c) * 33 + n;
        u32x2 o; o.x = pk4_fp8(s[0 * 33], s[1 * 33], s[2 * 33], s[3 * 33]); o.y = pk4_fp8(s[4 * 33], s[5 * 33], s[6 * 33], s[7 * 33]);
        *(u32x2*)(WT + (size_t)(n0 + n) * ldk + k0 + 8 * c) = o; }
    LDS_WAIT(); asm volatile("" ::: "memory");
}
template <bool W1>
DI void convert_family_f8(const float* src, unsigned char* dst, int N, int nmat, LAS float* scr, int gw, int NGW, int lane) {
    const int nbn = N / 32, ipm = 16 * nbn, total = nmat * ipm;
    float va[32], vb[32];
#define TF_DECODE(it, j_, k0_, n0_, cs_) const int j_ = (it) / ipm, q_##j_ = (it) % ipm, k0_ = 64 * (q_##j_ / nbn), n0_ = 32 * (q_##j_ % nbn), cs_ = W1 ? cmap_w1(n0_ + (lane & 31)) : n0_ + (lane & 31)
    int it = gw;
    if (it < total) { TF_DECODE(it, j0, k00, n00, cs0); titem_load(src + (size_t)j0 * 1024 * N, N, k00, cs0, lane, va); }
    while (it < total) {
        const int it2 = it + NGW;
        if (it2 < total) { TF_DECODE(it2, j2, k02, n02, cs2); titem_load(src + (size_t)j2 * 1024 * N, N, k02, cs2, lane, vb); }
        { TF_DECODE(it, j1, k01, n01, cs1); (void)cs1; titem_store_f8(va, dst + (size_t)j1 * N * 1024, 1024, scr, k01, n01, lane, 64.0f); }
        const int it3 = it2 + NGW;
        if (it3 < total) { TF_DECODE(it3, j3, k03, n03, cs3); titem_load(src + (size_t)j3 * 1024 * N, N, k03, cs3, lane, va); }
        if (it2 < total) { TF_DECODE(it2, j4, k04, n04, cs4); (void)cs4; titem_store_f8(vb, dst + (size_t)j4 * N * 1024, 1024, scr, k04, n04, lane, 64.0f); }
        it = it3;
    }
#undef TF_DECODE
}
DI void sincos_d(double x, float& s, float& c) {
    const double kd = __builtin_rint(x * 0.6366197723675814); const int k = (int)kd;
    double r = __builtin_fma(-kd, 1.5707963267948966, x); r = __builtin_fma(-kd, 6.123233995736766e-17, r);
    const double r2 = r * r;
    const double sp = r * (1.0 + r2 * (-1.0 / 6 + r2 * (1.0 / 120 + r2 * (-1.0 / 5040 + r2 * (1.0 / 362880 + r2 * (-1.0 / 39916800 + r2 * (1.0 / 6227020800.0)))))));
    const double cp = 1.0 + r2 * (-0.5 + r2 * (1.0 / 24 + r2 * (-1.0 / 720 + r2 * (1.0 / 40320 + r2 * (-1.0 / 3628800 + r2 * (1.0 / 479001600.0 + r2 * (-1.0 / 87178291200.0)))))));
    const int q = k & 3;
    const double ss = (q == 0) ? sp : (q == 1) ? cp : (q == 2) ? -sp : -cp;
    const double cc = (q == 0) ? cp : (q == 1) ? -sp : (q == 2) ? -cp : sp;
    s = (float)ss; c = (float)cc;
}
DI void phase_prologue(const Frame& F) {
    const int tid = F.tid, lane = F.lane, wave = F.wave;
    __syncthreads();
    const float* in_c = KIN_c; const float* in_wada = KIN_w_ada; const float* in_bada = KIN_b_ada; const int* in_pos = KIN_pos;
    if (F.bid < 192) {
        LAS float* cact = (LAS float*)F.lds;
        LAS float* red = (LAS float*)(F.lds + 65536);
        for (int idx = tid; idx < 16 * 1024; idx += 512) { const int b = idx >> 10, k = idx & 1023; const float cv = in_c[idx]; cact[k * 16 + b] = cv * fast_sigmoid(cv); }
        __syncthreads();
        float* MOD = WSP(float, WS_MOD);
        for (int it = F.bid; it < 192; it += F.G) {
            const int l = it / 96, cb = it % 96, col = cb * 64 + lane;
            float acc[16];
#pragma unroll
            for (int b = 0; b < 16; ++b) acc[b] = 0.f;
            const float* wp = in_wada + ((size_t)l * 1024 + wave * 128) * 6144 + col;
#pragma unroll 4
            for (int kk = 0; kk < 128; ++kk) { const float wv = wp[(size_t)kk * 6144]; const LAS f32x4* cp = (const LAS f32x4*)(cact + (wave * 128 + kk) * 16);
#pragma unroll
                for (int q = 0; q < 4; ++q) { const f32x4 cv = cp[q]; acc[4 * q] += cv[0] * wv; acc[4 * q + 1] += cv[1] * wv; acc[4 * q + 2] += cv[2] * wv; acc[4 * q + 3] += cv[3] * wv; } }
#pragma unroll
            for (int b = 0; b < 16; ++b) red[(wave * 16 + b) * 64 + lane] = acc[b];
            __syncthreads();
            for (int o = tid; o < 1024; o += 512) { const int b = o >> 6, ln = o & 63; float s = in_bada[l * 6144 + cb * 64 + ln];
#pragma unroll
                for (int w = 0; w < 8; ++w) s += red[(w * 16 + b) * 64 + ln];
                MOD[((size_t)l * 16 + b) * 6144 + cb * 64 + ln] = s; }
            __syncthreads();
        }
    }
    __syncthreads();
    {
        float* ROPE = WSP(float, WS_ROPE);
        const double r16 = 0.44036660267178046;
        for (int idx = F.bid * 512 + tid; idx < T_TOK * 24; idx += F.G * 512) {
            const int t = idx / 24, i = idx % 24; const int e = (i < 16) ? i : 2 * (i - 16);
            double f = 1.0; for (int j = 0; j < e; ++j) f *= r16;
            float s, c; sincos_d((double)in_pos[t] * f, s, c);
            ROPE[(size_t)t * 48 + 2 * i] = c; ROPE[(size_t)t * 48 + 2 * i + 1] = s;
        }
    }
    {
        LAS float* scr = (LAS float*)(F.lds + wave * 16384);
        const int gw = F.bid * 8 + wave, NGW = F.G * 8;
        constexpr int I_IN = 16 * 200, I_UQ = 4 * 24, I_UKV = 4 * 32, I_WB = 8 * 32, I_WO = 16 * 32, I_W1 = 16 * 64, I_W2 = 16 * 32;
        constexpr int N_IN = 2 * I_IN, N_UQ = 2 * I_UQ, N_UKV = 2 * I_UKV, N_WB = 6 * I_WB, N_WO = 2 * I_WO, N_W1 = 64 * I_W1, N_W2 = 64 * I_W2;
        constexpr int NITEMS = N_IN + N_UQ + N_UKV + N_WB + N_WO;
        (void)N_W1; (void)N_W2;
        for (int it = gw; it < NITEMS; it += NGW) {
            int r = it;
            if (r < N_IN) { const int l = r / I_IN, q = r % I_IN, kb = q / 200, nb = q % 200;
                if (32 * nb < G1_F8_COLS) transpose_item_f8(KIN_w_in + (size_t)l * 1024 * IN_COLS, 1024, IN_COLS, WSP(unsigned char, WS_WIN) + (size_t)l * NP * 2048, 1024, scr, 64 * kb, 32 * nb, cmap_in(32 * nb + (lane & 31)), lane, 64.0f);
                else transpose_item(KIN_w_in + (size_t)l * 1024 * IN_COLS, 1024, IN_COLS, WSP(bf16_t, WS_WIN) + (size_t)l * NP * 1024, 1024, 0, scr, 64 * kb, 32 * nb, cmap_in(32 * nb + (lane & 31)), lane);
                continue; } r -= N_IN;
            if (r < N_UQ) { const int l = r / I_UQ, q = r % I_UQ, kb = q / 24, nb = q % 24;
                transpose_item(KIN_w_uq + (size_t)l * 256 * 768, 256, 768, WSP(bf16_t, WS_WUQ) + (size_t)l * 768 * 256, 256, 0, scr, 64 * kb, 32 * nb, cmap_uq(32 * nb + (lane & 31)), lane); continue; } r -= N_UQ;
            if (r < N_UKV) { const int l = r / I_UKV, q = r % I_UKV, kb = q / 32, nb = q % 32;
                transpose_item(KIN_w_ukv + (size_t)l * 128 * 1024, 128, 1024, WSP(bf16_t, WS_WUKV) + (size_t)l * 1024 * 256, 256, 0, scr, 64 * kb, 32 * nb, 32 * nb + (lane & 31), lane); continue; } r -= N_UKV;
            if (r < N_WB) { const int j = r / I_WB, q = r % I_WB, kb = q / 32, nb = q % 32;
                transpose_item(KIN_w_branch + (size_t)j * 512 * 1024, 512, 1024, WSP(bf16_t, WS_WB) + (size_t)j * 1024 * 512, 512, 0, scr, 64 * kb, 32 * nb, 32 * nb + (lane & 31), lane); continue; } r -= N_WB;
            if (r < N_WO) { const int l = r / I_WO, q = r % I_WO, kb = q / 32, nb = q % 32;
                transpose_item(KIN_w_out + (size_t)l * 1024 * 1024, 1024, 1024, WSP(bf16_t, WS_WOUT) + (size_t)l * 1024 * 1024, 1024, 0, scr, 64 * kb, 32 * nb, 32 * nb + (lane & 31), lane); continue; } r -= N_WO;
            (void)r;
        }
        convert_family_f8<true>(KIN_w1, WSP(unsigned char, WS_W1), 2048, 64, scr, gw, NGW, lane);
#if M2_F8
        convert_family_f8<false>(KIN_w2, WSP(unsigned char, WS_W2), 1024, 64, scr, gw, NGW, lane);
#else
        for (int it = gw; it < 64 * I_W2; it += NGW) { const int j = it / I_W2, q = it % I_W2, kb = q / 32, nb = q % 32;
            transpose_item(KIN_w2 + (size_t)j * 1024 * 1024, 1024, 1024, WSP(bf16_t, WS_W2) + (size_t)j * 1024 * 1024, 1024, 0, scr, 64 * kb, 32 * nb, 32 * nb + (lane & 31), lane); }
#endif
    }
}

DI void phase_norm(const Frame& F, const float* xin, float* xout, bool combine, bool write_x, bool final_, int lnext, int lcomb) {
    const int lane = F.lane, gw = F.bid * 8 + F.wave, NGW = F.G * 8;
    const float* in_fg = KIN_final_g; const float* in_n1 = KIN_norm1_g;
    const float* MOD = WSP(float, WS_MOD); const bf16_t* Y = WSP(bf16_t, WS_Y); const int* SLOTOF = (const int*)(F.ws + WS_ROUTE + RT_SLOTOF); bf16_t* H = WSP(bf16_t, WS_H);
    u32x4 slots = {0u, 0u, 0u, 0u};
    if (combine && gw < T_TOK) slots = *(const u32x4*)(SLOTOF + (size_t)gw * 4);
    for (int t = gw; t < T_TOK; t += NGW) {
        const int b = t >> 11; f32x4 v[4];
#pragma unroll
        for (int i = 0; i < 4; ++i) v[i] = *(const f32x4*)(xin + (size_t)t * 1024 + 4 * lane + 256 * i);
        if (combine) {
            const unsigned s0 = slots.x, s1 = slots.y, s2 = slots.z, s3 = slots.w;
            u32x2 ya[4], yb[4], yc[4], yd[4];
#pragma unroll
            for (int i = 0; i < 4; ++i) { const int co = 4 * lane + 256 * i;
                ya[i] = *(const u32x2*)(Y + (size_t)s0 * 1024 + co); yb[i] = *(const u32x2*)(Y + (size_t)s1 * 1024 + co); yc[i] = *(const u32x2*)(Y + (size_t)s2 * 1024 + co); yd[i] = *(const u32x2*)(Y + (size_t)s3 * 1024 + co); }
            if (t + NGW < T_TOK) slots = *(const u32x4*)(SLOTOF + (size_t)(t + NGW) * 4);
            const float* g2 = MOD + ((size_t)lcomb * 16 + b) * 6144 + 5 * 1024;
#pragma unroll
            for (int i = 0; i < 4; ++i) { const int co = 4 * lane + 256 * i; const u32x2 a = ya[i], bq = yb[i], cq = yc[i], dq = yd[i];
                f32x4 sum = {bf_lo(a.x) + bf_lo(bq.x) + bf_lo(cq.x) + bf_lo(dq.x), bf_hi(a.x) + bf_hi(bq.x) + bf_hi(cq.x) + bf_hi(dq.x),
                             bf_lo(a.y) + bf_lo(bq.y) + bf_lo(cq.y) + bf_lo(dq.y), bf_hi(a.y) + bf_hi(bq.y) + bf_hi(cq.y) + bf_hi(dq.y)};
                v[i] += *(const f32x4*)(g2 + co) * sum; }
            if (write_x) {
#pragma unroll
                for (int i = 0; i < 4; ++i) *(f32x4*)(xout + (size_t)t * 1024 + 4 * lane + 256 * i) = v[i]; }
        }
        float ss = 0.f;
#pragma unroll
        for (int i = 0; i < 4; ++i) ss += (v[i][0] * v[i][0] + v[i][1] * v[i][1]) + (v[i][2] * v[i][2] + v[i][3] * v[i][3]);
        ss = wave_sum(ss); const float r = 1.0f / sqrtf(ss * (1.0f / 1024.0f) + NORM_EPS);
        if (final_) {
#pragma unroll
            for (int i = 0; i < 4; ++i) { const int co = 4 * lane + 256 * i; *(f32x4*)(F.out + (size_t)t * 1024 + co) = v[i] * r * *(const f32x4*)(in_fg + co); }
        } else {
            const float* md = MOD + ((size_t)lnext * 16 + b) * 6144;
#pragma unroll
            for (int i = 0; i < 4; ++i) { const int co = 4 * lane + 256 * i;
                const f32x4 g = *(const f32x4*)(in_n1 + lnext * 1024 + co), sc = *(const f32x4*)(md + 1024 + co), sh = *(const f32x4*)(md + co);
                f32x4 h = v[i] * r * g * (sc + 1.0f) + sh;
                u32x2 w; w.x = pk2(h[0], h[1]); w.y = pk2(h[2], h[3]);
                *(u32x2*)(H + (size_t)t * 1024 + co) = w;
                *(unsigned*)(WSP(unsigned char, WS_HG8) + (size_t)t * 1024 + co) = pk4_fp8(h[0], h[1], h[2], h[3]);
                }
        }
    }
}
DI u32x4 rope8v(u32x4 a, f32x4 c0, f32x4 c1) {
    u32x4 o;
    { const float x1 = bf_lo(a.x), x2 = bf_hi(a.x); o.x = pk2(x1 * c0[0] - x2 * c0[1], x2 * c0[0] + x1 * c0[1]); }
    { const float x1 = bf_lo(a.y), x2 = bf_hi(a.y); o.y = pk2(x1 * c0[2] - x2 * c0[3], x2 * c0[2] + x1 * c0[3]); }
    { const float x1 = bf_lo(a.z), x2 = bf_hi(a.z); o.z = pk2(x1 * c1[0] - x2 * c1[1], x2 * c1[0] + x1 * c1[1]); }
    { const float x1 = bf_lo(a.w), x2 = bf_hi(a.w); o.w = pk2(x1 * c1[2] - x2 * c1[3], x2 * c1[2] + x1 * c1[3]); }
    return o;
}
DI u32x4 rope8(u32x4 a, const float* cs) { return rope8v(a, *(const f32x4*)cs, *(const f32x4*)(cs + 4)); }
DI void unpack8(u32x4 a, float (&v)[8]) { v[0] = bf_lo(a.x); v[1] = bf_hi(a.x); v[2] = bf_lo(a.y); v[3] = bf_hi(a.y); v[4] = bf_lo(a.z); v[5] = bf_hi(a.z); v[6] = bf_lo(a.w); v[7] = bf_hi(a.w); }
DI void phase_post(const Frame& F, int l) {
    const int lane = F.lane, gw = F.bid * 8 + F.wave, NGW = F.G * 8;
    const bf16_t* P = WSP(bf16_t, WS_P); const float* ROPE = WSP(float, WS_ROPE);
    bf16_t *CQ = WSP(bf16_t, WS_CQ), *CKV = WSP(bf16_t, WS_CKV), *KPE = WSP(bf16_t, WS_KPE), *OB = WSP(bf16_t, WS_O3) + (size_t)T_TOK * 512, *QC = WSP(bf16_t, WS_QC), *KC = WSP(bf16_t, WS_KC),
           *VC = WSP(bf16_t, WS_VC), *QI = WSP(bf16_t, WS_QI), *KI = WSP(bf16_t, WS_KI); float* IW = WSP(float, WS_IW);
    const float* cw = KIN_conv_w + (size_t)l * 3 * 512 + 8 * lane;
    f32x4 cwv[3][2];
#pragma unroll
    for (int d = 0; d < 3; ++d) { cwv[d][0] = *(const f32x4*)(cw + d * 512); cwv[d][1] = *(const f32x4*)(cw + d * 512 + 4); }
    const float* in_qn = KIN_q_norm + l * 256 + 8 * (lane & 31); const float* in_kn = KIN_kv_norm + l * 128 + 8 * (lane & 15);
    const f32x4 qn0 = *(const f32x4*)in_qn, qn1 = *(const f32x4*)(in_qn + 4), kn0 = *(const f32x4*)in_kn, kn1 = *(const f32x4*)(in_kn + 4);
    const u32x4 z4 = {0u, 0u, 0u, 0u};
    for (int t = gw; t < T_TOK; t += NGW) {
        const bf16_t* pr = P + (size_t)t * NP; const float* rp = ROPE + (size_t)t * 48; const int s = t & (SEQ - 1);
        const bf16_t* pc = pr + PC_CONV + 8 * lane;
        const u32x4 gbw = *(const u32x4*)pc;
        const u32x4 gc2 = *(const u32x4*)(pc + 512), hc2 = *(const u32x4*)(pc + 1024);
        const u32x4 gc1 = (s >= 1) ? *(const u32x4*)(pc - NP + 512) : z4, hc1 = (s >= 1) ? *(const u32x4*)(pc - NP + 1024) : z4;
        const u32x4 gc0 = (s >= 2) ? *(const u32x4*)(pc - 2 * NP + 512) : z4, hc0 = (s >= 2) ? *(const u32x4*)(pc - 2 * NP + 1024) : z4;
        u32x4 dqw = *(const u32x4*)(pr + PC_DQ + 8 * lane), iqw = *(const u32x4*)(pr + PC_IQ + 8 * lane);
        const u32x4 qlw = *(const u32x4*)(pr + PC_QLAT + 8 * (lane & 31));
        const u32x4 kvw = *(const u32x4*)(pr + PC_KVLAT + 8 * (lane < 20 ? lane : 0));
        u32x4 dkw = *(const u32x4*)(pr + PC_DKV + 8 * (lane & 15));
        u32x4 ikw = *(const u32x4*)(pr + PC_IK + 8 * (lane & 7));
        const u32x4 iww = *(const u32x4*)(pr + PC_IW);
        const f32x4 r16a = *(const f32x4*)(rp + 32 + 8 * (lane & 1)), r16b = *(const f32x4*)(rp + 32 + 8 * (lane & 1) + 4);
        const f32x4 r32a = *(const f32x4*)(rp + 8 * (lane & 3)), r32b = *(const f32x4*)(rp + 8 * (lane & 3) + 4);
        asm volatile("" ::: "memory");
        {
            float gb[8], a0[8], b0[8], a1[8], b1[8], a2[8], b2[8]; unpack8(gbw, gb); unpack8(gc0, a0); unpack8(hc0, b0); unpack8(gc1, a1); unpack8(hc1, b1); unpack8(gc2, a2); unpack8(hc2, b2);
            float o[8];
#pragma unroll
            for (int i = 0; i < 8; ++i) { const float w0 = cwv[0][i >> 2][i & 3], w1 = cwv[1][i >> 2][i & 3], w2 = cwv[2][i >> 2][i & 3]; o[i] = gb[i] * (w0 * (a0[i] * b0[i]) + w1 * (a1[i] * b1[i]) + w2 * (a2[i] * b2[i])); }
            u32x4 ow; ow.x = pk2(o[0], o[1]); ow.y = pk2(o[2], o[3]); ow.z = pk2(o[4], o[5]); ow.w = pk2(o[6], o[7]);
            *(u32x4*)(OB + (size_t)t * 512 + 8 * lane) = ow;
        }
        if ((lane & 7) < 2) { dqw = rope8v(dqw, r16a, r16b); iqw = rope8v(iqw, r16a, r16b); }
        *(u32x4*)(QC + (size_t)t * 512 + 8 * lane) = dqw; *(u32x4*)(QI + (size_t)t * 512 + 8 * lane) = iqw;
        float ql[8], kv[8]; unpack8(qlw, ql); unpack8(kvw, kv);
        float ss1 = 0.f, ss2 = 0.f;
        if (lane < 32) {
#pragma unroll
            for (int i = 0; i < 8; ++i) ss1 += ql[i] * ql[i]; }
        if (lane < 16) {
#pragma unroll
            for (int i = 0; i < 8; ++i) ss2 += kv[i] * kv[i]; }
#pragma unroll
        for (int o = 1; o < 64; o <<= 1) { ss1 += __shfl_xor(ss1, o); ss2 += __shfl_xor(ss2, o); }
        const float r1 = 1.0f / sqrtf(ss1 * (1.0f / 256.0f) + NORM_EPS), r2 = 1.0f / sqrtf(ss2 * (1.0f / 128.0f) + NORM_EPS);
        if (lane < 32) { u32x4 o; o.x = pk2(ql[0] * r1 * qn0[0], ql[1] * r1 * qn0[1]); o.y = pk2(ql[2] * r1 * qn0[2], ql[3] * r1 * qn0[3]); o.z = pk2(ql[4] * r1 * qn1[0], ql[5] * r1 * qn1[1]); o.w = pk2(ql[6] * r1 * qn1[2], ql[7] * r1 * qn1[3]);
            *(u32x4*)(CQ + (size_t)t * 256 + 8 * lane) = o;
            u32x4 k = z4; if (lane < 16) { k.x = pk2(kv[0] * r2 * kn0[0], kv[1] * r2 * kn0[1]); k.y = pk2(kv[2] * r2 * kn0[2], kv[3] * r2 * kn0[3]); k.z = pk2(kv[4] * r2 * kn1[0], kv[5] * r2 * kn1[1]); k.w = pk2(kv[6] * r2 * kn1[2], kv[7] * r2 * kn1[3]); }
            *(u32x4*)(CKV + (size_t)t * 256 + 8 * lane) = k; }
        if (lane >= 16 && lane < 20) *(u32x4*)(KPE + (size_t)t * 32 + 8 * (lane - 16)) = rope8v(kvw, r32a, r32b);
        if (lane < 16) { if (lane < 2) dkw = rope8v(dkw, r16a, r16b); if (lane < 8) *(u32x4*)(KC + (size_t)t * 64 + 8 * lane) = dkw; else *(u32x4*)(VC + (size_t)t * 64 + 8 * (lane - 8)) = dkw; }
        if (lane >= 16 && lane < 24) { const int c = lane - 16; if (c < 2) ikw = rope8v(ikw, r16a, r16b); *(u32x4*)(KI + (size_t)t * 64 + 8 * c) = ikw; }
        if (lane == 32) { float v[8]; unpack8(iww, v); *(f32x4*)(IW + (size_t)t * 8) = (f32x4){v[0], v[1], v[2], v[3]}; *(f32x4*)(IW + (size_t)t * 8 + 4) = (f32x4){v[4], v[5], v[6], v[7]}; }
    }
}

DI int crow(int r, int hi) { return (r & 3) + 8 * (r >> 2) + 4 * hi; }
#define MFMA32(a, b, c) __builtin_amdgcn_mfma_f32_32x32x16_bf16((a), (b), (c), 0, 0, 0)
#define MFMA16(a, b, c) __builtin_amdgcn_mfma_f32_16x16x32_bf16((a), (b), (c), 0, 0, 0)
#define GLDS16(src, dst) __builtin_amdgcn_global_load_lds((const unsigned*)(src), (LAS unsigned*)(dst), 16, 0, 0)
typedef short v4i16_t __attribute__((ext_vector_type(4)));
DI s16x4 tr_read(const LAS unsigned char* p) { return __builtin_bit_cast(s16x4, __builtin_amdgcn_ds_read_tr16_b64_v4i16((LAS v4i16_t*)p)); }
DI bf16x8 pack8(float a0, float a1, float a2, float a3, float a4, float a5, float a6, float a7) { u32x4 w; w.x = pk2(a0, a1); w.y = pk2(a2, a3); w.z = pk2(a4, a5); w.w = pk2(a6, a7); return __builtin_bit_cast(bf16x8, w); }
DI bf16x8 cat4(s16x4 lo, s16x4 hi) { return (bf16x8){lo[0], lo[1], lo[2], lo[3], hi[0], hi[1], hi[2], hi[3]}; }

constexpr int MLA_K0 = 0, MLA_V0 = 24576, MLA_WS = 49152;
DI void mla_unit(const Frame& F, int b, int h, int qb) {
    const int lane = F.lane, wid = F.wave, r32 = lane & 31, hi = lane >> 5;
    const bf16_t* QA = WSP(bf16_t, WS_QA); const bf16_t* KPE = WSP(bf16_t, WS_KPE); const bf16_t* KV = WSP(bf16_t, WS_KV); bf16_t* OA = WSP(bf16_t, WS_O3);
    const size_t tb = (size_t)b * SEQ; const int q0 = qb * 256, qrow = q0 + 32 * wid + r32;
    const float C2 = 0.10206207261596577f * 1.4426950408889634f;
    LAS unsigned char* lds = F.lds; LAS float* wsf = (LAS float*)(lds + MLA_WS) + wid * 128;
    bf16x8 qr[6];
#pragma unroll
    for (int d0 = 0; d0 < 6; ++d0) qr[d0] = *(const bf16x8*)(QA + (tb + qrow) * 768 + h * 96 + d0 * 16 + hi * 8);
    {
        const float* rp = WSP(float, WS_ROPE) + (tb + qrow) * 48;
        qr[0] = __builtin_bit_cast(bf16x8, rope8(__builtin_bit_cast(u32x4, qr[0]), rp + 8 * hi));
        qr[1] = __builtin_bit_cast(bf16x8, rope8(__builtin_bit_cast(u32x4, qr[1]), rp + 16 + 8 * hi)); }
    const int NT = 4 * (qb + 1);
    const unsigned vo_pe = (unsigned)(lane * 32 + 8 * (wid & 3)) * 2u, vo_k0 = (unsigned)(lane * 1024 + 128 * h + 8 * ((wid + 4) & 7)) * 2u, vo_k1 = (unsigned)(lane * 1024 + 128 * h + 8 * (wid + 4)) * 2u,
                   vo_v = (unsigned)((16 * (wid & 3) + (lane >> 2)) * 1024 + 128 * h + 64 + 32 * (wid >> 2) + 8 * (lane & 3)) * 2u;
    const unsigned ldsb = (unsigned)(unsigned long long)lds;
    const char* pe_b = pg8::uni_ptr((const char*)(KPE + tb * 32)); const char* kv_b = pg8::uni_ptr((const char*)(KV + tb * 1024));
#define MLA_STAGE(kt, buf, vslot) do { const char* pe_ = pe_b + (size_t)(kt) * (64 * 32 * 2); const char* kv_ = kv_b + (size_t)(kt) * (64 * 1024 * 2); \
        if (wid < 4) { pg8::glds16_s(vo_pe, pe_, ldsb + MLA_K0 + (buf) * 12288 + wid * 1024); pg8::glds16_s(vo_k1, kv_, ldsb + MLA_K0 + (buf) * 12288 + (wid + 8) * 1024); } \
        else { pg8::glds16_s(vo_k0, kv_, ldsb + MLA_K0 + (buf) * 12288 + wid * 1024); } \
        pg8::glds16_s(vo_v, kv_, ldsb + MLA_V0 + (vslot) * 8192 + wid * 1024); } while (0)
    MLA_STAGE(0, 0, 0);
    float m = -1e30f, l = 0.f; f32x16 o[2];
#pragma unroll
    for (int r = 0; r < 16; ++r) { o[0][r] = 0.f; o[1][r] = 0.f; }
    const int vboff = ((lane >> 4) & 1) * 32 + (lane & 3) * 8 + (4 * hi + ((lane & 15) >> 2)) * 64;
    const bool upper = wid >= 4; bool have_prev = false; bf16x8 pa[4];
#define MLA_PV(vs) do { const LAS unsigned char* vb_ = lds + MLA_V0 + (vs) * 8192 + vboff; \
        _Pragma("unroll") for (int d0 = 0; d0 < 2; ++d0) _Pragma("unroll") for (int ks = 0; ks < 4; ++ks) { \
            const s16x4 lo_ = tr_read(vb_ + d0 * 4096 + ks * 1024), hh_ = tr_read(vb_ + d0 * 4096 + ks * 1024 + 512); o[d0] = MFMA32(pa[ks], cat4(lo_, hh_), o[d0]); } } while (0)
    int vs_cur = 0, vs_prev = 0;
    for (int kt = 0; kt < NT; ++kt) {
        const int buf = kt & 1; const int vs_next = (vs_cur == 2) ? 0 : vs_cur + 1;
        VM_WAIT(); __syncthreads();
        if (kt + 1 < NT) MLA_STAGE(kt + 1, buf ^ 1, vs_next);
        if (upper && have_prev) { MLA_PV(vs_prev); have_prev = false; }
        if (64 * kt <= q0 + 32 * wid + 31) {
            f32x16 p0, p1;
#pragma unroll
            for (int r = 0; r < 16; ++r) { p0[r] = 0.f; p1[r] = 0.f; }
            const LAS unsigned char* kb = lds + MLA_K0 + buf * 12288 + hi * 1024 + r32 * 16;
#pragma unroll
            for (int d0 = 0; d0 < 6; ++d0) { const bf16x8 b0 = *(const LAS bf16x8*)(kb + d0 * 2048), b1 = *(const LAS bf16x8*)(kb + d0 * 2048 + 512);
                p0 = MFMA32(b0, qr[d0], p0); p1 = MFMA32(b1, qr[d0], p1); }
            if (64 * kt + 63 > q0 + 32 * wid) {
#pragma unroll
                for (int r = 0; r < 16; ++r) { const int kv = 64 * kt + crow(r, hi); if (kv > qrow) p0[r] = -INFINITY; if (kv + 32 > qrow) p1[r] = -INFINITY; } }
            float rm = fmaxf(p0[0], p1[0]);
#pragma unroll
            for (int r = 1; r < 16; ++r) rm = fmaxf(rm, fmaxf(p0[r], p1[r]));
            rm = fmaxf(rm, __shfl_xor(rm, 32));
            const float mn = fmaxf(m, rm);
            if (__any(mn > m)) {
                const float alpha = __builtin_amdgcn_exp2f((m - mn) * C2); l *= alpha; m = mn;
                if (hi == 0) wsf[r32] = alpha;
                LDS_WAIT();
#pragma unroll
                for (int q = 0; q < 4; ++q) { const f32x4 a = *(const LAS f32x4*)(wsf + 8 * q + 4 * hi);
#pragma unroll
                    for (int j = 0; j < 4; ++j) { o[0][4 * q + j] *= a[j]; o[1][4 * q + j] *= a[j]; } }
            }
            const float mc = m * C2; float ls = 0.f;
#pragma unroll
            for (int r = 0; r < 16; ++r) { p0[r] = __builtin_amdgcn_exp2f(__builtin_fmaf(p0[r], C2, -mc)); p1[r] = __builtin_amdgcn_exp2f(__builtin_fmaf(p1[r], C2, -mc)); ls += p0[r] + p1[r]; }
            l += ls;
            pa[0] = pack8(p0[0], p0[1], p0[2], p0[3], p0[4], p0[5], p0[6], p0[7]); pa[1] = pack8(p0[8], p0[9], p0[10], p0[11], p0[12], p0[13], p0[14], p0[15]);
            pa[2] = pack8(p1[0], p1[1], p1[2], p1[3], p1[4], p1[5], p1[6], p1[7]); pa[3] = pack8(p1[8], p1[9], p1[10], p1[11], p1[12], p1[13], p1[14], p1[15]);
            if (upper) have_prev = true; else MLA_PV(vs_cur);
        }
        vs_prev = vs_cur; vs_cur = vs_next;
    }
    if (upper && have_prev) MLA_PV(vs_prev);
#undef MLA_PV
#undef MLA_STAGE
    l += __shfl_xor(l, 32);
    if (hi == 0) wsf[64 + r32] = 1.0f / l;
    LDS_WAIT();
    bf16_t* orow = OA + (tb + q0 + 32 * wid) * 512 + h * 64 + r32;
#pragma unroll
    for (int q = 0; q < 4; ++q) { const f32x4 a = *(const LAS f32x4*)(wsf + 64 + 8 * q + 4 * hi);
#pragma unroll
        for (int j = 0; j < 4; ++j) { const int r = 4 * q + j, rr = crow(r, hi);
            orow[(size_t)rr * 512] = (bf16_t)(pk2(o[0][r] * a[j], 0.f) & 0xffffu); orow[(size_t)rr * 512 + 32] = (bf16_t)(pk2(o[1][r] * a[j], 0.f) & 0xffffu); } }
    __syncthreads();
}

constexpr int DSA_SCW = 2052;
constexpr int DSA_SEL = 16 * DSA_SCW * 4;
DI int mbcnt64(unsigned long long m) { return (int)__builtin_amdgcn_mbcnt_hi((unsigned)(m >> 32), __builtin_amdgcn_mbcnt_lo((unsigned)m, 0u)); }
DI void dsa_unit(const Frame& F, int b, int qt) {
    const int tid = F.tid, lane = F.lane, wid = F.wave, fr = lane & 15, g = lane >> 4;
    const bf16_t *QI = WSP(bf16_t, WS_QI), *KI = WSP(bf16_t, WS_KI), *QC = WSP(bf16_t, WS_QC), *KC = WSP(bf16_t, WS_KC), *VC = WSP(bf16_t, WS_VC); const float* IW = WSP(float, WS_IW);
    bf16_t* OC = WSP(bf16_t, WS_O3) + (size_t)2 * T_TOK * 512;
    const size_t tb = (size_t)b * SEQ; const int t0 = 16 * qt;
    LAS unsigned char* lds = F.lds; LAS float* SC = (LAS float*)lds; LAS unsigned long long* BITS = (LAS unsigned long long*)(lds + DSA_SEL);
    {
        bf16x8 qf[8][2]; float wv[8];
        const bf16_t* qp = QI + (tb + t0 + fr) * 512 + 8 * g;
#pragma unroll
        for (int h = 0; h < 8; ++h) { qf[h][0] = *(const bf16x8*)(qp + h * 64); qf[h][1] = *(const bf16x8*)(qp + h * 64 + 32); }
        { const f32x4 w0 = *(const f32x4*)(IW + (tb + t0 + fr) * 8), w1 = *(const f32x4*)(IW + (tb + t0 + fr) * 8 + 4); wv[0] = w0[0]; wv[1] = w0[1]; wv[2] = w0[2]; wv[3] = w0[3]; wv[4] = w1[0]; wv[5] = w1[1]; wv[6] = w1[2]; wv[7] = w1[3]; }
        const bf16_t* kbase = KI + (tb + fr) * 64 + 8 * g;
        const bf16x8 z8 = {0, 0, 0, 0, 0, 0, 0, 0};
        bf16x8 a0 = z8, a1 = z8, b0 = z8, b1 = z8, c0 = z8, c1 = z8;
        if (wid <= qt) { a0 = *(const bf16x8*)(kbase + (size_t)wid * 1024); a1 = *(const bf16x8*)(kbase + (size_t)wid * 1024 + 32); }
        if (wid + 8 <= qt) { b0 = *(const bf16x8*)(kbase + (size_t)(wid + 8) * 1024); b1 = *(const bf16x8*)(kbase + (size_t)(wid + 8) * 1024 + 32); }
        if (wid + 16 <= qt) { c0 = *(const bf16x8*)(kbase + (size_t)(wid + 16) * 1024); c1 = *(const bf16x8*)(kbase + (size_t)(wid + 16) * 1024 + 32); }
        for (int kt = wid; kt <= qt; kt += 8) {
            bf16x8 n0 = z8, n1 = z8;
            if (kt + 24 <= qt) { n0 = *(const bf16x8*)(kbase + (size_t)(kt + 24) * 1024); n1 = *(const bf16x8*)(kbase + (size_t)(kt + 24) * 1024 + 32); }
            f32x4 s = {F.zf, F.zf, F.zf, F.zf};
#pragma unroll
            for (int h = 0; h < 8; ++h) { f32x4 acc = {F.zf, F.zf, F.zf, F.zf}; acc = MFMA16(a0, qf[h][0], acc); acc = MFMA16(a1, qf[h][1], acc);
#pragma unroll
                for (int r = 0; r < 4; ++r) s[r] += fmaxf(acc[r], 0.f) * wv[h]; }
#pragma unroll
            for (int r = 0; r < 4; ++r) if (16 * kt + 4 * g + r > t0 + fr) s[r] = -INFINITY;
            *(LAS f32x4*)(SC + fr * DSA_SCW + 16 * kt + 4 * g) = s;
            a0 = b0; a1 = b1; b0 = c0; b1 = c1; c0 = n0; c1 = n1;
        }
    }
    __syncthreads();
    for (int qi2 = 0; qi2 < 2; ++qi2) {
        const int qq = 2 * wid + qi2, t = t0 + qq, nvalid = t + 1;
        LAS unsigned long long* bits = BITS + qq * 32;
        if (nvalid <= 256) { if (lane < 32) { const int k0 = 64 * lane; bits[lane] = (k0 + 63 <= t) ? ~0ull : (k0 <= t) ? ((1ull << (t - k0 + 1)) - 1ull) : 0ull; } }
        else {
            const int nq = (nvalid + 511) >> 9;
            float v[32];
#pragma unroll
            for (int i = 0; i < 32; ++i) { const int key = i * 64 + lane; v[i] = (key <= t) ? SC[qq * DSA_SCW + key] : -INFINITY; }
            float vmax = v[0], vmin = (v[0] == -INFINITY) ? INFINITY : v[0];
#pragma unroll
            for (int i = 1; i < 32; ++i) { vmax = fmaxf(vmax, v[i]); vmin = fminf(vmin, (v[i] == -INFINITY) ? INFINITY : v[i]); }
#pragma unroll
            for (int o = 1; o < 64; o <<= 1) { vmax = fmaxf(vmax, __shfl_xor(vmax, o)); vmin = fminf(vmin, __shfl_xor(vmin, o)); }
#define DSA_COUNT(thr, OP, out) do { int c_ = 0; _Pragma("unroll") for (int qd = 0; qd < 4; ++qd) { if (qd < nq) { _Pragma("unroll") for (int i = 0; i < 8; ++i) c_ += (v[8 * qd + i] OP (thr)) ? 1 : 0; } } \
                int tot_ = 0; _Pragma("unroll") for (int b_ = 0; b_ < 6; ++b_) tot_ += __builtin_popcountll(__ballot((c_ >> b_) & 1)) << b_; out = tot_; } while (0)
            float lo = vmin, hi = vmax, K; int cnt;
            DSA_COUNT(hi, >=, cnt);
            if (cnt >= 256) { K = hi; }
            else {
                int clo = nvalid, chi = cnt;
                for (int it = 0;; ++it) {
                    float fr_ = 0.5f;
                    if ((it & 1) == 0) { fr_ = ((float)(clo - 256) + 0.5f) / (float)(clo - chi); fr_ = fminf(fmaxf(fr_, 0.03125f), 0.96875f); }
                    const float mid = lo + (hi - lo) * fr_;
                    if (!(mid > lo && mid < hi)) {
                        const float mid2 = lo + (hi - lo) * 0.5f;
                        if (!(mid2 > lo && mid2 < hi)) { K = lo; cnt = clo; break; }
                        DSA_COUNT(mid2, >=, cnt);
                        if (cnt == 256) { K = mid2; break; }
                        if (cnt > 256) { lo = mid2; clo = cnt; } else { hi = mid2; chi = cnt; }
                        continue;
                    }
                    DSA_COUNT(mid, >=, cnt);
                    if (cnt == 256) { K = mid; break; }
                    if (cnt > 256) { lo = mid; clo = cnt; } else { hi = mid; chi = cnt; }
                }
            }
            if (cnt == 256) {
#pragma unroll
                for (int qd = 0; qd < 4; ++qd) {
#pragma unroll
                    for (int i8 = 0; i8 < 8; ++i8) { const int i = 8 * qd + i8; const unsigned long long mt = (qd < nq) ? __ballot(v[i] >= K) : 0ull; if (lane == 0) bits[i] = mt; } }
            } else {
                int cgt; DSA_COUNT(K, >, cgt);
                const int need = 256 - cgt; int eqb = 0;
#pragma unroll
                for (int qd = 0; qd < 4; ++qd) {
#pragma unroll
                    for (int i8 = 0; i8 < 8; ++i8) { const int i = 8 * qd + i8; unsigned long long mt = 0ull;
                        if (qd < nq) { const bool gt = v[i] > K, eq = v[i] == K; const unsigned long long me = __ballot(eq); const int erank = eqb + mbcnt64(me);
                            mt = __ballot(gt || (eq && erank < need)); eqb += __builtin_popcountll(me); }
                        if (lane == 0) bits[i] = mt; } }
            }
#undef DSA_COUNT
        }
    }
    __syncthreads();
    {
        const float C2S = 0.125f * 1.4426950408889634f;
        int lane3 = lane; asm volatile("" : "+v"(lane3));
        const int r32 = lane3 & 31, hi = lane3 >> 5, cg = wid & 3, kp = wid >> 2;
        const int NT = (t0 + 16 + 63) >> 6, NS = (NT + 1) >> 1;
        const int qloc = 4 * cg + (r32 >> 3);
        LAS float* wsf = (LAS float*)(lds + 65536) + wid * 128;
        LAS float* OW = (LAS float*)(lds + 69632); LAS float* ML2 = (LAS float*)(lds + 69632 + 32768);
        bf16x8 qr[4];
#pragma unroll
        for (int d0 = 0; d0 < 4; ++d0) qr[d0] = *(const bf16x8*)(QC + (tb + t0 + qloc) * 512 + (r32 & 7) * 64 + d0 * 16 + hi * 8);
        const unsigned vo_kc = (unsigned)(lane3 * 64 + 8 * wid) * 2u, vo_vc = (unsigned)((16 * (wid & 3) + (lane3 >> 2)) * 64 + 32 * (wid >> 2) + 8 * (lane3 & 3)) * 2u, ldsb = (unsigned)(unsigned long long)lds;
        const char* kc_b = pg8::uni_ptr((const char*)(KC + tb * 64)); const char* vc_b = pg8::uni_ptr((const char*)(VC + tb * 64));
#define DSD_STAGE(j, buf) do { _Pragma("unroll") for (int par_ = 0; par_ < 2; ++par_) { const int kt_ = 2 * (j) + par_; if (kt_ < NT) { \
            const unsigned d_ = ldsb + (buf) * 32768 + par_ * 16384; \
            pg8::glds16_s(vo_kc, kc_b + (size_t)kt_ * (64 * 64 * 2), d_ + wid * 1024); pg8::glds16_s(vo_vc, vc_b + (size_t)kt_ * (64 * 64 * 2), d_ + 8192 + wid * 1024); } } } while (0)
        DSD_STAGE(0, 0);
        float m = -1e30f, l = 0.f; f32x16 o[2];
#pragma unroll
        for (int r = 0; r < 16; ++r) { o[0][r] = F.zf; o[1][r] = F.zf; }
        const int vboff = ((lane3 >> 4) & 1) * 32 + (lane3 & 3) * 8 + (4 * hi + ((lane3 & 15) >> 2)) * 64;
        for (int j = 0; j < NS; ++j) {
            const int buf = j & 1, kt = 2 * j + kp;
            VM_WAIT(); __syncthreads();
            if (j + 1 < NS) DSD_STAGE(j + 1, buf ^ 1);
            if (kt < NT) {
                const LAS unsigned char* tile = lds + buf * 32768 + kp * 16384;
                f32x16 p0, p1;
#pragma unroll
                for (int r = 0; r < 16; ++r) { p0[r] = F.zf; p1[r] = F.zf; }
                const LAS unsigned char* kb = tile + hi * 1024 + r32 * 16;
#pragma unroll
                for (int d0 = 0; d0 < 4; ++d0) { const bf16x8 b0 = *(const LAS bf16x8*)(kb + d0 * 2048), b1 = *(const LAS bf16x8*)(kb + d0 * 2048 + 512);
                    p0 = MFMA32(b0, qr[d0], p0); p1 = MFMA32(b1, qr[d0], p1); }
                float rm = fmaxf(p0[0], p1[0]);
#pragma unroll
                for (int r = 1; r < 16; ++r) rm = fmaxf(rm, fmaxf(p0[r], p1[r]));
                rm = fmaxf(rm, __shfl_xor(rm, 32));
                const float mn = fmaxf(m, rm);
                if (__any(mn > m)) {
                    const float alpha = __builtin_amdgcn_exp2f((m - mn) * C2S); l *= alpha; m = mn;
                    if (hi == 0) wsf[r32] = alpha;
                    LDS_WAIT();
#pragma unroll
                    for (int q = 0; q < 4; ++q) { const f32x4 a = *(const LAS f32x4*)(wsf + 8 * q + 4 * hi);
#pragma unroll
                        for (int jj = 0; jj < 4; ++jj) { o[0][4 * q + jj] *= a[jj]; o[1][4 * q + jj] *= a[jj]; } }
                }
                const unsigned long long bw = BITS[qloc * 32 + kt];
                const unsigned wl = (unsigned)bw >> (4 * hi), wh = (unsigned)(bw >> 32) >> (4 * hi);
                const float mc = m * C2S; float ls = 0.f;
#pragma unroll
                for (int r = 0; r < 16; ++r) { const int c = (r & 3) + 8 * (r >> 2);
                    const int m0 = ((int)(wl << (31 - c))) >> 31, m1 = ((int)(wh << (31 - c))) >> 31;
                    p0[r] = __uint_as_float(__float_as_uint(__builtin_amdgcn_exp2f(__builtin_fmaf(p0[r], C2S, -mc))) & (unsigned)m0);
                    p1[r] = __uint_as_float(__float_as_uint(__builtin_amdgcn_exp2f(__builtin_fmaf(p1[r], C2S, -mc))) & (unsigned)m1);
                    ls += p0[r] + p1[r]; }
                l += ls;
                bf16x8 pa[4];
                pa[0] = pack8(p0[0], p0[1], p0[2], p0[3], p0[4], p0[5], p0[6], p0[7]); pa[1] = pack8(p0[8], p0[9], p0[10], p0[11], p0[12], p0[13], p0[14], p0[15]);
                pa[2] = pack8(p1[0], p1[1], p1[2], p1[3], p1[4], p1[5], p1[6], p1[7]); pa[3] = pack8(p1[8], p1[9], p1[10], p1[11], p1[12], p1[13], p1[14], p1[15]);
                const LAS unsigned char* vb = tile + 8192 + vboff;
#pragma unroll
                for (int d0 = 0; d0 < 2; ++d0)
#pragma unroll
                    for (int ks = 0; ks < 4; ++ks) { const s16x4 lo = tr_read(vb + d0 * 4096 + ks * 1024), hh = tr_read(vb + d0 * 4096 + ks * 1024 + 512);
                        o[d0] = MFMA32(pa[ks], cat4(lo, hh), o[d0]); }
            }
        }
#undef DSD_STAGE
        l += __shfl_xor(l, 32);
        __syncthreads();
        if (kp == 1) {
            LAS float* ow = OW + cg * 2048;
#pragma unroll
            for (int r = 0; r < 16; ++r) { const int row = crow(r, hi); ow[row * 64 + r32] = o[0][r]; ow[row * 64 + 32 + r32] = o[1][r]; }
            if (hi == 0) { ML2[cg * 64 + r32] = m; ML2[cg * 64 + 32 + r32] = l; }
        }
        __syncthreads();
        if (kp == 0) {
            const float m2 = ML2[cg * 64 + r32], l2 = ML2[cg * 64 + 32 + r32];
            const float M = fmaxf(m, m2), a1 = __builtin_amdgcn_exp2f((m - M) * C2S), a2 = __builtin_amdgcn_exp2f((m2 - M) * C2S);
            const float linv = 1.0f / (a1 * l + a2 * l2);
            if (hi == 0) { wsf[r32] = a1 * linv; wsf[32 + r32] = a2 * linv; }
            LDS_WAIT();
            const LAS float* ow = OW + cg * 2048;
            bf16_t* op = OC + (tb + t0 + 4 * cg) * 512 + r32;
#pragma unroll
            for (int q = 0; q < 4; ++q) { const f32x4 s1 = *(const LAS f32x4*)(wsf + 8 * q + 4 * hi), s2 = *(const LAS f32x4*)(wsf + 32 + 8 * q + 4 * hi);
#pragma unroll
                for (int jj = 0; jj < 4; ++jj) { const int r = 4 * q + jj, row = crow(r, hi);
                    const float v0 = o[0][r] * s1[jj] + ow[row * 64 + r32] * s2[jj], v1 = o[1][r] * s1[jj] + ow[row * 64 + 32 + r32] * s2[jj];
                    bf16_t* dst = op + (size_t)(row >> 3) * 512 + (row & 7) * 64;
                    dst[0] = (bf16_t)(pk2(v0, 0.f) & 0xffffu); dst[32] = (bf16_t)(pk2(v1, 0.f) & 0xffffu); } }
        }
    }
    __syncthreads();
}
DI void attention_mla_units(const Frame& F, int rep_a) {
    for (int rep = 0; rep < rep_a; ++rep)
    for (int U = F.bid; U < 1024; U += F.G) { const int i = U >> 8, cp = U & 255, half = cp >> 7, rem = cp & 127; mla_unit(F, rem & 15, rem >> 4, 2 * i + (half ^ (i & 1))); }
}
DI void attention_dsa_units(const Frame& F, int rep_c) {
    for (int rep = 0; rep < rep_c; ++rep)
    for (int U = F.bid; U < 2048; U += F.G) { const int i = U >> 8, cp = U & 255; dsa_unit(F, cp & 15, 16 * i + (cp >> 4)); }
}
DI void phase_attention(const Frame& F, int rep_a, int rep_c) {
    if (F.bid & 1) { attention_dsa_units(F, rep_c); __syncthreads(); attention_mla_units(F, rep_a); }
    else { attention_mla_units(F, rep_a); __syncthreads(); attention_dsa_units(F, rep_c); }
}

constexpr int N2_WROW = 1032;
constexpr int N2_WH = 0, N2_WL = 32 * N2_WROW * 2, N2_CB = 2 * N2_WL, N2_PART = N2_CB + 128, N2_LGT = N2_PART + 2048, N2_RST = N2_LGT + 8 * 2304, N2_CNT = N2_RST + 512, N2_BASE = N2_CNT + 128, N2_TOK = N2_BASE + 128;
static_assert(N2_TOK + 2048 <= MISC_OFF, "router LDS map");
DI void phase_router(const Frame& F, int l, int cset) {
    const int tid = F.tid, lane = F.lane, wave = F.wave, fr = lane & 15, g = lane >> 4;
    LAS unsigned char* lds = F.lds;
    LAS bf16_t* WH = (LAS bf16_t*)(lds + N2_WH); LAS bf16_t* WL = (LAS bf16_t*)(lds + N2_WL); LAS float* CB = (LAS float*)(lds + N2_CB); LAS float* PART = (LAS float*)(lds + N2_PART);
    LAS float* LGT = (LAS float*)(lds + N2_LGT) + wave * 576; LAS float* RST = (LAS float*)(lds + N2_RST) + wave * 16;
    LAS int* CNT = (LAS int*)(lds + N2_CNT); LAS int* BASE = (LAS int*)(lds + N2_BASE); LAS int* TOKR = (LAS int*)(lds + N2_TOK);
    const float* X1 = WSP(float, WS_X1); const float* MOD = WSP(float, WS_MOD); unsigned char* H8 = WSP(unsigned char, WS_H8);
    const float* in_n2 = KIN_norm2_g + l * 1024; const float* in_rb = KIN_router_b + l * 32; const float* in_rw = KIN_router_w + (size_t)l * 32768;
    int* TOPE = (int*)(F.ws + WS_ROUTE + RT_TOPE); float* TOPG = (float*)(F.ws + WS_ROUTE + RT_TOPG); int* RANK = (int*)(F.ws + WS_ROUTE + RT_RANK);
    for (int chunk = F.bid; chunk < T_TOK / 128; chunk += F.G) {
        const int b = chunk >> 4; const float* md = MOD + ((size_t)l * 16 + b) * 6144;
        __syncthreads();
        { float cp = 0.f;
          for (int idx = tid; idx < 32 * 1024; idx += 512) { const int k = idx >> 5, e = idx & 31; const float w = in_rw[idx]; const float wp = w * (in_n2[k] * (1.0f + md[4 * 1024 + k]));
              const unsigned hw = pk2(wp, 0.f) & 0xffffu; const float lo = wp - __uint_as_float(hw << 16);
              WH[e * N2_WROW + k] = (bf16_t)hw; WL[e * N2_WROW + k] = (bf16_t)(pk2(lo, 0.f) & 0xffffu); cp += md[3 * 1024 + k] * w; }
          PART[(tid >> 5) * 32 + (tid & 31)] = cp; }
        if (tid < 32) CNT[tid] = 0;
        __syncthreads();
        if (tid < 32) { float c = in_rb[tid];
#pragma unroll
            for (int p = 0; p < 16; ++p) c += PART[p * 32 + tid];
            CB[tid] = c; }
        __syncthreads();
        const int t0w = chunk * 128 + wave * 16;
        {
            const float* xp = X1 + (size_t)(t0w + fr) * 1024 + 8 * g;
            f32x4 acc0 = {F.zf, F.zf, F.zf, F.zf}, acc1 = acc0; float ssq = 0.f;
            const LAS bf16_t* wh0 = WH + fr * N2_WROW + 8 * g; const LAS bf16_t* wl0 = WL + fr * N2_WROW + 8 * g;
#pragma unroll 4
            for (int ks = 0; ks < 32; ++ks) {
                const f32x4 xa = *(const f32x4*)(xp + 32 * ks), xb = *(const f32x4*)(xp + 32 * ks + 4);
                ssq += (xa[0] * xa[0] + xa[1] * xa[1]) + (xa[2] * xa[2] + xa[3] * xa[3]) + (xb[0] * xb[0] + xb[1] * xb[1]) + (xb[2] * xb[2] + xb[3] * xb[3]);
                u32x4 hw; hw.x = pk2(xa[0], xa[1]); hw.y = pk2(xa[2], xa[3]); hw.z = pk2(xb[0], xb[1]); hw.w = pk2(xb[2], xb[3]);
                u32x4 lw; lw.x = pk2(xa[0] - bf_lo(hw.x), xa[1] - bf_hi(hw.x)); lw.y = pk2(xa[2] - bf_lo(hw.y), xa[3] - bf_hi(hw.y)); lw.z = pk2(xb[0] - bf_lo(hw.z), xb[1] - bf_hi(hw.z)); lw.w = pk2(xb[2] - bf_lo(hw.w), xb[3] - bf_hi(hw.w));
                const bf16x8 ah = __builtin_bit_cast(bf16x8, hw), al = __builtin_bit_cast(bf16x8, lw);
                const bf16x8 bh0 = *(const LAS bf16x8*)(wh0 + 32 * ks), bh1 = *(const LAS bf16x8*)(wh0 + 16 * N2_WROW + 32 * ks), bl0 = *(const LAS bf16x8*)(wl0 + 32 * ks), bl1 = *(const LAS bf16x8*)(wl0 + 16 * N2_WROW + 32 * ks);
                acc0 = __builtin_amdgcn_mfma_f32_16x16x32_bf16(ah, bh0, acc0, 0, 0, 0); acc0 = __builtin_amdgcn_mfma_f32_16x16x32_bf16(ah, bl0, acc0, 0, 0, 0); acc0 = __builtin_amdgcn_mfma_f32_16x16x32_bf16(al, bh0, acc0, 0, 0, 0);
                acc1 = __builtin_amdgcn_mfma_f32_16x16x32_bf16(ah, bh1, acc1, 0, 0, 0); acc1 = __builtin_amdgcn_mfma_f32_16x16x32_bf16(ah, bl1, acc1, 0, 0, 0); acc1 = __builtin_amdgcn_mfma_f32_16x16x32_bf16(al, bh1, acc1, 0, 0, 0);
            }
            ssq += __shfl_xor(ssq, 16); ssq += __shfl_xor(ssq, 32);
            if (g == 0) RST[fr] = 1.0f / sqrtf(ssq * (1.0f / 1024.0f) + NORM_EPS);
#pragma unroll
            for (int r = 0; r < 4; ++r) { LGT[(4 * g + r) * 36 + fr] = acc0[r]; LGT[(4 * g + r) * 36 + 16 + fr] = acc1[r]; }
        }
        LDS_WAIT();
        if (lane < 16) {
            const int t = t0w + lane; const float rt = RST[lane];
            float a[32];
#pragma unroll
            for (int q = 0; q < 8; ++q) { const f32x4 w = *(const LAS f32x4*)(LGT + lane * 36 + 4 * q), c = *(const LAS f32x4*)(CB + 4 * q); a[4 * q] = w[0] * rt + c[0]; a[4 * q + 1] = w[1] * rt + c[1]; a[4 * q + 2] = w[2] * rt + c[2]; a[4 * q + 3] = w[3] * rt + c[3]; }
            float tv[4]; int te[4];
#pragma unroll
            for (int k = 0; k < 4; ++k) { float best = a[0]; int bi = 0;
#pragma unroll
                for (int e = 1; e < 32; ++e) if (a[e] > best) { best = a[e]; bi = e; }
                tv[k] = best; te[k] = bi;
#pragma unroll
                for (int e = 0; e < 32; ++e) if (e == bi) a[e] = -INFINITY; }
            const float e1 = __expf(tv[1] - tv[0]), e2 = __expf(tv[2] - tv[0]), e3 = __expf(tv[3] - tv[0]); const float inv = 1.0f / (1.0f + e1 + e2 + e3);
            const float gk[4] = {inv, e1 * inv, e2 * inv, e3 * inv};
#pragma unroll
            for (int k = 0; k < 4; ++k) { const int loc = __hip_atomic_fetch_add(&CNT[te[k]], 1, __ATOMIC_RELAXED, __HIP_MEMORY_SCOPE_WORKGROUP); TOKR[(wave * 16 + lane) * 4 + k] = te[k] | (loc << 8); }
            *(f32x4*)(TOPG + (size_t)t * 4) = (f32x4){gk[0], gk[1], gk[2], gk[3]};
        }
        for (int j = 0; j < 16; ++j) {
            const int t = t0w + j; const float r = RST[j];
#pragma unroll
            for (int i = 0; i < 4; ++i) { const int co = 4 * lane + 256 * i;
                const f32x4 xv = *(const f32x4*)(X1 + (size_t)t * 1024 + co), gg = *(const f32x4*)(in_n2 + co), sc = *(const f32x4*)(md + 4 * 1024 + co), sh = *(const f32x4*)(md + 3 * 1024 + co);
                const f32x4 hv = xv * r * gg * (sc + 1.0f) + sh;
                *(unsigned*)(H8 + (size_t)t * 1024 + co) = pk4_fp8(hv[0], hv[1], hv[2], hv[3]); }
        }
        __syncthreads();
        if (tid < 32) BASE[tid] = (int)__hip_atomic_fetch_add(F.ctl + CW_CNT + (cset * 32 + tid) * 64, (unsigned)CNT[tid], __ATOMIC_RELAXED, __HIP_MEMORY_SCOPE_AGENT);
        __syncthreads();
        { const int pr = TOKR[tid], e = pr & 255, loc = pr >> 8; const size_t o = (size_t)(chunk * 128) * 4 + tid; TOPE[o] = e; RANK[o] = BASE[e] + loc; }
    }
}
constexpr int MOE_OFF = LDS_X, MOE_CNTL = LDS_X + 256, MOE_TEXP = LDS_X + 512;
DI int moe_offsets(const Frame& F, int l) {
    LAS int* OFF = (LAS int*)(F.lds + MOE_OFF); LAS int* CNTL = (LAS int*)(F.lds + MOE_CNTL); LAS int* TEXP = (LAS int*)(F.lds + MOE_TEXP);
    __syncthreads();
    if (F.tid < 32) CNTL[F.tid] = (int)__hip_atomic_load(F.ctl + CW_CNT + (l * 32 + F.tid) * 64, __ATOMIC_RELAXED, __HIP_MEMORY_SCOPE_AGENT);
    __syncthreads();
    if (F.tid == 0) { int off = 0; for (int e = 0; e < 32; ++e) { OFF[e] = off; off += (CNTL[e] + 255) & ~255; } OFF[32] = off; }
    __syncthreads();
    const int ntiles = OFF[32] >> 8;
    for (int tl = F.tid; tl < ntiles; tl += 512) { int e = 0; for (int q = 0; q < 32; ++q) if (OFF[q] <= tl * 256 && tl * 256 < OFF[q + 1]) e = q; TEXP[tl] = e; }
    __syncthreads();
    return ntiles;
}
DI void phase_scatter(const Frame& F, int l) {
    const int lane = F.lane, wave = F.wave;
    (void)moe_offsets(F, l);
    const LAS int* OFF = (const LAS int*)(F.lds + MOE_OFF); const LAS int* CNTL = (const LAS int*)(F.lds + MOE_CNTL);
    const int* TOPE = (const int*)(F.ws + WS_ROUTE + RT_TOPE); const float* TOPG = (const float*)(F.ws + WS_ROUTE + RT_TOPG); const int* RANK = (const int*)(F.ws + WS_ROUTE + RT_RANK);
    int* SLOTOF = (int*)(F.ws + WS_ROUTE + RT_SLOTOF); int* TOKOF = (int*)(F.ws + WS_ROUTE + RT_TOKOF); float* GATEOF = (float*)(F.ws + WS_ROUTE + RT_GATEOF);
    const unsigned char* H8 = WSP(unsigned char, WS_H8); unsigned char* XB = WSP(unsigned char, WS_XB);
    for (int chunk = F.bid; chunk < T_TOK / 128; chunk += F.G) {
        const int pair = wave * 64 + lane, tl = chunk * 128 + (pair >> 2); const size_t o = (size_t)tl * 4 + (pair & 3);
        const int e = TOPE[o], slot = OFF[e] + RANK[o];
        SLOTOF[o] = slot; TOKOF[slot] = tl; GATEOF[slot] = TOPG[o];
#pragma unroll 4
        for (int p = 0; p < 64; ++p) {
            const int sp = __builtin_amdgcn_readlane(slot, p), tp = chunk * 128 + ((wave * 64 + p) >> 2);
            *(u32x4*)(XB + (size_t)sp * 1024 + 16 * lane) = *(const u32x4*)(H8 + (size_t)tp * 1024 + 16 * lane);
        }
    }
    for (int e = F.bid; e < 32; e += F.G) {
        const int s0 = OFF[e] + CNTL[e], s1 = OFF[e + 1];
        for (int s = s0 + wave; s < s1; s += 8) { if (lane == 0) { TOKOF[s] = 0; GATEOF[s] = 0.f; }
            *(u32x4*)(XB + (size_t)s * 1024 + 16 * lane) = (u32x4){0u, 0u, 0u, 0u}; }
    }
}

#ifndef MK_SPLIT
#define MK_SPLIT 0
#endif
constexpr int NPHASE = 2 + 11 * DEPTH;
struct Args { const void* in[23]; float* out; unsigned char* ws; int ph_lo, ph_hi; };
static_assert(sizeof(Args) == 25 * 8 + 8, "Args has no padding");


#ifndef PH_ENABLE
#define PH_ENABLE 0xFFFF
#endif
#define IN(k) (lo <= (k) && (k) < hi)
#define EN(j) (((PH_ENABLE) >> (j)) & 1)
#ifndef DUP_MASK
#define DUP_MASK 0
#endif
#define NREP(j) ((((DUP_MASK) >> (j)) & 1) ? 2 : 1)
#define SEAM(k) do { if (!MK_SPLIT && (k) + 1 < hi) { XcdBarrier bar_; bar_.bar = F.ctl + CW_BAR; bar_.x = xb_xcc_id(); bar_.st = (volatile LAS unsigned*)((LAS unsigned char*)lds_raw + MISC_OFF) + 8; xcd_barrier(bar_, F.tid); } } while (0)
DI void layer_phases(const int l, const int lo, const int hi, const int wave0) {
        const int pb = 2 + 11 * l;
        if (EN(2) && IN(pb + 0)) { const Frame F = make_frame(wave0);
            { int kb8 = 1024; asm volatile("" : "+s"(kb8));
              SchedPlain S; S.o.init(T_TOK / 256, G1_F8_COLS / 256, F.G, F.bid); S.A = (const char*)WSP(unsigned char, WS_HG8); S.B = (const char*)(WSP(unsigned char, WS_WIN) + (size_t)l * NP * 2048); S.tstep = (size_t)256 * 1024;
              EpiStoreBf16N E{WSP(bf16_t, WS_P), NP, 0};
              _Pragma("unroll") for (int rep = 0; rep < NREP(2); ++rep) pg8::gemm_phase_f8<EpiStoreBf16N, SchedPlain>(F.lds, F.tid, kb8, S, E); }
            { int tid2 = F.tid; asm volatile("" : "+v"(tid2));
              SchedPlain S; S.o.init(T_TOK / 256, (NP - G1_F8_COLS) / 256, F.G, F.bid); S.A = (const char*)WSP(bf16_t, WS_H); S.B = (const char*)(WSP(bf16_t, WS_WIN) + (size_t)l * NP * 1024 + (size_t)G1_F8_COLS * 1024); S.tstep = (size_t)256 * 1024 * 2;
              EpiStoreBf16 E{WSP(bf16_t, WS_P), NP, G1_F8_COLS};
              _Pragma("unroll") for (int rep = 0; rep < NREP(2); ++rep) pg8::gemm_phase<EpiStoreBf16, SchedPlain>(F.lds, tid2, 1024, S, E); }
            SEAM(pb + 0);
        }
        if (EN(3) && IN(pb + 1)) { const Frame F = make_frame(wave0); _Pragma("unroll") for (int rep = 0; rep < NREP(3); ++rep) phase_post(F, l); SEAM(pb + 1); }
        if (EN(4) && IN(pb + 2)) { const Frame F = make_frame(wave0);
            int k256 = 256; asm volatile("" : "+s"(k256));
            { SchedPlain S; S.o.init(T_TOK / 256, 3, F.G, F.bid); S.A = (const char*)WSP(bf16_t, WS_CQ); S.B = (const char*)(WSP(bf16_t, WS_WUQ) + (size_t)l * 768 * 256); S.tstep = (size_t)256 * 256 * 2;
              EpiStoreBf16 E{WSP(bf16_t, WS_QA), 768};
              pg8::gemm_phase<EpiStoreBf16, SchedPlain>(F.lds, F.tid, k256, S, E); }
            { int tid2 = F.tid; asm volatile("" : "+v"(tid2));
              SchedPlain S; S.o.init(T_TOK / 256, 4, F.G, F.bid); S.A = (const char*)WSP(bf16_t, WS_CKV); S.B = (const char*)(WSP(bf16_t, WS_WUKV) + (size_t)l * 1024 * 256); S.tstep = (size_t)256 * 256 * 2;
              EpiStoreBf16 E{WSP(bf16_t, WS_KV), 1024};
              pg8::gemm_phase<EpiStoreBf16, SchedPlain>(F.lds, tid2, k256, S, E); }
            SEAM(pb + 2);
        }
        if (EN(5) && IN(pb + 3)) { const Frame F = make_frame(wave0); phase_attention(F, NREP(5), NREP(13)); SEAM(pb + 3); }
        if (EN(6) && IN(pb + 4)) { const Frame F = make_frame(wave0);
            SchedBranch S; S.o.init(T_TOK / 256, 4, F.G, F.bid); S.A = (const char*)WSP(bf16_t, WS_O3); S.B = (const char*)(WSP(bf16_t, WS_WB) + (size_t)l * 3 * 1024 * 512); S.tstep = (size_t)256 * 512 * 2; S.aslab = (size_t)T_TOK * 512 * 2;
            EpiBranchGate E{WSP(bf16_t, WS_GY), WSP(bf16_t, WS_P), KIN_b_gate + l * 3072};
            _Pragma("unroll") for (int rep = 0; rep < NREP(6); ++rep) pg8::gemm_phase<EpiBranchGate, SchedBranch>(F.lds, F.tid, 512, S, E);
            SEAM(pb + 4);
        }
        if (EN(7) && IN(pb + 5)) { const Frame F = make_frame(wave0);
            SchedPlain S; S.o.init(T_TOK / 256, 4, F.G, F.bid); S.A = (const char*)WSP(bf16_t, WS_GY); S.B = (const char*)(WSP(bf16_t, WS_WOUT) + (size_t)l * 1024 * 1024); S.tstep = (size_t)256 * 1024 * 2;
            EpiResidual E{l == 0 ? KIN_x : WSP(float, WS_X1), WSP(float, WS_X1), WSP(float, WS_MOD) + (size_t)l * 16 * 6144 + 2 * 1024};
            _Pragma("unroll") for (int rep = 0; rep < NREP(7); ++rep) if (rep == 0 || l == 0) pg8::gemm_phase<EpiResidual, SchedPlain>(F.lds, F.tid, 1024, S, E);
            SEAM(pb + 5);
        }
        if (EN(8) && IN(pb + 6)) { const Frame F = make_frame(wave0); phase_router(F, l, l); if (NREP(8) == 2) phase_router(F, l, l + 2); SEAM(pb + 6); }
        if (EN(9) && IN(pb + 7)) { const Frame F = make_frame(wave0); _Pragma("unroll") for (int rep = 0; rep < NREP(9); ++rep) phase_scatter(F, l); SEAM(pb + 7); }
        if (EN(10) && IN(pb + 8)) { const Frame F = make_frame(wave0);
            const int ntiles = moe_offsets(F, l); int kb8 = 1024; asm volatile("" : "+s"(kb8));
            SchedMoe S; S.o.init(ntiles, 8, F.G, F.bid); S.A = (const char*)WSP(unsigned char, WS_XB); S.B = (const char*)(WSP(unsigned char, WS_W1) + (size_t)l * 32 * 2048 * 1024); S.eslab = 2048u * 1024u;
            S.texp = (const LAS int*)(F.lds + MOE_TEXP);
#if M2_F8
            EpiSwiglu8 E{WSP(unsigned char, WS_ACT), KIN_b1 + (size_t)l * 32 * 2048, (const LAS int*)(F.lds + MOE_TEXP)};
#else
            EpiSwiglu E{WSP(bf16_t, WS_ACT), KIN_b1 + (size_t)l * 32 * 2048, (const LAS int*)(F.lds + MOE_TEXP)};
#endif
            _Pragma("unroll") for (int rep = 0; rep < NREP(10); ++rep)
#if M2_F8
            pg8::gemm_phase_f8<EpiSwiglu8, SchedMoe>(F.lds, F.tid, kb8, S, E);
#else
            pg8::gemm_phase_f8<EpiSwiglu, SchedMoe>(F.lds, F.tid, kb8, S, E);
#endif

            SEAM(pb + 8);
        }
        if (EN(11) && IN(pb + 9)) { const Frame F = make_frame(wave0);
            const int ntiles = moe_offsets(F, l); int kb8 = 1024; asm volatile("" : "+s"(kb8));
#if M2_F8
            SchedMoe S; S.o.init(ntiles, 4, F.G, F.bid); S.A = (const char*)WSP(unsigned char, WS_ACT); S.B = (const char*)(WSP(unsigned char, WS_W2) + (size_t)l * 32 * 1024 * 1024); S.eslab = 1024u * 1024u;
            S.texp = (const LAS int*)(F.lds + MOE_TEXP);
            EpiMoeOut E{WSP(bf16_t, WS_Y), KIN_b2 + (size_t)l * 32 * 1024, (const float*)(F.ws + WS_ROUTE + RT_GATEOF), (const LAS int*)(F.lds + MOE_TEXP)};
            _Pragma("unroll") for (int rep = 0; rep < NREP(11); ++rep) pg8::gemm_phase_f8<EpiMoeOut, SchedMoe>(F.lds, F.tid, kb8, S, E);
#else
            SchedMoeB S; S.o.init(ntiles, 4, F.G, F.bid); S.A = (const char*)WSP(bf16_t, WS_ACT); S.B = (const char*)(WSP(bf16_t, WS_W2) + (size_t)l * 32 * 1024 * 1024); S.eslab = 1024u * 1024u * 2u;
            S.texp = (const LAS int*)(F.lds + MOE_TEXP);
            EpiMoeOut E{WSP(bf16_t, WS_Y), KIN_b2 + (size_t)l * 32 * 1024, (const float*)(F.ws + WS_ROUTE + RT_GATEOF), (const LAS int*)(F.lds + MOE_TEXP)};
            _Pragma("unroll") for (int rep = 0; rep < NREP(11); ++rep) pg8::gemm_phase<EpiMoeOut, SchedMoeB>(F.lds, F.tid, kb8, S, E);
#endif
            SEAM(pb + 9);
        }
        if (EN(12) && IN(pb + 10)) { const Frame F = make_frame(wave0);
            const bool last = (l == DEPTH - 1);
            _Pragma("unroll") for (int rep = 0; rep < NREP(12); ++rep) if (rep == 0 || last) phase_norm(F, WSP(float, WS_X1), WSP(float, WS_X1), true, !last, last, l + 1 < DEPTH ? l + 1 : 0, l);
            SEAM(pb + 10);
        }
}
__global__ void __launch_bounds__(512, 2) fwd_kernel(Args args) {
    const int wave0 = __builtin_amdgcn_readfirstlane(threadIdx.x >> 6);
    {
        volatile LAS unsigned* MISC = (volatile LAS unsigned*)((LAS unsigned char*)lds_raw + MISC_OFF);
        if (threadIdx.x < 32) MISC[threadIdx.x] = 0u;
        __syncthreads();
        if (!MK_SPLIT) { const Frame F = make_frame(wave0); (void)xcd_barrier_post(F.ctl + CW_BAR, MISC + 8, F.tid); }
    }
    const int lo = args.ph_lo, hi = args.ph_hi;
    if (EN(0) && IN(0)) { const Frame F = make_frame(wave0); _Pragma("unroll") for (int rep = 0; rep < NREP(0); ++rep) phase_prologue(F); SEAM(0); }
    if (EN(1) && IN(1)) { const Frame F = make_frame(wave0); _Pragma("unroll") for (int rep = 0; rep < NREP(1); ++rep) phase_norm(F, KIN_x, nullptr, false, false, false, 0, 0); SEAM(1); }
    layer_phases(0, lo, hi, wave0);
    layer_phases(1, lo, hi, wave0);
    static_assert(DEPTH == 2, "two layers");
#undef IN
#undef SEAM
}

extern "C" void kernel_launch(void* const* d_in, const int* in_sizes, int n_in, void* d_out, int out_size, void* d_ws, size_t ws_size, hipStream_t stream) {
    static int grid = 0;
    if (grid == 0) {
        if (n_in != 23 || out_size != T_TOK * D_MODEL || ws_size < WS_END) { fprintf(stderr, "kernel_launch: unexpected problem (n_in %d, out %d, ws %zu)\n", n_in, out_size, ws_size); grid = -1; return; }
        int dev = 0, cus = 0;
        if (hipGetDevice(&dev) != hipSuccess || hipDeviceGetAttribute(&cus, hipDeviceAttributeMultiprocessorCount, dev) != hipSuccess) { grid = -1; return; }
        if (hipFuncSetAttribute((const void*)fwd_kernel, hipFuncAttributeMaxDynamicSharedMemorySize, LDS_BYTES) != hipSuccess) { fprintf(stderr, "kernel_launch: hipFuncSetAttribute failed\n"); grid = -1; return; }
        int per_cu = 0;
        if (hipOccupancyMaxActiveBlocksPerMultiprocessor(&per_cu, (const void*)fwd_kernel, 512, LDS_BYTES) != hipSuccess || per_cu < 1) fprintf(stderr, "kernel_launch: occupancy query says %d\n", per_cu);
        (void)hipGetLastError();
        grid = cus > 256 ? 256 : cus;
    }
    if (grid < 0) return;
    (void)in_sizes;
    if (hipMemsetAsync((char*)d_ws + WS_CTL, 0, CTL_ZERO_BYTES, stream) != hipSuccess) return;
    Args a{};
    for (int i = 0; i < 23; ++i) a.in[i] = d_in[i];
    a.out = (float*)d_out; a.ws = (unsigned char*)d_ws;
#if MK_SPLIT
    for (int p = 0; p < NPHASE; ++p) { a.ph_lo = p; a.ph_hi = p + 1; hipLaunchKernelGGL(fwd_kernel, dim3(grid), dim3(512), LDS_BYTES, stream, a); }
#else
    a.ph_lo = 0; a.ph_hi = NPHASE;
    hipLaunchKernelGGL(fwd_kernel, dim3(grid), dim3(512), LDS_BYTES, stream, a);
#endif
}
```

```cpp
#include <hip/hip_runtime.h>
#include <cstdio>
#include <cstdint>

#ifndef M2_F8
#define M2_F8 1
#endif
#define LAS __attribute__((address_space(3)))
#define GAS __attribute__((address_space(1)))
typedef unsigned short bf16_t;
typedef short bf16x8 __attribute__((ext_vector_type(8)));
typedef short s16x4 __attribute__((ext_vector_type(4)));
typedef float f32x2 __attribute__((ext_vector_type(2)));
typedef float f32x4 __attribute__((ext_vector_type(4)));
typedef float f32x16 __attribute__((ext_vector_type(16)));
typedef unsigned u32x2 __attribute__((ext_vector_type(2)));
typedef unsigned u32x4 __attribute__((ext_vector_type(4)));
#define DI __device__ __forceinline__

constexpr int D_MODEL = 1024, BATCH = 16, SEQ = 2048, T_TOK = BATCH * SEQ, DEPTH = 2;
constexpr float NORM_EPS = 1e-6f;
constexpr int IN_COLS = 6248, NP = 6400;
constexpr int N_EXP = 32, TOP_K = 4, D_EXP = 1024;
constexpr int NSLOT_MAX = T_TOK * TOP_K + N_EXP * 256;
constexpr int PC_GATE = 0, PC_CONV = 3072, PC_DQ = 4608, PC_IQ = 5120, PC_QLAT = 5632, PC_KVLAT = 5888, PC_DKV = 6048, PC_IK = 6176, PC_IW = 6240;
constexpr int OC_QLAT = 0, OC_KVLAT = 256, OC_CONV = 416, OC_DQ = 1952, OC_DKV = 2464, OC_IQ = 2592, OC_IK = 3104, OC_IW = 3168, OC_GATE = 3176;

DI unsigned pk2(float lo, float hi) { typedef __bf16 bf16x2_t __attribute__((ext_vector_type(2))); f32x2 v = {lo, hi}; bf16x2_t b = __builtin_convertvector(v, bf16x2_t); return __builtin_bit_cast(unsigned, b); }
DI float bf_lo(unsigned w) { return __uint_as_float(w << 16); }
DI float bf_hi(unsigned w) { return __uint_as_float(w & 0xffff0000u); }
DI float bf2f(bf16_t h) { return __uint_as_float((unsigned)h << 16); }
DI float wave_sum(float v) {
#pragma unroll
    for (int o = 1; o < 64; o <<= 1) v += __shfl_xor(v, o);
    return v;
}
DI float fast_sigmoid(float x) { return __builtin_amdgcn_rcpf(1.0f + __builtin_amdgcn_exp2f(-1.4426950408889634f * x)); }
DI unsigned pk4_fp8(float a, float b, float c, float d) { int w = __builtin_amdgcn_cvt_pk_fp8_f32(a, b, 0, false); w = __builtin_amdgcn_cvt_pk_fp8_f32(c, d, w, true); return (unsigned)w; }
#define LDS_WAIT() asm volatile("s_waitcnt lgkmcnt(0)" ::: "memory")
#define VM_WAIT() asm volatile("s_waitcnt vmcnt(0)" ::: "memory")

namespace pg8 {
DI void glds16_s(unsigned voff, const char* sbase, unsigned lds_dst) { unsigned keep; asm volatile("s_nop 4\n\ts_mov_b32 %0, m0\n\ts_mov_b32 m0, %3\n\ts_nop 0\n\tglobal_load_lds_dwordx4 %1, %2\n\ts_mov_b32 m0, %0" : "=&s"(keep) : "v"(voff), "s"(sbase), "s"(lds_dst) : "memory"); }
DI const char* uni_ptr(const char* p) { const unsigned long long v = (unsigned long long)p; const unsigned lo = __builtin_amdgcn_readfirstlane((unsigned)v), hi = __builtin_amdgcn_readfirstlane((unsigned)(v >> 32)); return (const char*)(GAS const char*)(((unsigned long long)hi << 32) | lo); }
constexpr int BM = 256, BK = 64, HALF = 128, HTB = HALF * BK * 2, STAGE_BYTES = 8 * HTB, NXCD = 8, WGM = 8;
__host__ __device__ __forceinline__ int lds_byte(int r, int c) { const int st = (r >> 4) * 2 + (c >> 5), rr = r & 15, cc = c & 31, ob = rr * 64 + cc * 2; return st * 1024 + (ob ^ (((ob >> 9) & 1) << 5)); }
__host__ __device__ __forceinline__ void stage_rc(int b, int& R, int& C) { const int st = b / 1024, sb = b % 1024, swz = sb ^ (((sb >> 9) & 1) << 5); R = (st >> 1) * 16 + swz / 64; C = (st & 1) * 32 + (swz % 64) / 2; }
__host__ __device__ __forceinline__ int perm32(int rho) { const int n = rho >> 4, i = rho & 15; return 8 * (i >> 2) + 4 * n + (i & 3); }
struct Unit { int pm, pn; };
struct StaticOrder {
    int nM, nN, nwg, G, c;
    DI void init(int nM_, int nN_, int G_, int c_) { nM = nM_; nN = nN_; nwg = nM * nN; G = G_; c = c_; }
    DI bool next(int i, Unit& u) const {
        const long L = (long)i * G + c; if (L >= nwg) return false;
        int wgid = (int)L; { const int q = nwg / NXCD, r = nwg % NXCD, xcd = wgid % NXCD, off = wgid / NXCD; wgid = (xcd < r ? xcd * (q + 1) : r * (q + 1) + (xcd - r) * q) + off; }
        const int nig = WGM * nN, gid = wgid / nig, fm = gid * WGM, gsz = (nM - fm) < WGM ? (nM - fm) : WGM;
        u.pm = fm + ((wgid % nig) % gsz); u.pn = (wgid % nig) / gsz; return true;
    }
};

template <class Epi, class Sched, bool ALIGN_EPI = true, bool SP2 = true>
DI void gemm_phase(LAS unsigned char* lds, const int tid, const int K, const Sched& S, const Epi& E) {
    const int wid = __builtin_amdgcn_readfirstlane(tid >> 6), lane = tid & 63, wr = wid >> 2, wc = wid & 3, fr = lane & 15, fq = lane >> 4;
    const int nt = K / BK;
    unsigned voffA[2], voffB[2];
#pragma unroll
    for (int i = 0; i < 2; ++i) { int R, C; stage_rc(tid * 16 + i * 8192, R, C); const int Rb = Epi::PERM ? ((R & ~31) + perm32(R & 31)) : R;
        voffA[i] = (unsigned)(R * K + C) * 2u; voffB[i] = (unsigned)(Rb * K + C) * 2u; }
    const size_t kstep = (size_t)(BK * 2);
    const size_t hstep = (size_t)HALF * K * 2;
    const unsigned ldsw = (unsigned)wid * 1024u; const unsigned ldsb = (unsigned)(unsigned long long)(lds);
    const int aoff = lds_byte(wr * 64 + fr, fq * 8), boff = lds_byte(wc * 32 + fr, fq * 8);
#define PG8_SA(b, h) (((b) * 2 + (h)) * HTB)
#define PG8_SB(b, h) ((4 + (b) * 2 + (h)) * HTB)
#define PG8_STAGE(bufoff, gbase, voff) do { _Pragma("unroll") for (int _i = 0; _i < 2; ++_i) \
        glds16_s((voff)[_i], (const char*)(gbase), ldsb + (unsigned)(bufoff) + ldsw + (unsigned)(_i * 8192)); } while (0)
#define PG8_LDA(dst, b, h) do { int a_ = aoff; asm volatile("" : "+v"(a_)); _Pragma("unroll") for (int m = 0; m < 4; ++m) _Pragma("unroll") for (int k = 0; k < 2; ++k) dst[m][k] = *(const LAS bf16x8*)(lds + PG8_SA(b, h) + a_ + m * 2048 + k * 1024); } while (0)
#define PG8_LDB(dst, b, h) do { int b_ = boff; asm volatile("" : "+v"(b_)); _Pragma("unroll") for (int n = 0; n < 2; ++n) _Pragma("unroll") for (int k = 0; k < 2; ++k) dst[n][k] = *(const LAS bf16x8*)(lds + PG8_SB(b, h) + b_ + n * 2048 + k * 1024); } while (0)
#define PG8_MMA(ai, bj, At, Bt) do { __builtin_amdgcn_s_setprio(1); _Pragma("unroll") for (int m = 0; m < 4; ++m) _Pragma("unroll") for (int n = 0; n < 2; ++n) _Pragma("unroll") for (int k = 0; k < 2; ++k) \
        acc[ai][bj][m][n] = __builtin_amdgcn_mfma_f32_16x16x32_bf16(Bt[n][k], At[m][k], acc[ai][bj][m][n], 0, 0, 0); __builtin_amdgcn_s_setprio(0); } while (0)
#define PG8_WAIT_V(n) asm volatile("s_waitcnt vmcnt(" #n ")" ::: "memory")
#define PG8_WAIT_L(n) asm volatile("s_waitcnt lgkmcnt(" #n ")" ::: "memory")
#define PG8_BAR __builtin_amdgcn_s_barrier()
#define PG8_SCHED __builtin_amdgcn_sched_barrier(0)
    Unit cur, nxt; int ui = 0;
    if (!S.next(0, cur)) return;
    float zf_ = 0.f; asm volatile("" : "+v"(zf_));
    f32x4 acc[2][2][4][2];
#pragma unroll
    for (int a = 0; a < 2; ++a)
#pragma unroll
        for (int b = 0; b < 2; ++b)
#pragma unroll
            for (int m = 0; m < 4; ++m)
#pragma unroll
                for (int n = 0; n < 2; ++n) acc[a][b][m][n] = (f32x4){zf_, zf_, zf_, zf_};
    bf16x8 At[4][2], B0[2][2], B1[2][2];
    const char* cA = uni_ptr(S.abase(cur)); const char* cB = uni_ptr(S.bbase(cur));
    if constexpr (SP2) {
        PG8_STAGE(PG8_SB(0, 0), cB, voffB); PG8_STAGE(PG8_SB(0, 1), cB + hstep, voffB); PG8_STAGE(PG8_SA(0, 0), cA, voffA); PG8_STAGE(PG8_SA(0, 1), cA + hstep, voffA);
        if (wr == 1) PG8_BAR;
        PG8_WAIT_V(2); PG8_BAR;
        PG8_STAGE(PG8_SB(1, 0), cB + kstep, voffB); PG8_STAGE(PG8_SA(1, 0), cA + kstep, voffA); PG8_STAGE(PG8_SB(1, 1), cB + hstep + kstep, voffB);
        PG8_WAIT_V(6); PG8_BAR;
    } else {
        PG8_STAGE(PG8_SB(0, 0), cB, voffB); PG8_STAGE(PG8_SA(0, 0), cA, voffA); PG8_STAGE(PG8_SB(0, 1), cB + hstep, voffB); PG8_STAGE(PG8_SA(0, 1), cA + hstep, voffA);
        if (wr == 1) PG8_BAR;
        PG8_WAIT_V(4); PG8_BAR;
        PG8_STAGE(PG8_SB(1, 0), cB + kstep, voffB); PG8_STAGE(PG8_SA(1, 0), cA + kstep, voffA); PG8_STAGE(PG8_SB(1, 1), cB + hstep + kstep, voffB);
        PG8_WAIT_V(6); PG8_BAR;
    }
    for (;;) {
        const bool has_next = S.next(ui + 1, nxt);
        const char* nA = has_next ? uni_ptr(S.abase(nxt)) : cA; const char* nB = has_next ? uni_ptr(S.bbase(nxt)) : cB;
        for (int t = 0; t < nt; t += 2) {
            const bool last = (t == nt - 2);
            const char* a1 = cA + (size_t)(t + 1) * kstep;
            const char* a2 = last ? nA : cA + (size_t)(t + 2) * kstep; const char* b2 = last ? nB : cB + (size_t)(t + 2) * kstep;
            const char* a3 = a2 + kstep; const char* b3 = b2 + kstep;
            if constexpr (SP2) {
            PG8_LDB(B0, 0, 0); PG8_LDB(B1, 0, 1); PG8_SCHED; PG8_LDA(At, 0, 0); PG8_STAGE(PG8_SA(1, 1), a1 + hstep, voffA);
            PG8_WAIT_V(8); PG8_WAIT_L(0); PG8_BAR; PG8_MMA(0, 0, At, B0); PG8_MMA(0, 1, At, B1); PG8_BAR; PG8_SCHED;
            PG8_LDA(At, 0, 1); PG8_STAGE(PG8_SB(0, 0), b2, voffB); PG8_STAGE(PG8_SB(0, 1), b2 + hstep, voffB); PG8_STAGE(PG8_SA(0, 0), a2, voffA);
            PG8_WAIT_V(8); PG8_WAIT_L(0); PG8_BAR; PG8_MMA(1, 0, At, B0); PG8_MMA(1, 1, At, B1); PG8_BAR; PG8_SCHED;
            PG8_LDB(B0, 1, 0); PG8_LDB(B1, 1, 1); PG8_SCHED; PG8_LDA(At, 1, 0); PG8_STAGE(PG8_SA(0, 1), a2 + hstep, voffA);
            PG8_WAIT_V(8); PG8_WAIT_L(0); PG8_BAR; PG8_MMA(0, 0, At, B0); PG8_MMA(0, 1, At, B1); PG8_BAR; PG8_SCHED;
            PG8_LDA(At, 1, 1); PG8_STAGE(PG8_SB(1, 0), b3, voffB); PG8_STAGE(PG8_SB(1, 1), b3 + hstep, voffB); PG8_STAGE(PG8_SA(1, 0), a3, voffA);
            PG8_WAIT_V(8); PG8_WAIT_L(0); PG8_BAR; PG8_MMA(1, 0, At, B0); PG8_MMA(1, 1, At, B1); PG8_BAR; PG8_SCHED;
            } else {
            PG8_LDB(B0, 0, 0); PG8_SCHED; PG8_LDA(At, 0, 0); PG8_STAGE(PG8_SA(1, 1), a1 + hstep, voffA);
            PG8_WAIT_L(8); PG8_BAR; PG8_WAIT_L(0); PG8_MMA(0, 0, At, B0); PG8_BAR; PG8_SCHED;
            PG8_LDB(B1, 0, 1); PG8_STAGE(PG8_SB(0, 0), b2, voffB);
            PG8_BAR; PG8_WAIT_L(0); PG8_MMA(0, 1, At, B1); PG8_BAR;
            PG8_LDA(At, 0, 1); PG8_STAGE(PG8_SA(0, 0), a2, voffA);
            PG8_BAR; PG8_WAIT_L(0); PG8_MMA(1, 0, At, B0); PG8_BAR; PG8_SCHED;
            PG8_STAGE(PG8_SB(0, 1), b2 + hstep, voffB);
            PG8_WAIT_V(6); PG8_BAR; PG8_MMA(1, 1, At, B1); PG8_BAR;
            PG8_LDB(B0, 1, 0); PG8_SCHED; PG8_LDA(At, 1, 0); PG8_STAGE(PG8_SA(0, 1), a2 + hstep, voffA);
            PG8_WAIT_L(8); PG8_BAR; PG8_WAIT_L(0); PG8_MMA(0, 0, At, B0); PG8_BAR; PG8_SCHED;
            PG8_LDB(B1, 1, 1); PG8_STAGE(PG8_SB(1, 0), b3, voffB);
            PG8_BAR; PG8_WAIT_L(0); PG8_MMA(0, 1, At, B1); PG8_BAR;
            PG8_LDA(At, 1, 1); PG8_STAGE(PG8_SA(1, 0), a3, voffA);
            PG8_BAR; PG8_WAIT_L(0); PG8_MMA(1, 0, At, B0); PG8_BAR; PG8_SCHED;
            PG8_STAGE(PG8_SB(1, 1), b3 + hstep, voffB);
            PG8_WAIT_V(6); PG8_BAR; PG8_MMA(1, 1, At, B1); PG8_BAR;
            }
        }
        if constexpr (ALIGN_EPI) { if (wr == 0) PG8_BAR; }
        E(acc, cur, wr, wc, fr, fq);
        if (!has_next) break;
#pragma unroll
        for (int a = 0; a < 2; ++a)
#pragma unroll
            for (int b = 0; b < 2; ++b)
#pragma unroll
                for (int m = 0; m < 4; ++m)
#pragma unroll
                    for (int n = 0; n < 2; ++n) acc[a][b][m][n] = (f32x4){zf_, zf_, zf_, zf_};
        cur = nxt; cA = nA; cB = nB; ++ui;
        if constexpr (ALIGN_EPI) { if (wr == 1) PG8_BAR; }
    }
    PG8_WAIT_V(0);
    if constexpr (!ALIGN_EPI) { if (wr == 0) PG8_BAR; }
    PG8_BAR;
#undef PG8_SA
#undef PG8_SB
#undef PG8_STAGE
#undef PG8_LDA
#undef PG8_LDB
#undef PG8_MMA
#undef PG8_WAIT_V
#undef PG8_WAIT_L
#undef PG8_BAR
#undef PG8_SCHED
}
typedef int v8i __attribute__((ext_vector_type(8)));
template <class Epi, class Sched, bool ALIGN_EPI = true, bool SP2 = true>
DI void gemm_phase_f8(LAS unsigned char* lds, const int tid, const int KB, const Sched& S, const Epi& E) {
    const int wid = __builtin_amdgcn_readfirstlane(tid >> 6), lane = tid & 63, wr = wid >> 2, wc = wid & 3, fr = lane & 15, fq = lane >> 4;
    const int nt = KB / 128;
    unsigned voffA[2], voffB[2];
#pragma unroll
    for (int i = 0; i < 2; ++i) { int R, C; stage_rc(tid * 16 + i * 8192, R, C); const int Rb = Epi::PERM ? ((R & ~31) + perm32(R & 31)) : R;
        voffA[i] = (unsigned)(R * KB + 2 * C); voffB[i] = (unsigned)(Rb * KB + 2 * C); }
    const size_t kstep = (size_t)(BK * 2);
    const size_t hstep = (size_t)HALF * KB;
    const unsigned ldsw = (unsigned)wid * 1024u; const unsigned ldsb = (unsigned)(unsigned long long)(lds);
    const int aoff = lds_byte(wr * 64 + fr, fq * 16), boff = lds_byte(wc * 32 + fr, fq * 16);
#define PG8_SA(b, h) (((b) * 2 + (h)) * HTB)
#define PG8_SB(b, h) ((4 + (b) * 2 + (h)) * HTB)
#define PG8_STAGE(bufoff, gbase, voff) do { _Pragma("unroll") for (int _i = 0; _i < 2; ++_i) \
        glds16_s((voff)[_i], (const char*)(gbase), ldsb + (unsigned)(bufoff) + ldsw + (unsigned)(_i * 8192)); } while (0)
#define PG8_LDA(dst, b, h) do { int a_ = aoff; asm volatile("" : "+v"(a_)); _Pragma("unroll") for (int m = 0; m < 4; ++m) dst[m] = *(const LAS v8i*)(lds + PG8_SA(b, h) + a_ + m * 2048); } while (0)
#define PG8_LDB(dst, b, h) do { int b_ = boff; asm volatile("" : "+v"(b_)); _Pragma("unroll") for (int n = 0; n < 2; ++n) dst[n] = *(const LAS v8i*)(lds + PG8_SB(b, h) + b_ + n * 2048); } while (0)
#define PG8_MMA(ai, bj, At, Bt) do { __builtin_amdgcn_s_setprio(1); _Pragma("unroll") for (int m = 0; m < 4; ++m) _Pragma("unroll") for (int n = 0; n < 2; ++n) \
        acc[ai][bj][m][n] = __builtin_amdgcn_mfma_scale_f32_16x16x128_f8f6f4(Bt[n], At[m], acc[ai][bj][m][n], 0, 0, 0, sc8, 0, sc8); __builtin_amdgcn_s_setprio(0); } while (0)
#define PG8_WAIT_V(n) asm volatile("s_waitcnt vmcnt(" #n ")" ::: "memory")
#define PG8_WAIT_L(n) asm volatile("s_waitcnt lgkmcnt(" #n ")" ::: "memory")
#define PG8_BAR __builtin_amdgcn_s_barrier()
#define PG8_SCHED __builtin_amdgcn_sched_barrier(0)
    Unit cur, nxt; int ui = 0;
    if (!S.next(0, cur)) return;
    int sc8 = 0x7c7c7c7c; asm volatile("" : "+v"(sc8));
    float zf_ = 0.f; asm volatile("" : "+v"(zf_));
    f32x4 acc[2][2][4][2];
#pragma unroll
    for (int a = 0; a < 2; ++a)
#pragma unroll
        for (int b = 0; b < 2; ++b)
#pragma unroll
            for (int m = 0; m < 4; ++m)
#pragma unroll
                for (int n = 0; n < 2; ++n) acc[a][b][m][n] = (f32x4){zf_, zf_, zf_, zf_};
    v8i At[4], B0[2], B1[2];
    const char* cA = uni_ptr(S.abase(cur)); const char* cB = uni_ptr(S.bbase(cur));
    if constexpr (SP2) {
        PG8_STAGE(PG8_SB(0, 0), cB, voffB); PG8_STAGE(PG8_SB(0, 1), cB + hstep, voffB); PG8_STAGE(PG8_SA(0, 0), cA, voffA); PG8_STAGE(PG8_SA(0, 1), cA + hstep, voffA);
        if (wr == 1) PG8_BAR;
        PG8_WAIT_V(2); PG8_BAR;
        PG8_STAGE(PG8_SB(1, 0), cB + kstep, voffB); PG8_STAGE(PG8_SA(1, 0), cA + kstep, voffA); PG8_STAGE(PG8_SB(1, 1), cB + hstep + kstep, voffB);
        PG8_WAIT_V(6); PG8_BAR;
    } else {
        PG8_STAGE(PG8_SB(0, 0), cB, voffB); PG8_STAGE(PG8_SA(0, 0), cA, voffA); PG8_STAGE(PG8_SB(0, 1), cB + hstep, voffB); PG8_STAGE(PG8_SA(0, 1), cA + hstep, voffA);
        if (wr == 1) PG8_BAR;
        PG8_WAIT_V(4); PG8_BAR;
        PG8_STAGE(PG8_SB(1, 0), cB + kstep, voffB); PG8_STAGE(PG8_SA(1, 0), cA + kstep, voffA); PG8_STAGE(PG8_SB(1, 1), cB + hstep + kstep, voffB);
        PG8_WAIT_V(6); PG8_BAR;
    }
    for (;;) {
        const bool has_next = S.next(ui + 1, nxt);
        const char* nA = has_next ? uni_ptr(S.abase(nxt)) : cA; const char* nB = has_next ? uni_ptr(S.bbase(nxt)) : cB;
        for (int t = 0; t < nt; t += 2) {
            const bool last = (t == nt - 2);
            const char* a1 = cA + (size_t)(t + 1) * kstep;
            const char* a2 = last ? nA : cA + (size_t)(t + 2) * kstep; const char* b2 = last ? nB : cB + (size_t)(t + 2) * kstep;
            const char* a3 = a2 + kstep; const char* b3 = b2 + kstep;
            if constexpr (SP2) {
            PG8_LDB(B0, 0, 0); PG8_LDB(B1, 0, 1); PG8_SCHED; PG8_LDA(At, 0, 0); PG8_STAGE(PG8_SA(1, 1), a1 + hstep, voffA);
            PG8_WAIT_V(8); PG8_WAIT_L(0); PG8_BAR; PG8_MMA(0, 0, At, B0); PG8_MMA(0, 1, At, B1); PG8_BAR; PG8_SCHED;
            PG8_LDA(At, 0, 1); PG8_STAGE(PG8_SB(0, 0), b2, voffB); PG8_STAGE(PG8_SB(0, 1), b2 + hstep, voffB); PG8_STAGE(PG8_SA(0, 0), a2, voffA);
            PG8_WAIT_V(8); PG8_WAIT_L(0); PG8_BAR; PG8_MMA(1, 0, At, B0); PG8_MMA(1, 1, At, B1); PG8_BAR; PG8_SCHED;
            PG8_LDB(B0, 1, 0); PG8_LDB(B1, 1, 1); PG8_SCHED; PG8_LDA(At, 1, 0); PG8_STAGE(PG8_SA(0, 1), a2 + hstep, voffA);
            PG8_WAIT_V(8); PG8_WAIT_L(0); PG8_BAR; PG8_MMA(0, 0, At, B0); PG8_MMA(0, 1, At, B1); PG8_BAR; PG8_SCHED;
            PG8_LDA(At, 1, 1); PG8_STAGE(PG8_SB(1, 0), b3, voffB); PG8_STAGE(PG8_SB(1, 1), b3 + hstep, voffB); PG8_STAGE(PG8_SA(1, 0), a3, voffA);
            PG8_WAIT_V(8); PG8_WAIT_L(0); PG8_BAR; PG8_MMA(1, 0, At, B0); PG8_MMA(1, 1, At, B1); PG8_BAR; PG8_SCHED;
            } else {
            PG8_LDB(B0, 0, 0); PG8_SCHED; PG8_LDA(At, 0, 0); PG8_STAGE(PG8_SA(1, 1), a1 + hstep, voffA);
            PG8_WAIT_L(8); PG8_BAR; PG8_WAIT_L(0); PG8_MMA(0, 0, At, B0); PG8_BAR; PG8_SCHED;
            PG8_LDB(B1, 0, 1); PG8_STAGE(PG8_SB(0, 0), b2, voffB);
            PG8_BAR; PG8_WAIT_L(0); PG8_MMA(0, 1, At, B1); PG8_BAR;
            PG8_LDA(At, 0, 1); PG8_STAGE(PG8_SA(0, 0), a2, voffA);
            PG8_BAR; PG8_WAIT_L(0); PG8_MMA(1, 0, At, B0); PG8_BAR; PG8_SCHED;
            PG8_STAGE(PG8_SB(0, 1), b2 + hstep, voffB);
            PG8_WAIT_V(6); PG8_BAR; PG8_MMA(1, 1, At, B1); PG8_BAR;
            PG8_LDB(B0, 1, 0); PG8_SCHED; PG8_LDA(At, 1, 0); PG8_STAGE(PG8_SA(0, 1), a2 + hstep, voffA);
            PG8_WAIT_L(8); PG8_BAR; PG8_WAIT_L(0); PG8_MMA(0, 0, At, B0); PG8_BAR; PG8_SCHED;
            PG8_LDB(B1, 1, 1); PG8_STAGE(PG8_SB(1, 0), b3, voffB);
            PG8_BAR; PG8_WAIT_L(0); PG8_MMA(0, 1, At, B1); PG8_BAR;
            PG8_LDA(At, 1, 1); PG8_STAGE(PG8_SA(1, 0), a3, voffA);
            PG8_BAR; PG8_WAIT_L(0); PG8_MMA(1, 0, At, B0); PG8_BAR; PG8_SCHED;
            PG8_STAGE(PG8_SB(1, 1), b3 + hstep, voffB);
            PG8_WAIT_V(6); PG8_BAR; PG8_MMA(1, 1, At, B1); PG8_BAR;
            }
        }
        if constexpr (ALIGN_EPI) { if (wr == 0) PG8_BAR; }
        asm volatile("" ::: "memory"); __builtin_amdgcn_sched_barrier(0);
        { int t2_ = tid; asm volatile("" : "+v"(t2_)); const int w2_ = __builtin_amdgcn_readfirstlane(t2_ >> 6), l2_ = t2_ & 63; E(acc, cur, w2_ >> 2, w2_ & 3, l2_ & 15, l2_ >> 4); }
        if (!has_next) break;
#pragma unroll
        for (int a = 0; a < 2; ++a)
#pragma unroll
            for (int b = 0; b < 2; ++b)
#pragma unroll
                for (int m = 0; m < 4; ++m)
#pragma unroll
                    for (int n = 0; n < 2; ++n) acc[a][b][m][n] = (f32x4){zf_, zf_, zf_, zf_};
        cur = nxt; cA = nA; cB = nB; ++ui;
        if constexpr (ALIGN_EPI) { if (wr == 1) PG8_BAR; }
    }
    PG8_WAIT_V(0);
    if constexpr (!ALIGN_EPI) { if (wr == 0) PG8_BAR; }
    PG8_BAR;
#undef PG8_SA
#undef PG8_SB
#undef PG8_STAGE
#undef PG8_LDA
#undef PG8_LDB
#undef PG8_MMA
#undef PG8_WAIT_V
#undef PG8_WAIT_L
#undef PG8_BAR
#undef PG8_SCHED
}
}

struct SchedPlain {
    pg8::StaticOrder o; const char* A; const char* B; size_t tstep;
    DI bool next(int i, pg8::Unit& u) const { return o.next(i, u); }
    DI const char* abase(const pg8::Unit& u) const { return A + (size_t)u.pm * tstep; }
    DI const char* bbase(const pg8::Unit& u) const { return B + (size_t)u.pn * tstep; }
};
struct SchedBranch {
    pg8::StaticOrder o; const char* A; const char* B; size_t tstep, aslab;
    DI bool next(int i, pg8::Unit& u) const { pg8::Unit t; if (!o.next(i / 3, t)) return false; u.pm = t.pm; u.pn = t.pn + 4 * (i % 3); return true; }
    DI const char* abase(const pg8::Unit& u) const { return A + (size_t)(u.pn >> 2) * aslab + (size_t)u.pm * tstep; }
    DI const char* bbase(const pg8::Unit& u) const { return B + (size_t)u.pn * tstep; }
};
struct SchedMoe {
    pg8::StaticOrder o; const char* A; const char* B; unsigned eslab; const LAS int* texp;
    DI bool next(int i, pg8::Unit& u) const { return o.next(i, u); }
    DI const char* abase(const pg8::Unit& u) const { return A + (size_t)u.pm * (256u * 1024u); }
    DI const char* bbase(const pg8::Unit& u) const { return B + (size_t)((unsigned)texp[u.pm] * eslab) + (size_t)u.pn * (256u * 1024u); }
};

struct SchedMoeB {
    pg8::StaticOrder o; const char* A; const char* B; unsigned eslab; const LAS int* texp;
    DI bool next(int i, pg8::Unit& u) const { return o.next(i, u); }
    DI const char* abase(const pg8::Unit& u) const { return A + (size_t)u.pm * (256u * 2048u); }
    DI const char* bbase(const pg8::Unit& u) const { return B + (size_t)((unsigned)texp[u.pm] * eslab) + (size_t)u.pn * (256u * 2048u); }
};

#ifndef EPI_QT
#define EPI_QT 1
#endif
#ifndef EPI_QT_ST
#define EPI_QT_ST 1
#endif
DI int qt_src(int lane) { return (((lane >> 2) + 16 * (lane & 3)) * 4); }
DI f32x4 qt4f(int src4, f32x4 v);
DI u32x4 qt4(int src4, u32x4 w) { u32x4 r; r.x = (unsigned)__builtin_amdgcn_ds_bpermute(src4, (int)w.x); r.y = (unsigned)__builtin_amdgcn_ds_bpermute(src4, (int)w.y); r.z = (unsigned)__builtin_amdgcn_ds_bpermute(src4, (int)w.z); r.w = (unsigned)__builtin_amdgcn_ds_bpermute(src4, (int)w.w); return r; }
DI f32x4 qt4f(int src4, f32x4 v) { return __builtin_bit_cast(f32x4, qt4(src4, __builtin_bit_cast(u32x4, v))); }
struct EpiStoreBf16 {
    static constexpr bool PERM = true;
    bf16_t* O; int ldc; int coff = 0;
#ifdef PROBE_NOSTORE
    bool skip = false;
#endif
    DI void operator()(const f32x4 (&acc)[2][2][4][2], const pg8::Unit& u, int wr, int wc, int fr, int fq) const {
#if EPI_QT_ST
        const int lane = fr + 16 * fq, src4 = qt_src(lane); fr = lane >> 2; fq = lane & 3;
#endif
        const int row0 = u.pm * 256 + wr * 64 + fr, col0 = coff + u.pn * 256 + wc * 32 + 8 * fq;
#pragma unroll
        for (int ai = 0; ai < 2; ++ai)
#pragma unroll
            for (int m = 0; m < 4; ++m) { bf16_t* rowp = O + (size_t)(row0 + ai * 128 + m * 16) * ldc + col0;
#pragma unroll
                for (int bj = 0; bj < 2; ++bj) { const f32x4 v0 = acc[ai][bj][m][0], v1 = acc[ai][bj][m][1];
                    u32x4 w; w.x = pk2(v0[0], v0[1]); w.y = pk2(v0[2], v0[3]); w.z = pk2(v1[0], v1[1]); w.w = pk2(v1[2], v1[3]);
#if EPI_QT_ST
                    w = qt4(src4, w);
#endif
#ifdef PROBE_NOSTORE
                    if (skip) { asm volatile("" :: "v"(w.x), "v"(w.y), "v"(w.z), "v"(w.w)); } else
#endif
                    *(u32x4*)(rowp + bj * 128) = w; } }
    }
};
struct EpiStoreBf16N {
    static constexpr bool PERM = false;
    bf16_t* O; int ldc; int coff = 0;
#ifdef PROBE_NOSTORE
    bool skip = false;
#endif
    DI void operator()(const f32x4 (&acc)[2][2][4][2], const pg8::Unit& u, int wr, int wc, int fr, int fq) const {
#if EPI_QT
#if EPI_QT_ST
        const int lane = fr + 16 * fq, a_ = lane >> 2, b_ = lane & 3, src4 = (a_ + 16 * (((b_ & 1) << 1) | (b_ >> 1))) * 4;
        const int row0 = u.pm * 256 + wr * 64 + a_, col0 = coff + u.pn * 256 + wc * 32 + 8 * b_;
#else
        const int row0 = u.pm * 256 + wr * 64 + fr, col0 = coff + u.pn * 256 + wc * 32 + 8 * (((fq & 1) << 1) | (fq >> 1));
#endif
#pragma unroll
        for (int ai = 0; ai < 2; ++ai)
#pragma unroll
            for (int m = 0; m < 4; ++m) { bf16_t* rowp = O + (size_t)(row0 + ai * 128 + m * 16) * ldc + col0;
#pragma unroll
                for (int bj = 0; bj < 2; ++bj) { const f32x4 v0 = acc[ai][bj][m][0], v1 = acc[ai][bj][m][1];
                    unsigned x0 = pk2(v0[0], v0[1]), y0 = pk2(v0[2], v0[3]), x1 = pk2(v1[0], v1[1]), y1 = pk2(v1[2], v1[3]);
                    { const auto r = __builtin_amdgcn_permlane16_swap(x0, x1, false, false); x0 = r[0]; x1 = r[1]; }
                    { const auto r = __builtin_amdgcn_permlane16_swap(y0, y1, false, false); y0 = r[0]; y1 = r[1]; }
                    u32x4 w; w.x = x0; w.y = y0; w.z = x1; w.w = y1;
#if EPI_QT_ST
                    w = qt4(src4, w);
#endif
#ifdef PROBE_NOSTORE
                    if (skip) { asm volatile("" :: "v"(w.x), "v"(w.y), "v"(w.z), "v"(w.w)); } else
#endif
                    *(u32x4*)(rowp + bj * 128) = w; } }
#else
        const int row0 = u.pm * 256 + wr * 64 + fr, col0 = coff + u.pn * 256 + wc * 32 + 4 * fq;
#pragma unroll
        for (int ai = 0; ai < 2; ++ai)
#pragma unroll
            for (int m = 0; m < 4; ++m) { bf16_t* rowp = O + (size_t)(row0 + ai * 128 + m * 16) * ldc + col0;
#pragma unroll
                for (int bj = 0; bj < 2; ++bj)
#pragma unroll
                    for (int n = 0; n < 2; ++n) { const f32x4 v = acc[ai][bj][m][n]; u32x2 w; w.x = pk2(v[0], v[1]); w.y = pk2(v[2], v[3]);
#ifdef PROBE_NOSTORE
                        if (skip) { asm volatile("" :: "v"(w.x), "v"(w.y)); } else
#endif
                        *(u32x2*)(rowp + bj * 128 + n * 16) = w; } }
#endif
    }
};
struct EpiQaRope {
    static constexpr bool PERM = true;
    bf16_t* O; const float* rope;
    DI void operator()(const f32x4 (&acc)[2][2][4][2], const pg8::Unit& u, int wr, int wc, int fr, int fq) const {
        const int row0 = u.pm * 256 + wr * 64 + fr, col0 = u.pn * 256 + wc * 32 + 8 * fq;
#pragma unroll
        for (int ai = 0; ai < 2; ++ai)
#pragma unroll
            for (int m = 0; m < 4; ++m) { const int row = row0 + ai * 128 + m * 16; bf16_t* rowp = O + (size_t)row * 768 + col0;
#pragma unroll
                for (int bj = 0; bj < 2; ++bj) { f32x4 v0 = acc[ai][bj][m][0], v1 = acc[ai][bj][m][1];
                    const int c8 = col0 + bj * 128, p0 = c8 % 96;
                    if (p0 < 32) { const f32x4* cs = (const f32x4*)(rope + (size_t)row * 48 + p0); const f32x4 a = cs[0], b = cs[1];
                        const f32x4 r0 = {v0[0] * a[0] - v0[1] * a[1], v0[1] * a[0] + v0[0] * a[1], v0[2] * a[2] - v0[3] * a[3], v0[3] * a[2] + v0[2] * a[3]};
                        const f32x4 r1 = {v1[0] * b[0] - v1[1] * b[1], v1[1] * b[0] + v1[0] * b[1], v1[2] * b[2] - v1[3] * b[3], v1[3] * b[2] + v1[2] * b[3]};
                        v0 = r0; v1 = r1; }
                    u32x4 w; w.x = pk2(v0[0], v0[1]); w.y = pk2(v0[2], v0[3]); w.z = pk2(v1[0], v1[1]); w.w = pk2(v1[2], v1[3]);
                    *(u32x4*)(rowp + bj * 128) = w; } }
    }
};
struct EpiBranchGate {
    static constexpr bool PERM = true;
    bf16_t* MG; const bf16_t* P; const float* bgate;
    DI void operator()(const f32x4 (&acc)[2][2][4][2], const pg8::Unit& u, int wr, int wc, int fr, int fq) const {
#if EPI_QT
        const int lane = fr + 16 * fq, src4 = qt_src(lane); fr = lane >> 2; fq = lane & 3;
#endif
        const int n = u.pn >> 2, row0 = u.pm * 256 + wr * 64 + fr, colg = u.pn * 256 + wc * 32 + 8 * fq, col0 = colg - n * 1024;
        f32x4 bg[2][2];
#pragma unroll
        for (int bj = 0; bj < 2; ++bj) { bg[bj][0] = *(const f32x4*)(bgate + colg + bj * 128); bg[bj][1] = *(const f32x4*)(bgate + colg + bj * 128 + 4); }
        u32x4 gl[2][2][2], pv[2][2][2];
#define EBG_LOAD(slot, grp) do { _Pragma("unroll") for (int m2 = 0; m2 < 2; ++m2) _Pragma("unroll") for (int bj = 0; bj < 2; ++bj) { const size_t row = (size_t)(row0 + ((grp) >> 1) * 128 + (2 * ((grp) & 1) + m2) * 16); \
            gl[slot][m2][bj] = *(const u32x4*)(P + row * NP + colg + bj * 128); pv[slot][m2][bj] = (n > 0) ? *(const u32x4*)(MG + row * D_MODEL + col0 + bj * 128) : (u32x4){0u, 0u, 0u, 0u}; } } while (0)
        EBG_LOAD(0, 0);
#pragma unroll
        for (int grp = 0; grp < 4; ++grp) {
            const int slot = grp & 1, ai = grp >> 1, mh = grp & 1;
            if (grp + 1 < 4) { if (slot == 0) EBG_LOAD(1, grp + 1); else EBG_LOAD(0, grp + 1); }
            asm volatile("" ::: "memory");
#pragma unroll
            for (int m2 = 0; m2 < 2; ++m2)
#pragma unroll
                for (int bj = 0; bj < 2; ++bj) { const int m = 2 * mh + m2; const size_t row = (size_t)(row0 + ai * 128 + m * 16);
#if EPI_QT
                    const f32x4 v0 = qt4f(src4, acc[ai][bj][m][0]), v1 = qt4f(src4, acc[ai][bj][m][1]);
#else
                    const f32x4 v0 = acc[ai][bj][m][0], v1 = acc[ai][bj][m][1];
#endif
                    const u32x4 g = gl[slot][m2][bj], q = pv[slot][m2][bj];
                    float o[8];
                    o[0] = v0[0] * fast_sigmoid(bf_lo(g.x) + bg[bj][0][0]) + bf_lo(q.x); o[1] = v0[1] * fast_sigmoid(bf_hi(g.x) + bg[bj][0][1]) + bf_hi(q.x);
                    o[2] = v0[2] * fast_sigmoid(bf_lo(g.y) + bg[bj][0][2]) + bf_lo(q.y); o[3] = v0[3] * fast_sigmoid(bf_hi(g.y) + bg[bj][0][3]) + bf_hi(q.y);
                    o[4] = v1[0] * fast_sigmoid(bf_lo(g.z) + bg[bj][1][0]) + bf_lo(q.z); o[5] = v1[1] * fast_sigmoid(bf_hi(g.z) + bg[bj][1][1]) + bf_hi(q.z);
                    o[6] = v1[2] * fast_sigmoid(bf_lo(g.w) + bg[bj][1][2]) + bf_lo(q.w); o[7] = v1[3] * fast_sigmoid(bf_hi(g.w) + bg[bj][1][3]) + bf_hi(q.w);
                    u32x4 w; w.x = pk2(o[0], o[1]); w.y = pk2(o[2], o[3]); w.z = pk2(o[4], o[5]); w.w = pk2(o[6], o[7]);
                    *(u32x4*)(MG + row * D_MODEL + col0 + bj * 128) = w; }
        }
#undef EBG_LOAD
    }
};
struct EpiResidual {
    static constexpr bool PERM = false;
    const float* xin; float* xout; const float* gmod;
    DI void operator()(const f32x4 (&acc)[2][2][4][2], const pg8::Unit& u, int wr, int wc, int fr, int fq) const {
#if EPI_QT
        const int lane = fr + 16 * fq, src4 = qt_src(lane); fr = lane >> 2; fq = lane & 3;
#endif
        const int row0 = u.pm * 256 + wr * 64 + fr, col0 = u.pn * 256 + wc * 32 + 4 * fq;
        const float* gm = gmod + (size_t)(u.pm >> 3) * 6144 + col0;
        f32x4 gv[2][2];
#pragma unroll
        for (int bj = 0; bj < 2; ++bj)
#pragma unroll
            for (int n = 0; n < 2; ++n) gv[bj][n] = *(const f32x4*)(gm + bj * 128 + n * 16);
        f32x4 xv[2][2][2][2];
#define ERS_LOAD(slot, grp) do { _Pragma("unroll") for (int m2 = 0; m2 < 2; ++m2) { const size_t off = (size_t)(row0 + ((grp) >> 1) * 128 + (2 * ((grp) & 1) + m2) * 16) * D_MODEL + col0; \
            _Pragma("unroll") for (int bj = 0; bj < 2; ++bj) _Pragma("unroll") for (int n = 0; n < 2; ++n) xv[slot][m2][bj][n] = *(const f32x4*)(xin + off + bj * 128 + n * 16); } } while (0)
        ERS_LOAD(0, 0);
#pragma unroll
        for (int grp = 0; grp < 4; ++grp) {
            const int slot = grp & 1, ai = grp >> 1, mh = grp & 1;
            if (grp + 1 < 4) { if (slot == 0) ERS_LOAD(1, grp + 1); else ERS_LOAD(0, grp + 1); }
            asm volatile("" ::: "memory");
#pragma unroll
            for (int m2 = 0; m2 < 2; ++m2) { const size_t off = (size_t)(row0 + ai * 128 + (2 * mh + m2) * 16) * D_MODEL + col0;
#pragma unroll
                for (int bj = 0; bj < 2; ++bj)
#pragma unroll
                    for (int n = 0; n < 2; ++n) {
#if EPI_QT
                        const f32x4 av = qt4f(src4, acc[ai][bj][2 * mh + m2][n]);
#else
                        const f32x4 av = acc[ai][bj][2 * mh + m2][n];
#endif
                        *(f32x4*)(xout + off + bj * 128 + n * 16) = xv[slot][m2][bj][n] + gv[bj][n] * av; } }
        }
#undef ERS_LOAD
    }
};
struct EpiSwiglu {
    static constexpr bool PERM = false;
    bf16_t* ACT; const float* b1; const LAS int* texp;
    DI void operator()(const f32x4 (&acc)[2][2][4][2], const pg8::Unit& u, int wr, int wc, int fr, int fq) const {
        const int row0 = u.pm * 256 + wr * 64 + fr, e = texp[u.pm];
        const float* bb = b1 + (size_t)e * 2048;
#pragma unroll
        for (int bj = 0; bj < 2; ++bj) { const int j0 = u.pn * 128 + bj * 64 + wc * 16 + 4 * fq;
            const f32x4 ba = *(const f32x4*)(bb + 2 * j0), bc = *(const f32x4*)(bb + 2 * j0 + 4);
            const f32x4 bgt = {ba[0], ba[2], bc[0], bc[2]}, bup = {ba[1], ba[3], bc[1], bc[3]};
#pragma unroll
            for (int ai = 0; ai < 2; ++ai)
#pragma unroll
                for (int m = 0; m < 4; ++m) { const f32x4 g = acc[ai][bj][m][0] + bgt, up = acc[ai][bj][m][1] + bup; float o[4];
#pragma unroll
                    for (int i = 0; i < 4; ++i) { const float gg = fminf(g[i], 7.0f), uu = fminf(fmaxf(up[i], -7.0f), 7.0f);
                        o[i] = (uu + 1.0f) * gg * fast_sigmoid(1.702f * gg);
                    }
                    u32x2 w; w.x = pk2(o[0], o[1]); w.y = pk2(o[2], o[3]);
                    *(u32x2*)(ACT + (size_t)(row0 + ai * 128 + m * 16) * D_EXP + j0) = w; } }
    }
};
struct EpiSwiglu8 {
    static constexpr bool PERM = false;
    unsigned char* ACT; const float* b1; const LAS int* texp;
#ifdef PROBE_M1
    int skip = 0;
#endif
    DI void operator()(const f32x4 (&acc)[2][2][4][2], const pg8::Unit& u, int wr, int wc, int fr, int fq) const {
#ifdef PROBE_M1
        if (skip == 2) {
#pragma unroll
            for (int ai = 0; ai < 2; ++ai)
#pragma unroll
                for (int bj = 0; bj < 2; ++bj)
#pragma unroll
                    for (int m = 0; m < 4; ++m)
#pragma unroll
                        for (int n = 0; n < 2; ++n) asm volatile("" :: "v"(acc[ai][bj][m][n][0]), "v"(acc[ai][bj][m][n][1]), "v"(acc[ai][bj][m][n][2]), "v"(acc[ai][bj][m][n][3]));
            return; }
#endif
        const int row0 = u.pm * 256 + wr * 64 + fr, e = texp[u.pm];
        const float* bb = b1 + (size_t)e * 2048;
#pragma unroll
        for (int bj = 0; bj < 2; ++bj) { const int j0 = u.pn * 128 + bj * 64 + wc * 16 + 4 * fq;
            const f32x4 ba = *(const f32x4*)(bb + 2 * j0), bc = *(const f32x4*)(bb + 2 * j0 + 4);
            const f32x4 bgt = {ba[0], ba[2], bc[0], bc[2]}, bup = {ba[1], ba[3], bc[1], bc[3]};
#pragma unroll
            for (int ai = 0; ai < 2; ++ai) {
                unsigned w[4];
#pragma unroll
                for (int m = 0; m < 4; ++m) { const f32x4 g = acc[ai][bj][m][0] + bgt, up = acc[ai][bj][m][1] + bup; float o[4];
#pragma unroll
                    for (int i = 0; i < 4; ++i) { const float gg = fminf(g[i], 7.0f), uu = fminf(fmaxf(up[i], -7.0f), 7.0f);
                        o[i] = (uu + 1.0f) * gg * fast_sigmoid(1.702f * gg);
                    }
                    w[m] = pk4_fp8(o[0], o[1], o[2], o[3]); }
                { const auto r = __builtin_amdgcn_permlane16_swap(w[0], w[1], false, false); w[0] = r[0]; w[1] = r[1]; }
                { const auto r = __builtin_amdgcn_permlane16_swap(w[2], w[3], false, false); w[2] = r[0]; w[3] = r[1]; }
                { const auto r = __builtin_amdgcn_permlane32_swap(w[0], w[2], false, false); w[0] = r[0]; w[2] = r[1]; }
                { const auto r = __builtin_amdgcn_permlane32_swap(w[1], w[3], false, false); w[1] = r[0]; w[3] = r[1]; }
                u32x4 wv; wv.x = w[0]; wv.y = w[1]; wv.z = w[2]; wv.w = w[3];
#ifdef PROBE_M1
                if (skip == 1) { asm volatile("" :: "v"(wv.x), "v"(wv.y), "v"(wv.z), "v"(wv.w)); } else
#endif
                *(u32x4*)(ACT + (size_t)(row0 + ai * 128 + fq * 16) * D_EXP + (j0 - 4 * fq)) = wv; } }
    }
};
struct EpiMoeOut {
    static constexpr bool PERM = true;
    bf16_t* Y; const float* b2; const float* gate; const LAS int* texp;
    DI void operator()(const f32x4 (&acc)[2][2][4][2], const pg8::Unit& u, int wr, int wc, int fr, int fq) const {
        const int row0 = u.pm * 256 + wr * 64 + fr, col0 = u.pn * 256 + wc * 32 + 8 * fq, e = texp[u.pm];
        const float* bb = b2 + (size_t)e * D_MODEL + col0;
#if EPI_QT_ST
        const int lane = fr + 16 * fq, src4 = qt_src(lane), rowq = (lane >> 2) - fr, colq = 8 * ((lane & 3) - fq);
#endif
        f32x4 bv[2][2];
#pragma unroll
        for (int bj = 0; bj < 2; ++bj) { bv[bj][0] = *(const f32x4*)(bb + bj * 128); bv[bj][1] = *(const f32x4*)(bb + bj * 128 + 4); }
#pragma unroll
        for (int ai = 0; ai < 2; ++ai) {
            float gt[4];
#pragma unroll
            for (int m = 0; m < 4; ++m) gt[m] = gate[row0 + ai * 128 + m * 16];
            asm volatile("" ::: "memory");
#pragma unroll
            for (int m = 0; m < 4; ++m) { const int row = row0 + ai * 128 + m * 16; const float g = gt[m];
#pragma unroll
                for (int bj = 0; bj < 2; ++bj) { const f32x4 v0 = (acc[ai][bj][m][0] + bv[bj][0]) * g, v1 = (acc[ai][bj][m][1] + bv[bj][1]) * g;
                    u32x4 w; w.x = pk2(v0[0], v0[1]); w.y = pk2(v0[2], v0[3]); w.z = pk2(v1[0], v1[1]); w.w = pk2(v1[2], v1[3]);
#if EPI_QT_ST
                    *(u32x4*)(Y + (size_t)(row + rowq) * D_MODEL + col0 + colq + bj * 128) = qt4(src4, w); } }
#else
                    *(u32x4*)(Y + (size_t)row * D_MODEL + col0 + bj * 128) = w; } }
#endif
            asm volatile("" ::: "memory");
        }
    }
};

constexpr size_t MiB = 1u << 20;
constexpr size_t WS_CTL = 0, CTL_ZERO_BYTES = 1 * MiB;
constexpr size_t WS_MOD = 1 * MiB, WS_ROPE = 2 * MiB, WS_WIN = 8 * MiB, WS_WUQ = 33 * MiB, WS_WUKV = 34 * MiB, WS_WB = 35 * MiB, WS_WOUT = 41 * MiB, WS_W1 = 53 * MiB, WS_W2 = 309 * MiB,
                 WS_X1 = 437 * MiB, WS_H = 565 * MiB, WS_CQ = 629 * MiB, WS_CKV = 645 * MiB, WS_KPE = 661 * MiB, WS_QA = 663 * MiB, WS_KV = 711 * MiB, WS_O3 = 775 * MiB, WS_QC = 871 * MiB,
                 WS_KC = 903 * MiB, WS_VC = 907 * MiB, WS_QI = 911 * MiB, WS_KI = 943 * MiB, WS_IW = 947 * MiB, WS_ROUTE = 948 * MiB, WS_P = 952 * MiB, WS_GY = 1352 * MiB, WS_END = 1544 * MiB;
constexpr size_t WS_HG8 = WS_QA;
constexpr size_t WS_XB = WS_P, WS_ACT = WS_P + 272 * MiB, WS_Y = WS_P, WS_H8 = WS_H;
constexpr size_t RT_TOPE = 0, RT_TOPG = 512 * 1024, RT_RANK = 1 * MiB, RT_SLOTOF = 1 * MiB + 512 * 1024, RT_TOKOF = 2 * MiB, RT_GATEOF = 3 * MiB;
static_assert((size_t)NSLOT_MAX * 1024 * 2 <= 272 * MiB && WS_ACT + 272 * MiB <= WS_END, "MoE overlay: XB (fp8) and Y (bf16) share [P, P+272M) (XB is dead when Y is written); ACT in [P+272M, P+544M)");
static_assert((size_t)T_TOK * NP * 2 == 400 * MiB, "P size");
constexpr int CW_BAR = 4096, CW_CNT = 16384;
constexpr int LDS_BYTES = 163840, LDS_X = 131072, MISC_OFF = LDS_BYTES - 512;

struct Frame {
    LAS unsigned char* lds; int tid, lane, wave, G, bid; float zf;
    float* out; unsigned char* ws; unsigned* ctl;
};
extern __shared__ __attribute__((aligned(16))) unsigned char lds_raw[];
typedef __attribute__((address_space(4))) const char* kptr_t;
DI const void* kin(int i) {
#if defined(__HIP_DEVICE_COMPILE__)
    kptr_t ka = (kptr_t)__builtin_amdgcn_kernarg_segment_ptr(); asm volatile("" : "+s"(ka)); return (const void*)(GAS const void*)*(__attribute__((address_space(4))) const unsigned long long*)(ka + 8 * i);
#else
    (void)i; return nullptr;
#endif
}
#define KIN_x ((const float*)kin(0))
#define KIN_c ((const float*)kin(1))
#define KIN_pos ((const int*)kin(2))
#define KIN_norm1_g ((const float*)kin(3))
#define KIN_norm2_g ((const float*)kin(4))
#define KIN_w_ada ((const float*)kin(5))
#define KIN_b_ada ((const float*)kin(6))
#define KIN_w_in ((const float*)kin(7))
#define KIN_b_gate ((const float*)kin(8))
#define KIN_q_norm ((const float*)kin(9))
#define KIN_w_uq ((const float*)kin(10))
#define KIN_kv_norm ((const float*)kin(11))
#define KIN_w_ukv ((const float*)kin(12))
#define KIN_conv_w ((const float*)kin(13))
#define KIN_w_branch ((const float*)kin(14))
#define KIN_w_out ((const float*)kin(15))
#define KIN_router_w ((const float*)kin(16))
#define KIN_router_b ((const float*)kin(17))
#define KIN_w1 ((const float*)kin(18))
#define KIN_b1 ((const float*)kin(19))
#define KIN_w2 ((const float*)kin(20))
#define KIN_b2 ((const float*)kin(21))
#define KIN_final_g ((const float*)kin(22))
DI Frame make_frame(int wave0) {
    Frame F; unsigned z_ = 0u; asm volatile("" : "+v"(z_));
    F.lds = (LAS unsigned char*)lds_raw; F.lane = (int)__builtin_amdgcn_mbcnt_hi(~0u, __builtin_amdgcn_mbcnt_lo(~0u, z_)); F.wave = wave0; F.tid = wave0 * 64 + F.lane; F.G = gridDim.x; F.bid = blockIdx.x; F.zf = __uint_as_float(z_);
    F.out = (float*)kin(23); F.ws = (unsigned char*)kin(24); F.ctl = (unsigned*)F.ws;
    return F;
}
#define WSP(T, off) ((T*)(F.ws + (off)))
#ifndef STAG_MODE
#define STAG_MODE 1
#endif
#ifndef STAG_SCALE
#define STAG_SCALE 100
#endif
DI void stagger(const Frame& F, int spread_us) {
#if STAG_MODE == 0
    const unsigned ticks = (unsigned)(spread_us * STAG_SCALE) * (unsigned)F.bid / (unsigned)F.G;
#elif STAG_MODE == 1
    const unsigned ticks = (unsigned)(spread_us * STAG_SCALE) * (unsigned)(F.bid & 7) / 8u;
#else
    const unsigned ticks = (unsigned)(spread_us * STAG_SCALE) * (unsigned)((F.bid >> 3) & 3) / 4u;
#endif
    if (ticks == 0u) return;
    const unsigned long long t0 = __builtin_amdgcn_s_memrealtime();
    while ((unsigned)(__builtin_amdgcn_s_memrealtime() - t0) < ticks) __builtin_amdgcn_s_sleep(8);
}


#define XB_TMO      128
#define XB_XCNT(j)  (256  + 64 * (j))
#define XB_XSUB(j)  (1280 + 64 * (j))
#define XB_XGEN(j)  (2304 + 64 * (j))
#define XB_TOP      3328
#define XB_TOPGEN   3392
#define XCD_BAR_WORDS 3456
#define XB_SPIN_CAP (1u << 18)
DI unsigned xb_ld(unsigned* p)              { return __hip_atomic_load(p, __ATOMIC_RELAXED, __HIP_MEMORY_SCOPE_AGENT); }
DI unsigned xb_add(unsigned* p, unsigned v) { return __hip_atomic_fetch_add(p, v, __ATOMIC_RELAXED, __HIP_MEMORY_SCOPE_AGENT); }
DI unsigned xb_xcc_id() { return (unsigned)__builtin_amdgcn_s_getreg((3 << 11) | 20) & 0xFu; }
#define XB_SPIN(cond, bar) do { unsigned _sp = 0; while (cond) { __builtin_amdgcn_s_sleep(1); \
    if ((++_sp & 255u) == 0u) { if (xb_ld(&(bar)[XB_TMO])) break; if (_sp > XB_SPIN_CAP) { atomicAdd(&(bar)[XB_TMO], 1u); break; } } } } while (0)
struct XcdBarrier { unsigned* bar; unsigned x; volatile LAS unsigned* st; };
DI XcdBarrier xcd_barrier_post(unsigned* bar, volatile LAS unsigned* st, int tid) {
    XcdBarrier b; b.bar = bar; b.x = xb_xcc_id(); b.st = st;
    if (tid == 0) (void)xb_add(&bar[XB_XCNT(b.x)], 1u);
    return b;
}
DI void xcd_barrier_complete(unsigned* bar, unsigned x, unsigned& nloc, unsigned& nx) {
    const unsigned G = gridDim.x * gridDim.y * gridDim.z;
    unsigned sum, cnt, mine, sp = 0u;
    for (;;) {
        sum = 0u; cnt = 0u; mine = 0u;
#pragma unroll
        for (unsigned j = 0; j < 16; ++j) { const unsigned c = xb_ld(&bar[XB_XCNT(j)]); sum += c; cnt += (c > 0u) ? 1u : 0u; mine = (j == x) ? c : mine; }
        if (sum == G) break;
        __builtin_amdgcn_s_sleep(1);
        if ((++sp & 255u) == 0u) { if (xb_ld(&bar[XB_TMO])) break; if (sp > XB_SPIN_CAP) { atomicAdd(&bar[XB_TMO], 1u); break; } }
    }
    nloc = mine > 0u ? mine : 1u; nx = cnt > 0u ? cnt : 1u;
}
DI void xcd_barrier(const XcdBarrier& b, int tid) {
    asm volatile("s_waitcnt vmcnt(0)" ::: "memory");
    __syncthreads();
    if (tid == 0) {
        unsigned* bar = b.bar;
        __builtin_amdgcn_s_waitcnt(0);
        unsigned nloc = b.st[0], nx = b.st[1];
        if (nloc == 0u) { xcd_barrier_complete(bar, b.x, nloc, nx); b.st[0] = nloc; b.st[1] = nx; }
        const unsigned old = xb_add(&bar[XB_XSUB(b.x)], 1u);
        const unsigned gen = old / nloc;
        if (old + 1u == (gen + 1u) * nloc) {
            __builtin_amdgcn_fence(__ATOMIC_RELEASE, "agent");
            asm volatile("s_waitcnt vmcnt(0)" ::: "memory");
            const unsigned og = xb_add(&bar[XB_TOP], 1u);
            const unsigned tg = og / nx;
            if (og + 1u == (tg + 1u) * nx) xb_add(&bar[XB_TOPGEN], 1u);
            else XB_SPIN(xb_ld(&bar[XB_TOPGEN]) == tg, bar);
            __builtin_amdgcn_fence(__ATOMIC_ACQUIRE, "agent");
            xb_add(&bar[XB_XGEN(b.x)], 1u);
            asm volatile("s_waitcnt vmcnt(0)" ::: "memory");
        } else {
            XB_SPIN(xb_ld(&bar[XB_XGEN(b.x)]) == gen, bar);
            __builtin_amdgcn_fence(__ATOMIC_ACQUIRE, "agent");
            asm volatile("s_waitcnt vmcnt(0)" ::: "memory");
        }
    }
    __syncthreads();
}

#ifndef G1_F8_COLS
#define G1_F8_COLS 3072
#endif
DI int rope_perm(int p, int half) { return (p < 2 * half) ? (p >> 1) + half * (p & 1) : p; }
DI int cmap_in(int r) {
    if (r < PC_CONV) return OC_GATE + r;
    if (r < PC_DQ) return OC_CONV + (r - PC_CONV);
    if (r < PC_IQ) { const int j = r - PC_DQ; return OC_DQ + (j & ~63) + rope_perm(j & 63, 8); }
    if (r < PC_QLAT) { const int j = r - PC_IQ; return OC_IQ + (j & ~63) + rope_perm(j & 63, 8); }
    if (r < PC_KVLAT) return OC_QLAT + (r - PC_QLAT);
    if (r < PC_DKV) { const int j = r - PC_KVLAT; return j < 128 ? OC_KVLAT + j : OC_KVLAT + 128 + rope_perm(j - 128, 16); }
    if (r < PC_IK) { const int j = r - PC_DKV; return j < 64 ? OC_DKV + rope_perm(j, 8) : OC_DKV + j; }
    if (r < PC_IW) return OC_IK + rope_perm(r - PC_IK, 8);
    if (r < IN_COLS) return OC_IW + (r - PC_IW);
    return -1;
}
DI int cmap_uq(int r) { const int h = r / 96, p = r % 96; return h * 96 + rope_perm(p, 16); }
DI int cmap_w1(int R) { const int pn = R >> 8, rem = R & 255, bj = rem >> 7, wc = (rem >> 5) & 3, n = (rem >> 4) & 1, f = rem & 15; return 2 * (pn * 128 + bj * 64 + wc * 16 + f) + n; }
DI void transpose_item(const float* W, int K, int N, bf16_t* WT, int ldk, int koff, LAS float* scr, int k0, int n0, int csrc, int lane) {
#pragma unroll 8
    for (int i = 0; i < 32; ++i) { const int kk = 2 * i + (lane >> 5); float v = 0.f; if (csrc >= 0 && k0 + kk < K) v = W[(size_t)(k0 + kk) * N + csrc]; scr[kk * 33 + (lane & 31)] = v; }
    LDS_WAIT(); asm volatile("" ::: "memory");
    const int c = lane & 7;
#pragma unroll
    for (int j = 0; j < 4; ++j) { const int n = (lane >> 3) + 8 * j; const LAS float* s = scr + (8 * c) * 33 + n;
        u32x4 o; o.x = pk2(s[0 * 33], s[1 * 33]); o.y = pk2(s[2 * 33], s[3 * 33]); o.z = pk2(s[4 * 33], s[5 * 33]); o.w = pk2(s[6 * 33], s[7 * 33]);
        *(u32x4*)(WT + (size_t)(n0 + n) * ldk + koff + k0 + 8 * c) = o; }
    LDS_WAIT(); asm volatile("" ::: "memory");
}
DI void transpose_item_f8(const float* W, int K, int N, unsigned char* WT, int ldk, LAS float* scr, int k0, int n0, int csrc, int lane, float qs) {
#pragma unroll 8
    for (int i = 0; i < 32; ++i) { const int kk = 2 * i + (lane >> 5); scr[kk * 33 + (lane & 31)] = W[(size_t)(k0 + kk) * N + csrc] * qs; }
    LDS_WAIT(); asm volatile("" ::: "memory");
    const int c = lane & 7;
#pragma unroll
    for (int j = 0; j < 4; ++j) { const int n = (lane >> 3) + 8 * j; const LAS float* s = scr + (8 * c) * 33 + n;
        u32x2 o; o.x = pk4_fp8(s[0 * 33], s[1 * 33], s[2 * 33], s[3 * 33]); o.y = pk4_fp8(s[4 * 33], s[5 * 33], s[6 * 33], s[7 * 33]);
        *(u32x2*)(WT + (size_t)(n0 + n) * ldk + k0 + 8 * c) = o; }
    LDS_WAIT(); asm volatile("" ::: "memory");
}
DI void titem_load(const float* W, int N, int k0, int csrc, int lane, float (&v)[32]) {
#pragma unroll
    for (int i = 0; i < 32; ++i) v[i] = W[(size_t)(k0 + 2 * i + (lane >> 5)) * N + csrc];
}
DI void titem_store_f8(const float (&v)[32], unsigned char* WT, int ldk, LAS float* scr, int k0, int n0, int lane, float qs) {
#pragma unroll
    for (int i = 0; i < 32; ++i) scr[(2 * i + (lane >> 5)) * 33 + (lane & 31)] = v[i] * qs;
    LDS_WAIT(); asm volatile("" ::: "memory");
    const int c = lane & 7;
#pragma unroll
    for (int j = 0; j < 4; ++j) { const int n = (lane >> 3) + 8 * j; const LAS float* s = scr + (8 * c) * 33 + n;
        u32x2 o; o.x = pk4_fp8(s[0 * 33], s[1 * 33], s[2 * 33], s[3 * 33]); o.y = pk4_fp8(s[4 * 33], s[5 * 33], s[6 * 33], s[7 * 33]);
        *(u32x2*)(WT + (size_t)(n0 + n) * ldk + k0 + 8 * c) = o; }
    LDS_WAIT(); asm volatile("" ::: "memory");
}
template <bool W1>
DI void convert_family_f8(const float* src, unsigned char* dst, int N, int nmat, LAS float* scr, int gw, int NGW, int lane) {
    const int nbn = N / 32, ipm = 16 * nbn, total = nmat * ipm;
    float va[32], vb[32];
#define TF_DECODE(it, j_, k0_, n0_, cs_) const int j_ = (it) / ipm, q_##j_ = (it) % ipm, k0_ = 64 * (q_##j_ / nbn), n0_ = 32 * (q_##j_ % nbn), cs_ = W1 ? cmap_w1(n0_ + (lane & 31)) : n0_ + (lane & 31)
    int it = gw;
    if (it < total) { TF_DECODE(it, j0, k00, n00, cs0); titem_load(src + (size_t)j0 * 1024 * N, N, k00, cs0, lane, va); }
    while (it < total) {
        const int it2 = it + NGW;
        if (it2 < total) { TF_DECODE(it2, j2, k02, n02, cs2); titem_load(src + (size_t)j2 * 1024 * N, N, k02, cs2, lane, vb); }
        { TF_DECODE(it, j1, k01, n01, cs1); (void)cs1; titem_store_f8(va, dst + (size_t)j1 * N * 1024, 1024, scr, k01, n01, lane, 64.0f); }
        const int it3 = it2 + NGW;
        if (it3 < total) { TF_DECODE(it3, j3, k03, n03, cs3); titem_load(src + (size_t)j3 * 1024 * N, N, k03, cs3, lane, va); }
        if (it2 < total) { TF_DECODE(it2, j4, k04, n04, cs4); (void)cs4; titem_store_f8(vb, dst + (size_t)j4 * N * 1024, 1024, scr, k04, n04, lane, 64.0f); }
        it = it3;
    }
#undef TF_DECODE
}
DI void sincos_d(double x, float& s, float& c) {
    const double kd = __builtin_rint(x * 0.6366197723675814); const int k = (int)kd;
    double r = __builtin_fma(-kd, 1.5707963267948966, x); r = __builtin_fma(-kd, 6.123233995736766e-17, r);
    const double r2 = r * r;
    const double sp = r * (1.0 + r2 * (-1.0 / 6 + r2 * (1.0 / 120 + r2 * (-1.0 / 5040 + r2 * (1.0 / 362880 + r2 * (-1.0 / 39916800 + r2 * (1.0 / 6227020800.0)))))));
    const double cp = 1.0 + r2 * (-0.5 + r2 * (1.0 / 24 + r2 * (-1.0 / 720 + r2 * (1.0 / 40320 + r2 * (-1.0 / 3628800 + r2 * (1.0 / 479001600.0 + r2 * (-1.0 / 87178291200.0)))))));
    const int q = k & 3;
    const double ss = (q == 0) ? sp : (q == 1) ? cp : (q == 2) ? -sp : -cp;
    const double cc = (q == 0) ? cp : (q == 1) ? -sp : (q == 2) ? -cp : sp;
    s = (float)ss; c = (float)cc;
}
DI void phase_prologue(const Frame& F) {
    const int tid = F.tid, lane = F.lane, wave = F.wave;
    __syncthreads();
    const float* in_c = KIN_c; const float* in_wada = KIN_w_ada; const float* in_bada = KIN_b_ada; const int* in_pos = KIN_pos;
    if (F.bid < 192) {
        LAS float* cact = (LAS float*)F.lds;
        LAS float* red = (LAS float*)(F.lds + 65536);
        for (int idx = tid; idx < 16 * 1024; idx += 512) { const int b = idx >> 10, k = idx & 1023; const float cv = in_c[idx]; cact[k * 16 + b] = cv * fast_sigmoid(cv); }
        __syncthreads();
        float* MOD = WSP(float, WS_MOD);
        for (int it = F.bid; it < 192; it += F.G) {
            const int l = it / 96, cb = it % 96, col = cb * 64 + lane;
            float acc[16];
#pragma unroll
            for (int b = 0; b < 16; ++b) acc[b] = 0.f;
            const float* wp = in_wada + ((size_t)l * 1024 + wave * 128) * 6144 + col;
#pragma unroll 4
            for (int kk = 0; kk < 128; ++kk) { const float wv = wp[(size_t)kk * 6144]; const LAS f32x4* cp = (const LAS f32x4*)(cact + (wave * 128 + kk) * 16);
#pragma unroll
                for (int q = 0; q < 4; ++q) { const f32x4 cv = cp[q]; acc[4 * q] += cv[0] * wv; acc[4 * q + 1] += cv[1] * wv; acc[4 * q + 2] += cv[2] * wv; acc[4 * q + 3] += cv[3] * wv; } }
#pragma unroll
            for (int b = 0; b < 16; ++b) red[(wave * 16 + b) * 64 + lane] = acc[b];
            __syncthreads();
            for (int o = tid; o < 1024; o += 512) { const int b = o >> 6, ln = o & 63; float s = in_bada[l * 6144 + cb * 64 + ln];
#pragma unroll
                for (int w = 0; w < 8; ++w) s += red[(w * 16 + b) * 64 + ln];
                MOD[((size_t)l * 16 + b) * 6144 + cb * 64 + ln] = s; }
            __syncthreads();
        }
    }
    __syncthreads();
    {
        float* ROPE = WSP(float, WS_ROPE);
        const double r16 = 0.44036660267178046;
        for (int idx = F.bid * 512 + tid; idx < T_TOK * 24; idx += F.G * 512) {
            const int t = idx / 24, i = idx % 24; const int e = (i < 16) ? i : 2 * (i - 16);
            double f = 1.0; for (int j = 0; j < e; ++j) f *= r16;
            float s, c; sincos_d((double)in_pos[t] * f, s, c);
            ROPE[(size_t)t * 48 + 2 * i] = c; ROPE[(size_t)t * 48 + 2 * i + 1] = s;
        }
    }
    {
        LAS float* scr = (LAS float*)(F.lds + wave * 16384);
        const int gw = F.bid * 8 + wave, NGW = F.G * 8;
        constexpr int I_IN = 16 * 200, I_UQ = 4 * 24, I_UKV = 4 * 32, I_WB = 8 * 32, I_WO = 16 * 32, I_W1 = 16 * 64, I_W2 = 16 * 32;
        constexpr int N_IN = 2 * I_IN, N_UQ = 2 * I_UQ, N_UKV = 2 * I_UKV, N_WB = 6 * I_WB, N_WO = 2 * I_WO, N_W1 = 64 * I_W1, N_W2 = 64 * I_W2;
        constexpr int NITEMS = N_IN + N_UQ + N_UKV + N_WB + N_WO;
        (void)N_W1; (void)N_W2;
        for (int it = gw; it < NITEMS; it += NGW) {
            int r = it;
            if (r < N_IN) { const int l = r / I_IN, q = r % I_IN, kb = q / 200, nb = q % 200;
                if (32 * nb < G1_F8_COLS) transpose_item_f8(KIN_w_in + (size_t)l * 1024 * IN_COLS, 1024, IN_COLS, WSP(unsigned char, WS_WIN) + (size_t)l * NP * 2048, 1024, scr, 64 * kb, 32 * nb, cmap_in(32 * nb + (lane & 31)), lane, 64.0f);
                else transpose_item(KIN_w_in + (size_t)l * 1024 * IN_COLS, 1024, IN_COLS, WSP(bf16_t, WS_WIN) + (size_t)l * NP * 1024, 1024, 0, scr, 64 * kb, 32 * nb, cmap_in(32 * nb + (lane & 31)), lane);
                continue; } r -= N_IN;
            if (r < N_UQ) { const int l = r / I_UQ, q = r % I_UQ, kb = q / 24, nb = q % 24;
                transpose_item(KIN_w_uq + (size_t)l * 256 * 768, 256, 768, WSP(bf16_t, WS_WUQ) + (size_t)l * 768 * 256, 256, 0, scr, 64 * kb, 32 * nb, cmap_uq(32 * nb + (lane & 31)), lane); continue; } r -= N_UQ;
            if (r < N_UKV) { const int l = r / I_UKV, q = r % I_UKV, kb = q / 32, nb = q % 32;
                transpose_item(KIN_w_ukv + (size_t)l * 128 * 1024, 128, 1024, WSP(bf16_t, WS_WUKV) + (size_t)l * 1024 * 256, 256, 0, scr, 64 * kb, 32 * nb, 32 * nb + (lane & 31), lane); continue; } r -= N_UKV;
            if (r < N_WB) { const int j = r / I_WB, q = r % I_WB, kb = q / 32, nb = q % 32;
                transpose_item(KIN_w_branch + (size_t)j * 512 * 1024, 512, 1024, WSP(bf16_t, WS_WB) + (size_t)j * 1024 * 512, 512, 0, scr, 64 * kb, 32 * nb, 32 * nb + (lane & 31), lane); continue; } r -= N_WB;
            if (r < N_WO) { const int l = r / I_WO, q = r % I_WO, kb = q / 32, nb = q % 32;
                transpose_item(KIN_w_out + (size_t)l * 1024 * 1024, 1024, 1024, WSP(bf16_t, WS_WOUT) + (size_t)l * 1024 * 1024, 1024, 0, scr, 64 * kb, 32 * nb, 32 * nb + (lane & 31), lane); continue; } r -= N_WO;
            (void)r;
        }
        convert_family_f8<true>(KIN_w1, WSP(unsigned char, WS_W1), 2048, 64, scr, gw, NGW, lane);
#if M2_F8
        convert_family_f8<false>(KIN_w2, WSP(unsigned char, WS_W2), 1024, 64, scr, gw, NGW, lane);
#else
        for (int it = gw; it < 64 * I_W2; it += NGW) { const int j = it / I_W2, q = it % I_W2, kb = q / 32, nb = q % 32;
            transpose_item(KIN_w2 + (size_t)j * 1024 * 1024, 1024, 1024, WSP(bf16_t, WS_W2) + (size_t)j * 1024 * 1024, 1024, 0, scr, 64 * kb, 32 * nb, 32 * nb + (lane & 31), lane); }
#endif
    }
}

DI void phase_norm(const Frame& F, const float* xin, float* xout, bool combine, bool write_x, bool final_, int lnext, int lcomb) {
    const int lane = F.lane, gw = F.bid * 8 + F.wave, NGW = F.G * 8;
    const float* in_fg = KIN_final_g; const float* in_n1 = KIN_norm1_g;
    const float* MOD = WSP(float, WS_MOD); const bf16_t* Y = WSP(bf16_t, WS_Y); const int* SLOTOF = (const int*)(F.ws + WS_ROUTE + RT_SLOTOF); bf16_t* H = WSP(bf16_t, WS_H);
    u32x4 slots = {0u, 0u, 0u, 0u};
    if (combine && gw < T_TOK) slots = *(const u32x4*)(SLOTOF + (size_t)gw * 4);
    for (int t = gw; t < T_TOK; t += NGW) {
        const int b = t >> 11; f32x4 v[4];
#pragma unroll
        for (int i = 0; i < 4; ++i) v[i] = *(const f32x4*)(xin + (size_t)t * 1024 + 4 * lane + 256 * i);
        if (combine) {
            const unsigned s0 = slots.x, s1 = slots.y, s2 = slots.z, s3 = slots.w;
            u32x2 ya[4], yb[4], yc[4], yd[4];
#pragma unroll
            for (int i = 0; i < 4; ++i) { const int co = 4 * lane + 256 * i;
                ya[i] = *(const u32x2*)(Y + (size_t)s0 * 1024 + co); yb[i] = *(const u32x2*)(Y + (size_t)s1 * 1024 + co); yc[i] = *(const u32x2*)(Y + (size_t)s2 * 1024 + co); yd[i] = *(const u32x2*)(Y + (size_t)s3 * 1024 + co); }
            if (t + NGW < T_TOK) slots = *(const u32x4*)(SLOTOF + (size_t)(t + NGW) * 4);
            const float* g2 = MOD + ((size_t)lcomb * 16 + b) * 6144 + 5 * 1024;
#pragma unroll
            for (int i = 0; i < 4; ++i) { const int co = 4 * lane + 256 * i; const u32x2 a = ya[i], bq = yb[i], cq = yc[i], dq = yd[i];
                f32x4 sum = {bf_lo(a.x) + bf_lo(bq.x) + bf_lo(cq.x) + bf_lo(dq.x), bf_hi(a.x) + bf_hi(bq.x) + bf_hi(cq.x) + bf_hi(dq.x),
                             bf_lo(a.y) + bf_lo(bq.y) + bf_lo(cq.y) + bf_lo(dq.y), bf_hi(a.y) + bf_hi(bq.y) + bf_hi(cq.y) + bf_hi(dq.y)};
                v[i] += *(const f32x4*)(g2 + co) * sum; }
            if (write_x) {
#pragma unroll
                for (int i = 0; i < 4; ++i) *(f32x4*)(xout + (size_t)t * 1024 + 4 * lane + 256 * i) = v[i]; }
        }
        float ss = 0.f;
#pragma unroll
        for (int i = 0; i < 4; ++i) ss += (v[i][0] * v[i][0] + v[i][1] * v[i][1]) + (v[i][2] * v[i][2] + v[i][3] * v[i][3]);
        ss = wave_sum(ss); const float r = 1.0f / sqrtf(ss * (1.0f / 1024.0f) + NORM_EPS);
        if (final_) {
#pragma unroll
            for (int i = 0; i < 4; ++i) { const int co = 4 * lane + 256 * i; *(f32x4*)(F.out + (size_t)t * 1024 + co) = v[i] * r * *(const f32x4*)(in_fg + co); }
        } else {
            const float* md = MOD + ((size_t)lnext * 16 + b) * 6144;
#pragma unroll
            for (int i = 0; i < 4; ++i) { const int co = 4 * lane + 256 * i;
                const f32x4 g = *(const f32x4*)(in_n1 + lnext * 1024 + co), sc = *(const f32x4*)(md + 1024 + co), sh = *(const f32x4*)(md + co);
                f32x4 h = v[i] * r * g * (sc + 1.0f) + sh;
                u32x2 w; w.x = pk2(h[0], h[1]); w.y = pk2(h[2], h[3]);
                *(u32x2*)(H + (size_t)t * 1024 + co) = w;
                *(unsigned*)(WSP(unsigned char, WS_HG8) + (size_t)t * 1024 + co) = pk4_fp8(h[0], h[1], h[2], h[3]);
                }
        }
    }
}
DI u32x4 rope8v(u32x4 a, f32x4 c0, f32x4 c1) {
    u32x4 o;
    { const float x1 = bf_lo(a.x), x2 = bf_hi(a.x); o.x = pk2(x1 * c0[0] - x2 * c0[1], x2 * c0[0] + x1 * c0[1]); }
    { const float x1 = bf_lo(a.y), x2 = bf_hi(a.y); o.y = pk2(x1 * c0[2] - x2 * c0[3], x2 * c0[2] + x1 * c0[3]); }
    { const float x1 = bf_lo(a.z), x2 = bf_hi(a.z); o.z = pk2(x1 * c1[0] - x2 * c1[1], x2 * c1[0] + x1 * c1[1]); }
    { const float x1 = bf_lo(a.w), x2 = bf_hi(a.w); o.w = pk2(x1 * c1[2] - x2 * c1[3], x2 * c1[2] + x1 * c1[3]); }
    return o;
}
DI u32x4 rope8(u32x4 a, const float* cs) { return rope8v(a, *(const f32x4*)cs, *(const f32x4*)(cs + 4)); }
DI void unpack8(u32x4 a, float (&v)[8]) { v[0] = bf_lo(a.x); v[1] = bf_hi(a.x); v[2] = bf_lo(a.y); v[3] = bf_hi(a.y); v[4] = bf_lo(a.z); v[5] = bf_hi(a.z); v[6] = bf_lo(a.w); v[7] = bf_hi(a.w); }
DI void phase_post(const Frame& F, int l) {
    const int lane = F.lane, gw = F.bid * 8 + F.wave, NGW = F.G * 8;
    const bf16_t* P = WSP(bf16_t, WS_P); const float* ROPE = WSP(float, WS_ROPE);
    bf16_t *CQ = WSP(bf16_t, WS_CQ), *CKV = WSP(bf16_t, WS_CKV), *KPE = WSP(bf16_t, WS_KPE), *OB = WSP(bf16_t, WS_O3) + (size_t)T_TOK * 512, *QC = WSP(bf16_t, WS_QC), *KC = WSP(bf16_t, WS_KC),
           *VC = WSP(bf16_t, WS_VC), *QI = WSP(bf16_t, WS_QI), *KI = WSP(bf16_t, WS_KI); float* IW = WSP(float, WS_IW);
    const float* cw = KIN_conv_w + (size_t)l * 3 * 512 + 8 * lane;
    f32x4 cwv[3][2];
#pragma unroll
    for (int d = 0; d < 3; ++d) { cwv[d][0] = *(const f32x4*)(cw + d * 512); cwv[d][1] = *(const f32x4*)(cw + d * 512 + 4); }
    const float* in_qn = KIN_q_norm + l * 256 + 8 * (lane & 31); const float* in_kn = KIN_kv_norm + l * 128 + 8 * (lane & 15);
    const f32x4 qn0 = *(const f32x4*)in_qn, qn1 = *(const f32x4*)(in_qn + 4), kn0 = *(const f32x4*)in_kn, kn1 = *(const f32x4*)(in_kn + 4);
    const u32x4 z4 = {0u, 0u, 0u, 0u};
    for (int t = gw; t < T_TOK; t += NGW) {
        const bf16_t* pr = P + (size_t)t * NP; const float* rp = ROPE + (size_t)t * 48; const int s = t & (SEQ - 1);
        const bf16_t* pc = pr + PC_CONV + 8 * lane;
        const u32x4 gbw = *(const u32x4*)pc;
        const u32x4 gc2 = *(const u32x4*)(pc + 512), hc2 = *(const u32x4*)(pc + 1024);
        const u32x4 gc1 = (s >= 1) ? *(const u32x4*)(pc - NP + 512) : z4, hc1 = (s >= 1) ? *(const u32x4*)(pc - NP + 1024) : z4;
        const u32x4 gc0 = (s >= 2) ? *(const u32x4*)(pc - 2 * NP + 512) : z4, hc0 = (s >= 2) ? *(const u32x4*)(pc - 2 * NP + 1024) : z4;
        u32x4 dqw = *(const u32x4*)(pr + PC_DQ + 8 * lane), iqw = *(const u32x4*)(pr + PC_IQ + 8 * lane);
        const u32x4 qlw = *(const u32x4*)(pr + PC_QLAT + 8 * (lane & 31));
        const u32x4 kvw = *(const u32x4*)(pr + PC_KVLAT + 8 * (lane < 20 ? lane : 0));
        u32x4 dkw = *(const u32x4*)(pr + PC_DKV + 8 * (lane & 15));
        u32x4 ikw = *(const u32x4*)(pr + PC_IK + 8 * (lane & 7));
        const u32x4 iww = *(const u32x4*)(pr + PC_IW);
        const f32x4 r16a = *(const f32x4*)(rp + 32 + 8 * (lane & 1)), r16b = *(const f32x4*)(rp + 32 + 8 * (lane & 1) + 4);
        const f32x4 r32a = *(const f32x4*)(rp + 8 * (lane & 3)), r32b = *(const f32x4*)(rp + 8 * (lane & 3) + 4);
        asm volatile("" ::: "memory");
        {
            float gb[8], a0[8], b0[8], a1[8], b1[8], a2[8], b2[8]; unpack8(gbw, gb); unpack8(gc0, a0); unpack8(hc0, b0); unpack8(gc1, a1); unpack8(hc1, b1); unpack8(gc2, a2); unpack8(hc2, b2);
            float o[8];
#pragma unroll
            for (int i = 0; i < 8; ++i) { const float w0 = cwv[0][i >> 2][i & 3], w1 = cwv[1][i >> 2][i & 3], w2 = cwv[2][i >> 2][i & 3]; o[i] = gb[i] * (w0 * (a0[i] * b0[i]) + w1 * (a1[i] * b1[i]) + w2 * (a2[i] * b2[i])); }
            u32x4 ow; ow.x = pk2(o[0], o[1]); ow.y = pk2(o[2], o[3]); ow.z = pk2(o[4], o[5]); ow.w = pk2(o[6], o[7]);
            *(u32x4*)(OB + (size_t)t * 512 + 8 * lane) = ow;
        }
        if ((lane & 7) < 2) { dqw = rope8v(dqw, r16a, r16b); iqw = rope8v(iqw, r16a, r16b); }
        *(u32x4*)(QC + (size_t)t * 512 + 8 * lane) = dqw; *(u32x4*)(QI + (size_t)t * 512 + 8 * lane) = iqw;
        float ql[8], kv[8]; unpack8(qlw, ql); unpack8(kvw, kv);
        float ss1 = 0.f, ss2 = 0.f;
        if (lane < 32) {
#pragma unroll
            for (int i = 0; i < 8; ++i) ss1 += ql[i] * ql[i]; }
        if (lane < 16) {
#pragma unroll
            for (int i = 0; i < 8; ++i) ss2 += kv[i] * kv[i]; }
#pragma unroll
        for (int o = 1; o < 64; o <<= 1) { ss1 += __shfl_xor(ss1, o); ss2 += __shfl_xor(ss2, o); }
        const float r1 = 1.0f / sqrtf(ss1 * (1.0f / 256.0f) + NORM_EPS), r2 = 1.0f / sqrtf(ss2 * (1.0f / 128.0f) + NORM_EPS);
        if (lane < 32) { u32x4 o; o.x = pk2(ql[0] * r1 * qn0[0], ql[1] * r1 * qn0[1]); o.y = pk2(ql[2] * r1 * qn0[2], ql[3] * r1 * qn0[3]); o.z = pk2(ql[4] * r1 * qn1[0], ql[5] * r1 * qn1[1]); o.w = pk2(ql[6] * r1 * qn1[2], ql[7] * r1 * qn1[3]);
            *(u32x4*)(CQ + (size_t)t * 256 + 8 * lane) = o;
            u32x4 k = z4; if (lane < 16) { k.x = pk2(kv[0] * r2 * kn0[0], kv[1] * r2 * kn0[1]); k.y = pk2(kv[2] * r2 * kn0[2], kv[3] * r2 * kn0[3]); k.z = pk2(kv[4] * r2 * kn1[0], kv[5] * r2 * kn1[1]); k.w = pk2(kv[6] * r2 * kn1[2], kv[7] * r2 * kn1[3]); }
            *(u32x4*)(CKV + (size_t)t * 256 + 8 * lane) = k; }
        if (lane >= 16 && lane < 20) *(u32x4*)(KPE + (size_t)t * 32 + 8 * (lane - 16)) = rope8v(kvw, r32a, r32b);
        if (lane < 16) { if (lane < 2) dkw = rope8v(dkw, r16a, r16b); if (lane < 8) *(u32x4*)(KC + (size_t)t * 64 + 8 * lane) = dkw; else *(u32x4*)(VC + (size_t)t * 64 + 8 * (lane - 8)) = dkw; }
        if (lane >= 16 && lane < 24) { const int c = lane - 16; if (c < 2) ikw = rope8v(ikw, r16a, r16b); *(u32x4*)(KI + (size_t)t * 64 + 8 * c) = ikw; }
        if (lane == 32) { float v[8]; unpack8(iww, v); *(f32x4*)(IW + (size_t)t * 8) = (f32x4){v[0], v[1], v[2], v[3]}; *(f32x4*)(IW + (size_t)t * 8 + 4) = (f32x4){v[4], v[5], v[6], v[7]}; }
    }
}

DI int crow(int r, int hi) { return (r & 3) + 8 * (r >> 2) + 4 * hi; }
#define MFMA32(a, b, c) __builtin_amdgcn_mfma_f32_32x32x16_bf16((a), (b), (c), 0, 0, 0)
#define MFMA16(a, b, c) __builtin_amdgcn_mfma_f32_16x16x32_bf16((a), (b), (c), 0, 0, 0)
#define GLDS16(src, dst) __builtin_amdgcn_global_load_lds((const unsigned*)(src), (LAS unsigned*)(dst), 16, 0, 0)
typedef short v4i16_t __attribute__((ext_vector_type(4)));
DI s16x4 tr_read(const LAS unsigned char* p) { return __builtin_bit_cast(s16x4, __builtin_amdgcn_ds_read_tr16_b64_v4i16((LAS v4i16_t*)p)); }
DI bf16x8 pack8(float a0, float a1, float a2, float a3, float a4, float a5, float a6, float a7) { u32x4 w; w.x = pk2(a0, a1); w.y = pk2(a2, a3); w.z = pk2(a4, a5); w.w = pk2(a6, a7); return __builtin_bit_cast(bf16x8, w); }
DI bf16x8 cat4(s16x4 lo, s16x4 hi) { return (bf16x8){lo[0], lo[1], lo[2], lo[3], hi[0], hi[1], hi[2], hi[3]}; }

constexpr int MLA_K0 = 0, MLA_V0 = 24576, MLA_WS = 49152;
DI void mla_unit(const Frame& F, int b, int h, int qb) {
    const int lane = F.lane, wid = F.wave, r32 = lane & 31, hi = lane >> 5;
    const bf16_t* QA = WSP(bf16_t, WS_QA); const bf16_t* KPE = WSP(bf16_t, WS_KPE); const bf16_t* KV = WSP(bf16_t, WS_KV); bf16_t* OA = WSP(bf16_t, WS_O3);
    const size_t tb = (size_t)b * SEQ; const int q0 = qb * 256, qrow = q0 + 32 * wid + r32;
    const float C2 = 0.10206207261596577f * 1.4426950408889634f;
    LAS unsigned char* lds = F.lds; LAS float* wsf = (LAS float*)(lds + MLA_WS) + wid * 128;
    bf16x8 qr[6];
#pragma unroll
    for (int d0 = 0; d0 < 6; ++d0) qr[d0] = *(const bf16x8*)(QA + (tb + qrow) * 768 + h * 96 + d0 * 16 + hi * 8);
    {
        const float* rp = WSP(float, WS_ROPE) + (tb + qrow) * 48;
        qr[0] = __builtin_bit_cast(bf16x8, rope8(__builtin_bit_cast(u32x4, qr[0]), rp + 8 * hi));
        qr[1] = __builtin_bit_cast(bf16x8, rope8(__builtin_bit_cast(u32x4, qr[1]), rp + 16 + 8 * hi)); }
    const int NT = 4 * (qb + 1);
    const unsigned vo_pe = (unsigned)(lane * 32 + 8 * (wid & 3)) * 2u, vo_k0 = (unsigned)(lane * 1024 + 128 * h + 8 * ((wid + 4) & 7)) * 2u, vo_k1 = (unsigned)(lane * 1024 + 128 * h + 8 * (wid + 4)) * 2u,
                   vo_v = (unsigned)((16 * (wid & 3) + (lane >> 2)) * 1024 + 128 * h + 64 + 32 * (wid >> 2) + 8 * (lane & 3)) * 2u;
    const unsigned ldsb = (unsigned)(unsigned long long)lds;
    const char* pe_b = pg8::uni_ptr((const char*)(KPE + tb * 32)); const char* kv_b = pg8::uni_ptr((const char*)(KV + tb * 1024));
#define MLA_STAGE(kt, buf, vslot) do { const char* pe_ = pe_b + (size_t)(kt) * (64 * 32 * 2); const char* kv_ = kv_b + (size_t)(kt) * (64 * 1024 * 2); \
        if (wid < 4) { pg8::glds16_s(vo_pe, pe_, ldsb + MLA_K0 + (buf) * 12288 + wid * 1024); pg8::glds16_s(vo_k1, kv_, ldsb + MLA_K0 + (buf) * 12288 + (wid + 8) * 1024); } \
        else { pg8::glds16_s(vo_k0, kv_, ldsb + MLA_K0 + (buf) * 12288 + wid * 1024); } \
        pg8::glds16_s(vo_v, kv_, ldsb + MLA_V0 + (vslot) * 8192 + wid * 1024); } while (0)
    MLA_STAGE(0, 0, 0);
    float m = -1e30f, l = 0.f; f32x16 o[2];
#pragma unroll
    for (int r = 0; r < 16; ++r) { o[0][r] = 0.f; o[1][r] = 0.f; }
    const int vboff = ((lane >> 4) & 1) * 32 + (lane & 3) * 8 + (4 * hi + ((lane & 15) >> 2)) * 64;
    const bool upper = wid >= 4; bool have_prev = false; bf16x8 pa[4];
#define MLA_PV(vs) do { const LAS unsigned char* vb_ = lds + MLA_V0 + (vs) * 8192 + vboff; \
        _Pragma("unroll") for (int d0 = 0; d0 < 2; ++d0) _Pragma("unroll") for (int ks = 0; ks < 4; ++ks) { \
            const s16x4 lo_ = tr_read(vb_ + d0 * 4096 + ks * 1024), hh_ = tr_read(vb_ + d0 * 4096 + ks * 1024 + 512); o[d0] = MFMA32(pa[ks], cat4(lo_, hh_), o[d0]); } } while (0)
    int vs_cur = 0, vs_prev = 0;
    for (int kt = 0; kt < NT; ++kt) {
        const int buf = kt & 1; const int vs_next = (vs_cur == 2) ? 0 : vs_cur + 1;
        VM_WAIT(); __syncthreads();
        if (kt + 1 < NT) MLA_STAGE(kt + 1, buf ^ 1, vs_next);
        if (upper && have_prev) { MLA_PV(vs_prev); have_prev = false; }
        if (64 * kt <= q0 + 32 * wid + 31) {
            f32x16 p0, p1;
#pragma unroll
            for (int r = 0; r < 16; ++r) { p0[r] = 0.f; p1[r] = 0.f; }
            const LAS unsigned char* kb = lds + MLA_K0 + buf * 12288 + hi * 1024 + r32 * 16;
#pragma unroll
            for (int d0 = 0; d0 < 6; ++d0) { const bf16x8 b0 = *(const LAS bf16x8*)(kb + d0 * 2048), b1 = *(const LAS bf16x8*)(kb + d0 * 2048 + 512);
                p0 = MFMA32(b0, qr[d0], p0); p1 = MFMA32(b1, qr[d0], p1); }
            if (64 * kt + 63 > q0 + 32 * wid) {
#pragma unroll
                for (int r = 0; r < 16; ++r) { const int kv = 64 * kt + crow(r, hi); if (kv > qrow) p0[r] = -INFINITY; if (kv + 32 > qrow) p1[r] = -INFINITY; } }
            float rm = fmaxf(p0[0], p1[0]);
#pragma unroll
            for (int r = 1; r < 16; ++r) rm = fmaxf(rm, fmaxf(p0[r], p1[r]));
            rm = fmaxf(rm, __shfl_xor(rm, 32));
            const float mn = fmaxf(m, rm);
            if (__any(mn > m)) {
                const float alpha = __builtin_amdgcn_exp2f((m - mn) * C2); l *= alpha; m = mn;
                if (hi == 0) wsf[r32] = alpha;
                LDS_WAIT();
#pragma unroll
                for (int q = 0; q < 4; ++q) { const f32x4 a = *(const LAS f32x4*)(wsf + 8 * q + 4 * hi);
#pragma unroll
                    for (int j = 0; j < 4; ++j) { o[0][4 * q + j] *= a[j]; o[1][4 * q + j] *= a[j]; } }
            }
            const float mc = m * C2; float ls = 0.f;
#pragma unroll
            for (int r = 0; r < 16; ++r) { p0[r] = __builtin_amdgcn_exp2f(__builtin_fmaf(p0[r], C2, -mc)); p1[r] = __builtin_amdgcn_exp2f(__builtin_fmaf(p1[r], C2, -mc)); ls += p0[r] + p1[r]; }
            l += ls;
            pa[0] = pack8(p0[0], p0[1], p0[2], p0[3], p0[4], p0[5], p0[6], p0[7]); pa[1] = pack8(p0[8], p0[9], p0[10], p0[11], p0[12], p0[13], p0[14], p0[15]);
            pa[2] = pack8(p1[0], p1[1], p1[2], p1[3], p1[4], p1[5], p1[6], p1[7]); pa[3] = pack8(p1[8], p1[9], p1[10], p1[11], p1[12], p1[13], p1[14], p1[15]);
            if (upper) have_prev = true; else MLA_PV(vs_cur);
        }
        vs_prev = vs_cur; vs_cur = vs_next;
    }
    if (upper && have_prev) MLA_PV(vs_prev);
#undef MLA_PV
#undef MLA_STAGE
    l += __shfl_xor(l, 32);
    if (hi == 0) wsf[64 + r32] = 1.0f / l;
    LDS_WAIT();
    bf16_t* orow = OA + (tb + q0 + 32 * wid) * 512 + h * 64 + r32;
#pragma unroll
    for (int q = 0; q < 4; ++q) { const f32x4 a = *(const LAS f32x4*)(wsf + 64 + 8 * q + 4 * hi);
#pragma unroll
        for (int j = 0; j < 4; ++j) { const int r = 4 * q + j, rr = crow(r, hi);
            orow[(size_t)rr * 512] = (bf16_t)(pk2(o[0][r] * a[j], 0.f) & 0xffffu); orow[(size_t)rr * 512 + 32] = (bf16_t)(pk2(o[1][r] * a[j], 0.f) & 0xffffu); } }
    __syncthreads();
}

constexpr int DSA_SCW = 2052;
constexpr int DSA_SEL = 16 * DSA_SCW * 4;
DI int mbcnt64(unsigned long long m) { return (int)__builtin_amdgcn_mbcnt_hi((unsigned)(m >> 32), __builtin_amdgcn_mbcnt_lo((unsigned)m, 0u)); }
DI void dsa_unit(const Frame& F, int b, int qt) {
    const int tid = F.tid, lane = F.lane, wid = F.wave, fr = lane & 15, g = lane >> 4;
    const bf16_t *QI = WSP(bf16_t, WS_QI), *KI = WSP(bf16_t, WS_KI), *QC = WSP(bf16_t, WS_QC), *KC = WSP(bf16_t, WS_KC), *VC = WSP(bf16_t, WS_VC); const float* IW = WSP(float, WS_IW);
    bf16_t* OC = WSP(bf16_t, WS_O3) + (size_t)2 * T_TOK * 512;
    const size_t tb = (size_t)b * SEQ; const int t0 = 16 * qt;
    LAS unsigned char* lds = F.lds; LAS float* SC = (LAS float*)lds; LAS unsigned long long* BITS = (LAS unsigned long long*)(lds + DSA_SEL);
    {
        bf16x8 qf[8][2]; float wv[8];
        const bf16_t* qp = QI + (tb + t0 + fr) * 512 + 8 * g;
#pragma unroll
        for (int h = 0; h < 8; ++h) { qf[h][0] = *(const bf16x8*)(qp + h * 64); qf[h][1] = *(const bf16x8*)(qp + h * 64 + 32); }
        { const f32x4 w0 = *(const f32x4*)(IW + (tb + t0 + fr) * 8), w1 = *(const f32x4*)(IW + (tb + t0 + fr) * 8 + 4); wv[0] = w0[0]; wv[1] = w0[1]; wv[2] = w0[2]; wv[3] = w0[3]; wv[4] = w1[0]; wv[5] = w1[1]; wv[6] = w1[2]; wv[7] = w1[3]; }
        const bf16_t* kbase = KI + (tb + fr) * 64 + 8 * g;
        const bf16x8 z8 = {0, 0, 0, 0, 0, 0, 0, 0};
        bf16x8 a0 = z8, a1 = z8, b0 = z8, b1 = z8, c0 = z8, c1 = z8;
        if (wid <= qt) { a0 = *(const bf16x8*)(kbase + (size_t)wid * 1024); a1 = *(const bf16x8*)(kbase + (size_t)wid * 1024 + 32); }
        if (wid + 8 <= qt) { b0 = *(const bf16x8*)(kbase + (size_t)(wid + 8) * 1024); b1 = *(const bf16x8*)(kbase + (size_t)(wid + 8) * 1024 + 32); }
        if (wid + 16 <= qt) { c0 = *(const bf16x8*)(kbase + (size_t)(wid + 16) * 1024); c1 = *(const bf16x8*)(kbase + (size_t)(wid + 16) * 1024 + 32); }
        for (int kt = wid; kt <= qt; kt += 8) {
            bf16x8 n0 = z8, n1 = z8;
            if (kt + 24 <= qt) { n0 = *(const bf16x8*)(kbase + (size_t)(kt + 24) * 1024); n1 = *(const bf16x8*)(kbase + (size_t)(kt + 24) * 1024 + 32); }
            f32x4 s = {F.zf, F.zf, F.zf, F.zf};
#pragma unroll
            for (int h = 0; h < 8; ++h) { f32x4 acc = {F.zf, F.zf, F.zf, F.zf}; acc = MFMA16(a0, qf[h][0], acc); acc = MFMA16(a1, qf[h][1], acc);
#pragma unroll
                for (int r = 0; r < 4; ++r) s[r] += fmaxf(acc[r], 0.f) * wv[h]; }
#pragma unroll
            for (int r = 0; r < 4; ++r) if (16 * kt + 4 * g + r > t0 + fr) s[r] = -INFINITY;
            *(LAS f32x4*)(SC + fr * DSA_SCW + 16 * kt + 4 * g) = s;
            a0 = b0; a1 = b1; b0 = c0; b1 = c1; c0 = n0; c1 = n1;
        }
    }
    __syncthreads();
    for (int qi2 = 0; qi2 < 2; ++qi2) {
        const int qq = 2 * wid + qi2, t = t0 + qq, nvalid = t + 1;
        LAS unsigned long long* bits = BITS + qq * 32;
        if (nvalid <= 256) { if (lane < 32) { const int k0 = 64 * lane; bits[lane] = (k0 + 63 <= t) ? ~0ull : (k0 <= t) ? ((1ull << (t - k0 + 1)) - 1ull) : 0ull; } }
        else {
            const int nq = (nvalid + 511) >> 9;
            float v[32];
#pragma unroll
            for (int i = 0; i < 32; ++i) { const int key = i * 64 + lane; v[i] = (key <= t) ? SC[qq * DSA_SCW + key] : -INFINITY; }
            float vmax = v[0], vmin = (v[0] == -INFINITY) ? INFINITY : v[0];
#pragma unroll
            for (int i = 1; i < 32; ++i) { vmax = fmaxf(vmax, v[i]); vmin = fminf(vmin, (v[i] == -INFINITY) ? INFINITY : v[i]); }
#pragma unroll
            for (int o = 1; o < 64; o <<= 1) { vmax = fmaxf(vmax, __shfl_xor(vmax, o)); vmin = fminf(vmin, __shfl_xor(vmin, o)); }
#define DSA_COUNT(thr, OP, out) do { int c_ = 0; _Pragma("unroll") for (int qd = 0; qd < 4; ++qd) { if (qd < nq) { _Pragma("unroll") for (int i = 0; i < 8; ++i) c_ += (v[8 * qd + i] OP (thr)) ? 1 : 0; } } \
                int tot_ = 0; _Pragma("unroll") for (int b_ = 0; b_ < 6; ++b_) tot_ += __builtin_popcountll(__ballot((c_ >> b_) & 1)) << b_; out = tot_; } while (0)
            float lo = vmin, hi = vmax, K; int cnt;
            DSA_COUNT(hi, >=, cnt);
            if (cnt >= 256) { K = hi; }
            else {
                int clo = nvalid, chi = cnt;
                for (int it = 0;; ++it) {
                    float fr_ = 0.5f;
                    if ((it & 1) == 0) { fr_ = ((float)(clo - 256) + 0.5f) / (float)(clo - chi); fr_ = fminf(fmaxf(fr_, 0.03125f), 0.96875f); }
                    const float mid = lo + (hi - lo) * fr_;
                    if (!(mid > lo && mid < hi)) {
                        const float mid2 = lo + (hi - lo) * 0.5f;
                        if (!(mid2 > lo && mid2 < hi)) { K = lo; cnt = clo; break; }
                        DSA_COUNT(mid2, >=, cnt);
                        if (cnt == 256) { K = mid2; break; }
                        if (cnt > 256) { lo = mid2; clo = cnt; } else { hi = mid2; chi = cnt; }
                        continue;
                    }
                    DSA_COUNT(mid, >=, cnt);
                    if (cnt == 256) { K = mid; break; }
                    if (cnt > 256) { lo = mid; clo = cnt; } else { hi = mid; chi = cnt; }
                }
            }
            if (cnt == 256) {
#pragma unroll
                for (int qd = 0; qd < 4; ++qd) {
#pragma unroll
                    for (int i8 = 0; i8 < 8; ++i8) { const int i = 8 * qd + i8; const unsigned long long mt = (qd < nq) ? __ballot(v[i] >= K) : 0ull; if (lane == 0) bits[i] = mt; } }
            } else {
                int cgt; DSA_COUNT(K, >, cgt);
                const int need = 256 - cgt; int eqb = 0;
#pragma unroll
                for (int qd = 0; qd < 4; ++qd) {
#pragma unroll
                    for (int i8 = 0; i8 < 8; ++i8) { const int i = 8 * qd + i8; unsigned long long mt = 0ull;
                        if (qd < nq) { const bool gt = v[i] > K, eq = v[i] == K; const unsigned long long me = __ballot(eq); const int erank = eqb + mbcnt64(me);
                            mt = __ballot(gt || (eq && erank < need)); eqb += __builtin_popcountll(me); }
                        if (lane == 0) bits[i] = mt; } }
            }
#undef DSA_COUNT
        }
    }
    __syncthreads();
    {
        const float C2S = 0.125f * 1.4426950408889634f;
        int lane3 = lane; asm volatile("" : "+v"(lane3));
        const int r32 = lane3 & 31, hi = lane3 >> 5, cg = wid & 3, kp = wid >> 2;
        const int NT = (t0 + 16 + 63) >> 6, NS = (NT + 1) >> 1;
        const int qloc = 4 * cg + (r32 >> 3);
        LAS float* wsf = (LAS float*)(lds + 65536) + wid * 128;
        LAS float* OW = (LAS float*)(lds + 69632); LAS float* ML2 = (LAS float*)(lds + 69632 + 32768);
        bf16x8 qr[4];
#pragma unroll
        for (int d0 = 0; d0 < 4; ++d0) qr[d0] = *(const bf16x8*)(QC + (tb + t0 + qloc) * 512 + (r32 & 7) * 64 + d0 * 16 + hi * 8);
        const unsigned vo_kc = (unsigned)(lane3 * 64 + 8 * wid) * 2u, vo_vc = (unsigned)((16 * (wid & 3) + (lane3 >> 2)) * 64 + 32 * (wid >> 2) + 8 * (lane3 & 3)) * 2u, ldsb = (unsigned)(unsigned long long)lds;
        const char* kc_b = pg8::uni_ptr((const char*)(KC + tb * 64)); const char* vc_b = pg8::uni_ptr((const char*)(VC + tb * 64));
#define DSD_STAGE(j, buf) do { _Pragma("unroll") for (int par_ = 0; par_ < 2; ++par_) { const int kt_ = 2 * (j) + par_; if (kt_ < NT) { \
            const unsigned d_ = ldsb + (buf) * 32768 + par_ * 16384; \
            pg8::glds16_s(vo_kc, kc_b + (size_t)kt_ * (64 * 64 * 2), d_ + wid * 1024); pg8::glds16_s(vo_vc, vc_b + (size_t)kt_ * (64 * 64 * 2), d_ + 8192 + wid * 1024); } } } while (0)
        DSD_STAGE(0, 0);
        float m = -1e30f, l = 0.f; f32x16 o[2];
#pragma unroll
        for (int r = 0; r < 16; ++r) { o[0][r] = F.zf; o[1][r] = F.zf; }
        const int vboff = ((lane3 >> 4) & 1) * 32 + (lane3 & 3) * 8 + (4 * hi + ((lane3 & 15) >> 2)) * 64;
        for (int j = 0; j < NS; ++j) {
            const int buf = j & 1, kt = 2 * j + kp;
            VM_WAIT(); __syncthreads();
            if (j + 1 < NS) DSD_STAGE(j + 1, buf ^ 1);
            if (kt < NT) {
                const LAS unsigned char* tile = lds + buf * 32768 + kp * 16384;
                f32x16 p0, p1;
#pragma unroll
                for (int r = 0; r < 16; ++r) { p0[r] = F.zf; p1[r] = F.zf; }
                const LAS unsigned char* kb = tile + hi * 1024 + r32 * 16;
#pragma unroll
                for (int d0 = 0; d0 < 4; ++d0) { const bf16x8 b0 = *(const LAS bf16x8*)(kb + d0 * 2048), b1 = *(const LAS bf16x8*)(kb + d0 * 2048 + 512);
                    p0 = MFMA32(b0, qr[d0], p0); p1 = MFMA32(b1, qr[d0], p1); }
                float rm = fmaxf(p0[0], p1[0]);
#pragma unroll
                for (int r = 1; r < 16; ++r) rm = fmaxf(rm, fmaxf(p0[r], p1[r]));
                rm = fmaxf(rm, __shfl_xor(rm, 32));
                const float mn = fmaxf(m, rm);
                if (__any(mn > m)) {
                    const float alpha = __builtin_amdgcn_exp2f((m - mn) * C2S); l *= alpha; m = mn;
                    if (hi == 0) wsf[r32] = alpha;
                    LDS_WAIT();
#pragma unroll
                    for (int q = 0; q < 4; ++q) { const f32x4 a = *(const LAS f32x4*)(wsf + 8 * q + 4 * hi);
#pragma unroll
                        for (int jj = 0; jj < 4; ++jj) { o[0][4 * q + jj] *= a[jj]; o[1][4 * q + jj] *= a[jj]; } }
                }
                const unsigned long long bw = BITS[qloc * 32 + kt];
                const unsigned wl = (unsigned)bw >> (4 * hi), wh = (unsigned)(bw >> 32) >> (4 * hi);
                const float mc = m * C2S; float ls = 0.f;
#pragma unroll
                for (int r = 0; r < 16; ++r) { const int c = (r & 3) + 8 * (r >> 2);
                    const int m0 = ((int)(wl << (31 - c))) >> 31, m1 = ((int)(wh << (31 - c))) >> 31;
                    p0[r] = __uint_as_float(__float_as_uint(__builtin_amdgcn_exp2f(__builtin_fmaf(p0[r], C2S, -mc))) & (unsigned)m0);
                    p1[r] = __uint_as_float(__float_as_uint(__builtin_amdgcn_exp2f(__builtin_fmaf(p1[r], C2S, -mc))) & (unsigned)m1);
                    ls += p0[r] + p1[r]; }
                l += ls;
                bf16x8 pa[4];
                pa[0] = pack8(p0[0], p0[1], p0[2], p0[3], p0[4], p0[5], p0[6], p0[7]); pa[1] = pack8(p0[8], p0[9], p0[10], p0[11], p0[12], p0[13], p0[14], p0[15]);
                pa[2] = pack8(p1[0], p1[1], p1[2], p1[3], p1[4], p1[5], p1[6], p1[7]); pa[3] = pack8(p1[8], p1[9], p1[10], p1[11], p1[12], p1[13], p1[14], p1[15]);
                const LAS unsigned char* vb = tile + 8192 + vboff;
#pragma unroll
                for (int d0 = 0; d0 < 2; ++d0)
#pragma unroll
                    for (int ks = 0; ks < 4; ++ks) { const s16x4 lo = tr_read(vb + d0 * 4096 + ks * 1024), hh = tr_read(vb + d0 * 4096 + ks * 1024 + 512);
                        o[d0] = MFMA32(pa[ks], cat4(lo, hh), o[d0]); }
            }
        }
#undef DSD_STAGE
        l += __shfl_xor(l, 32);
        __syncthreads();
        if (kp == 1) {
            LAS float* ow = OW + cg * 2048;
#pragma unroll
            for (int r = 0; r < 16; ++r) { const int row = crow(r, hi); ow[row * 64 + r32] = o[0][r]; ow[row * 64 + 32 + r32] = o[1][r]; }
            if (hi == 0) { ML2[cg * 64 + r32] = m; ML2[cg * 64 + 32 + r32] = l; }
        }
        __syncthreads();
        if (kp == 0) {
            const float m2 = ML2[cg * 64 + r32], l2 = ML2[cg * 64 + 32 + r32];
            const float M = fmaxf(m, m2), a1 = __builtin_amdgcn_exp2f((m - M) * C2S), a2 = __builtin_amdgcn_exp2f((m2 - M) * C2S);
            const float linv = 1.0f / (a1 * l + a2 * l2);
            if (hi == 0) { wsf[r32] = a1 * linv; wsf[32 + r32] = a2 * linv; }
            LDS_WAIT();
            const LAS float* ow = OW + cg * 2048;
            bf16_t* op = OC + (tb + t0 + 4 * cg) * 512 + r32;
#pragma unroll
            for (int q = 0; q < 4; ++q) { const f32x4 s1 = *(const LAS f32x4*)(wsf + 8 * q + 4 * hi), s2 = *(const LAS f32x4*)(wsf + 32 + 8 * q + 4 * hi);
#pragma unroll
                for (int jj = 0; jj < 4; ++jj) { const int r = 4 * q + jj, row = crow(r, hi);
                    const float v0 = o[0][r] * s1[jj] + ow[row * 64 + r32] * s2[jj], v1 = o[1][r] * s1[jj] + ow[row * 64 + 32 + r32] * s2[jj];
                    bf16_t* dst = op + (size_t)(row >> 3) * 512 + (row & 7) * 64;
                    dst[0] = (bf16_t)(pk2(v0, 0.f) & 0xffffu); dst[32] = (bf16_t)(pk2(v1, 0.f) & 0xffffu); } }
        }
    }
    __syncthreads();
}
DI void attention_mla_units(const Frame& F, int rep_a) {
    for (int rep = 0; rep < rep_a; ++rep)
    for (int U = F.bid; U < 1024; U += F.G) { const int i = U >> 8, cp = U & 255, half = cp >> 7, rem = cp & 127; mla_unit(F, rem & 15, rem >> 4, 2 * i + (half ^ (i & 1))); }
}
DI void attention_dsa_units(const Frame& F, int rep_c) {
    for (int rep = 0; rep < rep_c; ++rep)
    for (int U = F.bid; U < 2048; U += F.G) { const int i = U >> 8, cp = U & 255; dsa_unit(F, cp & 15, 16 * i + (cp >> 4)); }
}
DI void phase_attention(const Frame& F, int rep_a, int rep_c) {
    if (F.bid & 1) { attention_dsa_units(F, rep_c); __syncthreads(); attention_mla_units(F, rep_a); }
    else { attention_mla_units(F, rep_a); __syncthreads(); attention_dsa_units(F, rep_c); }
}

constexpr int N2_WROW = 1032;
constexpr int N2_WH = 0, N2_WL = 32 * N2_WROW * 2, N2_CB = 2 * N2_WL, N2_PART = N2_CB + 128, N2_LGT = N2_PART + 2048, N2_RST = N2_LGT + 8 * 2304, N2_CNT = N2_RST + 512, N2_BASE = N2_CNT + 128, N2_TOK = N2_BASE + 128;
static_assert(N2_TOK + 2048 <= MISC_OFF, "router LDS map");
DI void phase_router(const Frame& F, int l, int cset) {
    const int tid = F.tid, lane = F.lane, wave = F.wave, fr = lane & 15, g = lane >> 4;
    LAS unsigned char* lds = F.lds;
    LAS bf16_t* WH = (LAS bf16_t*)(lds + N2_WH); LAS bf16_t* WL = (LAS bf16_t*)(lds + N2_WL); LAS float* CB = (LAS float*)(lds + N2_CB); LAS float* PART = (LAS float*)(lds + N2_PART);
    LAS float* LGT = (LAS float*)(lds + N2_LGT) + wave * 576; LAS float* RST = (LAS float*)(lds + N2_RST) + wave * 16;
    LAS int* CNT = (LAS int*)(lds + N2_CNT); LAS int* BASE = (LAS int*)(lds + N2_BASE); LAS int* TOKR = (LAS int*)(lds + N2_TOK);
    const float* X1 = WSP(float, WS_X1); const float* MOD = WSP(float, WS_MOD); unsigned char* H8 = WSP(unsigned char, WS_H8);
    const float* in_n2 = KIN_norm2_g + l * 1024; const float* in_rb = KIN_router_b + l * 32; const float* in_rw = KIN_router_w + (size_t)l * 32768;
    int* TOPE = (int*)(F.ws + WS_ROUTE + RT_TOPE); float* TOPG = (float*)(F.ws + WS_ROUTE + RT_TOPG); int* RANK = (int*)(F.ws + WS_ROUTE + RT_RANK);
    for (int chunk = F.bid; chunk < T_TOK / 128; chunk += F.G) {
        const int b = chunk >> 4; const float* md = MOD + ((size_t)l * 16 + b) * 6144;
        __syncthreads();
        { float cp = 0.f;
          for (int idx = tid; idx < 32 * 1024; idx += 512) { const int k = idx >> 5, e = idx & 31; const float w = in_rw[idx]; const float wp = w * (in_n2[k] * (1.0f + md[4 * 1024 + k]));
              const unsigned hw = pk2(wp, 0.f) & 0xffffu; const float lo = wp - __uint_as_float(hw << 16);
              WH[e * N2_WROW + k] = (bf16_t)hw; WL[e * N2_WROW + k] = (bf16_t)(pk2(lo, 0.f) & 0xffffu); cp += md[3 * 1024 + k] * w; }
          PART[(tid >> 5) * 32 + (tid & 31)] = cp; }
        if (tid < 32) CNT[tid] = 0;
        __syncthreads();
        if (tid < 32) { float c = in_rb[tid];
#pragma unroll
            for (int p = 0; p < 16; ++p) c += PART[p * 32 + tid];
            CB[tid] = c; }
        __syncthreads();
        const int t0w = chunk * 128 + wave * 16;
        {
            const float* xp = X1 + (size_t)(t0w + fr) * 1024 + 8 * g;
            f32x4 acc0 = {F.zf, F.zf, F.zf, F.zf}, acc1 = acc0; float ssq = 0.f;
            const LAS bf16_t* wh0 = WH + fr * N2_WROW + 8 * g; const LAS bf16_t* wl0 = WL + fr * N2_WROW + 8 * g;
#pragma unroll 8
            for (int ks = 0; ks < 32; ++ks) {
                const f32x4 xa = *(const f32x4*)(xp + 32 * ks), xb = *(const f32x4*)(xp + 32 * ks + 4);
                ssq += (xa[0] * xa[0] + xa[1] * xa[1]) + (xa[2] * xa[2] + xa[3] * xa[3]) + (xb[0] * xb[0] + xb[1] * xb[1]) + (xb[2] * xb[2] + xb[3] * xb[3]);
                u32x4 hw; hw.x = pk2(xa[0], xa[1]); hw.y = pk2(xa[2], xa[3]); hw.z = pk2(xb[0], xb[1]); hw.w = pk2(xb[2], xb[3]);
                u32x4 lw; lw.x = pk2(xa[0] - bf_lo(hw.x), xa[1] - bf_hi(hw.x)); lw.y = pk2(xa[2] - bf_lo(hw.y), xa[3] - bf_hi(hw.y)); lw.z = pk2(xb[0] - bf_lo(hw.z), xb[1] - bf_hi(hw.z)); lw.w = pk2(xb[2] - bf_lo(hw.w), xb[3] - bf_hi(hw.w));
                const bf16x8 ah = __builtin_bit_cast(bf16x8, hw), al = __builtin_bit_cast(bf16x8, lw);
                const bf16x8 bh0 = *(const LAS bf16x8*)(wh0 + 32 * ks), bh1 = *(const LAS bf16x8*)(wh0 + 16 * N2_WROW + 32 * ks), bl0 = *(const LAS bf16x8*)(wl0 + 32 * ks), bl1 = *(const LAS bf16x8*)(wl0 + 16 * N2_WROW + 32 * ks);
                acc0 = __builtin_amdgcn_mfma_f32_16x16x32_bf16(ah, bh0, acc0, 0, 0, 0); acc0 = __builtin_amdgcn_mfma_f32_16x16x32_bf16(ah, bl0, acc0, 0, 0, 0); acc0 = __builtin_amdgcn_mfma_f32_16x16x32_bf16(al, bh0, acc0, 0, 0, 0);
                acc1 = __builtin_amdgcn_mfma_f32_16x16x32_bf16(ah, bh1, acc1, 0, 0, 0); acc1 = __builtin_amdgcn_mfma_f32_16x16x32_bf16(ah, bl1, acc1, 0, 0, 0); acc1 = __builtin_amdgcn_mfma_f32_16x16x32_bf16(al, bh1, acc1, 0, 0, 0);
            }
            ssq += __shfl_xor(ssq, 16); ssq += __shfl_xor(ssq, 32);
            if (g == 0) RST[fr] = 1.0f / sqrtf(ssq * (1.0f / 1024.0f) + NORM_EPS);
#pragma unroll
            for (int r = 0; r < 4; ++r) { LGT[(4 * g + r) * 36 + fr] = acc0[r]; LGT[(4 * g + r) * 36 + 16 + fr] = acc1[r]; }
        }
        LDS_WAIT();
        if (lane < 16) {
            const int t = t0w + lane; const float rt = RST[lane];
            float a[32];
#pragma unroll
            for (int q = 0; q < 8; ++q) { const f32x4 w = *(const LAS f32x4*)(LGT + lane * 36 + 4 * q), c = *(const LAS f32x4*)(CB + 4 * q); a[4 * q] = w[0] * rt + c[0]; a[4 * q + 1] = w[1] * rt + c[1]; a[4 * q + 2] = w[2] * rt + c[2]; a[4 * q + 3] = w[3] * rt + c[3]; }
            float tv[4]; int te[4];
#pragma unroll
            for (int k = 0; k < 4; ++k) { float best = a[0]; int bi = 0;
#pragma unroll
                for (int e = 1; e < 32; ++e) if (a[e] > best) { best = a[e]; bi = e; }
                tv[k] = best; te[k] = bi;
#pragma unroll
                for (int e = 0; e < 32; ++e) if (e == bi) a[e] = -INFINITY; }
            const float e1 = __expf(tv[1] - tv[0]), e2 = __expf(tv[2] - tv[0]), e3 = __expf(tv[3] - tv[0]); const float inv = 1.0f / (1.0f + e1 + e2 + e3);
            const float gk[4] = {inv, e1 * inv, e2 * inv, e3 * inv};
#pragma unroll
            for (int k = 0; k < 4; ++k) { const int loc = __hip_atomic_fetch_add(&CNT[te[k]], 1, __ATOMIC_RELAXED, __HIP_MEMORY_SCOPE_WORKGROUP); TOKR[(wave * 16 + lane) * 4 + k] = te[k] | (loc << 8); }
            *(f32x4*)(TOPG + (size_t)t * 4) = (f32x4){gk[0], gk[1], gk[2], gk[3]};
        }
        { f32x4 gs[4], shv[4];
#pragma unroll
          for (int i = 0; i < 4; ++i) { const int co = 4 * lane + 256 * i; gs[i] = *(const f32x4*)(in_n2 + co) * (*(const f32x4*)(md + 4 * 1024 + co) + 1.0f); shv[i] = *(const f32x4*)(md + 3 * 1024 + co); }
          for (int j = 0; j < 16; j += 4) {
            f32x4 xv[4][4];
#pragma unroll
            for (int jj = 0; jj < 4; ++jj)
#pragma unroll
                for (int i = 0; i < 4; ++i) xv[jj][i] = *(const f32x4*)(X1 + (size_t)(t0w + j + jj) * 1024 + 4 * lane + 256 * i);
#pragma unroll
            for (int jj = 0; jj < 4; ++jj) { const float r = RST[j + jj];
#pragma unroll
                for (int i = 0; i < 4; ++i) { const f32x4 hv = xv[jj][i] * r * gs[i] + shv[i];
                    *(unsigned*)(H8 + (size_t)(t0w + j + jj) * 1024 + 4 * lane + 256 * i) = pk4_fp8(hv[0], hv[1], hv[2], hv[3]); } }
          } }
        __syncthreads();
        if (tid < 32) BASE[tid] = (int)__hip_atomic_fetch_add(F.ctl + CW_CNT + (cset * 32 + tid) * 64, (unsigned)CNT[tid], __ATOMIC_RELAXED, __HIP_MEMORY_SCOPE_AGENT);
        __syncthreads();
        { const int pr = TOKR[tid], e = pr & 255, loc = pr >> 8; const size_t o = (size_t)(chunk * 128) * 4 + tid; TOPE[o] = e; RANK[o] = BASE[e] + loc; }
    }
}
constexpr int MOE_OFF = LDS_X, MOE_CNTL = LDS_X + 256, MOE_TEXP = LDS_X + 512;
DI int moe_offsets(const Frame& F, int l) {
    LAS int* OFF = (LAS int*)(F.lds + MOE_OFF); LAS int* CNTL = (LAS int*)(F.lds + MOE_CNTL); LAS int* TEXP = (LAS int*)(F.lds + MOE_TEXP);
    __syncthreads();
    if (F.tid < 32) CNTL[F.tid] = (int)__hip_atomic_load(F.ctl + CW_CNT + (l * 32 + F.tid) * 64, __ATOMIC_RELAXED, __HIP_MEMORY_SCOPE_AGENT);
    __syncthreads();
    if (F.tid == 0) { int off = 0; for (int e = 0; e < 32; ++e) { OFF[e] = off; off += (CNTL[e] + 255) & ~255; } OFF[32] = off; }
    __syncthreads();
    const int ntiles = OFF[32] >> 8;
    for (int tl = F.tid; tl < ntiles; tl += 512) { int e = 0; for (int q = 0; q < 32; ++q) if (OFF[q] <= tl * 256 && tl * 256 < OFF[q + 1]) e = q; TEXP[tl] = e; }
    __syncthreads();
    return ntiles;
}
DI void phase_scatter(const Frame& F, int l) {
    const int lane = F.lane, wave = F.wave;
    (void)moe_offsets(F, l);
    const LAS int* OFF = (const LAS int*)(F.lds + MOE_OFF); const LAS int* CNTL = (const LAS int*)(F.lds + MOE_CNTL);
    const int* TOPE = (const int*)(F.ws + WS_ROUTE + RT_TOPE); const float* TOPG = (const float*)(F.ws + WS_ROUTE + RT_TOPG); const int* RANK = (const int*)(F.ws + WS_ROUTE + RT_RANK);
    int* SLOTOF = (int*)(F.ws + WS_ROUTE + RT_SLOTOF); int* TOKOF = (int*)(F.ws + WS_ROUTE + RT_TOKOF); float* GATEOF = (float*)(F.ws + WS_ROUTE + RT_GATEOF);
    const unsigned char* H8 = WSP(unsigned char, WS_H8); unsigned char* XB = WSP(unsigned char, WS_XB);
    for (int chunk = F.bid; chunk < T_TOK / 128; chunk += F.G) {
        const int pair = wave * 64 + lane, tl = chunk * 128 + (pair >> 2); const size_t o = (size_t)tl * 4 + (pair & 3);
        const int e = TOPE[o], slot = OFF[e] + RANK[o];
        SLOTOF[o] = slot; TOKOF[slot] = tl; GATEOF[slot] = TOPG[o];
#pragma unroll 4
        for (int p = 0; p < 64; ++p) {
            const int sp = __builtin_amdgcn_readlane(slot, p), tp = chunk * 128 + ((wave * 64 + p) >> 2);
            *(u32x4*)(XB + (size_t)sp * 1024 + 16 * lane) = *(const u32x4*)(H8 + (size_t)tp * 1024 + 16 * lane);
        }
    }
    for (int e = F.bid; e < 32; e += F.G) {
        const int s0 = OFF[e] + CNTL[e], s1 = OFF[e + 1];
        for (int s = s0 + wave; s < s1; s += 8) { if (lane == 0) { TOKOF[s] = 0; GATEOF[s] = 0.f; }
            *(u32x4*)(XB + (size_t)s * 1024 + 16 * lane) = (u32x4){0u, 0u, 0u, 0u}; }
    }
}

#ifndef MK_SPLIT
#define MK_SPLIT 0
#endif
constexpr int NPHASE = 2 + 11 * DEPTH;
struct Args { const void* in[23]; float* out; unsigned char* ws; int ph_lo, ph_hi; };
static_assert(sizeof(Args) == 25 * 8 + 8, "Args has no padding");


#ifndef PH_ENABLE
#define PH_ENABLE 0xFFFF
#endif
#define IN(k) (lo <= (k) && (k) < hi)
#define EN(j) (((PH_ENABLE) >> (j)) & 1)
#ifndef STAG_G1
#define STAG_G1 0
#endif
#ifndef STAG_G3
#define STAG_G3 0
#endif
#ifndef STAG_G4
#define STAG_G4 0
#endif
#ifndef STAG_M2
#define STAG_M2 0
#endif
#ifndef DUP_MASK
#define DUP_MASK 0
#endif
#define NREP(j) ((((DUP_MASK) >> (j)) & 1) ? 2 : 1)
#define SEAM(k) do { if (!MK_SPLIT && (k) + 1 < hi) { XcdBarrier bar_; bar_.bar = F.ctl + CW_BAR; bar_.x = xb_xcc_id(); bar_.st = (volatile LAS unsigned*)((LAS unsigned char*)lds_raw + MISC_OFF) + 8; xcd_barrier(bar_, F.tid); } } while (0)
DI void layer_phases(const int l, const int lo, const int hi, const int wave0) {
        const int pb = 2 + 11 * l;
        if (EN(2) && IN(pb + 0)) { const Frame F = make_frame(wave0);
            stagger(F, STAG_G1);
            { int kb8 = 1024; asm volatile("" : "+s"(kb8));
              SchedPlain S; S.o.init(T_TOK / 256, G1_F8_COLS / 256, F.G, F.bid); S.A = (const char*)WSP(unsigned char, WS_HG8); S.B = (const char*)(WSP(unsigned char, WS_WIN) + (size_t)l * NP * 2048); S.tstep = (size_t)256 * 1024;
              EpiStoreBf16N E{WSP(bf16_t, WS_P), NP, 0};
#ifdef PROBE_NOSTORE
              _Pragma("unroll") for (int rep = 0; rep < NREP(2); ++rep) { E.skip = (rep + 1 < NREP(2)); pg8::gemm_phase_f8<EpiStoreBf16N, SchedPlain>(F.lds, F.tid, kb8, S, E); } }
#else
              _Pragma("unroll") for (int rep = 0; rep < NREP(2) + NREP(14) - 1; ++rep) pg8::gemm_phase_f8<EpiStoreBf16N, SchedPlain>(F.lds, F.tid, kb8, S, E); }
#endif
            { int tid2 = F.tid; asm volatile("" : "+v"(tid2));
              SchedPlain S; S.o.init(T_TOK / 256, (NP - G1_F8_COLS) / 256, F.G, F.bid); S.A = (const char*)WSP(bf16_t, WS_H); S.B = (const char*)(WSP(bf16_t, WS_WIN) + (size_t)l * NP * 1024 + (size_t)G1_F8_COLS * 1024); S.tstep = (size_t)256 * 1024 * 2;
              EpiStoreBf16 E{WSP(bf16_t, WS_P), NP, G1_F8_COLS};
#ifdef PROBE_NOSTORE
              _Pragma("unroll") for (int rep = 0; rep < NREP(2); ++rep) { E.skip = (rep + 1 < NREP(2)); pg8::gemm_phase<EpiStoreBf16, SchedPlain>(F.lds, tid2, 1024, S, E); } }
#else
              _Pragma("unroll") for (int rep = 0; rep < NREP(2) + NREP(15) - 1; ++rep) pg8::gemm_phase<EpiStoreBf16, SchedPlain>(F.lds, tid2, 1024, S, E); }
#endif
            SEAM(pb + 0);
        }
        if (EN(3) && IN(pb + 1)) { const Frame F = make_frame(wave0); _Pragma("unroll") for (int rep = 0; rep < NREP(3); ++rep) phase_post(F, l); SEAM(pb + 1); }
        if (EN(4) && IN(pb + 2)) { const Frame F = make_frame(wave0);
            int k256 = 256; asm volatile("" : "+s"(k256));
            { SchedPlain S; S.o.init(T_TOK / 256, 3, F.G, F.bid); S.A = (const char*)WSP(bf16_t, WS_CQ); S.B = (const char*)(WSP(bf16_t, WS_WUQ) + (size_t)l * 768 * 256); S.tstep = (size_t)256 * 256 * 2;
              EpiStoreBf16 E{WSP(bf16_t, WS_QA), 768};
              pg8::gemm_phase<EpiStoreBf16, SchedPlain>(F.lds, F.tid, k256, S, E); }
            { int tid2 = F.tid; asm volatile("" : "+v"(tid2));
              SchedPlain S; S.o.init(T_TOK / 256, 4, F.G, F.bid); S.A = (const char*)WSP(bf16_t, WS_CKV); S.B = (const char*)(WSP(bf16_t, WS_WUKV) + (size_t)l * 1024 * 256); S.tstep = (size_t)256 * 256 * 2;
              EpiStoreBf16 E{WSP(bf16_t, WS_KV), 1024};
              pg8::gemm_phase<EpiStoreBf16, SchedPlain>(F.lds, tid2, k256, S, E); }
            SEAM(pb + 2);
        }
        if (EN(5) && IN(pb + 3)) { const Frame F = make_frame(wave0); phase_attention(F, NREP(5), NREP(13)); SEAM(pb + 3); }
        if (EN(6) && IN(pb + 4)) { const Frame F = make_frame(wave0);
            stagger(F, STAG_G3);
            SchedBranch S; S.o.init(T_TOK / 256, 4, F.G, F.bid); S.A = (const char*)WSP(bf16_t, WS_O3); S.B = (const char*)(WSP(bf16_t, WS_WB) + (size_t)l * 3 * 1024 * 512); S.tstep = (size_t)256 * 512 * 2; S.aslab = (size_t)T_TOK * 512 * 2;
            EpiBranchGate E{WSP(bf16_t, WS_GY), WSP(bf16_t, WS_P), KIN_b_gate + l * 3072};
            _Pragma("unroll") for (int rep = 0; rep < NREP(6); ++rep) pg8::gemm_phase<EpiBranchGate, SchedBranch>(F.lds, F.tid, 512, S, E);
            SEAM(pb + 4);
        }
        if (EN(7) && IN(pb + 5)) { const Frame F = make_frame(wave0);
            stagger(F, STAG_G4);
            SchedPlain S; S.o.init(T_TOK / 256, 4, F.G, F.bid); S.A = (const char*)WSP(bf16_t, WS_GY); S.B = (const char*)(WSP(bf16_t, WS_WOUT) + (size_t)l * 1024 * 1024); S.tstep = (size_t)256 * 1024 * 2;
            EpiResidual E{l == 0 ? KIN_x : WSP(float, WS_X1), WSP(float, WS_X1), WSP(float, WS_MOD) + (size_t)l * 16 * 6144 + 2 * 1024};
            _Pragma("unroll") for (int rep = 0; rep < NREP(7); ++rep) if (rep == 0 || l == 0) pg8::gemm_phase<EpiResidual, SchedPlain>(F.lds, F.tid, 1024, S, E);
            SEAM(pb + 5);
        }
        if (EN(8) && IN(pb + 6)) { const Frame F = make_frame(wave0); phase_router(F, l, l); if (NREP(8) == 2) phase_router(F, l, l + 2); SEAM(pb + 6); }
        if (EN(9) && IN(pb + 7)) { const Frame F = make_frame(wave0); _Pragma("unroll") for (int rep = 0; rep < NREP(9); ++rep) phase_scatter(F, l); SEAM(pb + 7); }
        if (EN(10) && IN(pb + 8)) { const Frame F = make_frame(wave0);
            const int ntiles = moe_offsets(F, l); int kb8 = 1024; asm volatile("" : "+s"(kb8));
            SchedMoe S; S.o.init(ntiles, 8, F.G, F.bid); S.A = (const char*)WSP(unsigned char, WS_XB); S.B = (const char*)(WSP(unsigned char, WS_W1) + (size_t)l * 32 * 2048 * 1024); S.eslab = 2048u * 1024u;
            S.texp = (const LAS int*)(F.lds + MOE_TEXP);
#if M2_F8
            EpiSwiglu8 E{WSP(unsigned char, WS_ACT), KIN_b1 + (size_t)l * 32 * 2048, (const LAS int*)(F.lds + MOE_TEXP)};
#else
            EpiSwiglu E{WSP(bf16_t, WS_ACT), KIN_b1 + (size_t)l * 32 * 2048, (const LAS int*)(F.lds + MOE_TEXP)};
#endif
            _Pragma("unroll") for (int rep = 0; rep < NREP(10); ++rep)
#if M2_F8
#ifdef PROBE_M1
            { E.skip = (rep + 1 < NREP(10)) ? PROBE_M1 : 0; pg8::gemm_phase_f8<EpiSwiglu8, SchedMoe>(F.lds, F.tid, kb8, S, E); }
#else
            pg8::gemm_phase_f8<EpiSwiglu8, SchedMoe>(F.lds, F.tid, kb8, S, E);
#endif
#else
            pg8::gemm_phase_f8<EpiSwiglu, SchedMoe>(F.lds, F.tid, kb8, S, E);
#endif

            SEAM(pb + 8);
        }
        if (EN(11) && IN(pb + 9)) { const Frame F = make_frame(wave0);
            const int ntiles = moe_offsets(F, l); int kb8 = 1024; asm volatile("" : "+s"(kb8));
            stagger(F, STAG_M2);
#if M2_F8
            SchedMoe S; S.o.init(ntiles, 4, F.G, F.bid); S.A = (const char*)WSP(unsigned char, WS_ACT); S.B = (const char*)(WSP(unsigned char, WS_W2) + (size_t)l * 32 * 1024 * 1024); S.eslab = 1024u * 1024u;
            S.texp = (const LAS int*)(F.lds + MOE_TEXP);
            EpiMoeOut E{WSP(bf16_t, WS_Y), KIN_b2 + (size_t)l * 32 * 1024, (const float*)(F.ws + WS_ROUTE + RT_GATEOF), (const LAS int*)(F.lds + MOE_TEXP)};
            _Pragma("unroll") for (int rep = 0; rep < NREP(11); ++rep) pg8::gemm_phase_f8<EpiMoeOut, SchedMoe>(F.lds, F.tid, kb8, S, E);
#else
            SchedMoeB S; S.o.init(ntiles, 4, F.G, F.bid); S.A = (const char*)WSP(bf16_t, WS_ACT); S.B = (const char*)(WSP(bf16_t, WS_W2) + (size_t)l * 32 * 1024 * 1024); S.eslab = 1024u * 1024u * 2u;
            S.texp = (const LAS int*)(F.lds + MOE_TEXP);
            EpiMoeOut E{WSP(bf16_t, WS_Y), KIN_b2 + (size_t)l * 32 * 1024, (const float*)(F.ws + WS_ROUTE + RT_GATEOF), (const LAS int*)(F.lds + MOE_TEXP)};
            _Pragma("unroll") for (int rep = 0; rep < NREP(11); ++rep) pg8::gemm_phase<EpiMoeOut, SchedMoeB>(F.lds, F.tid, kb8, S, E);
#endif
            SEAM(pb + 9);
        }
        if (EN(12) && IN(pb + 10)) { const Frame F = make_frame(wave0);
            const bool last = (l == DEPTH - 1);
            _Pragma("unroll") for (int rep = 0; rep < NREP(12); ++rep) if (rep == 0 || last) phase_norm(F, WSP(float, WS_X1), WSP(float, WS_X1), true, !last, last, l + 1 < DEPTH ? l + 1 : 0, l);
            SEAM(pb + 10);
        }
}
__global__ void __launch_bounds__(512, 2) fwd_kernel(Args args) {
    const int wave0 = __builtin_amdgcn_readfirstlane(threadIdx.x >> 6);
    {
        volatile LAS unsigned* MISC = (volatile LAS unsigned*)((LAS unsigned char*)lds_raw + MISC_OFF);
        if (threadIdx.x < 32) MISC[threadIdx.x] = 0u;
        __syncthreads();
        if (!MK_SPLIT) { const Frame F = make_frame(wave0); (void)xcd_barrier_post(F.ctl + CW_BAR, MISC + 8, F.tid); }
    }
    const int lo = args.ph_lo, hi = args.ph_hi;
    if (EN(0) && IN(0)) { const Frame F = make_frame(wave0); _Pragma("unroll") for (int rep = 0; rep < NREP(0); ++rep) phase_prologue(F); SEAM(0); }
    if (EN(1) && IN(1)) { const Frame F = make_frame(wave0); _Pragma("unroll") for (int rep = 0; rep < NREP(1); ++rep) phase_norm(F, KIN_x, nullptr, false, false, false, 0, 0); SEAM(1); }
    layer_phases(0, lo, hi, wave0);
    layer_phases(1, lo, hi, wave0);
    static_assert(DEPTH == 2, "two layers");
#undef IN
#undef SEAM
}

extern "C" void kernel_launch(void* const* d_in, const int* in_sizes, int n_in, void* d_out, int out_size, void* d_ws, size_t ws_size, hipStream_t stream) {
    static int grid = 0;
    if (grid == 0) {
        if (n_in != 23 || out_size != T_TOK * D_MODEL || ws_size < WS_END) { fprintf(stderr, "kernel_launch: unexpected problem (n_in %d, out %d, ws %zu)\n", n_in, out_size, ws_size); grid = -1; return; }
        int dev = 0, cus = 0;
        if (hipGetDevice(&dev) != hipSuccess || hipDeviceGetAttribute(&cus, hipDeviceAttributeMultiprocessorCount, dev) != hipSuccess) { grid = -1; return; }
        if (hipFuncSetAttribute((const void*)fwd_kernel, hipFuncAttributeMaxDynamicSharedMemorySize, LDS_BYTES) != hipSuccess) { fprintf(stderr, "kernel_launch: hipFuncSetAttribute failed\n"); grid = -1; return; }
        int per_cu = 0;
        if (hipOccupancyMaxActiveBlocksPerMultiprocessor(&per_cu, (const void*)fwd_kernel, 512, LDS_BYTES) != hipSuccess || per_cu < 1) fprintf(stderr, "kernel_launch: occupancy query says %d\n", per_cu);
        (void)hipGetLastError();
        grid = cus > 256 ? 256 : cus;
    }
    if (grid < 0) return;
    (void)in_sizes;
    if (hipMemsetAsync((char*)d_ws + WS_CTL, 0, CTL_ZERO_BYTES, stream) != hipSuccess) return;
    Args a{};
    for (int i = 0; i < 23; ++i) a.in[i] = d_in[i];
    a.out = (float*)d_out; a.ws = (unsigned char*)d_ws;
#if MK_SPLIT
    for (int p = 0; p < NPHASE; ++p) { a.ph_lo = p; a.ph_hi = p + 1; hipLaunchKernelGGL(fwd_kernel, dim3(grid), dim3(512), LDS_BYTES, stream, a); }
#else
    a.ph_lo = 0; a.ph_hi = NPHASE;
    hipLaunchKernelGGL(fwd_kernel, dim3(grid), dim3(512), LDS_BYTES, stream, a);
#endif
}
```

```cpp
#include <hip/hip_runtime.h>
#include <cstdio>
#include <cstdint>

#ifndef M2_F8
#define M2_F8 1
#endif
#define LAS __attribute__((address_space(3)))
#define GAS __attribute__((address_space(1)))
typedef unsigned short bf16_t;
typedef short bf16x8 __attribute__((ext_vector_type(8)));
typedef short s16x4 __attribute__((ext_vector_type(4)));
typedef float f32x2 __attribute__((ext_vector_type(2)));
typedef float f32x4 __attribute__((ext_vector_type(4)));
typedef float f32x16 __attribute__((ext_vector_type(16)));
typedef unsigned u32x2 __attribute__((ext_vector_type(2)));
typedef unsigned u32x4 __attribute__((ext_vector_type(4)));
#define DI __device__ __forceinline__

constexpr int D_MODEL = 1024, BATCH = 16, SEQ = 2048, T_TOK = BATCH * SEQ, DEPTH = 2;
constexpr float NORM_EPS = 1e-6f;
constexpr int IN_COLS = 6248, NP = 6400;
constexpr int N_EXP = 32, TOP_K = 4, D_EXP = 1024;
constexpr int NSLOT_MAX = T_TOK * TOP_K + N_EXP * 256;
constexpr int PC_GATE = 0, PC_CONV = 3072, PC_DQ = 4608, PC_IQ = 5120, PC_QLAT = 5632, PC_KVLAT = 5888, PC_DKV = 6048, PC_IK = 6176, PC_IW = 6240;
constexpr int OC_QLAT = 0, OC_KVLAT = 256, OC_CONV = 416, OC_DQ = 1952, OC_DKV = 2464, OC_IQ = 2592, OC_IK = 3104, OC_IW = 3168, OC_GATE = 3176;

DI unsigned pk2(float lo, float hi) { typedef __bf16 bf16x2_t __attribute__((ext_vector_type(2))); f32x2 v = {lo, hi}; bf16x2_t b = __builtin_convertvector(v, bf16x2_t); return __builtin_bit_cast(unsigned, b); }
DI float bf_lo(unsigned w) { return __uint_as_float(w << 16); }
DI float bf_hi(unsigned w) { return __uint_as_float(w & 0xffff0000u); }
DI float bf2f(bf16_t h) { return __uint_as_float((unsigned)h << 16); }
DI float wave_sum(float v) {
#pragma unroll
    for (int o = 1; o < 64; o <<= 1) v += __shfl_xor(v, o);
    return v;
}
DI float fast_sigmoid(float x) { return __builtin_amdgcn_rcpf(1.0f + __builtin_amdgcn_exp2f(-1.4426950408889634f * x)); }
DI unsigned pk4_fp8(float a, float b, float c, float d) { int w = __builtin_amdgcn_cvt_pk_fp8_f32(a, b, 0, false); w = __builtin_amdgcn_cvt_pk_fp8_f32(c, d, w, true); return (unsigned)w; }
#define LDS_WAIT() asm volatile("s_waitcnt lgkmcnt(0)" ::: "memory")
#define VM_WAIT() asm volatile("s_waitcnt vmcnt(0)" ::: "memory")

namespace pg8 {
DI void glds16_s(unsigned voff, const char* sbase, unsigned lds_dst) { unsigned keep; asm volatile("s_nop 4\n\ts_mov_b32 %0, m0\n\ts_mov_b32 m0, %3\n\ts_nop 0\n\tglobal_load_lds_dwordx4 %1, %2\n\ts_mov_b32 m0, %0" : "=&s"(keep) : "v"(voff), "s"(sbase), "s"(lds_dst) : "memory"); }
DI const char* uni_ptr(const char* p) { const unsigned long long v = (unsigned long long)p; const unsigned lo = __builtin_amdgcn_readfirstlane((unsigned)v), hi = __builtin_amdgcn_readfirstlane((unsigned)(v >> 32)); return (const char*)(GAS const char*)(((unsigned long long)hi << 32) | lo); }
constexpr int BM = 256, BK = 64, HALF = 128, HTB = HALF * BK * 2, STAGE_BYTES = 8 * HTB, NXCD = 8, WGM = 8;
__host__ __device__ __forceinline__ int lds_byte(int r, int c) { const int st = (r >> 4) * 2 + (c >> 5), rr = r & 15, cc = c & 31, ob = rr * 64 + cc * 2; return st * 1024 + (ob ^ (((ob >> 9) & 1) << 5)); }
__host__ __device__ __forceinline__ void stage_rc(int b, int& R, int& C) { const int st = b / 1024, sb = b % 1024, swz = sb ^ (((sb >> 9) & 1) << 5); R = (st >> 1) * 16 + swz / 64; C = (st & 1) * 32 + (swz % 64) / 2; }
__host__ __device__ __forceinline__ int perm32(int rho) { const int n = rho >> 4, i = rho & 15; return 8 * (i >> 2) + 4 * n + (i & 3); }
struct Unit { int pm, pn; };
struct StaticOrder {
    int nM, nN, nwg, G, c;
    DI void init(int nM_, int nN_, int G_, int c_) { nM = nM_; nN = nN_; nwg = nM * nN; G = G_; c = c_; }
    DI bool next(int i, Unit& u) const {
        const long L = (long)i * G + c; if (L >= nwg) return false;
        int wgid = (int)L; { const int q = nwg / NXCD, r = nwg % NXCD, xcd = wgid % NXCD, off = wgid / NXCD; wgid = (xcd < r ? xcd * (q + 1) : r * (q + 1) + (xcd - r) * q) + off; }
        const int nig = WGM * nN, gid = wgid / nig, fm = gid * WGM, gsz = (nM - fm) < WGM ? (nM - fm) : WGM;
        u.pm = fm + ((wgid % nig) % gsz); u.pn = (wgid % nig) / gsz; return true;
    }
};

template <class Epi, class Sched, bool ALIGN_EPI = true, bool SP2 = true>
DI void gemm_phase(LAS unsigned char* lds, const int tid, const int K, const Sched& S, const Epi& E) {
    const int wid = __builtin_amdgcn_readfirstlane(tid >> 6), lane = tid & 63, wr = wid >> 2, wc = wid & 3, fr = lane & 15, fq = lane >> 4;
    const int nt = K / BK;
    unsigned voffA[2], voffB[2];
#pragma unroll
    for (int i = 0; i < 2; ++i) { int R, C; stage_rc(tid * 16 + i * 8192, R, C); const int Rb = Epi::PERM ? ((R & ~31) + perm32(R & 31)) : R;
        voffA[i] = (unsigned)(R * K + C) * 2u; voffB[i] = (unsigned)(Rb * K + C) * 2u; }
    const size_t kstep = (size_t)(BK * 2);
    const size_t hstep = (size_t)HALF * K * 2;
    const unsigned ldsw = (unsigned)wid * 1024u; const unsigned ldsb = (unsigned)(unsigned long long)(lds);
    const int aoff = lds_byte(wr * 64 + fr, fq * 8), boff = lds_byte(wc * 32 + fr, fq * 8);
#define PG8_SA(b, h) (((b) * 2 + (h)) * HTB)
#define PG8_SB(b, h) ((4 + (b) * 2 + (h)) * HTB)
#define PG8_STAGE(bufoff, gbase, voff) do { _Pragma("unroll") for (int _i = 0; _i < 2; ++_i) \
        glds16_s((voff)[_i], (const char*)(gbase), ldsb + (unsigned)(bufoff) + ldsw + (unsigned)(_i * 8192)); } while (0)
#define PG8_LDA(dst, b, h) do { int a_ = aoff; asm volatile("" : "+v"(a_)); _Pragma("unroll") for (int m = 0; m < 4; ++m) _Pragma("unroll") for (int k = 0; k < 2; ++k) dst[m][k] = *(const LAS bf16x8*)(lds + PG8_SA(b, h) + a_ + m * 2048 + k * 1024); } while (0)
#define PG8_LDB(dst, b, h) do { int b_ = boff; asm volatile("" : "+v"(b_)); _Pragma("unroll") for (int n = 0; n < 2; ++n) _Pragma("unroll") for (int k = 0; k < 2; ++k) dst[n][k] = *(const LAS bf16x8*)(lds + PG8_SB(b, h) + b_ + n * 2048 + k * 1024); } while (0)
#define PG8_MMA(ai, bj, At, Bt) do { __builtin_amdgcn_s_setprio(1); _Pragma("unroll") for (int m = 0; m < 4; ++m) _Pragma("unroll") for (int n = 0; n < 2; ++n) _Pragma("unroll") for (int k = 0; k < 2; ++k) \
        acc[ai][bj][m][n] = __builtin_amdgcn_mfma_f32_16x16x32_bf16(Bt[n][k], At[m][k], acc[ai][bj][m][n], 0, 0, 0); __builtin_amdgcn_s_setprio(0); } while (0)
#define PG8_WAIT_V(n) asm volatile("s_waitcnt vmcnt(" #n ")" ::: "memory")
#define PG8_WAIT_L(n) asm volatile("s_waitcnt lgkmcnt(" #n ")" ::: "memory")
#define PG8_BAR __builtin_amdgcn_s_barrier()
#define PG8_SCHED __builtin_amdgcn_sched_barrier(0)
    Unit cur, nxt; int ui = 0;
    if (!S.next(0, cur)) return;
    float zf_ = 0.f; asm volatile("" : "+v"(zf_));
    f32x4 acc[2][2][4][2];
#pragma unroll
    for (int a = 0; a < 2; ++a)
#pragma unroll
        for (int b = 0; b < 2; ++b)
#pragma unroll
            for (int m = 0; m < 4; ++m)
#pragma unroll
                for (int n = 0; n < 2; ++n) acc[a][b][m][n] = (f32x4){zf_, zf_, zf_, zf_};
    bf16x8 At[4][2], B0[2][2], B1[2][2];
    const char* cA = uni_ptr(S.abase(cur)); const char* cB = uni_ptr(S.bbase(cur));
    if constexpr (SP2) {
        PG8_STAGE(PG8_SB(0, 0), cB, voffB); PG8_STAGE(PG8_SB(0, 1), cB + hstep, voffB); PG8_STAGE(PG8_SA(0, 0), cA, voffA); PG8_STAGE(PG8_SA(0, 1), cA + hstep, voffA);
        if (wr == 1) PG8_BAR;
        PG8_WAIT_V(2); PG8_BAR;
        PG8_STAGE(PG8_SB(1, 0), cB + kstep, voffB); PG8_STAGE(PG8_SA(1, 0), cA + kstep, voffA); PG8_STAGE(PG8_SB(1, 1), cB + hstep + kstep, voffB);
        PG8_WAIT_V(6); PG8_BAR;
    } else {
        PG8_STAGE(PG8_SB(0, 0), cB, voffB); PG8_STAGE(PG8_SA(0, 0), cA, voffA); PG8_STAGE(PG8_SB(0, 1), cB + hstep, voffB); PG8_STAGE(PG8_SA(0, 1), cA + hstep, voffA);
        if (wr == 1) PG8_BAR;
        PG8_WAIT_V(4); PG8_BAR;
        PG8_STAGE(PG8_SB(1, 0), cB + kstep, voffB); PG8_STAGE(PG8_SA(1, 0), cA + kstep, voffA); PG8_STAGE(PG8_SB(1, 1), cB + hstep + kstep, voffB);
        PG8_WAIT_V(6); PG8_BAR;
    }
    for (;;) {
        const bool has_next = S.next(ui + 1, nxt);
        const char* nA = has_next ? uni_ptr(S.abase(nxt)) : cA; const char* nB = has_next ? uni_ptr(S.bbase(nxt)) : cB;
        for (int t = 0; t < nt; t += 2) {
            const bool last = (t == nt - 2);
            const char* a1 = cA + (size_t)(t + 1) * kstep;
            const char* a2 = last ? nA : cA + (size_t)(t + 2) * kstep; const char* b2 = last ? nB : cB + (size_t)(t + 2) * kstep;
            const char* a3 = a2 + kstep; const char* b3 = b2 + kstep;
            if constexpr (SP2) {
            PG8_LDB(B0, 0, 0); PG8_LDB(B1, 0, 1); PG8_SCHED; PG8_LDA(At, 0, 0); PG8_STAGE(PG8_SA(1, 1), a1 + hstep, voffA);
            PG8_WAIT_V(8); PG8_WAIT_L(0); PG8_BAR; PG8_MMA(0, 0, At, B0); PG8_MMA(0, 1, At, B1); PG8_BAR; PG8_SCHED;
            PG8_LDA(At, 0, 1); PG8_STAGE(PG8_SB(0, 0), b2, voffB); PG8_STAGE(PG8_SB(0, 1), b2 + hstep, voffB); PG8_STAGE(PG8_SA(0, 0), a2, voffA);
            PG8_WAIT_V(8); PG8_WAIT_L(0); PG8_BAR; PG8_MMA(1, 0, At, B0); PG8_MMA(1, 1, At, B1); PG8_BAR; PG8_SCHED;
            PG8_LDB(B0, 1, 0); PG8_LDB(B1, 1, 1); PG8_SCHED; PG8_LDA(At, 1, 0); PG8_STAGE(PG8_SA(0, 1), a2 + hstep, voffA);
            PG8_WAIT_V(8); PG8_WAIT_L(0); PG8_BAR; PG8_MMA(0, 0, At, B0); PG8_MMA(0, 1, At, B1); PG8_BAR; PG8_SCHED;
            PG8_LDA(At, 1, 1); PG8_STAGE(PG8_SB(1, 0), b3, voffB); PG8_STAGE(PG8_SB(1, 1), b3 + hstep, voffB); PG8_STAGE(PG8_SA(1, 0), a3, voffA);
            PG8_WAIT_V(8); PG8_WAIT_L(0); PG8_BAR; PG8_MMA(1, 0, At, B0); PG8_MMA(1, 1, At, B1); PG8_BAR; PG8_SCHED;
            } else {
            PG8_LDB(B0, 0, 0); PG8_SCHED; PG8_LDA(At, 0, 0); PG8_STAGE(PG8_SA(1, 1), a1 + hstep, voffA);
            PG8_WAIT_L(8); PG8_BAR; PG8_WAIT_L(0); PG8_MMA(0, 0, At, B0); PG8_BAR; PG8_SCHED;
            PG8_LDB(B1, 0, 1); PG8_STAGE(PG8_SB(0, 0), b2, voffB);
            PG8_BAR; PG8_WAIT_L(0); PG8_MMA(0, 1, At, B1); PG8_BAR;
            PG8_LDA(At, 0, 1); PG8_STAGE(PG8_SA(0, 0), a2, voffA);
            PG8_BAR; PG8_WAIT_L(0); PG8_MMA(1, 0, At, B0); PG8_BAR; PG8_SCHED;
            PG8_STAGE(PG8_SB(0, 1), b2 + hstep, voffB);
            PG8_WAIT_V(6); PG8_BAR; PG8_MMA(1, 1, At, B1); PG8_BAR;
            PG8_LDB(B0, 1, 0); PG8_SCHED; PG8_LDA(At, 1, 0); PG8_STAGE(PG8_SA(0, 1), a2 + hstep, voffA);
            PG8_WAIT_L(8); PG8_BAR; PG8_WAIT_L(0); PG8_MMA(0, 0, At, B0); PG8_BAR; PG8_SCHED;
            PG8_LDB(B1, 1, 1); PG8_STAGE(PG8_SB(1, 0), b3, voffB);
            PG8_BAR; PG8_WAIT_L(0); PG8_MMA(0, 1, At, B1); PG8_BAR;
            PG8_LDA(At, 1, 1); PG8_STAGE(PG8_SA(1, 0), a3, voffA);
            PG8_BAR; PG8_WAIT_L(0); PG8_MMA(1, 0, At, B0); PG8_BAR; PG8_SCHED;
            PG8_STAGE(PG8_SB(1, 1), b3 + hstep, voffB);
            PG8_WAIT_V(6); PG8_BAR; PG8_MMA(1, 1, At, B1); PG8_BAR;
            }
        }
        if constexpr (ALIGN_EPI) { if (wr == 0) PG8_BAR; }
        E(acc, cur, wr, wc, fr, fq);
        if (!has_next) break;
#pragma unroll
        for (int a = 0; a < 2; ++a)
#pragma unroll
            for (int b = 0; b < 2; ++b)
#pragma unroll
                for (int m = 0; m < 4; ++m)
#pragma unroll
                    for (int n = 0; n < 2; ++n) acc[a][b][m][n] = (f32x4){zf_, zf_, zf_, zf_};
        cur = nxt; cA = nA; cB = nB; ++ui;
        if constexpr (ALIGN_EPI) { if (wr == 1) PG8_BAR; }
    }
    PG8_WAIT_V(0);
    if constexpr (!ALIGN_EPI) { if (wr == 0) PG8_BAR; }
    PG8_BAR;
#undef PG8_SA
#undef PG8_SB
#undef PG8_STAGE
#undef PG8_LDA
#undef PG8_LDB
#undef PG8_MMA
#undef PG8_WAIT_V
#undef PG8_WAIT_L
#undef PG8_BAR
#undef PG8_SCHED
}
typedef int v8i __attribute__((ext_vector_type(8)));
template <class Epi, class Sched, bool ALIGN_EPI = true, bool SP2 = true>
DI void gemm_phase_f8(LAS unsigned char* lds, const int tid, const int KB, const Sched& S, const Epi& E) {
    const int wid = __builtin_amdgcn_readfirstlane(tid >> 6), lane = tid & 63, wr = wid >> 2, wc = wid & 3, fr = lane & 15, fq = lane >> 4;
    const int nt = KB / 128;
    unsigned voffA[2], voffB[2];
#pragma unroll
    for (int i = 0; i < 2; ++i) { int R, C; stage_rc(tid * 16 + i * 8192, R, C); const int Rb = Epi::PERM ? ((R & ~31) + perm32(R & 31)) : R;
        voffA[i] = (unsigned)(R * KB + 2 * C); voffB[i] = (unsigned)(Rb * KB + 2 * C); }
    const size_t kstep = (size_t)(BK * 2);
    const size_t hstep = (size_t)HALF * KB;
    const unsigned ldsw = (unsigned)wid * 1024u; const unsigned ldsb = (unsigned)(unsigned long long)(lds);
    const int aoff = lds_byte(wr * 64 + fr, fq * 16), boff = lds_byte(wc * 32 + fr, fq * 16);
#define PG8_SA(b, h) (((b) * 2 + (h)) * HTB)
#define PG8_SB(b, h) ((4 + (b) * 2 + (h)) * HTB)
#define PG8_STAGE(bufoff, gbase, voff) do { _Pragma("unroll") for (int _i = 0; _i < 2; ++_i) \
        glds16_s((voff)[_i], (const char*)(gbase), ldsb + (unsigned)(bufoff) + ldsw + (unsigned)(_i * 8192)); } while (0)
#define PG8_LDA(dst, b, h) do { int a_ = aoff; asm volatile("" : "+v"(a_)); _Pragma("unroll") for (int m = 0; m < 4; ++m) dst[m] = *(const LAS v8i*)(lds + PG8_SA(b, h) + a_ + m * 2048); } while (0)
#define PG8_LDB(dst, b, h) do { int b_ = boff; asm volatile("" : "+v"(b_)); _Pragma("unroll") for (int n = 0; n < 2; ++n) dst[n] = *(const LAS v8i*)(lds + PG8_SB(b, h) + b_ + n * 2048); } while (0)
#define PG8_MMA(ai, bj, At, Bt) do { __builtin_amdgcn_s_setprio(1); _Pragma("unroll") for (int m = 0; m < 4; ++m) _Pragma("unroll") for (int n = 0; n < 2; ++n) \
        acc[ai][bj][m][n] = __builtin_amdgcn_mfma_scale_f32_16x16x128_f8f6f4(Bt[n], At[m], acc[ai][bj][m][n], 0, 0, 0, sc8, 0, sc8); __builtin_amdgcn_s_setprio(0); } while (0)
#define PG8_WAIT_V(n) asm volatile("s_waitcnt vmcnt(" #n ")" ::: "memory")
#define PG8_WAIT_L(n) asm volatile("s_waitcnt lgkmcnt(" #n ")" ::: "memory")
#define PG8_BAR __builtin_amdgcn_s_barrier()
#define PG8_SCHED __builtin_amdgcn_sched_barrier(0)
    Unit cur, nxt; int ui = 0;
    if (!S.next(0, cur)) return;
    int sc8 = 0x7c7c7c7c; asm volatile("" : "+v"(sc8));
    float zf_ = 0.f; asm volatile("" : "+v"(zf_));
    f32x4 acc[2][2][4][2];
#pragma unroll
    for (int a = 0; a < 2; ++a)
#pragma unroll
        for (int b = 0; b < 2; ++b)
#pragma unroll
            for (int m = 0; m < 4; ++m)
#pragma unroll
                for (int n = 0; n < 2; ++n) acc[a][b][m][n] = (f32x4){zf_, zf_, zf_, zf_};
    v8i At[4], B0[2], B1[2];
    const char* cA = uni_ptr(S.abase(cur)); const char* cB = uni_ptr(S.bbase(cur));
    if constexpr (SP2) {
        PG8_STAGE(PG8_SB(0, 0), cB, voffB); PG8_STAGE(PG8_SB(0, 1), cB + hstep, voffB); PG8_STAGE(PG8_SA(0, 0), cA, voffA); PG8_STAGE(PG8_SA(0, 1), cA + hstep, voffA);
        if (wr == 1) PG8_BAR;
        PG8_WAIT_V(2); PG8_BAR;
        PG8_STAGE(PG8_SB(1, 0), cB + kstep, voffB); PG8_STAGE(PG8_SA(1, 0), cA + kstep, voffA); PG8_STAGE(PG8_SB(1, 1), cB + hstep + kstep, voffB);
        PG8_WAIT_V(6); PG8_BAR;
    } else {
        PG8_STAGE(PG8_SB(0, 0), cB, voffB); PG8_STAGE(PG8_SA(0, 0), cA, voffA); PG8_STAGE(PG8_SB(0, 1), cB + hstep, voffB); PG8_STAGE(PG8_SA(0, 1), cA + hstep, voffA);
        if (wr == 1) PG8_BAR;
        PG8_WAIT_V(4); PG8_BAR;
        PG8_STAGE(PG8_SB(1, 0), cB + kstep, voffB); PG8_STAGE(PG8_SA(1, 0), cA + kstep, voffA); PG8_STAGE(PG8_SB(1, 1), cB + hstep + kstep, voffB);
        PG8_WAIT_V(6); PG8_BAR;
    }
    for (;;) {
        const bool has_next = S.next(ui + 1, nxt);
        const char* nA = has_next ? uni_ptr(S.abase(nxt)) : cA; const char* nB = has_next ? uni_ptr(S.bbase(nxt)) : cB;
        for (int t = 0; t < nt; t += 2) {
            const bool last = (t == nt - 2);
            const char* a1 = cA + (size_t)(t + 1) * kstep;
            const char* a2 = last ? nA : cA + (size_t)(t + 2) * kstep; const char* b2 = last ? nB : cB + (size_t)(t + 2) * kstep;
            const char* a3 = a2 + kstep; const char* b3 = b2 + kstep;
            if constexpr (SP2) {
            PG8_LDB(B0, 0, 0); PG8_LDB(B1, 0, 1); PG8_SCHED; PG8_LDA(At, 0, 0); PG8_STAGE(PG8_SA(1, 1), a1 + hstep, voffA);
            PG8_WAIT_V(8); PG8_WAIT_L(0); PG8_BAR; PG8_MMA(0, 0, At, B0); PG8_MMA(0, 1, At, B1); PG8_BAR; PG8_SCHED;
            PG8_LDA(At, 0, 1); PG8_STAGE(PG8_SB(0, 0), b2, voffB); PG8_STAGE(PG8_SB(0, 1), b2 + hstep, voffB); PG8_STAGE(PG8_SA(0, 0), a2, voffA);
            PG8_WAIT_V(8); PG8_WAIT_L(0); PG8_BAR; PG8_MMA(1, 0, At, B0); PG8_MMA(1, 1, At, B1); PG8_BAR; PG8_SCHED;
            PG8_LDB(B0, 1, 0); PG8_LDB(B1, 1, 1); PG8_SCHED; PG8_LDA(At, 1, 0); PG8_STAGE(PG8_SA(0, 1), a2 + hstep, voffA);
            PG8_WAIT_V(8); PG8_WAIT_L(0); PG8_BAR; PG8_MMA(0, 0, At, B0); PG8_MMA(0, 1, At, B1); PG8_BAR; PG8_SCHED;
            PG8_LDA(At, 1, 1); PG8_STAGE(PG8_SB(1, 0), b3, voffB); PG8_STAGE(PG8_SB(1, 1), b3 + hstep, voffB); PG8_STAGE(PG8_SA(1, 0), a3, voffA);
            PG8_WAIT_V(8); PG8_WAIT_L(0); PG8_BAR; PG8_MMA(1, 0, At, B0); PG8_MMA(1, 1, At, B1); PG8_BAR; PG8_SCHED;
            } else {
            PG8_LDB(B0, 0, 0); PG8_SCHED; PG8_LDA(At, 0, 0); PG8_STAGE(PG8_SA(1, 1), a1 + hstep, voffA);
            PG8_WAIT_L(8); PG8_BAR; PG8_WAIT_L(0); PG8_MMA(0, 0, At, B0); PG8_BAR; PG8_SCHED;
            PG8_LDB(B1, 0, 1); PG8_STAGE(PG8_SB(0, 0), b2, voffB);
            PG8_BAR; PG8_WAIT_L(0); PG8_MMA(0, 1, At, B1); PG8_BAR;
            PG8_LDA(At, 0, 1); PG8_STAGE(PG8_SA(0, 0), a2, voffA);
            PG8_BAR; PG8_WAIT_L(0); PG8_MMA(1, 0, At, B0); PG8_BAR; PG8_SCHED;
            PG8_STAGE(PG8_SB(0, 1), b2 + hstep, voffB);
            PG8_WAIT_V(6); PG8_BAR; PG8_MMA(1, 1, At, B1); PG8_BAR;
            PG8_LDB(B0, 1, 0); PG8_SCHED; PG8_LDA(At, 1, 0); PG8_STAGE(PG8_SA(0, 1), a2 + hstep, voffA);
            PG8_WAIT_L(8); PG8_BAR; PG8_WAIT_L(0); PG8_MMA(0, 0, At, B0); PG8_BAR; PG8_SCHED;
            PG8_LDB(B1, 1, 1); PG8_STAGE(PG8_SB(1, 0), b3, voffB);
            PG8_BAR; PG8_WAIT_L(0); PG8_MMA(0, 1, At, B1); PG8_BAR;
            PG8_LDA(At, 1, 1); PG8_STAGE(PG8_SA(1, 0), a3, voffA);
            PG8_BAR; PG8_WAIT_L(0); PG8_MMA(1, 0, At, B0); PG8_BAR; PG8_SCHED;
            PG8_STAGE(PG8_SB(1, 1), b3 + hstep, voffB);
            PG8_WAIT_V(6); PG8_BAR; PG8_MMA(1, 1, At, B1); PG8_BAR;
            }
        }
        if constexpr (ALIGN_EPI) { if (wr == 0) PG8_BAR; }
        asm volatile("" ::: "memory"); __builtin_amdgcn_sched_barrier(0);
        { int t2_ = tid; asm volatile("" : "+v"(t2_)); const int w2_ = __builtin_amdgcn_readfirstlane(t2_ >> 6), l2_ = t2_ & 63; E(acc, cur, w2_ >> 2, w2_ & 3, l2_ & 15, l2_ >> 4); }
        if (!has_next) break;
#pragma unroll
        for (int a = 0; a < 2; ++a)
#pragma unroll
            for (int b = 0; b < 2; ++b)
#pragma unroll
                for (int m = 0; m < 4; ++m)
#pragma unroll
                    for (int n = 0; n < 2; ++n) acc[a][b][m][n] = (f32x4){zf_, zf_, zf_, zf_};
        cur = nxt; cA = nA; cB = nB; ++ui;
        if constexpr (ALIGN_EPI) { if (wr == 1) PG8_BAR; }
    }
    PG8_WAIT_V(0);
    if constexpr (!ALIGN_EPI) { if (wr == 0) PG8_BAR; }
    PG8_BAR;
#undef PG8_SA
#undef PG8_SB
#undef PG8_STAGE
#undef PG8_LDA
#undef PG8_LDB
#undef PG8_MMA
#undef PG8_WAIT_V
#undef PG8_WAIT_L
#undef PG8_BAR
#undef PG8_SCHED
}
}

struct SchedPlain {
    pg8::StaticOrder o; const char* A; const char* B; size_t tstep;
    DI bool next(int i, pg8::Unit& u) const { return o.next(i, u); }
    DI const char* abase(const pg8::Unit& u) const { return A + (size_t)u.pm * tstep; }
    DI const char* bbase(const pg8::Unit& u) const { return B + (size_t)u.pn * tstep; }
};
struct SchedBranch {
    pg8::StaticOrder o; const char* A; const char* B; size_t tstep, aslab;
    DI bool next(int i, pg8::Unit& u) const { pg8::Unit t; if (!o.next(i / 3, t)) return false; u.pm = t.pm; u.pn = t.pn + 4 * (i % 3); return true; }
    DI const char* abase(const pg8::Unit& u) const { return A + (size_t)(u.pn >> 2) * aslab + (size_t)u.pm * tstep; }
    DI const char* bbase(const pg8::Unit& u) const { return B + (size_t)u.pn * tstep; }
};
struct SchedMoe {
    pg8::StaticOrder o; const char* A; const char* B; unsigned eslab; const LAS int* texp;
    DI bool next(int i, pg8::Unit& u) const { return o.next(i, u); }
    DI const char* abase(const pg8::Unit& u) const { return A + (size_t)u.pm * (256u * 1024u); }
    DI const char* bbase(const pg8::Unit& u) const { return B + (size_t)((unsigned)texp[u.pm] * eslab) + (size_t)u.pn * (256u * 1024u); }
};

struct SchedMoeB {
    pg8::StaticOrder o; const char* A; const char* B; unsigned eslab; const LAS int* texp;
    DI bool next(int i, pg8::Unit& u) const { return o.next(i, u); }
    DI const char* abase(const pg8::Unit& u) const { return A + (size_t)u.pm * (256u * 2048u); }
    DI const char* bbase(const pg8::Unit& u) const { return B + (size_t)((unsigned)texp[u.pm] * eslab) + (size_t)u.pn * (256u * 2048u); }
};

#ifndef EPI_QT
#define EPI_QT 1
#endif
#ifndef EPI_QT_ST
#define EPI_QT_ST 1
#endif
DI int qt_src(int lane) { return (((lane >> 2) + 16 * (lane & 3)) * 4); }
DI f32x4 qt4f(int src4, f32x4 v);
DI u32x4 qt4(int src4, u32x4 w) { u32x4 r; r.x = (unsigned)__builtin_amdgcn_ds_bpermute(src4, (int)w.x); r.y = (unsigned)__builtin_amdgcn_ds_bpermute(src4, (int)w.y); r.z = (unsigned)__builtin_amdgcn_ds_bpermute(src4, (int)w.z); r.w = (unsigned)__builtin_amdgcn_ds_bpermute(src4, (int)w.w); return r; }
DI f32x4 qt4f(int src4, f32x4 v) { return __builtin_bit_cast(f32x4, qt4(src4, __builtin_bit_cast(u32x4, v))); }
struct EpiStoreBf16 {
    static constexpr bool PERM = true;
    bf16_t* O; int ldc; int coff = 0;
#ifdef PROBE_NOSTORE
    bool skip = false;
#endif
    DI void operator()(const f32x4 (&acc)[2][2][4][2], const pg8::Unit& u, int wr, int wc, int fr, int fq) const {
#if EPI_QT_ST
        const int lane = fr + 16 * fq, src4 = qt_src(lane); fr = lane >> 2; fq = lane & 3;
#endif
        const int row0 = u.pm * 256 + wr * 64 + fr, col0 = coff + u.pn * 256 + wc * 32 + 8 * fq;
#pragma unroll
        for (int ai = 0; ai < 2; ++ai)
#pragma unroll
            for (int m = 0; m < 4; ++m) { bf16_t* rowp = O + (size_t)(row0 + ai * 128 + m * 16) * ldc + col0;
#pragma unroll
                for (int bj = 0; bj < 2; ++bj) { const f32x4 v0 = acc[ai][bj][m][0], v1 = acc[ai][bj][m][1];
                    u32x4 w; w.x = pk2(v0[0], v0[1]); w.y = pk2(v0[2], v0[3]); w.z = pk2(v1[0], v1[1]); w.w = pk2(v1[2], v1[3]);
#if EPI_QT_ST
                    w = qt4(src4, w);
#endif
#ifdef PROBE_NOSTORE
                    if (skip) { asm volatile("" :: "v"(w.x), "v"(w.y), "v"(w.z), "v"(w.w)); } else
#endif
                    *(u32x4*)(rowp + bj * 128) = w; } }
    }
};
struct EpiStoreBf16N {
    static constexpr bool PERM = false;
    bf16_t* O; int ldc; int coff = 0;
#ifdef PROBE_NOSTORE
    bool skip = false;
#endif
    DI void operator()(const f32x4 (&acc)[2][2][4][2], const pg8::Unit& u, int wr, int wc, int fr, int fq) const {
#if EPI_QT
#if EPI_QT_ST
        const int lane = fr + 16 * fq, a_ = lane >> 2, b_ = lane & 3, src4 = (a_ + 16 * (((b_ & 1) << 1) | (b_ >> 1))) * 4;
        const int row0 = u.pm * 256 + wr * 64 + a_, col0 = coff + u.pn * 256 + wc * 32 + 8 * b_;
#else
        const int row0 = u.pm * 256 + wr * 64 + fr, col0 = coff + u.pn * 256 + wc * 32 + 8 * (((fq & 1) << 1) | (fq >> 1));
#endif
#pragma unroll
        for (int ai = 0; ai < 2; ++ai)
#pragma unroll
            for (int m = 0; m < 4; ++m) { bf16_t* rowp = O + (size_t)(row0 + ai * 128 + m * 16) * ldc + col0;
#pragma unroll
                for (int bj = 0; bj < 2; ++bj) { const f32x4 v0 = acc[ai][bj][m][0], v1 = acc[ai][bj][m][1];
                    unsigned x0 = pk2(v0[0], v0[1]), y0 = pk2(v0[2], v0[3]), x1 = pk2(v1[0], v1[1]), y1 = pk2(v1[2], v1[3]);
                    { const auto r = __builtin_amdgcn_permlane16_swap(x0, x1, false, false); x0 = r[0]; x1 = r[1]; }
                    { const auto r = __builtin_amdgcn_permlane16_swap(y0, y1, false, false); y0 = r[0]; y1 = r[1]; }
                    u32x4 w; w.x = x0; w.y = y0; w.z = x1; w.w = y1;
#if EPI_QT_ST
                    w = qt4(src4, w);
#endif
#ifdef PROBE_NOSTORE
                    if (skip) { asm volatile("" :: "v"(w.x), "v"(w.y), "v"(w.z), "v"(w.w)); } else
#endif
                    *(u32x4*)(rowp + bj * 128) = w; } }
#else
        const int row0 = u.pm * 256 + wr * 64 + fr, col0 = coff + u.pn * 256 + wc * 32 + 4 * fq;
#pragma unroll
        for (int ai = 0; ai < 2; ++ai)
#pragma unroll
            for (int m = 0; m < 4; ++m) { bf16_t* rowp = O + (size_t)(row0 + ai * 128 + m * 16) * ldc + col0;
#pragma unroll
                for (int bj = 0; bj < 2; ++bj)
#pragma unroll
                    for (int n = 0; n < 2; ++n) { const f32x4 v = acc[ai][bj][m][n]; u32x2 w; w.x = pk2(v[0], v[1]); w.y = pk2(v[2], v[3]);
#ifdef PROBE_NOSTORE
                        if (skip) { asm volatile("" :: "v"(w.x), "v"(w.y)); } else
#endif
                        *(u32x2*)(rowp + bj * 128 + n * 16) = w; } }
#endif
    }
};
struct EpiQaRope {
    static constexpr bool PERM = true;
    bf16_t* O; const float* rope;
    DI void operator()(const f32x4 (&acc)[2][2][4][2], const pg8::Unit& u, int wr, int wc, int fr, int fq) const {
        const int row0 = u.pm * 256 + wr * 64 + fr, col0 = u.pn * 256 + wc * 32 + 8 * fq;
#pragma unroll
        for (int ai = 0; ai < 2; ++ai)
#pragma unroll
            for (int m = 0; m < 4; ++m) { const int row = row0 + ai * 128 + m * 16; bf16_t* rowp = O + (size_t)row * 768 + col0;
#pragma unroll
                for (int bj = 0; bj < 2; ++bj) { f32x4 v0 = acc[ai][bj][m][0], v1 = acc[ai][bj][m][1];
                    const int c8 = col0 + bj * 128, p0 = c8 % 96;
                    if (p0 < 32) { const f32x4* cs = (const f32x4*)(rope + (size_t)row * 48 + p0); const f32x4 a = cs[0], b = cs[1];
                        const f32x4 r0 = {v0[0] * a[0] - v0[1] * a[1], v0[1] * a[0] + v0[0] * a[1], v0[2] * a[2] - v0[3] * a[3], v0[3] * a[2] + v0[2] * a[3]};
                        const f32x4 r1 = {v1[0] * b[0] - v1[1] * b[1], v1[1] * b[0] + v1[0] * b[1], v1[2] * b[2] - v1[3] * b[3], v1[3] * b[2] + v1[2] * b[3]};
                        v0 = r0; v1 = r1; }
                    u32x4 w; w.x = pk2(v0[0], v0[1]); w.y = pk2(v0[2], v0[3]); w.z = pk2(v1[0], v1[1]); w.w = pk2(v1[2], v1[3]);
                    *(u32x4*)(rowp + bj * 128) = w; } }
    }
};
struct EpiBranchGate {
    static constexpr bool PERM = true;
    bf16_t* MG; const bf16_t* P; const float* bgate;
    DI void operator()(const f32x4 (&acc)[2][2][4][2], const pg8::Unit& u, int wr, int wc, int fr, int fq) const {
#if EPI_QT
        const int lane = fr + 16 * fq, src4 = qt_src(lane); fr = lane >> 2; fq = lane & 3;
#endif
        const int n = u.pn >> 2, row0 = u.pm * 256 + wr * 64 + fr, colg = u.pn * 256 + wc * 32 + 8 * fq, col0 = colg - n * 1024;
        f32x4 bg[2][2];
#pragma unroll
        for (int bj = 0; bj < 2; ++bj) { bg[bj][0] = *(const f32x4*)(bgate + colg + bj * 128); bg[bj][1] = *(const f32x4*)(bgate + colg + bj * 128 + 4); }
        u32x4 gl[2][2][2], pv[2][2][2];
#define EBG_LOAD(slot, grp) do { _Pragma("unroll") for (int m2 = 0; m2 < 2; ++m2) _Pragma("unroll") for (int bj = 0; bj < 2; ++bj) { const size_t row = (size_t)(row0 + ((grp) >> 1) * 128 + (2 * ((grp) & 1) + m2) * 16); \
            gl[slot][m2][bj] = *(const u32x4*)(P + row * NP + colg + bj * 128); pv[slot][m2][bj] = (n > 0) ? *(const u32x4*)(MG + row * D_MODEL + col0 + bj * 128) : (u32x4){0u, 0u, 0u, 0u}; } } while (0)
        EBG_LOAD(0, 0);
#pragma unroll
        for (int grp = 0; grp < 4; ++grp) {
            const int slot = grp & 1, ai = grp >> 1, mh = grp & 1;
            if (grp + 1 < 4) { if (slot == 0) EBG_LOAD(1, grp + 1); else EBG_LOAD(0, grp + 1); }
            asm volatile("" ::: "memory");
#pragma unroll
            for (int m2 = 0; m2 < 2; ++m2)
#pragma unroll
                for (int bj = 0; bj < 2; ++bj) { const int m = 2 * mh + m2; const size_t row = (size_t)(row0 + ai * 128 + m * 16);
#if EPI_QT
                    const f32x4 v0 = qt4f(src4, acc[ai][bj][m][0]), v1 = qt4f(src4, acc[ai][bj][m][1]);
#else
                    const f32x4 v0 = acc[ai][bj][m][0], v1 = acc[ai][bj][m][1];
#endif
                    const u32x4 g = gl[slot][m2][bj], q = pv[slot][m2][bj];
                    float o[8];
                    o[0] = v0[0] * fast_sigmoid(bf_lo(g.x) + bg[bj][0][0]) + bf_lo(q.x); o[1] = v0[1] * fast_sigmoid(bf_hi(g.x) + bg[bj][0][1]) + bf_hi(q.x);
                    o[2] = v0[2] * fast_sigmoid(bf_lo(g.y) + bg[bj][0][2]) + bf_lo(q.y); o[3] = v0[3] * fast_sigmoid(bf_hi(g.y) + bg[bj][0][3]) + bf_hi(q.y);
                    o[4] = v1[0] * fast_sigmoid(bf_lo(g.z) + bg[bj][1][0]) + bf_lo(q.z); o[5] = v1[1] * fast_sigmoid(bf_hi(g.z) + bg[bj][1][1]) + bf_hi(q.z);
                    o[6] = v1[2] * fast_sigmoid(bf_lo(g.w) + bg[bj][1][2]) + bf_lo(q.w); o[7] = v1[3] * fast_sigmoid(bf_hi(g.w) + bg[bj][1][3]) + bf_hi(q.w);
                    u32x4 w; w.x = pk2(o[0], o[1]); w.y = pk2(o[2], o[3]); w.z = pk2(o[4], o[5]); w.w = pk2(o[6], o[7]);
                    *(u32x4*)(MG + row * D_MODEL + col0 + bj * 128) = w; }
        }
#undef EBG_LOAD
    }
};
struct EpiResidual {
    static constexpr bool PERM = false;
    const float* xin; float* xout; const float* gmod;
    DI void operator()(const f32x4 (&acc)[2][2][4][2], const pg8::Unit& u, int wr, int wc, int fr, int fq) const {
#if EPI_QT
        const int lane = fr + 16 * fq, src4 = qt_src(lane); fr = lane >> 2; fq = lane & 3;
#endif
        const int row0 = u.pm * 256 + wr * 64 + fr, col0 = u.pn * 256 + wc * 32 + 4 * fq;
        const float* gm = gmod + (size_t)(u.pm >> 3) * 6144 + col0;
        f32x4 gv[2][2];
#pragma unroll
        for (int bj = 0; bj < 2; ++bj)
#pragma unroll
            for (int n = 0; n < 2; ++n) gv[bj][n] = *(const f32x4*)(gm + bj * 128 + n * 16);
        f32x4 xv[2][2][2][2];
#define ERS_LOAD(slot, grp) do { _Pragma("unroll") for (int m2 = 0; m2 < 2; ++m2) { const size_t off = (size_t)(row0 + ((grp) >> 1) * 128 + (2 * ((grp) & 1) + m2) * 16) * D_MODEL + col0; \
            _Pragma("unroll") for (int bj = 0; bj < 2; ++bj) _Pragma("unroll") for (int n = 0; n < 2; ++n) xv[slot][m2][bj][n] = *(const f32x4*)(xin + off + bj * 128 + n * 16); } } while (0)
        ERS_LOAD(0, 0);
#pragma unroll
        for (int grp = 0; grp < 4; ++grp) {
            const int slot = grp & 1, ai = grp >> 1, mh = grp & 1;
            if (grp + 1 < 4) { if (slot == 0) ERS_LOAD(1, grp + 1); else ERS_LOAD(0, grp + 1); }
            asm volatile("" ::: "memory");
#pragma unroll
            for (int m2 = 0; m2 < 2; ++m2) { const size_t off = (size_t)(row0 + ai * 128 + (2 * mh + m2) * 16) * D_MODEL + col0;
#pragma unroll
                for (int bj = 0; bj < 2; ++bj)
#pragma unroll
                    for (int n = 0; n < 2; ++n) {
#if EPI_QT
                        const f32x4 av = qt4f(src4, acc[ai][bj][2 * mh + m2][n]);
#else
                        const f32x4 av = acc[ai][bj][2 * mh + m2][n];
#endif
                        *(f32x4*)(xout + off + bj * 128 + n * 16) = xv[slot][m2][bj][n] + gv[bj][n] * av; } }
        }
#undef ERS_LOAD
    }
};
struct EpiSwiglu {
    static constexpr bool PERM = false;
    bf16_t* ACT; const float* b1; const LAS int* texp;
    DI void operator()(const f32x4 (&acc)[2][2][4][2], const pg8::Unit& u, int wr, int wc, int fr, int fq) const {
        const int row0 = u.pm * 256 + wr * 64 + fr, e = texp[u.pm];
        const float* bb = b1 + (size_t)e * 2048;
#pragma unroll
        for (int bj = 0; bj < 2; ++bj) { const int j0 = u.pn * 128 + bj * 64 + wc * 16 + 4 * fq;
            const f32x4 ba = *(const f32x4*)(bb + 2 * j0), bc = *(const f32x4*)(bb + 2 * j0 + 4);
            const f32x4 bgt = {ba[0], ba[2], bc[0], bc[2]}, bup = {ba[1], ba[3], bc[1], bc[3]};
#pragma unroll
            for (int ai = 0; ai < 2; ++ai)
#pragma unroll
                for (int m = 0; m < 4; ++m) { const f32x4 g = acc[ai][bj][m][0] + bgt, up = acc[ai][bj][m][1] + bup; float o[4];
#pragma unroll
                    for (int i = 0; i < 4; ++i) { const float gg = fminf(g[i], 7.0f), uu = fminf(fmaxf(up[i], -7.0f), 7.0f);
                        o[i] = (uu + 1.0f) * gg * fast_sigmoid(1.702f * gg);
                    }
                    u32x2 w; w.x = pk2(o[0], o[1]); w.y = pk2(o[2], o[3]);
                    *(u32x2*)(ACT + (size_t)(row0 + ai * 128 + m * 16) * D_EXP + j0) = w; } }
    }
};
struct EpiSwiglu8 {
    static constexpr bool PERM = false;
    unsigned char* ACT; const float* b1; const LAS int* texp;
#ifdef PROBE_M1
    int skip = 0;
#endif
    DI void operator()(const f32x4 (&acc)[2][2][4][2], const pg8::Unit& u, int wr, int wc, int fr, int fq) const {
#ifdef PROBE_M1
        if (skip == 2) {
#pragma unroll
            for (int ai = 0; ai < 2; ++ai)
#pragma unroll
                for (int bj = 0; bj < 2; ++bj)
#pragma unroll
                    for (int m = 0; m < 4; ++m)
#pragma unroll
                        for (int n = 0; n < 2; ++n) asm volatile("" :: "v"(acc[ai][bj][m][n][0]), "v"(acc[ai][bj][m][n][1]), "v"(acc[ai][bj][m][n][2]), "v"(acc[ai][bj][m][n][3]));
            return; }
#endif
        const int row0 = u.pm * 256 + wr * 64 + fr, e = texp[u.pm];
        const float* bb = b1 + (size_t)e * 2048;
#pragma unroll
        for (int bj = 0; bj < 2; ++bj) { const int j0 = u.pn * 128 + bj * 64 + wc * 16 + 4 * fq;
            const f32x4 ba = *(const f32x4*)(bb + 2 * j0), bc = *(const f32x4*)(bb + 2 * j0 + 4);
            const f32x4 bgt = {ba[0], ba[2], bc[0], bc[2]}, bup = {ba[1], ba[3], bc[1], bc[3]};
#pragma unroll
            for (int ai = 0; ai < 2; ++ai) {
                unsigned w[4];
#pragma unroll
                for (int m = 0; m < 4; ++m) { const f32x4 g = acc[ai][bj][m][0] + bgt, up = acc[ai][bj][m][1] + bup; float o[4];
#pragma unroll
                    for (int i = 0; i < 4; ++i) { const float gg = fminf(g[i], 7.0f), uu = fminf(fmaxf(up[i], -7.0f), 7.0f);
                        o[i] = (uu + 1.0f) * gg * fast_sigmoid(1.702f * gg);
                    }
                    w[m] = pk4_fp8(o[0], o[1], o[2], o[3]); }
                { const auto r = __builtin_amdgcn_permlane16_swap(w[0], w[1], false, false); w[0] = r[0]; w[1] = r[1]; }
                { const auto r = __builtin_amdgcn_permlane16_swap(w[2], w[3], false, false); w[2] = r[0]; w[3] = r[1]; }
                { const auto r = __builtin_amdgcn_permlane32_swap(w[0], w[2], false, false); w[0] = r[0]; w[2] = r[1]; }
                { const auto r = __builtin_amdgcn_permlane32_swap(w[1], w[3], false, false); w[1] = r[0]; w[3] = r[1]; }
                u32x4 wv; wv.x = w[0]; wv.y = w[1]; wv.z = w[2]; wv.w = w[3];
#ifdef PROBE_M1
                if (skip == 1) { asm volatile("" :: "v"(wv.x), "v"(wv.y), "v"(wv.z), "v"(wv.w)); } else
#endif
                *(u32x4*)(ACT + (size_t)(row0 + ai * 128 + fq * 16) * D_EXP + (j0 - 4 * fq)) = wv; } }
    }
};
struct EpiMoeOut {
    static constexpr bool PERM = true;
    bf16_t* Y; const float* b2; const float* gate; const LAS int* texp;
    DI void operator()(const f32x4 (&acc)[2][2][4][2], const pg8::Unit& u, int wr, int wc, int fr, int fq) const {
        const int row0 = u.pm * 256 + wr * 64 + fr, col0 = u.pn * 256 + wc * 32 + 8 * fq, e = texp[u.pm];
        const float* bb = b2 + (size_t)e * D_MODEL + col0;
#if EPI_QT_ST
        const int lane = fr + 16 * fq, src4 = qt_src(lane), rowq = (lane >> 2) - fr, colq = 8 * ((lane & 3) - fq);
#endif
        f32x4 bv[2][2];
#pragma unroll
        for (int bj = 0; bj < 2; ++bj) { bv[bj][0] = *(const f32x4*)(bb + bj * 128); bv[bj][1] = *(const f32x4*)(bb + bj * 128 + 4); }
#pragma unroll
        for (int ai = 0; ai < 2; ++ai) {
            float gt[4];
#pragma unroll
            for (int m = 0; m < 4; ++m) gt[m] = gate[row0 + ai * 128 + m * 16];
            asm volatile("" ::: "memory");
#pragma unroll
            for (int m = 0; m < 4; ++m) { const int row = row0 + ai * 128 + m * 16; const float g = gt[m];
#pragma unroll
                for (int bj = 0; bj < 2; ++bj) { const f32x4 v0 = (acc[ai][bj][m][0] + bv[bj][0]) * g, v1 = (acc[ai][bj][m][1] + bv[bj][1]) * g;
                    u32x4 w; w.x = pk2(v0[0], v0[1]); w.y = pk2(v0[2], v0[3]); w.z = pk2(v1[0], v1[1]); w.w = pk2(v1[2], v1[3]);
#if EPI_QT_ST
                    *(u32x4*)(Y + (size_t)(row + rowq) * D_MODEL + col0 + colq + bj * 128) = qt4(src4, w); } }
#else
                    *(u32x4*)(Y + (size_t)row * D_MODEL + col0 + bj * 128) = w; } }
#endif
            asm volatile("" ::: "memory");
        }
    }
};

constexpr size_t MiB = 1u << 20;
constexpr size_t WS_CTL = 0, CTL_ZERO_BYTES = 1 * MiB;
constexpr size_t WS_MOD = 1 * MiB, WS_ROPE = 2 * MiB, WS_WIN = 8 * MiB, WS_WUQ = 33 * MiB, WS_WUKV = 34 * MiB, WS_WB = 35 * MiB, WS_WOUT = 41 * MiB, WS_W1 = 53 * MiB, WS_W2 = 309 * MiB,
                 WS_X1 = 437 * MiB, WS_H = 565 * MiB, WS_CQ = 629 * MiB, WS_CKV = 645 * MiB, WS_KPE = 661 * MiB, WS_QA = 663 * MiB, WS_KV = 711 * MiB, WS_O3 = 775 * MiB, WS_QC = 871 * MiB,
                 WS_KC = 903 * MiB, WS_VC = 907 * MiB, WS_QI = 911 * MiB, WS_KI = 943 * MiB, WS_IW = 947 * MiB, WS_ROUTE = 948 * MiB, WS_P = 952 * MiB, WS_GY = 1352 * MiB, WS_END = 1544 * MiB;
constexpr size_t WS_HG8 = WS_QA;
constexpr size_t WS_XB = WS_P, WS_ACT = WS_P + 272 * MiB, WS_Y = WS_P, WS_H8 = WS_H;
constexpr size_t RT_TOPE = 0, RT_TOPG = 512 * 1024, RT_RANK = 1 * MiB, RT_SLOTOF = 1 * MiB + 512 * 1024, RT_TOKOF = 2 * MiB, RT_GATEOF = 3 * MiB;
static_assert((size_t)NSLOT_MAX * 1024 * 2 <= 272 * MiB && WS_ACT + 272 * MiB <= WS_END, "MoE overlay: XB (fp8) and Y (bf16) share [P, P+272M) (XB is dead when Y is written); ACT in [P+272M, P+544M)");
static_assert((size_t)T_TOK * NP * 2 == 400 * MiB, "P size");
constexpr int CW_BAR = 4096, CW_CNT = 16384;
constexpr int LDS_BYTES = 163840, LDS_X = 131072, MISC_OFF = LDS_BYTES - 512;

struct Frame {
    LAS unsigned char* lds; int tid, lane, wave, G, bid; float zf;
    float* out; unsigned char* ws; unsigned* ctl;
};
extern __shared__ __attribute__((aligned(16))) unsigned char lds_raw[];
typedef __attribute__((address_space(4))) const char* kptr_t;
DI const void* kin(int i) {
#if defined(__HIP_DEVICE_COMPILE__)
    kptr_t ka = (kptr_t)__builtin_amdgcn_kernarg_segment_ptr(); asm volatile("" : "+s"(ka)); return (const void*)(GAS const void*)*(__attribute__((address_space(4))) const unsigned long long*)(ka + 8 * i);
#else
    (void)i; return nullptr;
#endif
}
#define KIN_x ((const float*)kin(0))
#define KIN_c ((const float*)kin(1))
#define KIN_pos ((const int*)kin(2))
#define KIN_norm1_g ((const float*)kin(3))
#define KIN_norm2_g ((const float*)kin(4))
#define KIN_w_ada ((const float*)kin(5))
#define KIN_b_ada ((const float*)kin(6))
#define KIN_w_in ((const float*)kin(7))
#define KIN_b_gate ((const float*)kin(8))
#define KIN_q_norm ((const float*)kin(9))
#define KIN_w_uq ((const float*)kin(10))
#define KIN_kv_norm ((const float*)kin(11))
#define KIN_w_ukv ((const float*)kin(12))
#define KIN_conv_w ((const float*)kin(13))
#define KIN_w_branch ((const float*)kin(14))
#define KIN_w_out ((const float*)kin(15))
#define KIN_router_w ((const float*)kin(16))
#define KIN_router_b ((const float*)kin(17))
#define KIN_w1 ((const float*)kin(18))
#define KIN_b1 ((const float*)kin(19))
#define KIN_w2 ((const float*)kin(20))
#define KIN_b2 ((const float*)kin(21))
#define KIN_final_g ((const float*)kin(22))
DI Frame make_frame(int wave0) {
    Frame F; unsigned z_ = 0u; asm volatile("" : "+v"(z_));
    F.lds = (LAS unsigned char*)lds_raw; F.lane = (int)__builtin_amdgcn_mbcnt_hi(~0u, __builtin_amdgcn_mbcnt_lo(~0u, z_)); F.wave = wave0; F.tid = wave0 * 64 + F.lane; F.G = gridDim.x; F.bid = blockIdx.x; F.zf = __uint_as_float(z_);
    F.out = (float*)kin(23); F.ws = (unsigned char*)kin(24); F.ctl = (unsigned*)F.ws;
    return F;
}
#define WSP(T, off) ((T*)(F.ws + (off)))
#ifndef STAG_MODE
#define STAG_MODE 1
#endif
#ifndef STAG_SCALE
#define STAG_SCALE 100
#endif
DI void stagger(const Frame& F, int spread_us) {
#if STAG_MODE == 0
    const unsigned ticks = (unsigned)(spread_us * STAG_SCALE) * (unsigned)F.bid / (unsigned)F.G;
#elif STAG_MODE == 1
    const unsigned ticks = (unsigned)(spread_us * STAG_SCALE) * (unsigned)(F.bid & 7) / 8u;
#else
    const unsigned ticks = (unsigned)(spread_us * STAG_SCALE) * (unsigned)((F.bid >> 3) & 3) / 4u;
#endif
    if (ticks == 0u) return;
    const unsigned long long t0 = __builtin_amdgcn_s_memrealtime();
    while ((unsigned)(__builtin_amdgcn_s_memrealtime() - t0) < ticks) __builtin_amdgcn_s_sleep(8);
}


#define XB_TMO      128
#define XB_XCNT(j)  (256  + 64 * (j))
#define XB_XSUB(j)  (1280 + 64 * (j))
#define XB_XGEN(j)  (2304 + 64 * (j))
#define XB_TOP      3328
#define XB_TOPGEN   3392
#define XCD_BAR_WORDS 3456
#define XB_SPIN_CAP (1u << 18)
DI unsigned xb_ld(unsigned* p)              { return __hip_atomic_load(p, __ATOMIC_RELAXED, __HIP_MEMORY_SCOPE_AGENT); }
DI unsigned xb_add(unsigned* p, unsigned v) { return __hip_atomic_fetch_add(p, v, __ATOMIC_RELAXED, __HIP_MEMORY_SCOPE_AGENT); }
DI unsigned xb_xcc_id() { return (unsigned)__builtin_amdgcn_s_getreg((3 << 11) | 20) & 0xFu; }
#define XB_SPIN(cond, bar) do { unsigned _sp = 0; while (cond) { __builtin_amdgcn_s_sleep(1); \
    if ((++_sp & 255u) == 0u) { if (xb_ld(&(bar)[XB_TMO])) break; if (_sp > XB_SPIN_CAP) { atomicAdd(&(bar)[XB_TMO], 1u); break; } } } } while (0)
struct XcdBarrier { unsigned* bar; unsigned x; volatile LAS unsigned* st; };
DI XcdBarrier xcd_barrier_post(unsigned* bar, volatile LAS unsigned* st, int tid) {
    XcdBarrier b; b.bar = bar; b.x = xb_xcc_id(); b.st = st;
    if (tid == 0) (void)xb_add(&bar[XB_XCNT(b.x)], 1u);
    return b;
}
DI void xcd_barrier_complete(unsigned* bar, unsigned x, unsigned& nloc, unsigned& nx) {
    const unsigned G = gridDim.x * gridDim.y * gridDim.z;
    unsigned sum, cnt, mine, sp = 0u;
    for (;;) {
        sum = 0u; cnt = 0u; mine = 0u;
#pragma unroll
        for (unsigned j = 0; j < 16; ++j) { const unsigned c = xb_ld(&bar[XB_XCNT(j)]); sum += c; cnt += (c > 0u) ? 1u : 0u; mine = (j == x) ? c : mine; }
        if (sum == G) break;
        __builtin_amdgcn_s_sleep(1);
        if ((++sp & 255u) == 0u) { if (xb_ld(&bar[XB_TMO])) break; if (sp > XB_SPIN_CAP) { atomicAdd(&bar[XB_TMO], 1u); break; } }
    }
    nloc = mine > 0u ? mine : 1u; nx = cnt > 0u ? cnt : 1u;
}
DI void xcd_barrier(const XcdBarrier& b, int tid) {
    asm volatile("s_waitcnt vmcnt(0)" ::: "memory");
    __syncthreads();
    if (tid == 0) {
        unsigned* bar = b.bar;
        __builtin_amdgcn_s_waitcnt(0);
        unsigned nloc = b.st[0], nx = b.st[1];
        if (nloc == 0u) { xcd_barrier_complete(bar, b.x, nloc, nx); b.st[0] = nloc; b.st[1] = nx; }
        const unsigned old = xb_add(&bar[XB_XSUB(b.x)], 1u);
        const unsigned gen = old / nloc;
        if (old + 1u == (gen + 1u) * nloc) {
            __builtin_amdgcn_fence(__ATOMIC_RELEASE, "agent");
            asm volatile("s_waitcnt vmcnt(0)" ::: "memory");
            const unsigned og = xb_add(&bar[XB_TOP], 1u);
            const unsigned tg = og / nx;
            if (og + 1u == (tg + 1u) * nx) xb_add(&bar[XB_TOPGEN], 1u);
            else XB_SPIN(xb_ld(&bar[XB_TOPGEN]) == tg, bar);
            __builtin_amdgcn_fence(__ATOMIC_ACQUIRE, "agent");
            xb_add(&bar[XB_XGEN(b.x)], 1u);
            asm volatile("s_waitcnt vmcnt(0)" ::: "memory");
        } else {
            XB_SPIN(xb_ld(&bar[XB_XGEN(b.x)]) == gen, bar);
            __builtin_amdgcn_fence(__ATOMIC_ACQUIRE, "agent");
            asm volatile("s_waitcnt vmcnt(0)" ::: "memory");
        }
    }
    __syncthreads();
}

#ifndef G1_F8_COLS
#define G1_F8_COLS 3072
#endif
DI int rope_perm(int p, int half) { return (p < 2 * half) ? (p >> 1) + half * (p & 1) : p; }
DI int cmap_in(int r) {
    if (r < PC_CONV) return OC_GATE + r;
    if (r < PC_DQ) return OC_CONV + (r - PC_CONV);
    if (r < PC_IQ) { const int j = r - PC_DQ; return OC_DQ + (j & ~63) + rope_perm(j & 63, 8); }
    if (r < PC_QLAT) { const int j = r - PC_IQ; return OC_IQ + (j & ~63) + rope_perm(j & 63, 8); }
    if (r < PC_KVLAT) return OC_QLAT + (r - PC_QLAT);
    if (r < PC_DKV) { const int j = r - PC_KVLAT; return j < 128 ? OC_KVLAT + j : OC_KVLAT + 128 + rope_perm(j - 128, 16); }
    if (r < PC_IK) { const int j = r - PC_DKV; return j < 64 ? OC_DKV + rope_perm(j, 8) : OC_DKV + j; }
    if (r < PC_IW) return OC_IK + rope_perm(r - PC_IK, 8);
    if (r < IN_COLS) return OC_IW + (r - PC_IW);
    return -1;
}
DI int cmap_uq(int r) { const int h = r / 96, p = r % 96; return h * 96 + rope_perm(p, 16); }
DI int cmap_w1(int R) { const int pn = R >> 8, rem = R & 255, bj = rem >> 7, wc = (rem >> 5) & 3, n = (rem >> 4) & 1, f = rem & 15; return 2 * (pn * 128 + bj * 64 + wc * 16 + f) + n; }
DI void transpose_item(const float* W, int K, int N, bf16_t* WT, int ldk, int koff, LAS float* scr, int k0, int n0, int csrc, int lane) {
#pragma unroll 8
    for (int i = 0; i < 32; ++i) { const int kk = 2 * i + (lane >> 5); float v = 0.f; if (csrc >= 0 && k0 + kk < K) v = W[(size_t)(k0 + kk) * N + csrc]; scr[kk * 33 + (lane & 31)] = v; }
    LDS_WAIT(); asm volatile("" ::: "memory");
    const int c = lane & 7;
#pragma unroll
    for (int j = 0; j < 4; ++j) { const int n = (lane >> 3) + 8 * j; const LAS float* s = scr + (8 * c) * 33 + n;
        u32x4 o; o.x = pk2(s[0 * 33], s[1 * 33]); o.y = pk2(s[2 * 33], s[3 * 33]); o.z = pk2(s[4 * 33], s[5 * 33]); o.w = pk2(s[6 * 33], s[7 * 33]);
        *(u32x4*)(WT + (size_t)(n0 + n) * ldk + koff + k0 + 8 * c) = o; }
    LDS_WAIT(); asm volatile("" ::: "memory");
}
DI void transpose_item_f8(const float* W, int K, int N, unsigned char* WT, int ldk, LAS float* scr, int k0, int n0, int csrc, int lane, float qs) {
#pragma unroll 8
    for (int i = 0; i < 32; ++i) { const int kk = 2 * i + (lane >> 5); scr[kk * 33 + (lane & 31)] = W[(size_t)(k0 + kk) * N + csrc] * qs; }
    LDS_WAIT(); asm volatile("" ::: "memory");
    const int c = lane & 7;
#pragma unroll
    for (int j = 0; j < 4; ++j) { const int n = (lane >> 3) + 8 * j; const LAS float* s = scr + (8 * c) * 33 + n;
        u32x2 o; o.x = pk4_fp8(s[0 * 33], s[1 * 33], s[2 * 33], s[3 * 33]); o.y = pk4_fp8(s[4 * 33], s[5 * 33], s[6 * 33], s[7 * 33]);
        *(u32x2*)(WT + (size_t)(n0 + n) * ldk + k0 + 8 * c) = o; }
    LDS_WAIT(); asm volatile("" ::: "memory");
}
DI void titem_load(const float* W, int N, int k0, int csrc, int lane, float (&v)[32]) {
#pragma unroll
    for (int i = 0; i < 32; ++i) v[i] = W[(size_t)(k0 + 2 * i + (lane >> 5)) * N + csrc];
}
DI void titem_store_f8(const float (&v)[32], unsigned char* WT, int ldk, LAS float* scr, int k0, int n0, int lane, float qs) {
#pragma unroll
    for (int i = 0; i < 32; ++i) scr[(2 * i + (lane >> 5)) * 33 + (lane & 31)] = v[i] * qs;
    LDS_WAIT(); asm volatile("" ::: "memory");
    const int c = lane & 7;
#pragma unroll
    for (int j = 0; j < 4; ++j) { const int n = (lane >> 3) + 8 * j; const LAS float* s = scr + (8 * c) * 33 + n;
        u32x2 o; o.x = pk4_fp8(s[0 * 33], s[1 * 33], s[2 * 33], s[3 * 33]); o.y = pk4_fp8(s[4 * 33], s[5 * 33], s[6 * 33], s[7 * 33]);
        *(u32x2*)(WT + (size_t)(n0 + n) * ldk + k0 + 8 * c) = o; }
    LDS_WAIT(); asm volatile("" ::: "memory");
}
template <bool W1>
DI void convert_family_f8(const float* src, unsigned char* dst, int N, int nmat, LAS float* scr, int gw, int NGW, int lane) {
    const int nbn = N / 32, ipm = 16 * nbn, total = nmat * ipm;
    float va[32], vb[32];
#define TF_DECODE(it, j_, k0_, n0_, cs_) const int j_ = (it) / ipm, q_##j_ = (it) % ipm, k0_ = 64 * (q_##j_ / nbn), n0_ = 32 * (q_##j_ % nbn), cs_ = W1 ? cmap_w1(n0_ + (lane & 31)) : n0_ + (lane & 31)
    int it = gw;
    if (it < total) { TF_DECODE(it, j0, k00, n00, cs0); titem_load(src + (size_t)j0 * 1024 * N, N, k00, cs0, lane, va); }
    while (it < total) {
        const int it2 = it + NGW;
        if (it2 < total) { TF_DECODE(it2, j2, k02, n02, cs2); titem_load(src + (size_t)j2 * 1024 * N, N, k02, cs2, lane, vb); }
        { TF_DECODE(it, j1, k01, n01, cs1); (void)cs1; titem_store_f8(va, dst + (size_t)j1 * N * 1024, 1024, scr, k01, n01, lane, 64.0f); }
        const int it3 = it2 + NGW;
        if (it3 < total) { TF_DECODE(it3, j3, k03, n03, cs3); titem_load(src + (size_t)j3 * 1024 * N, N, k03, cs3, lane, va); }
        if (it2 < total) { TF_DECODE(it2, j4, k04, n04, cs4); (void)cs4; titem_store_f8(vb, dst + (size_t)j4 * N * 1024, 1024, scr, k04, n04, lane, 64.0f); }
        it = it3;
    }
#undef TF_DECODE
}
DI void sincos_d(double x, float& s, float& c) {
    const double kd = __builtin_rint(x * 0.6366197723675814); const int k = (int)kd;
    double r = __builtin_fma(-kd, 1.5707963267948966, x); r = __builtin_fma(-kd, 6.123233995736766e-17, r);
    const double r2 = r * r;
    const double sp = r * (1.0 + r2 * (-1.0 / 6 + r2 * (1.0 / 120 + r2 * (-1.0 / 5040 + r2 * (1.0 / 362880 + r2 * (-1.0 / 39916800 + r2 * (1.0 / 6227020800.0)))))));
    const double cp = 1.0 + r2 * (-0.5 + r2 * (1.0 / 24 + r2 * (-1.0 / 720 + r2 * (1.0 / 40320 + r2 * (-1.0 / 3628800 + r2 * (1.0 / 479001600.0 + r2 * (-1.0 / 87178291200.0)))))));
    const int q = k & 3;
    const double ss = (q == 0) ? sp : (q == 1) ? cp : (q == 2) ? -sp : -cp;
    const double cc = (q == 0) ? cp : (q == 1) ? -sp : (q == 2) ? -cp : sp;
    s = (float)ss; c = (float)cc;
}
DI void phase_prologue(const Frame& F) {
    const int tid = F.tid, lane = F.lane, wave = F.wave;
    __syncthreads();
    const float* in_c = KIN_c; const float* in_wada = KIN_w_ada; const float* in_bada = KIN_b_ada; const int* in_pos = KIN_pos;
    if (F.bid < 192) {
        LAS float* cact = (LAS float*)F.lds;
        LAS float* red = (LAS float*)(F.lds + 65536);
        for (int idx = tid; idx < 16 * 1024; idx += 512) { const int b = idx >> 10, k = idx & 1023; const float cv = in_c[idx]; cact[k * 16 + b] = cv * fast_sigmoid(cv); }
        __syncthreads();
        float* MOD = WSP(float, WS_MOD);
        for (int it = F.bid; it < 192; it += F.G) {
            const int l = it / 96, cb = it % 96, col = cb * 64 + lane;
            float acc[16];
#pragma unroll
            for (int b = 0; b < 16; ++b) acc[b] = 0.f;
            const float* wp = in_wada + ((size_t)l * 1024 + wave * 128) * 6144 + col;
#pragma unroll 4
            for (int kk = 0; kk < 128; ++kk) { const float wv = wp[(size_t)kk * 6144]; const LAS f32x4* cp = (const LAS f32x4*)(cact + (wave * 128 + kk) * 16);
#pragma unroll
                for (int q = 0; q < 4; ++q) { const f32x4 cv = cp[q]; acc[4 * q] += cv[0] * wv; acc[4 * q + 1] += cv[1] * wv; acc[4 * q + 2] += cv[2] * wv; acc[4 * q + 3] += cv[3] * wv; } }
#pragma unroll
            for (int b = 0; b < 16; ++b) red[(wave * 16 + b) * 64 + lane] = acc[b];
            __syncthreads();
            for (int o = tid; o < 1024; o += 512) { const int b = o >> 6, ln = o & 63; float s = in_bada[l * 6144 + cb * 64 + ln];
#pragma unroll
                for (int w = 0; w < 8; ++w) s += red[(w * 16 + b) * 64 + ln];
                MOD[((size_t)l * 16 + b) * 6144 + cb * 64 + ln] = s; }
            __syncthreads();
        }
    }
    __syncthreads();
    {
        float* ROPE = WSP(float, WS_ROPE);
        const double r16 = 0.44036660267178046;
        for (int idx = F.bid * 512 + tid; idx < T_TOK * 24; idx += F.G * 512) {
            const int t = idx / 24, i = idx % 24; const int e = (i < 16) ? i : 2 * (i - 16);
            double f = 1.0; for (int j = 0; j < e; ++j) f *= r16;
            float s, c; sincos_d((double)in_pos[t] * f, s, c);
            ROPE[(size_t)t * 48 + 2 * i] = c; ROPE[(size_t)t * 48 + 2 * i + 1] = s;
        }
    }
    {
        LAS float* scr = (LAS float*)(F.lds + wave * 16384);
        const int gw = F.bid * 8 + wave, NGW = F.G * 8;
        constexpr int I_IN = 16 * 200, I_UQ = 4 * 24, I_UKV = 4 * 32, I_WB = 8 * 32, I_WO = 16 * 32, I_W1 = 16 * 64, I_W2 = 16 * 32;
        constexpr int N_IN = 2 * I_IN, N_UQ = 2 * I_UQ, N_UKV = 2 * I_UKV, N_WB = 6 * I_WB, N_WO = 2 * I_WO, N_W1 = 64 * I_W1, N_W2 = 64 * I_W2;
        constexpr int NITEMS = N_IN + N_UQ + N_UKV + N_WB + N_WO;
        (void)N_W1; (void)N_W2;
        for (int it = gw; it < NITEMS; it += NGW) {
            int r = it;
            if (r < N_IN) { const int l = r / I_IN, q = r % I_IN, kb = q / 200, nb = q % 200;
                if (32 * nb < G1_F8_COLS) transpose_item_f8(KIN_w_in + (size_t)l * 1024 * IN_COLS, 1024, IN_COLS, WSP(unsigned char, WS_WIN) + (size_t)l * NP * 2048, 1024, scr, 64 * kb, 32 * nb, cmap_in(32 * nb + (lane & 31)), lane, 64.0f);
                else transpose_item(KIN_w_in + (size_t)l * 1024 * IN_COLS, 1024, IN_COLS, WSP(bf16_t, WS_WIN) + (size_t)l * NP * 1024, 1024, 0, scr, 64 * kb, 32 * nb, cmap_in(32 * nb + (lane & 31)), lane);
                continue; } r -= N_IN;
            if (r < N_UQ) { const int l = r / I_UQ, q = r % I_UQ, kb = q / 24, nb = q % 24;
                transpose_item(KIN_w_uq + (size_t)l * 256 * 768, 256, 768, WSP(bf16_t, WS_WUQ) + (size_t)l * 768 * 256, 256, 0, scr, 64 * kb, 32 * nb, cmap_uq(32 * nb + (lane & 31)), lane); continue; } r -= N_UQ;
            if (r < N_UKV) { const int l = r / I_UKV, q = r % I_UKV, kb = q / 32, nb = q % 32;
                transpose_item(KIN_w_ukv + (size_t)l * 128 * 1024, 128, 1024, WSP(bf16_t, WS_WUKV) + (size_t)l * 1024 * 256, 256, 0, scr, 64 * kb, 32 * nb, 32 * nb + (lane & 31), lane); continue; } r -= N_UKV;
            if (r < N_WB) { const int j = r / I_WB, q = r % I_WB, kb = q / 32, nb = q % 32;
                transpose_item(KIN_w_branch + (size_t)j * 512 * 1024, 512, 1024, WSP(bf16_t, WS_WB) + (size_t)j * 1024 * 512, 512, 0, scr, 64 * kb, 32 * nb, 32 * nb + (lane & 31), lane); continue; } r -= N_WB;
            if (r < N_WO) { const int l = r / I_WO, q = r % I_WO, kb = q / 32, nb = q % 32;
                transpose_item(KIN_w_out + (size_t)l * 1024 * 1024, 1024, 1024, WSP(bf16_t, WS_WOUT) + (size_t)l * 1024 * 1024, 1024, 0, scr, 64 * kb, 32 * nb, 32 * nb + (lane & 31), lane); continue; } r -= N_WO;
            (void)r;
        }
        convert_family_f8<true>(KIN_w1, WSP(unsigned char, WS_W1), 2048, 64, scr, gw, NGW, lane);
#if M2_F8
        convert_family_f8<false>(KIN_w2, WSP(unsigned char, WS_W2), 1024, 64, scr, gw, NGW, lane);
#else
        for (int it = gw; it < 64 * I_W2; it += NGW) { const int j = it / I_W2, q = it % I_W2, kb = q / 32, nb = q % 32;
            transpose_item(KIN_w2 + (size_t)j * 1024 * 1024, 1024, 1024, WSP(bf16_t, WS_W2) + (size_t)j * 1024 * 1024, 1024, 0, scr, 64 * kb, 32 * nb, 32 * nb + (lane & 31), lane); }
#endif
    }
}

DI void phase_norm(const Frame& F, const float* xin, float* xout, bool combine, bool write_x, bool final_, int lnext, int lcomb) {
    const int lane = F.lane, gw = F.bid * 8 + F.wave, NGW = F.G * 8;
    const float* in_fg = KIN_final_g; const float* in_n1 = KIN_norm1_g;
    const float* MOD = WSP(float, WS_MOD); const bf16_t* Y = WSP(bf16_t, WS_Y); const int* SLOTOF = (const int*)(F.ws + WS_ROUTE + RT_SLOTOF); bf16_t* H = WSP(bf16_t, WS_H);
    u32x4 slots = {0u, 0u, 0u, 0u};
    if (combine && gw < T_TOK) slots = *(const u32x4*)(SLOTOF + (size_t)gw * 4);
    for (int t = gw; t < T_TOK; t += NGW) {
        const int b = t >> 11; f32x4 v[4];
#pragma unroll
        for (int i = 0; i < 4; ++i) v[i] = *(const f32x4*)(xin + (size_t)t * 1024 + 4 * lane + 256 * i);
        if (combine) {
            const unsigned s0 = slots.x, s1 = slots.y, s2 = slots.z, s3 = slots.w;
            u32x2 ya[4], yb[4], yc[4], yd[4];
#pragma unroll
            for (int i = 0; i < 4; ++i) { const int co = 4 * lane + 256 * i;
                ya[i] = *(const u32x2*)(Y + (size_t)s0 * 1024 + co); yb[i] = *(const u32x2*)(Y + (size_t)s1 * 1024 + co); yc[i] = *(const u32x2*)(Y + (size_t)s2 * 1024 + co); yd[i] = *(const u32x2*)(Y + (size_t)s3 * 1024 + co); }
            if (t + NGW < T_TOK) slots = *(const u32x4*)(SLOTOF + (size_t)(t + NGW) * 4);
            const float* g2 = MOD + ((size_t)lcomb * 16 + b) * 6144 + 5 * 1024;
#pragma unroll
            for (int i = 0; i < 4; ++i) { const int co = 4 * lane + 256 * i; const u32x2 a = ya[i], bq = yb[i], cq = yc[i], dq = yd[i];
                f32x4 sum = {bf_lo(a.x) + bf_lo(bq.x) + bf_lo(cq.x) + bf_lo(dq.x), bf_hi(a.x) + bf_hi(bq.x) + bf_hi(cq.x) + bf_hi(dq.x),
                             bf_lo(a.y) + bf_lo(bq.y) + bf_lo(cq.y) + bf_lo(dq.y), bf_hi(a.y) + bf_hi(bq.y) + bf_hi(cq.y) + bf_hi(dq.y)};
                v[i] += *(const f32x4*)(g2 + co) * sum; }
            if (write_x) {
#pragma unroll
                for (int i = 0; i < 4; ++i) *(f32x4*)(xout + (size_t)t * 1024 + 4 * lane + 256 * i) = v[i]; }
        }
        float ss = 0.f;
#pragma unroll
        for (int i = 0; i < 4; ++i) ss += (v[i][0] * v[i][0] + v[i][1] * v[i][1]) + (v[i][2] * v[i][2] + v[i][3] * v[i][3]);
        ss = wave_sum(ss); const float r = 1.0f / sqrtf(ss * (1.0f / 1024.0f) + NORM_EPS);
        if (final_) {
#pragma unroll
            for (int i = 0; i < 4; ++i) { const int co = 4 * lane + 256 * i; *(f32x4*)(F.out + (size_t)t * 1024 + co) = v[i] * r * *(const f32x4*)(in_fg + co); }
        } else {
            const float* md = MOD + ((size_t)lnext * 16 + b) * 6144;
#pragma unroll
            for (int i = 0; i < 4; ++i) { const int co = 4 * lane + 256 * i;
                const f32x4 g = *(const f32x4*)(in_n1 + lnext * 1024 + co), sc = *(const f32x4*)(md + 1024 + co), sh = *(const f32x4*)(md + co);
                f32x4 h = v[i] * r * g * (sc + 1.0f) + sh;
                u32x2 w; w.x = pk2(h[0], h[1]); w.y = pk2(h[2], h[3]);
                *(u32x2*)(H + (size_t)t * 1024 + co) = w;
                *(unsigned*)(WSP(unsigned char, WS_HG8) + (size_t)t * 1024 + co) = pk4_fp8(h[0], h[1], h[2], h[3]);
                }
        }
    }
}
DI u32x4 rope8v(u32x4 a, f32x4 c0, f32x4 c1) {
    u32x4 o;
    { const float x1 = bf_lo(a.x), x2 = bf_hi(a.x); o.x = pk2(x1 * c0[0] - x2 * c0[1], x2 * c0[0] + x1 * c0[1]); }
    { const float x1 = bf_lo(a.y), x2 = bf_hi(a.y); o.y = pk2(x1 * c0[2] - x2 * c0[3], x2 * c0[2] + x1 * c0[3]); }
    { const float x1 = bf_lo(a.z), x2 = bf_hi(a.z); o.z = pk2(x1 * c1[0] - x2 * c1[1], x2 * c1[0] + x1 * c1[1]); }
    { const float x1 = bf_lo(a.w), x2 = bf_hi(a.w); o.w = pk2(x1 * c1[2] - x2 * c1[3], x2 * c1[2] + x1 * c1[3]); }
    return o;
}
DI u32x4 rope8(u32x4 a, const float* cs) { return rope8v(a, *(const f32x4*)cs, *(const f32x4*)(cs + 4)); }
DI void unpack8(u32x4 a, float (&v)[8]) { v[0] = bf_lo(a.x); v[1] = bf_hi(a.x); v[2] = bf_lo(a.y); v[3] = bf_hi(a.y); v[4] = bf_lo(a.z); v[5] = bf_hi(a.z); v[6] = bf_lo(a.w); v[7] = bf_hi(a.w); }
DI void phase_post(const Frame& F, int l) {
    const int lane = F.lane, gw = F.bid * 8 + F.wave, NGW = F.G * 8;
    const bf16_t* P = WSP(bf16_t, WS_P); const float* ROPE = WSP(float, WS_ROPE);
    bf16_t *CQ = WSP(bf16_t, WS_CQ), *CKV = WSP(bf16_t, WS_CKV), *KPE = WSP(bf16_t, WS_KPE), *OB = WSP(bf16_t, WS_O3) + (size_t)T_TOK * 512, *QC = WSP(bf16_t, WS_QC), *KC = WSP(bf16_t, WS_KC),
           *VC = WSP(bf16_t, WS_VC), *QI = WSP(bf16_t, WS_QI), *KI = WSP(bf16_t, WS_KI); float* IW = WSP(float, WS_IW);
    const float* cw = KIN_conv_w + (size_t)l * 3 * 512 + 8 * lane;
    f32x4 cwv[3][2];
#pragma unroll
    for (int d = 0; d < 3; ++d) { cwv[d][0] = *(const f32x4*)(cw + d * 512); cwv[d][1] = *(const f32x4*)(cw + d * 512 + 4); }
    const float* in_qn = KIN_q_norm + l * 256 + 8 * (lane & 31); const float* in_kn = KIN_kv_norm + l * 128 + 8 * (lane & 15);
    const f32x4 qn0 = *(const f32x4*)in_qn, qn1 = *(const f32x4*)(in_qn + 4), kn0 = *(const f32x4*)in_kn, kn1 = *(const f32x4*)(in_kn + 4);
    const u32x4 z4 = {0u, 0u, 0u, 0u};
    for (int t = gw; t < T_TOK; t += NGW) {
        const bf16_t* pr = P + (size_t)t * NP; const float* rp = ROPE + (size_t)t * 48; const int s = t & (SEQ - 1);
        const bf16_t* pc = pr + PC_CONV + 8 * lane;
        const u32x4 gbw = *(const u32x4*)pc;
        const u32x4 gc2 = *(const u32x4*)(pc + 512), hc2 = *(const u32x4*)(pc + 1024);
        const u32x4 gc1 = (s >= 1) ? *(const u32x4*)(pc - NP + 512) : z4, hc1 = (s >= 1) ? *(const u32x4*)(pc - NP + 1024) : z4;
        const u32x4 gc0 = (s >= 2) ? *(const u32x4*)(pc - 2 * NP + 512) : z4, hc0 = (s >= 2) ? *(const u32x4*)(pc - 2 * NP + 1024) : z4;
        u32x4 dqw = *(const u32x4*)(pr + PC_DQ + 8 * lane), iqw = *(const u32x4*)(pr + PC_IQ + 8 * lane);
        const u32x4 qlw = *(const u32x4*)(pr + PC_QLAT + 8 * (lane & 31));
        const u32x4 kvw = *(const u32x4*)(pr + PC_KVLAT + 8 * (lane < 20 ? lane : 0));
        u32x4 dkw = *(const u32x4*)(pr + PC_DKV + 8 * (lane & 15));
        u32x4 ikw = *(const u32x4*)(pr + PC_IK + 8 * (lane & 7));
        const u32x4 iww = *(const u32x4*)(pr + PC_IW);
        const f32x4 r16a = *(const f32x4*)(rp + 32 + 8 * (lane & 1)), r16b = *(const f32x4*)(rp + 32 + 8 * (lane & 1) + 4);
        const f32x4 r32a = *(const f32x4*)(rp + 8 * (lane & 3)), r32b = *(const f32x4*)(rp + 8 * (lane & 3) + 4);
        asm volatile("" ::: "memory");
        {
            float gb[8], a0[8], b0[8], a1[8], b1[8], a2[8], b2[8]; unpack8(gbw, gb); unpack8(gc0, a0); unpack8(hc0, b0); unpack8(gc1, a1); unpack8(hc1, b1); unpack8(gc2, a2); unpack8(hc2, b2);
            float o[8];
#pragma unroll
            for (int i = 0; i < 8; ++i) { const float w0 = cwv[0][i >> 2][i & 3], w1 = cwv[1][i >> 2][i & 3], w2 = cwv[2][i >> 2][i & 3]; o[i] = gb[i] * (w0 * (a0[i] * b0[i]) + w1 * (a1[i] * b1[i]) + w2 * (a2[i] * b2[i])); }
            u32x4 ow; ow.x = pk2(o[0], o[1]); ow.y = pk2(o[2], o[3]); ow.z = pk2(o[4], o[5]); ow.w = pk2(o[6], o[7]);
            *(u32x4*)(OB + (size_t)t * 512 + 8 * lane) = ow;
        }
        if ((lane & 7) < 2) { dqw = rope8v(dqw, r16a, r16b); iqw = rope8v(iqw, r16a, r16b); }
        *(u32x4*)(QC + (size_t)t * 512 + 8 * lane) = dqw; *(u32x4*)(QI + (size_t)t * 512 + 8 * lane) = iqw;
        float ql[8], kv[8]; unpack8(qlw, ql); unpack8(kvw, kv);
        float ss1 = 0.f, ss2 = 0.f;
        if (lane < 32) {
#pragma unroll
            for (int i = 0; i < 8; ++i) ss1 += ql[i] * ql[i]; }
        if (lane < 16) {
#pragma unroll
            for (int i = 0; i < 8; ++i) ss2 += kv[i] * kv[i]; }
#pragma unroll
        for (int o = 1; o < 64; o <<= 1) { ss1 += __shfl_xor(ss1, o); ss2 += __shfl_xor(ss2, o); }
        const float r1 = 1.0f / sqrtf(ss1 * (1.0f / 256.0f) + NORM_EPS), r2 = 1.0f / sqrtf(ss2 * (1.0f / 128.0f) + NORM_EPS);
        if (lane < 32) { u32x4 o; o.x = pk2(ql[0] * r1 * qn0[0], ql[1] * r1 * qn0[1]); o.y = pk2(ql[2] * r1 * qn0[2], ql[3] * r1 * qn0[3]); o.z = pk2(ql[4] * r1 * qn1[0], ql[5] * r1 * qn1[1]); o.w = pk2(ql[6] * r1 * qn1[2], ql[7] * r1 * qn1[3]);
            *(u32x4*)(CQ + (size_t)t * 256 + 8 * lane) = o;
            u32x4 k = z4; if (lane < 16) { k.x = pk2(kv[0] * r2 * kn0[0], kv[1] * r2 * kn0[1]); k.y = pk2(kv[2] * r2 * kn0[2], kv[3] * r2 * kn0[3]); k.z = pk2(kv[4] * r2 * kn1[0], kv[5] * r2 * kn1[1]); k.w = pk2(kv[6] * r2 * kn1[2], kv[7] * r2 * kn1[3]); }
            *(u32x4*)(CKV + (size_t)t * 256 + 8 * lane) = k; }
        if (lane >= 16 && lane < 20) *(u32x4*)(KPE + (size_t)t * 32 + 8 * (lane - 16)) = rope8v(kvw, r32a, r32b);
        if (lane < 16) { if (lane < 2) dkw = rope8v(dkw, r16a, r16b); if (lane < 8) *(u32x4*)(KC + (size_t)t * 64 + 8 * lane) = dkw; else *(u32x4*)(VC + (size_t)t * 64 + 8 * (lane - 8)) = dkw; }
        if (lane >= 16 && lane < 24) { const int c = lane - 16; if (c < 2) ikw = rope8v(ikw, r16a, r16b); *(u32x4*)(KI + (size_t)t * 64 + 8 * c) = ikw; }
        if (lane == 32) { float v[8]; unpack8(iww, v); *(f32x4*)(IW + (size_t)t * 8) = (f32x4){v[0], v[1], v[2], v[3]}; *(f32x4*)(IW + (size_t)t * 8 + 4) = (f32x4){v[4], v[5], v[6], v[7]}; }
    }
}

DI int crow(int r, int hi) { return (r & 3) + 8 * (r >> 2) + 4 * hi; }
#define MFMA32(a, b, c) __builtin_amdgcn_mfma_f32_32x32x16_bf16((a), (b), (c), 0, 0, 0)
#define MFMA16(a, b, c) __builtin_amdgcn_mfma_f32_16x16x32_bf16((a), (b), (c), 0, 0, 0)
#define GLDS16(src, dst) __builtin_amdgcn_global_load_lds((const unsigned*)(src), (LAS unsigned*)(dst), 16, 0, 0)
typedef short v4i16_t __attribute__((ext_vector_type(4)));
DI s16x4 tr_read(const LAS unsigned char* p) { return __builtin_bit_cast(s16x4, __builtin_amdgcn_ds_read_tr16_b64_v4i16((LAS v4i16_t*)p)); }
DI bf16x8 pack8(float a0, float a1, float a2, float a3, float a4, float a5, float a6, float a7) { u32x4 w; w.x = pk2(a0, a1); w.y = pk2(a2, a3); w.z = pk2(a4, a5); w.w = pk2(a6, a7); return __builtin_bit_cast(bf16x8, w); }
DI bf16x8 cat4(s16x4 lo, s16x4 hi) { return (bf16x8){lo[0], lo[1], lo[2], lo[3], hi[0], hi[1], hi[2], hi[3]}; }

constexpr int MLA_K0 = 0, MLA_V0 = 24576, MLA_WS = 49152;
DI void mla_unit(const Frame& F, int b, int h, int qb) {
    const int lane = F.lane, wid = F.wave, r32 = lane & 31, hi = lane >> 5;
    const bf16_t* QA = WSP(bf16_t, WS_QA); const bf16_t* KPE = WSP(bf16_t, WS_KPE); const bf16_t* KV = WSP(bf16_t, WS_KV); bf16_t* OA = WSP(bf16_t, WS_O3);
    const size_t tb = (size_t)b * SEQ; const int q0 = qb * 256, qrow = q0 + 32 * wid + r32;
    const float C2 = 0.10206207261596577f * 1.4426950408889634f;
    LAS unsigned char* lds = F.lds; LAS float* wsf = (LAS float*)(lds + MLA_WS) + wid * 128;
    bf16x8 qr[6];
#pragma unroll
    for (int d0 = 0; d0 < 6; ++d0) qr[d0] = *(const bf16x8*)(QA + (tb + qrow) * 768 + h * 96 + d0 * 16 + hi * 8);
    {
        const float* rp = WSP(float, WS_ROPE) + (tb + qrow) * 48;
        qr[0] = __builtin_bit_cast(bf16x8, rope8(__builtin_bit_cast(u32x4, qr[0]), rp + 8 * hi));
        qr[1] = __builtin_bit_cast(bf16x8, rope8(__builtin_bit_cast(u32x4, qr[1]), rp + 16 + 8 * hi)); }
    const int NT = 4 * (qb + 1);
    const unsigned vo_pe = (unsigned)(lane * 32 + 8 * (wid & 3)) * 2u, vo_k0 = (unsigned)(lane * 1024 + 128 * h + 8 * ((wid + 4) & 7)) * 2u, vo_k1 = (unsigned)(lane * 1024 + 128 * h + 8 * (wid + 4)) * 2u,
                   vo_v = (unsigned)((16 * (wid & 3) + (lane >> 2)) * 1024 + 128 * h + 64 + 32 * (wid >> 2) + 8 * (lane & 3)) * 2u;
    const unsigned ldsb = (unsigned)(unsigned long long)lds;
    const char* pe_b = pg8::uni_ptr((const char*)(KPE + tb * 32)); const char* kv_b = pg8::uni_ptr((const char*)(KV + tb * 1024));
#define MLA_STAGE(kt, buf, vslot) do { const char* pe_ = pe_b + (size_t)(kt) * (64 * 32 * 2); const char* kv_ = kv_b + (size_t)(kt) * (64 * 1024 * 2); \
        if (wid < 4) { pg8::glds16_s(vo_pe, pe_, ldsb + MLA_K0 + (buf) * 12288 + wid * 1024); pg8::glds16_s(vo_k1, kv_, ldsb + MLA_K0 + (buf) * 12288 + (wid + 8) * 1024); } \
        else { pg8::glds16_s(vo_k0, kv_, ldsb + MLA_K0 + (buf) * 12288 + wid * 1024); } \
        pg8::glds16_s(vo_v, kv_, ldsb + MLA_V0 + (vslot) * 8192 + wid * 1024); } while (0)
    MLA_STAGE(0, 0, 0);
    float m = -1e30f, l = 0.f; f32x16 o[2];
#pragma unroll
    for (int r = 0; r < 16; ++r) { o[0][r] = 0.f; o[1][r] = 0.f; }
    const int vboff = ((lane >> 4) & 1) * 32 + (lane & 3) * 8 + (4 * hi + ((lane & 15) >> 2)) * 64;
    const bool upper = wid >= 4; bool have_prev = false; bf16x8 pa[4];
#define MLA_PV(vs) do { const LAS unsigned char* vb_ = lds + MLA_V0 + (vs) * 8192 + vboff; \
        _Pragma("unroll") for (int d0 = 0; d0 < 2; ++d0) _Pragma("unroll") for (int ks = 0; ks < 4; ++ks) { \
            const s16x4 lo_ = tr_read(vb_ + d0 * 4096 + ks * 1024), hh_ = tr_read(vb_ + d0 * 4096 + ks * 1024 + 512); o[d0] = MFMA32(pa[ks], cat4(lo_, hh_), o[d0]); } } while (0)
    int vs_cur = 0, vs_prev = 0;
    for (int kt = 0; kt < NT; ++kt) {
        const int buf = kt & 1; const int vs_next = (vs_cur == 2) ? 0 : vs_cur + 1;
        VM_WAIT(); __syncthreads();
        if (kt + 1 < NT) MLA_STAGE(kt + 1, buf ^ 1, vs_next);
        if (upper && have_prev) { MLA_PV(vs_prev); have_prev = false; }
        if (64 * kt <= q0 + 32 * wid + 31) {
            f32x16 p0, p1;
#pragma unroll
            for (int r = 0; r < 16; ++r) { p0[r] = 0.f; p1[r] = 0.f; }
            const LAS unsigned char* kb = lds + MLA_K0 + buf * 12288 + hi * 1024 + r32 * 16;
#pragma unroll
            for (int d0 = 0; d0 < 6; ++d0) { const bf16x8 b0 = *(const LAS bf16x8*)(kb + d0 * 2048), b1 = *(const LAS bf16x8*)(kb + d0 * 2048 + 512);
                p0 = MFMA32(b0, qr[d0], p0); p1 = MFMA32(b1, qr[d0], p1); }
            if (64 * kt + 63 > q0 + 32 * wid) {
#pragma unroll
                for (int r = 0; r < 16; ++r) { const int kv = 64 * kt + crow(r, hi); if (kv > qrow) p0[r] = -INFINITY; if (kv + 32 > qrow) p1[r] = -INFINITY; } }
            float rm = fmaxf(p0[0], p1[0]);
#pragma unroll
            for (int r = 1; r < 16; ++r) rm = fmaxf(rm, fmaxf(p0[r], p1[r]));
            rm = fmaxf(rm, __shfl_xor(rm, 32));
            const float mn = fmaxf(m, rm);
            if (__any(mn > m)) {
                const float alpha = __builtin_amdgcn_exp2f((m - mn) * C2); l *= alpha; m = mn;
                if (hi == 0) wsf[r32] = alpha;
                LDS_WAIT();
#pragma unroll
                for (int q = 0; q < 4; ++q) { const f32x4 a = *(const LAS f32x4*)(wsf + 8 * q + 4 * hi);
#pragma unroll
                    for (int j = 0; j < 4; ++j) { o[0][4 * q + j] *= a[j]; o[1][4 * q + j] *= a[j]; } }
            }
            const float mc = m * C2; float ls = 0.f;
#pragma unroll
            for (int r = 0; r < 16; ++r) { p0[r] = __builtin_amdgcn_exp2f(__builtin_fmaf(p0[r], C2, -mc)); p1[r] = __builtin_amdgcn_exp2f(__builtin_fmaf(p1[r], C2, -mc)); ls += p0[r] + p1[r]; }
            l += ls;
            pa[0] = pack8(p0[0], p0[1], p0[2], p0[3], p0[4], p0[5], p0[6], p0[7]); pa[1] = pack8(p0[8], p0[9], p0[10], p0[11], p0[12], p0[13], p0[14], p0[15]);
            pa[2] = pack8(p1[0], p1[1], p1[2], p1[3], p1[4], p1[5], p1[6], p1[7]); pa[3] = pack8(p1[8], p1[9], p1[10], p1[11], p1[12], p1[13], p1[14], p1[15]);
            if (upper) have_prev = true; else MLA_PV(vs_cur);
        }
        vs_prev = vs_cur; vs_cur = vs_next;
    }
    if (upper && have_prev) MLA_PV(vs_prev);
#undef MLA_PV
#undef MLA_STAGE
    l += __shfl_xor(l, 32);
    if (hi == 0) wsf[64 + r32] = 1.0f / l;
    LDS_WAIT();
    bf16_t* orow = OA + (tb + q0 + 32 * wid) * 512 + h * 64 + r32;
#pragma unroll
    for (int q = 0; q < 4; ++q) { const f32x4 a = *(const LAS f32x4*)(wsf + 64 + 8 * q + 4 * hi);
#pragma unroll
        for (int j = 0; j < 4; ++j) { const int r = 4 * q + j, rr = crow(r, hi);
            orow[(size_t)rr * 512] = (bf16_t)(pk2(o[0][r] * a[j], 0.f) & 0xffffu); orow[(size_t)rr * 512 + 32] = (bf16_t)(pk2(o[1][r] * a[j], 0.f) & 0xffffu); } }
    __syncthreads();
}

constexpr int DSA_SCW = 2052;
constexpr int DSA_SEL = 16 * DSA_SCW * 4;
DI int mbcnt64(unsigned long long m) { return (int)__builtin_amdgcn_mbcnt_hi((unsigned)(m >> 32), __builtin_amdgcn_mbcnt_lo((unsigned)m, 0u)); }
DI void dsa_unit(const Frame& F, int b, int qt) {
    const int tid = F.tid, lane = F.lane, wid = F.wave, fr = lane & 15, g = lane >> 4;
    const bf16_t *QI = WSP(bf16_t, WS_QI), *KI = WSP(bf16_t, WS_KI), *QC = WSP(bf16_t, WS_QC), *KC = WSP(bf16_t, WS_KC), *VC = WSP(bf16_t, WS_VC); const float* IW = WSP(float, WS_IW);
    bf16_t* OC = WSP(bf16_t, WS_O3) + (size_t)2 * T_TOK * 512;
    const size_t tb = (size_t)b * SEQ; const int t0 = 16 * qt;
    LAS unsigned char* lds = F.lds; LAS float* SC = (LAS float*)lds; LAS unsigned long long* BITS = (LAS unsigned long long*)(lds + DSA_SEL);
    {
        bf16x8 qf[8][2]; float wv[8];
        const bf16_t* qp = QI + (tb + t0 + fr) * 512 + 8 * g;
#pragma unroll
        for (int h = 0; h < 8; ++h) { qf[h][0] = *(const bf16x8*)(qp + h * 64); qf[h][1] = *(const bf16x8*)(qp + h * 64 + 32); }
        { const f32x4 w0 = *(const f32x4*)(IW + (tb + t0 + fr) * 8), w1 = *(const f32x4*)(IW + (tb + t0 + fr) * 8 + 4); wv[0] = w0[0]; wv[1] = w0[1]; wv[2] = w0[2]; wv[3] = w0[3]; wv[4] = w1[0]; wv[5] = w1[1]; wv[6] = w1[2]; wv[7] = w1[3]; }
        const bf16_t* kbase = KI + (tb + fr) * 64 + 8 * g;
        const bf16x8 z8 = {0, 0, 0, 0, 0, 0, 0, 0};
        bf16x8 a0 = z8, a1 = z8, b0 = z8, b1 = z8, c0 = z8, c1 = z8;
        if (wid <= qt) { a0 = *(const bf16x8*)(kbase + (size_t)wid * 1024); a1 = *(const bf16x8*)(kbase + (size_t)wid * 1024 + 32); }
        if (wid + 8 <= qt) { b0 = *(const bf16x8*)(kbase + (size_t)(wid + 8) * 1024); b1 = *(const bf16x8*)(kbase + (size_t)(wid + 8) * 1024 + 32); }
        if (wid + 16 <= qt) { c0 = *(const bf16x8*)(kbase + (size_t)(wid + 16) * 1024); c1 = *(const bf16x8*)(kbase + (size_t)(wid + 16) * 1024 + 32); }
        for (int kt = wid; kt <= qt; kt += 8) {
            bf16x8 n0 = z8, n1 = z8;
            if (kt + 24 <= qt) { n0 = *(const bf16x8*)(kbase + (size_t)(kt + 24) * 1024); n1 = *(const bf16x8*)(kbase + (size_t)(kt + 24) * 1024 + 32); }
            f32x4 s = {F.zf, F.zf, F.zf, F.zf};
#pragma unroll
            for (int h = 0; h < 8; ++h) { f32x4 acc = {F.zf, F.zf, F.zf, F.zf}; acc = MFMA16(a0, qf[h][0], acc); acc = MFMA16(a1, qf[h][1], acc);
#pragma unroll
                for (int r = 0; r < 4; ++r) s[r] += fmaxf(acc[r], 0.f) * wv[h]; }
#pragma unroll
            for (int r = 0; r < 4; ++r) if (16 * kt + 4 * g + r > t0 + fr) s[r] = -INFINITY;
            *(LAS f32x4*)(SC + fr * DSA_SCW + 16 * kt + 4 * g) = s;
            a0 = b0; a1 = b1; b0 = c0; b1 = c1; c0 = n0; c1 = n1;
        }
    }
    __syncthreads();
#ifdef PROBE_S2DUP
    for (int qi2_ = 0; qi2_ < 2 * PROBE_S2DUP; ++qi2_) { const int qi2 = qi2_ & 1;
#else
    for (int qi2 = 0; qi2 < 2; ++qi2) {
#endif
        const int qq = 2 * wid + qi2, t = t0 + qq, nvalid = t + 1;
#ifdef PROBE_S2DUP
        const bool probe_pass = (qi2_ < 2 * (PROBE_S2DUP - 1));
#endif
        LAS unsigned long long* bits = BITS + qq * 32;
        if (nvalid <= 256) { if (lane < 32) { const int k0 = 64 * lane; bits[lane] = (k0 + 63 <= t) ? ~0ull : (k0 <= t) ? ((1ull << (t - k0 + 1)) - 1ull) : 0ull; } }
        else {
            const int nq = (nvalid + 511) >> 9;
            float v[32];
#pragma unroll
            for (int i = 0; i < 32; ++i) { const int key = i * 64 + lane; v[i] = (key <= t) ? SC[qq * DSA_SCW + key] : -INFINITY; }
            float vmax = v[0], vmin = (v[0] == -INFINITY) ? INFINITY : v[0];
#pragma unroll
            for (int i = 1; i < 32; ++i) { vmax = fmaxf(vmax, v[i]); vmin = fminf(vmin, (v[i] == -INFINITY) ? INFINITY : v[i]); }
#pragma unroll
            for (int o = 1; o < 64; o <<= 1) { vmax = fmaxf(vmax, __shfl_xor(vmax, o)); vmin = fminf(vmin, __shfl_xor(vmin, o)); }
#ifndef S2_BALLOT
#define S2_BALLOT 1
#endif
#if S2_BALLOT
#define DSA_CMP_ge(m_, x_, t_) asm("v_cmp_ge_f32_e64 %0, %1, %2" : "=s"(m_) : "v"(x_), "v"(t_))
#define DSA_CMP_gt(m_, x_, t_) asm("v_cmp_gt_f32_e64 %0, %1, %2" : "=s"(m_) : "v"(x_), "v"(t_))
#define DSA_COUNT(thr, OPN, out) do { int tot_ = 0; const float thr_ = (thr); _Pragma("unroll") for (int qd = 0; qd < 4; ++qd) { if (qd < nq) { unsigned long long m_[8]; \
                _Pragma("unroll") for (int i = 0; i < 8; ++i) DSA_CMP_##OPN(m_[i], v[8 * qd + i], thr_); __builtin_amdgcn_sched_barrier(0); _Pragma("unroll") for (int i = 0; i < 8; ++i) tot_ += __builtin_popcountll(m_[i]); __builtin_amdgcn_sched_barrier(0); } } out = tot_; } while (0)
#else
#define DSA_OP_ge >=
#define DSA_OP_gt >
#define DSA_COUNT(thr, OPN, out) do { int c_ = 0; _Pragma("unroll") for (int qd = 0; qd < 4; ++qd) { if (qd < nq) { _Pragma("unroll") for (int i = 0; i < 8; ++i) c_ += (v[8 * qd + i] DSA_OP_##OPN (thr)) ? 1 : 0; } } \
                int tot_ = 0; _Pragma("unroll") for (int b_ = 0; b_ < 6; ++b_) tot_ += __builtin_popcountll(__ballot((c_ >> b_) & 1)) << b_; out = tot_; } while (0)
#endif
            float lo = vmin, hi = vmax, K; int cnt;
            DSA_COUNT(hi, ge, cnt);
            if (cnt >= 256) { K = hi; }
            else {
                int clo = nvalid, chi = cnt;
                for (int it = 0;; ++it) {
#ifdef PROBE_S2CAP
                    if (probe_pass && it >= PROBE_S2CAP) { K = lo; cnt = 256; break; }
#endif
                    float fr_ = 0.5f;
                    if ((it & 1) == 0) { fr_ = ((float)(clo - 256) + 0.5f) / (float)(clo - chi); fr_ = fminf(fmaxf(fr_, 0.03125f), 0.96875f); }
                    const float mid = lo + (hi - lo) * fr_;
                    if (!(mid > lo && mid < hi)) {
                        const float mid2 = lo + (hi - lo) * 0.5f;
                        if (!(mid2 > lo && mid2 < hi)) { K = lo; cnt = clo; break; }
                        DSA_COUNT(mid2, ge, cnt);
                        if (cnt == 256) { K = mid2; break; }
                        if (cnt > 256) { lo = mid2; clo = cnt; } else { hi = mid2; chi = cnt; }
                        continue;
                    }
                    DSA_COUNT(mid, ge, cnt);
                    if (cnt == 256) { K = mid; break; }
                    if (cnt > 256) { lo = mid; clo = cnt; } else { hi = mid; chi = cnt; }
                }
            }
#ifdef PROBE_S2NOW
            if (probe_pass) { asm volatile("" :: "v"(K)); } else
#endif
            if (cnt == 256) {
#pragma unroll
                for (int qd = 0; qd < 4; ++qd) {
#pragma unroll
                    for (int i8 = 0; i8 < 8; ++i8) { const int i = 8 * qd + i8; const unsigned long long mt = (qd < nq) ? __ballot(v[i] >= K) : 0ull; if (lane == 0) bits[i] = mt; } }
            } else {
                int cgt; DSA_COUNT(K, gt, cgt);
                const int need = 256 - cgt; int eqb = 0;
#pragma unroll
                for (int qd = 0; qd < 4; ++qd) {
#pragma unroll
                    for (int i8 = 0; i8 < 8; ++i8) { const int i = 8 * qd + i8; unsigned long long mt = 0ull;
                        if (qd < nq) { const bool gt = v[i] > K, eq = v[i] == K; const unsigned long long me = __ballot(eq); const int erank = eqb + mbcnt64(me);
                            mt = __ballot(gt || (eq && erank < need)); eqb += __builtin_popcountll(me); }
                        if (lane == 0) bits[i] = mt; } }
            }
#undef DSA_COUNT
        }
    }
    __syncthreads();
    {
        const float C2S = 0.125f * 1.4426950408889634f;
        int lane3 = lane; asm volatile("" : "+v"(lane3));
        const int r32 = lane3 & 31, hi = lane3 >> 5, cg = wid & 3, kp = wid >> 2;
        const int NT = (t0 + 16 + 63) >> 6, NS = (NT + 1) >> 1;
        const int qloc = 4 * cg + (r32 >> 3);
        LAS float* wsf = (LAS float*)(lds + 65536) + wid * 128;
        LAS float* OW = (LAS float*)(lds + 69632); LAS float* ML2 = (LAS float*)(lds + 69632 + 32768);
        bf16x8 qr[4];
#pragma unroll
        for (int d0 = 0; d0 < 4; ++d0) qr[d0] = *(const bf16x8*)(QC + (tb + t0 + qloc) * 512 + (r32 & 7) * 64 + d0 * 16 + hi * 8);
        const unsigned vo_kc = (unsigned)(lane3 * 64 + 8 * wid) * 2u, vo_vc = (unsigned)((16 * (wid & 3) + (lane3 >> 2)) * 64 + 32 * (wid >> 2) + 8 * (lane3 & 3)) * 2u, ldsb = (unsigned)(unsigned long long)lds;
        const char* kc_b = pg8::uni_ptr((const char*)(KC + tb * 64)); const char* vc_b = pg8::uni_ptr((const char*)(VC + tb * 64));
#define DSD_STAGE(j, buf) do { _Pragma("unroll") for (int par_ = 0; par_ < 2; ++par_) { const int kt_ = 2 * (j) + par_; if (kt_ < NT) { \
            const unsigned d_ = ldsb + (buf) * 32768 + par_ * 16384; \
            pg8::glds16_s(vo_kc, kc_b + (size_t)kt_ * (64 * 64 * 2), d_ + wid * 1024); pg8::glds16_s(vo_vc, vc_b + (size_t)kt_ * (64 * 64 * 2), d_ + 8192 + wid * 1024); } } } while (0)
        DSD_STAGE(0, 0);
        float m = -1e30f, l = 0.f; f32x16 o[2];
#pragma unroll
        for (int r = 0; r < 16; ++r) { o[0][r] = F.zf; o[1][r] = F.zf; }
        const int vboff = ((lane3 >> 4) & 1) * 32 + (lane3 & 3) * 8 + (4 * hi + ((lane3 & 15) >> 2)) * 64;
        for (int j = 0; j < NS; ++j) {
            const int buf = j & 1, kt = 2 * j + kp;
            VM_WAIT(); __syncthreads();
            if (j + 1 < NS) DSD_STAGE(j + 1, buf ^ 1);
            if (kt < NT) {
                const LAS unsigned char* tile = lds + buf * 32768 + kp * 16384;
                f32x16 p0, p1;
#pragma unroll
                for (int r = 0; r < 16; ++r) { p0[r] = F.zf; p1[r] = F.zf; }
                const LAS unsigned char* kb = tile + hi * 1024 + r32 * 16;
#pragma unroll
                for (int d0 = 0; d0 < 4; ++d0) { const bf16x8 b0 = *(const LAS bf16x8*)(kb + d0 * 2048), b1 = *(const LAS bf16x8*)(kb + d0 * 2048 + 512);
                    p0 = MFMA32(b0, qr[d0], p0); p1 = MFMA32(b1, qr[d0], p1); }
                float rm = fmaxf(p0[0], p1[0]);
#pragma unroll
                for (int r = 1; r < 16; ++r) rm = fmaxf(rm, fmaxf(p0[r], p1[r]));
                rm = fmaxf(rm, __shfl_xor(rm, 32));
                const float mn = fmaxf(m, rm);
                if (__any(mn > m)) {
                    const float alpha = __builtin_amdgcn_exp2f((m - mn) * C2S); l *= alpha; m = mn;
                    if (hi == 0) wsf[r32] = alpha;
                    LDS_WAIT();
#pragma unroll
                    for (int q = 0; q < 4; ++q) { const f32x4 a = *(const LAS f32x4*)(wsf + 8 * q + 4 * hi);
#pragma unroll
                        for (int jj = 0; jj < 4; ++jj) { o[0][4 * q + jj] *= a[jj]; o[1][4 * q + jj] *= a[jj]; } }
                }
                const unsigned long long bw = BITS[qloc * 32 + kt];
                const unsigned wl = (unsigned)bw >> (4 * hi), wh = (unsigned)(bw >> 32) >> (4 * hi);
                const float mc = m * C2S; float ls = 0.f;
#pragma unroll
                for (int r = 0; r < 16; ++r) { const int c = (r & 3) + 8 * (r >> 2);
                    const int m0 = ((int)(wl << (31 - c))) >> 31, m1 = ((int)(wh << (31 - c))) >> 31;
                    p0[r] = __uint_as_float(__float_as_uint(__builtin_amdgcn_exp2f(__builtin_fmaf(p0[r], C2S, -mc))) & (unsigned)m0);
                    p1[r] = __uint_as_float(__float_as_uint(__builtin_amdgcn_exp2f(__builtin_fmaf(p1[r], C2S, -mc))) & (unsigned)m1);
                    ls += p0[r] + p1[r]; }
                l += ls;
                bf16x8 pa[4];
                pa[0] = pack8(p0[0], p0[1], p0[2], p0[3], p0[4], p0[5], p0[6], p0[7]); pa[1] = pack8(p0[8], p0[9], p0[10], p0[11], p0[12], p0[13], p0[14], p0[15]);
                pa[2] = pack8(p1[0], p1[1], p1[2], p1[3], p1[4], p1[5], p1[6], p1[7]); pa[3] = pack8(p1[8], p1[9], p1[10], p1[11], p1[12], p1[13], p1[14], p1[15]);
                const LAS unsigned char* vb = tile + 8192 + vboff;
#pragma unroll
                for (int d0 = 0; d0 < 2; ++d0)
#pragma unroll
                    for (int ks = 0; ks < 4; ++ks) { const s16x4 lo = tr_read(vb + d0 * 4096 + ks * 1024), hh = tr_read(vb + d0 * 4096 + ks * 1024 + 512);
                        o[d0] = MFMA32(pa[ks], cat4(lo, hh), o[d0]); }
            }
        }
#undef DSD_STAGE
        l += __shfl_xor(l, 32);
        __syncthreads();
        if (kp == 1) {
            LAS float* ow = OW + cg * 2048;
#pragma unroll
            for (int r = 0; r < 16; ++r) { const int row = crow(r, hi); ow[row * 64 + r32] = o[0][r]; ow[row * 64 + 32 + r32] = o[1][r]; }
            if (hi == 0) { ML2[cg * 64 + r32] = m; ML2[cg * 64 + 32 + r32] = l; }
        }
        __syncthreads();
        if (kp == 0) {
            const float m2 = ML2[cg * 64 + r32], l2 = ML2[cg * 64 + 32 + r32];
            const float M = fmaxf(m, m2), a1 = __builtin_amdgcn_exp2f((m - M) * C2S), a2 = __builtin_amdgcn_exp2f((m2 - M) * C2S);
            const float linv = 1.0f / (a1 * l + a2 * l2);
            if (hi == 0) { wsf[r32] = a1 * linv; wsf[32 + r32] = a2 * linv; }
            LDS_WAIT();
            const LAS float* ow = OW + cg * 2048;
            bf16_t* op = OC + (tb + t0 + 4 * cg) * 512 + r32;
#pragma unroll
            for (int q = 0; q < 4; ++q) { const f32x4 s1 = *(const LAS f32x4*)(wsf + 8 * q + 4 * hi), s2 = *(const LAS f32x4*)(wsf + 32 + 8 * q + 4 * hi);
#pragma unroll
                for (int jj = 0; jj < 4; ++jj) { const int r = 4 * q + jj, row = crow(r, hi);
                    const float v0 = o[0][r] * s1[jj] + ow[row * 64 + r32] * s2[jj], v1 = o[1][r] * s1[jj] + ow[row * 64 + 32 + r32] * s2[jj];
                    bf16_t* dst = op + (size_t)(row >> 3) * 512 + (row & 7) * 64;
                    dst[0] = (bf16_t)(pk2(v0, 0.f) & 0xffffu); dst[32] = (bf16_t)(pk2(v1, 0.f) & 0xffffu); } }
        }
    }
    __syncthreads();
}
DI void attention_mla_units(const Frame& F, int rep_a) {
    for (int rep = 0; rep < rep_a; ++rep)
    for (int U = F.bid; U < 1024; U += F.G) { const int i = U >> 8, cp = U & 255, half = cp >> 7, rem = cp & 127; mla_unit(F, rem & 15, rem >> 4, 2 * i + (half ^ (i & 1))); }
}
DI void attention_dsa_units(const Frame& F, int rep_c) {
    for (int rep = 0; rep < rep_c; ++rep)
    for (int U = F.bid; U < 2048; U += F.G) { const int i = U >> 8, cp = U & 255; dsa_unit(F, cp & 15, 16 * i + (cp >> 4)); }
}
DI void phase_attention(const Frame& F, int rep_a, int rep_c) {
    if (F.bid & 1) { attention_dsa_units(F, rep_c); __syncthreads(); attention_mla_units(F, rep_a); }
    else { attention_mla_units(F, rep_a); __syncthreads(); attention_dsa_units(F, rep_c); }
}

constexpr int N2_WROW = 1032;
constexpr int N2_WH = 0, N2_WL = 32 * N2_WROW * 2, N2_CB = 2 * N2_WL, N2_PART = N2_CB + 128, N2_LGT = N2_PART + 2048, N2_RST = N2_LGT + 8 * 2304, N2_CNT = N2_RST + 512, N2_BASE = N2_CNT + 128, N2_TOK = N2_BASE + 128;
static_assert(N2_TOK + 2048 <= MISC_OFF, "router LDS map");
DI void phase_router(const Frame& F, int l, int cset) {
    const int tid = F.tid, lane = F.lane, wave = F.wave, fr = lane & 15, g = lane >> 4;
    LAS unsigned char* lds = F.lds;
    LAS bf16_t* WH = (LAS bf16_t*)(lds + N2_WH); LAS bf16_t* WL = (LAS bf16_t*)(lds + N2_WL); LAS float* CB = (LAS float*)(lds + N2_CB); LAS float* PART = (LAS float*)(lds + N2_PART);
    LAS float* LGT = (LAS float*)(lds + N2_LGT) + wave * 576; LAS float* RST = (LAS float*)(lds + N2_RST) + wave * 16;
    LAS int* CNT = (LAS int*)(lds + N2_CNT); LAS int* BASE = (LAS int*)(lds + N2_BASE); LAS int* TOKR = (LAS int*)(lds + N2_TOK);
    const float* X1 = WSP(float, WS_X1); const float* MOD = WSP(float, WS_MOD); unsigned char* H8 = WSP(unsigned char, WS_H8);
    const float* in_n2 = KIN_norm2_g + l * 1024; const float* in_rb = KIN_router_b + l * 32; const float* in_rw = KIN_router_w + (size_t)l * 32768;
    int* TOPE = (int*)(F.ws + WS_ROUTE + RT_TOPE); float* TOPG = (float*)(F.ws + WS_ROUTE + RT_TOPG); int* RANK = (int*)(F.ws + WS_ROUTE + RT_RANK);
    for (int chunk = F.bid; chunk < T_TOK / 128; chunk += F.G) {
        const int b = chunk >> 4; const float* md = MOD + ((size_t)l * 16 + b) * 6144;
        __syncthreads();
        { float cp = 0.f;
          for (int idx = tid; idx < 32 * 1024; idx += 512) { const int k = idx >> 5, e = idx & 31; const float w = in_rw[idx]; const float wp = w * (in_n2[k] * (1.0f + md[4 * 1024 + k]));
              const unsigned hw = pk2(wp, 0.f) & 0xffffu; const float lo = wp - __uint_as_float(hw << 16);
              WH[e * N2_WROW + k] = (bf16_t)hw; WL[e * N2_WROW + k] = (bf16_t)(pk2(lo, 0.f) & 0xffffu); cp += md[3 * 1024 + k] * w; }
          PART[(tid >> 5) * 32 + (tid & 31)] = cp; }
        if (tid < 32) CNT[tid] = 0;
        __syncthreads();
        if (tid < 32) { float c = in_rb[tid];
#pragma unroll
            for (int p = 0; p < 16; ++p) c += PART[p * 32 + tid];
            CB[tid] = c; }
        __syncthreads();
        const int t0w = chunk * 128 + wave * 16;
        {
            const float* xp = X1 + (size_t)(t0w + fr) * 1024 + 8 * g;
            f32x4 acc0 = {F.zf, F.zf, F.zf, F.zf}, acc1 = acc0; float ssq = 0.f;
            const LAS bf16_t* wh0 = WH + fr * N2_WROW + 8 * g; const LAS bf16_t* wl0 = WL + fr * N2_WROW + 8 * g;
#pragma unroll 8
            for (int ks = 0; ks < 32; ++ks) {
                const f32x4 xa = *(const f32x4*)(xp + 32 * ks), xb = *(const f32x4*)(xp + 32 * ks + 4);
                ssq += (xa[0] * xa[0] + xa[1] * xa[1]) + (xa[2] * xa[2] + xa[3] * xa[3]) + (xb[0] * xb[0] + xb[1] * xb[1]) + (xb[2] * xb[2] + xb[3] * xb[3]);
                u32x4 hw; hw.x = pk2(xa[0], xa[1]); hw.y = pk2(xa[2], xa[3]); hw.z = pk2(xb[0], xb[1]); hw.w = pk2(xb[2], xb[3]);
                u32x4 lw; lw.x = pk2(xa[0] - bf_lo(hw.x), xa[1] - bf_hi(hw.x)); lw.y = pk2(xa[2] - bf_lo(hw.y), xa[3] - bf_hi(hw.y)); lw.z = pk2(xb[0] - bf_lo(hw.z), xb[1] - bf_hi(hw.z)); lw.w = pk2(xb[2] - bf_lo(hw.w), xb[3] - bf_hi(hw.w));
                const bf16x8 ah = __builtin_bit_cast(bf16x8, hw), al = __builtin_bit_cast(bf16x8, lw);
                const bf16x8 bh0 = *(const LAS bf16x8*)(wh0 + 32 * ks), bh1 = *(const LAS bf16x8*)(wh0 + 16 * N2_WROW + 32 * ks), bl0 = *(const LAS bf16x8*)(wl0 + 32 * ks), bl1 = *(const LAS bf16x8*)(wl0 + 16 * N2_WROW + 32 * ks);
                acc0 = __builtin_amdgcn_mfma_f32_16x16x32_bf16(ah, bh0, acc0, 0, 0, 0); acc0 = __builtin_amdgcn_mfma_f32_16x16x32_bf16(ah, bl0, acc0, 0, 0, 0); acc0 = __builtin_amdgcn_mfma_f32_16x16x32_bf16(al, bh0, acc0, 0, 0, 0);
                acc1 = __builtin_amdgcn_mfma_f32_16x16x32_bf16(ah, bh1, acc1, 0, 0, 0); acc1 = __builtin_amdgcn_mfma_f32_16x16x32_bf16(ah, bl1, acc1, 0, 0, 0); acc1 = __builtin_amdgcn_mfma_f32_16x16x32_bf16(al, bh1, acc1, 0, 0, 0);
            }
            ssq += __shfl_xor(ssq, 16); ssq += __shfl_xor(ssq, 32);
            if (g == 0) RST[fr] = 1.0f / sqrtf(ssq * (1.0f / 1024.0f) + NORM_EPS);
#pragma unroll
            for (int r = 0; r < 4; ++r) { LGT[(4 * g + r) * 36 + fr] = acc0[r]; LGT[(4 * g + r) * 36 + 16 + fr] = acc1[r]; }
        }
        LDS_WAIT();
        if (lane < 16) {
            const int t = t0w + lane; const float rt = RST[lane];
            float a[32];
#pragma unroll
            for (int q = 0; q < 8; ++q) { const f32x4 w = *(const LAS f32x4*)(LGT + lane * 36 + 4 * q), c = *(const LAS f32x4*)(CB + 4 * q); a[4 * q] = w[0] * rt + c[0]; a[4 * q + 1] = w[1] * rt + c[1]; a[4 * q + 2] = w[2] * rt + c[2]; a[4 * q + 3] = w[3] * rt + c[3]; }
            float tv[4]; int te[4];
#pragma unroll
            for (int k = 0; k < 4; ++k) { float best = a[0]; int bi = 0;
#pragma unroll
                for (int e = 1; e < 32; ++e) if (a[e] > best) { best = a[e]; bi = e; }
                tv[k] = best; te[k] = bi;
#pragma unroll
                for (int e = 0; e < 32; ++e) if (e == bi) a[e] = -INFINITY; }
            const float e1 = __expf(tv[1] - tv[0]), e2 = __expf(tv[2] - tv[0]), e3 = __expf(tv[3] - tv[0]); const float inv = 1.0f / (1.0f + e1 + e2 + e3);
            const float gk[4] = {inv, e1 * inv, e2 * inv, e3 * inv};
#pragma unroll
            for (int k = 0; k < 4; ++k) { const int loc = __hip_atomic_fetch_add(&CNT[te[k]], 1, __ATOMIC_RELAXED, __HIP_MEMORY_SCOPE_WORKGROUP); TOKR[(wave * 16 + lane) * 4 + k] = te[k] | (loc << 8); }
            *(f32x4*)(TOPG + (size_t)t * 4) = (f32x4){gk[0], gk[1], gk[2], gk[3]};
        }
        { f32x4 gs[4], shv[4];
#pragma unroll
          for (int i = 0; i < 4; ++i) { const int co = 4 * lane + 256 * i; gs[i] = *(const f32x4*)(in_n2 + co) * (*(const f32x4*)(md + 4 * 1024 + co) + 1.0f); shv[i] = *(const f32x4*)(md + 3 * 1024 + co); }
          for (int j = 0; j < 16; j += 4) {
            f32x4 xv[4][4];
#pragma unroll
            for (int jj = 0; jj < 4; ++jj)
#pragma unroll
                for (int i = 0; i < 4; ++i) xv[jj][i] = *(const f32x4*)(X1 + (size_t)(t0w + j + jj) * 1024 + 4 * lane + 256 * i);
#pragma unroll
            for (int jj = 0; jj < 4; ++jj) { const float r = RST[j + jj];
#pragma unroll
                for (int i = 0; i < 4; ++i) { const f32x4 hv = xv[jj][i] * r * gs[i] + shv[i];
                    *(unsigned*)(H8 + (size_t)(t0w + j + jj) * 1024 + 4 * lane + 256 * i) = pk4_fp8(hv[0], hv[1], hv[2], hv[3]); } }
          } }
        __syncthreads();
        if (tid < 32) BASE[tid] = (int)__hip_atomic_fetch_add(F.ctl + CW_CNT + (cset * 32 + tid) * 64, (unsigned)CNT[tid], __ATOMIC_RELAXED, __HIP_MEMORY_SCOPE_AGENT);
        __syncthreads();
        { const int pr = TOKR[tid], e = pr & 255, loc = pr >> 8; const size_t o = (size_t)(chunk * 128) * 4 + tid; TOPE[o] = e; RANK[o] = BASE[e] + loc; }
    }
}
constexpr int MOE_OFF = LDS_X, MOE_CNTL = LDS_X + 256, MOE_TEXP = LDS_X + 512;
DI int moe_offsets(const Frame& F, int l) {
    LAS int* OFF = (LAS int*)(F.lds + MOE_OFF); LAS int* CNTL = (LAS int*)(F.lds + MOE_CNTL); LAS int* TEXP = (LAS int*)(F.lds + MOE_TEXP);
    __syncthreads();
    if (F.tid < 32) CNTL[F.tid] = (int)__hip_atomic_load(F.ctl + CW_CNT + (l * 32 + F.tid) * 64, __ATOMIC_RELAXED, __HIP_MEMORY_SCOPE_AGENT);
    __syncthreads();
    if (F.tid == 0) { int off = 0; for (int e = 0; e < 32; ++e) { OFF[e] = off; off += (CNTL[e] + 255) & ~255; } OFF[32] = off; }
    __syncthreads();
    const int ntiles = OFF[32] >> 8;
    for (int tl = F.tid; tl < ntiles; tl += 512) { int e = 0; for (int q = 0; q < 32; ++q) if (OFF[q] <= tl * 256 && tl * 256 < OFF[q + 1]) e = q; TEXP[tl] = e; }
    __syncthreads();
    return ntiles;
}
DI void phase_scatter(const Frame& F, int l) {
    const int lane = F.lane, wave = F.wave;
    (void)moe_offsets(F, l);
    const LAS int* OFF = (const LAS int*)(F.lds + MOE_OFF); const LAS int* CNTL = (const LAS int*)(F.lds + MOE_CNTL);
    const int* TOPE = (const int*)(F.ws + WS_ROUTE + RT_TOPE); const float* TOPG = (const float*)(F.ws + WS_ROUTE + RT_TOPG); const int* RANK = (const int*)(F.ws + WS_ROUTE + RT_RANK);
    int* SLOTOF = (int*)(F.ws + WS_ROUTE + RT_SLOTOF); int* TOKOF = (int*)(F.ws + WS_ROUTE + RT_TOKOF); float* GATEOF = (float*)(F.ws + WS_ROUTE + RT_GATEOF);
    const unsigned char* H8 = WSP(unsigned char, WS_H8); unsigned char* XB = WSP(unsigned char, WS_XB);
    for (int chunk = F.bid; chunk < T_TOK / 128; chunk += F.G) {
        const int pair = wave * 64 + lane, tl = chunk * 128 + (pair >> 2); const size_t o = (size_t)tl * 4 + (pair & 3);
        const int e = TOPE[o], slot = OFF[e] + RANK[o];
        SLOTOF[o] = slot; TOKOF[slot] = tl; GATEOF[slot] = TOPG[o];
#pragma unroll 4
        for (int p = 0; p < 64; ++p) {
            const int sp = __builtin_amdgcn_readlane(slot, p), tp = chunk * 128 + ((wave * 64 + p) >> 2);
            *(u32x4*)(XB + (size_t)sp * 1024 + 16 * lane) = *(const u32x4*)(H8 + (size_t)tp * 1024 + 16 * lane);
        }
    }
    for (int e = F.bid; e < 32; e += F.G) {
        const int s0 = OFF[e] + CNTL[e], s1 = OFF[e + 1];
        for (int s = s0 + wave; s < s1; s += 8) { if (lane == 0) { TOKOF[s] = 0; GATEOF[s] = 0.f; }
            *(u32x4*)(XB + (size_t)s * 1024 + 16 * lane) = (u32x4){0u, 0u, 0u, 0u}; }
    }
}

#ifndef MK_SPLIT
#define MK_SPLIT 0
#endif
constexpr int NPHASE = 2 + 11 * DEPTH;
struct Args { const void* in[23]; float* out; unsigned char* ws; int ph_lo, ph_hi; };
static_assert(sizeof(Args) == 25 * 8 + 8, "Args has no padding");


#ifndef PH_ENABLE
#define PH_ENABLE 0xFFFF
#endif
#define IN(k) (lo <= (k) && (k) < hi)
#define EN(j) (((PH_ENABLE) >> (j)) & 1)
#ifndef STAG_G1
#define STAG_G1 0
#endif
#ifndef STAG_G3
#define STAG_G3 0
#endif
#ifndef STAG_G4
#define STAG_G4 0
#endif
#ifndef STAG_M2
#define STAG_M2 0
#endif
#ifndef DUP_MASK
#define DUP_MASK 0
#endif
#define NREP(j) ((((DUP_MASK) >> (j)) & 1) ? 2 : 1)
#define SEAM(k) do { if (!MK_SPLIT && (k) + 1 < hi) { XcdBarrier bar_; bar_.bar = F.ctl + CW_BAR; bar_.x = xb_xcc_id(); bar_.st = (volatile LAS unsigned*)((LAS unsigned char*)lds_raw + MISC_OFF) + 8; xcd_barrier(bar_, F.tid); } } while (0)
DI void layer_phases(const int l, const int lo, const int hi, const int wave0) {
        const int pb = 2 + 11 * l;
        if (EN(2) && IN(pb + 0)) { const Frame F = make_frame(wave0);
            stagger(F, STAG_G1);
            { int kb8 = 1024; asm volatile("" : "+s"(kb8));
              SchedPlain S; S.o.init(T_TOK / 256, G1_F8_COLS / 256, F.G, F.bid); S.A = (const char*)WSP(unsigned char, WS_HG8); S.B = (const char*)(WSP(unsigned char, WS_WIN) + (size_t)l * NP * 2048); S.tstep = (size_t)256 * 1024;
              EpiStoreBf16N E{WSP(bf16_t, WS_P), NP, 0};
#ifdef PROBE_NOSTORE
              _Pragma("unroll") for (int rep = 0; rep < NREP(2); ++rep) { E.skip = (rep + 1 < NREP(2)); pg8::gemm_phase_f8<EpiStoreBf16N, SchedPlain>(F.lds, F.tid, kb8, S, E); } }
#else
              _Pragma("unroll") for (int rep = 0; rep < NREP(2) + NREP(14) - 1; ++rep) pg8::gemm_phase_f8<EpiStoreBf16N, SchedPlain>(F.lds, F.tid, kb8, S, E); }
#endif
            { int tid2 = F.tid; asm volatile("" : "+v"(tid2));
              SchedPlain S; S.o.init(T_TOK / 256, (NP - G1_F8_COLS) / 256, F.G, F.bid); S.A = (const char*)WSP(bf16_t, WS_H); S.B = (const char*)(WSP(bf16_t, WS_WIN) + (size_t)l * NP * 1024 + (size_t)G1_F8_COLS * 1024); S.tstep = (size_t)256 * 1024 * 2;
              EpiStoreBf16 E{WSP(bf16_t, WS_P), NP, G1_F8_COLS};
#ifdef PROBE_NOSTORE
              _Pragma("unroll") for (int rep = 0; rep < NREP(2); ++rep) { E.skip = (rep + 1 < NREP(2)); pg8::gemm_phase<EpiStoreBf16, SchedPlain>(F.lds, tid2, 1024, S, E); } }
#else
              _Pragma("unroll") for (int rep = 0; rep < NREP(2) + NREP(15) - 1; ++rep) pg8::gemm_phase<EpiStoreBf16, SchedPlain>(F.lds, tid2, 1024, S, E); }
#endif
            SEAM(pb + 0);
        }
        if (EN(3) && IN(pb + 1)) { const Frame F = make_frame(wave0); _Pragma("unroll") for (int rep = 0; rep < NREP(3); ++rep) phase_post(F, l); SEAM(pb + 1); }
        if (EN(4) && IN(pb + 2)) { const Frame F = make_frame(wave0);
            int k256 = 256; asm volatile("" : "+s"(k256));
            { SchedPlain S; S.o.init(T_TOK / 256, 3, F.G, F.bid); S.A = (const char*)WSP(bf16_t, WS_CQ); S.B = (const char*)(WSP(bf16_t, WS_WUQ) + (size_t)l * 768 * 256); S.tstep = (size_t)256 * 256 * 2;
              EpiStoreBf16 E{WSP(bf16_t, WS_QA), 768};
              pg8::gemm_phase<EpiStoreBf16, SchedPlain>(F.lds, F.tid, k256, S, E); }
            { int tid2 = F.tid; asm volatile("" : "+v"(tid2));
              SchedPlain S; S.o.init(T_TOK / 256, 4, F.G, F.bid); S.A = (const char*)WSP(bf16_t, WS_CKV); S.B = (const char*)(WSP(bf16_t, WS_WUKV) + (size_t)l * 1024 * 256); S.tstep = (size_t)256 * 256 * 2;
              EpiStoreBf16 E{WSP(bf16_t, WS_KV), 1024};
              pg8::gemm_phase<EpiStoreBf16, SchedPlain>(F.lds, tid2, k256, S, E); }
            SEAM(pb + 2);
        }
        if (EN(5) && IN(pb + 3)) { const Frame F = make_frame(wave0); phase_attention(F, NREP(5), NREP(13)); SEAM(pb + 3); }
        if (EN(6) && IN(pb + 4)) { const Frame F = make_frame(wave0);
            stagger(F, STAG_G3);
            SchedBranch S; S.o.init(T_TOK / 256, 4, F.G, F.bid); S.A = (const char*)WSP(bf16_t, WS_O3); S.B = (const char*)(WSP(bf16_t, WS_WB) + (size_t)l * 3 * 1024 * 512); S.tstep = (size_t)256 * 512 * 2; S.aslab = (size_t)T_TOK * 512 * 2;
            EpiBranchGate E{WSP(bf16_t, WS_GY), WSP(bf16_t, WS_P), KIN_b_gate + l * 3072};
            _Pragma("unroll") for (int rep = 0; rep < NREP(6); ++rep) pg8::gemm_phase<EpiBranchGate, SchedBranch>(F.lds, F.tid, 512, S, E);
            SEAM(pb + 4);
        }
        if (EN(7) && IN(pb + 5)) { const Frame F = make_frame(wave0);
            stagger(F, STAG_G4);
            SchedPlain S; S.o.init(T_TOK / 256, 4, F.G, F.bid); S.A = (const char*)WSP(bf16_t, WS_GY); S.B = (const char*)(WSP(bf16_t, WS_WOUT) + (size_t)l * 1024 * 1024); S.tstep = (size_t)256 * 1024 * 2;
            EpiResidual E{l == 0 ? KIN_x : WSP(float, WS_X1), WSP(float, WS_X1), WSP(float, WS_MOD) + (size_t)l * 16 * 6144 + 2 * 1024};
            _Pragma("unroll") for (int rep = 0; rep < NREP(7); ++rep) if (rep == 0 || l == 0) pg8::gemm_phase<EpiResidual, SchedPlain>(F.lds, F.tid, 1024, S, E);
            SEAM(pb + 5);
        }
        if (EN(8) && IN(pb + 6)) { const Frame F = make_frame(wave0); phase_router(F, l, l); if (NREP(8) == 2) phase_router(F, l, l + 2); SEAM(pb + 6); }
        if (EN(9) && IN(pb + 7)) { const Frame F = make_frame(wave0); _Pragma("unroll") for (int rep = 0; rep < NREP(9); ++rep) phase_scatter(F, l); SEAM(pb + 7); }
        if (EN(10) && IN(pb + 8)) { const Frame F = make_frame(wave0);
            const int ntiles = moe_offsets(F, l); int kb8 = 1024; asm volatile("" : "+s"(kb8));
            SchedMoe S; S.o.init(ntiles, 8, F.G, F.bid); S.A = (const char*)WSP(unsigned char, WS_XB); S.B = (const char*)(WSP(unsigned char, WS_W1) + (size_t)l * 32 * 2048 * 1024); S.eslab = 2048u * 1024u;
            S.texp = (const LAS int*)(F.lds + MOE_TEXP);
#if M2_F8
            EpiSwiglu8 E{WSP(unsigned char, WS_ACT), KIN_b1 + (size_t)l * 32 * 2048, (const LAS int*)(F.lds + MOE_TEXP)};
#else
            EpiSwiglu E{WSP(bf16_t, WS_ACT), KIN_b1 + (size_t)l * 32 * 2048, (const LAS int*)(F.lds + MOE_TEXP)};
#endif
            _Pragma("unroll") for (int rep = 0; rep < NREP(10); ++rep)
#if M2_F8
#ifdef PROBE_M1
            { E.skip = (rep + 1 < NREP(10)) ? PROBE_M1 : 0; pg8::gemm_phase_f8<EpiSwiglu8, SchedMoe>(F.lds, F.tid, kb8, S, E); }
#else
            pg8::gemm_phase_f8<EpiSwiglu8, SchedMoe>(F.lds, F.tid, kb8, S, E);
#endif
#else
            pg8::gemm_phase_f8<EpiSwiglu, SchedMoe>(F.lds, F.tid, kb8, S, E);
#endif

            SEAM(pb + 8);
        }
        if (EN(11) && IN(pb + 9)) { const Frame F = make_frame(wave0);
            const int ntiles = moe_offsets(F, l); int kb8 = 1024; asm volatile("" : "+s"(kb8));
            stagger(F, STAG_M2);
#if M2_F8
            SchedMoe S; S.o.init(ntiles, 4, F.G, F.bid); S.A = (const char*)WSP(unsigned char, WS_ACT); S.B = (const char*)(WSP(unsigned char, WS_W2) + (size_t)l * 32 * 1024 * 1024); S.eslab = 1024u * 1024u;
            S.texp = (const LAS int*)(F.lds + MOE_TEXP);
            EpiMoeOut E{WSP(bf16_t, WS_Y), KIN_b2 + (size_t)l * 32 * 1024, (const float*)(F.ws + WS_ROUTE + RT_GATEOF), (const LAS int*)(F.lds + MOE_TEXP)};
            _Pragma("unroll") for (int rep = 0; rep < NREP(11); ++rep) pg8::gemm_phase_f8<EpiMoeOut, SchedMoe>(F.lds, F.tid, kb8, S, E);
#else
            SchedMoeB S; S.o.init(ntiles, 4, F.G, F.bid); S.A = (const char*)WSP(bf16_t, WS_ACT); S.B = (const char*)(WSP(bf16_t, WS_W2) + (size_t)l * 32 * 1024 * 1024); S.eslab = 1024u * 1024u * 2u;
            S.texp = (const LAS int*)(F.lds + MOE_TEXP);
            EpiMoeOut E{WSP(bf16_t, WS_Y), KIN_b2 + (size_t)l * 32 * 1024, (const float*)(F.ws + WS_ROUTE + RT_GATEOF), (const LAS int*)(F.lds + MOE_TEXP)};
            _Pragma("unroll") for (int rep = 0; rep < NREP(11); ++rep) pg8::gemm_phase<EpiMoeOut, SchedMoeB>(F.lds, F.tid, kb8, S, E);
#endif
            SEAM(pb + 9);
        }
        if (EN(12) && IN(pb + 10)) { const Frame F = make_frame(wave0);
            const bool last = (l == DEPTH - 1);
            _Pragma("unroll") for (int rep = 0; rep < NREP(12); ++rep) if (rep == 0 || last) phase_norm(F, WSP(float, WS_X1), WSP(float, WS_X1), true, !last, last, l + 1 < DEPTH ? l + 1 : 0, l);
            SEAM(pb + 10);
        }
}
__global__ void __launch_bounds__(512, 2) fwd_kernel(Args args) {
    const int wave0 = __builtin_amdgcn_readfirstlane(threadIdx.x >> 6);
    {
        volatile LAS unsigned* MISC = (volatile LAS unsigned*)((LAS unsigned char*)lds_raw + MISC_OFF);
        if (threadIdx.x < 32) MISC[threadIdx.x] = 0u;
        __syncthreads();
        if (!MK_SPLIT) { const Frame F = make_frame(wave0); (void)xcd_barrier_post(F.ctl + CW_BAR, MISC + 8, F.tid); }
    }
    const int lo = args.ph_lo, hi = args.ph_hi;
    if (EN(0) && IN(0)) { const Frame F = make_frame(wave0); _Pragma("unroll") for (int rep = 0; rep < NREP(0); ++rep) phase_prologue(F); SEAM(0); }
    if (EN(1) && IN(1)) { const Frame F = make_frame(wave0); _Pragma("unroll") for (int rep = 0; rep < NREP(1); ++rep) phase_norm(F, KIN_x, nullptr, false, false, false, 0, 0); SEAM(1); }
    layer_phases(0, lo, hi, wave0);
    layer_phases(1, lo, hi, wave0);
    static_assert(DEPTH == 2, "two layers");
#undef IN
#undef SEAM
}

extern "C" void kernel_launch(void* const* d_in, const int* in_sizes, int n_in, void* d_out, int out_size, void* d_ws, size_t ws_size, hipStream_t stream) {
    static int grid = 0;
    if (grid == 0) {
        if (n_in != 23 || out_size != T_TOK * D_MODEL || ws_size < WS_END) { fprintf(stderr, "kernel_launch: unexpected problem (n_in %d, out %d, ws %zu)\n", n_in, out_size, ws_size); grid = -1; return; }
        int dev = 0, cus = 0;
        if (hipGetDevice(&dev) != hipSuccess || hipDeviceGetAttribute(&cus, hipDeviceAttributeMultiprocessorCount, dev) != hipSuccess) { grid = -1; return; }
        if (hipFuncSetAttribute((const void*)fwd_kernel, hipFuncAttributeMaxDynamicSharedMemorySize, LDS_BYTES) != hipSuccess) { fprintf(stderr, "kernel_launch: hipFuncSetAttribute failed\n"); grid = -1; return; }
        int per_cu = 0;
        if (hipOccupancyMaxActiveBlocksPerMultiprocessor(&per_cu, (const void*)fwd_kernel, 512, LDS_BYTES) != hipSuccess || per_cu < 1) fprintf(stderr, "kernel_launch: occupancy query says %d\n", per_cu);
        (void)hipGetLastError();
        grid = cus > 256 ? 256 : cus;
    }
    if (grid < 0) return;
    (void)in_sizes;
    if (hipMemsetAsync((char*)d_ws + WS_CTL, 0, CTL_ZERO_BYTES, stream) != hipSuccess) return;
    Args a{};
    for (int i = 0; i < 23; ++i) a.in[i] = d_in[i];
    a.out = (float*)d_out; a.ws = (unsigned char*)d_ws;
#if MK_SPLIT
    for (int p = 0; p < NPHASE; ++p) { a.ph_lo = p; a.ph_hi = p + 1; hipLaunchKernelGGL(fwd_kernel, dim3(grid), dim3(512), LDS_BYTES, stream, a); }
#else
    a.ph_lo = 0; a.ph_hi = NPHASE;
    hipLaunchKernelGGL(fwd_kernel, dim3(grid), dim3(512), LDS_BYTES, stream, a);
#endif
}
```

```cpp
#include <hip/hip_runtime.h>
#include <cstdio>
#include <cstdint>

#ifndef M2_F8
#define M2_F8 1
#endif
#define LAS __attribute__((address_space(3)))
#define GAS __attribute__((address_space(1)))
typedef unsigned short bf16_t;
typedef short bf16x8 __attribute__((ext_vector_type(8)));
typedef short s16x4 __attribute__((ext_vector_type(4)));
typedef float f32x2 __attribute__((ext_vector_type(2)));
typedef float f32x4 __attribute__((ext_vector_type(4)));
typedef float f32x16 __attribute__((ext_vector_type(16)));
typedef unsigned u32x2 __attribute__((ext_vector_type(2)));
typedef unsigned u32x4 __attribute__((ext_vector_type(4)));
#define DI __device__ __forceinline__

constexpr int D_MODEL = 1024, BATCH = 16, SEQ = 2048, T_TOK = BATCH * SEQ, DEPTH = 2;
constexpr float NORM_EPS = 1e-6f;
constexpr int IN_COLS = 6248, NP = 6400;
constexpr int N_EXP = 32, TOP_K = 4, D_EXP = 1024;
constexpr int NSLOT_MAX = T_TOK * TOP_K + N_EXP * 256;
constexpr int PC_GATE = 0, PC_CONV = 3072, PC_DQ = 4608, PC_IQ = 5120, PC_QLAT = 5632, PC_KVLAT = 5888, PC_DKV = 6048, PC_IK = 6176, PC_IW = 6240;
constexpr int OC_QLAT = 0, OC_KVLAT = 256, OC_CONV = 416, OC_DQ = 1952, OC_DKV = 2464, OC_IQ = 2592, OC_IK = 3104, OC_IW = 3168, OC_GATE = 3176;

DI unsigned pk2(float lo, float hi) { typedef __bf16 bf16x2_t __attribute__((ext_vector_type(2))); f32x2 v = {lo, hi}; bf16x2_t b = __builtin_convertvector(v, bf16x2_t); return __builtin_bit_cast(unsigned, b); }
DI float bf_lo(unsigned w) { return __uint_as_float(w << 16); }
DI float bf_hi(unsigned w) { return __uint_as_float(w & 0xffff0000u); }
DI float bf2f(bf16_t h) { return __uint_as_float((unsigned)h << 16); }
DI float wave_sum(float v) {
#pragma unroll
    for (int o = 1; o < 64; o <<= 1) v += __shfl_xor(v, o);
    return v;
}
DI float fast_sigmoid(float x) { return __builtin_amdgcn_rcpf(1.0f + __builtin_amdgcn_exp2f(-1.4426950408889634f * x)); }
DI unsigned pk4_fp8(float a, float b, float c, float d) { int w = __builtin_amdgcn_cvt_pk_fp8_f32(a, b, 0, false); w = __builtin_amdgcn_cvt_pk_fp8_f32(c, d, w, true); return (unsigned)w; }
#define LDS_WAIT() asm volatile("s_waitcnt lgkmcnt(0)" ::: "memory")
#define VM_WAIT() asm volatile("s_waitcnt vmcnt(0)" ::: "memory")

namespace pg8 {
DI void glds16_s(unsigned voff, const char* sbase, unsigned lds_dst) { unsigned keep; asm volatile("s_nop 4\n\ts_mov_b32 %0, m0\n\ts_mov_b32 m0, %3\n\ts_nop 0\n\tglobal_load_lds_dwordx4 %1, %2\n\ts_mov_b32 m0, %0" : "=&s"(keep) : "v"(voff), "s"(sbase), "s"(lds_dst) : "memory"); }
DI const char* uni_ptr(const char* p) { const unsigned long long v = (unsigned long long)p; const unsigned lo = __builtin_amdgcn_readfirstlane((unsigned)v), hi = __builtin_amdgcn_readfirstlane((unsigned)(v >> 32)); return (const char*)(GAS const char*)(((unsigned long long)hi << 32) | lo); }
constexpr int BM = 256, BK = 64, HALF = 128, HTB = HALF * BK * 2, STAGE_BYTES = 8 * HTB, NXCD = 8, WGM = 8;
__host__ __device__ __forceinline__ int lds_byte(int r, int c) { const int st = (r >> 4) * 2 + (c >> 5), rr = r & 15, cc = c & 31, ob = rr * 64 + cc * 2; return st * 1024 + (ob ^ (((ob >> 9) & 1) << 5)); }
__host__ __device__ __forceinline__ void stage_rc(int b, int& R, int& C) { const int st = b / 1024, sb = b % 1024, swz = sb ^ (((sb >> 9) & 1) << 5); R = (st >> 1) * 16 + swz / 64; C = (st & 1) * 32 + (swz % 64) / 2; }
__host__ __device__ __forceinline__ int perm32(int rho) { const int n = rho >> 4, i = rho & 15; return 8 * (i >> 2) + 4 * n + (i & 3); }
struct Unit { int pm, pn; };
struct StaticOrder {
    int nM, nN, nwg, G, c;
    DI void init(int nM_, int nN_, int G_, int c_) { nM = nM_; nN = nN_; nwg = nM * nN; G = G_; c = c_; }
    DI bool next(int i, Unit& u) const {
        const long L = (long)i * G + c; if (L >= nwg) return false;
        int wgid = (int)L; { const int q = nwg / NXCD, r = nwg % NXCD, xcd = wgid % NXCD, off = wgid / NXCD; wgid = (xcd < r ? xcd * (q + 1) : r * (q + 1) + (xcd - r) * q) + off; }
        const int nig = WGM * nN, gid = wgid / nig, fm = gid * WGM, gsz = (nM - fm) < WGM ? (nM - fm) : WGM;
        u.pm = fm + ((wgid % nig) % gsz); u.pn = (wgid % nig) / gsz; return true;
    }
};

template <class Epi, class Sched, bool ALIGN_EPI = true, bool SP2 = true>
DI void gemm_phase(LAS unsigned char* lds, const int tid, const int K, const Sched& S, const Epi& E) {
    const int wid = __builtin_amdgcn_readfirstlane(tid >> 6), lane = tid & 63, wr = wid >> 2, wc = wid & 3, fr = lane & 15, fq = lane >> 4;
    const int nt = K / BK;
    unsigned voffA[2], voffB[2];
#pragma unroll
    for (int i = 0; i < 2; ++i) { int R, C; stage_rc(tid * 16 + i * 8192, R, C); const int Rb = Epi::PERM ? ((R & ~31) + perm32(R & 31)) : R;
        voffA[i] = (unsigned)(R * K + C) * 2u; voffB[i] = (unsigned)(Rb * K + C) * 2u; }
    const size_t kstep = (size_t)(BK * 2);
    const size_t hstep = (size_t)HALF * K * 2;
    const unsigned ldsw = (unsigned)wid * 1024u; const unsigned ldsb = (unsigned)(unsigned long long)(lds);
    const int aoff = lds_byte(wr * 64 + fr, fq * 8), boff = lds_byte(wc * 32 + fr, fq * 8);
#define PG8_SA(b, h) (((b) * 2 + (h)) * HTB)
#define PG8_SB(b, h) ((4 + (b) * 2 + (h)) * HTB)
#define PG8_STAGE(bufoff, gbase, voff) do { _Pragma("unroll") for (int _i = 0; _i < 2; ++_i) \
        glds16_s((voff)[_i], (const char*)(gbase), ldsb + (unsigned)(bufoff) + ldsw + (unsigned)(_i * 8192)); } while (0)
#define PG8_LDA(dst, b, h) do { int a_ = aoff; asm volatile("" : "+v"(a_)); _Pragma("unroll") for (int m = 0; m < 4; ++m) _Pragma("unroll") for (int k = 0; k < 2; ++k) dst[m][k] = *(const LAS bf16x8*)(lds + PG8_SA(b, h) + a_ + m * 2048 + k * 1024); } while (0)
#define PG8_LDB(dst, b, h) do { int b_ = boff; asm volatile("" : "+v"(b_)); _Pragma("unroll") for (int n = 0; n < 2; ++n) _Pragma("unroll") for (int k = 0; k < 2; ++k) dst[n][k] = *(const LAS bf16x8*)(lds + PG8_SB(b, h) + b_ + n * 2048 + k * 1024); } while (0)
#define PG8_MMA(ai, bj, At, Bt) do { __builtin_amdgcn_s_setprio(1); _Pragma("unroll") for (int m = 0; m < 4; ++m) _Pragma("unroll") for (int n = 0; n < 2; ++n) _Pragma("unroll") for (int k = 0; k < 2; ++k) \
        acc[ai][bj][m][n] = __builtin_amdgcn_mfma_f32_16x16x32_bf16(Bt[n][k], At[m][k], acc[ai][bj][m][n], 0, 0, 0); __builtin_amdgcn_s_setprio(0); } while (0)
#define PG8_WAIT_V(n) asm volatile("s_waitcnt vmcnt(" #n ")" ::: "memory")
#define PG8_WAIT_L(n) asm volatile("s_waitcnt lgkmcnt(" #n ")" ::: "memory")
#define PG8_BAR __builtin_amdgcn_s_barrier()
#define PG8_SCHED __builtin_amdgcn_sched_barrier(0)
    Unit cur, nxt; int ui = 0;
    if (!S.next(0, cur)) return;
    float zf_ = 0.f; asm volatile("" : "+v"(zf_));
    f32x4 acc[2][2][4][2];
#pragma unroll
    for (int a = 0; a < 2; ++a)
#pragma unroll
        for (int b = 0; b < 2; ++b)
#pragma unroll
            for (int m = 0; m < 4; ++m)
#pragma unroll
                for (int n = 0; n < 2; ++n) acc[a][b][m][n] = (f32x4){zf_, zf_, zf_, zf_};
    bf16x8 At[4][2], B0[2][2], B1[2][2];
    const char* cA = uni_ptr(S.abase(cur)); const char* cB = uni_ptr(S.bbase(cur));
    if constexpr (SP2) {
        PG8_STAGE(PG8_SB(0, 0), cB, voffB); PG8_STAGE(PG8_SB(0, 1), cB + hstep, voffB); PG8_STAGE(PG8_SA(0, 0), cA, voffA); PG8_STAGE(PG8_SA(0, 1), cA + hstep, voffA);
        if (wr == 1) PG8_BAR;
        PG8_WAIT_V(2); PG8_BAR;
        PG8_STAGE(PG8_SB(1, 0), cB + kstep, voffB); PG8_STAGE(PG8_SA(1, 0), cA + kstep, voffA); PG8_STAGE(PG8_SB(1, 1), cB + hstep + kstep, voffB);
        PG8_WAIT_V(6); PG8_BAR;
    } else {
        PG8_STAGE(PG8_SB(0, 0), cB, voffB); PG8_STAGE(PG8_SA(0, 0), cA, voffA); PG8_STAGE(PG8_SB(0, 1), cB + hstep, voffB); PG8_STAGE(PG8_SA(0, 1), cA + hstep, voffA);
        if (wr == 1) PG8_BAR;
        PG8_WAIT_V(4); PG8_BAR;
        PG8_STAGE(PG8_SB(1, 0), cB + kstep, voffB); PG8_STAGE(PG8_SA(1, 0), cA + kstep, voffA); PG8_STAGE(PG8_SB(1, 1), cB + hstep + kstep, voffB);
        PG8_WAIT_V(6); PG8_BAR;
    }
    for (;;) {
        const bool has_next = S.next(ui + 1, nxt);
        const char* nA = has_next ? uni_ptr(S.abase(nxt)) : cA; const char* nB = has_next ? uni_ptr(S.bbase(nxt)) : cB;
        for (int t = 0; t < nt; t += 2) {
            const bool last = (t == nt - 2);
            const char* a1 = cA + (size_t)(t + 1) * kstep;
            const char* a2 = last ? nA : cA + (size_t)(t + 2) * kstep; const char* b2 = last ? nB : cB + (size_t)(t + 2) * kstep;
            const char* a3 = a2 + kstep; const char* b3 = b2 + kstep;
            if constexpr (SP2) {
            PG8_LDB(B0, 0, 0); PG8_LDB(B1, 0, 1); PG8_SCHED; PG8_LDA(At, 0, 0); PG8_STAGE(PG8_SA(1, 1), a1 + hstep, voffA);
            PG8_WAIT_V(8); PG8_WAIT_L(0); PG8_BAR; PG8_MMA(0, 0, At, B0); PG8_MMA(0, 1, At, B1); PG8_BAR; PG8_SCHED;
            PG8_LDA(At, 0, 1); PG8_STAGE(PG8_SB(0, 0), b2, voffB); PG8_STAGE(PG8_SB(0, 1), b2 + hstep, voffB); PG8_STAGE(PG8_SA(0, 0), a2, voffA);
            PG8_WAIT_V(8); PG8_WAIT_L(0); PG8_BAR; PG8_MMA(1, 0, At, B0); PG8_MMA(1, 1, At, B1); PG8_BAR; PG8_SCHED;
            PG8_LDB(B0, 1, 0); PG8_LDB(B1, 1, 1); PG8_SCHED; PG8_LDA(At, 1, 0); PG8_STAGE(PG8_SA(0, 1), a2 + hstep, voffA);
            PG8_WAIT_V(8); PG8_WAIT_L(0); PG8_BAR; PG8_MMA(0, 0, At, B0); PG8_MMA(0, 1, At, B1); PG8_BAR; PG8_SCHED;
            PG8_LDA(At, 1, 1); PG8_STAGE(PG8_SB(1, 0), b3, voffB); PG8_STAGE(PG8_SB(1, 1), b3 + hstep, voffB); PG8_STAGE(PG8_SA(1, 0), a3, voffA);
            PG8_WAIT_V(8); PG8_WAIT_L(0); PG8_BAR; PG8_MMA(1, 0, At, B0); PG8_MMA(1, 1, At, B1); PG8_BAR; PG8_SCHED;
            } else {
            PG8_LDB(B0, 0, 0); PG8_SCHED; PG8_LDA(At, 0, 0); PG8_STAGE(PG8_SA(1, 1), a1 + hstep, voffA);
            PG8_WAIT_L(8); PG8_BAR; PG8_WAIT_L(0); PG8_MMA(0, 0, At, B0); PG8_BAR; PG8_SCHED;
            PG8_LDB(B1, 0, 1); PG8_STAGE(PG8_SB(0, 0), b2, voffB);
            PG8_BAR; PG8_WAIT_L(0); PG8_MMA(0, 1, At, B1); PG8_BAR;
            PG8_LDA(At, 0, 1); PG8_STAGE(PG8_SA(0, 0), a2, voffA);
            PG8_BAR; PG8_WAIT_L(0); PG8_MMA(1, 0, At, B0); PG8_BAR; PG8_SCHED;
            PG8_STAGE(PG8_SB(0, 1), b2 + hstep, voffB);
            PG8_WAIT_V(6); PG8_BAR; PG8_MMA(1, 1, At, B1); PG8_BAR;
            PG8_LDB(B0, 1, 0); PG8_SCHED; PG8_LDA(At, 1, 0); PG8_STAGE(PG8_SA(0, 1), a2 + hstep, voffA);
            PG8_WAIT_L(8); PG8_BAR; PG8_WAIT_L(0); PG8_MMA(0, 0, At, B0); PG8_BAR; PG8_SCHED;
            PG8_LDB(B1, 1, 1); PG8_STAGE(PG8_SB(1, 0), b3, voffB);
            PG8_BAR; PG8_WAIT_L(0); PG8_MMA(0, 1, At, B1); PG8_BAR;
            PG8_LDA(At, 1, 1); PG8_STAGE(PG8_SA(1, 0), a3, voffA);
            PG8_BAR; PG8_WAIT_L(0); PG8_MMA(1, 0, At, B0); PG8_BAR; PG8_SCHED;
            PG8_STAGE(PG8_SB(1, 1), b3 + hstep, voffB);
            PG8_WAIT_V(6); PG8_BAR; PG8_MMA(1, 1, At, B1); PG8_BAR;
            }
        }
        if constexpr (ALIGN_EPI) { if (wr == 0) PG8_BAR; }
        E(acc, cur, wr, wc, fr, fq);
        if (!has_next) break;
#pragma unroll
        for (int a = 0; a < 2; ++a)
#pragma unroll
            for (int b = 0; b < 2; ++b)
#pragma unroll
                for (int m = 0; m < 4; ++m)
#pragma unroll
                    for (int n = 0; n < 2; ++n) acc[a][b][m][n] = (f32x4){zf_, zf_, zf_, zf_};
        cur = nxt; cA = nA; cB = nB; ++ui;
        if constexpr (ALIGN_EPI) { if (wr == 1) PG8_BAR; }
    }
    PG8_WAIT_V(0);
    if constexpr (!ALIGN_EPI) { if (wr == 0) PG8_BAR; }
    PG8_BAR;
#undef PG8_SA
#undef PG8_SB
#undef PG8_STAGE
#undef PG8_LDA
#undef PG8_LDB
#undef PG8_MMA
#undef PG8_WAIT_V
#undef PG8_WAIT_L
#undef PG8_BAR
#undef PG8_SCHED
}
typedef int v8i __attribute__((ext_vector_type(8)));
template <class Epi, class Sched, bool ALIGN_EPI = true, bool SP2 = true>
DI void gemm_phase_f8(LAS unsigned char* lds, const int tid, const int KB, const Sched& S, const Epi& E) {
    const int wid = __builtin_amdgcn_readfirstlane(tid >> 6), lane = tid & 63, wr = wid >> 2, wc = wid & 3, fr = lane & 15, fq = lane >> 4;
    const int nt = KB / 128;
    unsigned voffA[2], voffB[2];
#pragma unroll
    for (int i = 0; i < 2; ++i) { int R, C; stage_rc(tid * 16 + i * 8192, R, C); const int Rb = Epi::PERM ? ((R & ~31) + perm32(R & 31)) : R;
        voffA[i] = (unsigned)(R * KB + 2 * C); voffB[i] = (unsigned)(Rb * KB + 2 * C); }
    const size_t kstep = (size_t)(BK * 2);
    const size_t hstep = (size_t)HALF * KB;
    const unsigned ldsw = (unsigned)wid * 1024u; const unsigned ldsb = (unsigned)(unsigned long long)(lds);
    const int aoff = lds_byte(wr * 64 + fr, fq * 16), boff = lds_byte(wc * 32 + fr, fq * 16);
#define PG8_SA(b, h) (((b) * 2 + (h)) * HTB)
#define PG8_SB(b, h) ((4 + (b) * 2 + (h)) * HTB)
#define PG8_STAGE(bufoff, gbase, voff) do { _Pragma("unroll") for (int _i = 0; _i < 2; ++_i) \
        glds16_s((voff)[_i], (const char*)(gbase), ldsb + (unsigned)(bufoff) + ldsw + (unsigned)(_i * 8192)); } while (0)
#define PG8_LDA(dst, b, h) do { int a_ = aoff; asm volatile("" : "+v"(a_)); _Pragma("unroll") for (int m = 0; m < 4; ++m) dst[m] = *(const LAS v8i*)(lds + PG8_SA(b, h) + a_ + m * 2048); } while (0)
#define PG8_LDB(dst, b, h) do { int b_ = boff; asm volatile("" : "+v"(b_)); _Pragma("unroll") for (int n = 0; n < 2; ++n) dst[n] = *(const LAS v8i*)(lds + PG8_SB(b, h) + b_ + n * 2048); } while (0)
#define PG8_MMA(ai, bj, At, Bt) do { __builtin_amdgcn_s_setprio(1); _Pragma("unroll") for (int m = 0; m < 4; ++m) _Pragma("unroll") for (int n = 0; n < 2; ++n) \
        acc[ai][bj][m][n] = __builtin_amdgcn_mfma_scale_f32_16x16x128_f8f6f4(Bt[n], At[m], acc[ai][bj][m][n], 0, 0, 0, sc8, 0, sc8); __builtin_amdgcn_s_setprio(0); } while (0)
#define PG8_WAIT_V(n) asm volatile("s_waitcnt vmcnt(" #n ")" ::: "memory")
#define PG8_WAIT_L(n) asm volatile("s_waitcnt lgkmcnt(" #n ")" ::: "memory")
#define PG8_BAR __builtin_amdgcn_s_barrier()
#define PG8_SCHED __builtin_amdgcn_sched_barrier(0)
    Unit cur, nxt; int ui = 0;
    if (!S.next(0, cur)) return;
    int sc8 = 0x7c7c7c7c; asm volatile("" : "+v"(sc8));
    float zf_ = 0.f; asm volatile("" : "+v"(zf_));
    f32x4 acc[2][2][4][2];
#pragma unroll
    for (int a = 0; a < 2; ++a)
#pragma unroll
        for (int b = 0; b < 2; ++b)
#pragma unroll
            for (int m = 0; m < 4; ++m)
#pragma unroll
                for (int n = 0; n < 2; ++n) acc[a][b][m][n] = (f32x4){zf_, zf_, zf_, zf_};
    v8i At[4], B0[2], B1[2];
    const char* cA = uni_ptr(S.abase(cur)); const char* cB = uni_ptr(S.bbase(cur));
    if constexpr (SP2) {
        PG8_STAGE(PG8_SB(0, 0), cB, voffB); PG8_STAGE(PG8_SB(0, 1), cB + hstep, voffB); PG8_STAGE(PG8_SA(0, 0), cA, voffA); PG8_STAGE(PG8_SA(0, 1), cA + hstep, voffA);
        if (wr == 1) PG8_BAR;
        PG8_WAIT_V(2); PG8_BAR;
        PG8_STAGE(PG8_SB(1, 0), cB + kstep, voffB); PG8_STAGE(PG8_SA(1, 0), cA + kstep, voffA); PG8_STAGE(PG8_SB(1, 1), cB + hstep + kstep, voffB);
        PG8_WAIT_V(6); PG8_BAR;
    } else {
        PG8_STAGE(PG8_SB(0, 0), cB, voffB); PG8_STAGE(PG8_SA(0, 0), cA, voffA); PG8_STAGE(PG8_SB(0, 1), cB + hstep, voffB); PG8_STAGE(PG8_SA(0, 1), cA + hstep, voffA);
        if (wr == 1) PG8_BAR;
        PG8_WAIT_V(4); PG8_BAR;
        PG8_STAGE(PG8_SB(1, 0), cB + kstep, voffB); PG8_STAGE(PG8_SA(1, 0), cA + kstep, voffA); PG8_STAGE(PG8_SB(1, 1), cB + hstep + kstep, voffB);
        PG8_WAIT_V(6); PG8_BAR;
    }
    for (;;) {
        const bool has_next = S.next(ui + 1, nxt);
        const char* nA = has_next ? uni_ptr(S.abase(nxt)) : cA; const char* nB = has_next ? uni_ptr(S.bbase(nxt)) : cB;
        for (int t = 0; t < nt; t += 2) {
            const bool last = (t == nt - 2);
            const char* a1 = cA + (size_t)(t + 1) * kstep;
            const char* a2 = last ? nA : cA + (size_t)(t + 2) * kstep; const char* b2 = last ? nB : cB + (size_t)(t + 2) * kstep;
            const char* a3 = a2 + kstep; const char* b3 = b2 + kstep;
            if constexpr (SP2) {
            PG8_LDB(B0, 0, 0); PG8_LDB(B1, 0, 1); PG8_SCHED; PG8_LDA(At, 0, 0); PG8_STAGE(PG8_SA(1, 1), a1 + hstep, voffA);
            PG8_WAIT_V(8); PG8_WAIT_L(0); PG8_BAR; PG8_MMA(0, 0, At, B0); PG8_MMA(0, 1, At, B1); PG8_BAR; PG8_SCHED;
            PG8_LDA(At, 0, 1); PG8_STAGE(PG8_SB(0, 0), b2, voffB); PG8_STAGE(PG8_SB(0, 1), b2 + hstep, voffB); PG8_STAGE(PG8_SA(0, 0), a2, voffA);
            PG8_WAIT_V(8); PG8_WAIT_L(0); PG8_BAR; PG8_MMA(1, 0, At, B0); PG8_MMA(1, 1, At, B1); PG8_BAR; PG8_SCHED;
            PG8_LDB(B0, 1, 0); PG8_LDB(B1, 1, 1); PG8_SCHED; PG8_LDA(At, 1, 0); PG8_STAGE(PG8_SA(0, 1), a2 + hstep, voffA);
            PG8_WAIT_V(8); PG8_WAIT_L(0); PG8_BAR; PG8_MMA(0, 0, At, B0); PG8_MMA(0, 1, At, B1); PG8_BAR; PG8_SCHED;
            PG8_LDA(At, 1, 1); PG8_STAGE(PG8_SB(1, 0), b3, voffB); PG8_STAGE(PG8_SB(1, 1), b3 + hstep, voffB); PG8_STAGE(PG8_SA(1, 0), a3, voffA);
            PG8_WAIT_V(8); PG8_WAIT_L(0); PG8_BAR; PG8_MMA(1, 0, At, B0); PG8_MMA(1, 1, At, B1); PG8_BAR; PG8_SCHED;
            } else {
            PG8_LDB(B0, 0, 0); PG8_SCHED; PG8_LDA(At, 0, 0); PG8_STAGE(PG8_SA(1, 1), a1 + hstep, voffA);
            PG8_WAIT_L(8); PG8_BAR; PG8_WAIT_L(0); PG8_MMA(0, 0, At, B0); PG8_BAR; PG8_SCHED;
            PG8_LDB(B1, 0, 1); PG8_STAGE(PG8_SB(0, 0), b2, voffB);
            PG8_BAR; PG8_WAIT_L(0); PG8_MMA(0, 1, At, B1); PG8_BAR;
            PG8_LDA(At, 0, 1); PG8_STAGE(PG8_SA(0, 0), a2, voffA);
            PG8_BAR; PG8_WAIT_L(0); PG8_MMA(1, 0, At, B0); PG8_BAR; PG8_SCHED;
            PG8_STAGE(PG8_SB(0, 1), b2 + hstep, voffB);
            PG8_WAIT_V(6); PG8_BAR; PG8_MMA(1, 1, At, B1); PG8_BAR;
            PG8_LDB(B0, 1, 0); PG8_SCHED; PG8_LDA(At, 1, 0); PG8_STAGE(PG8_SA(0, 1), a2 + hstep, voffA);
            PG8_WAIT_L(8); PG8_BAR; PG8_WAIT_L(0); PG8_MMA(0, 0, At, B0); PG8_BAR; PG8_SCHED;
            PG8_LDB(B1, 1, 1); PG8_STAGE(PG8_SB(1, 0), b3, voffB);
            PG8_BAR; PG8_WAIT_L(0); PG8_MMA(0, 1, At, B1); PG8_BAR;
            PG8_LDA(At, 1, 1); PG8_STAGE(PG8_SA(1, 0), a3, voffA);
            PG8_BAR; PG8_WAIT_L(0); PG8_MMA(1, 0, At, B0); PG8_BAR; PG8_SCHED;
            PG8_STAGE(PG8_SB(1, 1), b3 + hstep, voffB);
            PG8_WAIT_V(6); PG8_BAR; PG8_MMA(1, 1, At, B1); PG8_BAR;
            }
        }
        if constexpr (ALIGN_EPI) { if (wr == 0) PG8_BAR; }
        asm volatile("" ::: "memory"); __builtin_amdgcn_sched_barrier(0);
        { int t2_ = tid; asm volatile("" : "+v"(t2_)); const int w2_ = __builtin_amdgcn_readfirstlane(t2_ >> 6), l2_ = t2_ & 63; E(acc, cur, w2_ >> 2, w2_ & 3, l2_ & 15, l2_ >> 4); }
        if (!has_next) break;
#pragma unroll
        for (int a = 0; a < 2; ++a)
#pragma unroll
            for (int b = 0; b < 2; ++b)
#pragma unroll
                for (int m = 0; m < 4; ++m)
#pragma unroll
                    for (int n = 0; n < 2; ++n) acc[a][b][m][n] = (f32x4){zf_, zf_, zf_, zf_};
        cur = nxt; cA = nA; cB = nB; ++ui;
        if constexpr (ALIGN_EPI) { if (wr == 1) PG8_BAR; }
    }
    PG8_WAIT_V(0);
    if constexpr (!ALIGN_EPI) { if (wr == 0) PG8_BAR; }
    PG8_BAR;
#undef PG8_SA
#undef PG8_SB
#undef PG8_STAGE
#undef PG8_LDA
#undef PG8_LDB
#undef PG8_MMA
#undef PG8_WAIT_V
#undef PG8_WAIT_L
#undef PG8_BAR
#undef PG8_SCHED
}
}

struct SchedPlain {
    pg8::StaticOrder o; const char* A; const char* B; size_t tstep;
    DI bool next(int i, pg8::Unit& u) const { return o.next(i, u); }
    DI const char* abase(const pg8::Unit& u) const { return A + (size_t)u.pm * tstep; }
    DI const char* bbase(const pg8::Unit& u) const { return B + (size_t)u.pn * tstep; }
};
struct SchedBranch {
    pg8::StaticOrder o; const char* A; const char* B; size_t tstep, aslab;
    DI bool next(int i, pg8::Unit& u) const { pg8::Unit t; if (!o.next(i / 3, t)) return false; u.pm = t.pm; u.pn = t.pn + 4 * (i % 3); return true; }
    DI const char* abase(const pg8::Unit& u) const { return A + (size_t)(u.pn >> 2) * aslab + (size_t)u.pm * tstep; }
    DI const char* bbase(const pg8::Unit& u) const { return B + (size_t)u.pn * tstep; }
};
struct SchedMoe {
    pg8::StaticOrder o; const char* A; const char* B; unsigned eslab; const LAS int* texp;
    DI bool next(int i, pg8::Unit& u) const { return o.next(i, u); }
    DI const char* abase(const pg8::Unit& u) const { return A + (size_t)u.pm * (256u * 1024u); }
    DI const char* bbase(const pg8::Unit& u) const { return B + (size_t)((unsigned)texp[u.pm] * eslab) + (size_t)u.pn * (256u * 1024u); }
};

struct SchedMoeB {
    pg8::StaticOrder o; const char* A; const char* B; unsigned eslab; const LAS int* texp;
    DI bool next(int i, pg8::Unit& u) const { return o.next(i, u); }
    DI const char* abase(const pg8::Unit& u) const { return A + (size_t)u.pm * (256u * 2048u); }
    DI const char* bbase(const pg8::Unit& u) const { return B + (size_t)((unsigned)texp[u.pm] * eslab) + (size_t)u.pn * (256u * 2048u); }
};

#ifndef EPI_QT
#define EPI_QT 1
#endif
#ifndef EPI_QT_ST
#define EPI_QT_ST 1
#endif
DI int qt_src(int lane) { return (((lane >> 2) + 16 * (lane & 3)) * 4); }
DI f32x4 qt4f(int src4, f32x4 v);
DI u32x4 qt4(int src4, u32x4 w) { u32x4 r; r.x = (unsigned)__builtin_amdgcn_ds_bpermute(src4, (int)w.x); r.y = (unsigned)__builtin_amdgcn_ds_bpermute(src4, (int)w.y); r.z = (unsigned)__builtin_amdgcn_ds_bpermute(src4, (int)w.z); r.w = (unsigned)__builtin_amdgcn_ds_bpermute(src4, (int)w.w); return r; }
DI f32x4 qt4f(int src4, f32x4 v) { return __builtin_bit_cast(f32x4, qt4(src4, __builtin_bit_cast(u32x4, v))); }
struct EpiStoreBf16 {
    static constexpr bool PERM = true;
    bf16_t* O; int ldc; int coff = 0;
#ifdef PROBE_NOSTORE
    bool skip = false;
#endif
    DI void operator()(const f32x4 (&acc)[2][2][4][2], const pg8::Unit& u, int wr, int wc, int fr, int fq) const {
#if EPI_QT_ST
        const int lane = fr + 16 * fq, src4 = qt_src(lane); fr = lane >> 2; fq = lane & 3;
#endif
        const int row0 = u.pm * 256 + wr * 64 + fr, col0 = coff + u.pn * 256 + wc * 32 + 8 * fq;
#pragma unroll
        for (int ai = 0; ai < 2; ++ai)
#pragma unroll
            for (int m = 0; m < 4; ++m) { bf16_t* rowp = O + (size_t)(row0 + ai * 128 + m * 16) * ldc + col0;
#pragma unroll
                for (int bj = 0; bj < 2; ++bj) { const f32x4 v0 = acc[ai][bj][m][0], v1 = acc[ai][bj][m][1];
                    u32x4 w; w.x = pk2(v0[0], v0[1]); w.y = pk2(v0[2], v0[3]); w.z = pk2(v1[0], v1[1]); w.w = pk2(v1[2], v1[3]);
#if EPI_QT_ST
                    w = qt4(src4, w);
#endif
#ifdef PROBE_NOSTORE
                    if (skip) { asm volatile("" :: "v"(w.x), "v"(w.y), "v"(w.z), "v"(w.w)); } else
#endif
                    *(u32x4*)(rowp + bj * 128) = w; } }
    }
};
struct EpiStoreBf16N {
    static constexpr bool PERM = false;
    bf16_t* O; int ldc; int coff = 0;
#ifdef PROBE_NOSTORE
    bool skip = false;
#endif
    DI void operator()(const f32x4 (&acc)[2][2][4][2], const pg8::Unit& u, int wr, int wc, int fr, int fq) const {
#if EPI_QT
#if EPI_QT_ST
        const int lane = fr + 16 * fq, a_ = lane >> 2, b_ = lane & 3, src4 = (a_ + 16 * (((b_ & 1) << 1) | (b_ >> 1))) * 4;
        const int row0 = u.pm * 256 + wr * 64 + a_, col0 = coff + u.pn * 256 + wc * 32 + 8 * b_;
#else
        const int row0 = u.pm * 256 + wr * 64 + fr, col0 = coff + u.pn * 256 + wc * 32 + 8 * (((fq & 1) << 1) | (fq >> 1));
#endif
#pragma unroll
        for (int ai = 0; ai < 2; ++ai)
#pragma unroll
            for (int m = 0; m < 4; ++m) { bf16_t* rowp = O + (size_t)(row0 + ai * 128 + m * 16) * ldc + col0;
#pragma unroll
                for (int bj = 0; bj < 2; ++bj) { const f32x4 v0 = acc[ai][bj][m][0], v1 = acc[ai][bj][m][1];
                    unsigned x0 = pk2(v0[0], v0[1]), y0 = pk2(v0[2], v0[3]), x1 = pk2(v1[0], v1[1]), y1 = pk2(v1[2], v1[3]);
                    { const auto r = __builtin_amdgcn_permlane16_swap(x0, x1, false, false); x0 = r[0]; x1 = r[1]; }
                    { const auto r = __builtin_amdgcn_permlane16_swap(y0, y1, false, false); y0 = r[0]; y1 = r[1]; }
                    u32x4 w; w.x = x0; w.y = y0; w.z = x1; w.w = y1;
#if EPI_QT_ST
                    w = qt4(src4, w);
#endif
#ifdef PROBE_NOSTORE
                    if (skip) { asm volatile("" :: "v"(w.x), "v"(w.y), "v"(w.z), "v"(w.w)); } else
#endif
                    *(u32x4*)(rowp + bj * 128) = w; } }
#else
        const int row0 = u.pm * 256 + wr * 64 + fr, col0 = coff + u.pn * 256 + wc * 32 + 4 * fq;
#pragma unroll
        for (int ai = 0; ai < 2; ++ai)
#pragma unroll
            for (int m = 0; m < 4; ++m) { bf16_t* rowp = O + (size_t)(row0 + ai * 128 + m * 16) * ldc + col0;
#pragma unroll
                for (int bj = 0; bj < 2; ++bj)
#pragma unroll
                    for (int n = 0; n < 2; ++n) { const f32x4 v = acc[ai][bj][m][n]; u32x2 w; w.x = pk2(v[0], v[1]); w.y = pk2(v[2], v[3]);
#ifdef PROBE_NOSTORE
                        if (skip) { asm volatile("" :: "v"(w.x), "v"(w.y)); } else
#endif
                        *(u32x2*)(rowp + bj * 128 + n * 16) = w; } }
#endif
    }
};
struct EpiQaRope {
    static constexpr bool PERM = true;
    bf16_t* O; const float* rope;
    DI void operator()(const f32x4 (&acc)[2][2][4][2], const pg8::Unit& u, int wr, int wc, int fr, int fq) const {
        const int row0 = u.pm * 256 + wr * 64 + fr, col0 = u.pn * 256 + wc * 32 + 8 * fq;
#pragma unroll
        for (int ai = 0; ai < 2; ++ai)
#pragma unroll
            for (int m = 0; m < 4; ++m) { const int row = row0 + ai * 128 + m * 16; bf16_t* rowp = O + (size_t)row * 768 + col0;
#pragma unroll
                for (int bj = 0; bj < 2; ++bj) { f32x4 v0 = acc[ai][bj][m][0], v1 = acc[ai][bj][m][1];
                    const int c8 = col0 + bj * 128, p0 = c8 % 96;
                    if (p0 < 32) { const f32x4* cs = (const f32x4*)(rope + (size_t)row * 48 + p0); const f32x4 a = cs[0], b = cs[1];
                        const f32x4 r0 = {v0[0] * a[0] - v0[1] * a[1], v0[1] * a[0] + v0[0] * a[1], v0[2] * a[2] - v0[3] * a[3], v0[3] * a[2] + v0[2] * a[3]};
                        const f32x4 r1 = {v1[0] * b[0] - v1[1] * b[1], v1[1] * b[0] + v1[0] * b[1], v1[2] * b[2] - v1[3] * b[3], v1[3] * b[2] + v1[2] * b[3]};
                        v0 = r0; v1 = r1; }
                    u32x4 w; w.x = pk2(v0[0], v0[1]); w.y = pk2(v0[2], v0[3]); w.z = pk2(v1[0], v1[1]); w.w = pk2(v1[2], v1[3]);
                    *(u32x4*)(rowp + bj * 128) = w; } }
    }
};
struct EpiBranchGate {
    static constexpr bool PERM = true;
    bf16_t* MG; const bf16_t* P; const float* bgate;
    DI void operator()(const f32x4 (&acc)[2][2][4][2], const pg8::Unit& u, int wr, int wc, int fr, int fq) const {
#if EPI_QT
        const int lane = fr + 16 * fq, src4 = qt_src(lane); fr = lane >> 2; fq = lane & 3;
#endif
        const int n = u.pn >> 2, row0 = u.pm * 256 + wr * 64 + fr, colg = u.pn * 256 + wc * 32 + 8 * fq, col0 = colg - n * 1024;
        f32x4 bg[2][2];
#pragma unroll
        for (int bj = 0; bj < 2; ++bj) { bg[bj][0] = *(const f32x4*)(bgate + colg + bj * 128); bg[bj][1] = *(const f32x4*)(bgate + colg + bj * 128 + 4); }
        u32x4 gl[2][2][2], pv[2][2][2];
#define EBG_LOAD(slot, grp) do { _Pragma("unroll") for (int m2 = 0; m2 < 2; ++m2) _Pragma("unroll") for (int bj = 0; bj < 2; ++bj) { const size_t row = (size_t)(row0 + ((grp) >> 1) * 128 + (2 * ((grp) & 1) + m2) * 16); \
            gl[slot][m2][bj] = *(const u32x4*)(P + row * NP + colg + bj * 128); pv[slot][m2][bj] = (n > 0) ? *(const u32x4*)(MG + row * D_MODEL + col0 + bj * 128) : (u32x4){0u, 0u, 0u, 0u}; } } while (0)
        EBG_LOAD(0, 0);
#pragma unroll
        for (int grp = 0; grp < 4; ++grp) {
            const int slot = grp & 1, ai = grp >> 1, mh = grp & 1;
            if (grp + 1 < 4) { if (slot == 0) EBG_LOAD(1, grp + 1); else EBG_LOAD(0, grp + 1); }
            asm volatile("" ::: "memory");
#pragma unroll
            for (int m2 = 0; m2 < 2; ++m2)
#pragma unroll
                for (int bj = 0; bj < 2; ++bj) { const int m = 2 * mh + m2; const size_t row = (size_t)(row0 + ai * 128 + m * 16);
#if EPI_QT
                    const f32x4 v0 = qt4f(src4, acc[ai][bj][m][0]), v1 = qt4f(src4, acc[ai][bj][m][1]);
#else
                    const f32x4 v0 = acc[ai][bj][m][0], v1 = acc[ai][bj][m][1];
#endif
                    const u32x4 g = gl[slot][m2][bj], q = pv[slot][m2][bj];
                    float o[8];
                    o[0] = v0[0] * fast_sigmoid(bf_lo(g.x) + bg[bj][0][0]) + bf_lo(q.x); o[1] = v0[1] * fast_sigmoid(bf_hi(g.x) + bg[bj][0][1]) + bf_hi(q.x);
                    o[2] = v0[2] * fast_sigmoid(bf_lo(g.y) + bg[bj][0][2]) + bf_lo(q.y); o[3] = v0[3] * fast_sigmoid(bf_hi(g.y) + bg[bj][0][3]) + bf_hi(q.y);
                    o[4] = v1[0] * fast_sigmoid(bf_lo(g.z) + bg[bj][1][0]) + bf_lo(q.z); o[5] = v1[1] * fast_sigmoid(bf_hi(g.z) + bg[bj][1][1]) + bf_hi(q.z);
                    o[6] = v1[2] * fast_sigmoid(bf_lo(g.w) + bg[bj][1][2]) + bf_lo(q.w); o[7] = v1[3] * fast_sigmoid(bf_hi(g.w) + bg[bj][1][3]) + bf_hi(q.w);
                    u32x4 w; w.x = pk2(o[0], o[1]); w.y = pk2(o[2], o[3]); w.z = pk2(o[4], o[5]); w.w = pk2(o[6], o[7]);
                    *(u32x4*)(MG + row * D_MODEL + col0 + bj * 128) = w; }
        }
#undef EBG_LOAD
    }
};
struct EpiResidual {
    static constexpr bool PERM = false;
    const float* xin; float* xout; const float* gmod;
    DI void operator()(const f32x4 (&acc)[2][2][4][2], const pg8::Unit& u, int wr, int wc, int fr, int fq) const {
#if EPI_QT
        const int lane = fr + 16 * fq, src4 = qt_src(lane); fr = lane >> 2; fq = lane & 3;
#endif
        const int row0 = u.pm * 256 + wr * 64 + fr, col0 = u.pn * 256 + wc * 32 + 4 * fq;
        const float* gm = gmod + (size_t)(u.pm >> 3) * 6144 + col0;
        f32x4 gv[2][2];
#pragma unroll
        for (int bj = 0; bj < 2; ++bj)
#pragma unroll
            for (int n = 0; n < 2; ++n) gv[bj][n] = *(const f32x4*)(gm + bj * 128 + n * 16);
        f32x4 xv[2][2][2][2];
#define ERS_LOAD(slot, grp) do { _Pragma("unroll") for (int m2 = 0; m2 < 2; ++m2) { const size_t off = (size_t)(row0 + ((grp) >> 1) * 128 + (2 * ((grp) & 1) + m2) * 16) * D_MODEL + col0; \
            _Pragma("unroll") for (int bj = 0; bj < 2; ++bj) _Pragma("unroll") for (int n = 0; n < 2; ++n) xv[slot][m2][bj][n] = *(const f32x4*)(xin + off + bj * 128 + n * 16); } } while (0)
        ERS_LOAD(0, 0);
#pragma unroll
        for (int grp = 0; grp < 4; ++grp) {
            const int slot = grp & 1, ai = grp >> 1, mh = grp & 1;
            if (grp + 1 < 4) { if (slot == 0) ERS_LOAD(1, grp + 1); else ERS_LOAD(0, grp + 1); }
            asm volatile("" ::: "memory");
#pragma unroll
            for (int m2 = 0; m2 < 2; ++m2) { const size_t off = (size_t)(row0 + ai * 128 + (2 * mh + m2) * 16) * D_MODEL + col0;
#pragma unroll
                for (int bj = 0; bj < 2; ++bj)
#pragma unroll
                    for (int n = 0; n < 2; ++n) {
#if EPI_QT
                        const f32x4 av = qt4f(src4, acc[ai][bj][2 * mh + m2][n]);
#else
                        const f32x4 av = acc[ai][bj][2 * mh + m2][n];
#endif
                        *(f32x4*)(xout + off + bj * 128 + n * 16) = xv[slot][m2][bj][n] + gv[bj][n] * av; } }
        }
#undef ERS_LOAD
    }
};
struct EpiSwiglu {
    static constexpr bool PERM = false;
    bf16_t* ACT; const float* b1; const LAS int* texp;
    DI void operator()(const f32x4 (&acc)[2][2][4][2], const pg8::Unit& u, int wr, int wc, int fr, int fq) const {
        const int row0 = u.pm * 256 + wr * 64 + fr, e = texp[u.pm];
        const float* bb = b1 + (size_t)e * 2048;
#pragma unroll
        for (int bj = 0; bj < 2; ++bj) { const int j0 = u.pn * 128 + bj * 64 + wc * 16 + 4 * fq;
            const f32x4 ba = *(const f32x4*)(bb + 2 * j0), bc = *(const f32x4*)(bb + 2 * j0 + 4);
            const f32x4 bgt = {ba[0], ba[2], bc[0], bc[2]}, bup = {ba[1], ba[3], bc[1], bc[3]};
#pragma unroll
            for (int ai = 0; ai < 2; ++ai)
#pragma unroll
                for (int m = 0; m < 4; ++m) { const f32x4 g = acc[ai][bj][m][0] + bgt, up = acc[ai][bj][m][1] + bup; float o[4];
#pragma unroll
                    for (int i = 0; i < 4; ++i) { const float gg = fminf(g[i], 7.0f), uu = fminf(fmaxf(up[i], -7.0f), 7.0f);
                        o[i] = (uu + 1.0f) * gg * fast_sigmoid(1.702f * gg);
                    }
                    u32x2 w; w.x = pk2(o[0], o[1]); w.y = pk2(o[2], o[3]);
                    *(u32x2*)(ACT + (size_t)(row0 + ai * 128 + m * 16) * D_EXP + j0) = w; } }
    }
};
struct EpiSwiglu8 {
    static constexpr bool PERM = false;
    unsigned char* ACT; const float* b1; const LAS int* texp;
#ifdef PROBE_M1
    int skip = 0;
#endif
    DI void operator()(const f32x4 (&acc)[2][2][4][2], const pg8::Unit& u, int wr, int wc, int fr, int fq) const {
#ifdef PROBE_M1
        if (skip == 2) {
#pragma unroll
            for (int ai = 0; ai < 2; ++ai)
#pragma unroll
                for (int bj = 0; bj < 2; ++bj)
#pragma unroll
                    for (int m = 0; m < 4; ++m)
#pragma unroll
                        for (int n = 0; n < 2; ++n) asm volatile("" :: "v"(acc[ai][bj][m][n][0]), "v"(acc[ai][bj][m][n][1]), "v"(acc[ai][bj][m][n][2]), "v"(acc[ai][bj][m][n][3]));
            return; }
#endif
        const int row0 = u.pm * 256 + wr * 64 + fr, e = texp[u.pm];
        const float* bb = b1 + (size_t)e * 2048;
#pragma unroll
        for (int bj = 0; bj < 2; ++bj) { const int j0 = u.pn * 128 + bj * 64 + wc * 16 + 4 * fq;
            const f32x4 ba = *(const f32x4*)(bb + 2 * j0), bc = *(const f32x4*)(bb + 2 * j0 + 4);
            const f32x4 bgt = {ba[0], ba[2], bc[0], bc[2]}, bup = {ba[1], ba[3], bc[1], bc[3]};
#pragma unroll
            for (int ai = 0; ai < 2; ++ai) {
                unsigned w[4];
#pragma unroll
                for (int m = 0; m < 4; ++m) { const f32x4 g = acc[ai][bj][m][0] + bgt, up = acc[ai][bj][m][1] + bup; float o[4];
#pragma unroll
                    for (int i = 0; i < 4; ++i) { const float gg = fminf(g[i], 7.0f), uu = fminf(fmaxf(up[i], -7.0f), 7.0f);
                        o[i] = (uu + 1.0f) * gg * fast_sigmoid(1.702f * gg);
                    }
                    w[m] = pk4_fp8(o[0], o[1], o[2], o[3]); }
                { const auto r = __builtin_amdgcn_permlane16_swap(w[0], w[1], false, false); w[0] = r[0]; w[1] = r[1]; }
                { const auto r = __builtin_amdgcn_permlane16_swap(w[2], w[3], false, false); w[2] = r[0]; w[3] = r[1]; }
                { const auto r = __builtin_amdgcn_permlane32_swap(w[0], w[2], false, false); w[0] = r[0]; w[2] = r[1]; }
                { const auto r = __builtin_amdgcn_permlane32_swap(w[1], w[3], false, false); w[1] = r[0]; w[3] = r[1]; }
                u32x4 wv; wv.x = w[0]; wv.y = w[1]; wv.z = w[2]; wv.w = w[3];
#ifdef PROBE_M1
                if (skip == 1) { asm volatile("" :: "v"(wv.x), "v"(wv.y), "v"(wv.z), "v"(wv.w)); } else
#endif
                *(u32x4*)(ACT + (size_t)(row0 + ai * 128 + fq * 16) * D_EXP + (j0 - 4 * fq)) = wv; } }
    }
};
struct EpiMoeOut {
    static constexpr bool PERM = true;
    bf16_t* Y; const float* b2; const float* gate; const LAS int* texp;
    DI void operator()(const f32x4 (&acc)[2][2][4][2], const pg8::Unit& u, int wr, int wc, int fr, int fq) const {
        const int row0 = u.pm * 256 + wr * 64 + fr, col0 = u.pn * 256 + wc * 32 + 8 * fq, e = texp[u.pm];
        const float* bb = b2 + (size_t)e * D_MODEL + col0;
#if EPI_QT_ST
        const int lane = fr + 16 * fq, src4 = qt_src(lane), rowq = (lane >> 2) - fr, colq = 8 * ((lane & 3) - fq);
#endif
        f32x4 bv[2][2];
#pragma unroll
        for (int bj = 0; bj < 2; ++bj) { bv[bj][0] = *(const f32x4*)(bb + bj * 128); bv[bj][1] = *(const f32x4*)(bb + bj * 128 + 4); }
#pragma unroll
        for (int ai = 0; ai < 2; ++ai) {
            float gt[4];
#pragma unroll
            for (int m = 0; m < 4; ++m) gt[m] = gate[row0 + ai * 128 + m * 16];
            asm volatile("" ::: "memory");
#pragma unroll
            for (int m = 0; m < 4; ++m) { const int row = row0 + ai * 128 + m * 16; const float g = gt[m];
#pragma unroll
                for (int bj = 0; bj < 2; ++bj) { const f32x4 v0 = (acc[ai][bj][m][0] + bv[bj][0]) * g, v1 = (acc[ai][bj][m][1] + bv[bj][1]) * g;
                    u32x4 w; w.x = pk2(v0[0], v0[1]); w.y = pk2(v0[2], v0[3]); w.z = pk2(v1[0], v1[1]); w.w = pk2(v1[2], v1[3]);
#if EPI_QT_ST
                    *(u32x4*)(Y + (size_t)(row + rowq) * D_MODEL + col0 + colq + bj * 128) = qt4(src4, w); } }
#else
                    *(u32x4*)(Y + (size_t)row * D_MODEL + col0 + bj * 128) = w; } }
#endif
            asm volatile("" ::: "memory");
        }
    }
};

constexpr size_t MiB = 1u << 20;
constexpr size_t WS_CTL = 0, CTL_ZERO_BYTES = 1 * MiB;
constexpr size_t WS_MOD = 1 * MiB, WS_ROPE = 2 * MiB, WS_WIN = 8 * MiB, WS_WUQ = 33 * MiB, WS_WUKV = 34 * MiB, WS_WB = 35 * MiB, WS_WOUT = 41 * MiB, WS_W1 = 53 * MiB, WS_W2 = 309 * MiB,
                 WS_X1 = 437 * MiB, WS_H = 565 * MiB, WS_CQ = 629 * MiB, WS_CKV = 645 * MiB, WS_KPE = 661 * MiB, WS_QA = 663 * MiB, WS_KV = 711 * MiB, WS_O3 = 775 * MiB, WS_QC = 871 * MiB,
                 WS_KC = 903 * MiB, WS_VC = 907 * MiB, WS_QI = 911 * MiB, WS_KI = 943 * MiB, WS_IW = 947 * MiB, WS_ROUTE = 948 * MiB, WS_P = 952 * MiB, WS_GY = 1352 * MiB, WS_END = 1544 * MiB;
constexpr size_t WS_HG8 = WS_QA;
constexpr size_t WS_XB = WS_P, WS_ACT = WS_P + 272 * MiB, WS_Y = WS_P, WS_H8 = WS_H;
constexpr size_t RT_TOPE = 0, RT_TOPG = 512 * 1024, RT_RANK = 1 * MiB, RT_SLOTOF = 1 * MiB + 512 * 1024, RT_TOKOF = 2 * MiB, RT_GATEOF = 3 * MiB;
static_assert((size_t)NSLOT_MAX * 1024 * 2 <= 272 * MiB && WS_ACT + 272 * MiB <= WS_END, "MoE overlay: XB (fp8) and Y (bf16) share [P, P+272M) (XB is dead when Y is written); ACT in [P+272M, P+544M)");
static_assert((size_t)T_TOK * NP * 2 == 400 * MiB, "P size");
constexpr int CW_BAR = 4096, CW_CNT = 16384;
constexpr int LDS_BYTES = 163840, LDS_X = 131072, MISC_OFF = LDS_BYTES - 512;

struct Frame {
    LAS unsigned char* lds; int tid, lane, wave, G, bid; float zf;
    float* out; unsigned char* ws; unsigned* ctl;
};
extern __shared__ __attribute__((aligned(16))) unsigned char lds_raw[];
typedef __attribute__((address_space(4))) const char* kptr_t;
DI const void* kin(int i) {
#if defined(__HIP_DEVICE_COMPILE__)
    kptr_t ka = (kptr_t)__builtin_amdgcn_kernarg_segment_ptr(); asm volatile("" : "+s"(ka)); return (const void*)(GAS const void*)*(__attribute__((address_space(4))) const unsigned long long*)(ka + 8 * i);
#else
    (void)i; return nullptr;
#endif
}
#define KIN_x ((const float*)kin(0))
#define KIN_c ((const float*)kin(1))
#define KIN_pos ((const int*)kin(2))
#define KIN_norm1_g ((const float*)kin(3))
#define KIN_norm2_g ((const float*)kin(4))
#define KIN_w_ada ((const float*)kin(5))
#define KIN_b_ada ((const float*)kin(6))
#define KIN_w_in ((const float*)kin(7))
#define KIN_b_gate ((const float*)kin(8))
#define KIN_q_norm ((const float*)kin(9))
#define KIN_w_uq ((const float*)kin(10))
#define KIN_kv_norm ((const float*)kin(11))
#define KIN_w_ukv ((const float*)kin(12))
#define KIN_conv_w ((const float*)kin(13))
#define KIN_w_branch ((const float*)kin(14))
#define KIN_w_out ((const float*)kin(15))
#define KIN_router_w ((const float*)kin(16))
#define KIN_router_b ((const float*)kin(17))
#define KIN_w1 ((const float*)kin(18))
#define KIN_b1 ((const float*)kin(19))
#define KIN_w2 ((const float*)kin(20))
#define KIN_b2 ((const float*)kin(21))
#define KIN_final_g ((const float*)kin(22))
DI Frame make_frame(int wave0) {
    Frame F; unsigned z_ = 0u; asm volatile("" : "+v"(z_));
    F.lds = (LAS unsigned char*)lds_raw; F.lane = (int)__builtin_amdgcn_mbcnt_hi(~0u, __builtin_amdgcn_mbcnt_lo(~0u, z_)); F.wave = wave0; F.tid = wave0 * 64 + F.lane; F.G = gridDim.x; F.bid = blockIdx.x; F.zf = __uint_as_float(z_);
    F.out = (float*)kin(23); F.ws = (unsigned char*)kin(24); F.ctl = (unsigned*)F.ws;
    return F;
}
#define WSP(T, off) ((T*)(F.ws + (off)))
#ifndef STAG_MODE
#define STAG_MODE 1
#endif
#ifndef STAG_SCALE
#define STAG_SCALE 100
#endif
DI void stagger(const Frame& F, int spread_us) {
#if STAG_MODE == 0
    const unsigned ticks = (unsigned)(spread_us * STAG_SCALE) * (unsigned)F.bid / (unsigned)F.G;
#elif STAG_MODE == 1
    const unsigned ticks = (unsigned)(spread_us * STAG_SCALE) * (unsigned)(F.bid & 7) / 8u;
#else
    const unsigned ticks = (unsigned)(spread_us * STAG_SCALE) * (unsigned)((F.bid >> 3) & 3) / 4u;
#endif
    if (ticks == 0u) return;
    const unsigned long long t0 = __builtin_amdgcn_s_memrealtime();
    while ((unsigned)(__builtin_amdgcn_s_memrealtime() - t0) < ticks) __builtin_amdgcn_s_sleep(8);
}


#define XB_TMO      128
#define XB_XCNT(j)  (256  + 64 * (j))
#define XB_XSUB(j)  (1280 + 64 * (j))
#define XB_XGEN(j)  (2304 + 64 * (j))
#define XB_TOP      3328
#define XB_TOPGEN   3392
#define XCD_BAR_WORDS 3456
#define XB_SPIN_CAP (1u << 18)
DI unsigned xb_ld(unsigned* p)              { return __hip_atomic_load(p, __ATOMIC_RELAXED, __HIP_MEMORY_SCOPE_AGENT); }
DI unsigned xb_add(unsigned* p, unsigned v) { return __hip_atomic_fetch_add(p, v, __ATOMIC_RELAXED, __HIP_MEMORY_SCOPE_AGENT); }
DI unsigned xb_xcc_id() { return (unsigned)__builtin_amdgcn_s_getreg((3 << 11) | 20) & 0xFu; }
#define XB_SPIN(cond, bar) do { unsigned _sp = 0; while (cond) { __builtin_amdgcn_s_sleep(1); \
    if ((++_sp & 255u) == 0u) { if (xb_ld(&(bar)[XB_TMO])) break; if (_sp > XB_SPIN_CAP) { atomicAdd(&(bar)[XB_TMO], 1u); break; } } } } while (0)
struct XcdBarrier { unsigned* bar; unsigned x; volatile LAS unsigned* st; };
DI XcdBarrier xcd_barrier_post(unsigned* bar, volatile LAS unsigned* st, int tid) {
    XcdBarrier b; b.bar = bar; b.x = xb_xcc_id(); b.st = st;
    if (tid == 0) (void)xb_add(&bar[XB_XCNT(b.x)], 1u);
    return b;
}
DI void xcd_barrier_complete(unsigned* bar, unsigned x, unsigned& nloc, unsigned& nx) {
    const unsigned G = gridDim.x * gridDim.y * gridDim.z;
    unsigned sum, cnt, mine, sp = 0u;
    for (;;) {
        sum = 0u; cnt = 0u; mine = 0u;
#pragma unroll
        for (unsigned j = 0; j < 16; ++j) { const unsigned c = xb_ld(&bar[XB_XCNT(j)]); sum += c; cnt += (c > 0u) ? 1u : 0u; mine = (j == x) ? c : mine; }
        if (sum == G) break;
        __builtin_amdgcn_s_sleep(1);
        if ((++sp & 255u) == 0u) { if (xb_ld(&bar[XB_TMO])) break; if (sp > XB_SPIN_CAP) { atomicAdd(&bar[XB_TMO], 1u); break; } }
    }
    nloc = mine > 0u ? mine : 1u; nx = cnt > 0u ? cnt : 1u;
}
DI void xcd_barrier(const XcdBarrier& b, int tid) {
    asm volatile("s_waitcnt vmcnt(0)" ::: "memory");
    __syncthreads();
    if (tid == 0) {
        unsigned* bar = b.bar;
        __builtin_amdgcn_s_waitcnt(0);
        unsigned nloc = b.st[0], nx = b.st[1];
        if (nloc == 0u) { xcd_barrier_complete(bar, b.x, nloc, nx); b.st[0] = nloc; b.st[1] = nx; }
        const unsigned old = xb_add(&bar[XB_XSUB(b.x)], 1u);
        const unsigned gen = old / nloc;
        if (old + 1u == (gen + 1u) * nloc) {
            __builtin_amdgcn_fence(__ATOMIC_RELEASE, "agent");
            asm volatile("s_waitcnt vmcnt(0)" ::: "memory");
            const unsigned og = xb_add(&bar[XB_TOP], 1u);
            const unsigned tg = og / nx;
            if (og + 1u == (tg + 1u) * nx) xb_add(&bar[XB_TOPGEN], 1u);
            else XB_SPIN(xb_ld(&bar[XB_TOPGEN]) == tg, bar);
            __builtin_amdgcn_fence(__ATOMIC_ACQUIRE, "agent");
            xb_add(&bar[XB_XGEN(b.x)], 1u);
            asm volatile("s_waitcnt vmcnt(0)" ::: "memory");
        } else {
            XB_SPIN(xb_ld(&bar[XB_XGEN(b.x)]) == gen, bar);
            __builtin_amdgcn_fence(__ATOMIC_ACQUIRE, "agent");
            asm volatile("s_waitcnt vmcnt(0)" ::: "memory");
        }
    }
    __syncthreads();
}

#ifndef G1_F8_COLS
#define G1_F8_COLS 3072
#endif
DI int rope_perm(int p, int half) { return (p < 2 * half) ? (p >> 1) + half * (p & 1) : p; }
DI int cmap_in(int r) {
    if (r < PC_CONV) return OC_GATE + r;
    if (r < PC_DQ) return OC_CONV + (r - PC_CONV);
    if (r < PC_IQ) { const int j = r - PC_DQ; return OC_DQ + (j & ~63) + rope_perm(j & 63, 8); }
    if (r < PC_QLAT) { const int j = r - PC_IQ; return OC_IQ + (j & ~63) + rope_perm(j & 63, 8); }
    if (r < PC_KVLAT) return OC_QLAT + (r - PC_QLAT);
    if (r < PC_DKV) { const int j = r - PC_KVLAT; return j < 128 ? OC_KVLAT + j : OC_KVLAT + 128 + rope_perm(j - 128, 16); }
    if (r < PC_IK) { const int j = r - PC_DKV; return j < 64 ? OC_DKV + rope_perm(j, 8) : OC_DKV + j; }
    if (r < PC_IW) return OC_IK + rope_perm(r - PC_IK, 8);
    if (r < IN_COLS) return OC_IW + (r - PC_IW);
    return -1;
}
DI int cmap_uq(int r) { const int h = r / 96, p = r % 96; return h * 96 + rope_perm(p, 16); }
DI int cmap_w1(int R) { const int pn = R >> 8, rem = R & 255, bj = rem >> 7, wc = (rem >> 5) & 3, n = (rem >> 4) & 1, f = rem & 15; return 2 * (pn * 128 + bj * 64 + wc * 16 + f) + n; }
DI void transpose_item(const float* W, int K, int N, bf16_t* WT, int ldk, int koff, LAS float* scr, int k0, int n0, int csrc, int lane) {
#pragma unroll 8
    for (int i = 0; i < 32; ++i) { const int kk = 2 * i + (lane >> 5); float v = 0.f; if (csrc >= 0 && k0 + kk < K) v = W[(size_t)(k0 + kk) * N + csrc]; scr[kk * 33 + (lane & 31)] = v; }
    LDS_WAIT(); asm volatile("" ::: "memory");
    const int c = lane & 7;
#pragma unroll
    for (int j = 0; j < 4; ++j) { const int n = (lane >> 3) + 8 * j; const LAS float* s = scr + (8 * c) * 33 + n;
        u32x4 o; o.x = pk2(s[0 * 33], s[1 * 33]); o.y = pk2(s[2 * 33], s[3 * 33]); o.z = pk2(s[4 * 33], s[5 * 33]); o.w = pk2(s[6 * 33], s[7 * 33]);
        *(u32x4*)(WT + (size_t)(n0 + n) * ldk + koff + k0 + 8 * c) = o; }
    LDS_WAIT(); asm volatile("" ::: "memory");
}
DI void transpose_item_f8(const float* W, int K, int N, unsigned char* WT, int ldk, LAS float* scr, int k0, int n0, int csrc, int lane, float qs) {
#pragma unroll 8
    for (int i = 0; i < 32; ++i) { const int kk = 2 * i + (lane >> 5); scr[kk * 33 + (lane & 31)] = W[(size_t)(k0 + kk) * N + csrc] * qs; }
    LDS_WAIT(); asm volatile("" ::: "memory");
    const int c = lane & 7;
#pragma unroll
    for (int j = 0; j < 4; ++j) { const int n = (lane >> 3) + 8 * j; const LAS float* s = scr + (8 * c) * 33 + n;
        u32x2 o; o.x = pk4_fp8(s[0 * 33], s[1 * 33], s[2 * 33], s[3 * 33]); o.y = pk4_fp8(s[4 * 33], s[5 * 33], s[6 * 33], s[7 * 33]);
        *(u32x2*)(WT + (size_t)(n0 + n) * ldk + k0 + 8 * c) = o; }
    LDS_WAIT(); asm volatile("" ::: "memory");
}
DI void titem_load(const float* W, int N, int k0, int csrc, int lane, float (&v)[32]) {
#pragma unroll
    for (int i = 0; i < 32; ++i) v[i] = W[(size_t)(k0 + 2 * i + (lane >> 5)) * N + csrc];
}
DI void titem_store_f8(const float (&v)[32], unsigned char* WT, int ldk, LAS float* scr, int k0, int n0, int lane, float qs) {
#pragma unroll
    for (int i = 0; i < 32; ++i) scr[(2 * i + (lane >> 5)) * 33 + (lane & 31)] = v[i] * qs;
    LDS_WAIT(); asm volatile("" ::: "memory");
    const int c = lane & 7;
#pragma unroll
    for (int j = 0; j < 4; ++j) { const int n = (lane >> 3) + 8 * j; const LAS float* s = scr + (8 * c) * 33 + n;
        u32x2 o; o.x = pk4_fp8(s[0 * 33], s[1 * 33], s[2 * 33], s[3 * 33]); o.y = pk4_fp8(s[4 * 33], s[5 * 33], s[6 * 33], s[7 * 33]);
        *(u32x2*)(WT + (size_t)(n0 + n) * ldk + k0 + 8 * c) = o; }
    LDS_WAIT(); asm volatile("" ::: "memory");
}
template <bool W1>
DI void convert_family_f8(const float* src, unsigned char* dst, int N, int nmat, LAS float* scr, int gw, int NGW, int lane) {
    const int nbn = N / 32, ipm = 16 * nbn, total = nmat * ipm;
    float va[32], vb[32];
#define TF_DECODE(it, j_, k0_, n0_, cs_) const int j_ = (it) / ipm, q_##j_ = (it) % ipm, k0_ = 64 * (q_##j_ / nbn), n0_ = 32 * (q_##j_ % nbn), cs_ = W1 ? cmap_w1(n0_ + (lane & 31)) : n0_ + (lane & 31)
    int it = gw;
    if (it < total) { TF_DECODE(it, j0, k00, n00, cs0); titem_load(src + (size_t)j0 * 1024 * N, N, k00, cs0, lane, va); }
    while (it < total) {
        const int it2 = it + NGW;
        if (it2 < total) { TF_DECODE(it2, j2, k02, n02, cs2); titem_load(src + (size_t)j2 * 1024 * N, N, k02, cs2, lane, vb); }
        { TF_DECODE(it, j1, k01, n01, cs1); (void)cs1; titem_store_f8(va, dst + (size_t)j1 * N * 1024, 1024, scr, k01, n01, lane, 64.0f); }
        const int it3 = it2 + NGW;
        if (it3 < total) { TF_DECODE(it3, j3, k03, n03, cs3); titem_load(src + (size_t)j3 * 1024 * N, N, k03, cs3, lane, va); }
        if (it2 < total) { TF_DECODE(it2, j4, k04, n04, cs4); (void)cs4; titem_store_f8(vb, dst + (size_t)j4 * N * 1024, 1024, scr, k04, n04, lane, 64.0f); }
        it = it3;
    }
#undef TF_DECODE
}
DI void sincos_d(double x, float& s, float& c) {
    const double kd = __builtin_rint(x * 0.6366197723675814); const int k = (int)kd;
    double r = __builtin_fma(-kd, 1.5707963267948966, x); r = __builtin_fma(-kd, 6.123233995736766e-17, r);
    const double r2 = r * r;
    const double sp = r * (1.0 + r2 * (-1.0 / 6 + r2 * (1.0 / 120 + r2 * (-1.0 / 5040 + r2 * (1.0 / 362880 + r2 * (-1.0 / 39916800 + r2 * (1.0 / 6227020800.0)))))));
    const double cp = 1.0 + r2 * (-0.5 + r2 * (1.0 / 24 + r2 * (-1.0 / 720 + r2 * (1.0 / 40320 + r2 * (-1.0 / 3628800 + r2 * (1.0 / 479001600.0 + r2 * (-1.0 / 87178291200.0)))))));
    const int q = k & 3;
    const double ss = (q == 0) ? sp : (q == 1) ? cp : (q == 2) ? -sp : -cp;
    const double cc = (q == 0) ? cp : (q == 1) ? -sp : (q == 2) ? -cp : sp;
    s = (float)ss; c = (float)cc;
}
DI void phase_prologue(const Frame& F) {
    const int tid = F.tid, lane = F.lane, wave = F.wave;
    __syncthreads();
    const float* in_c = KIN_c; const float* in_wada = KIN_w_ada; const float* in_bada = KIN_b_ada; const int* in_pos = KIN_pos;
    if (F.bid < 192) {
        LAS float* cact = (LAS float*)F.lds;
        LAS float* red = (LAS float*)(F.lds + 65536);
        for (int idx = tid; idx < 16 * 1024; idx += 512) { const int b = idx >> 10, k = idx & 1023; const float cv = in_c[idx]; cact[k * 16 + b] = cv * fast_sigmoid(cv); }
        __syncthreads();
        float* MOD = WSP(float, WS_MOD);
        for (int it = F.bid; it < 192; it += F.G) {
            const int l = it / 96, cb = it % 96, col = cb * 64 + lane;
            float acc[16];
#pragma unroll
            for (int b = 0; b < 16; ++b) acc[b] = 0.f;
            const float* wp = in_wada + ((size_t)l * 1024 + wave * 128) * 6144 + col;
#pragma unroll 4
            for (int kk = 0; kk < 128; ++kk) { const float wv = wp[(size_t)kk * 6144]; const LAS f32x4* cp = (const LAS f32x4*)(cact + (wave * 128 + kk) * 16);
#pragma unroll
                for (int q = 0; q < 4; ++q) { const f32x4 cv = cp[q]; acc[4 * q] += cv[0] * wv; acc[4 * q + 1] += cv[1] * wv; acc[4 * q + 2] += cv[2] * wv; acc[4 * q + 3] += cv[3] * wv; } }
#pragma unroll
            for (int b = 0; b < 16; ++b) red[(wave * 16 + b) * 64 + lane] = acc[b];
            __syncthreads();
            for (int o = tid; o < 1024; o += 512) { const int b = o >> 6, ln = o & 63; float s = in_bada[l * 6144 + cb * 64 + ln];
#pragma unroll
                for (int w = 0; w < 8; ++w) s += red[(w * 16 + b) * 64 + ln];
                MOD[((size_t)l * 16 + b) * 6144 + cb * 64 + ln] = s; }
            __syncthreads();
        }
    }
    __syncthreads();
    {
        float* ROPE = WSP(float, WS_ROPE);
        const double r16 = 0.44036660267178046;
        for (int idx = F.bid * 512 + tid; idx < T_TOK * 24; idx += F.G * 512) {
            const int t = idx / 24, i = idx % 24; const int e = (i < 16) ? i : 2 * (i - 16);
            double f = 1.0; for (int j = 0; j < e; ++j) f *= r16;
            float s, c; sincos_d((double)in_pos[t] * f, s, c);
            ROPE[(size_t)t * 48 + 2 * i] = c; ROPE[(size_t)t * 48 + 2 * i + 1] = s;
        }
    }
    {
        LAS float* scr = (LAS float*)(F.lds + wave * 16384);
        const int gw = F.bid * 8 + wave, NGW = F.G * 8;
        constexpr int I_IN = 16 * 200, I_UQ = 4 * 24, I_UKV = 4 * 32, I_WB = 8 * 32, I_WO = 16 * 32, I_W1 = 16 * 64, I_W2 = 16 * 32;
        constexpr int N_IN = 2 * I_IN, N_UQ = 2 * I_UQ, N_UKV = 2 * I_UKV, N_WB = 6 * I_WB, N_WO = 2 * I_WO, N_W1 = 64 * I_W1, N_W2 = 64 * I_W2;
        constexpr int NITEMS = N_IN + N_UQ + N_UKV + N_WB + N_WO;
        (void)N_W1; (void)N_W2;
        for (int it = gw; it < NITEMS; it += NGW) {
            int r = it;
            if (r < N_IN) { const int l = r / I_IN, q = r % I_IN, kb = q / 200, nb = q % 200;
                if (32 * nb < G1_F8_COLS) transpose_item_f8(KIN_w_in + (size_t)l * 1024 * IN_COLS, 1024, IN_COLS, WSP(unsigned char, WS_WIN) + (size_t)l * NP * 2048, 1024, scr, 64 * kb, 32 * nb, cmap_in(32 * nb + (lane & 31)), lane, 64.0f);
                else transpose_item(KIN_w_in + (size_t)l * 1024 * IN_COLS, 1024, IN_COLS, WSP(bf16_t, WS_WIN) + (size_t)l * NP * 1024, 1024, 0, scr, 64 * kb, 32 * nb, cmap_in(32 * nb + (lane & 31)), lane);
                continue; } r -= N_IN;
            if (r < N_UQ) { const int l = r / I_UQ, q = r % I_UQ, kb = q / 24, nb = q % 24;
                transpose_item(KIN_w_uq + (size_t)l * 256 * 768, 256, 768, WSP(bf16_t, WS_WUQ) + (size_t)l * 768 * 256, 256, 0, scr, 64 * kb, 32 * nb, cmap_uq(32 * nb + (lane & 31)), lane); continue; } r -= N_UQ;
            if (r < N_UKV) { const int l = r / I_UKV, q = r % I_UKV, kb = q / 32, nb = q % 32;
                transpose_item(KIN_w_ukv + (size_t)l * 128 * 1024, 128, 1024, WSP(bf16_t, WS_WUKV) + (size_t)l * 1024 * 256, 256, 0, scr, 64 * kb, 32 * nb, 32 * nb + (lane & 31), lane); continue; } r -= N_UKV;
            if (r < N_WB) { const int j = r / I_WB, q = r % I_WB, kb = q / 32, nb = q % 32;
                transpose_item(KIN_w_branch + (size_t)j * 512 * 1024, 512, 1024, WSP(bf16_t, WS_WB) + (size_t)j * 1024 * 512, 512, 0, scr, 64 * kb, 32 * nb, 32 * nb + (lane & 31), lane); continue; } r -= N_WB;
            if (r < N_WO) { const int l = r / I_WO, q = r % I_WO, kb = q / 32, nb = q % 32;
                transpose_item(KIN_w_out + (size_t)l * 1024 * 1024, 1024, 1024, WSP(bf16_t, WS_WOUT) + (size_t)l * 1024 * 1024, 1024, 0, scr, 64 * kb, 32 * nb, 32 * nb + (lane & 31), lane); continue; } r -= N_WO;
            (void)r;
        }
        convert_family_f8<true>(KIN_w1, WSP(unsigned char, WS_W1), 2048, 64, scr, gw, NGW, lane);
#if M2_F8
        convert_family_f8<false>(KIN_w2, WSP(unsigned char, WS_W2), 1024, 64, scr, gw, NGW, lane);
#else
        for (int it = gw; it < 64 * I_W2; it += NGW) { const int j = it / I_W2, q = it % I_W2, kb = q / 32, nb = q % 32;
            transpose_item(KIN_w2 + (size_t)j * 1024 * 1024, 1024, 1024, WSP(bf16_t, WS_W2) + (size_t)j * 1024 * 1024, 1024, 0, scr, 64 * kb, 32 * nb, 32 * nb + (lane & 31), lane); }
#endif
    }
}

DI void phase_norm(const Frame& F, const float* xin, float* xout, bool combine, bool write_x, bool final_, int lnext, int lcomb) {
    const int lane = F.lane, gw = F.bid * 8 + F.wave, NGW = F.G * 8;
    const float* in_fg = KIN_final_g; const float* in_n1 = KIN_norm1_g;
    const float* MOD = WSP(float, WS_MOD); const bf16_t* Y = WSP(bf16_t, WS_Y); const int* SLOTOF = (const int*)(F.ws + WS_ROUTE + RT_SLOTOF); bf16_t* H = WSP(bf16_t, WS_H);
    u32x4 slots = {0u, 0u, 0u, 0u};
    if (combine && gw < T_TOK) slots = *(const u32x4*)(SLOTOF + (size_t)gw * 4);
    for (int t = gw; t < T_TOK; t += NGW) {
        const int b = t >> 11; f32x4 v[4];
#pragma unroll
        for (int i = 0; i < 4; ++i) v[i] = *(const f32x4*)(xin + (size_t)t * 1024 + 4 * lane + 256 * i);
        if (combine) {
            const unsigned s0 = slots.x, s1 = slots.y, s2 = slots.z, s3 = slots.w;
            u32x2 ya[4], yb[4], yc[4], yd[4];
#pragma unroll
            for (int i = 0; i < 4; ++i) { const int co = 4 * lane + 256 * i;
                ya[i] = *(const u32x2*)(Y + (size_t)s0 * 1024 + co); yb[i] = *(const u32x2*)(Y + (size_t)s1 * 1024 + co); yc[i] = *(const u32x2*)(Y + (size_t)s2 * 1024 + co); yd[i] = *(const u32x2*)(Y + (size_t)s3 * 1024 + co); }
            if (t + NGW < T_TOK) slots = *(const u32x4*)(SLOTOF + (size_t)(t + NGW) * 4);
            const float* g2 = MOD + ((size_t)lcomb * 16 + b) * 6144 + 5 * 1024;
#pragma unroll
            for (int i = 0; i < 4; ++i) { const int co = 4 * lane + 256 * i; const u32x2 a = ya[i], bq = yb[i], cq = yc[i], dq = yd[i];
                f32x4 sum = {bf_lo(a.x) + bf_lo(bq.x) + bf_lo(cq.x) + bf_lo(dq.x), bf_hi(a.x) + bf_hi(bq.x) + bf_hi(cq.x) + bf_hi(dq.x),
                             bf_lo(a.y) + bf_lo(bq.y) + bf_lo(cq.y) + bf_lo(dq.y), bf_hi(a.y) + bf_hi(bq.y) + bf_hi(cq.y) + bf_hi(dq.y)};
                v[i] += *(const f32x4*)(g2 + co) * sum; }
            if (write_x) {
#pragma unroll
                for (int i = 0; i < 4; ++i) *(f32x4*)(xout + (size_t)t * 1024 + 4 * lane + 256 * i) = v[i]; }
        }
        float ss = 0.f;
#pragma unroll
        for (int i = 0; i < 4; ++i) ss += (v[i][0] * v[i][0] + v[i][1] * v[i][1]) + (v[i][2] * v[i][2] + v[i][3] * v[i][3]);
        ss = wave_sum(ss); const float r = 1.0f / sqrtf(ss * (1.0f / 1024.0f) + NORM_EPS);
        if (final_) {
#pragma unroll
            for (int i = 0; i < 4; ++i) { const int co = 4 * lane + 256 * i; *(f32x4*)(F.out + (size_t)t * 1024 + co) = v[i] * r * *(const f32x4*)(in_fg + co); }
        } else {
            const float* md = MOD + ((size_t)lnext * 16 + b) * 6144;
#pragma unroll
            for (int i = 0; i < 4; ++i) { const int co = 4 * lane + 256 * i;
                const f32x4 g = *(const f32x4*)(in_n1 + lnext * 1024 + co), sc = *(const f32x4*)(md + 1024 + co), sh = *(const f32x4*)(md + co);
                f32x4 h = v[i] * r * g * (sc + 1.0f) + sh;
                u32x2 w; w.x = pk2(h[0], h[1]); w.y = pk2(h[2], h[3]);
                *(u32x2*)(H + (size_t)t * 1024 + co) = w;
                *(unsigned*)(WSP(unsigned char, WS_HG8) + (size_t)t * 1024 + co) = pk4_fp8(h[0], h[1], h[2], h[3]);
                }
        }
    }
}
DI u32x4 rope8v(u32x4 a, f32x4 c0, f32x4 c1) {
    u32x4 o;
    { const float x1 = bf_lo(a.x), x2 = bf_hi(a.x); o.x = pk2(x1 * c0[0] - x2 * c0[1], x2 * c0[0] + x1 * c0[1]); }
    { const float x1 = bf_lo(a.y), x2 = bf_hi(a.y); o.y = pk2(x1 * c0[2] - x2 * c0[3], x2 * c0[2] + x1 * c0[3]); }
    { const float x1 = bf_lo(a.z), x2 = bf_hi(a.z); o.z = pk2(x1 * c1[0] - x2 * c1[1], x2 * c1[0] + x1 * c1[1]); }
    { const float x1 = bf_lo(a.w), x2 = bf_hi(a.w); o.w = pk2(x1 * c1[2] - x2 * c1[3], x2 * c1[2] + x1 * c1[3]); }
    return o;
}
DI u32x4 rope8(u32x4 a, const float* cs) { return rope8v(a, *(const f32x4*)cs, *(const f32x4*)(cs + 4)); }
DI void unpack8(u32x4 a, float (&v)[8]) { v[0] = bf_lo(a.x); v[1] = bf_hi(a.x); v[2] = bf_lo(a.y); v[3] = bf_hi(a.y); v[4] = bf_lo(a.z); v[5] = bf_hi(a.z); v[6] = bf_lo(a.w); v[7] = bf_hi(a.w); }
DI void phase_post(const Frame& F, int l) {
    const int lane = F.lane, gw = F.bid * 8 + F.wave, NGW = F.G * 8;
    const bf16_t* P = WSP(bf16_t, WS_P); const float* ROPE = WSP(float, WS_ROPE);
    bf16_t *CQ = WSP(bf16_t, WS_CQ), *CKV = WSP(bf16_t, WS_CKV), *KPE = WSP(bf16_t, WS_KPE), *OB = WSP(bf16_t, WS_O3) + (size_t)T_TOK * 512, *QC = WSP(bf16_t, WS_QC), *KC = WSP(bf16_t, WS_KC),
           *VC = WSP(bf16_t, WS_VC), *QI = WSP(bf16_t, WS_QI), *KI = WSP(bf16_t, WS_KI); float* IW = WSP(float, WS_IW);
    const float* cw = KIN_conv_w + (size_t)l * 3 * 512 + 8 * lane;
    f32x4 cwv[3][2];
#pragma unroll
    for (int d = 0; d < 3; ++d) { cwv[d][0] = *(const f32x4*)(cw + d * 512); cwv[d][1] = *(const f32x4*)(cw + d * 512 + 4); }
    const float* in_qn = KIN_q_norm + l * 256 + 8 * (lane & 31); const float* in_kn = KIN_kv_norm + l * 128 + 8 * (lane & 15);
    const f32x4 qn0 = *(const f32x4*)in_qn, qn1 = *(const f32x4*)(in_qn + 4), kn0 = *(const f32x4*)in_kn, kn1 = *(const f32x4*)(in_kn + 4);
    const u32x4 z4 = {0u, 0u, 0u, 0u};
    for (int t = gw; t < T_TOK; t += NGW) {
        const bf16_t* pr = P + (size_t)t * NP; const float* rp = ROPE + (size_t)t * 48; const int s = t & (SEQ - 1);
        const bf16_t* pc = pr + PC_CONV + 8 * lane;
        const u32x4 gbw = *(const u32x4*)pc;
        const u32x4 gc2 = *(const u32x4*)(pc + 512), hc2 = *(const u32x4*)(pc + 1024);
        const u32x4 gc1 = (s >= 1) ? *(const u32x4*)(pc - NP + 512) : z4, hc1 = (s >= 1) ? *(const u32x4*)(pc - NP + 1024) : z4;
        const u32x4 gc0 = (s >= 2) ? *(const u32x4*)(pc - 2 * NP + 512) : z4, hc0 = (s >= 2) ? *(const u32x4*)(pc - 2 * NP + 1024) : z4;
        u32x4 dqw = *(const u32x4*)(pr + PC_DQ + 8 * lane), iqw = *(const u32x4*)(pr + PC_IQ + 8 * lane);
        const u32x4 qlw = *(const u32x4*)(pr + PC_QLAT + 8 * (lane & 31));
        const u32x4 kvw = *(const u32x4*)(pr + PC_KVLAT + 8 * (lane < 20 ? lane : 0));
        u32x4 dkw = *(const u32x4*)(pr + PC_DKV + 8 * (lane & 15));
        u32x4 ikw = *(const u32x4*)(pr + PC_IK + 8 * (lane & 7));
        const u32x4 iww = *(const u32x4*)(pr + PC_IW);
        const f32x4 r16a = *(const f32x4*)(rp + 32 + 8 * (lane & 1)), r16b = *(const f32x4*)(rp + 32 + 8 * (lane & 1) + 4);
        const f32x4 r32a = *(const f32x4*)(rp + 8 * (lane & 3)), r32b = *(const f32x4*)(rp + 8 * (lane & 3) + 4);
        asm volatile("" ::: "memory");
        {
            float gb[8], a0[8], b0[8], a1[8], b1[8], a2[8], b2[8]; unpack8(gbw, gb); unpack8(gc0, a0); unpack8(hc0, b0); unpack8(gc1, a1); unpack8(hc1, b1); unpack8(gc2, a2); unpack8(hc2, b2);
            float o[8];
#pragma unroll
            for (int i = 0; i < 8; ++i) { const float w0 = cwv[0][i >> 2][i & 3], w1 = cwv[1][i >> 2][i & 3], w2 = cwv[2][i >> 2][i & 3]; o[i] = gb[i] * (w0 * (a0[i] * b0[i]) + w1 * (a1[i] * b1[i]) + w2 * (a2[i] * b2[i])); }
            u32x4 ow; ow.x = pk2(o[0], o[1]); ow.y = pk2(o[2], o[3]); ow.z = pk2(o[4], o[5]); ow.w = pk2(o[6], o[7]);
            *(u32x4*)(OB + (size_t)t * 512 + 8 * lane) = ow;
        }
        if ((lane & 7) < 2) { dqw = rope8v(dqw, r16a, r16b); iqw = rope8v(iqw, r16a, r16b); }
        *(u32x4*)(QC + (size_t)t * 512 + 8 * lane) = dqw; *(u32x4*)(QI + (size_t)t * 512 + 8 * lane) = iqw;
        float ql[8], kv[8]; unpack8(qlw, ql); unpack8(kvw, kv);
        float ss1 = 0.f, ss2 = 0.f;
        if (lane < 32) {
#pragma unroll
            for (int i = 0; i < 8; ++i) ss1 += ql[i] * ql[i]; }
        if (lane < 16) {
#pragma unroll
            for (int i = 0; i < 8; ++i) ss2 += kv[i] * kv[i]; }
#pragma unroll
        for (int o = 1; o < 64; o <<= 1) { ss1 += __shfl_xor(ss1, o); ss2 += __shfl_xor(ss2, o); }
        const float r1 = 1.0f / sqrtf(ss1 * (1.0f / 256.0f) + NORM_EPS), r2 = 1.0f / sqrtf(ss2 * (1.0f / 128.0f) + NORM_EPS);
        if (lane < 32) { u32x4 o; o.x = pk2(ql[0] * r1 * qn0[0], ql[1] * r1 * qn0[1]); o.y = pk2(ql[2] * r1 * qn0[2], ql[3] * r1 * qn0[3]); o.z = pk2(ql[4] * r1 * qn1[0], ql[5] * r1 * qn1[1]); o.w = pk2(ql[6] * r1 * qn1[2], ql[7] * r1 * qn1[3]);
            *(u32x4*)(CQ + (size_t)t * 256 + 8 * lane) = o;
            u32x4 k = z4; if (lane < 16) { k.x = pk2(kv[0] * r2 * kn0[0], kv[1] * r2 * kn0[1]); k.y = pk2(kv[2] * r2 * kn0[2], kv[3] * r2 * kn0[3]); k.z = pk2(kv[4] * r2 * kn1[0], kv[5] * r2 * kn1[1]); k.w = pk2(kv[6] * r2 * kn1[2], kv[7] * r2 * kn1[3]); }
            *(u32x4*)(CKV + (size_t)t * 256 + 8 * lane) = k; }
        if (lane >= 16 && lane < 20) *(u32x4*)(KPE + (size_t)t * 32 + 8 * (lane - 16)) = rope8v(kvw, r32a, r32b);
        if (lane < 16) { if (lane < 2) dkw = rope8v(dkw, r16a, r16b); if (lane < 8) *(u32x4*)(KC + (size_t)t * 64 + 8 * lane) = dkw; else *(u32x4*)(VC + (size_t)t * 64 + 8 * (lane - 8)) = dkw; }
        if (lane >= 16 && lane < 24) { const int c = lane - 16; if (c < 2) ikw = rope8v(ikw, r16a, r16b); *(u32x4*)(KI + (size_t)t * 64 + 8 * c) = ikw; }
        if (lane == 32) { float v[8]; unpack8(iww, v); *(f32x4*)(IW + (size_t)t * 8) = (f32x4){v[0], v[1], v[2], v[3]}; *(f32x4*)(IW + (size_t)t * 8 + 4) = (f32x4){v[4], v[5], v[6], v[7]}; }
    }
}

DI int crow(int r, int hi) { return (r & 3) + 8 * (r >> 2) + 4 * hi; }
#define MFMA32(a, b, c) __builtin_amdgcn_mfma_f32_32x32x16_bf16((a), (b), (c), 0, 0, 0)
#define MFMA16(a, b, c) __builtin_amdgcn_mfma_f32_16x16x32_bf16((a), (b), (c), 0, 0, 0)
#define GLDS16(src, dst) __builtin_amdgcn_global_load_lds((const unsigned*)(src), (LAS unsigned*)(dst), 16, 0, 0)
typedef short v4i16_t __attribute__((ext_vector_type(4)));
DI s16x4 tr_read(const LAS unsigned char* p) { return __builtin_bit_cast(s16x4, __builtin_amdgcn_ds_read_tr16_b64_v4i16((LAS v4i16_t*)p)); }
DI bf16x8 pack8(float a0, float a1, float a2, float a3, float a4, float a5, float a6, float a7) { u32x4 w; w.x = pk2(a0, a1); w.y = pk2(a2, a3); w.z = pk2(a4, a5); w.w = pk2(a6, a7); return __builtin_bit_cast(bf16x8, w); }
DI bf16x8 cat4(s16x4 lo, s16x4 hi) { return (bf16x8){lo[0], lo[1], lo[2], lo[3], hi[0], hi[1], hi[2], hi[3]}; }

constexpr int MLA_K0 = 0, MLA_V0 = 24576, MLA_WS = 49152;
DI void mla_unit(const Frame& F, int b, int h, int qb) {
    const int lane = F.lane, wid = F.wave, r32 = lane & 31, hi = lane >> 5;
    const bf16_t* QA = WSP(bf16_t, WS_QA); const bf16_t* KPE = WSP(bf16_t, WS_KPE); const bf16_t* KV = WSP(bf16_t, WS_KV); bf16_t* OA = WSP(bf16_t, WS_O3);
    const size_t tb = (size_t)b * SEQ; const int q0 = qb * 256, qrow = q0 + 32 * wid + r32;
    const float C2 = 0.10206207261596577f * 1.4426950408889634f;
    LAS unsigned char* lds = F.lds; LAS float* wsf = (LAS float*)(lds + MLA_WS) + wid * 128;
    bf16x8 qr[6];
#pragma unroll
    for (int d0 = 0; d0 < 6; ++d0) qr[d0] = *(const bf16x8*)(QA + (tb + qrow) * 768 + h * 96 + d0 * 16 + hi * 8);
    {
        const float* rp = WSP(float, WS_ROPE) + (tb + qrow) * 48;
        qr[0] = __builtin_bit_cast(bf16x8, rope8(__builtin_bit_cast(u32x4, qr[0]), rp + 8 * hi));
        qr[1] = __builtin_bit_cast(bf16x8, rope8(__builtin_bit_cast(u32x4, qr[1]), rp + 16 + 8 * hi)); }
    const int NT = 4 * (qb + 1);
    const unsigned vo_pe = (unsigned)(lane * 32 + 8 * (wid & 3)) * 2u, vo_k0 = (unsigned)(lane * 1024 + 128 * h + 8 * ((wid + 4) & 7)) * 2u, vo_k1 = (unsigned)(lane * 1024 + 128 * h + 8 * (wid + 4)) * 2u,
                   vo_v = (unsigned)((16 * (wid & 3) + (lane >> 2)) * 1024 + 128 * h + 64 + 32 * (wid >> 2) + 8 * (lane & 3)) * 2u;
    const unsigned ldsb = (unsigned)(unsigned long long)lds;
    const char* pe_b = pg8::uni_ptr((const char*)(KPE + tb * 32)); const char* kv_b = pg8::uni_ptr((const char*)(KV + tb * 1024));
#define MLA_STAGE(kt, buf, vslot) do { const char* pe_ = pe_b + (size_t)(kt) * (64 * 32 * 2); const char* kv_ = kv_b + (size_t)(kt) * (64 * 1024 * 2); \
        if (wid < 4) { pg8::glds16_s(vo_pe, pe_, ldsb + MLA_K0 + (buf) * 12288 + wid * 1024); pg8::glds16_s(vo_k1, kv_, ldsb + MLA_K0 + (buf) * 12288 + (wid + 8) * 1024); } \
        else { pg8::glds16_s(vo_k0, kv_, ldsb + MLA_K0 + (buf) * 12288 + wid * 1024); } \
        pg8::glds16_s(vo_v, kv_, ldsb + MLA_V0 + (vslot) * 8192 + wid * 1024); } while (0)
    MLA_STAGE(0, 0, 0);
    float m = -1e30f, l = 0.f; f32x16 o[2];
#pragma unroll
    for (int r = 0; r < 16; ++r) { o[0][r] = 0.f; o[1][r] = 0.f; }
    const int vboff = ((lane >> 4) & 1) * 32 + (lane & 3) * 8 + (4 * hi + ((lane & 15) >> 2)) * 64;
    const bool upper = wid >= 4; bool have_prev = false; bf16x8 pa[4];
#define MLA_PV(vs) do { const LAS unsigned char* vb_ = lds + MLA_V0 + (vs) * 8192 + vboff; \
        _Pragma("unroll") for (int d0 = 0; d0 < 2; ++d0) _Pragma("unroll") for (int ks = 0; ks < 4; ++ks) { \
            const s16x4 lo_ = tr_read(vb_ + d0 * 4096 + ks * 1024), hh_ = tr_read(vb_ + d0 * 4096 + ks * 1024 + 512); o[d0] = MFMA32(pa[ks], cat4(lo_, hh_), o[d0]); } } while (0)
    int vs_cur = 0, vs_prev = 0;
    for (int kt = 0; kt < NT; ++kt) {
        const int buf = kt & 1; const int vs_next = (vs_cur == 2) ? 0 : vs_cur + 1;
        VM_WAIT(); __syncthreads();
        if (kt + 1 < NT) MLA_STAGE(kt + 1, buf ^ 1, vs_next);
        if (upper && have_prev) { MLA_PV(vs_prev); have_prev = false; }
        if (64 * kt <= q0 + 32 * wid + 31) {
            f32x16 p0, p1;
#pragma unroll
            for (int r = 0; r < 16; ++r) { p0[r] = 0.f; p1[r] = 0.f; }
            const LAS unsigned char* kb = lds + MLA_K0 + buf * 12288 + hi * 1024 + r32 * 16;
#pragma unroll
            for (int d0 = 0; d0 < 6; ++d0) { const bf16x8 b0 = *(const LAS bf16x8*)(kb + d0 * 2048), b1 = *(const LAS bf16x8*)(kb + d0 * 2048 + 512);
                p0 = MFMA32(b0, qr[d0], p0); p1 = MFMA32(b1, qr[d0], p1); }
            if (64 * kt + 63 > q0 + 32 * wid) {
#pragma unroll
                for (int r = 0; r < 16; ++r) { const int kv = 64 * kt + crow(r, hi); if (kv > qrow) p0[r] = -INFINITY; if (kv + 32 > qrow) p1[r] = -INFINITY; } }
            float rm = fmaxf(p0[0], p1[0]);
#pragma unroll
            for (int r = 1; r < 16; ++r) rm = fmaxf(rm, fmaxf(p0[r], p1[r]));
            rm = fmaxf(rm, __shfl_xor(rm, 32));
            const float mn = fmaxf(m, rm);
            if (__any(mn > m)) {
                const float alpha = __builtin_amdgcn_exp2f((m - mn) * C2); l *= alpha; m = mn;
                if (hi == 0) wsf[r32] = alpha;
                LDS_WAIT();
#pragma unroll
                for (int q = 0; q < 4; ++q) { const f32x4 a = *(const LAS f32x4*)(wsf + 8 * q + 4 * hi);
#pragma unroll
                    for (int j = 0; j < 4; ++j) { o[0][4 * q + j] *= a[j]; o[1][4 * q + j] *= a[j]; } }
            }
            const float mc = m * C2; float ls = 0.f;
#pragma unroll
            for (int r = 0; r < 16; ++r) { p0[r] = __builtin_amdgcn_exp2f(__builtin_fmaf(p0[r], C2, -mc)); p1[r] = __builtin_amdgcn_exp2f(__builtin_fmaf(p1[r], C2, -mc)); ls += p0[r] + p1[r]; }
            l += ls;
            pa[0] = pack8(p0[0], p0[1], p0[2], p0[3], p0[4], p0[5], p0[6], p0[7]); pa[1] = pack8(p0[8], p0[9], p0[10], p0[11], p0[12], p0[13], p0[14], p0[15]);
            pa[2] = pack8(p1[0], p1[1], p1[2], p1[3], p1[4], p1[5], p1[6], p1[7]); pa[3] = pack8(p1[8], p1[9], p1[10], p1[11], p1[12], p1[13], p1[14], p1[15]);
            if (upper) have_prev = true; else MLA_PV(vs_cur);
        }
        vs_prev = vs_cur; vs_cur = vs_next;
    }
    if (upper && have_prev) MLA_PV(vs_prev);
#undef MLA_PV
#undef MLA_STAGE
    l += __shfl_xor(l, 32);
    if (hi == 0) wsf[64 + r32] = 1.0f / l;
    LDS_WAIT();
    bf16_t* orow = OA + (tb + q0 + 32 * wid) * 512 + h * 64 + r32;
#pragma unroll
    for (int q = 0; q < 4; ++q) { const f32x4 a = *(const LAS f32x4*)(wsf + 64 + 8 * q + 4 * hi);
#pragma unroll
        for (int j = 0; j < 4; ++j) { const int r = 4 * q + j, rr = crow(r, hi);
            orow[(size_t)rr * 512] = (bf16_t)(pk2(o[0][r] * a[j], 0.f) & 0xffffu); orow[(size_t)rr * 512 + 32] = (bf16_t)(pk2(o[1][r] * a[j], 0.f) & 0xffffu); } }
    __syncthreads();
}

constexpr int DSA_SCW = 2052;
constexpr int DSA_SEL = 16 * DSA_SCW * 4;
constexpr int DSA_CAND = DSA_SEL + 4096;
DI int mbcnt64(unsigned long long m) { return (int)__builtin_amdgcn_mbcnt_hi((unsigned)(m >> 32), __builtin_amdgcn_mbcnt_lo((unsigned)m, 0u)); }
DI void dsa_unit(const Frame& F, int b, int qt) {
    const int tid = F.tid, lane = F.lane, wid = F.wave, fr = lane & 15, g = lane >> 4;
    const bf16_t *QI = WSP(bf16_t, WS_QI), *KI = WSP(bf16_t, WS_KI), *QC = WSP(bf16_t, WS_QC), *KC = WSP(bf16_t, WS_KC), *VC = WSP(bf16_t, WS_VC); const float* IW = WSP(float, WS_IW);
    bf16_t* OC = WSP(bf16_t, WS_O3) + (size_t)2 * T_TOK * 512;
    const size_t tb = (size_t)b * SEQ; const int t0 = 16 * qt;
    LAS unsigned char* lds = F.lds; LAS float* SC = (LAS float*)lds; LAS unsigned long long* BITS = (LAS unsigned long long*)(lds + DSA_SEL);
    {
        bf16x8 qf[8][2]; float wv[8];
        const bf16_t* qp = QI + (tb + t0 + fr) * 512 + 8 * g;
#pragma unroll
        for (int h = 0; h < 8; ++h) { qf[h][0] = *(const bf16x8*)(qp + h * 64); qf[h][1] = *(const bf16x8*)(qp + h * 64 + 32); }
        { const f32x4 w0 = *(const f32x4*)(IW + (tb + t0 + fr) * 8), w1 = *(const f32x4*)(IW + (tb + t0 + fr) * 8 + 4); wv[0] = w0[0]; wv[1] = w0[1]; wv[2] = w0[2]; wv[3] = w0[3]; wv[4] = w1[0]; wv[5] = w1[1]; wv[6] = w1[2]; wv[7] = w1[3]; }
        const bf16_t* kbase = KI + (tb + fr) * 64 + 8 * g;
        const bf16x8 z8 = {0, 0, 0, 0, 0, 0, 0, 0};
        bf16x8 a0 = z8, a1 = z8, b0 = z8, b1 = z8, c0 = z8, c1 = z8;
        if (wid <= qt) { a0 = *(const bf16x8*)(kbase + (size_t)wid * 1024); a1 = *(const bf16x8*)(kbase + (size_t)wid * 1024 + 32); }
        if (wid + 8 <= qt) { b0 = *(const bf16x8*)(kbase + (size_t)(wid + 8) * 1024); b1 = *(const bf16x8*)(kbase + (size_t)(wid + 8) * 1024 + 32); }
        if (wid + 16 <= qt) { c0 = *(const bf16x8*)(kbase + (size_t)(wid + 16) * 1024); c1 = *(const bf16x8*)(kbase + (size_t)(wid + 16) * 1024 + 32); }
        for (int kt = wid; kt <= qt; kt += 8) {
            bf16x8 n0 = z8, n1 = z8;
            if (kt + 24 <= qt) { n0 = *(const bf16x8*)(kbase + (size_t)(kt + 24) * 1024); n1 = *(const bf16x8*)(kbase + (size_t)(kt + 24) * 1024 + 32); }
            f32x4 s = {F.zf, F.zf, F.zf, F.zf};
#pragma unroll
            for (int h = 0; h < 8; ++h) { f32x4 acc = {F.zf, F.zf, F.zf, F.zf}; acc = MFMA16(a0, qf[h][0], acc); acc = MFMA16(a1, qf[h][1], acc);
#pragma unroll
                for (int r = 0; r < 4; ++r) s[r] += fmaxf(acc[r], 0.f) * wv[h]; }
#pragma unroll
            for (int r = 0; r < 4; ++r) if (16 * kt + 4 * g + r > t0 + fr) s[r] = -INFINITY;
            *(LAS f32x4*)(SC + fr * DSA_SCW + 16 * kt + 4 * g) = s;
            a0 = b0; a1 = b1; b0 = c0; b1 = c1; c0 = n0; c1 = n1;
        }
    }
    __syncthreads();
#ifdef PROBE_S2DUP
    for (int qi2_ = 0; qi2_ < 2 * PROBE_S2DUP; ++qi2_) { const int qi2 = qi2_ & 1;
#else
    for (int qi2 = 0; qi2 < 2; ++qi2) {
#endif
        const int qq = 2 * wid + qi2, t = t0 + qq, nvalid = t + 1;
#ifdef PROBE_S2DUP
        const bool probe_pass = (qi2_ < 2 * (PROBE_S2DUP - 1));
#endif
        LAS unsigned long long* bits = BITS + qq * 32;
        if (nvalid <= 256) { if (lane < 32) { const int k0 = 64 * lane; bits[lane] = (k0 + 63 <= t) ? ~0ull : (k0 <= t) ? ((1ull << (t - k0 + 1)) - 1ull) : 0ull; } }
        else {
            const int nq = (nvalid + 511) >> 9;
            float v[32];
#pragma unroll
            for (int i = 0; i < 32; ++i) { const int key = i * 64 + lane; v[i] = (key <= t) ? SC[qq * DSA_SCW + key] : -INFINITY; }
            float vmax = v[0], vmin = (v[0] == -INFINITY) ? INFINITY : v[0];
#pragma unroll
            for (int i = 1; i < 32; ++i) { vmax = fmaxf(vmax, v[i]); vmin = fminf(vmin, (v[i] == -INFINITY) ? INFINITY : v[i]); }
#pragma unroll
            for (int o = 1; o < 64; o <<= 1) { vmax = fmaxf(vmax, __shfl_xor(vmax, o)); vmin = fminf(vmin, __shfl_xor(vmin, o)); }
#ifndef S2_BALLOT
#define S2_BALLOT 1
#endif
#ifndef S2_FINISH
#define S2_FINISH 1
#endif
#ifndef S2_PREBRACKET
#define S2_PREBRACKET 1
#endif
#if S2_BALLOT
#define DSA_CMP_ge(m_, x_, t_) asm("v_cmp_ge_f32_e64 %0, %1, %2" : "=s"(m_) : "v"(x_), "v"(t_))
#define DSA_CMP_gt(m_, x_, t_) asm("v_cmp_gt_f32_e64 %0, %1, %2" : "=s"(m_) : "v"(x_), "v"(t_))
#define DSA_COUNT(thr, OPN, out) do { int tot_ = 0; const float thr_ = (thr); _Pragma("unroll") for (int qd = 0; qd < 4; ++qd) { if (qd < nq) { unsigned long long m_[8]; \
                _Pragma("unroll") for (int i = 0; i < 8; ++i) DSA_CMP_##OPN(m_[i], v[8 * qd + i], thr_); __builtin_amdgcn_sched_barrier(0); _Pragma("unroll") for (int i = 0; i < 8; ++i) tot_ += __builtin_popcountll(m_[i]); __builtin_amdgcn_sched_barrier(0); } } out = tot_; } while (0)
#else
#define DSA_OP_ge >=
#define DSA_OP_gt >
#define DSA_COUNT(thr, OPN, out) do { int c_ = 0; _Pragma("unroll") for (int qd = 0; qd < 4; ++qd) { if (qd < nq) { _Pragma("unroll") for (int i = 0; i < 8; ++i) c_ += (v[8 * qd + i] DSA_OP_##OPN (thr)) ? 1 : 0; } } \
                int tot_ = 0; _Pragma("unroll") for (int b_ = 0; b_ < 6; ++b_) tot_ += __builtin_popcountll(__ballot((c_ >> b_) & 1)) << b_; out = tot_; } while (0)
#endif
            float lo = vmin, hi = vmax, K; int cnt;
            DSA_COUNT(hi, ge, cnt);
            if (cnt >= 256) { K = hi; }
            else {
                int clo = nvalid, chi = cnt; bool done = false;
#if S2_PREBRACKET
                if (nvalid >= 512) {
                    float a1 = -INFINITY, a2 = -INFINITY, a3 = -INFINITY, a4 = -INFINITY, a5 = -INFINITY;
#pragma unroll
                    for (int qd = 0; qd < 4; ++qd) { if (qd < nq) {
#pragma unroll
                        for (int i = 0; i < 8; ++i) { const float x = v[8 * qd + i];
                            const float n5 = __builtin_amdgcn_fmed3f(a4, a5, x), n4 = __builtin_amdgcn_fmed3f(a3, a4, x), n3 = __builtin_amdgcn_fmed3f(a2, a3, x), n2 = __builtin_amdgcn_fmed3f(a1, a2, x);
                            a1 = fmaxf(a1, x); a2 = n2; a3 = n3; a4 = n4; a5 = n5; } } }
                    float m3 = a3, m4 = a4, m5 = a5;
#pragma unroll
                    for (int o = 1; o < 64; o <<= 1) { m3 += __shfl_xor(m3, o); m4 += __shfl_xor(m4, o); m5 += __shfl_xor(m5, o); }
                    m3 *= (1.0f / 64.0f); m4 *= (1.0f / 64.0f); m5 *= (1.0f / 64.0f);
                    int c5; DSA_COUNT(m5, ge, c5);
                    if (c5 == 256) { K = m5; cnt = 256; done = true; }
                    else if (c5 < 256) { if (m5 < hi) { hi = m5; chi = c5; } }
                    else { if (m5 > lo) { lo = m5; clo = c5; }
                        int c4; DSA_COUNT(m4, ge, c4);
                        if (c4 == 256) { K = m4; cnt = 256; done = true; }
                        else if (c4 < 256) { if (m4 < hi) { hi = m4; chi = c4; } }
                        else { if (m4 > lo) { lo = m4; clo = c4; }
                            int c3; DSA_COUNT(m3, ge, c3);
                            if (c3 == 256) { K = m3; cnt = 256; done = true; }
                            else if (c3 < 256) { if (m3 < hi) { hi = m3; chi = c3; } }
                            else { if (m3 > lo) { lo = m3; clo = c3; } } } }
                }
#endif
                if (!done)
                for (int it = 0;; ++it) {
#if S2_FINISH
                    if (clo - chi <= 64) {
                        LAS float* cand = (LAS float*)(lds + DSA_CAND) + wid * 64;
                        cand[lane] = -INFINITY;
                        int base = 0;
#pragma unroll
                        for (int qd = 0; qd < 4; ++qd) { if (qd < nq) {
#pragma unroll
                            for (int i = 0; i < 8; ++i) { const float x = v[8 * qd + i]; const bool c = (x >= lo) && (x < hi); const unsigned long long m = __ballot(c);
                                if (c) cand[base + mbcnt64(m)] = x;
                                base += __builtin_popcountll(m); } } }
                        const float cv = cand[lane]; const int need = 256 - chi; int ge = 0;
                        for (int k = 0; k < base; ++k) { const float ck = __uint_as_float((unsigned)__builtin_amdgcn_readlane((int)__float_as_uint(cv), k)); ge += (ck >= cv) ? 1 : 0; }
                        float kc = (ge >= need) ? cv : -INFINITY;
#pragma unroll
                        for (int o = 1; o < 64; o <<= 1) kc = fmaxf(kc, __shfl_xor(kc, o));
                        K = kc; DSA_COUNT(K, ge, cnt);
                        break;
                    }
#endif
#ifdef PROBE_S2CAP
                    if (probe_pass && it >= PROBE_S2CAP) { K = lo; cnt = 256; break; }
#endif
                    float fr_ = 0.5f;
                    if ((it & 1) == 0) { fr_ = ((float)(clo - 256) + 0.5f) / (float)(clo - chi); fr_ = fminf(fmaxf(fr_, 0.03125f), 0.96875f); }
                    const float mid = lo + (hi - lo) * fr_;
                    if (!(mid > lo && mid < hi)) {
                        const float mid2 = lo + (hi - lo) * 0.5f;
                        if (!(mid2 > lo && mid2 < hi)) { K = lo; cnt = clo; break; }
                        DSA_COUNT(mid2, ge, cnt);
                        if (cnt == 256) { K = mid2; break; }
                        if (cnt > 256) { lo = mid2; clo = cnt; } else { hi = mid2; chi = cnt; }
                        continue;
                    }
                    DSA_COUNT(mid, ge, cnt);
                    if (cnt == 256) { K = mid; break; }
                    if (cnt > 256) { lo = mid; clo = cnt; } else { hi = mid; chi = cnt; }
                }
            }
#ifdef PROBE_S2NOW
            if (probe_pass) { asm volatile("" :: "v"(K)); } else
#endif
            if (cnt == 256) {
#pragma unroll
                for (int qd = 0; qd < 4; ++qd) {
#pragma unroll
                    for (int i8 = 0; i8 < 8; ++i8) { const int i = 8 * qd + i8; const unsigned long long mt = (qd < nq) ? __ballot(v[i] >= K) : 0ull; if (lane == 0) bits[i] = mt; } }
            } else {
                int cgt; DSA_COUNT(K, gt, cgt);
                const int need = 256 - cgt; int eqb = 0;
#pragma unroll
                for (int qd = 0; qd < 4; ++qd) {
#pragma unroll
                    for (int i8 = 0; i8 < 8; ++i8) { const int i = 8 * qd + i8; unsigned long long mt = 0ull;
                        if (qd < nq) { const bool gt = v[i] > K, eq = v[i] == K; const unsigned long long me = __ballot(eq); const int erank = eqb + mbcnt64(me);
                            mt = __ballot(gt || (eq && erank < need)); eqb += __builtin_popcountll(me); }
                        if (lane == 0) bits[i] = mt; } }
            }
#undef DSA_COUNT
        }
    }
    __syncthreads();
    {
        const float C2S = 0.125f * 1.4426950408889634f;
        int lane3 = lane; asm volatile("" : "+v"(lane3));
        const int r32 = lane3 & 31, hi = lane3 >> 5, cg = wid & 3, kp = wid >> 2;
        const int NT = (t0 + 16 + 63) >> 6, NS = (NT + 1) >> 1;
        const int qloc = 4 * cg + (r32 >> 3);
        LAS float* wsf = (LAS float*)(lds + 65536) + wid * 128;
        LAS float* OW = (LAS float*)(lds + 69632); LAS float* ML2 = (LAS float*)(lds + 69632 + 32768);
        bf16x8 qr[4];
#pragma unroll
        for (int d0 = 0; d0 < 4; ++d0) qr[d0] = *(const bf16x8*)(QC + (tb + t0 + qloc) * 512 + (r32 & 7) * 64 + d0 * 16 + hi * 8);
        const unsigned vo_kc = (unsigned)(lane3 * 64 + 8 * wid) * 2u, vo_vc = (unsigned)((16 * (wid & 3) + (lane3 >> 2)) * 64 + 32 * (wid >> 2) + 8 * (lane3 & 3)) * 2u, ldsb = (unsigned)(unsigned long long)lds;
        const char* kc_b = pg8::uni_ptr((const char*)(KC + tb * 64)); const char* vc_b = pg8::uni_ptr((const char*)(VC + tb * 64));
#define DSD_STAGE(j, buf) do { _Pragma("unroll") for (int par_ = 0; par_ < 2; ++par_) { const int kt_ = 2 * (j) + par_; if (kt_ < NT) { \
            const unsigned d_ = ldsb + (buf) * 32768 + par_ * 16384; \
            pg8::glds16_s(vo_kc, kc_b + (size_t)kt_ * (64 * 64 * 2), d_ + wid * 1024); pg8::glds16_s(vo_vc, vc_b + (size_t)kt_ * (64 * 64 * 2), d_ + 8192 + wid * 1024); } } } while (0)
        DSD_STAGE(0, 0);
        float m = -1e30f, l = 0.f; f32x16 o[2];
#pragma unroll
        for (int r = 0; r < 16; ++r) { o[0][r] = F.zf; o[1][r] = F.zf; }
        const int vboff = ((lane3 >> 4) & 1) * 32 + (lane3 & 3) * 8 + (4 * hi + ((lane3 & 15) >> 2)) * 64;
        for (int j = 0; j < NS; ++j) {
            const int buf = j & 1, kt = 2 * j + kp;
            VM_WAIT(); __syncthreads();
            if (j + 1 < NS) DSD_STAGE(j + 1, buf ^ 1);
            if (kt < NT) {
                const LAS unsigned char* tile = lds + buf * 32768 + kp * 16384;
                f32x16 p0, p1;
#pragma unroll
                for (int r = 0; r < 16; ++r) { p0[r] = F.zf; p1[r] = F.zf; }
                const LAS unsigned char* kb = tile + hi * 1024 + r32 * 16;
#pragma unroll
                for (int d0 = 0; d0 < 4; ++d0) { const bf16x8 b0 = *(const LAS bf16x8*)(kb + d0 * 2048), b1 = *(const LAS bf16x8*)(kb + d0 * 2048 + 512);
                    p0 = MFMA32(b0, qr[d0], p0); p1 = MFMA32(b1, qr[d0], p1); }
                float rm = fmaxf(p0[0], p1[0]);
#pragma unroll
                for (int r = 1; r < 16; ++r) rm = fmaxf(rm, fmaxf(p0[r], p1[r]));
                rm = fmaxf(rm, __shfl_xor(rm, 32));
                const float mn = fmaxf(m, rm);
                if (__any(mn > m)) {
                    const float alpha = __builtin_amdgcn_exp2f((m - mn) * C2S); l *= alpha; m = mn;
                    if (hi == 0) wsf[r32] = alpha;
                    LDS_WAIT();
#pragma unroll
                    for (int q = 0; q < 4; ++q) { const f32x4 a = *(const LAS f32x4*)(wsf + 8 * q + 4 * hi);
#pragma unroll
                        for (int jj = 0; jj < 4; ++jj) { o[0][4 * q + jj] *= a[jj]; o[1][4 * q + jj] *= a[jj]; } }
                }
                const unsigned long long bw = BITS[qloc * 32 + kt];
                const unsigned wl = (unsigned)bw >> (4 * hi), wh = (unsigned)(bw >> 32) >> (4 * hi);
                const float mc = m * C2S; float ls = 0.f;
#pragma unroll
                for (int r = 0; r < 16; ++r) { const int c = (r & 3) + 8 * (r >> 2);
                    const int m0 = ((int)(wl << (31 - c))) >> 31, m1 = ((int)(wh << (31 - c))) >> 31;
                    p0[r] = __uint_as_float(__float_as_uint(__builtin_amdgcn_exp2f(__builtin_fmaf(p0[r], C2S, -mc))) & (unsigned)m0);
                    p1[r] = __uint_as_float(__float_as_uint(__builtin_amdgcn_exp2f(__builtin_fmaf(p1[r], C2S, -mc))) & (unsigned)m1);
                    ls += p0[r] + p1[r]; }
                l += ls;
                bf16x8 pa[4];
                pa[0] = pack8(p0[0], p0[1], p0[2], p0[3], p0[4], p0[5], p0[6], p0[7]); pa[1] = pack8(p0[8], p0[9], p0[10], p0[11], p0[12], p0[13], p0[14], p0[15]);
                pa[2] = pack8(p1[0], p1[1], p1[2], p1[3], p1[4], p1[5], p1[6], p1[7]); pa[3] = pack8(p1[8], p1[9], p1[10], p1[11], p1[12], p1[13], p1[14], p1[15]);
                const LAS unsigned char* vb = tile + 8192 + vboff;
#pragma unroll
                for (int d0 = 0; d0 < 2; ++d0)
#pragma unroll
                    for (int ks = 0; ks < 4; ++ks) { const s16x4 lo = tr_read(vb + d0 * 4096 + ks * 1024), hh = tr_read(vb + d0 * 4096 + ks * 1024 + 512);
                        o[d0] = MFMA32(pa[ks], cat4(lo, hh), o[d0]); }
            }
        }
#undef DSD_STAGE
        l += __shfl_xor(l, 32);
        __syncthreads();
        if (kp == 1) {
            LAS float* ow = OW + cg * 2048;
#pragma unroll
            for (int r = 0; r < 16; ++r) { const int row = crow(r, hi); ow[row * 64 + r32] = o[0][r]; ow[row * 64 + 32 + r32] = o[1][r]; }
            if (hi == 0) { ML2[cg * 64 + r32] = m; ML2[cg * 64 + 32 + r32] = l; }
        }
        __syncthreads();
        if (kp == 0) {
            const float m2 = ML2[cg * 64 + r32], l2 = ML2[cg * 64 + 32 + r32];
            const float M = fmaxf(m, m2), a1 = __builtin_amdgcn_exp2f((m - M) * C2S), a2 = __builtin_amdgcn_exp2f((m2 - M) * C2S);
            const float linv = 1.0f / (a1 * l + a2 * l2);
            if (hi == 0) { wsf[r32] = a1 * linv; wsf[32 + r32] = a2 * linv; }
            LDS_WAIT();
            const LAS float* ow = OW + cg * 2048;
            bf16_t* op = OC + (tb + t0 + 4 * cg) * 512 + r32;
#pragma unroll
            for (int q = 0; q < 4; ++q) { const f32x4 s1 = *(const LAS f32x4*)(wsf + 8 * q + 4 * hi), s2 = *(const LAS f32x4*)(wsf + 32 + 8 * q + 4 * hi);
#pragma unroll
                for (int jj = 0; jj < 4; ++jj) { const int r = 4 * q + jj, row = crow(r, hi);
                    const float v0 = o[0][r] * s1[jj] + ow[row * 64 + r32] * s2[jj], v1 = o[1][r] * s1[jj] + ow[row * 64 + 32 + r32] * s2[jj];
                    bf16_t* dst = op + (size_t)(row >> 3) * 512 + (row & 7) * 64;
                    dst[0] = (bf16_t)(pk2(v0, 0.f) & 0xffffu); dst[32] = (bf16_t)(pk2(v1, 0.f) & 0xffffu); } }
        }
    }
    __syncthreads();
}
DI void attention_mla_units(const Frame& F, int rep_a) {
    for (int rep = 0; rep < rep_a; ++rep)
    for (int U = F.bid; U < 1024; U += F.G) { const int i = U >> 8, cp = U & 255, half = cp >> 7, rem = cp & 127; mla_unit(F, rem & 15, rem >> 4, 2 * i + (half ^ (i & 1))); }
}
DI void attention_dsa_units(const Frame& F, int rep_c) {
    for (int rep = 0; rep < rep_c; ++rep)
    for (int U = F.bid; U < 2048; U += F.G) { const int i = U >> 8, cp = U & 255; dsa_unit(F, cp & 15, 16 * i + (cp >> 4)); }
}
DI void phase_attention(const Frame& F, int rep_a, int rep_c) {
    if (F.bid & 1) { attention_dsa_units(F, rep_c); __syncthreads(); attention_mla_units(F, rep_a); }
    else { attention_mla_units(F, rep_a); __syncthreads(); attention_dsa_units(F, rep_c); }
}

constexpr int N2_WROW = 1032;
constexpr int N2_WH = 0, N2_WL = 32 * N2_WROW * 2, N2_CB = 2 * N2_WL, N2_PART = N2_CB + 128, N2_LGT = N2_PART + 2048, N2_RST = N2_LGT + 8 * 2304, N2_CNT = N2_RST + 512, N2_BASE = N2_CNT + 128, N2_TOK = N2_BASE + 128;
static_assert(N2_TOK + 2048 <= MISC_OFF, "router LDS map");
DI void phase_router(const Frame& F, int l, int cset) {
    const int tid = F.tid, lane = F.lane, wave = F.wave, fr = lane & 15, g = lane >> 4;
    LAS unsigned char* lds = F.lds;
    LAS bf16_t* WH = (LAS bf16_t*)(lds + N2_WH); LAS bf16_t* WL = (LAS bf16_t*)(lds + N2_WL); LAS float* CB = (LAS float*)(lds + N2_CB); LAS float* PART = (LAS float*)(lds + N2_PART);
    LAS float* LGT = (LAS float*)(lds + N2_LGT) + wave * 576; LAS float* RST = (LAS float*)(lds + N2_RST) + wave * 16;
    LAS int* CNT = (LAS int*)(lds + N2_CNT); LAS int* BASE = (LAS int*)(lds + N2_BASE); LAS int* TOKR = (LAS int*)(lds + N2_TOK);
    const float* X1 = WSP(float, WS_X1); const float* MOD = WSP(float, WS_MOD); unsigned char* H8 = WSP(unsigned char, WS_H8);
    const float* in_n2 = KIN_norm2_g + l * 1024; const float* in_rb = KIN_router_b + l * 32; const float* in_rw = KIN_router_w + (size_t)l * 32768;
    int* TOPE = (int*)(F.ws + WS_ROUTE + RT_TOPE); float* TOPG = (float*)(F.ws + WS_ROUTE + RT_TOPG); int* RANK = (int*)(F.ws + WS_ROUTE + RT_RANK);
    for (int chunk = F.bid; chunk < T_TOK / 128; chunk += F.G) {
        const int b = chunk >> 4; const float* md = MOD + ((size_t)l * 16 + b) * 6144;
        __syncthreads();
        { float cp = 0.f;
          for (int idx = tid; idx < 32 * 1024; idx += 512) { const int k = idx >> 5, e = idx & 31; const float w = in_rw[idx]; const float wp = w * (in_n2[k] * (1.0f + md[4 * 1024 + k]));
              const unsigned hw = pk2(wp, 0.f) & 0xffffu; const float lo = wp - __uint_as_float(hw << 16);
              WH[e * N2_WROW + k] = (bf16_t)hw; WL[e * N2_WROW + k] = (bf16_t)(pk2(lo, 0.f) & 0xffffu); cp += md[3 * 1024 + k] * w; }
          PART[(tid >> 5) * 32 + (tid & 31)] = cp; }
        if (tid < 32) CNT[tid] = 0;
        __syncthreads();
        if (tid < 32) { float c = in_rb[tid];
#pragma unroll
            for (int p = 0; p < 16; ++p) c += PART[p * 32 + tid];
            CB[tid] = c; }
        __syncthreads();
        const int t0w = chunk * 128 + wave * 16;
        {
            const float* xp = X1 + (size_t)(t0w + fr) * 1024 + 8 * g;
            f32x4 acc0 = {F.zf, F.zf, F.zf, F.zf}, acc1 = acc0; float ssq = 0.f;
            const LAS bf16_t* wh0 = WH + fr * N2_WROW + 8 * g; const LAS bf16_t* wl0 = WL + fr * N2_WROW + 8 * g;
#pragma unroll 8
            for (int ks = 0; ks < 32; ++ks) {
                const f32x4 xa = *(const f32x4*)(xp + 32 * ks), xb = *(const f32x4*)(xp + 32 * ks + 4);
                ssq += (xa[0] * xa[0] + xa[1] * xa[1]) + (xa[2] * xa[2] + xa[3] * xa[3]) + (xb[0] * xb[0] + xb[1] * xb[1]) + (xb[2] * xb[2] + xb[3] * xb[3]);
                u32x4 hw; hw.x = pk2(xa[0], xa[1]); hw.y = pk2(xa[2], xa[3]); hw.z = pk2(xb[0], xb[1]); hw.w = pk2(xb[2], xb[3]);
                u32x4 lw; lw.x = pk2(xa[0] - bf_lo(hw.x), xa[1] - bf_hi(hw.x)); lw.y = pk2(xa[2] - bf_lo(hw.y), xa[3] - bf_hi(hw.y)); lw.z = pk2(xb[0] - bf_lo(hw.z), xb[1] - bf_hi(hw.z)); lw.w = pk2(xb[2] - bf_lo(hw.w), xb[3] - bf_hi(hw.w));
                const bf16x8 ah = __builtin_bit_cast(bf16x8, hw), al = __builtin_bit_cast(bf16x8, lw);
                const bf16x8 bh0 = *(const LAS bf16x8*)(wh0 + 32 * ks), bh1 = *(const LAS bf16x8*)(wh0 + 16 * N2_WROW + 32 * ks), bl0 = *(const LAS bf16x8*)(wl0 + 32 * ks), bl1 = *(const LAS bf16x8*)(wl0 + 16 * N2_WROW + 32 * ks);
                acc0 = __builtin_amdgcn_mfma_f32_16x16x32_bf16(ah, bh0, acc0, 0, 0, 0); acc0 = __builtin_amdgcn_mfma_f32_16x16x32_bf16(ah, bl0, acc0, 0, 0, 0); acc0 = __builtin_amdgcn_mfma_f32_16x16x32_bf16(al, bh0, acc0, 0, 0, 0);
                acc1 = __builtin_amdgcn_mfma_f32_16x16x32_bf16(ah, bh1, acc1, 0, 0, 0); acc1 = __builtin_amdgcn_mfma_f32_16x16x32_bf16(ah, bl1, acc1, 0, 0, 0); acc1 = __builtin_amdgcn_mfma_f32_16x16x32_bf16(al, bh1, acc1, 0, 0, 0);
            }
            ssq += __shfl_xor(ssq, 16); ssq += __shfl_xor(ssq, 32);
            if (g == 0) RST[fr] = 1.0f / sqrtf(ssq * (1.0f / 1024.0f) + NORM_EPS);
#pragma unroll
            for (int r = 0; r < 4; ++r) { LGT[(4 * g + r) * 36 + fr] = acc0[r]; LGT[(4 * g + r) * 36 + 16 + fr] = acc1[r]; }
        }
        LDS_WAIT();
        if (lane < 16) {
            const int t = t0w + lane; const float rt = RST[lane];
            float a[32];
#pragma unroll
            for (int q = 0; q < 8; ++q) { const f32x4 w = *(const LAS f32x4*)(LGT + lane * 36 + 4 * q), c = *(const LAS f32x4*)(CB + 4 * q); a[4 * q] = w[0] * rt + c[0]; a[4 * q + 1] = w[1] * rt + c[1]; a[4 * q + 2] = w[2] * rt + c[2]; a[4 * q + 3] = w[3] * rt + c[3]; }
            float tv[4]; int te[4];
#pragma unroll
            for (int k = 0; k < 4; ++k) { float best = a[0]; int bi = 0;
#pragma unroll
                for (int e = 1; e < 32; ++e) if (a[e] > best) { best = a[e]; bi = e; }
                tv[k] = best; te[k] = bi;
#pragma unroll
                for (int e = 0; e < 32; ++e) if (e == bi) a[e] = -INFINITY; }
            const float e1 = __expf(tv[1] - tv[0]), e2 = __expf(tv[2] - tv[0]), e3 = __expf(tv[3] - tv[0]); const float inv = 1.0f / (1.0f + e1 + e2 + e3);
            const float gk[4] = {inv, e1 * inv, e2 * inv, e3 * inv};
#pragma unroll
            for (int k = 0; k < 4; ++k) { const int loc = __hip_atomic_fetch_add(&CNT[te[k]], 1, __ATOMIC_RELAXED, __HIP_MEMORY_SCOPE_WORKGROUP); TOKR[(wave * 16 + lane) * 4 + k] = te[k] | (loc << 8); }
            *(f32x4*)(TOPG + (size_t)t * 4) = (f32x4){gk[0], gk[1], gk[2], gk[3]};
        }
        { f32x4 gs[4], shv[4];
#pragma unroll
          for (int i = 0; i < 4; ++i) { const int co = 4 * lane + 256 * i; gs[i] = *(const f32x4*)(in_n2 + co) * (*(const f32x4*)(md + 4 * 1024 + co) + 1.0f); shv[i] = *(const f32x4*)(md + 3 * 1024 + co); }
          for (int j = 0; j < 16; j += 4) {
            f32x4 xv[4][4];
#pragma unroll
            for (int jj = 0; jj < 4; ++jj)
#pragma unroll
                for (int i = 0; i < 4; ++i) xv[jj][i] = *(const f32x4*)(X1 + (size_t)(t0w + j + jj) * 1024 + 4 * lane + 256 * i);
#pragma unroll
            for (int jj = 0; jj < 4; ++jj) { const float r = RST[j + jj];
#pragma unroll
                for (int i = 0; i < 4; ++i) { const f32x4 hv = xv[jj][i] * r * gs[i] + shv[i];
                    *(unsigned*)(H8 + (size_t)(t0w + j + jj) * 1024 + 4 * lane + 256 * i) = pk4_fp8(hv[0], hv[1], hv[2], hv[3]); } }
          } }
        __syncthreads();
        if (tid < 32) BASE[tid] = (int)__hip_atomic_fetch_add(F.ctl + CW_CNT + (cset * 32 + tid) * 64, (unsigned)CNT[tid], __ATOMIC_RELAXED, __HIP_MEMORY_SCOPE_AGENT);
        __syncthreads();
        { const int pr = TOKR[tid], e = pr & 255, loc = pr >> 8; const size_t o = (size_t)(chunk * 128) * 4 + tid; TOPE[o] = e; RANK[o] = BASE[e] + loc; }
    }
}
constexpr int MOE_OFF = LDS_X, MOE_CNTL = LDS_X + 256, MOE_TEXP = LDS_X + 512;
DI int moe_offsets(const Frame& F, int l) {
    LAS int* OFF = (LAS int*)(F.lds + MOE_OFF); LAS int* CNTL = (LAS int*)(F.lds + MOE_CNTL); LAS int* TEXP = (LAS int*)(F.lds + MOE_TEXP);
    __syncthreads();
    if (F.tid < 32) CNTL[F.tid] = (int)__hip_atomic_load(F.ctl + CW_CNT + (l * 32 + F.tid) * 64, __ATOMIC_RELAXED, __HIP_MEMORY_SCOPE_AGENT);
    __syncthreads();
    if (F.tid == 0) { int off = 0; for (int e = 0; e < 32; ++e) { OFF[e] = off; off += (CNTL[e] + 255) & ~255; } OFF[32] = off; }
    __syncthreads();
    const int ntiles = OFF[32] >> 8;
    for (int tl = F.tid; tl < ntiles; tl += 512) { int e = 0; for (int q = 0; q < 32; ++q) if (OFF[q] <= tl * 256 && tl * 256 < OFF[q + 1]) e = q; TEXP[tl] = e; }
    __syncthreads();
    return ntiles;
}
DI void phase_scatter(const Frame& F, int l) {
    const int lane = F.lane, wave = F.wave;
    (void)moe_offsets(F, l);
    const LAS int* OFF = (const LAS int*)(F.lds + MOE_OFF); const LAS int* CNTL = (const LAS int*)(F.lds + MOE_CNTL);
    const int* TOPE = (const int*)(F.ws + WS_ROUTE + RT_TOPE); const float* TOPG = (const float*)(F.ws + WS_ROUTE + RT_TOPG); const int* RANK = (const int*)(F.ws + WS_ROUTE + RT_RANK);
    int* SLOTOF = (int*)(F.ws + WS_ROUTE + RT_SLOTOF); int* TOKOF = (int*)(F.ws + WS_ROUTE + RT_TOKOF); float* GATEOF = (float*)(F.ws + WS_ROUTE + RT_GATEOF);
    const unsigned char* H8 = WSP(unsigned char, WS_H8); unsigned char* XB = WSP(unsigned char, WS_XB);
    for (int chunk = F.bid; chunk < T_TOK / 128; chunk += F.G) {
        const int pair = wave * 64 + lane, tl = chunk * 128 + (pair >> 2); const size_t o = (size_t)tl * 4 + (pair & 3);
        const int e = TOPE[o], slot = OFF[e] + RANK[o];
        SLOTOF[o] = slot; TOKOF[slot] = tl; GATEOF[slot] = TOPG[o];
#pragma unroll 4
        for (int p = 0; p < 64; ++p) {
            const int sp = __builtin_amdgcn_readlane(slot, p), tp = chunk * 128 + ((wave * 64 + p) >> 2);
            *(u32x4*)(XB + (size_t)sp * 1024 + 16 * lane) = *(const u32x4*)(H8 + (size_t)tp * 1024 + 16 * lane);
        }
    }
    for (int e = F.bid; e < 32; e += F.G) {
        const int s0 = OFF[e] + CNTL[e], s1 = OFF[e + 1];
        for (int s = s0 + wave; s < s1; s += 8) { if (lane == 0) { TOKOF[s] = 0; GATEOF[s] = 0.f; }
            *(u32x4*)(XB + (size_t)s * 1024 + 16 * lane) = (u32x4){0u, 0u, 0u, 0u}; }
    }
}

#ifndef MK_SPLIT
#define MK_SPLIT 0
#endif
constexpr int NPHASE = 2 + 11 * DEPTH;
struct Args { const void* in[23]; float* out; unsigned char* ws; int ph_lo, ph_hi; };
static_assert(sizeof(Args) == 25 * 8 + 8, "Args has no padding");


#ifndef PH_ENABLE
#define PH_ENABLE 0xFFFF
#endif
#define IN(k) (lo <= (k) && (k) < hi)
#define EN(j) (((PH_ENABLE) >> (j)) & 1)
#ifndef STAG_G1
#define STAG_G1 0
#endif
#ifndef STAG_G3
#define STAG_G3 0
#endif
#ifndef STAG_G4
#define STAG_G4 0
#endif
#ifndef STAG_M2
#define STAG_M2 0
#endif
#ifndef DUP_MASK
#define DUP_MASK 0
#endif
#define NREP(j) ((((DUP_MASK) >> (j)) & 1) ? 2 : 1)
#define SEAM(k) do { if (!MK_SPLIT && (k) + 1 < hi) { XcdBarrier bar_; bar_.bar = F.ctl + CW_BAR; bar_.x = xb_xcc_id(); bar_.st = (volatile LAS unsigned*)((LAS unsigned char*)lds_raw + MISC_OFF) + 8; xcd_barrier(bar_, F.tid); } } while (0)
DI void layer_phases(const int l, const int lo, const int hi, const int wave0) {
        const int pb = 2 + 11 * l;
        if (EN(2) && IN(pb + 0)) { const Frame F = make_frame(wave0);
            stagger(F, STAG_G1);
            { int kb8 = 1024; asm volatile("" : "+s"(kb8));
              SchedPlain S; S.o.init(T_TOK / 256, G1_F8_COLS / 256, F.G, F.bid); S.A = (const char*)WSP(unsigned char, WS_HG8); S.B = (const char*)(WSP(unsigned char, WS_WIN) + (size_t)l * NP * 2048); S.tstep = (size_t)256 * 1024;
              EpiStoreBf16N E{WSP(bf16_t, WS_P), NP, 0};
#ifdef PROBE_NOSTORE
              _Pragma("unroll") for (int rep = 0; rep < NREP(2); ++rep) { E.skip = (rep + 1 < NREP(2)); pg8::gemm_phase_f8<EpiStoreBf16N, SchedPlain>(F.lds, F.tid, kb8, S, E); } }
#else
              _Pragma("unroll") for (int rep = 0; rep < NREP(2) + NREP(14) - 1; ++rep) pg8::gemm_phase_f8<EpiStoreBf16N, SchedPlain>(F.lds, F.tid, kb8, S, E); }
#endif
            { int tid2 = F.tid; asm volatile("" : "+v"(tid2));
              SchedPlain S; S.o.init(T_TOK / 256, (NP - G1_F8_COLS) / 256, F.G, F.bid); S.A = (const char*)WSP(bf16_t, WS_H); S.B = (const char*)(WSP(bf16_t, WS_WIN) + (size_t)l * NP * 1024 + (size_t)G1_F8_COLS * 1024); S.tstep = (size_t)256 * 1024 * 2;
              EpiStoreBf16 E{WSP(bf16_t, WS_P), NP, G1_F8_COLS};
#ifdef PROBE_NOSTORE
              _Pragma("unroll") for (int rep = 0; rep < NREP(2); ++rep) { E.skip = (rep + 1 < NREP(2)); pg8::gemm_phase<EpiStoreBf16, SchedPlain>(F.lds, tid2, 1024, S, E); } }
#else
              _Pragma("unroll") for (int rep = 0; rep < NREP(2) + NREP(15) - 1; ++rep) pg8::gemm_phase<EpiStoreBf16, SchedPlain>(F.lds, tid2, 1024, S, E); }
#endif
            SEAM(pb + 0);
        }
        if (EN(3) && IN(pb + 1)) { const Frame F = make_frame(wave0); _Pragma("unroll") for (int rep = 0; rep < NREP(3); ++rep) phase_post(F, l); SEAM(pb + 1); }
        if (EN(4) && IN(pb + 2)) { const Frame F = make_frame(wave0);
            int k256 = 256; asm volatile("" : "+s"(k256));
            { SchedPlain S; S.o.init(T_TOK / 256, 3, F.G, F.bid); S.A = (const char*)WSP(bf16_t, WS_CQ); S.B = (const char*)(WSP(bf16_t, WS_WUQ) + (size_t)l * 768 * 256); S.tstep = (size_t)256 * 256 * 2;
              EpiStoreBf16 E{WSP(bf16_t, WS_QA), 768};
              pg8::gemm_phase<EpiStoreBf16, SchedPlain>(F.lds, F.tid, k256, S, E); }
            { int tid2 = F.tid; asm volatile("" : "+v"(tid2));
              SchedPlain S; S.o.init(T_TOK / 256, 4, F.G, F.bid); S.A = (const char*)WSP(bf16_t, WS_CKV); S.B = (const char*)(WSP(bf16_t, WS_WUKV) + (size_t)l * 1024 * 256); S.tstep = (size_t)256 * 256 * 2;
              EpiStoreBf16 E{WSP(bf16_t, WS_KV), 1024};
              pg8::gemm_phase<EpiStoreBf16, SchedPlain>(F.lds, tid2, k256, S, E); }
            SEAM(pb + 2);
        }
        if (EN(5) && IN(pb + 3)) { const Frame F = make_frame(wave0); phase_attention(F, NREP(5), NREP(13)); SEAM(pb + 3); }
        if (EN(6) && IN(pb + 4)) { const Frame F = make_frame(wave0);
            stagger(F, STAG_G3);
            SchedBranch S; S.o.init(T_TOK / 256, 4, F.G, F.bid); S.A = (const char*)WSP(bf16_t, WS_O3); S.B = (const char*)(WSP(bf16_t, WS_WB) + (size_t)l * 3 * 1024 * 512); S.tstep = (size_t)256 * 512 * 2; S.aslab = (size_t)T_TOK * 512 * 2;
            EpiBranchGate E{WSP(bf16_t, WS_GY), WSP(bf16_t, WS_P), KIN_b_gate + l * 3072};
            _Pragma("unroll") for (int rep = 0; rep < NREP(6); ++rep) pg8::gemm_phase<EpiBranchGate, SchedBranch>(F.lds, F.tid, 512, S, E);
            SEAM(pb + 4);
        }
        if (EN(7) && IN(pb + 5)) { const Frame F = make_frame(wave0);
            stagger(F, STAG_G4);
            SchedPlain S; S.o.init(T_TOK / 256, 4, F.G, F.bid); S.A = (const char*)WSP(bf16_t, WS_GY); S.B = (const char*)(WSP(bf16_t, WS_WOUT) + (size_t)l * 1024 * 1024); S.tstep = (size_t)256 * 1024 * 2;
            EpiResidual E{l == 0 ? KIN_x : WSP(float, WS_X1), WSP(float, WS_X1), WSP(float, WS_MOD) + (size_t)l * 16 * 6144 + 2 * 1024};
            _Pragma("unroll") for (int rep = 0; rep < NREP(7); ++rep) if (rep == 0 || l == 0) pg8::gemm_phase<EpiResidual, SchedPlain>(F.lds, F.tid, 1024, S, E);
            SEAM(pb + 5);
        }
        if (EN(8) && IN(pb + 6)) { const Frame F = make_frame(wave0); phase_router(F, l, l); if (NREP(8) == 2) phase_router(F, l, l + 2); SEAM(pb + 6); }
        if (EN(9) && IN(pb + 7)) { const Frame F = make_frame(wave0); _Pragma("unroll") for (int rep = 0; rep < NREP(9); ++rep) phase_scatter(F, l); SEAM(pb + 7); }
        if (EN(10) && IN(pb + 8)) { const Frame F = make_frame(wave0);
            const int ntiles = moe_offsets(F, l); int kb8 = 1024; asm volatile("" : "+s"(kb8));
            SchedMoe S; S.o.init(ntiles, 8, F.G, F.bid); S.A = (const char*)WSP(unsigned char, WS_XB); S.B = (const char*)(WSP(unsigned char, WS_W1) + (size_t)l * 32 * 2048 * 1024); S.eslab = 2048u * 1024u;
            S.texp = (const LAS int*)(F.lds + MOE_TEXP);
#if M2_F8
            EpiSwiglu8 E{WSP(unsigned char, WS_ACT), KIN_b1 + (size_t)l * 32 * 2048, (const LAS int*)(F.lds + MOE_TEXP)};
#else
            EpiSwiglu E{WSP(bf16_t, WS_ACT), KIN_b1 + (size_t)l * 32 * 2048, (const LAS int*)(F.lds + MOE_TEXP)};
#endif
            _Pragma("unroll") for (int rep = 0; rep < NREP(10); ++rep)
#if M2_F8
#ifdef PROBE_M1
            { E.skip = (rep + 1 < NREP(10)) ? PROBE_M1 : 0; pg8::gemm_phase_f8<EpiSwiglu8, SchedMoe>(F.lds, F.tid, kb8, S, E); }
#else
            pg8::gemm_phase_f8<EpiSwiglu8, SchedMoe>(F.lds, F.tid, kb8, S, E);
#endif
#else
            pg8::gemm_phase_f8<EpiSwiglu, SchedMoe>(F.lds, F.tid, kb8, S, E);
#endif

            SEAM(pb + 8);
        }
        if (EN(11) && IN(pb + 9)) { const Frame F = make_frame(wave0);
            const int ntiles = moe_offsets(F, l); int kb8 = 1024; asm volatile("" : "+s"(kb8));
            stagger(F, STAG_M2);
#if M2_F8
            SchedMoe S; S.o.init(ntiles, 4, F.G, F.bid); S.A = (const char*)WSP(unsigned char, WS_ACT); S.B = (const char*)(WSP(unsigned char, WS_W2) + (size_t)l * 32 * 1024 * 1024); S.eslab = 1024u * 1024u;
            S.texp = (const LAS int*)(F.lds + MOE_TEXP);
            EpiMoeOut E{WSP(bf16_t, WS_Y), KIN_b2 + (size_t)l * 32 * 1024, (const float*)(F.ws + WS_ROUTE + RT_GATEOF), (const LAS int*)(F.lds + MOE_TEXP)};
            _Pragma("unroll") for (int rep = 0; rep < NREP(11); ++rep) pg8::gemm_phase_f8<EpiMoeOut, SchedMoe>(F.lds, F.tid, kb8, S, E);
#else
            SchedMoeB S; S.o.init(ntiles, 4, F.G, F.bid); S.A = (const char*)WSP(bf16_t, WS_ACT); S.B = (const char*)(WSP(bf16_t, WS_W2) + (size_t)l * 32 * 1024 * 1024); S.eslab = 1024u * 1024u * 2u;
            S.texp = (const LAS int*)(F.lds + MOE_TEXP);
            EpiMoeOut E{WSP(bf16_t, WS_Y), KIN_b2 + (size_t)l * 32 * 1024, (const float*)(F.ws + WS_ROUTE + RT_GATEOF), (const LAS int*)(F.lds + MOE_TEXP)};
            _Pragma("unroll") for (int rep = 0; rep < NREP(11); ++rep) pg8::gemm_phase<EpiMoeOut, SchedMoeB>(F.lds, F.tid, kb8, S, E);
#endif
            SEAM(pb + 9);
        }
        if (EN(12) && IN(pb + 10)) { const Frame F = make_frame(wave0);
            const bool last = (l == DEPTH - 1);
            _Pragma("unroll") for (int rep = 0; rep < NREP(12); ++rep) if (rep == 0 || last) phase_norm(F, WSP(float, WS_X1), WSP(float, WS_X1), true, !last, last, l + 1 < DEPTH ? l + 1 : 0, l);
            SEAM(pb + 10);
        }
}
__global__ void __launch_bounds__(512, 2) fwd_kernel(Args args) {
    const int wave0 = __builtin_amdgcn_readfirstlane(threadIdx.x >> 6);
    {
        volatile LAS unsigned* MISC = (volatile LAS unsigned*)((LAS unsigned char*)lds_raw + MISC_OFF);
        if (threadIdx.x < 32) MISC[threadIdx.x] = 0u;
        __syncthreads();
        if (!MK_SPLIT) { const Frame F = make_frame(wave0); (void)xcd_barrier_post(F.ctl + CW_BAR, MISC + 8, F.tid); }
    }
    const int lo = args.ph_lo, hi = args.ph_hi;
    if (EN(0) && IN(0)) { const Frame F = make_frame(wave0); _Pragma("unroll") for (int rep = 0; rep < NREP(0); ++rep) phase_prologue(F); SEAM(0); }
    if (EN(1) && IN(1)) { const Frame F = make_frame(wave0); _Pragma("unroll") for (int rep = 0; rep < NREP(1); ++rep) phase_norm(F, KIN_x, nullptr, false, false, false, 0, 0); SEAM(1); }
    layer_phases(0, lo, hi, wave0);
    layer_phases(1, lo, hi, wave0);
    static_assert(DEPTH == 2, "two layers");
#undef IN
#undef SEAM
}

extern "C" void kernel_launch(void* const* d_in, const int* in_sizes, int n_in, void* d_out, int out_size, void* d_ws, size_t ws_size, hipStream_t stream) {
    static int grid = 0;
    if (grid == 0) {
        if (n_in != 23 || out_size != T_TOK * D_MODEL || ws_size < WS_END) { fprintf(stderr, "kernel_launch: unexpected problem (n_in %d, out %d, ws %zu)\n", n_in, out_size, ws_size); grid = -1; return; }
        int dev = 0, cus = 0;
        if (hipGetDevice(&dev) != hipSuccess || hipDeviceGetAttribute(&cus, hipDeviceAttributeMultiprocessorCount, dev) != hipSuccess) { grid = -1; return; }
        if (hipFuncSetAttribute((const void*)fwd_kernel, hipFuncAttributeMaxDynamicSharedMemorySize, LDS_BYTES) != hipSuccess) { fprintf(stderr, "kernel_launch: hipFuncSetAttribute failed\n"); grid = -1; return; }
        int per_cu = 0;
        if (hipOccupancyMaxActiveBlocksPerMultiprocessor(&per_cu, (const void*)fwd_kernel, 512, LDS_BYTES) != hipSuccess || per_cu < 1) fprintf(stderr, "kernel_launch: occupancy query says %d\n", per_cu);
        (void)hipGetLastError();
        grid = cus > 256 ? 256 : cus;
    }
    if (grid < 0) return;
    (void)in_sizes;
    if (hipMemsetAsync((char*)d_ws + WS_CTL, 0, CTL_ZERO_BYTES, stream) != hipSuccess) return;
    Args a{};
    for (int i = 0; i < 23; ++i) a.in[i] = d_in[i];
    a.out = (float*)d_out; a.ws = (unsigned char*)d_ws;
#if MK_SPLIT
    for (int p = 0; p < NPHASE; ++p) { a.ph_lo = p; a.ph_hi = p + 1; hipLaunchKernelGGL(fwd_kernel, dim3(grid), dim3(512), LDS_BYTES, stream, a); }
#else
    a.ph_lo = 0; a.ph_hi = NPHASE;
    hipLaunchKernelGGL(fwd_kernel, dim3(grid), dim3(512), LDS_BYTES, stream, a);
#endif
}
```

```cpp
#include <hip/hip_runtime.h>
#include <cstdio>
#include <cstdint>

#ifndef M2_F8
#define M2_F8 1
#endif
#define LAS __attribute__((address_space(3)))
#define GAS __attribute__((address_space(1)))
typedef unsigned short bf16_t;
typedef short bf16x8 __attribute__((ext_vector_type(8)));
typedef short s16x4 __attribute__((ext_vector_type(4)));
typedef float f32x2 __attribute__((ext_vector_type(2)));
typedef float f32x4 __attribute__((ext_vector_type(4)));
typedef float f32x16 __attribute__((ext_vector_type(16)));
typedef unsigned u32x2 __attribute__((ext_vector_type(2)));
typedef unsigned u32x4 __attribute__((ext_vector_type(4)));
#define DI __device__ __forceinline__

constexpr int D_MODEL = 1024, BATCH = 16, SEQ = 2048, T_TOK = BATCH * SEQ, DEPTH = 2;
constexpr float NORM_EPS = 1e-6f;
constexpr int IN_COLS = 6248, NP = 6400;
constexpr int N_EXP = 32, TOP_K = 4, D_EXP = 1024;
constexpr int NSLOT_MAX = T_TOK * TOP_K + N_EXP * 256;
constexpr int PC_GATE = 0, PC_CONV = 3072, PC_DQ = 4608, PC_IQ = 5120, PC_QLAT = 5632, PC_KVLAT = 5888, PC_DKV = 6048, PC_IK = 6176, PC_IW = 6240;
constexpr int OC_QLAT = 0, OC_KVLAT = 256, OC_CONV = 416, OC_DQ = 1952, OC_DKV = 2464, OC_IQ = 2592, OC_IK = 3104, OC_IW = 3168, OC_GATE = 3176;

DI unsigned pk2(float lo, float hi) { typedef __bf16 bf16x2_t __attribute__((ext_vector_type(2))); f32x2 v = {lo, hi}; bf16x2_t b = __builtin_convertvector(v, bf16x2_t); return __builtin_bit_cast(unsigned, b); }
DI float bf_lo(unsigned w) { return __uint_as_float(w << 16); }
DI float bf_hi(unsigned w) { return __uint_as_float(w & 0xffff0000u); }
DI float bf2f(bf16_t h) { return __uint_as_float((unsigned)h << 16); }
DI float wave_sum(float v) {
#pragma unroll
    for (int o = 1; o < 64; o <<= 1) v += __shfl_xor(v, o);
    return v;
}
DI float fast_sigmoid(float x) { return __builtin_amdgcn_rcpf(1.0f + __builtin_amdgcn_exp2f(-1.4426950408889634f * x)); }
DI unsigned pk4_fp8(float a, float b, float c, float d) { int w = __builtin_amdgcn_cvt_pk_fp8_f32(a, b, 0, false); w = __builtin_amdgcn_cvt_pk_fp8_f32(c, d, w, true); return (unsigned)w; }
#define LDS_WAIT() asm volatile("s_waitcnt lgkmcnt(0)" ::: "memory")
#define VM_WAIT() asm volatile("s_waitcnt vmcnt(0)" ::: "memory")

namespace pg8 {
DI void glds16_s(unsigned voff, const char* sbase, unsigned lds_dst) { unsigned keep; asm volatile("s_nop 4\n\ts_mov_b32 %0, m0\n\ts_mov_b32 m0, %3\n\ts_nop 0\n\tglobal_load_lds_dwordx4 %1, %2\n\ts_mov_b32 m0, %0" : "=&s"(keep) : "v"(voff), "s"(sbase), "s"(lds_dst) : "memory"); }
DI const char* uni_ptr(const char* p) { const unsigned long long v = (unsigned long long)p; const unsigned lo = __builtin_amdgcn_readfirstlane((unsigned)v), hi = __builtin_amdgcn_readfirstlane((unsigned)(v >> 32)); return (const char*)(GAS const char*)(((unsigned long long)hi << 32) | lo); }
constexpr int BM = 256, BK = 64, HALF = 128, HTB = HALF * BK * 2, STAGE_BYTES = 8 * HTB, NXCD = 8, WGM = 8;
__host__ __device__ __forceinline__ int lds_byte(int r, int c) { const int st = (r >> 4) * 2 + (c >> 5), rr = r & 15, cc = c & 31, ob = rr * 64 + cc * 2; return st * 1024 + (ob ^ (((ob >> 9) & 1) << 5)); }
__host__ __device__ __forceinline__ void stage_rc(int b, int& R, int& C) { const int st = b / 1024, sb = b % 1024, swz = sb ^ (((sb >> 9) & 1) << 5); R = (st >> 1) * 16 + swz / 64; C = (st & 1) * 32 + (swz % 64) / 2; }
__host__ __device__ __forceinline__ int perm32(int rho) { const int n = rho >> 4, i = rho & 15; return 8 * (i >> 2) + 4 * n + (i & 3); }
struct Unit { int pm, pn; };
struct StaticOrder {
    int nM, nN, nwg, G, c;
    DI void init(int nM_, int nN_, int G_, int c_) { nM = nM_; nN = nN_; nwg = nM * nN; G = G_; c = c_; }
    DI bool next(int i, Unit& u) const {
        const long L = (long)i * G + c; if (L >= nwg) return false;
        int wgid = (int)L; { const int q = nwg / NXCD, r = nwg % NXCD, xcd = wgid % NXCD, off = wgid / NXCD; wgid = (xcd < r ? xcd * (q + 1) : r * (q + 1) + (xcd - r) * q) + off; }
        const int nig = WGM * nN, gid = wgid / nig, fm = gid * WGM, gsz = (nM - fm) < WGM ? (nM - fm) : WGM;
        u.pm = fm + ((wgid % nig) % gsz); u.pn = (wgid % nig) / gsz; return true;
    }
};

template <class Epi, class Sched, bool ALIGN_EPI = true, bool SP2 = true>
DI void gemm_phase(LAS unsigned char* lds, const int tid, const int K, const Sched& S, const Epi& E) {
    const int wid = __builtin_amdgcn_readfirstlane(tid >> 6), lane = tid & 63, wr = wid >> 2, wc = wid & 3, fr = lane & 15, fq = lane >> 4;
    const int nt = K / BK;
    unsigned voffA[2], voffB[2];
#pragma unroll
    for (int i = 0; i < 2; ++i) { int R, C; stage_rc(tid * 16 + i * 8192, R, C); const int Rb = Epi::PERM ? ((R & ~31) + perm32(R & 31)) : R;
        voffA[i] = (unsigned)(R * K + C) * 2u; voffB[i] = (unsigned)(Rb * K + C) * 2u; }
    const size_t kstep = (size_t)(BK * 2);
    const size_t hstep = (size_t)HALF * K * 2;
    const unsigned ldsw = (unsigned)wid * 1024u; const unsigned ldsb = (unsigned)(unsigned long long)(lds);
    const int aoff = lds_byte(wr * 64 + fr, fq * 8), boff = lds_byte(wc * 32 + fr, fq * 8);
#define PG8_SA(b, h) (((b) * 2 + (h)) * HTB)
#define PG8_SB(b, h) ((4 + (b) * 2 + (h)) * HTB)
#define PG8_STAGE(bufoff, gbase, voff) do { _Pragma("unroll") for (int _i = 0; _i < 2; ++_i) \
        glds16_s((voff)[_i], (const char*)(gbase), ldsb + (unsigned)(bufoff) + ldsw + (unsigned)(_i * 8192)); } while (0)
#define PG8_LDA(dst, b, h) do { int a_ = aoff; asm volatile("" : "+v"(a_)); _Pragma("unroll") for (int m = 0; m < 4; ++m) _Pragma("unroll") for (int k = 0; k < 2; ++k) dst[m][k] = *(const LAS bf16x8*)(lds + PG8_SA(b, h) + a_ + m * 2048 + k * 1024); } while (0)
#define PG8_LDB(dst, b, h) do { int b_ = boff; asm volatile("" : "+v"(b_)); _Pragma("unroll") for (int n = 0; n < 2; ++n) _Pragma("unroll") for (int k = 0; k < 2; ++k) dst[n][k] = *(const LAS bf16x8*)(lds + PG8_SB(b, h) + b_ + n * 2048 + k * 1024); } while (0)
#define PG8_MMA(ai, bj, At, Bt) do { __builtin_amdgcn_s_setprio(1); _Pragma("unroll") for (int m = 0; m < 4; ++m) _Pragma("unroll") for (int n = 0; n < 2; ++n) _Pragma("unroll") for (int k = 0; k < 2; ++k) \
        acc[ai][bj][m][n] = __builtin_amdgcn_mfma_f32_16x16x32_bf16(Bt[n][k], At[m][k], acc[ai][bj][m][n], 0, 0, 0); __builtin_amdgcn_s_setprio(0); } while (0)
#define PG8_WAIT_V(n) asm volatile("s_waitcnt vmcnt(" #n ")" ::: "memory")
#define PG8_WAIT_L(n) asm volatile("s_waitcnt lgkmcnt(" #n ")" ::: "memory")
#define PG8_BAR __builtin_amdgcn_s_barrier()
#define PG8_SCHED __builtin_amdgcn_sched_barrier(0)
    Unit cur, nxt; int ui = 0;
    if (!S.next(0, cur)) return;
    float zf_ = 0.f; asm volatile("" : "+v"(zf_));
    f32x4 acc[2][2][4][2];
#pragma unroll
    for (int a = 0; a < 2; ++a)
#pragma unroll
        for (int b = 0; b < 2; ++b)
#pragma unroll
            for (int m = 0; m < 4; ++m)
#pragma unroll
                for (int n = 0; n < 2; ++n) acc[a][b][m][n] = (f32x4){zf_, zf_, zf_, zf_};
    bf16x8 At[4][2], B0[2][2], B1[2][2];
    const char* cA = uni_ptr(S.abase(cur)); const char* cB = uni_ptr(S.bbase(cur));
    if constexpr (SP2) {
        PG8_STAGE(PG8_SB(0, 0), cB, voffB); PG8_STAGE(PG8_SB(0, 1), cB + hstep, voffB); PG8_STAGE(PG8_SA(0, 0), cA, voffA); PG8_STAGE(PG8_SA(0, 1), cA + hstep, voffA);
        if (wr == 1) PG8_BAR;
        PG8_WAIT_V(2); PG8_BAR;
        PG8_STAGE(PG8_SB(1, 0), cB + kstep, voffB); PG8_STAGE(PG8_SA(1, 0), cA + kstep, voffA); PG8_STAGE(PG8_SB(1, 1), cB + hstep + kstep, voffB);
        PG8_WAIT_V(6); PG8_BAR;
    } else {
        PG8_STAGE(PG8_SB(0, 0), cB, voffB); PG8_STAGE(PG8_SA(0, 0), cA, voffA); PG8_STAGE(PG8_SB(0, 1), cB + hstep, voffB); PG8_STAGE(PG8_SA(0, 1), cA + hstep, voffA);
        if (wr == 1) PG8_BAR;
        PG8_WAIT_V(4); PG8_BAR;
        PG8_STAGE(PG8_SB(1, 0), cB + kstep, voffB); PG8_STAGE(PG8_SA(1, 0), cA + kstep, voffA); PG8_STAGE(PG8_SB(1, 1), cB + hstep + kstep, voffB);
        PG8_WAIT_V(6); PG8_BAR;
    }
    for (;;) {
        const bool has_next = S.next(ui + 1, nxt);
        const char* nA = has_next ? uni_ptr(S.abase(nxt)) : cA; const char* nB = has_next ? uni_ptr(S.bbase(nxt)) : cB;
        for (int t = 0; t < nt; t += 2) {
            const bool last = (t == nt - 2);
            const char* a1 = cA + (size_t)(t + 1) * kstep;
            const char* a2 = last ? nA : cA + (size_t)(t + 2) * kstep; const char* b2 = last ? nB : cB + (size_t)(t + 2) * kstep;
            const char* a3 = a2 + kstep; const char* b3 = b2 + kstep;
            if constexpr (SP2) {
            PG8_LDB(B0, 0, 0); PG8_LDB(B1, 0, 1); PG8_SCHED; PG8_LDA(At, 0, 0); PG8_STAGE(PG8_SA(1, 1), a1 + hstep, voffA);
            PG8_WAIT_V(8); PG8_WAIT_L(0); PG8_BAR; PG8_MMA(0, 0, At, B0); PG8_MMA(0, 1, At, B1); PG8_BAR; PG8_SCHED;
            PG8_LDA(At, 0, 1); PG8_STAGE(PG8_SB(0, 0), b2, voffB); PG8_STAGE(PG8_SB(0, 1), b2 + hstep, voffB); PG8_STAGE(PG8_SA(0, 0), a2, voffA);
            PG8_WAIT_V(8); PG8_WAIT_L(0); PG8_BAR; PG8_MMA(1, 0, At, B0); PG8_MMA(1, 1, At, B1); PG8_BAR; PG8_SCHED;
            PG8_LDB(B0, 1, 0); PG8_LDB(B1, 1, 1); PG8_SCHED; PG8_LDA(At, 1, 0); PG8_STAGE(PG8_SA(0, 1), a2 + hstep, voffA);
            PG8_WAIT_V(8); PG8_WAIT_L(0); PG8_BAR; PG8_MMA(0, 0, At, B0); PG8_MMA(0, 1, At, B1); PG8_BAR; PG8_SCHED;
            PG8_LDA(At, 1, 1); PG8_STAGE(PG8_SB(1, 0), b3, voffB); PG8_STAGE(PG8_SB(1, 1), b3 + hstep, voffB); PG8_STAGE(PG8_SA(1, 0), a3, voffA);
            PG8_WAIT_V(8); PG8_WAIT_L(0); PG8_BAR; PG8_MMA(1, 0, At, B0); PG8_MMA(1, 1, At, B1); PG8_BAR; PG8_SCHED;
            } else {
            PG8_LDB(B0, 0, 0); PG8_SCHED; PG8_LDA(At, 0, 0); PG8_STAGE(PG8_SA(1, 1), a1 + hstep, voffA);
            PG8_WAIT_L(8); PG8_BAR; PG8_WAIT_L(0); PG8_MMA(0, 0, At, B0); PG8_BAR; PG8_SCHED;
            PG8_LDB(B1, 0, 1); PG8_STAGE(PG8_SB(0, 0), b2, voffB);
            PG8_BAR; PG8_WAIT_L(0); PG8_MMA(0, 1, At, B1); PG8_BAR;
            PG8_LDA(At, 0, 1); PG8_STAGE(PG8_SA(0, 0), a2, voffA);
            PG8_BAR; PG8_WAIT_L(0); PG8_MMA(1, 0, At, B0); PG8_BAR; PG8_SCHED;
            PG8_STAGE(PG8_SB(0, 1), b2 + hstep, voffB);
            PG8_WAIT_V(6); PG8_BAR; PG8_MMA(1, 1, At, B1); PG8_BAR;
            PG8_LDB(B0, 1, 0); PG8_SCHED; PG8_LDA(At, 1, 0); PG8_STAGE(PG8_SA(0, 1), a2 + hstep, voffA);
            PG8_WAIT_L(8); PG8_BAR; PG8_WAIT_L(0); PG8_MMA(0, 0, At, B0); PG8_BAR; PG8_SCHED;
            PG8_LDB(B1, 1, 1); PG8_STAGE(PG8_SB(1, 0), b3, voffB);
            PG8_BAR; PG8_WAIT_L(0); PG8_MMA(0, 1, At, B1); PG8_BAR;
            PG8_LDA(At, 1, 1); PG8_STAGE(PG8_SA(1, 0), a3, voffA);
            PG8_BAR; PG8_WAIT_L(0); PG8_MMA(1, 0, At, B0); PG8_BAR; PG8_SCHED;
            PG8_STAGE(PG8_SB(1, 1), b3 + hstep, voffB);
            PG8_WAIT_V(6); PG8_BAR; PG8_MMA(1, 1, At, B1); PG8_BAR;
            }
        }
        if constexpr (ALIGN_EPI) { if (wr == 0) PG8_BAR; }
        E(acc, cur, wr, wc, fr, fq);
        if (!has_next) break;
#pragma unroll
        for (int a = 0; a < 2; ++a)
#pragma unroll
            for (int b = 0; b < 2; ++b)
#pragma unroll
                for (int m = 0; m < 4; ++m)
#pragma unroll
                    for (int n = 0; n < 2; ++n) acc[a][b][m][n] = (f32x4){zf_, zf_, zf_, zf_};
        cur = nxt; cA = nA; cB = nB; ++ui;
        if constexpr (ALIGN_EPI) { if (wr == 1) PG8_BAR; }
    }
    PG8_WAIT_V(0);
    if constexpr (!ALIGN_EPI) { if (wr == 0) PG8_BAR; }
    PG8_BAR;
#undef PG8_SA
#undef PG8_SB
#undef PG8_STAGE
#undef PG8_LDA
#undef PG8_LDB
#undef PG8_MMA
#undef PG8_WAIT_V
#undef PG8_WAIT_L
#undef PG8_BAR
#undef PG8_SCHED
}
typedef int v8i __attribute__((ext_vector_type(8)));
template <class Epi, class Sched, bool ALIGN_EPI = true, bool SP2 = true>
DI void gemm_phase_f8(LAS unsigned char* lds, const int tid, const int KB, const Sched& S, const Epi& E) {
    const int wid = __builtin_amdgcn_readfirstlane(tid >> 6), lane = tid & 63, wr = wid >> 2, wc = wid & 3, fr = lane & 15, fq = lane >> 4;
    const int nt = KB / 128;
    unsigned voffA[2], voffB[2];
#pragma unroll
    for (int i = 0; i < 2; ++i) { int R, C; stage_rc(tid * 16 + i * 8192, R, C); const int Rb = Epi::PERM ? ((R & ~31) + perm32(R & 31)) : R;
        voffA[i] = (unsigned)(R * KB + 2 * C); voffB[i] = (unsigned)(Rb * KB + 2 * C); }
    const size_t kstep = (size_t)(BK * 2);
    const size_t hstep = (size_t)HALF * KB;
    const unsigned ldsw = (unsigned)wid * 1024u; const unsigned ldsb = (unsigned)(unsigned long long)(lds);
    const int aoff = lds_byte(wr * 64 + fr, fq * 16), boff = lds_byte(wc * 32 + fr, fq * 16);
#define PG8_SA(b, h) (((b) * 2 + (h)) * HTB)
#define PG8_SB(b, h) ((4 + (b) * 2 + (h)) * HTB)
#define PG8_STAGE(bufoff, gbase, voff) do { _Pragma("unroll") for (int _i = 0; _i < 2; ++_i) \
        glds16_s((voff)[_i], (const char*)(gbase), ldsb + (unsigned)(bufoff) + ldsw + (unsigned)(_i * 8192)); } while (0)
#define PG8_LDA(dst, b, h) do { int a_ = aoff; asm volatile("" : "+v"(a_)); _Pragma("unroll") for (int m = 0; m < 4; ++m) dst[m] = *(const LAS v8i*)(lds + PG8_SA(b, h) + a_ + m * 2048); } while (0)
#define PG8_LDB(dst, b, h) do { int b_ = boff; asm volatile("" : "+v"(b_)); _Pragma("unroll") for (int n = 0; n < 2; ++n) dst[n] = *(const LAS v8i*)(lds + PG8_SB(b, h) + b_ + n * 2048); } while (0)
#define PG8_MMA(ai, bj, At, Bt) do { __builtin_amdgcn_s_setprio(1); _Pragma("unroll") for (int m = 0; m < 4; ++m) _Pragma("unroll") for (int n = 0; n < 2; ++n) \
        acc[ai][bj][m][n] = __builtin_amdgcn_mfma_scale_f32_16x16x128_f8f6f4(Bt[n], At[m], acc[ai][bj][m][n], 0, 0, 0, sc8, 0, sc8); __builtin_amdgcn_s_setprio(0); } while (0)
#define PG8_WAIT_V(n) asm volatile("s_waitcnt vmcnt(" #n ")" ::: "memory")
#define PG8_WAIT_L(n) asm volatile("s_waitcnt lgkmcnt(" #n ")" ::: "memory")
#define PG8_BAR __builtin_amdgcn_s_barrier()
#define PG8_SCHED __builtin_amdgcn_sched_barrier(0)
    Unit cur, nxt; int ui = 0;
    if (!S.next(0, cur)) return;
    int sc8 = 0x7c7c7c7c; asm volatile("" : "+v"(sc8));
    float zf_ = 0.f; asm volatile("" : "+v"(zf_));
    f32x4 acc[2][2][4][2];
#pragma unroll
    for (int a = 0; a < 2; ++a)
#pragma unroll
        for (int b = 0; b < 2; ++b)
#pragma unroll
            for (int m = 0; m < 4; ++m)
#pragma unroll
                for (int n = 0; n < 2; ++n) acc[a][b][m][n] = (f32x4){zf_, zf_, zf_, zf_};
    v8i At[4], B0[2], B1[2];
    const char* cA = uni_ptr(S.abase(cur)); const char* cB = uni_ptr(S.bbase(cur));
    if constexpr (SP2) {
        PG8_STAGE(PG8_SB(0, 0), cB, voffB); PG8_STAGE(PG8_SB(0, 1), cB + hstep, voffB); PG8_STAGE(PG8_SA(0, 0), cA, voffA); PG8_STAGE(PG8_SA(0, 1), cA + hstep, voffA);
        if (wr == 1) PG8_BAR;
        PG8_WAIT_V(2); PG8_BAR;
        PG8_STAGE(PG8_SB(1, 0), cB + kstep, voffB); PG8_STAGE(PG8_SA(1, 0), cA + kstep, voffA); PG8_STAGE(PG8_SB(1, 1), cB + hstep + kstep, voffB);
        PG8_WAIT_V(6); PG8_BAR;
    } else {
        PG8_STAGE(PG8_SB(0, 0), cB, voffB); PG8_STAGE(PG8_SA(0, 0), cA, voffA); PG8_STAGE(PG8_SB(0, 1), cB + hstep, voffB); PG8_STAGE(PG8_SA(0, 1), cA + hstep, voffA);
        if (wr == 1) PG8_BAR;
        PG8_WAIT_V(4); PG8_BAR;
        PG8_STAGE(PG8_SB(1, 0), cB + kstep, voffB); PG8_STAGE(PG8_SA(1, 0), cA + kstep, voffA); PG8_STAGE(PG8_SB(1, 1), cB + hstep + kstep, voffB);
        PG8_WAIT_V(6); PG8_BAR;
    }
    for (;;) {
        const bool has_next = S.next(ui + 1, nxt);
        const char* nA = has_next ? uni_ptr(S.abase(nxt)) : cA; const char* nB = has_next ? uni_ptr(S.bbase(nxt)) : cB;
        for (int t = 0; t < nt; t += 2) {
            const bool last = (t == nt - 2);
            const char* a1 = cA + (size_t)(t + 1) * kstep;
            const char* a2 = last ? nA : cA + (size_t)(t + 2) * kstep; const char* b2 = last ? nB : cB + (size_t)(t + 2) * kstep;
            const char* a3 = a2 + kstep; const char* b3 = b2 + kstep;
            if constexpr (SP2) {
            PG8_LDB(B0, 0, 0); PG8_LDB(B1, 0, 1); PG8_SCHED; PG8_LDA(At, 0, 0); PG8_STAGE(PG8_SA(1, 1), a1 + hstep, voffA);
            PG8_WAIT_V(8); PG8_WAIT_L(0); PG8_BAR; PG8_MMA(0, 0, At, B0); PG8_MMA(0, 1, At, B1); PG8_BAR; PG8_SCHED;
            PG8_LDA(At, 0, 1); PG8_STAGE(PG8_SB(0, 0), b2, voffB); PG8_STAGE(PG8_SB(0, 1), b2 + hstep, voffB); PG8_STAGE(PG8_SA(0, 0), a2, voffA);
            PG8_WAIT_V(8); PG8_WAIT_L(0); PG8_BAR; PG8_MMA(1, 0, At, B0); PG8_MMA(1, 1, At, B1); PG8_BAR; PG8_SCHED;
            PG8_LDB(B0, 1, 0); PG8_LDB(B1, 1, 1); PG8_SCHED; PG8_LDA(At, 1, 0); PG8_STAGE(PG8_SA(0, 1), a2 + hstep, voffA);
            PG8_WAIT_V(8); PG8_WAIT_L(0); PG8_BAR; PG8_MMA(0, 0, At, B0); PG8_MMA(0, 1, At, B1); PG8_BAR; PG8_SCHED;
            PG8_LDA(At, 1, 1); PG8_STAGE(PG8_SB(1, 0), b3, voffB); PG8_STAGE(PG8_SB(1, 1), b3 + hstep, voffB); PG8_STAGE(PG8_SA(1, 0), a3, voffA);
            PG8_WAIT_V(8); PG8_WAIT_L(0); PG8_BAR; PG8_MMA(1, 0, At, B0); PG8_MMA(1, 1, At, B1); PG8_BAR; PG8_SCHED;
            } else {
            PG8_LDB(B0, 0, 0); PG8_SCHED; PG8_LDA(At, 0, 0); PG8_STAGE(PG8_SA(1, 1), a1 + hstep, voffA);
            PG8_WAIT_L(8); PG8_BAR; PG8_WAIT_L(0); PG8_MMA(0, 0, At, B0); PG8_BAR; PG8_SCHED;
            PG8_LDB(B1, 0, 1); PG8_STAGE(PG8_SB(0, 0), b2, voffB);
            PG8_BAR; PG8_WAIT_L(0); PG8_MMA(0, 1, At, B1); PG8_BAR;
            PG8_LDA(At, 0, 1); PG8_STAGE(PG8_SA(0, 0), a2, voffA);
            PG8_BAR; PG8_WAIT_L(0); PG8_MMA(1, 0, At, B0); PG8_BAR; PG8_SCHED;
            PG8_STAGE(PG8_SB(0, 1), b2 + hstep, voffB);
            PG8_WAIT_V(6); PG8_BAR; PG8_MMA(1, 1, At, B1); PG8_BAR;
            PG8_LDB(B0, 1, 0); PG8_SCHED; PG8_LDA(At, 1, 0); PG8_STAGE(PG8_SA(0, 1), a2 + hstep, voffA);
            PG8_WAIT_L(8); PG8_BAR; PG8_WAIT_L(0); PG8_MMA(0, 0, At, B0); PG8_BAR; PG8_SCHED;
            PG8_LDB(B1, 1, 1); PG8_STAGE(PG8_SB(1, 0), b3, voffB);
            PG8_BAR; PG8_WAIT_L(0); PG8_MMA(0, 1, At, B1); PG8_BAR;
            PG8_LDA(At, 1, 1); PG8_STAGE(PG8_SA(1, 0), a3, voffA);
            PG8_BAR; PG8_WAIT_L(0); PG8_MMA(1, 0, At, B0); PG8_BAR; PG8_SCHED;
            PG8_STAGE(PG8_SB(1, 1), b3 + hstep, voffB);
            PG8_WAIT_V(6); PG8_BAR; PG8_MMA(1, 1, At, B1); PG8_BAR;
            }
        }
        if constexpr (ALIGN_EPI) { if (wr == 0) PG8_BAR; }
        asm volatile("" ::: "memory"); __builtin_amdgcn_sched_barrier(0);
        { int t2_ = tid; asm volatile("" : "+v"(t2_)); const int w2_ = __builtin_amdgcn_readfirstlane(t2_ >> 6), l2_ = t2_ & 63; E(acc, cur, w2_ >> 2, w2_ & 3, l2_ & 15, l2_ >> 4); }
        if (!has_next) break;
#pragma unroll
        for (int a = 0; a < 2; ++a)
#pragma unroll
            for (int b = 0; b < 2; ++b)
#pragma unroll
                for (int m = 0; m < 4; ++m)
#pragma unroll
                    for (int n = 0; n < 2; ++n) acc[a][b][m][n] = (f32x4){zf_, zf_, zf_, zf_};
        cur = nxt; cA = nA; cB = nB; ++ui;
        if constexpr (ALIGN_EPI) { if (wr == 1) PG8_BAR; }
    }
    PG8_WAIT_V(0);
    if constexpr (!ALIGN_EPI) { if (wr == 0) PG8_BAR; }
    PG8_BAR;
#undef PG8_SA
#undef PG8_SB
#undef PG8_STAGE
#undef PG8_LDA
#undef PG8_LDB
#undef PG8_MMA
#undef PG8_WAIT_V
#undef PG8_WAIT_L
#undef PG8_BAR
#undef PG8_SCHED
}
}

struct SchedPlain {
    pg8::StaticOrder o; const char* A; const char* B; size_t tstep;
    DI bool next(int i, pg8::Unit& u) const { return o.next(i, u); }
    DI const char* abase(const pg8::Unit& u) const { return A + (size_t)u.pm * tstep; }
    DI const char* bbase(const pg8::Unit& u) const { return B + (size_t)u.pn * tstep; }
};
struct SchedBranch {
    pg8::StaticOrder o; const char* A; const char* B; size_t tstep, aslab;
    DI bool next(int i, pg8::Unit& u) const { pg8::Unit t; if (!o.next(i / 3, t)) return false; u.pm = t.pm; u.pn = t.pn + 4 * (i % 3); return true; }
    DI const char* abase(const pg8::Unit& u) const { return A + (size_t)(u.pn >> 2) * aslab + (size_t)u.pm * tstep; }
    DI const char* bbase(const pg8::Unit& u) const { return B + (size_t)u.pn * tstep; }
};
struct SchedMoe {
    pg8::StaticOrder o; const char* A; const char* B; unsigned eslab; const LAS int* texp;
    DI bool next(int i, pg8::Unit& u) const { return o.next(i, u); }
    DI const char* abase(const pg8::Unit& u) const { return A + (size_t)u.pm * (256u * 1024u); }
    DI const char* bbase(const pg8::Unit& u) const { return B + (size_t)((unsigned)texp[u.pm] * eslab) + (size_t)u.pn * (256u * 1024u); }
};

struct SchedMoeB {
    pg8::StaticOrder o; const char* A; const char* B; unsigned eslab; const LAS int* texp;
    DI bool next(int i, pg8::Unit& u) const { return o.next(i, u); }
    DI const char* abase(const pg8::Unit& u) const { return A + (size_t)u.pm * (256u * 2048u); }
    DI const char* bbase(const pg8::Unit& u) const { return B + (size_t)((unsigned)texp[u.pm] * eslab) + (size_t)u.pn * (256u * 2048u); }
};

#ifndef EPI_QT
#define EPI_QT 1
#endif
#ifndef EPI_QT_ST
#define EPI_QT_ST 1
#endif
DI int qt_src(int lane) { return (((lane >> 2) + 16 * (lane & 3)) * 4); }
DI f32x4 qt4f(int src4, f32x4 v);
DI u32x4 qt4(int src4, u32x4 w) { u32x4 r; r.x = (unsigned)__builtin_amdgcn_ds_bpermute(src4, (int)w.x); r.y = (unsigned)__builtin_amdgcn_ds_bpermute(src4, (int)w.y); r.z = (unsigned)__builtin_amdgcn_ds_bpermute(src4, (int)w.z); r.w = (unsigned)__builtin_amdgcn_ds_bpermute(src4, (int)w.w); return r; }
DI f32x4 qt4f(int src4, f32x4 v) { return __builtin_bit_cast(f32x4, qt4(src4, __builtin_bit_cast(u32x4, v))); }
struct EpiStoreBf16 {
    static constexpr bool PERM = true;
    bf16_t* O; int ldc; int coff = 0;
#ifdef PROBE_NOSTORE
    bool skip = false;
#endif
    DI void operator()(const f32x4 (&acc)[2][2][4][2], const pg8::Unit& u, int wr, int wc, int fr, int fq) const {
#if EPI_QT_ST
        const int lane = fr + 16 * fq, src4 = qt_src(lane); fr = lane >> 2; fq = lane & 3;
#endif
        const int row0 = u.pm * 256 + wr * 64 + fr, col0 = coff + u.pn * 256 + wc * 32 + 8 * fq;
#pragma unroll
        for (int ai = 0; ai < 2; ++ai)
#pragma unroll
            for (int m = 0; m < 4; ++m) { bf16_t* rowp = O + (size_t)(row0 + ai * 128 + m * 16) * ldc + col0;
#pragma unroll
                for (int bj = 0; bj < 2; ++bj) { const f32x4 v0 = acc[ai][bj][m][0], v1 = acc[ai][bj][m][1];
                    u32x4 w; w.x = pk2(v0[0], v0[1]); w.y = pk2(v0[2], v0[3]); w.z = pk2(v1[0], v1[1]); w.w = pk2(v1[2], v1[3]);
#if EPI_QT_ST
                    w = qt4(src4, w);
#endif
#ifdef PROBE_NOSTORE
                    if (skip) { asm volatile("" :: "v"(w.x), "v"(w.y), "v"(w.z), "v"(w.w)); } else
#endif
                    *(u32x4*)(rowp + bj * 128) = w; } }
    }
};
struct EpiStoreBf16N {
    static constexpr bool PERM = false;
    bf16_t* O; int ldc; int coff = 0;
#ifdef PROBE_NOSTORE
    bool skip = false;
#endif
    DI void operator()(const f32x4 (&acc)[2][2][4][2], const pg8::Unit& u, int wr, int wc, int fr, int fq) const {
#if EPI_QT
#if EPI_QT_ST
        const int lane = fr + 16 * fq, a_ = lane >> 2, b_ = lane & 3, src4 = (a_ + 16 * (((b_ & 1) << 1) | (b_ >> 1))) * 4;
        const int row0 = u.pm * 256 + wr * 64 + a_, col0 = coff + u.pn * 256 + wc * 32 + 8 * b_;
#else
        const int row0 = u.pm * 256 + wr * 64 + fr, col0 = coff + u.pn * 256 + wc * 32 + 8 * (((fq & 1) << 1) | (fq >> 1));
#endif
#pragma unroll
        for (int ai = 0; ai < 2; ++ai)
#pragma unroll
            for (int m = 0; m < 4; ++m) { bf16_t* rowp = O + (size_t)(row0 + ai * 128 + m * 16) * ldc + col0;
#pragma unroll
                for (int bj = 0; bj < 2; ++bj) { const f32x4 v0 = acc[ai][bj][m][0], v1 = acc[ai][bj][m][1];
                    unsigned x0 = pk2(v0[0], v0[1]), y0 = pk2(v0[2], v0[3]), x1 = pk2(v1[0], v1[1]), y1 = pk2(v1[2], v1[3]);
                    { const auto r = __builtin_amdgcn_permlane16_swap(x0, x1, false, false); x0 = r[0]; x1 = r[1]; }
                    { const auto r = __builtin_amdgcn_permlane16_swap(y0, y1, false, false); y0 = r[0]; y1 = r[1]; }
                    u32x4 w; w.x = x0; w.y = y0; w.z = x1; w.w = y1;
#if EPI_QT_ST
                    w = qt4(src4, w);
#endif
#ifdef PROBE_NOSTORE
                    if (skip) { asm volatile("" :: "v"(w.x), "v"(w.y), "v"(w.z), "v"(w.w)); } else
#endif
                    *(u32x4*)(rowp + bj * 128) = w; } }
#else
        const int row0 = u.pm * 256 + wr * 64 + fr, col0 = coff + u.pn * 256 + wc * 32 + 4 * fq;
#pragma unroll
        for (int ai = 0; ai < 2; ++ai)
#pragma unroll
            for (int m = 0; m < 4; ++m) { bf16_t* rowp = O + (size_t)(row0 + ai * 128 + m * 16) * ldc + col0;
#pragma unroll
                for (int bj = 0; bj < 2; ++bj)
#pragma unroll
                    for (int n = 0; n < 2; ++n) { const f32x4 v = acc[ai][bj][m][n]; u32x2 w; w.x = pk2(v[0], v[1]); w.y = pk2(v[2], v[3]);
#ifdef PROBE_NOSTORE
                        if (skip) { asm volatile("" :: "v"(w.x), "v"(w.y)); } else
#endif
                        *(u32x2*)(rowp + bj * 128 + n * 16) = w; } }
#endif
    }
};
struct EpiQaRope {
    static constexpr bool PERM = true;
    bf16_t* O; const float* rope;
    DI void operator()(const f32x4 (&acc)[2][2][4][2], const pg8::Unit& u, int wr, int wc, int fr, int fq) const {
        const int row0 = u.pm * 256 + wr * 64 + fr, col0 = u.pn * 256 + wc * 32 + 8 * fq;
#pragma unroll
        for (int ai = 0; ai < 2; ++ai)
#pragma unroll
            for (int m = 0; m < 4; ++m) { const int row = row0 + ai * 128 + m * 16; bf16_t* rowp = O + (size_t)row * 768 + col0;
#pragma unroll
                for (int bj = 0; bj < 2; ++bj) { f32x4 v0 = acc[ai][bj][m][0], v1 = acc[ai][bj][m][1];
                    const int c8 = col0 + bj * 128, p0 = c8 % 96;
                    if (p0 < 32) { const f32x4* cs = (const f32x4*)(rope + (size_t)row * 48 + p0); const f32x4 a = cs[0], b = cs[1];
                        const f32x4 r0 = {v0[0] * a[0] - v0[1] * a[1], v0[1] * a[0] + v0[0] * a[1], v0[2] * a[2] - v0[3] * a[3], v0[3] * a[2] + v0[2] * a[3]};
                        const f32x4 r1 = {v1[0] * b[0] - v1[1] * b[1], v1[1] * b[0] + v1[0] * b[1], v1[2] * b[2] - v1[3] * b[3], v1[3] * b[2] + v1[2] * b[3]};
                        v0 = r0; v1 = r1; }
                    u32x4 w; w.x = pk2(v0[0], v0[1]); w.y = pk2(v0[2], v0[3]); w.z = pk2(v1[0], v1[1]); w.w = pk2(v1[2], v1[3]);
                    *(u32x4*)(rowp + bj * 128) = w; } }
    }
};
struct EpiBranchGate {
    static constexpr bool PERM = true;
    bf16_t* MG; const bf16_t* P; const float* bgate;
    DI void operator()(const f32x4 (&acc)[2][2][4][2], const pg8::Unit& u, int wr, int wc, int fr, int fq) const {
#if EPI_QT
        const int lane = fr + 16 * fq, src4 = qt_src(lane); fr = lane >> 2; fq = lane & 3;
#endif
        const int n = u.pn >> 2, row0 = u.pm * 256 + wr * 64 + fr, colg = u.pn * 256 + wc * 32 + 8 * fq, col0 = colg - n * 1024;
        f32x4 bg[2][2];
#pragma unroll
        for (int bj = 0; bj < 2; ++bj) { bg[bj][0] = *(const f32x4*)(bgate + colg + bj * 128); bg[bj][1] = *(const f32x4*)(bgate + colg + bj * 128 + 4); }
        u32x4 gl[2][2][2], pv[2][2][2];
#define EBG_LOAD(slot, grp) do { _Pragma("unroll") for (int m2 = 0; m2 < 2; ++m2) _Pragma("unroll") for (int bj = 0; bj < 2; ++bj) { const size_t row = (size_t)(row0 + ((grp) >> 1) * 128 + (2 * ((grp) & 1) + m2) * 16); \
            gl[slot][m2][bj] = *(const u32x4*)(P + row * NP + colg + bj * 128); pv[slot][m2][bj] = (n > 0) ? *(const u32x4*)(MG + row * D_MODEL + col0 + bj * 128) : (u32x4){0u, 0u, 0u, 0u}; } } while (0)
        EBG_LOAD(0, 0);
#pragma unroll
        for (int grp = 0; grp < 4; ++grp) {
            const int slot = grp & 1, ai = grp >> 1, mh = grp & 1;
            if (grp + 1 < 4) { if (slot == 0) EBG_LOAD(1, grp + 1); else EBG_LOAD(0, grp + 1); }
            asm volatile("" ::: "memory");
#pragma unroll
            for (int m2 = 0; m2 < 2; ++m2)
#pragma unroll
                for (int bj = 0; bj < 2; ++bj) { const int m = 2 * mh + m2; const size_t row = (size_t)(row0 + ai * 128 + m * 16);
#if EPI_QT
                    const f32x4 v0 = qt4f(src4, acc[ai][bj][m][0]), v1 = qt4f(src4, acc[ai][bj][m][1]);
#else
                    const f32x4 v0 = acc[ai][bj][m][0], v1 = acc[ai][bj][m][1];
#endif
                    const u32x4 g = gl[slot][m2][bj], q = pv[slot][m2][bj];
                    float o[8];
                    o[0] = v0[0] * fast_sigmoid(bf_lo(g.x) + bg[bj][0][0]) + bf_lo(q.x); o[1] = v0[1] * fast_sigmoid(bf_hi(g.x) + bg[bj][0][1]) + bf_hi(q.x);
                    o[2] = v0[2] * fast_sigmoid(bf_lo(g.y) + bg[bj][0][2]) + bf_lo(q.y); o[3] = v0[3] * fast_sigmoid(bf_hi(g.y) + bg[bj][0][3]) + bf_hi(q.y);
                    o[4] = v1[0] * fast_sigmoid(bf_lo(g.z) + bg[bj][1][0]) + bf_lo(q.z); o[5] = v1[1] * fast_sigmoid(bf_hi(g.z) + bg[bj][1][1]) + bf_hi(q.z);
                    o[6] = v1[2] * fast_sigmoid(bf_lo(g.w) + bg[bj][1][2]) + bf_lo(q.w); o[7] = v1[3] * fast_sigmoid(bf_hi(g.w) + bg[bj][1][3]) + bf_hi(q.w);
                    u32x4 w; w.x = pk2(o[0], o[1]); w.y = pk2(o[2], o[3]); w.z = pk2(o[4], o[5]); w.w = pk2(o[6], o[7]);
                    *(u32x4*)(MG + row * D_MODEL + col0 + bj * 128) = w; }
        }
#undef EBG_LOAD
    }
};
struct EpiResidual {
    static constexpr bool PERM = false;
    const float* xin; float* xout; const float* gmod;
    DI void operator()(const f32x4 (&acc)[2][2][4][2], const pg8::Unit& u, int wr, int wc, int fr, int fq) const {
#if EPI_QT
        const int lane = fr + 16 * fq, src4 = qt_src(lane); fr = lane >> 2; fq = lane & 3;
#endif
        const int row0 = u.pm * 256 + wr * 64 + fr, col0 = u.pn * 256 + wc * 32 + 4 * fq;
        const float* gm = gmod + (size_t)(u.pm >> 3) * 6144 + col0;
        f32x4 gv[2][2];
#pragma unroll
        for (int bj = 0; bj < 2; ++bj)
#pragma unroll
            for (int n = 0; n < 2; ++n) gv[bj][n] = *(const f32x4*)(gm + bj * 128 + n * 16);
        f32x4 xv[2][2][2][2];
#define ERS_LOAD(slot, grp) do { _Pragma("unroll") for (int m2 = 0; m2 < 2; ++m2) { const size_t off = (size_t)(row0 + ((grp) >> 1) * 128 + (2 * ((grp) & 1) + m2) * 16) * D_MODEL + col0; \
            _Pragma("unroll") for (int bj = 0; bj < 2; ++bj) _Pragma("unroll") for (int n = 0; n < 2; ++n) xv[slot][m2][bj][n] = *(const f32x4*)(xin + off + bj * 128 + n * 16); } } while (0)
        ERS_LOAD(0, 0);
#pragma unroll
        for (int grp = 0; grp < 4; ++grp) {
            const int slot = grp & 1, ai = grp >> 1, mh = grp & 1;
            if (grp + 1 < 4) { if (slot == 0) ERS_LOAD(1, grp + 1); else ERS_LOAD(0, grp + 1); }
            asm volatile("" ::: "memory");
#pragma unroll
            for (int m2 = 0; m2 < 2; ++m2) { const size_t off = (size_t)(row0 + ai * 128 + (2 * mh + m2) * 16) * D_MODEL + col0;
#pragma unroll
                for (int bj = 0; bj < 2; ++bj)
#pragma unroll
                    for (int n = 0; n < 2; ++n) {
#if EPI_QT
                        const f32x4 av = qt4f(src4, acc[ai][bj][2 * mh + m2][n]);
#else
                        const f32x4 av = acc[ai][bj][2 * mh + m2][n];
#endif
                        *(f32x4*)(xout + off + bj * 128 + n * 16) = xv[slot][m2][bj][n] + gv[bj][n] * av; } }
        }
#undef ERS_LOAD
    }
};
struct EpiSwiglu {
    static constexpr bool PERM = false;
    bf16_t* ACT; const float* b1; const LAS int* texp;
    DI void operator()(const f32x4 (&acc)[2][2][4][2], const pg8::Unit& u, int wr, int wc, int fr, int fq) const {
        const int row0 = u.pm * 256 + wr * 64 + fr, e = texp[u.pm];
        const float* bb = b1 + (size_t)e * 2048;
#pragma unroll
        for (int bj = 0; bj < 2; ++bj) { const int j0 = u.pn * 128 + bj * 64 + wc * 16 + 4 * fq;
            const f32x4 ba = *(const f32x4*)(bb + 2 * j0), bc = *(const f32x4*)(bb + 2 * j0 + 4);
            const f32x4 bgt = {ba[0], ba[2], bc[0], bc[2]}, bup = {ba[1], ba[3], bc[1], bc[3]};
#pragma unroll
            for (int ai = 0; ai < 2; ++ai)
#pragma unroll
                for (int m = 0; m < 4; ++m) { const f32x4 g = acc[ai][bj][m][0] + bgt, up = acc[ai][bj][m][1] + bup; float o[4];
#pragma unroll
                    for (int i = 0; i < 4; ++i) { const float gg = fminf(g[i], 7.0f), uu = fminf(fmaxf(up[i], -7.0f), 7.0f);
                        o[i] = (uu + 1.0f) * gg * fast_sigmoid(1.702f * gg);
                    }
                    u32x2 w; w.x = pk2(o[0], o[1]); w.y = pk2(o[2], o[3]);
                    *(u32x2*)(ACT + (size_t)(row0 + ai * 128 + m * 16) * D_EXP + j0) = w; } }
    }
};
struct EpiSwiglu8 {
    static constexpr bool PERM = false;
    unsigned char* ACT; const float* b1; const LAS int* texp;
#ifdef PROBE_M1
    int skip = 0;
#endif
    DI void operator()(const f32x4 (&acc)[2][2][4][2], const pg8::Unit& u, int wr, int wc, int fr, int fq) const {
#ifdef PROBE_M1
        if (skip == 2) {
#pragma unroll
            for (int ai = 0; ai < 2; ++ai)
#pragma unroll
                for (int bj = 0; bj < 2; ++bj)
#pragma unroll
                    for (int m = 0; m < 4; ++m)
#pragma unroll
                        for (int n = 0; n < 2; ++n) asm volatile("" :: "v"(acc[ai][bj][m][n][0]), "v"(acc[ai][bj][m][n][1]), "v"(acc[ai][bj][m][n][2]), "v"(acc[ai][bj][m][n][3]));
            return; }
#endif
        const int row0 = u.pm * 256 + wr * 64 + fr, e = texp[u.pm];
        const float* bb = b1 + (size_t)e * 2048;
#pragma unroll
        for (int bj = 0; bj < 2; ++bj) { const int j0 = u.pn * 128 + bj * 64 + wc * 16 + 4 * fq;
            const f32x4 ba = *(const f32x4*)(bb + 2 * j0), bc = *(const f32x4*)(bb + 2 * j0 + 4);
            const f32x4 bgt = {ba[0], ba[2], bc[0], bc[2]}, bup = {ba[1], ba[3], bc[1], bc[3]};
#pragma unroll
            for (int ai = 0; ai < 2; ++ai) {
                unsigned w[4];
#pragma unroll
                for (int m = 0; m < 4; ++m) { const f32x4 g = acc[ai][bj][m][0] + bgt, up = acc[ai][bj][m][1] + bup; float o[4];
#pragma unroll
                    for (int i = 0; i < 4; ++i) { const float gg = fminf(g[i], 7.0f), uu = fminf(fmaxf(up[i], -7.0f), 7.0f);
                        o[i] = (uu + 1.0f) * gg * fast_sigmoid(1.702f * gg);
                    }
                    w[m] = pk4_fp8(o[0], o[1], o[2], o[3]); }
                { const auto r = __builtin_amdgcn_permlane16_swap(w[0], w[1], false, false); w[0] = r[0]; w[1] = r[1]; }
                { const auto r = __builtin_amdgcn_permlane16_swap(w[2], w[3], false, false); w[2] = r[0]; w[3] = r[1]; }
                { const auto r = __builtin_amdgcn_permlane32_swap(w[0], w[2], false, false); w[0] = r[0]; w[2] = r[1]; }
                { const auto r = __builtin_amdgcn_permlane32_swap(w[1], w[3], false, false); w[1] = r[0]; w[3] = r[1]; }
                u32x4 wv; wv.x = w[0]; wv.y = w[1]; wv.z = w[2]; wv.w = w[3];
#ifdef PROBE_M1
                if (skip == 1) { asm volatile("" :: "v"(wv.x), "v"(wv.y), "v"(wv.z), "v"(wv.w)); } else
#endif
                *(u32x4*)(ACT + (size_t)(row0 + ai * 128 + fq * 16) * D_EXP + (j0 - 4 * fq)) = wv; } }
    }
};
struct EpiMoeOut {
    static constexpr bool PERM = true;
    bf16_t* Y; const float* b2; const float* gate; const LAS int* texp;
    DI void operator()(const f32x4 (&acc)[2][2][4][2], const pg8::Unit& u, int wr, int wc, int fr, int fq) const {
        const int row0 = u.pm * 256 + wr * 64 + fr, col0 = u.pn * 256 + wc * 32 + 8 * fq, e = texp[u.pm];
        const float* bb = b2 + (size_t)e * D_MODEL + col0;
#if EPI_QT_ST
        const int lane = fr + 16 * fq, src4 = qt_src(lane), rowq = (lane >> 2) - fr, colq = 8 * ((lane & 3) - fq);
#endif
        f32x4 bv[2][2];
#pragma unroll
        for (int bj = 0; bj < 2; ++bj) { bv[bj][0] = *(const f32x4*)(bb + bj * 128); bv[bj][1] = *(const f32x4*)(bb + bj * 128 + 4); }
#pragma unroll
        for (int ai = 0; ai < 2; ++ai) {
            float gt[4];
#pragma unroll
            for (int m = 0; m < 4; ++m) gt[m] = gate[row0 + ai * 128 + m * 16];
            asm volatile("" ::: "memory");
#pragma unroll
            for (int m = 0; m < 4; ++m) { const int row = row0 + ai * 128 + m * 16; const float g = gt[m];
#pragma unroll
                for (int bj = 0; bj < 2; ++bj) { const f32x4 v0 = (acc[ai][bj][m][0] + bv[bj][0]) * g, v1 = (acc[ai][bj][m][1] + bv[bj][1]) * g;
                    u32x4 w; w.x = pk2(v0[0], v0[1]); w.y = pk2(v0[2], v0[3]); w.z = pk2(v1[0], v1[1]); w.w = pk2(v1[2], v1[3]);
#if EPI_QT_ST
                    *(u32x4*)(Y + (size_t)(row + rowq) * D_MODEL + col0 + colq + bj * 128) = qt4(src4, w); } }
#else
                    *(u32x4*)(Y + (size_t)row * D_MODEL + col0 + bj * 128) = w; } }
#endif
            asm volatile("" ::: "memory");
        }
    }
};

constexpr size_t MiB = 1u << 20;
constexpr size_t WS_CTL = 0, CTL_ZERO_BYTES = 1 * MiB;
constexpr size_t WS_MOD = 1 * MiB, WS_ROPE = 2 * MiB, WS_WIN = 8 * MiB, WS_WUQ = 33 * MiB, WS_WUKV = 34 * MiB, WS_WB = 35 * MiB, WS_WOUT = 41 * MiB, WS_W1 = 53 * MiB, WS_W2 = 309 * MiB,
                 WS_X1 = 437 * MiB, WS_H = 565 * MiB, WS_CQ = 629 * MiB, WS_CKV = 645 * MiB, WS_KPE = 661 * MiB, WS_QA = 663 * MiB, WS_KV = 711 * MiB, WS_O3 = 775 * MiB, WS_QC = 871 * MiB,
                 WS_KC = 903 * MiB, WS_VC = 907 * MiB, WS_QI = 911 * MiB, WS_KI = 943 * MiB, WS_IW = 947 * MiB, WS_ROUTE = 948 * MiB, WS_P = 952 * MiB, WS_GY = 1352 * MiB, WS_END = 1544 * MiB;
constexpr size_t WS_HG8 = WS_QA;
constexpr size_t WS_XB = WS_P, WS_ACT = WS_P + 272 * MiB, WS_Y = WS_P, WS_H8 = WS_H;
constexpr size_t RT_TOPE = 0, RT_TOPG = 512 * 1024, RT_RANK = 1 * MiB, RT_SLOTOF = 1 * MiB + 512 * 1024, RT_TOKOF = 2 * MiB, RT_GATEOF = 3 * MiB;
static_assert((size_t)NSLOT_MAX * 1024 * 2 <= 272 * MiB && WS_ACT + 272 * MiB <= WS_END, "MoE overlay: XB (fp8) and Y (bf16) share [P, P+272M) (XB is dead when Y is written); ACT in [P+272M, P+544M)");
static_assert((size_t)T_TOK * NP * 2 == 400 * MiB, "P size");
constexpr int CW_BAR = 4096, CW_CNT = 16384;
constexpr int LDS_BYTES = 163840, LDS_X = 131072, MISC_OFF = LDS_BYTES - 512;

struct Frame {
    LAS unsigned char* lds; int tid, lane, wave, G, bid; float zf;
    float* out; unsigned char* ws; unsigned* ctl;
};
extern __shared__ __attribute__((aligned(16))) unsigned char lds_raw[];
typedef __attribute__((address_space(4))) const char* kptr_t;
DI const void* kin(int i) {
#if defined(__HIP_DEVICE_COMPILE__)
    kptr_t ka = (kptr_t)__builtin_amdgcn_kernarg_segment_ptr(); asm volatile("" : "+s"(ka)); return (const void*)(GAS const void*)*(__attribute__((address_space(4))) const unsigned long long*)(ka + 8 * i);
#else
    (void)i; return nullptr;
#endif
}
#define KIN_x ((const float*)kin(0))
#define KIN_c ((const float*)kin(1))
#define KIN_pos ((const int*)kin(2))
#define KIN_norm1_g ((const float*)kin(3))
#define KIN_norm2_g ((const float*)kin(4))
#define KIN_w_ada ((const float*)kin(5))
#define KIN_b_ada ((const float*)kin(6))
#define KIN_w_in ((const float*)kin(7))
#define KIN_b_gate ((const float*)kin(8))
#define KIN_q_norm ((const float*)kin(9))
#define KIN_w_uq ((const float*)kin(10))
#define KIN_kv_norm ((const float*)kin(11))
#define KIN_w_ukv ((const float*)kin(12))
#define KIN_conv_w ((const float*)kin(13))
#define KIN_w_branch ((const float*)kin(14))
#define KIN_w_out ((const float*)kin(15))
#define KIN_router_w ((const float*)kin(16))
#define KIN_router_b ((const float*)kin(17))
#define KIN_w1 ((const float*)kin(18))
#define KIN_b1 ((const float*)kin(19))
#define KIN_w2 ((const float*)kin(20))
#define KIN_b2 ((const float*)kin(21))
#define KIN_final_g ((const float*)kin(22))
DI Frame make_frame(int wave0) {
    Frame F; unsigned z_ = 0u; asm volatile("" : "+v"(z_));
    F.lds = (LAS unsigned char*)lds_raw; F.lane = (int)__builtin_amdgcn_mbcnt_hi(~0u, __builtin_amdgcn_mbcnt_lo(~0u, z_)); F.wave = wave0; F.tid = wave0 * 64 + F.lane; F.G = gridDim.x; F.bid = blockIdx.x; F.zf = __uint_as_float(z_);
    F.out = (float*)kin(23); F.ws = (unsigned char*)kin(24); F.ctl = (unsigned*)F.ws;
    return F;
}
#define WSP(T, off) ((T*)(F.ws + (off)))
#ifndef STAG_MODE
#define STAG_MODE 1
#endif
#ifndef STAG_SCALE
#define STAG_SCALE 100
#endif
DI void stagger(const Frame& F, int spread_us) {
#if STAG_MODE == 0
    const unsigned ticks = (unsigned)(spread_us * STAG_SCALE) * (unsigned)F.bid / (unsigned)F.G;
#elif STAG_MODE == 1
    const unsigned ticks = (unsigned)(spread_us * STAG_SCALE) * (unsigned)(F.bid & 7) / 8u;
#else
    const unsigned ticks = (unsigned)(spread_us * STAG_SCALE) * (unsigned)((F.bid >> 3) & 3) / 4u;
#endif
    if (ticks == 0u) return;
    const unsigned long long t0 = __builtin_amdgcn_s_memrealtime();
    while ((unsigned)(__builtin_amdgcn_s_memrealtime() - t0) < ticks) __builtin_amdgcn_s_sleep(8);
}


#define XB_TMO      128
#define XB_XCNT(j)  (256  + 64 * (j))
#define XB_XSUB(j)  (1280 + 64 * (j))
#define XB_XGEN(j)  (2304 + 64 * (j))
#define XB_TOP      3328
#define XB_TOPGEN   3392
#define XCD_BAR_WORDS 3456
#define XB_SPIN_CAP (1u << 18)
DI unsigned xb_ld(unsigned* p)              { return __hip_atomic_load(p, __ATOMIC_RELAXED, __HIP_MEMORY_SCOPE_AGENT); }
DI unsigned xb_add(unsigned* p, unsigned v) { return __hip_atomic_fetch_add(p, v, __ATOMIC_RELAXED, __HIP_MEMORY_SCOPE_AGENT); }
DI unsigned xb_xcc_id() { return (unsigned)__builtin_amdgcn_s_getreg((3 << 11) | 20) & 0xFu; }
#define XB_SPIN(cond, bar) do { unsigned _sp = 0; while (cond) { __builtin_amdgcn_s_sleep(1); \
    if ((++_sp & 255u) == 0u) { if (xb_ld(&(bar)[XB_TMO])) break; if (_sp > XB_SPIN_CAP) { atomicAdd(&(bar)[XB_TMO], 1u); break; } } } } while (0)
struct XcdBarrier { unsigned* bar; unsigned x; volatile LAS unsigned* st; };
DI XcdBarrier xcd_barrier_post(unsigned* bar, volatile LAS unsigned* st, int tid) {
    XcdBarrier b; b.bar = bar; b.x = xb_xcc_id(); b.st = st;
    if (tid == 0) (void)xb_add(&bar[XB_XCNT(b.x)], 1u);
    return b;
}
DI void xcd_barrier_complete(unsigned* bar, unsigned x, unsigned& nloc, unsigned& nx) {
    const unsigned G = gridDim.x * gridDim.y * gridDim.z;
    unsigned sum, cnt, mine, sp = 0u;
    for (;;) {
        sum = 0u; cnt = 0u; mine = 0u;
#pragma unroll
        for (unsigned j = 0; j < 16; ++j) { const unsigned c = xb_ld(&bar[XB_XCNT(j)]); sum += c; cnt += (c > 0u) ? 1u : 0u; mine = (j == x) ? c : mine; }
        if (sum == G) break;
        __builtin_amdgcn_s_sleep(1);
        if ((++sp & 255u) == 0u) { if (xb_ld(&bar[XB_TMO])) break; if (sp > XB_SPIN_CAP) { atomicAdd(&bar[XB_TMO], 1u); break; } }
    }
    nloc = mine > 0u ? mine : 1u; nx = cnt > 0u ? cnt : 1u;
}
DI void xcd_barrier(const XcdBarrier& b, int tid) {
    asm volatile("s_waitcnt vmcnt(0)" ::: "memory");
    __syncthreads();
    if (tid == 0) {
        unsigned* bar = b.bar;
        __builtin_amdgcn_s_waitcnt(0);
        unsigned nloc = b.st[0], nx = b.st[1];
        if (nloc == 0u) { xcd_barrier_complete(bar, b.x, nloc, nx); b.st[0] = nloc; b.st[1] = nx; }
        const unsigned old = xb_add(&bar[XB_XSUB(b.x)], 1u);
        const unsigned gen = old / nloc;
        if (old + 1u == (gen + 1u) * nloc) {
            __builtin_amdgcn_fence(__ATOMIC_RELEASE, "agent");
            asm volatile("s_waitcnt vmcnt(0)" ::: "memory");
            const unsigned og = xb_add(&bar[XB_TOP], 1u);
            const unsigned tg = og / nx;
            if (og + 1u == (tg + 1u) * nx) xb_add(&bar[XB_TOPGEN], 1u);
            else XB_SPIN(xb_ld(&bar[XB_TOPGEN]) == tg, bar);
            __builtin_amdgcn_fence(__ATOMIC_ACQUIRE, "agent");
            xb_add(&bar[XB_XGEN(b.x)], 1u);
            asm volatile("s_waitcnt vmcnt(0)" ::: "memory");
        } else {
            XB_SPIN(xb_ld(&bar[XB_XGEN(b.x)]) == gen, bar);
            __builtin_amdgcn_fence(__ATOMIC_ACQUIRE, "agent");
            asm volatile("s_waitcnt vmcnt(0)" ::: "memory");
        }
    }
    __syncthreads();
}

#ifndef G1_F8_COLS
#define G1_F8_COLS 3072
#endif
DI int rope_perm(int p, int half) { return (p < 2 * half) ? (p >> 1) + half * (p & 1) : p; }
DI int cmap_in(int r) {
    if (r < PC_CONV) return OC_GATE + r;
    if (r < PC_DQ) return OC_CONV + (r - PC_CONV);
    if (r < PC_IQ) { const int j = r - PC_DQ; return OC_DQ + (j & ~63) + rope_perm(j & 63, 8); }
    if (r < PC_QLAT) { const int j = r - PC_IQ; return OC_IQ + (j & ~63) + rope_perm(j & 63, 8); }
    if (r < PC_KVLAT) return OC_QLAT + (r - PC_QLAT);
    if (r < PC_DKV) { const int j = r - PC_KVLAT; return j < 128 ? OC_KVLAT + j : OC_KVLAT + 128 + rope_perm(j - 128, 16); }
    if (r < PC_IK) { const int j = r - PC_DKV; return j < 64 ? OC_DKV + rope_perm(j, 8) : OC_DKV + j; }
    if (r < PC_IW) return OC_IK + rope_perm(r - PC_IK, 8);
    if (r < IN_COLS) return OC_IW + (r - PC_IW);
    return -1;
}
DI int cmap_uq(int r) { const int h = r / 96, p = r % 96; return h * 96 + rope_perm(p, 16); }
DI int cmap_w1(int R) { const int pn = R >> 8, rem = R & 255, bj = rem >> 7, wc = (rem >> 5) & 3, n = (rem >> 4) & 1, f = rem & 15; return 2 * (pn * 128 + bj * 64 + wc * 16 + f) + n; }
DI void transpose_item(const float* W, int K, int N, bf16_t* WT, int ldk, int koff, LAS float* scr, int k0, int n0, int csrc, int lane) {
#pragma unroll 8
    for (int i = 0; i < 32; ++i) { const int kk = 2 * i + (lane >> 5); float v = 0.f; if (csrc >= 0 && k0 + kk < K) v = W[(size_t)(k0 + kk) * N + csrc]; scr[kk * 33 + (lane & 31)] = v; }
    LDS_WAIT(); asm volatile("" ::: "memory");
    const int c = lane & 7;
#pragma unroll
    for (int j = 0; j < 4; ++j) { const int n = (lane >> 3) + 8 * j; const LAS float* s = scr + (8 * c) * 33 + n;
        u32x4 o; o.x = pk2(s[0 * 33], s[1 * 33]); o.y = pk2(s[2 * 33], s[3 * 33]); o.z = pk2(s[4 * 33], s[5 * 33]); o.w = pk2(s[6 * 33], s[7 * 33]);
        *(u32x4*)(WT + (size_t)(n0 + n) * ldk + koff + k0 + 8 * c) = o; }
    LDS_WAIT(); asm volatile("" ::: "memory");
}
DI void transpose_item_f8(const float* W, int K, int N, unsigned char* WT, int ldk, LAS float* scr, int k0, int n0, int csrc, int lane, float qs) {
#pragma unroll 8
    for (int i = 0; i < 32; ++i) { const int kk = 2 * i + (lane >> 5); scr[kk * 33 + (lane & 31)] = W[(size_t)(k0 + kk) * N + csrc] * qs; }
    LDS_WAIT(); asm volatile("" ::: "memory");
    const int c = lane & 7;
#pragma unroll
    for (int j = 0; j < 4; ++j) { const int n = (lane >> 3) + 8 * j; const LAS float* s = scr + (8 * c) * 33 + n;
        u32x2 o; o.x = pk4_fp8(s[0 * 33], s[1 * 33], s[2 * 33], s[3 * 33]); o.y = pk4_fp8(s[4 * 33], s[5 * 33], s[6 * 33], s[7 * 33]);
        *(u32x2*)(WT + (size_t)(n0 + n) * ldk + k0 + 8 * c) = o; }
    LDS_WAIT(); asm volatile("" ::: "memory");
}
DI void titem_load(const float* W, int N, int k0, int csrc, int lane, float (&v)[32]) {
#pragma unroll
    for (int i = 0; i < 32; ++i) v[i] = W[(size_t)(k0 + 2 * i + (lane >> 5)) * N + csrc];
}
DI void titem_store_f8(const float (&v)[32], unsigned char* WT, int ldk, LAS float* scr, int k0, int n0, int lane, float qs) {
#pragma unroll
    for (int i = 0; i < 32; ++i) scr[(2 * i + (lane >> 5)) * 33 + (lane & 31)] = v[i] * qs;
    LDS_WAIT(); asm volatile("" ::: "memory");
    const int c = lane & 7;
#pragma unroll
    for (int j = 0; j < 4; ++j) { const int n = (lane >> 3) + 8 * j; const LAS float* s = scr + (8 * c) * 33 + n;
        u32x2 o; o.x = pk4_fp8(s[0 * 33], s[1 * 33], s[2 * 33], s[3 * 33]); o.y = pk4_fp8(s[4 * 33], s[5 * 33], s[6 * 33], s[7 * 33]);
        *(u32x2*)(WT + (size_t)(n0 + n) * ldk + k0 + 8 * c) = o; }
    LDS_WAIT(); asm volatile("" ::: "memory");
}
template <bool W1>
DI void convert_family_f8(const float* src, unsigned char* dst, int N, int nmat, LAS float* scr, int gw, int NGW, int lane) {
    const int nbn = N / 32, ipm = 16 * nbn, total = nmat * ipm;
    float va[32], vb[32];
#define TF_DECODE(it, j_, k0_, n0_, cs_) const int j_ = (it) / ipm, q_##j_ = (it) % ipm, k0_ = 64 * (q_##j_ / nbn), n0_ = 32 * (q_##j_ % nbn), cs_ = W1 ? cmap_w1(n0_ + (lane & 31)) : n0_ + (lane & 31)
    int it = gw;
    if (it < total) { TF_DECODE(it, j0, k00, n00, cs0); titem_load(src + (size_t)j0 * 1024 * N, N, k00, cs0, lane, va); }
    while (it < total) {
        const int it2 = it + NGW;
        if (it2 < total) { TF_DECODE(it2, j2, k02, n02, cs2); titem_load(src + (size_t)j2 * 1024 * N, N, k02, cs2, lane, vb); }
        { TF_DECODE(it, j1, k01, n01, cs1); (void)cs1; titem_store_f8(va, dst + (size_t)j1 * N * 1024, 1024, scr, k01, n01, lane, 64.0f); }
        const int it3 = it2 + NGW;
        if (it3 < total) { TF_DECODE(it3, j3, k03, n03, cs3); titem_load(src + (size_t)j3 * 1024 * N, N, k03, cs3, lane, va); }
        if (it2 < total) { TF_DECODE(it2, j4, k04, n04, cs4); (void)cs4; titem_store_f8(vb, dst + (size_t)j4 * N * 1024, 1024, scr, k04, n04, lane, 64.0f); }
        it = it3;
    }
#undef TF_DECODE
}
DI void sincos_d(double x, float& s, float& c) {
    const double kd = __builtin_rint(x * 0.6366197723675814); const int k = (int)kd;
    double r = __builtin_fma(-kd, 1.5707963267948966, x); r = __builtin_fma(-kd, 6.123233995736766e-17, r);
    const double r2 = r * r;
    const double sp = r * (1.0 + r2 * (-1.0 / 6 + r2 * (1.0 / 120 + r2 * (-1.0 / 5040 + r2 * (1.0 / 362880 + r2 * (-1.0 / 39916800 + r2 * (1.0 / 6227020800.0)))))));
    const double cp = 1.0 + r2 * (-0.5 + r2 * (1.0 / 24 + r2 * (-1.0 / 720 + r2 * (1.0 / 40320 + r2 * (-1.0 / 3628800 + r2 * (1.0 / 479001600.0 + r2 * (-1.0 / 87178291200.0)))))));
    const int q = k & 3;
    const double ss = (q == 0) ? sp : (q == 1) ? cp : (q == 2) ? -sp : -cp;
    const double cc = (q == 0) ? cp : (q == 1) ? -sp : (q == 2) ? -cp : sp;
    s = (float)ss; c = (float)cc;
}
DI void phase_prologue(const Frame& F) {
    const int tid = F.tid, lane = F.lane, wave = F.wave;
    __syncthreads();
    const float* in_c = KIN_c; const float* in_wada = KIN_w_ada; const float* in_bada = KIN_b_ada; const int* in_pos = KIN_pos;
    if (F.bid < 192) {
        LAS float* cact = (LAS float*)F.lds;
        LAS float* red = (LAS float*)(F.lds + 65536);
        for (int idx = tid; idx < 16 * 1024; idx += 512) { const int b = idx >> 10, k = idx & 1023; const float cv = in_c[idx]; cact[k * 16 + b] = cv * fast_sigmoid(cv); }
        __syncthreads();
        float* MOD = WSP(float, WS_MOD);
        for (int it = F.bid; it < 192; it += F.G) {
            const int l = it / 96, cb = it % 96, col = cb * 64 + lane;
            float acc[16];
#pragma unroll
            for (int b = 0; b < 16; ++b) acc[b] = 0.f;
            const float* wp = in_wada + ((size_t)l * 1024 + wave * 128) * 6144 + col;
#pragma unroll 4
            for (int kk = 0; kk < 128; ++kk) { const float wv = wp[(size_t)kk * 6144]; const LAS f32x4* cp = (const LAS f32x4*)(cact + (wave * 128 + kk) * 16);
#pragma unroll
                for (int q = 0; q < 4; ++q) { const f32x4 cv = cp[q]; acc[4 * q] += cv[0] * wv; acc[4 * q + 1] += cv[1] * wv; acc[4 * q + 2] += cv[2] * wv; acc[4 * q + 3] += cv[3] * wv; } }
#pragma unroll
            for (int b = 0; b < 16; ++b) red[(wave * 16 + b) * 64 + lane] = acc[b];
            __syncthreads();
            for (int o = tid; o < 1024; o += 512) { const int b = o >> 6, ln = o & 63; float s = in_bada[l * 6144 + cb * 64 + ln];
#pragma unroll
                for (int w = 0; w < 8; ++w) s += red[(w * 16 + b) * 64 + ln];
                MOD[((size_t)l * 16 + b) * 6144 + cb * 64 + ln] = s; }
            __syncthreads();
        }
    }
    __syncthreads();
    {
        float* ROPE = WSP(float, WS_ROPE);
        const double r16 = 0.44036660267178046;
        for (int idx = F.bid * 512 + tid; idx < T_TOK * 24; idx += F.G * 512) {
            const int t = idx / 24, i = idx % 24; const int e = (i < 16) ? i : 2 * (i - 16);
            double f = 1.0; for (int j = 0; j < e; ++j) f *= r16;
            float s, c; sincos_d((double)in_pos[t] * f, s, c);
            ROPE[(size_t)t * 48 + 2 * i] = c; ROPE[(size_t)t * 48 + 2 * i + 1] = s;
        }
    }
    {
        LAS float* scr = (LAS float*)(F.lds + wave * 16384);
        const int gw = F.bid * 8 + wave, NGW = F.G * 8;
        constexpr int I_IN = 16 * 200, I_UQ = 4 * 24, I_UKV = 4 * 32, I_WB = 8 * 32, I_WO = 16 * 32, I_W1 = 16 * 64, I_W2 = 16 * 32;
        constexpr int N_IN = 2 * I_IN, N_UQ = 2 * I_UQ, N_UKV = 2 * I_UKV, N_WB = 6 * I_WB, N_WO = 2 * I_WO, N_W1 = 64 * I_W1, N_W2 = 64 * I_W2;
        constexpr int NITEMS = N_IN + N_UQ + N_UKV + N_WB + N_WO;
        (void)N_W1; (void)N_W2;
        for (int it = gw; it < NITEMS; it += NGW) {
            int r = it;
            if (r < N_IN) { const int l = r / I_IN, q = r % I_IN, kb = q / 200, nb = q % 200;
                if (32 * nb < G1_F8_COLS) transpose_item_f8(KIN_w_in + (size_t)l * 1024 * IN_COLS, 1024, IN_COLS, WSP(unsigned char, WS_WIN) + (size_t)l * NP * 2048, 1024, scr, 64 * kb, 32 * nb, cmap_in(32 * nb + (lane & 31)), lane, 64.0f);
                else transpose_item(KIN_w_in + (size_t)l * 1024 * IN_COLS, 1024, IN_COLS, WSP(bf16_t, WS_WIN) + (size_t)l * NP * 1024, 1024, 0, scr, 64 * kb, 32 * nb, cmap_in(32 * nb + (lane & 31)), lane);
                continue; } r -= N_IN;
            if (r < N_UQ) { const int l = r / I_UQ, q = r % I_UQ, kb = q / 24, nb = q % 24;
                transpose_item(KIN_w_uq + (size_t)l * 256 * 768, 256, 768, WSP(bf16_t, WS_WUQ) + (size_t)l * 768 * 256, 256, 0, scr, 64 * kb, 32 * nb, cmap_uq(32 * nb + (lane & 31)), lane); continue; } r -= N_UQ;
            if (r < N_UKV) { const int l = r / I_UKV, q = r % I_UKV, kb = q / 32, nb = q % 32;
                transpose_item(KIN_w_ukv + (size_t)l * 128 * 1024, 128, 1024, WSP(bf16_t, WS_WUKV) + (size_t)l * 1024 * 256, 256, 0, scr, 64 * kb, 32 * nb, 32 * nb + (lane & 31), lane); continue; } r -= N_UKV;
            if (r < N_WB) { const int j = r / I_WB, q = r % I_WB, kb = q / 32, nb = q % 32;
                transpose_item(KIN_w_branch + (size_t)j * 512 * 1024, 512, 1024, WSP(bf16_t, WS_WB) + (size_t)j * 1024 * 512, 512, 0, scr, 64 * kb, 32 * nb, 32 * nb + (lane & 31), lane); continue; } r -= N_WB;
            if (r < N_WO) { const int l = r / I_WO, q = r % I_WO, kb = q / 32, nb = q % 32;
                transpose_item(KIN_w_out + (size_t)l * 1024 * 1024, 1024, 1024, WSP(bf16_t, WS_WOUT) + (size_t)l * 1024 * 1024, 1024, 0, scr, 64 * kb, 32 * nb, 32 * nb + (lane & 31), lane); continue; } r -= N_WO;
            (void)r;
        }
        convert_family_f8<true>(KIN_w1, WSP(unsigned char, WS_W1), 2048, 64, scr, gw, NGW, lane);
#if M2_F8
        convert_family_f8<false>(KIN_w2, WSP(unsigned char, WS_W2), 1024, 64, scr, gw, NGW, lane);
#else
        for (int it = gw; it < 64 * I_W2; it += NGW) { const int j = it / I_W2, q = it % I_W2, kb = q / 32, nb = q % 32;
            transpose_item(KIN_w2 + (size_t)j * 1024 * 1024, 1024, 1024, WSP(bf16_t, WS_W2) + (size_t)j * 1024 * 1024, 1024, 0, scr, 64 * kb, 32 * nb, 32 * nb + (lane & 31), lane); }
#endif
    }
}

DI void phase_norm(const Frame& F, const float* xin, float* xout, bool combine, bool write_x, bool final_, int lnext, int lcomb) {
    const int lane = F.lane, gw = F.bid * 8 + F.wave, NGW = F.G * 8;
    const float* in_fg = KIN_final_g; const float* in_n1 = KIN_norm1_g;
    const float* MOD = WSP(float, WS_MOD); const bf16_t* Y = WSP(bf16_t, WS_Y); const int* SLOTOF = (const int*)(F.ws + WS_ROUTE + RT_SLOTOF); bf16_t* H = WSP(bf16_t, WS_H);
    u32x4 slots = {0u, 0u, 0u, 0u};
    if (combine && gw < T_TOK) slots = *(const u32x4*)(SLOTOF + (size_t)gw * 4);
    for (int t = gw; t < T_TOK; t += NGW) {
        const int b = t >> 11; f32x4 v[4];
#pragma unroll
        for (int i = 0; i < 4; ++i) v[i] = *(const f32x4*)(xin + (size_t)t * 1024 + 4 * lane + 256 * i);
        if (combine) {
            const unsigned s0 = slots.x, s1 = slots.y, s2 = slots.z, s3 = slots.w;
            u32x2 ya[4], yb[4], yc[4], yd[4];
#pragma unroll
            for (int i = 0; i < 4; ++i) { const int co = 4 * lane + 256 * i;
                ya[i] = *(const u32x2*)(Y + (size_t)s0 * 1024 + co); yb[i] = *(const u32x2*)(Y + (size_t)s1 * 1024 + co); yc[i] = *(const u32x2*)(Y + (size_t)s2 * 1024 + co); yd[i] = *(const u32x2*)(Y + (size_t)s3 * 1024 + co); }
            if (t + NGW < T_TOK) slots = *(const u32x4*)(SLOTOF + (size_t)(t + NGW) * 4);
            const float* g2 = MOD + ((size_t)lcomb * 16 + b) * 6144 + 5 * 1024;
#pragma unroll
            for (int i = 0; i < 4; ++i) { const int co = 4 * lane + 256 * i; const u32x2 a = ya[i], bq = yb[i], cq = yc[i], dq = yd[i];
                f32x4 sum = {bf_lo(a.x) + bf_lo(bq.x) + bf_lo(cq.x) + bf_lo(dq.x), bf_hi(a.x) + bf_hi(bq.x) + bf_hi(cq.x) + bf_hi(dq.x),
                             bf_lo(a.y) + bf_lo(bq.y) + bf_lo(cq.y) + bf_lo(dq.y), bf_hi(a.y) + bf_hi(bq.y) + bf_hi(cq.y) + bf_hi(dq.y)};
                v[i] += *(const f32x4*)(g2 + co) * sum; }
            if (write_x) {
#pragma unroll
                for (int i = 0; i < 4; ++i) *(f32x4*)(xout + (size_t)t * 1024 + 4 * lane + 256 * i) = v[i]; }
        }
        float ss = 0.f;
#pragma unroll
        for (int i = 0; i < 4; ++i) ss += (v[i][0] * v[i][0] + v[i][1] * v[i][1]) + (v[i][2] * v[i][2] + v[i][3] * v[i][3]);
        ss = wave_sum(ss); const float r = 1.0f / sqrtf(ss * (1.0f / 1024.0f) + NORM_EPS);
        if (final_) {
#pragma unroll
            for (int i = 0; i < 4; ++i) { const int co = 4 * lane + 256 * i; *(f32x4*)(F.out + (size_t)t * 1024 + co) = v[i] * r * *(const f32x4*)(in_fg + co); }
        } else {
            const float* md = MOD + ((size_t)lnext * 16 + b) * 6144;
#pragma unroll
            for (int i = 0; i < 4; ++i) { const int co = 4 * lane + 256 * i;
                const f32x4 g = *(const f32x4*)(in_n1 + lnext * 1024 + co), sc = *(const f32x4*)(md + 1024 + co), sh = *(const f32x4*)(md + co);
                f32x4 h = v[i] * r * g * (sc + 1.0f) + sh;
                u32x2 w; w.x = pk2(h[0], h[1]); w.y = pk2(h[2], h[3]);
                *(u32x2*)(H + (size_t)t * 1024 + co) = w;
                *(unsigned*)(WSP(unsigned char, WS_HG8) + (size_t)t * 1024 + co) = pk4_fp8(h[0], h[1], h[2], h[3]);
                }
        }
    }
}
DI u32x4 rope8v(u32x4 a, f32x4 c0, f32x4 c1) {
    u32x4 o;
    { const float x1 = bf_lo(a.x), x2 = bf_hi(a.x); o.x = pk2(x1 * c0[0] - x2 * c0[1], x2 * c0[0] + x1 * c0[1]); }
    { const float x1 = bf_lo(a.y), x2 = bf_hi(a.y); o.y = pk2(x1 * c0[2] - x2 * c0[3], x2 * c0[2] + x1 * c0[3]); }
    { const float x1 = bf_lo(a.z), x2 = bf_hi(a.z); o.z = pk2(x1 * c1[0] - x2 * c1[1], x2 * c1[0] + x1 * c1[1]); }
    { const float x1 = bf_lo(a.w), x2 = bf_hi(a.w); o.w = pk2(x1 * c1[2] - x2 * c1[3], x2 * c1[2] + x1 * c1[3]); }
    return o;
}
DI u32x4 rope8(u32x4 a, const float* cs) { return rope8v(a, *(const f32x4*)cs, *(const f32x4*)(cs + 4)); }
DI void unpack8(u32x4 a, float (&v)[8]) { v[0] = bf_lo(a.x); v[1] = bf_hi(a.x); v[2] = bf_lo(a.y); v[3] = bf_hi(a.y); v[4] = bf_lo(a.z); v[5] = bf_hi(a.z); v[6] = bf_lo(a.w); v[7] = bf_hi(a.w); }
DI void phase_post(const Frame& F, int l) {
    const int lane = F.lane, gw = F.bid * 8 + F.wave, NGW = F.G * 8;
    const bf16_t* P = WSP(bf16_t, WS_P); const float* ROPE = WSP(float, WS_ROPE);
    bf16_t *CQ = WSP(bf16_t, WS_CQ), *CKV = WSP(bf16_t, WS_CKV), *KPE = WSP(bf16_t, WS_KPE), *OB = WSP(bf16_t, WS_O3) + (size_t)T_TOK * 512, *QC = WSP(bf16_t, WS_QC), *KC = WSP(bf16_t, WS_KC),
           *VC = WSP(bf16_t, WS_VC), *QI = WSP(bf16_t, WS_QI), *KI = WSP(bf16_t, WS_KI); float* IW = WSP(float, WS_IW);
    const float* cw = KIN_conv_w + (size_t)l * 3 * 512 + 8 * lane;
    f32x4 cwv[3][2];
#pragma unroll
    for (int d = 0; d < 3; ++d) { cwv[d][0] = *(const f32x4*)(cw + d * 512); cwv[d][1] = *(const f32x4*)(cw + d * 512 + 4); }
    const float* in_qn = KIN_q_norm + l * 256 + 8 * (lane & 31); const float* in_kn = KIN_kv_norm + l * 128 + 8 * (lane & 15);
    const f32x4 qn0 = *(const f32x4*)in_qn, qn1 = *(const f32x4*)(in_qn + 4), kn0 = *(const f32x4*)in_kn, kn1 = *(const f32x4*)(in_kn + 4);
    const u32x4 z4 = {0u, 0u, 0u, 0u};
    for (int t = gw; t < T_TOK; t += NGW) {
        const bf16_t* pr = P + (size_t)t * NP; const float* rp = ROPE + (size_t)t * 48; const int s = t & (SEQ - 1);
        const bf16_t* pc = pr + PC_CONV + 8 * lane;
        const u32x4 gbw = *(const u32x4*)pc;
        const u32x4 gc2 = *(const u32x4*)(pc + 512), hc2 = *(const u32x4*)(pc + 1024);
        const u32x4 gc1 = (s >= 1) ? *(const u32x4*)(pc - NP + 512) : z4, hc1 = (s >= 1) ? *(const u32x4*)(pc - NP + 1024) : z4;
        const u32x4 gc0 = (s >= 2) ? *(const u32x4*)(pc - 2 * NP + 512) : z4, hc0 = (s >= 2) ? *(const u32x4*)(pc - 2 * NP + 1024) : z4;
        u32x4 dqw = *(const u32x4*)(pr + PC_DQ + 8 * lane), iqw = *(const u32x4*)(pr + PC_IQ + 8 * lane);
        const u32x4 qlw = *(const u32x4*)(pr + PC_QLAT + 8 * (lane & 31));
        const u32x4 kvw = *(const u32x4*)(pr + PC_KVLAT + 8 * (lane < 20 ? lane : 0));
        u32x4 dkw = *(const u32x4*)(pr + PC_DKV + 8 * (lane & 15));
        u32x4 ikw = *(const u32x4*)(pr + PC_IK + 8 * (lane & 7));
        const u32x4 iww = *(const u32x4*)(pr + PC_IW);
        const f32x4 r16a = *(const f32x4*)(rp + 32 + 8 * (lane & 1)), r16b = *(const f32x4*)(rp + 32 + 8 * (lane & 1) + 4);
        const f32x4 r32a = *(const f32x4*)(rp + 8 * (lane & 3)), r32b = *(const f32x4*)(rp + 8 * (lane & 3) + 4);
        asm volatile("" ::: "memory");
        {
            float gb[8], a0[8], b0[8], a1[8], b1[8], a2[8], b2[8]; unpack8(gbw, gb); unpack8(gc0, a0); unpack8(hc0, b0); unpack8(gc1, a1); unpack8(hc1, b1); unpack8(gc2, a2); unpack8(hc2, b2);
            float o[8];
#pragma unroll
            for (int i = 0; i < 8; ++i) { const float w0 = cwv[0][i >> 2][i & 3], w1 = cwv[1][i >> 2][i & 3], w2 = cwv[2][i >> 2][i & 3]; o[i] = gb[i] * (w0 * (a0[i] * b0[i]) + w1 * (a1[i] * b1[i]) + w2 * (a2[i] * b2[i])); }
            u32x4 ow; ow.x = pk2(o[0], o[1]); ow.y = pk2(o[2], o[3]); ow.z = pk2(o[4], o[5]); ow.w = pk2(o[6], o[7]);
            *(u32x4*)(OB + (size_t)t * 512 + 8 * lane) = ow;
        }
        if ((lane & 7) < 2) { dqw = rope8v(dqw, r16a, r16b); iqw = rope8v(iqw, r16a, r16b); }
        *(u32x4*)(QC + (size_t)t * 512 + 8 * lane) = dqw; *(u32x4*)(QI + (size_t)t * 512 + 8 * lane) = iqw;
        float ql[8], kv[8]; unpack8(qlw, ql); unpack8(kvw, kv);
        float ss1 = 0.f, ss2 = 0.f;
        if (lane < 32) {
#pragma unroll
            for (int i = 0; i < 8; ++i) ss1 += ql[i] * ql[i]; }
        if (lane < 16) {
#pragma unroll
            for (int i = 0; i < 8; ++i) ss2 += kv[i] * kv[i]; }
#pragma unroll
        for (int o = 1; o < 64; o <<= 1) { ss1 += __shfl_xor(ss1, o); ss2 += __shfl_xor(ss2, o); }
        const float r1 = 1.0f / sqrtf(ss1 * (1.0f / 256.0f) + NORM_EPS), r2 = 1.0f / sqrtf(ss2 * (1.0f / 128.0f) + NORM_EPS);
        if (lane < 32) { u32x4 o; o.x = pk2(ql[0] * r1 * qn0[0], ql[1] * r1 * qn0[1]); o.y = pk2(ql[2] * r1 * qn0[2], ql[3] * r1 * qn0[3]); o.z = pk2(ql[4] * r1 * qn1[0], ql[5] * r1 * qn1[1]); o.w = pk2(ql[6] * r1 * qn1[2], ql[7] * r1 * qn1[3]);
            *(u32x4*)(CQ + (size_t)t * 256 + 8 * lane) = o;
            u32x4 k = z4; if (lane < 16) { k.x = pk2(kv[0] * r2 * kn0[0], kv[1] * r2 * kn0[1]); k.y = pk2(kv[2] * r2 * kn0[2], kv[3] * r2 * kn0[3]); k.z = pk2(kv[4] * r2 * kn1[0], kv[5] * r2 * kn1[1]); k.w = pk2(kv[6] * r2 * kn1[2], kv[7] * r2 * kn1[3]); }
            *(u32x4*)(CKV + (size_t)t * 256 + 8 * lane) = k; }
        if (lane >= 16 && lane < 20) *(u32x4*)(KPE + (size_t)t * 32 + 8 * (lane - 16)) = rope8v(kvw, r32a, r32b);
        if (lane < 16) { if (lane < 2) dkw = rope8v(dkw, r16a, r16b); if (lane < 8) *(u32x4*)(KC + (size_t)t * 64 + 8 * lane) = dkw; else *(u32x4*)(VC + (size_t)t * 64 + 8 * (lane - 8)) = dkw; }
        if (lane >= 16 && lane < 24) { const int c = lane - 16; if (c < 2) ikw = rope8v(ikw, r16a, r16b); *(u32x4*)(KI + (size_t)t * 64 + 8 * c) = ikw; }
        if (lane == 32) { float v[8]; unpack8(iww, v); *(f32x4*)(IW + (size_t)t * 8) = (f32x4){v[0], v[1], v[2], v[3]}; *(f32x4*)(IW + (size_t)t * 8 + 4) = (f32x4){v[4], v[5], v[6], v[7]}; }
    }
}

DI int crow(int r, int hi) { return (r & 3) + 8 * (r >> 2) + 4 * hi; }
#define MFMA32(a, b, c) __builtin_amdgcn_mfma_f32_32x32x16_bf16((a), (b), (c), 0, 0, 0)
#define MFMA16(a, b, c) __builtin_amdgcn_mfma_f32_16x16x32_bf16((a), (b), (c), 0, 0, 0)
#define GLDS16(src, dst) __builtin_amdgcn_global_load_lds((const unsigned*)(src), (LAS unsigned*)(dst), 16, 0, 0)
typedef short v4i16_t __attribute__((ext_vector_type(4)));
DI s16x4 tr_read(const LAS unsigned char* p) { return __builtin_bit_cast(s16x4, __builtin_amdgcn_ds_read_tr16_b64_v4i16((LAS v4i16_t*)p)); }
DI bf16x8 pack8(float a0, float a1, float a2, float a3, float a4, float a5, float a6, float a7) { u32x4 w; w.x = pk2(a0, a1); w.y = pk2(a2, a3); w.z = pk2(a4, a5); w.w = pk2(a6, a7); return __builtin_bit_cast(bf16x8, w); }
DI bf16x8 cat4(s16x4 lo, s16x4 hi) { return (bf16x8){lo[0], lo[1], lo[2], lo[3], hi[0], hi[1], hi[2], hi[3]}; }

constexpr int MLA_K0 = 0, MLA_V0 = 24576, MLA_WS = 49152;
DI void mla_unit(const Frame& F, int b, int h, int qb) {
    const int lane = F.lane, wid = F.wave, r32 = lane & 31, hi = lane >> 5;
    const bf16_t* QA = WSP(bf16_t, WS_QA); const bf16_t* KPE = WSP(bf16_t, WS_KPE); const bf16_t* KV = WSP(bf16_t, WS_KV); bf16_t* OA = WSP(bf16_t, WS_O3);
    const size_t tb = (size_t)b * SEQ; const int q0 = qb * 256, qrow = q0 + 32 * wid + r32;
    const float C2 = 0.10206207261596577f * 1.4426950408889634f;
    LAS unsigned char* lds = F.lds; LAS float* wsf = (LAS float*)(lds + MLA_WS) + wid * 128;
    bf16x8 qr[6];
#pragma unroll
    for (int d0 = 0; d0 < 6; ++d0) qr[d0] = *(const bf16x8*)(QA + (tb + qrow) * 768 + h * 96 + d0 * 16 + hi * 8);
    {
        const float* rp = WSP(float, WS_ROPE) + (tb + qrow) * 48;
        qr[0] = __builtin_bit_cast(bf16x8, rope8(__builtin_bit_cast(u32x4, qr[0]), rp + 8 * hi));
        qr[1] = __builtin_bit_cast(bf16x8, rope8(__builtin_bit_cast(u32x4, qr[1]), rp + 16 + 8 * hi)); }
    const int NT = 4 * (qb + 1);
    const unsigned vo_pe = (unsigned)(lane * 32 + 8 * (wid & 3)) * 2u, vo_k0 = (unsigned)(lane * 1024 + 128 * h + 8 * ((wid + 4) & 7)) * 2u, vo_k1 = (unsigned)(lane * 1024 + 128 * h + 8 * (wid + 4)) * 2u,
                   vo_v = (unsigned)((16 * (wid & 3) + (lane >> 2)) * 1024 + 128 * h + 64 + 32 * (wid >> 2) + 8 * (lane & 3)) * 2u;
    const unsigned ldsb = (unsigned)(unsigned long long)lds;
    const char* pe_b = pg8::uni_ptr((const char*)(KPE + tb * 32)); const char* kv_b = pg8::uni_ptr((const char*)(KV + tb * 1024));
#define MLA_STAGE(kt, buf, vslot) do { const char* pe_ = pe_b + (size_t)(kt) * (64 * 32 * 2); const char* kv_ = kv_b + (size_t)(kt) * (64 * 1024 * 2); \
        if (wid < 4) { pg8::glds16_s(vo_pe, pe_, ldsb + MLA_K0 + (buf) * 12288 + wid * 1024); pg8::glds16_s(vo_k1, kv_, ldsb + MLA_K0 + (buf) * 12288 + (wid + 8) * 1024); } \
        else { pg8::glds16_s(vo_k0, kv_, ldsb + MLA_K0 + (buf) * 12288 + wid * 1024); } \
        pg8::glds16_s(vo_v, kv_, ldsb + MLA_V0 + (vslot) * 8192 + wid * 1024); } while (0)
    MLA_STAGE(0, 0, 0);
    float m = -1e30f, l = 0.f; f32x16 o[2];
#pragma unroll
    for (int r = 0; r < 16; ++r) { o[0][r] = 0.f; o[1][r] = 0.f; }
    const int vboff = ((lane >> 4) & 1) * 32 + (lane & 3) * 8 + (4 * hi + ((lane & 15) >> 2)) * 64;
    const bool upper = wid >= 4; bool have_prev = false; bf16x8 pa[4];
#define MLA_PV(vs) do { const LAS unsigned char* vb_ = lds + MLA_V0 + (vs) * 8192 + vboff; \
        _Pragma("unroll") for (int d0 = 0; d0 < 2; ++d0) _Pragma("unroll") for (int ks = 0; ks < 4; ++ks) { \
            const s16x4 lo_ = tr_read(vb_ + d0 * 4096 + ks * 1024), hh_ = tr_read(vb_ + d0 * 4096 + ks * 1024 + 512); o[d0] = MFMA32(pa[ks], cat4(lo_, hh_), o[d0]); } } while (0)
    int vs_cur = 0, vs_prev = 0;
    for (int kt = 0; kt < NT; ++kt) {
        const int buf = kt & 1; const int vs_next = (vs_cur == 2) ? 0 : vs_cur + 1;
        VM_WAIT(); __syncthreads();
        if (kt + 1 < NT) MLA_STAGE(kt + 1, buf ^ 1, vs_next);
        if (upper && have_prev) { MLA_PV(vs_prev); have_prev = false; }
        if (64 * kt <= q0 + 32 * wid + 31) {
            f32x16 p0, p1;
#pragma unroll
            for (int r = 0; r < 16; ++r) { p0[r] = 0.f; p1[r] = 0.f; }
            const LAS unsigned char* kb = lds + MLA_K0 + buf * 12288 + hi * 1024 + r32 * 16;
#pragma unroll
            for (int d0 = 0; d0 < 6; ++d0) { const bf16x8 b0 = *(const LAS bf16x8*)(kb + d0 * 2048), b1 = *(const LAS bf16x8*)(kb + d0 * 2048 + 512);
                p0 = MFMA32(b0, qr[d0], p0); p1 = MFMA32(b1, qr[d0], p1); }
            if (64 * kt + 63 > q0 + 32 * wid) {
#pragma unroll
                for (int r = 0; r < 16; ++r) { const int kv = 64 * kt + crow(r, hi); if (kv > qrow) p0[r] = -INFINITY; if (kv + 32 > qrow) p1[r] = -INFINITY; } }
            float rm = fmaxf(p0[0], p1[0]);
#pragma unroll
            for (int r = 1; r < 16; ++r) rm = fmaxf(rm, fmaxf(p0[r], p1[r]));
            rm = fmaxf(rm, __shfl_xor(rm, 32));
            const float mn = fmaxf(m, rm);
            if (__any(mn > m)) {
                const float alpha = __builtin_amdgcn_exp2f((m - mn) * C2); l *= alpha; m = mn;
                if (hi == 0) wsf[r32] = alpha;
                LDS_WAIT();
#pragma unroll
                for (int q = 0; q < 4; ++q) { const f32x4 a = *(const LAS f32x4*)(wsf + 8 * q + 4 * hi);
#pragma unroll
                    for (int j = 0; j < 4; ++j) { o[0][4 * q + j] *= a[j]; o[1][4 * q + j] *= a[j]; } }
            }
            const float mc = m * C2; float ls = 0.f;
#pragma unroll
            for (int r = 0; r < 16; ++r) { p0[r] = __builtin_amdgcn_exp2f(__builtin_fmaf(p0[r], C2, -mc)); p1[r] = __builtin_amdgcn_exp2f(__builtin_fmaf(p1[r], C2, -mc)); ls += p0[r] + p1[r]; }
            l += ls;
            pa[0] = pack8(p0[0], p0[1], p0[2], p0[3], p0[4], p0[5], p0[6], p0[7]); pa[1] = pack8(p0[8], p0[9], p0[10], p0[11], p0[12], p0[13], p0[14], p0[15]);
            pa[2] = pack8(p1[0], p1[1], p1[2], p1[3], p1[4], p1[5], p1[6], p1[7]); pa[3] = pack8(p1[8], p1[9], p1[10], p1[11], p1[12], p1[13], p1[14], p1[15]);
            if (upper) have_prev = true; else MLA_PV(vs_cur);
        }
        vs_prev = vs_cur; vs_cur = vs_next;
    }
    if (upper && have_prev) MLA_PV(vs_prev);
#undef MLA_PV
#undef MLA_STAGE
    l += __shfl_xor(l, 32);
    if (hi == 0) wsf[64 + r32] = 1.0f / l;
    LDS_WAIT();
    bf16_t* orow = OA + (tb + q0 + 32 * wid) * 512 + h * 64 + r32;
#pragma unroll
    for (int q = 0; q < 4; ++q) { const f32x4 a = *(const LAS f32x4*)(wsf + 64 + 8 * q + 4 * hi);
#pragma unroll
        for (int j = 0; j < 4; ++j) { const int r = 4 * q + j, rr = crow(r, hi);
            orow[(size_t)rr * 512] = (bf16_t)(pk2(o[0][r] * a[j], 0.f) & 0xffffu); orow[(size_t)rr * 512 + 32] = (bf16_t)(pk2(o[1][r] * a[j], 0.f) & 0xffffu); } }
    __syncthreads();
}

constexpr int DSA_SCW = 2052;
constexpr int DSA_SEL = 16 * DSA_SCW * 4;
constexpr int DSA_CAND = DSA_SEL + 4096;
template <int CTRL> DI float dpp_f(float x) { return __uint_as_float((unsigned)__builtin_amdgcn_update_dpp(0, (int)__float_as_uint(x), CTRL, 0xf, 0xf, false)); }
DI float rl_f(float x, int l) { return __uint_as_float((unsigned)__builtin_amdgcn_readlane((int)__float_as_uint(x), l)); }
DI float wave_sum_dpp(float x) { x += dpp_f<0x128>(x); x += dpp_f<0x124>(x); x += dpp_f<0x122>(x); x += dpp_f<0x121>(x); return (rl_f(x, 0) + rl_f(x, 16)) + (rl_f(x, 32) + rl_f(x, 48)); }
DI float wave_max_dpp(float x) { x = fmaxf(x, dpp_f<0x128>(x)); x = fmaxf(x, dpp_f<0x124>(x)); x = fmaxf(x, dpp_f<0x122>(x)); x = fmaxf(x, dpp_f<0x121>(x)); return fmaxf(fmaxf(rl_f(x, 0), rl_f(x, 16)), fmaxf(rl_f(x, 32), rl_f(x, 48))); }
DI int mbcnt64(unsigned long long m) { return (int)__builtin_amdgcn_mbcnt_hi((unsigned)(m >> 32), __builtin_amdgcn_mbcnt_lo((unsigned)m, 0u)); }
DI void dsa_unit(const Frame& F, int b, int qt) {
    const int tid = F.tid, lane = F.lane, wid = F.wave, fr = lane & 15, g = lane >> 4;
    const bf16_t *QI = WSP(bf16_t, WS_QI), *KI = WSP(bf16_t, WS_KI), *QC = WSP(bf16_t, WS_QC), *KC = WSP(bf16_t, WS_KC), *VC = WSP(bf16_t, WS_VC); const float* IW = WSP(float, WS_IW);
    bf16_t* OC = WSP(bf16_t, WS_O3) + (size_t)2 * T_TOK * 512;
    const size_t tb = (size_t)b * SEQ; const int t0 = 16 * qt;
    LAS unsigned char* lds = F.lds; LAS float* SC = (LAS float*)lds; LAS unsigned long long* BITS = (LAS unsigned long long*)(lds + DSA_SEL);
#ifdef PROBE_S1DUP
    for (int rep1_ = 0; rep1_ < PROBE_S1DUP; ++rep1_)
#endif
    {
        bf16x8 qf[8][2]; float wv[8];
        const bf16_t* qp = QI + (tb + t0 + fr) * 512 + 8 * g;
#pragma unroll
        for (int h = 0; h < 8; ++h) { qf[h][0] = *(const bf16x8*)(qp + h * 64); qf[h][1] = *(const bf16x8*)(qp + h * 64 + 32); }
        { const f32x4 w0 = *(const f32x4*)(IW + (tb + t0 + fr) * 8), w1 = *(const f32x4*)(IW + (tb + t0 + fr) * 8 + 4); wv[0] = w0[0]; wv[1] = w0[1]; wv[2] = w0[2]; wv[3] = w0[3]; wv[4] = w1[0]; wv[5] = w1[1]; wv[6] = w1[2]; wv[7] = w1[3]; }
        const bf16_t* kbase = KI + (tb + fr) * 64 + 8 * g;
        const bf16x8 z8 = {0, 0, 0, 0, 0, 0, 0, 0};
        bf16x8 a0 = z8, a1 = z8, b0 = z8, b1 = z8, c0 = z8, c1 = z8;
        if (wid <= qt) { a0 = *(const bf16x8*)(kbase + (size_t)wid * 1024); a1 = *(const bf16x8*)(kbase + (size_t)wid * 1024 + 32); }
        if (wid + 8 <= qt) { b0 = *(const bf16x8*)(kbase + (size_t)(wid + 8) * 1024); b1 = *(const bf16x8*)(kbase + (size_t)(wid + 8) * 1024 + 32); }
        if (wid + 16 <= qt) { c0 = *(const bf16x8*)(kbase + (size_t)(wid + 16) * 1024); c1 = *(const bf16x8*)(kbase + (size_t)(wid + 16) * 1024 + 32); }
        for (int kt = wid; kt <= qt; kt += 8) {
            bf16x8 n0 = z8, n1 = z8;
            if (kt + 24 <= qt) { n0 = *(const bf16x8*)(kbase + (size_t)(kt + 24) * 1024); n1 = *(const bf16x8*)(kbase + (size_t)(kt + 24) * 1024 + 32); }
            f32x4 s = {F.zf, F.zf, F.zf, F.zf};
#pragma unroll
            for (int h = 0; h < 8; ++h) { f32x4 acc = {F.zf, F.zf, F.zf, F.zf}; acc = MFMA16(a0, qf[h][0], acc); acc = MFMA16(a1, qf[h][1], acc);
#pragma unroll
                for (int r = 0; r < 4; ++r) s[r] += fmaxf(acc[r], 0.f) * wv[h]; }
#pragma unroll
            for (int r = 0; r < 4; ++r) if (16 * kt + 4 * g + r > t0 + fr) s[r] = -INFINITY;
            *(LAS f32x4*)(SC + fr * DSA_SCW + 16 * kt + 4 * g) = s;
            a0 = b0; a1 = b1; b0 = c0; b1 = c1; c0 = n0; c1 = n1;
        }
    }
    __syncthreads();
    for (int qi2 = 0; qi2 < 2; ++qi2) {
        const int qq = 2 * wid + qi2, t = t0 + qq, nvalid = t + 1;
        LAS unsigned long long* bits = BITS + qq * 32;
        if (nvalid <= 256) { if (lane < 32) { const int k0 = 64 * lane; bits[lane] = (k0 + 63 <= t) ? ~0ull : (k0 <= t) ? ((1ull << (t - k0 + 1)) - 1ull) : 0ull; } }
        else {
            const int nq = (nvalid + 511) >> 9;
            float v[32];
#pragma unroll
            for (int i = 0; i < 32; ++i) { const int key = i * 64 + lane; v[i] = (key <= t) ? SC[qq * DSA_SCW + key] : -INFINITY; }
#define DSA_CMP_ge(m_, x_, t_) asm("v_cmp_ge_f32_e64 %0, %1, %2" : "=s"(m_) : "v"(x_), "v"(t_))
#define DSA_CMP_gt(m_, x_, t_) asm("v_cmp_gt_f32_e64 %0, %1, %2" : "=s"(m_) : "v"(x_), "v"(t_))
#define DSA_COUNT(thr, OPN, out) do { int tot_ = 0; const float thr_ = (thr); _Pragma("unroll") for (int qd = 0; qd < 4; ++qd) { if (qd < nq) { unsigned long long m_[8]; \
                _Pragma("unroll") for (int i = 0; i < 8; ++i) DSA_CMP_##OPN(m_[i], v[8 * qd + i], thr_); __builtin_amdgcn_sched_barrier(0); _Pragma("unroll") for (int i = 0; i < 8; ++i) tot_ += __builtin_popcountll(m_[i]); __builtin_amdgcn_sched_barrier(0); } } out = tot_; } while (0)
            float lo = 0.f, hi = 0.f, K = 0.f; int cnt = 0, clo = nvalid, chi = 0; bool done = false, have_lo = false, have_hi = false;
            if (nvalid >= 512) {
                float a1 = -INFINITY, a2 = -INFINITY, a3 = -INFINITY, a4 = -INFINITY, a5 = -INFINITY;
#pragma unroll
                for (int qd = 0; qd < 4; ++qd) { if (qd < nq) {
#pragma unroll
                    for (int i = 0; i < 8; ++i) { const float x = v[8 * qd + i];
                        const float n5 = __builtin_amdgcn_fmed3f(a4, a5, x), n4 = __builtin_amdgcn_fmed3f(a3, a4, x), n3 = __builtin_amdgcn_fmed3f(a2, a3, x), n2 = __builtin_amdgcn_fmed3f(a1, a2, x);
                        a1 = fmaxf(a1, x); a2 = n2; a3 = n3; a4 = n4; a5 = n5; } } }
                const float m3 = wave_sum_dpp(a3) * (1.0f / 64.0f), m4 = wave_sum_dpp(a4) * (1.0f / 64.0f), m5 = wave_sum_dpp(a5) * (1.0f / 64.0f);
                int c5; DSA_COUNT(m5, ge, c5);
                if (c5 == 256) { K = m5; cnt = 256; done = true; }
                else if (c5 < 256) { hi = m5; chi = c5; have_hi = true; }
                else { lo = m5; clo = c5; have_lo = true;
                    int c4; DSA_COUNT(m4, ge, c4);
                    if (c4 == 256) { K = m4; cnt = 256; done = true; }
                    else if (c4 < 256) { hi = m4; chi = c4; have_hi = true; }
                    else { lo = m4; clo = c4;
                        int c3; DSA_COUNT(m3, ge, c3);
                        if (c3 == 256) { K = m3; cnt = 256; done = true; }
                        else if (c3 < 256) { hi = m3; chi = c3; have_hi = true; }
                        else { lo = m3; clo = c3; } } }
            }
            if (!done && !(have_lo && have_hi)) {
                float vmax = v[0], vmin = (v[0] == -INFINITY) ? INFINITY : v[0];
#pragma unroll
                for (int i = 1; i < 32; ++i) { vmax = fmaxf(vmax, v[i]); vmin = fminf(vmin, (v[i] == -INFINITY) ? INFINITY : v[i]); }
                vmax = wave_max_dpp(vmax); vmin = -wave_max_dpp(-vmin);
                if (!have_hi) { hi = vmax; DSA_COUNT(hi, ge, cnt); if (cnt >= 256) { K = hi; done = true; } else chi = cnt; }
                if (!have_lo) { lo = vmin; clo = nvalid; }
            }
            if (!done)
            for (int it = 0;; ++it) {
                if (clo - chi <= 64) {
                    LAS float* cand = (LAS float*)(lds + DSA_CAND) + wid * 64;
                    cand[lane] = -INFINITY;
                    int base = 0;
#pragma unroll
                    for (int qd = 0; qd < 4; ++qd) { if (qd < nq) {
#pragma unroll
                        for (int i = 0; i < 8; ++i) { const float x = v[8 * qd + i]; const bool c = (x >= lo) && (x < hi); const unsigned long long m = __ballot(c);
                            if (c) cand[base + mbcnt64(m)] = x;
                            base += __builtin_popcountll(m); } } }
                    const float cv = cand[lane]; const int need = 256 - chi; int ge = 0;
                    for (int k = 0; k < base; ++k) { const float ck = __uint_as_float((unsigned)__builtin_amdgcn_readlane((int)__float_as_uint(cv), k)); ge += (ck >= cv) ? 1 : 0; }
                    K = wave_max_dpp((ge >= need) ? cv : -INFINITY); DSA_COUNT(K, ge, cnt);
                    break;
                }
                float fr_ = 0.5f;
                if ((it & 1) == 0) { fr_ = ((float)(clo - 256) + 0.5f) * __builtin_amdgcn_rcpf((float)(clo - chi)); fr_ = fminf(fmaxf(fr_, 0.03125f), 0.96875f); }
                const float mid = lo + (hi - lo) * fr_;
                if (!(mid > lo && mid < hi)) {
                    const float mid2 = lo + (hi - lo) * 0.5f;
                    if (!(mid2 > lo && mid2 < hi)) { K = lo; cnt = clo; break; }
                    DSA_COUNT(mid2, ge, cnt);
                    if (cnt == 256) { K = mid2; break; }
                    if (cnt > 256) { lo = mid2; clo = cnt; } else { hi = mid2; chi = cnt; }
                    continue;
                }
                DSA_COUNT(mid, ge, cnt);
                if (cnt == 256) { K = mid; break; }
                if (cnt > 256) { lo = mid; clo = cnt; } else { hi = mid; chi = cnt; }
            }
            if (cnt == 256) {
#pragma unroll
                for (int qd = 0; qd < 4; ++qd) {
#pragma unroll
                    for (int i8 = 0; i8 < 8; ++i8) { const int i = 8 * qd + i8; const unsigned long long mt = (qd < nq) ? __ballot(v[i] >= K) : 0ull; if (lane == 0) bits[i] = mt; } }
            } else {
                int cgt; DSA_COUNT(K, gt, cgt);
                const int need = 256 - cgt; int eqb = 0;
#pragma unroll
                for (int qd = 0; qd < 4; ++qd) {
#pragma unroll
                    for (int i8 = 0; i8 < 8; ++i8) { const int i = 8 * qd + i8; unsigned long long mt = 0ull;
                        if (qd < nq) { const bool gt = v[i] > K, eq = v[i] == K; const unsigned long long me = __ballot(eq); const int erank = eqb + mbcnt64(me);
                            mt = __ballot(gt || (eq && erank < need)); eqb += __builtin_popcountll(me); }
                        if (lane == 0) bits[i] = mt; } }
            }
#undef DSA_COUNT
#undef DSA_CMP_ge
#undef DSA_CMP_gt
        }
    }
    __syncthreads();
#ifdef PROBE_S3DUP
    for (int rep3_ = 0; rep3_ < PROBE_S3DUP; ++rep3_) { if (rep3_) __syncthreads();
#endif
    {
        const float C2S = 0.125f * 1.4426950408889634f;
        int lane3 = lane; asm volatile("" : "+v"(lane3));
        const int r32 = lane3 & 31, hi = lane3 >> 5, cg = wid & 3, kp = wid >> 2;
        const int NT = (t0 + 16 + 63) >> 6, NS = (NT + 1) >> 1;
        const int qloc = 4 * cg + (r32 >> 3);
        LAS float* wsf = (LAS float*)(lds + 98304) + wid * 128;
        LAS float* OW = (LAS float*)lds; LAS float* ML2 = (LAS float*)(lds + 102400);
        bf16x8 qr[4];
#pragma unroll
        for (int d0 = 0; d0 < 4; ++d0) qr[d0] = *(const bf16x8*)(QC + (tb + t0 + qloc) * 512 + (r32 & 7) * 64 + d0 * 16 + hi * 8);
        const unsigned vo_kc = (unsigned)(lane3 * 64 + 8 * wid) * 2u, vo_vc = (unsigned)((16 * (wid & 3) + (lane3 >> 2)) * 64 + 32 * (wid >> 2) + 8 * (lane3 & 3)) * 2u, ldsb = (unsigned)(unsigned long long)lds;
        const char* kc_b = pg8::uni_ptr((const char*)(KC + tb * 64)); const char* vc_b = pg8::uni_ptr((const char*)(VC + tb * 64));
#define DSD_STAGE(j, buf) do { _Pragma("unroll") for (int par_ = 0; par_ < 2; ++par_) { int kt_ = 2 * (j) + par_; kt_ = kt_ < NT ? kt_ : NT - 1; \
            const unsigned d_ = ldsb + (buf) * 32768 + par_ * 16384; \
            pg8::glds16_s(vo_kc, kc_b + (size_t)kt_ * (64 * 64 * 2), d_ + wid * 1024); pg8::glds16_s(vo_vc, vc_b + (size_t)kt_ * (64 * 64 * 2), d_ + 8192 + wid * 1024); } } while (0)
        DSD_STAGE(0, 0);
        if (NS > 1) DSD_STAGE(1, 1);
        float m = -1e30f, l = 0.f; f32x16 o[2];
#pragma unroll
        for (int r = 0; r < 16; ++r) { o[0][r] = F.zf; o[1][r] = F.zf; }
        const int vboff = ((lane3 >> 4) & 1) * 32 + (lane3 & 3) * 8 + (4 * hi + ((lane3 & 15) >> 2)) * 64;
        int buf = 0, bufn = 2;
        for (int j = 0; j < NS; ++j) {
            const int kt = 2 * j + kp;
            if (j + 1 < NS) asm volatile("s_waitcnt vmcnt(4)" ::: "memory"); else VM_WAIT();
            __syncthreads();
            if (j + 2 < NS) DSD_STAGE(j + 2, bufn);
            if (kt < NT) {
                const LAS unsigned char* tile = lds + buf * 32768 + kp * 16384;
                f32x16 p0, p1;
#pragma unroll
                for (int r = 0; r < 16; ++r) { p0[r] = F.zf; p1[r] = F.zf; }
                const LAS unsigned char* kb = tile + hi * 1024 + r32 * 16;
#pragma unroll
                for (int d0 = 0; d0 < 4; ++d0) { const bf16x8 b0 = *(const LAS bf16x8*)(kb + d0 * 2048), b1 = *(const LAS bf16x8*)(kb + d0 * 2048 + 512);
                    p0 = MFMA32(b0, qr[d0], p0); p1 = MFMA32(b1, qr[d0], p1); }
                float rm = fmaxf(p0[0], p1[0]);
#pragma unroll
                for (int r = 1; r < 16; ++r) rm = fmaxf(rm, fmaxf(p0[r], p1[r]));
                rm = fmaxf(rm, __shfl_xor(rm, 32));
                const float mn = fmaxf(m, rm);
                if (__any(mn > m)) {
                    const float alpha = __builtin_amdgcn_exp2f((m - mn) * C2S); l *= alpha; m = mn;
                    if (hi == 0) wsf[r32] = alpha;
                    LDS_WAIT();
#pragma unroll
                    for (int q = 0; q < 4; ++q) { const f32x4 a = *(const LAS f32x4*)(wsf + 8 * q + 4 * hi);
#pragma unroll
                        for (int jj = 0; jj < 4; ++jj) { o[0][4 * q + jj] *= a[jj]; o[1][4 * q + jj] *= a[jj]; } }
                }
                const unsigned long long bw = BITS[qloc * 32 + kt];
                const unsigned wl = (unsigned)bw >> (4 * hi), wh = (unsigned)(bw >> 32) >> (4 * hi);
                const float mc = m * C2S; float ls = 0.f;
#pragma unroll
                for (int r = 0; r < 16; ++r) { const int c = (r & 3) + 8 * (r >> 2);
                    const int m0 = ((int)(wl << (31 - c))) >> 31, m1 = ((int)(wh << (31 - c))) >> 31;
                    p0[r] = __uint_as_float(__float_as_uint(__builtin_amdgcn_exp2f(__builtin_fmaf(p0[r], C2S, -mc))) & (unsigned)m0);
                    p1[r] = __uint_as_float(__float_as_uint(__builtin_amdgcn_exp2f(__builtin_fmaf(p1[r], C2S, -mc))) & (unsigned)m1);
                    ls += p0[r] + p1[r]; }
                l += ls;
                bf16x8 pa[4];
                pa[0] = pack8(p0[0], p0[1], p0[2], p0[3], p0[4], p0[5], p0[6], p0[7]); pa[1] = pack8(p0[8], p0[9], p0[10], p0[11], p0[12], p0[13], p0[14], p0[15]);
                pa[2] = pack8(p1[0], p1[1], p1[2], p1[3], p1[4], p1[5], p1[6], p1[7]); pa[3] = pack8(p1[8], p1[9], p1[10], p1[11], p1[12], p1[13], p1[14], p1[15]);
                const LAS unsigned char* vb = tile + 8192 + vboff;
#pragma unroll
                for (int d0 = 0; d0 < 2; ++d0)
#pragma unroll
                    for (int ks = 0; ks < 4; ++ks) { const s16x4 lo = tr_read(vb + d0 * 4096 + ks * 1024), hh = tr_read(vb + d0 * 4096 + ks * 1024 + 512);
                        o[d0] = MFMA32(pa[ks], cat4(lo, hh), o[d0]); }
            }
            buf = (buf == 2) ? 0 : buf + 1; bufn = (bufn == 2) ? 0 : bufn + 1;
        }
#undef DSD_STAGE
        l += __shfl_xor(l, 32);
        __syncthreads();
        if (kp == 1) {
            LAS float* ow = OW + cg * 2048;
#pragma unroll
            for (int r = 0; r < 16; ++r) { const int row = crow(r, hi); ow[row * 64 + r32] = o[0][r]; ow[row * 64 + 32 + r32] = o[1][r]; }
            if (hi == 0) { ML2[cg * 64 + r32] = m; ML2[cg * 64 + 32 + r32] = l; }
        }
        __syncthreads();
        if (kp == 0) {
            const float m2 = ML2[cg * 64 + r32], l2 = ML2[cg * 64 + 32 + r32];
            const float M = fmaxf(m, m2), a1 = __builtin_amdgcn_exp2f((m - M) * C2S), a2 = __builtin_amdgcn_exp2f((m2 - M) * C2S);
            const float linv = 1.0f / (a1 * l + a2 * l2);
            if (hi == 0) { wsf[r32] = a1 * linv; wsf[32 + r32] = a2 * linv; }
            LDS_WAIT();
            const LAS float* ow = OW + cg * 2048;
            bf16_t* op = OC + (tb + t0 + 4 * cg) * 512 + r32;
#pragma unroll
            for (int q = 0; q < 4; ++q) { const f32x4 s1 = *(const LAS f32x4*)(wsf + 8 * q + 4 * hi), s2 = *(const LAS f32x4*)(wsf + 32 + 8 * q + 4 * hi);
#pragma unroll
                for (int jj = 0; jj < 4; ++jj) { const int r = 4 * q + jj, row = crow(r, hi);
                    const float v0 = o[0][r] * s1[jj] + ow[row * 64 + r32] * s2[jj], v1 = o[1][r] * s1[jj] + ow[row * 64 + 32 + r32] * s2[jj];
                    bf16_t* dst = op + (size_t)(row >> 3) * 512 + (row & 7) * 64;
                    dst[0] = (bf16_t)(pk2(v0, 0.f) & 0xffffu); dst[32] = (bf16_t)(pk2(v1, 0.f) & 0xffffu); } }
        }
    }
#ifdef PROBE_S3DUP
    }
#endif
    __syncthreads();
}
DI void attention_mla_units(const Frame& F, int rep_a) {
    for (int rep = 0; rep < rep_a; ++rep)
    for (int U = F.bid; U < 1024; U += F.G) { const int i = U >> 8, cp = U & 255, half = cp >> 7, rem = cp & 127; mla_unit(F, rem & 15, rem >> 4, 2 * i + (half ^ (i & 1))); }
}
DI void attention_dsa_units(const Frame& F, int rep_c) {
    for (int rep = 0; rep < rep_c; ++rep)
    for (int U = F.bid; U < 2048; U += F.G) { const int i = U >> 8, cp = U & 255; dsa_unit(F, cp & 15, 16 * i + (cp >> 4)); }
}
DI void phase_attention(const Frame& F, int rep_a, int rep_c) {
    if (F.bid & 1) { attention_dsa_units(F, rep_c); __syncthreads(); attention_mla_units(F, rep_a); }
    else { attention_mla_units(F, rep_a); __syncthreads(); attention_dsa_units(F, rep_c); }
}

constexpr int N2_WROW = 1032;
constexpr int N2_WH = 0, N2_WL = 32 * N2_WROW * 2, N2_CB = 2 * N2_WL, N2_PART = N2_CB + 128, N2_LGT = N2_PART + 2048, N2_RST = N2_LGT + 8 * 2304, N2_CNT = N2_RST + 512, N2_BASE = N2_CNT + 128, N2_TOK = N2_BASE + 128;
static_assert(N2_TOK + 2048 <= MISC_OFF, "router LDS map");
DI void phase_router(const Frame& F, int l, int cset) {
    const int tid = F.tid, lane = F.lane, wave = F.wave, fr = lane & 15, g = lane >> 4;
    LAS unsigned char* lds = F.lds;
    LAS bf16_t* WH = (LAS bf16_t*)(lds + N2_WH); LAS bf16_t* WL = (LAS bf16_t*)(lds + N2_WL); LAS float* CB = (LAS float*)(lds + N2_CB); LAS float* PART = (LAS float*)(lds + N2_PART);
    LAS float* LGT = (LAS float*)(lds + N2_LGT) + wave * 576; LAS float* RST = (LAS float*)(lds + N2_RST) + wave * 16;
    LAS int* CNT = (LAS int*)(lds + N2_CNT); LAS int* BASE = (LAS int*)(lds + N2_BASE); LAS int* TOKR = (LAS int*)(lds + N2_TOK);
    const float* X1 = WSP(float, WS_X1); const float* MOD = WSP(float, WS_MOD); unsigned char* H8 = WSP(unsigned char, WS_H8);
    const float* in_n2 = KIN_norm2_g + l * 1024; const float* in_rb = KIN_router_b + l * 32; const float* in_rw = KIN_router_w + (size_t)l * 32768;
    int* TOPE = (int*)(F.ws + WS_ROUTE + RT_TOPE); float* TOPG = (float*)(F.ws + WS_ROUTE + RT_TOPG); int* RANK = (int*)(F.ws + WS_ROUTE + RT_RANK);
    for (int chunk = F.bid; chunk < T_TOK / 128; chunk += F.G) {
        const int b = chunk >> 4; const float* md = MOD + ((size_t)l * 16 + b) * 6144;
        __syncthreads();
        { float cp = 0.f;
          for (int idx = tid; idx < 32 * 1024; idx += 512) { const int k = idx >> 5, e = idx & 31; const float w = in_rw[idx]; const float wp = w * (in_n2[k] * (1.0f + md[4 * 1024 + k]));
              const unsigned hw = pk2(wp, 0.f) & 0xffffu; const float lo = wp - __uint_as_float(hw << 16);
              WH[e * N2_WROW + k] = (bf16_t)hw; WL[e * N2_WROW + k] = (bf16_t)(pk2(lo, 0.f) & 0xffffu); cp += md[3 * 1024 + k] * w; }
          PART[(tid >> 5) * 32 + (tid & 31)] = cp; }
        if (tid < 32) CNT[tid] = 0;
        __syncthreads();
        if (tid < 32) { float c = in_rb[tid];
#pragma unroll
            for (int p = 0; p < 16; ++p) c += PART[p * 32 + tid];
            CB[tid] = c; }
        __syncthreads();
        const int t0w = chunk * 128 + wave * 16;
        {
            const float* xp = X1 + (size_t)(t0w + fr) * 1024 + 8 * g;
            f32x4 acc0 = {F.zf, F.zf, F.zf, F.zf}, acc1 = acc0; float ssq = 0.f;
            const LAS bf16_t* wh0 = WH + fr * N2_WROW + 8 * g; const LAS bf16_t* wl0 = WL + fr * N2_WROW + 8 * g;
#pragma unroll 8
            for (int ks = 0; ks < 32; ++ks) {
                const f32x4 xa = *(const f32x4*)(xp + 32 * ks), xb = *(const f32x4*)(xp + 32 * ks + 4);
                ssq += (xa[0] * xa[0] + xa[1] * xa[1]) + (xa[2] * xa[2] + xa[3] * xa[3]) + (xb[0] * xb[0] + xb[1] * xb[1]) + (xb[2] * xb[2] + xb[3] * xb[3]);
                u32x4 hw; hw.x = pk2(xa[0], xa[1]); hw.y = pk2(xa[2], xa[3]); hw.z = pk2(xb[0], xb[1]); hw.w = pk2(xb[2], xb[3]);
                u32x4 lw; lw.x = pk2(xa[0] - bf_lo(hw.x), xa[1] - bf_hi(hw.x)); lw.y = pk2(xa[2] - bf_lo(hw.y), xa[3] - bf_hi(hw.y)); lw.z = pk2(xb[0] - bf_lo(hw.z), xb[1] - bf_hi(hw.z)); lw.w = pk2(xb[2] - bf_lo(hw.w), xb[3] - bf_hi(hw.w));
                const bf16x8 ah = __builtin_bit_cast(bf16x8, hw), al = __builtin_bit_cast(bf16x8, lw);
                const bf16x8 bh0 = *(const LAS bf16x8*)(wh0 + 32 * ks), bh1 = *(const LAS bf16x8*)(wh0 + 16 * N2_WROW + 32 * ks), bl0 = *(const LAS bf16x8*)(wl0 + 32 * ks), bl1 = *(const LAS bf16x8*)(wl0 + 16 * N2_WROW + 32 * ks);
                acc0 = __builtin_amdgcn_mfma_f32_16x16x32_bf16(ah, bh0, acc0, 0, 0, 0); acc0 = __builtin_amdgcn_mfma_f32_16x16x32_bf16(ah, bl0, acc0, 0, 0, 0); acc0 = __builtin_amdgcn_mfma_f32_16x16x32_bf16(al, bh0, acc0, 0, 0, 0);
                acc1 = __builtin_amdgcn_mfma_f32_16x16x32_bf16(ah, bh1, acc1, 0, 0, 0); acc1 = __builtin_amdgcn_mfma_f32_16x16x32_bf16(ah, bl1, acc1, 0, 0, 0); acc1 = __builtin_amdgcn_mfma_f32_16x16x32_bf16(al, bh1, acc1, 0, 0, 0);
            }
            ssq += __shfl_xor(ssq, 16); ssq += __shfl_xor(ssq, 32);
            if (g == 0) RST[fr] = 1.0f / sqrtf(ssq * (1.0f / 1024.0f) + NORM_EPS);
#pragma unroll
            for (int r = 0; r < 4; ++r) { LGT[(4 * g + r) * 36 + fr] = acc0[r]; LGT[(4 * g + r) * 36 + 16 + fr] = acc1[r]; }
        }
        LDS_WAIT();
        if (lane < 16) {
            const int t = t0w + lane; const float rt = RST[lane];
            float a[32];
#pragma unroll
            for (int q = 0; q < 8; ++q) { const f32x4 w = *(const LAS f32x4*)(LGT + lane * 36 + 4 * q), c = *(const LAS f32x4*)(CB + 4 * q); a[4 * q] = w[0] * rt + c[0]; a[4 * q + 1] = w[1] * rt + c[1]; a[4 * q + 2] = w[2] * rt + c[2]; a[4 * q + 3] = w[3] * rt + c[3]; }
            float tv[4]; int te[4];
#pragma unroll
            for (int k = 0; k < 4; ++k) { float best = a[0]; int bi = 0;
#pragma unroll
                for (int e = 1; e < 32; ++e) if (a[e] > best) { best = a[e]; bi = e; }
                tv[k] = best; te[k] = bi;
#pragma unroll
                for (int e = 0; e < 32; ++e) if (e == bi) a[e] = -INFINITY; }
            const float e1 = __expf(tv[1] - tv[0]), e2 = __expf(tv[2] - tv[0]), e3 = __expf(tv[3] - tv[0]); const float inv = 1.0f / (1.0f + e1 + e2 + e3);
            const float gk[4] = {inv, e1 * inv, e2 * inv, e3 * inv};
#pragma unroll
            for (int k = 0; k < 4; ++k) { const int loc = __hip_atomic_fetch_add(&CNT[te[k]], 1, __ATOMIC_RELAXED, __HIP_MEMORY_SCOPE_WORKGROUP); TOKR[(wave * 16 + lane) * 4 + k] = te[k] | (loc << 8); }
            *(f32x4*)(TOPG + (size_t)t * 4) = (f32x4){gk[0], gk[1], gk[2], gk[3]};
        }
        { f32x4 gs[4], shv[4];
#pragma unroll
          for (int i = 0; i < 4; ++i) { const int co = 4 * lane + 256 * i; gs[i] = *(const f32x4*)(in_n2 + co) * (*(const f32x4*)(md + 4 * 1024 + co) + 1.0f); shv[i] = *(const f32x4*)(md + 3 * 1024 + co); }
          for (int j = 0; j < 16; j += 4) {
            f32x4 xv[4][4];
#pragma unroll
            for (int jj = 0; jj < 4; ++jj)
#pragma unroll
                for (int i = 0; i < 4; ++i) xv[jj][i] = *(const f32x4*)(X1 + (size_t)(t0w + j + jj) * 1024 + 4 * lane + 256 * i);
#pragma unroll
            for (int jj = 0; jj < 4; ++jj) { const float r = RST[j + jj];
#pragma unroll
                for (int i = 0; i < 4; ++i) { const f32x4 hv = xv[jj][i] * r * gs[i] + shv[i];
                    *(unsigned*)(H8 + (size_t)(t0w + j + jj) * 1024 + 4 * lane + 256 * i) = pk4_fp8(hv[0], hv[1], hv[2], hv[3]); } }
          } }
        __syncthreads();
        if (tid < 32) BASE[tid] = (int)__hip_atomic_fetch_add(F.ctl + CW_CNT + (cset * 32 + tid) * 64, (unsigned)CNT[tid], __ATOMIC_RELAXED, __HIP_MEMORY_SCOPE_AGENT);
        __syncthreads();
        { const int pr = TOKR[tid], e = pr & 255, loc = pr >> 8; const size_t o = (size_t)(chunk * 128) * 4 + tid; TOPE[o] = e; RANK[o] = BASE[e] + loc; }
    }
}
constexpr int MOE_OFF = LDS_X, MOE_CNTL = LDS_X + 256, MOE_TEXP = LDS_X + 512;
DI int moe_offsets(const Frame& F, int l) {
    LAS int* OFF = (LAS int*)(F.lds + MOE_OFF); LAS int* CNTL = (LAS int*)(F.lds + MOE_CNTL); LAS int* TEXP = (LAS int*)(F.lds + MOE_TEXP);
    __syncthreads();
    if (F.tid < 32) CNTL[F.tid] = (int)__hip_atomic_load(F.ctl + CW_CNT + (l * 32 + F.tid) * 64, __ATOMIC_RELAXED, __HIP_MEMORY_SCOPE_AGENT);
    __syncthreads();
    if (F.tid == 0) { int off = 0; for (int e = 0; e < 32; ++e) { OFF[e] = off; off += (CNTL[e] + 255) & ~255; } OFF[32] = off; }
    __syncthreads();
    const int ntiles = OFF[32] >> 8;
    for (int tl = F.tid; tl < ntiles; tl += 512) { int e = 0; for (int q = 0; q < 32; ++q) if (OFF[q] <= tl * 256 && tl * 256 < OFF[q + 1]) e = q; TEXP[tl] = e; }
    __syncthreads();
    return ntiles;
}
DI void phase_scatter(const Frame& F, int l) {
    const int lane = F.lane, wave = F.wave;
    (void)moe_offsets(F, l);
    const LAS int* OFF = (const LAS int*)(F.lds + MOE_OFF); const LAS int* CNTL = (const LAS int*)(F.lds + MOE_CNTL);
    const int* TOPE = (const int*)(F.ws + WS_ROUTE + RT_TOPE); const float* TOPG = (const float*)(F.ws + WS_ROUTE + RT_TOPG); const int* RANK = (const int*)(F.ws + WS_ROUTE + RT_RANK);
    int* SLOTOF = (int*)(F.ws + WS_ROUTE + RT_SLOTOF); int* TOKOF = (int*)(F.ws + WS_ROUTE + RT_TOKOF); float* GATEOF = (float*)(F.ws + WS_ROUTE + RT_GATEOF);
    const unsigned char* H8 = WSP(unsigned char, WS_H8); unsigned char* XB = WSP(unsigned char, WS_XB);
    for (int chunk = F.bid; chunk < T_TOK / 128; chunk += F.G) {
        const int pair = wave * 64 + lane, tl = chunk * 128 + (pair >> 2); const size_t o = (size_t)tl * 4 + (pair & 3);
        const int e = TOPE[o], slot = OFF[e] + RANK[o];
        SLOTOF[o] = slot; TOKOF[slot] = tl; GATEOF[slot] = TOPG[o];
#pragma unroll 4
        for (int p = 0; p < 64; ++p) {
            const int sp = __builtin_amdgcn_readlane(slot, p), tp = chunk * 128 + ((wave * 64 + p) >> 2);
            *(u32x4*)(XB + (size_t)sp * 1024 + 16 * lane) = *(const u32x4*)(H8 + (size_t)tp * 1024 + 16 * lane);
        }
    }
    for (int e = F.bid; e < 32; e += F.G) {
        const int s0 = OFF[e] + CNTL[e], s1 = OFF[e + 1];
        for (int s = s0 + wave; s < s1; s += 8) { if (lane == 0) { TOKOF[s] = 0; GATEOF[s] = 0.f; }
            *(u32x4*)(XB + (size_t)s * 1024 + 16 * lane) = (u32x4){0u, 0u, 0u, 0u}; }
    }
}

#ifndef MK_SPLIT
#define MK_SPLIT 0
#endif
constexpr int NPHASE = 2 + 11 * DEPTH;
struct Args { const void* in[23]; float* out; unsigned char* ws; int ph_lo, ph_hi; };
static_assert(sizeof(Args) == 25 * 8 + 8, "Args has no padding");


#ifndef PH_ENABLE
#define PH_ENABLE 0xFFFF
#endif
#define IN(k) (lo <= (k) && (k) < hi)
#define EN(j) (((PH_ENABLE) >> (j)) & 1)
#ifndef STAG_G1
#define STAG_G1 0
#endif
#ifndef STAG_G3
#define STAG_G3 0
#endif
#ifndef STAG_G4
#define STAG_G4 0
#endif
#ifndef STAG_M2
#define STAG_M2 0
#endif
#ifndef DUP_MASK
#define DUP_MASK 0
#endif
#define NREP(j) ((((DUP_MASK) >> (j)) & 1) ? 2 : 1)
#define SEAM(k) do { if (!MK_SPLIT && (k) + 1 < hi) { XcdBarrier bar_; bar_.bar = F.ctl + CW_BAR; bar_.x = xb_xcc_id(); bar_.st = (volatile LAS unsigned*)((LAS unsigned char*)lds_raw + MISC_OFF) + 8; xcd_barrier(bar_, F.tid); } } while (0)
DI void layer_phases(const int l, const int lo, const int hi, const int wave0) {
        const int pb = 2 + 11 * l;
        if (EN(2) && IN(pb + 0)) { const Frame F = make_frame(wave0);
            stagger(F, STAG_G1);
            { int kb8 = 1024; asm volatile("" : "+s"(kb8));
              SchedPlain S; S.o.init(T_TOK / 256, G1_F8_COLS / 256, F.G, F.bid); S.A = (const char*)WSP(unsigned char, WS_HG8); S.B = (const char*)(WSP(unsigned char, WS_WIN) + (size_t)l * NP * 2048); S.tstep = (size_t)256 * 1024;
              EpiStoreBf16N E{WSP(bf16_t, WS_P), NP, 0};
#ifdef PROBE_NOSTORE
              _Pragma("unroll") for (int rep = 0; rep < NREP(2); ++rep) { E.skip = (rep + 1 < NREP(2)); pg8::gemm_phase_f8<EpiStoreBf16N, SchedPlain>(F.lds, F.tid, kb8, S, E); } }
#else
              _Pragma("unroll") for (int rep = 0; rep < NREP(2) + NREP(14) - 1; ++rep) pg8::gemm_phase_f8<EpiStoreBf16N, SchedPlain>(F.lds, F.tid, kb8, S, E); }
#endif
            { int tid2 = F.tid; asm volatile("" : "+v"(tid2));
              SchedPlain S; S.o.init(T_TOK / 256, (NP - G1_F8_COLS) / 256, F.G, F.bid); S.A = (const char*)WSP(bf16_t, WS_H); S.B = (const char*)(WSP(bf16_t, WS_WIN) + (size_t)l * NP * 1024 + (size_t)G1_F8_COLS * 1024); S.tstep = (size_t)256 * 1024 * 2;
              EpiStoreBf16 E{WSP(bf16_t, WS_P), NP, G1_F8_COLS};
#ifdef PROBE_NOSTORE
              _Pragma("unroll") for (int rep = 0; rep < NREP(2); ++rep) { E.skip = (rep + 1 < NREP(2)); pg8::gemm_phase<EpiStoreBf16, SchedPlain>(F.lds, tid2, 1024, S, E); } }
#else
              _Pragma("unroll") for (int rep = 0; rep < NREP(2) + NREP(15) - 1; ++rep) pg8::gemm_phase<EpiStoreBf16, SchedPlain>(F.lds, tid2, 1024, S, E); }
#endif
            SEAM(pb + 0);
        }
        if (EN(3) && IN(pb + 1)) { const Frame F = make_frame(wave0); _Pragma("unroll") for (int rep = 0; rep < NREP(3); ++rep) phase_post(F, l); SEAM(pb + 1); }
        if (EN(4) && IN(pb + 2)) { const Frame F = make_frame(wave0);
            int k256 = 256; asm volatile("" : "+s"(k256));
            { SchedPlain S; S.o.init(T_TOK / 256, 3, F.G, F.bid); S.A = (const char*)WSP(bf16_t, WS_CQ); S.B = (const char*)(WSP(bf16_t, WS_WUQ) + (size_t)l * 768 * 256); S.tstep = (size_t)256 * 256 * 2;
              EpiStoreBf16 E{WSP(bf16_t, WS_QA), 768};
              pg8::gemm_phase<EpiStoreBf16, SchedPlain>(F.lds, F.tid, k256, S, E); }
            { int tid2 = F.tid; asm volatile("" : "+v"(tid2));
              SchedPlain S; S.o.init(T_TOK / 256, 4, F.G, F.bid); S.A = (const char*)WSP(bf16_t, WS_CKV); S.B = (const char*)(WSP(bf16_t, WS_WUKV) + (size_t)l * 1024 * 256); S.tstep = (size_t)256 * 256 * 2;
              EpiStoreBf16 E{WSP(bf16_t, WS_KV), 1024};
              pg8::gemm_phase<EpiStoreBf16, SchedPlain>(F.lds, tid2, k256, S, E); }
            SEAM(pb + 2);
        }
        if (EN(5) && IN(pb + 3)) { const Frame F = make_frame(wave0); phase_attention(F, NREP(5), NREP(13)); SEAM(pb + 3); }
        if (EN(6) && IN(pb + 4)) { const Frame F = make_frame(wave0);
            stagger(F, STAG_G3);
            SchedBranch S; S.o.init(T_TOK / 256, 4, F.G, F.bid); S.A = (const char*)WSP(bf16_t, WS_O3); S.B = (const char*)(WSP(bf16_t, WS_WB) + (size_t)l * 3 * 1024 * 512); S.tstep = (size_t)256 * 512 * 2; S.aslab = (size_t)T_TOK * 512 * 2;
            EpiBranchGate E{WSP(bf16_t, WS_GY), WSP(bf16_t, WS_P), KIN_b_gate + l * 3072};
            _Pragma("unroll") for (int rep = 0; rep < NREP(6); ++rep) pg8::gemm_phase<EpiBranchGate, SchedBranch>(F.lds, F.tid, 512, S, E);
            SEAM(pb + 4);
        }
        if (EN(7) && IN(pb + 5)) { const Frame F = make_frame(wave0);
            stagger(F, STAG_G4);
            SchedPlain S; S.o.init(T_TOK / 256, 4, F.G, F.bid); S.A = (const char*)WSP(bf16_t, WS_GY); S.B = (const char*)(WSP(bf16_t, WS_WOUT) + (size_t)l * 1024 * 1024); S.tstep = (size_t)256 * 1024 * 2;
            EpiResidual E{l == 0 ? KIN_x : WSP(float, WS_X1), WSP(float, WS_X1), WSP(float, WS_MOD) + (size_t)l * 16 * 6144 + 2 * 1024};
            _Pragma("unroll") for (int rep = 0; rep < NREP(7); ++rep) if (rep == 0 || l == 0) pg8::gemm_phase<EpiResidual, SchedPlain>(F.lds, F.tid, 1024, S, E);
            SEAM(pb + 5);
        }
        if (EN(8) && IN(pb + 6)) { const Frame F = make_frame(wave0); phase_router(F, l, l); if (NREP(8) == 2) phase_router(F, l, l + 2); SEAM(pb + 6); }
        if (EN(9) && IN(pb + 7)) { const Frame F = make_frame(wave0); _Pragma("unroll") for (int rep = 0; rep < NREP(9); ++rep) phase_scatter(F, l); SEAM(pb + 7); }
        if (EN(10) && IN(pb + 8)) { const Frame F = make_frame(wave0);
            const int ntiles = moe_offsets(F, l); int kb8 = 1024; asm volatile("" : "+s"(kb8));
            SchedMoe S; S.o.init(ntiles, 8, F.G, F.bid); S.A = (const char*)WSP(unsigned char, WS_XB); S.B = (const char*)(WSP(unsigned char, WS_W1) + (size_t)l * 32 * 2048 * 1024); S.eslab = 2048u * 1024u;
            S.texp = (const LAS int*)(F.lds + MOE_TEXP);
#if M2_F8
            EpiSwiglu8 E{WSP(unsigned char, WS_ACT), KIN_b1 + (size_t)l * 32 * 2048, (const LAS int*)(F.lds + MOE_TEXP)};
#else
            EpiSwiglu E{WSP(bf16_t, WS_ACT), KIN_b1 + (size_t)l * 32 * 2048, (const LAS int*)(F.lds + MOE_TEXP)};
#endif
            _Pragma("unroll") for (int rep = 0; rep < NREP(10); ++rep)
#if M2_F8
#ifdef PROBE_M1
            { E.skip = (rep + 1 < NREP(10)) ? PROBE_M1 : 0; pg8::gemm_phase_f8<EpiSwiglu8, SchedMoe>(F.lds, F.tid, kb8, S, E); }
#else
            pg8::gemm_phase_f8<EpiSwiglu8, SchedMoe>(F.lds, F.tid, kb8, S, E);
#endif
#else
            pg8::gemm_phase_f8<EpiSwiglu, SchedMoe>(F.lds, F.tid, kb8, S, E);
#endif

            SEAM(pb + 8);
        }
        if (EN(11) && IN(pb + 9)) { const Frame F = make_frame(wave0);
            const int ntiles = moe_offsets(F, l); int kb8 = 1024; asm volatile("" : "+s"(kb8));
            stagger(F, STAG_M2);
#if M2_F8
            SchedMoe S; S.o.init(ntiles, 4, F.G, F.bid); S.A = (const char*)WSP(unsigned char, WS_ACT); S.B = (const char*)(WSP(unsigned char, WS_W2) + (size_t)l * 32 * 1024 * 1024); S.eslab = 1024u * 1024u;
            S.texp = (const LAS int*)(F.lds + MOE_TEXP);
            EpiMoeOut E{WSP(bf16_t, WS_Y), KIN_b2 + (size_t)l * 32 * 1024, (const float*)(F.ws + WS_ROUTE + RT_GATEOF), (const LAS int*)(F.lds + MOE_TEXP)};
            _Pragma("unroll") for (int rep = 0; rep < NREP(11); ++rep) pg8::gemm_phase_f8<EpiMoeOut, SchedMoe>(F.lds, F.tid, kb8, S, E);
#else
            SchedMoeB S; S.o.init(ntiles, 4, F.G, F.bid); S.A = (const char*)WSP(bf16_t, WS_ACT); S.B = (const char*)(WSP(bf16_t, WS_W2) + (size_t)l * 32 * 1024 * 1024); S.eslab = 1024u * 1024u * 2u;
            S.texp = (const LAS int*)(F.lds + MOE_TEXP);
            EpiMoeOut E{WSP(bf16_t, WS_Y), KIN_b2 + (size_t)l * 32 * 1024, (const float*)(F.ws + WS_ROUTE + RT_GATEOF), (const LAS int*)(F.lds + MOE_TEXP)};
            _Pragma("unroll") for (int rep = 0; rep < NREP(11); ++rep) pg8::gemm_phase<EpiMoeOut, SchedMoeB>(F.lds, F.tid, kb8, S, E);
#endif
            SEAM(pb + 9);
        }
        if (EN(12) && IN(pb + 10)) { const Frame F = make_frame(wave0);
            const bool last = (l == DEPTH - 1);
            _Pragma("unroll") for (int rep = 0; rep < NREP(12); ++rep) if (rep == 0 || last) phase_norm(F, WSP(float, WS_X1), WSP(float, WS_X1), true, !last, last, l + 1 < DEPTH ? l + 1 : 0, l);
            SEAM(pb + 10);
        }
}
__global__ void __launch_bounds__(512, 2) fwd_kernel(Args args) {
    const int wave0 = __builtin_amdgcn_readfirstlane(threadIdx.x >> 6);
    {
        volatile LAS unsigned* MISC = (volatile LAS unsigned*)((LAS unsigned char*)lds_raw + MISC_OFF);
        if (threadIdx.x < 32) MISC[threadIdx.x] = 0u;
        __syncthreads();
        if (!MK_SPLIT) { const Frame F = make_frame(wave0); (void)xcd_barrier_post(F.ctl + CW_BAR, MISC + 8, F.tid); }
    }
    const int lo = args.ph_lo, hi = args.ph_hi;
    if (EN(0) && IN(0)) { const Frame F = make_frame(wave0); _Pragma("unroll") for (int rep = 0; rep < NREP(0); ++rep) phase_prologue(F); SEAM(0); }
    if (EN(1) && IN(1)) { const Frame F = make_frame(wave0); _Pragma("unroll") for (int rep = 0; rep < NREP(1); ++rep) phase_norm(F, KIN_x, nullptr, false, false, false, 0, 0); SEAM(1); }
    layer_phases(0, lo, hi, wave0);
    layer_phases(1, lo, hi, wave0);
    static_assert(DEPTH == 2, "two layers");
#undef IN
#undef SEAM
}

extern "C" void kernel_launch(void* const* d_in, const int* in_sizes, int n_in, void* d_out, int out_size, void* d_ws, size_t ws_size, hipStream_t stream) {
    static int grid = 0;
    if (grid == 0) {
        if (n_in != 23 || out_size != T_TOK * D_MODEL || ws_size < WS_END) { fprintf(stderr, "kernel_launch: unexpected problem (n_in %d, out %d, ws %zu)\n", n_in, out_size, ws_size); grid = -1; return; }
        int dev = 0, cus = 0;
        if (hipGetDevice(&dev) != hipSuccess || hipDeviceGetAttribute(&cus, hipDeviceAttributeMultiprocessorCount, dev) != hipSuccess) { grid = -1; return; }
        if (hipFuncSetAttribute((const void*)fwd_kernel, hipFuncAttributeMaxDynamicSharedMemorySize, LDS_BYTES) != hipSuccess) { fprintf(stderr, "kernel_launch: hipFuncSetAttribute failed\n"); grid = -1; return; }
        int per_cu = 0;
        if (hipOccupancyMaxActiveBlocksPerMultiprocessor(&per_cu, (const void*)fwd_kernel, 512, LDS_BYTES) != hipSuccess || per_cu < 1) fprintf(stderr, "kernel_launch: occupancy query says %d\n", per_cu);
        (void)hipGetLastError();
        grid = cus > 256 ? 256 : cus;
    }
    if (grid < 0) return;
    (void)in_sizes;
    if (hipMemsetAsync((char*)d_ws + WS_CTL, 0, CTL_ZERO_BYTES, stream) != hipSuccess) return;
    Args a{};
    for (int i = 0; i < 23; ++i) a.in[i] = d_in[i];
    a.out = (float*)d_out; a.ws = (unsigned char*)d_ws;
#if MK_SPLIT
    for (int p = 0; p < NPHASE; ++p) { a.ph_lo = p; a.ph_hi = p + 1; hipLaunchKernelGGL(fwd_kernel, dim3(grid), dim3(512), LDS_BYTES, stream, a); }
#else
    a.ph_lo = 0; a.ph_hi = NPHASE;
    hipLaunchKernelGGL(fwd_kernel, dim3(grid), dim3(512), LDS_BYTES, stream, a);
#endif
}
```

```cpp
#include <hip/hip_runtime.h>
#include <cstdio>
#include <cstdint>

#ifndef M2_F8
#define M2_F8 1
#endif
#define LAS __attribute__((address_space(3)))
#define GAS __attribute__((address_space(1)))
typedef unsigned short bf16_t;
typedef short bf16x8 __attribute__((ext_vector_type(8)));
typedef short s16x4 __attribute__((ext_vector_type(4)));
typedef float f32x2 __attribute__((ext_vector_type(2)));
typedef float f32x4 __attribute__((ext_vector_type(4)));
typedef float f32x16 __attribute__((ext_vector_type(16)));
typedef unsigned u32x2 __attribute__((ext_vector_type(2)));
typedef unsigned u32x4 __attribute__((ext_vector_type(4)));
#define DI __device__ __forceinline__

constexpr int D_MODEL = 1024, BATCH = 16, SEQ = 2048, T_TOK = BATCH * SEQ, DEPTH = 2;
constexpr float NORM_EPS = 1e-6f;
constexpr int IN_COLS = 6248, NP = 6400;
constexpr int N_EXP = 32, TOP_K = 4, D_EXP = 1024;
constexpr int NSLOT_MAX = T_TOK * TOP_K + N_EXP * 256;
constexpr int PC_GATE = 0, PC_CONV = 3072, PC_DQ = 4608, PC_IQ = 5120, PC_QLAT = 5632, PC_KVLAT = 5888, PC_DKV = 6048, PC_IK = 6176, PC_IW = 6240;
constexpr int OC_QLAT = 0, OC_KVLAT = 256, OC_CONV = 416, OC_DQ = 1952, OC_DKV = 2464, OC_IQ = 2592, OC_IK = 3104, OC_IW = 3168, OC_GATE = 3176;

DI unsigned pk2(float lo, float hi) { typedef __bf16 bf16x2_t __attribute__((ext_vector_type(2))); f32x2 v = {lo, hi}; bf16x2_t b = __builtin_convertvector(v, bf16x2_t); return __builtin_bit_cast(unsigned, b); }
DI float bf_lo(unsigned w) { return __uint_as_float(w << 16); }
DI float bf_hi(unsigned w) { return __uint_as_float(w & 0xffff0000u); }
DI float bf2f(bf16_t h) { return __uint_as_float((unsigned)h << 16); }
DI float wave_sum(float v) {
#pragma unroll
    for (int o = 1; o < 64; o <<= 1) v += __shfl_xor(v, o);
    return v;
}
DI float fast_sigmoid(float x) { return __builtin_amdgcn_rcpf(1.0f + __builtin_amdgcn_exp2f(-1.4426950408889634f * x)); }
DI unsigned pk4_fp8(float a, float b, float c, float d) { int w = __builtin_amdgcn_cvt_pk_fp8_f32(a, b, 0, false); w = __builtin_amdgcn_cvt_pk_fp8_f32(c, d, w, true); return (unsigned)w; }
#define LDS_WAIT() asm volatile("s_waitcnt lgkmcnt(0)" ::: "memory")
#define VM_WAIT() asm volatile("s_waitcnt vmcnt(0)" ::: "memory")

#ifndef PG8_F8_SPLITK
#define PG8_F8_SPLITK 0
#endif
#ifndef PG8_DMA_IN_MMA
#define PG8_DMA_IN_MMA 0
#endif
namespace pg8 {
DI void glds16_s(unsigned voff, const char* sbase, unsigned lds_dst) { unsigned keep; asm volatile("s_nop 4\n\ts_mov_b32 %0, m0\n\ts_mov_b32 m0, %3\n\ts_nop 0\n\tglobal_load_lds_dwordx4 %1, %2\n\ts_mov_b32 m0, %0" : "=&s"(keep) : "v"(voff), "s"(sbase), "s"(lds_dst) : "memory"); }
DI const char* uni_ptr(const char* p) { const unsigned long long v = (unsigned long long)p; const unsigned lo = __builtin_amdgcn_readfirstlane((unsigned)v), hi = __builtin_amdgcn_readfirstlane((unsigned)(v >> 32)); return (const char*)(GAS const char*)(((unsigned long long)hi << 32) | lo); }
constexpr int BM = 256, BK = 64, HALF = 128, HTB = HALF * BK * 2, STAGE_BYTES = 8 * HTB, NXCD = 8, WGM = 8;
__host__ __device__ __forceinline__ int lds_byte(int r, int c) { const int st = (r >> 4) * 2 + (c >> 5), rr = r & 15, cc = c & 31, ob = rr * 64 + cc * 2; return st * 1024 + (ob ^ (((ob >> 9) & 1) << 5)); }
__host__ __device__ __forceinline__ void stage_rc(int b, int& R, int& C) { const int st = b / 1024, sb = b % 1024, swz = sb ^ (((sb >> 9) & 1) << 5); R = (st >> 1) * 16 + swz / 64; C = (st & 1) * 32 + (swz % 64) / 2; }
__host__ __device__ __forceinline__ int perm32(int rho) { const int n = rho >> 4, i = rho & 15; return 8 * (i >> 2) + 4 * n + (i & 3); }
struct Unit { int pm, pn; };
struct StaticOrder {
    int nM, nN, nwg, G, c;
    DI void init(int nM_, int nN_, int G_, int c_) { nM = nM_; nN = nN_; nwg = nM * nN; G = G_; c = c_; }
    DI bool next(int i, Unit& u) const {
        const long L = (long)i * G + c; if (L >= nwg) return false;
        int wgid = (int)L; { const int q = nwg / NXCD, r = nwg % NXCD, xcd = wgid % NXCD, off = wgid / NXCD; wgid = (xcd < r ? xcd * (q + 1) : r * (q + 1) + (xcd - r) * q) + off; }
        const int nig = WGM * nN, gid = wgid / nig, fm = gid * WGM, gsz = (nM - fm) < WGM ? (nM - fm) : WGM;
        u.pm = fm + ((wgid % nig) % gsz); u.pn = (wgid % nig) / gsz; return true;
    }
};

template <class Epi, class Sched, bool ALIGN_EPI = true, bool SP2 = true>
DI void gemm_phase(LAS unsigned char* lds, const int tid, const int K, const Sched& S, const Epi& E) {
    const int wid = __builtin_amdgcn_readfirstlane(tid >> 6), lane = tid & 63, wr = wid >> 2, wc = wid & 3, fr = lane & 15, fq = lane >> 4;
    const int nt = K / BK;
    unsigned voffA[2], voffB[2];
#pragma unroll
    for (int i = 0; i < 2; ++i) { int R, C; stage_rc(tid * 16 + i * 8192, R, C); const int Rb = Epi::PERM ? ((R & ~31) + perm32(R & 31)) : R;
        voffA[i] = (unsigned)(R * K + C) * 2u; voffB[i] = (unsigned)(Rb * K + C) * 2u; }
    const size_t kstep = (size_t)(BK * 2);
    const size_t hstep = (size_t)HALF * K * 2;
    const unsigned ldsw = (unsigned)wid * 1024u; const unsigned ldsb = (unsigned)(unsigned long long)(lds);
    const int aoff = lds_byte(wr * 64 + fr, fq * 8), boff = lds_byte(wc * 32 + fr, fq * 8);
#define PG8_SA(b, h) (((b) * 2 + (h)) * HTB)
#define PG8_SB(b, h) ((4 + (b) * 2 + (h)) * HTB)
#define PG8_STAGE(bufoff, gbase, voff) do { _Pragma("unroll") for (int _i = 0; _i < 2; ++_i) \
        glds16_s((voff)[_i], (const char*)(gbase), ldsb + (unsigned)(bufoff) + ldsw + (unsigned)(_i * 8192)); } while (0)
#define PG8_LDA(dst, b, h) do { int a_ = aoff; asm volatile("" : "+v"(a_)); _Pragma("unroll") for (int m = 0; m < 4; ++m) _Pragma("unroll") for (int k = 0; k < 2; ++k) dst[m][k] = *(const LAS bf16x8*)(lds + PG8_SA(b, h) + a_ + m * 2048 + k * 1024); } while (0)
#define PG8_LDB(dst, b, h) do { int b_ = boff; asm volatile("" : "+v"(b_)); _Pragma("unroll") for (int n = 0; n < 2; ++n) _Pragma("unroll") for (int k = 0; k < 2; ++k) dst[n][k] = *(const LAS bf16x8*)(lds + PG8_SB(b, h) + b_ + n * 2048 + k * 1024); } while (0)
#define PG8_MMA(ai, bj, At, Bt) do { __builtin_amdgcn_s_setprio(1); _Pragma("unroll") for (int m = 0; m < 4; ++m) _Pragma("unroll") for (int n = 0; n < 2; ++n) _Pragma("unroll") for (int k = 0; k < 2; ++k) \
        acc[ai][bj][m][n] = __builtin_amdgcn_mfma_f32_16x16x32_bf16(Bt[n][k], At[m][k], acc[ai][bj][m][n], 0, 0, 0); __builtin_amdgcn_s_setprio(0); } while (0)
#define PG8_WAIT_V(n) asm volatile("s_waitcnt vmcnt(" #n ")" ::: "memory")
#define PG8_WAIT_L(n) asm volatile("s_waitcnt lgkmcnt(" #n ")" ::: "memory")
#define PG8_BAR __builtin_amdgcn_s_barrier()
#define PG8_SCHED __builtin_amdgcn_sched_barrier(0)
    Unit cur, nxt; int ui = 0;
    if (!S.next(0, cur)) return;
    float zf_ = 0.f; asm volatile("" : "+v"(zf_));
    f32x4 acc[2][2][4][2];
#pragma unroll
    for (int a = 0; a < 2; ++a)
#pragma unroll
        for (int b = 0; b < 2; ++b)
#pragma unroll
            for (int m = 0; m < 4; ++m)
#pragma unroll
                for (int n = 0; n < 2; ++n) acc[a][b][m][n] = (f32x4){zf_, zf_, zf_, zf_};
    bf16x8 At[4][2], B0[2][2], B1[2][2];
    const char* cA = uni_ptr(S.abase(cur)); const char* cB = uni_ptr(S.bbase(cur));
    if constexpr (SP2) {
        PG8_STAGE(PG8_SB(0, 0), cB, voffB); PG8_STAGE(PG8_SB(0, 1), cB + hstep, voffB); PG8_STAGE(PG8_SA(0, 0), cA, voffA); PG8_STAGE(PG8_SA(0, 1), cA + hstep, voffA);
        if (wr == 1) PG8_BAR;
        PG8_WAIT_V(2); PG8_BAR;
        PG8_STAGE(PG8_SB(1, 0), cB + kstep, voffB); PG8_STAGE(PG8_SA(1, 0), cA + kstep, voffA); PG8_STAGE(PG8_SB(1, 1), cB + hstep + kstep, voffB);
        PG8_WAIT_V(6); PG8_BAR;
    } else {
        PG8_STAGE(PG8_SB(0, 0), cB, voffB); PG8_STAGE(PG8_SA(0, 0), cA, voffA); PG8_STAGE(PG8_SB(0, 1), cB + hstep, voffB); PG8_STAGE(PG8_SA(0, 1), cA + hstep, voffA);
        if (wr == 1) PG8_BAR;
        PG8_WAIT_V(4); PG8_BAR;
        PG8_STAGE(PG8_SB(1, 0), cB + kstep, voffB); PG8_STAGE(PG8_SA(1, 0), cA + kstep, voffA); PG8_STAGE(PG8_SB(1, 1), cB + hstep + kstep, voffB);
        PG8_WAIT_V(6); PG8_BAR;
    }
    for (;;) {
        const bool has_next = S.next(ui + 1, nxt);
        const char* nA = has_next ? uni_ptr(S.abase(nxt)) : cA; const char* nB = has_next ? uni_ptr(S.bbase(nxt)) : cB;
        for (int t = 0; t < nt; t += 2) {
            const bool last = (t == nt - 2);
            const char* a1 = cA + (size_t)(t + 1) * kstep;
            const char* a2 = last ? nA : cA + (size_t)(t + 2) * kstep; const char* b2 = last ? nB : cB + (size_t)(t + 2) * kstep;
            const char* a3 = a2 + kstep; const char* b3 = b2 + kstep;
            if constexpr (SP2) {
            PG8_LDB(B0, 0, 0); PG8_LDB(B1, 0, 1); PG8_SCHED; PG8_LDA(At, 0, 0); PG8_STAGE(PG8_SA(1, 1), a1 + hstep, voffA);
            PG8_WAIT_V(8); PG8_WAIT_L(0); PG8_BAR; PG8_MMA(0, 0, At, B0); PG8_MMA(0, 1, At, B1); PG8_BAR; PG8_SCHED;
            PG8_LDA(At, 0, 1); PG8_STAGE(PG8_SB(0, 0), b2, voffB); PG8_STAGE(PG8_SB(0, 1), b2 + hstep, voffB); PG8_STAGE(PG8_SA(0, 0), a2, voffA);
            PG8_WAIT_V(8); PG8_WAIT_L(0); PG8_BAR; PG8_MMA(1, 0, At, B0); PG8_MMA(1, 1, At, B1); PG8_BAR; PG8_SCHED;
            PG8_LDB(B0, 1, 0); PG8_LDB(B1, 1, 1); PG8_SCHED; PG8_LDA(At, 1, 0); PG8_STAGE(PG8_SA(0, 1), a2 + hstep, voffA);
            PG8_WAIT_V(8); PG8_WAIT_L(0); PG8_BAR; PG8_MMA(0, 0, At, B0); PG8_MMA(0, 1, At, B1); PG8_BAR; PG8_SCHED;
            PG8_LDA(At, 1, 1); PG8_STAGE(PG8_SB(1, 0), b3, voffB); PG8_STAGE(PG8_SB(1, 1), b3 + hstep, voffB); PG8_STAGE(PG8_SA(1, 0), a3, voffA);
            PG8_WAIT_V(8); PG8_WAIT_L(0); PG8_BAR; PG8_MMA(1, 0, At, B0); PG8_MMA(1, 1, At, B1); PG8_BAR; PG8_SCHED;
            } else {
            PG8_LDB(B0, 0, 0); PG8_SCHED; PG8_LDA(At, 0, 0); PG8_STAGE(PG8_SA(1, 1), a1 + hstep, voffA);
            PG8_WAIT_L(8); PG8_BAR; PG8_WAIT_L(0); PG8_MMA(0, 0, At, B0); PG8_BAR; PG8_SCHED;
            PG8_LDB(B1, 0, 1); PG8_STAGE(PG8_SB(0, 0), b2, voffB);
            PG8_BAR; PG8_WAIT_L(0); PG8_MMA(0, 1, At, B1); PG8_BAR;
            PG8_LDA(At, 0, 1); PG8_STAGE(PG8_SA(0, 0), a2, voffA);
            PG8_BAR; PG8_WAIT_L(0); PG8_MMA(1, 0, At, B0); PG8_BAR; PG8_SCHED;
            PG8_STAGE(PG8_SB(0, 1), b2 + hstep, voffB);
            PG8_WAIT_V(6); PG8_BAR; PG8_MMA(1, 1, At, B1); PG8_BAR;
            PG8_LDB(B0, 1, 0); PG8_SCHED; PG8_LDA(At, 1, 0); PG8_STAGE(PG8_SA(0, 1), a2 + hstep, voffA);
            PG8_WAIT_L(8); PG8_BAR; PG8_WAIT_L(0); PG8_MMA(0, 0, At, B0); PG8_BAR; PG8_SCHED;
            PG8_LDB(B1, 1, 1); PG8_STAGE(PG8_SB(1, 0), b3, voffB);
            PG8_BAR; PG8_WAIT_L(0); PG8_MMA(0, 1, At, B1); PG8_BAR;
            PG8_LDA(At, 1, 1); PG8_STAGE(PG8_SA(1, 0), a3, voffA);
            PG8_BAR; PG8_WAIT_L(0); PG8_MMA(1, 0, At, B0); PG8_BAR; PG8_SCHED;
            PG8_STAGE(PG8_SB(1, 1), b3 + hstep, voffB);
            PG8_WAIT_V(6); PG8_BAR; PG8_MMA(1, 1, At, B1); PG8_BAR;
            }
        }
        if constexpr (ALIGN_EPI) { if (wr == 0) PG8_BAR; }
        E(acc, cur, wr, wc, fr, fq);
        if (!has_next) break;
#pragma unroll
        for (int a = 0; a < 2; ++a)
#pragma unroll
            for (int b = 0; b < 2; ++b)
#pragma unroll
                for (int m = 0; m < 4; ++m)
#pragma unroll
                    for (int n = 0; n < 2; ++n) acc[a][b][m][n] = (f32x4){zf_, zf_, zf_, zf_};
        cur = nxt; cA = nA; cB = nB; ++ui;
        if constexpr (ALIGN_EPI) { if (wr == 1) PG8_BAR; }
    }
    PG8_WAIT_V(0);
    if constexpr (!ALIGN_EPI) { if (wr == 0) PG8_BAR; }
    PG8_BAR;
#undef PG8_SA
#undef PG8_SB
#undef PG8_STAGE
#undef PG8_LDA
#undef PG8_LDB
#undef PG8_MMA
#undef PG8_WAIT_V
#undef PG8_WAIT_L
#undef PG8_BAR
#undef PG8_SCHED
}
typedef int v8i __attribute__((ext_vector_type(8)));
template <class Epi, class Sched, bool ALIGN_EPI = true, bool SP2 = true, bool TILEDA = false>
DI void gemm_phase_f8(LAS unsigned char* lds, const int tid, const int KB, const Sched& S, const Epi& E) {
    const int wid = __builtin_amdgcn_readfirstlane(tid >> 6), lane = tid & 63, wr = wid >> 2, wc = wid & 3, fr = lane & 15, fq = lane >> 4;
    const int nt = KB / 128;
    unsigned voffA[2], voffB[2];
#pragma unroll
    for (int i = 0; i < 2; ++i) { int R, C; stage_rc(tid * 16 + i * 8192, R, C); const int Rb = Epi::PERM ? ((R & ~31) + perm32(R & 31)) : R;
        voffA[i] = TILEDA ? (unsigned)(R * 128 + 2 * C) : (unsigned)(R * KB + 2 * C); voffB[i] = (unsigned)(Rb * KB + 2 * C); }
    const size_t kstep = (size_t)(BK * 2);
    const size_t hstep = (size_t)HALF * KB;
    const size_t kstepA = TILEDA ? (size_t)(256 * 128) : kstep, hstepA = TILEDA ? (size_t)(HALF * 128) : hstep;
    const unsigned ldsw = (unsigned)wid * 1024u; const unsigned ldsb = (unsigned)(unsigned long long)(lds);
#if PG8_F8_SPLITK
    const int aoff = lds_byte(wr * 64 + fr, fq * 8), boff = lds_byte(wc * 32 + fr, fq * 8);
#else
    const int aoff = lds_byte(wr * 64 + fr, fq * 16), boff = lds_byte(wc * 32 + fr, fq * 16);
#endif
#define PG8_SA(b, h) (((b) * 2 + (h)) * HTB)
#define PG8_SB(b, h) ((4 + (b) * 2 + (h)) * HTB)
#define PG8_STAGE(bufoff, gbase, voff) do { _Pragma("unroll") for (int _i = 0; _i < 2; ++_i) \
        glds16_s((voff)[_i], (const char*)(gbase), ldsb + (unsigned)(bufoff) + ldsw + (unsigned)(_i * 8192)); } while (0)
#if PG8_F8_SPLITK
#define PG8_LD32(p_) ([&]() { const u32x4 lo_ = *(const LAS u32x4*)(p_), hi_ = *(const LAS u32x4*)((p_) + 1024); return (v8i){(int)lo_.x, (int)lo_.y, (int)lo_.z, (int)lo_.w, (int)hi_.x, (int)hi_.y, (int)hi_.z, (int)hi_.w}; }())
#else
#define PG8_LD32(p_) (*(const LAS v8i*)(p_))
#endif
#define PG8_LDA(dst, b, h) do { int a_ = aoff; asm volatile("" : "+v"(a_)); _Pragma("unroll") for (int m = 0; m < 4; ++m) dst[m] = PG8_LD32(lds + PG8_SA(b, h) + a_ + m * 2048); } while (0)
#define PG8_LDB(dst, b, h) do { int b_ = boff; asm volatile("" : "+v"(b_)); _Pragma("unroll") for (int n = 0; n < 2; ++n) dst[n] = PG8_LD32(lds + PG8_SB(b, h) + b_ + n * 2048); } while (0)
#define PG8_MMA(ai, bj, At, Bt) do { __builtin_amdgcn_s_setprio(1); _Pragma("unroll") for (int m = 0; m < 4; ++m) _Pragma("unroll") for (int n = 0; n < 2; ++n) \
        acc[ai][bj][m][n] = __builtin_amdgcn_mfma_scale_f32_16x16x128_f8f6f4(Bt[n], At[m], acc[ai][bj][m][n], 0, 0, 0, sc8, 0, sc8); __builtin_amdgcn_s_setprio(0); } while (0)
#define PG8_PIECE(bufoff, gbase, voff, i) do { glds16_s((voff)[i], (const char*)(gbase), ldsb + (unsigned)(bufoff) + ldsw + (unsigned)((i) * 8192)); __builtin_amdgcn_sched_barrier(0); } while (0)
#define PG8_MMA_I(ai, bj, At, Bt, P1, P2, P3) do { __builtin_amdgcn_s_setprio(1); _Pragma("unroll") for (int m = 0; m < 4; ++m) _Pragma("unroll") for (int n = 0; n < 2; ++n) { \
        acc[ai][bj][m][n] = __builtin_amdgcn_mfma_scale_f32_16x16x128_f8f6f4(Bt[n], At[m], acc[ai][bj][m][n], 0, 0, 0, sc8, 0, sc8); \
        if (2 * m + n == 1) { __builtin_amdgcn_sched_barrier(0); P1; } if (2 * m + n == 3) { __builtin_amdgcn_sched_barrier(0); P2; } if (2 * m + n == 5) { __builtin_amdgcn_sched_barrier(0); P3; } } __builtin_amdgcn_s_setprio(0); } while (0)
#define PG8_WAIT_V(n) asm volatile("s_waitcnt vmcnt(" #n ")" ::: "memory")
#define PG8_WAIT_L(n) asm volatile("s_waitcnt lgkmcnt(" #n ")" ::: "memory")
#define PG8_BAR __builtin_amdgcn_s_barrier()
#define PG8_SCHED __builtin_amdgcn_sched_barrier(0)
    Unit cur, nxt; int ui = 0;
    if (!S.next(0, cur)) return;
    int sc8 = 0x7c7c7c7c; asm volatile("" : "+v"(sc8));
    float zf_ = 0.f; asm volatile("" : "+v"(zf_));
    f32x4 acc[2][2][4][2];
#pragma unroll
    for (int a = 0; a < 2; ++a)
#pragma unroll
        for (int b = 0; b < 2; ++b)
#pragma unroll
            for (int m = 0; m < 4; ++m)
#pragma unroll
                for (int n = 0; n < 2; ++n) acc[a][b][m][n] = (f32x4){zf_, zf_, zf_, zf_};
    v8i At[4], B0[2], B1[2];
    const char* cA = uni_ptr(S.abase(cur)); const char* cB = uni_ptr(S.bbase(cur));
    if constexpr (SP2) {
        PG8_STAGE(PG8_SB(0, 0), cB, voffB); PG8_STAGE(PG8_SB(0, 1), cB + hstep, voffB); PG8_STAGE(PG8_SA(0, 0), cA, voffA); PG8_STAGE(PG8_SA(0, 1), cA + hstepA, voffA);
        if (wr == 1) PG8_BAR;
        PG8_WAIT_V(2); PG8_BAR;
        PG8_STAGE(PG8_SB(1, 0), cB + kstep, voffB); PG8_STAGE(PG8_SA(1, 0), cA + kstepA, voffA); PG8_STAGE(PG8_SB(1, 1), cB + hstep + kstep, voffB);
        PG8_WAIT_V(6); PG8_BAR;
    } else {
        PG8_STAGE(PG8_SB(0, 0), cB, voffB); PG8_STAGE(PG8_SA(0, 0), cA, voffA); PG8_STAGE(PG8_SB(0, 1), cB + hstep, voffB); PG8_STAGE(PG8_SA(0, 1), cA + hstepA, voffA);
        if (wr == 1) PG8_BAR;
        PG8_WAIT_V(4); PG8_BAR;
        PG8_STAGE(PG8_SB(1, 0), cB + kstep, voffB); PG8_STAGE(PG8_SA(1, 0), cA + kstepA, voffA); PG8_STAGE(PG8_SB(1, 1), cB + hstep + kstep, voffB);
        PG8_WAIT_V(6); PG8_BAR;
    }
    for (;;) {
        const bool has_next = S.next(ui + 1, nxt);
        const char* nA = has_next ? uni_ptr(S.abase(nxt)) : cA; const char* nB = has_next ? uni_ptr(S.bbase(nxt)) : cB;
        for (int t = 0; t < nt; t += 2) {
            const bool last = (t == nt - 2);
            const char* a1 = cA + (size_t)(t + 1) * kstepA;
            const char* a2 = last ? nA : cA + (size_t)(t + 2) * kstepA; const char* b2 = last ? nB : cB + (size_t)(t + 2) * kstep;
            const char* a3 = a2 + kstepA; const char* b3 = b2 + kstep;
            if constexpr (SP2) {
#if PG8_DMA_IN_MMA
            PG8_LDB(B0, 0, 0); PG8_LDB(B1, 0, 1); PG8_SCHED; PG8_LDA(At, 0, 0);
            PG8_WAIT_V(6); PG8_WAIT_L(0); PG8_BAR; PG8_MMA_I(0, 0, At, B0, , PG8_PIECE(PG8_SA(1, 1), a1 + hstepA, voffA, 0), ); PG8_MMA_I(0, 1, At, B1, , PG8_PIECE(PG8_SA(1, 1), a1 + hstepA, voffA, 1), ); PG8_BAR; PG8_SCHED;
            PG8_LDA(At, 0, 1);
            PG8_WAIT_V(2); PG8_WAIT_L(0); PG8_BAR; PG8_MMA_I(1, 0, At, B0, PG8_PIECE(PG8_SB(0, 0), b2, voffB, 0), PG8_PIECE(PG8_SB(0, 0), b2, voffB, 1), PG8_PIECE(PG8_SB(0, 1), b2 + hstep, voffB, 0));
            PG8_MMA_I(1, 1, At, B1, PG8_PIECE(PG8_SB(0, 1), b2 + hstep, voffB, 1), PG8_PIECE(PG8_SA(0, 0), a2, voffA, 0), PG8_PIECE(PG8_SA(0, 0), a2, voffA, 1)); PG8_BAR; PG8_SCHED;
            PG8_LDB(B0, 1, 0); PG8_LDB(B1, 1, 1); PG8_SCHED; PG8_LDA(At, 1, 0);
            PG8_WAIT_V(6); PG8_WAIT_L(0); PG8_BAR; PG8_MMA_I(0, 0, At, B0, , PG8_PIECE(PG8_SA(0, 1), a2 + hstepA, voffA, 0), ); PG8_MMA_I(0, 1, At, B1, , PG8_PIECE(PG8_SA(0, 1), a2 + hstepA, voffA, 1), ); PG8_BAR; PG8_SCHED;
            PG8_LDA(At, 1, 1);
            PG8_WAIT_V(2); PG8_WAIT_L(0); PG8_BAR; PG8_MMA_I(1, 0, At, B0, PG8_PIECE(PG8_SB(1, 0), b3, voffB, 0), PG8_PIECE(PG8_SB(1, 0), b3, voffB, 1), PG8_PIECE(PG8_SB(1, 1), b3 + hstep, voffB, 0));
            PG8_MMA_I(1, 1, At, B1, PG8_PIECE(PG8_SB(1, 1), b3 + hstep, voffB, 1), PG8_PIECE(PG8_SA(1, 0), a3, voffA, 0), PG8_PIECE(PG8_SA(1, 0), a3, voffA, 1)); PG8_BAR; PG8_SCHED;
#else
            PG8_LDB(B0, 0, 0); PG8_LDB(B1, 0, 1); PG8_SCHED; PG8_LDA(At, 0, 0); PG8_STAGE(PG8_SA(1, 1), a1 + hstepA, voffA);
            PG8_WAIT_V(8); PG8_WAIT_L(0); PG8_BAR; PG8_MMA(0, 0, At, B0); PG8_MMA(0, 1, At, B1); PG8_BAR; PG8_SCHED;
            PG8_LDA(At, 0, 1); PG8_STAGE(PG8_SB(0, 0), b2, voffB); PG8_STAGE(PG8_SB(0, 1), b2 + hstep, voffB); PG8_STAGE(PG8_SA(0, 0), a2, voffA);
            PG8_WAIT_V(8); PG8_WAIT_L(0); PG8_BAR; PG8_MMA(1, 0, At, B0); PG8_MMA(1, 1, At, B1); PG8_BAR; PG8_SCHED;
            PG8_LDB(B0, 1, 0); PG8_LDB(B1, 1, 1); PG8_SCHED; PG8_LDA(At, 1, 0); PG8_STAGE(PG8_SA(0, 1), a2 + hstepA, voffA);
            PG8_WAIT_V(8); PG8_WAIT_L(0); PG8_BAR; PG8_MMA(0, 0, At, B0); PG8_MMA(0, 1, At, B1); PG8_BAR; PG8_SCHED;
            PG8_LDA(At, 1, 1); PG8_STAGE(PG8_SB(1, 0), b3, voffB); PG8_STAGE(PG8_SB(1, 1), b3 + hstep, voffB); PG8_STAGE(PG8_SA(1, 0), a3, voffA);
            PG8_WAIT_V(8); PG8_WAIT_L(0); PG8_BAR; PG8_MMA(1, 0, At, B0); PG8_MMA(1, 1, At, B1); PG8_BAR; PG8_SCHED;
#endif
            } else {
            PG8_LDB(B0, 0, 0); PG8_SCHED; PG8_LDA(At, 0, 0); PG8_STAGE(PG8_SA(1, 1), a1 + hstepA, voffA);
            PG8_WAIT_L(8); PG8_BAR; PG8_WAIT_L(0); PG8_MMA(0, 0, At, B0); PG8_BAR; PG8_SCHED;
            PG8_LDB(B1, 0, 1); PG8_STAGE(PG8_SB(0, 0), b2, voffB);
            PG8_BAR; PG8_WAIT_L(0); PG8_MMA(0, 1, At, B1); PG8_BAR;
            PG8_LDA(At, 0, 1); PG8_STAGE(PG8_SA(0, 0), a2, voffA);
            PG8_BAR; PG8_WAIT_L(0); PG8_MMA(1, 0, At, B0); PG8_BAR; PG8_SCHED;
            PG8_STAGE(PG8_SB(0, 1), b2 + hstep, voffB);
            PG8_WAIT_V(6); PG8_BAR; PG8_MMA(1, 1, At, B1); PG8_BAR;
            PG8_LDB(B0, 1, 0); PG8_SCHED; PG8_LDA(At, 1, 0); PG8_STAGE(PG8_SA(0, 1), a2 + hstepA, voffA);
            PG8_WAIT_L(8); PG8_BAR; PG8_WAIT_L(0); PG8_MMA(0, 0, At, B0); PG8_BAR; PG8_SCHED;
            PG8_LDB(B1, 1, 1); PG8_STAGE(PG8_SB(1, 0), b3, voffB);
            PG8_BAR; PG8_WAIT_L(0); PG8_MMA(0, 1, At, B1); PG8_BAR;
            PG8_LDA(At, 1, 1); PG8_STAGE(PG8_SA(1, 0), a3, voffA);
            PG8_BAR; PG8_WAIT_L(0); PG8_MMA(1, 0, At, B0); PG8_BAR; PG8_SCHED;
            PG8_STAGE(PG8_SB(1, 1), b3 + hstep, voffB);
            PG8_WAIT_V(6); PG8_BAR; PG8_MMA(1, 1, At, B1); PG8_BAR;
            }
        }
        if constexpr (ALIGN_EPI) { if (wr == 0) PG8_BAR; }
        asm volatile("" ::: "memory"); __builtin_amdgcn_sched_barrier(0);
        { int t2_ = tid; asm volatile("" : "+v"(t2_)); const int w2_ = __builtin_amdgcn_readfirstlane(t2_ >> 6), l2_ = t2_ & 63; E(acc, cur, w2_ >> 2, w2_ & 3, l2_ & 15, l2_ >> 4); }
        if (!has_next) break;
#pragma unroll
        for (int a = 0; a < 2; ++a)
#pragma unroll
            for (int b = 0; b < 2; ++b)
#pragma unroll
                for (int m = 0; m < 4; ++m)
#pragma unroll
                    for (int n = 0; n < 2; ++n) acc[a][b][m][n] = (f32x4){zf_, zf_, zf_, zf_};
        cur = nxt; cA = nA; cB = nB; ++ui;
        if constexpr (ALIGN_EPI) { if (wr == 1) PG8_BAR; }
    }
    PG8_WAIT_V(0);
    if constexpr (!ALIGN_EPI) { if (wr == 0) PG8_BAR; }
    PG8_BAR;
#undef PG8_SA
#undef PG8_SB
#undef PG8_STAGE
#undef PG8_LDA
#undef PG8_LD32
#undef PG8_LDB
#undef PG8_MMA
#undef PG8_MMA_I
#undef PG8_PIECE
#undef PG8_WAIT_V
#undef PG8_WAIT_L
#undef PG8_BAR
#undef PG8_SCHED
}
}

struct SchedPlain {
    pg8::StaticOrder o; const char* A; const char* B; size_t tstep;
    DI bool next(int i, pg8::Unit& u) const { return o.next(i, u); }
    DI const char* abase(const pg8::Unit& u) const { return A + (size_t)u.pm * tstep; }
    DI const char* bbase(const pg8::Unit& u) const { return B + (size_t)u.pn * tstep; }
};
struct SchedBranch {
    pg8::StaticOrder o; const char* A; const char* B; size_t tstep, aslab;
    DI bool next(int i, pg8::Unit& u) const { pg8::Unit t; if (!o.next(i / 3, t)) return false; u.pm = t.pm; u.pn = t.pn + 4 * (i % 3); return true; }
    DI const char* abase(const pg8::Unit& u) const { return A + (size_t)(u.pn >> 2) * aslab + (size_t)u.pm * tstep; }
    DI const char* bbase(const pg8::Unit& u) const { return B + (size_t)u.pn * tstep; }
};
struct SchedMoe {
    pg8::StaticOrder o; const char* A; const char* B; unsigned eslab; const LAS int* texp;
    DI bool next(int i, pg8::Unit& u) const { return o.next(i, u); }
#ifdef PROBE_FIXAB
    int fix = 0;
    DI const char* abase(const pg8::Unit& u) const { return A + ((fix & 1) ? (size_t)0 : (size_t)u.pm * (256u * 1024u)); }
    DI const char* bbase(const pg8::Unit& u) const { return B + ((fix & 2) ? (size_t)0 : (size_t)((unsigned)texp[u.pm] * eslab) + (size_t)u.pn * (256u * 1024u)); }
#else
    DI const char* abase(const pg8::Unit& u) const { return A + (size_t)u.pm * (256u * 1024u); }
    DI const char* bbase(const pg8::Unit& u) const { return B + (size_t)((unsigned)texp[u.pm] * eslab) + (size_t)u.pn * (256u * 1024u); }
#endif
};

struct SchedMoeB {
    pg8::StaticOrder o; const char* A; const char* B; unsigned eslab; const LAS int* texp;
    DI bool next(int i, pg8::Unit& u) const { return o.next(i, u); }
    DI const char* abase(const pg8::Unit& u) const { return A + (size_t)u.pm * (256u * 2048u); }
    DI const char* bbase(const pg8::Unit& u) const { return B + (size_t)((unsigned)texp[u.pm] * eslab) + (size_t)u.pn * (256u * 2048u); }
};

#ifndef EPI_QT
#define EPI_QT 1
#endif
#ifndef EPI_QT_ST
#define EPI_QT_ST 1
#endif
DI int qt_src(int lane) { return (((lane >> 2) + 16 * (lane & 3)) * 4); }
DI f32x4 qt4f(int src4, f32x4 v);
DI u32x4 qt4(int src4, u32x4 w) { u32x4 r; r.x = (unsigned)__builtin_amdgcn_ds_bpermute(src4, (int)w.x); r.y = (unsigned)__builtin_amdgcn_ds_bpermute(src4, (int)w.y); r.z = (unsigned)__builtin_amdgcn_ds_bpermute(src4, (int)w.z); r.w = (unsigned)__builtin_amdgcn_ds_bpermute(src4, (int)w.w); return r; }
DI f32x4 qt4f(int src4, f32x4 v) { return __builtin_bit_cast(f32x4, qt4(src4, __builtin_bit_cast(u32x4, v))); }
struct EpiStoreBf16 {
    static constexpr bool PERM = true;
    bf16_t* O; int ldc; int coff = 0;
#ifdef PROBE_NOSTORE
    bool skip = false;
#endif
    DI void operator()(const f32x4 (&acc)[2][2][4][2], const pg8::Unit& u, int wr, int wc, int fr, int fq) const {
#if EPI_QT_ST
        const int lane = fr + 16 * fq, src4 = qt_src(lane); fr = lane >> 2; fq = lane & 3;
#endif
        const int row0 = u.pm * 256 + wr * 64 + fr, col0 = coff + u.pn * 256 + wc * 32 + 8 * fq;
#pragma unroll
        for (int ai = 0; ai < 2; ++ai)
#pragma unroll
            for (int m = 0; m < 4; ++m) { bf16_t* rowp = O + (size_t)(row0 + ai * 128 + m * 16) * ldc + col0;
#pragma unroll
                for (int bj = 0; bj < 2; ++bj) { const f32x4 v0 = acc[ai][bj][m][0], v1 = acc[ai][bj][m][1];
                    u32x4 w; w.x = pk2(v0[0], v0[1]); w.y = pk2(v0[2], v0[3]); w.z = pk2(v1[0], v1[1]); w.w = pk2(v1[2], v1[3]);
#if EPI_QT_ST
                    w = qt4(src4, w);
#endif
#ifdef PROBE_NOSTORE
                    if (skip) { asm volatile("" :: "v"(w.x), "v"(w.y), "v"(w.z), "v"(w.w)); } else
#endif
                    *(u32x4*)(rowp + bj * 128) = w; } }
    }
};
struct EpiStoreBf16N {
    static constexpr bool PERM = false;
    bf16_t* O; int ldc; int coff = 0;
#ifdef PROBE_NOSTORE
    bool skip = false;
#endif
    DI void operator()(const f32x4 (&acc)[2][2][4][2], const pg8::Unit& u, int wr, int wc, int fr, int fq) const {
#if EPI_QT
#if EPI_QT_ST
        const int lane = fr + 16 * fq, a_ = lane >> 2, b_ = lane & 3, src4 = (a_ + 16 * (((b_ & 1) << 1) | (b_ >> 1))) * 4;
        const int row0 = u.pm * 256 + wr * 64 + a_, col0 = coff + u.pn * 256 + wc * 32 + 8 * b_;
#else
        const int row0 = u.pm * 256 + wr * 64 + fr, col0 = coff + u.pn * 256 + wc * 32 + 8 * (((fq & 1) << 1) | (fq >> 1));
#endif
#pragma unroll
        for (int ai = 0; ai < 2; ++ai)
#pragma unroll
            for (int m = 0; m < 4; ++m) { bf16_t* rowp = O + (size_t)(row0 + ai * 128 + m * 16) * ldc + col0;
#pragma unroll
                for (int bj = 0; bj < 2; ++bj) { const f32x4 v0 = acc[ai][bj][m][0], v1 = acc[ai][bj][m][1];
                    unsigned x0 = pk2(v0[0], v0[1]), y0 = pk2(v0[2], v0[3]), x1 = pk2(v1[0], v1[1]), y1 = pk2(v1[2], v1[3]);
                    { const auto r = __builtin_amdgcn_permlane16_swap(x0, x1, false, false); x0 = r[0]; x1 = r[1]; }
                    { const auto r = __builtin_amdgcn_permlane16_swap(y0, y1, false, false); y0 = r[0]; y1 = r[1]; }
                    u32x4 w; w.x = x0; w.y = y0; w.z = x1; w.w = y1;
#if EPI_QT_ST
                    w = qt4(src4, w);
#endif
#ifdef PROBE_NOSTORE
                    if (skip) { asm volatile("" :: "v"(w.x), "v"(w.y), "v"(w.z), "v"(w.w)); } else
#endif
                    *(u32x4*)(rowp + bj * 128) = w; } }
#else
        const int row0 = u.pm * 256 + wr * 64 + fr, col0 = coff + u.pn * 256 + wc * 32 + 4 * fq;
#pragma unroll
        for (int ai = 0; ai < 2; ++ai)
#pragma unroll
            for (int m = 0; m < 4; ++m) { bf16_t* rowp = O + (size_t)(row0 + ai * 128 + m * 16) * ldc + col0;
#pragma unroll
                for (int bj = 0; bj < 2; ++bj)
#pragma unroll
                    for (int n = 0; n < 2; ++n) { const f32x4 v = acc[ai][bj][m][n]; u32x2 w; w.x = pk2(v[0], v[1]); w.y = pk2(v[2], v[3]);
#ifdef PROBE_NOSTORE
                        if (skip) { asm volatile("" :: "v"(w.x), "v"(w.y)); } else
#endif
                        *(u32x2*)(rowp + bj * 128 + n * 16) = w; } }
#endif
    }
};
struct EpiQaRope {
    static constexpr bool PERM = true;
    bf16_t* O; const float* rope;
    DI void operator()(const f32x4 (&acc)[2][2][4][2], const pg8::Unit& u, int wr, int wc, int fr, int fq) const {
        const int row0 = u.pm * 256 + wr * 64 + fr, col0 = u.pn * 256 + wc * 32 + 8 * fq;
#pragma unroll
        for (int ai = 0; ai < 2; ++ai)
#pragma unroll
            for (int m = 0; m < 4; ++m) { const int row = row0 + ai * 128 + m * 16; bf16_t* rowp = O + (size_t)row * 768 + col0;
#pragma unroll
                for (int bj = 0; bj < 2; ++bj) { f32x4 v0 = acc[ai][bj][m][0], v1 = acc[ai][bj][m][1];
                    const int c8 = col0 + bj * 128, p0 = c8 % 96;
                    if (p0 < 32) { const f32x4* cs = (const f32x4*)(rope + (size_t)row * 48 + p0); const f32x4 a = cs[0], b = cs[1];
                        const f32x4 r0 = {v0[0] * a[0] - v0[1] * a[1], v0[1] * a[0] + v0[0] * a[1], v0[2] * a[2] - v0[3] * a[3], v0[3] * a[2] + v0[2] * a[3]};
                        const f32x4 r1 = {v1[0] * b[0] - v1[1] * b[1], v1[1] * b[0] + v1[0] * b[1], v1[2] * b[2] - v1[3] * b[3], v1[3] * b[2] + v1[2] * b[3]};
                        v0 = r0; v1 = r1; }
                    u32x4 w; w.x = pk2(v0[0], v0[1]); w.y = pk2(v0[2], v0[3]); w.z = pk2(v1[0], v1[1]); w.w = pk2(v1[2], v1[3]);
                    *(u32x4*)(rowp + bj * 128) = w; } }
    }
};
struct EpiBranchGate {
    static constexpr bool PERM = true;
    bf16_t* MG; const bf16_t* P; const float* bgate;
    DI void operator()(const f32x4 (&acc)[2][2][4][2], const pg8::Unit& u, int wr, int wc, int fr, int fq) const {
#if EPI_QT
        const int lane = fr + 16 * fq, src4 = qt_src(lane); fr = lane >> 2; fq = lane & 3;
#endif
        const int n = u.pn >> 2, row0 = u.pm * 256 + wr * 64 + fr, colg = u.pn * 256 + wc * 32 + 8 * fq, col0 = colg - n * 1024;
        f32x4 bg[2][2];
#pragma unroll
        for (int bj = 0; bj < 2; ++bj) { bg[bj][0] = *(const f32x4*)(bgate + colg + bj * 128); bg[bj][1] = *(const f32x4*)(bgate + colg + bj * 128 + 4); }
        u32x4 gl[2][2][2], pv[2][2][2];
#define EBG_LOAD(slot, grp) do { _Pragma("unroll") for (int m2 = 0; m2 < 2; ++m2) _Pragma("unroll") for (int bj = 0; bj < 2; ++bj) { const size_t row = (size_t)(row0 + ((grp) >> 1) * 128 + (2 * ((grp) & 1) + m2) * 16); \
            gl[slot][m2][bj] = *(const u32x4*)(P + row * NP + colg + bj * 128); pv[slot][m2][bj] = (n > 0) ? *(const u32x4*)(MG + row * D_MODEL + col0 + bj * 128) : (u32x4){0u, 0u, 0u, 0u}; } } while (0)
        EBG_LOAD(0, 0);
#pragma unroll
        for (int grp = 0; grp < 4; ++grp) {
            const int slot = grp & 1, ai = grp >> 1, mh = grp & 1;
            if (grp + 1 < 4) { if (slot == 0) EBG_LOAD(1, grp + 1); else EBG_LOAD(0, grp + 1); }
            asm volatile("" ::: "memory");
#pragma unroll
            for (int m2 = 0; m2 < 2; ++m2)
#pragma unroll
                for (int bj = 0; bj < 2; ++bj) { const int m = 2 * mh + m2; const size_t row = (size_t)(row0 + ai * 128 + m * 16);
#if EPI_QT
                    const f32x4 v0 = qt4f(src4, acc[ai][bj][m][0]), v1 = qt4f(src4, acc[ai][bj][m][1]);
#else
                    const f32x4 v0 = acc[ai][bj][m][0], v1 = acc[ai][bj][m][1];
#endif
                    const u32x4 g = gl[slot][m2][bj], q = pv[slot][m2][bj];
                    float o[8];
                    o[0] = v0[0] * fast_sigmoid(bf_lo(g.x) + bg[bj][0][0]) + bf_lo(q.x); o[1] = v0[1] * fast_sigmoid(bf_hi(g.x) + bg[bj][0][1]) + bf_hi(q.x);
                    o[2] = v0[2] * fast_sigmoid(bf_lo(g.y) + bg[bj][0][2]) + bf_lo(q.y); o[3] = v0[3] * fast_sigmoid(bf_hi(g.y) + bg[bj][0][3]) + bf_hi(q.y);
                    o[4] = v1[0] * fast_sigmoid(bf_lo(g.z) + bg[bj][1][0]) + bf_lo(q.z); o[5] = v1[1] * fast_sigmoid(bf_hi(g.z) + bg[bj][1][1]) + bf_hi(q.z);
                    o[6] = v1[2] * fast_sigmoid(bf_lo(g.w) + bg[bj][1][2]) + bf_lo(q.w); o[7] = v1[3] * fast_sigmoid(bf_hi(g.w) + bg[bj][1][3]) + bf_hi(q.w);
                    u32x4 w; w.x = pk2(o[0], o[1]); w.y = pk2(o[2], o[3]); w.z = pk2(o[4], o[5]); w.w = pk2(o[6], o[7]);
                    *(u32x4*)(MG + row * D_MODEL + col0 + bj * 128) = w; }
        }
#undef EBG_LOAD
    }
};
struct EpiResidual {
    static constexpr bool PERM = false;
    const float* xin; float* xout; const float* gmod;
    DI void operator()(const f32x4 (&acc)[2][2][4][2], const pg8::Unit& u, int wr, int wc, int fr, int fq) const {
#if EPI_QT
        const int lane = fr + 16 * fq, src4 = qt_src(lane); fr = lane >> 2; fq = lane & 3;
#endif
        const int row0 = u.pm * 256 + wr * 64 + fr, col0 = u.pn * 256 + wc * 32 + 4 * fq;
        const float* gm = gmod + (size_t)(u.pm >> 3) * 6144 + col0;
        f32x4 gv[2][2];
#pragma unroll
        for (int bj = 0; bj < 2; ++bj)
#pragma unroll
            for (int n = 0; n < 2; ++n) gv[bj][n] = *(const f32x4*)(gm + bj * 128 + n * 16);
        f32x4 xv[2][2][2][2];
#define ERS_LOAD(slot, grp) do { _Pragma("unroll") for (int m2 = 0; m2 < 2; ++m2) { const size_t off = (size_t)(row0 + ((grp) >> 1) * 128 + (2 * ((grp) & 1) + m2) * 16) * D_MODEL + col0; \
            _Pragma("unroll") for (int bj = 0; bj < 2; ++bj) _Pragma("unroll") for (int n = 0; n < 2; ++n) xv[slot][m2][bj][n] = *(const f32x4*)(xin + off + bj * 128 + n * 16); } } while (0)
        ERS_LOAD(0, 0);
#pragma unroll
        for (int grp = 0; grp < 4; ++grp) {
            const int slot = grp & 1, ai = grp >> 1, mh = grp & 1;
            if (grp + 1 < 4) { if (slot == 0) ERS_LOAD(1, grp + 1); else ERS_LOAD(0, grp + 1); }
            asm volatile("" ::: "memory");
#pragma unroll
            for (int m2 = 0; m2 < 2; ++m2) { const size_t off = (size_t)(row0 + ai * 128 + (2 * mh + m2) * 16) * D_MODEL + col0;
#pragma unroll
                for (int bj = 0; bj < 2; ++bj)
#pragma unroll
                    for (int n = 0; n < 2; ++n) {
#if EPI_QT
                        const f32x4 av = qt4f(src4, acc[ai][bj][2 * mh + m2][n]);
#else
                        const f32x4 av = acc[ai][bj][2 * mh + m2][n];
#endif
                        *(f32x4*)(xout + off + bj * 128 + n * 16) = xv[slot][m2][bj][n] + gv[bj][n] * av; } }
        }
#undef ERS_LOAD
    }
};
struct EpiSwiglu {
    static constexpr bool PERM = false;
    bf16_t* ACT; const float* b1; const LAS int* texp;
    DI void operator()(const f32x4 (&acc)[2][2][4][2], const pg8::Unit& u, int wr, int wc, int fr, int fq) const {
        const int row0 = u.pm * 256 + wr * 64 + fr, e = texp[u.pm];
        const float* bb = b1 + (size_t)e * 2048;
#pragma unroll
        for (int bj = 0; bj < 2; ++bj) { const int j0 = u.pn * 128 + bj * 64 + wc * 16 + 4 * fq;
            const f32x4 ba = *(const f32x4*)(bb + 2 * j0), bc = *(const f32x4*)(bb + 2 * j0 + 4);
            const f32x4 bgt = {ba[0], ba[2], bc[0], bc[2]}, bup = {ba[1], ba[3], bc[1], bc[3]};
#pragma unroll
            for (int ai = 0; ai < 2; ++ai)
#pragma unroll
                for (int m = 0; m < 4; ++m) { const f32x4 g = acc[ai][bj][m][0] + bgt, up = acc[ai][bj][m][1] + bup; float o[4];
#pragma unroll
                    for (int i = 0; i < 4; ++i) { const float gg = fminf(g[i], 7.0f), uu = fminf(fmaxf(up[i], -7.0f), 7.0f);
                        o[i] = (uu + 1.0f) * gg * fast_sigmoid(1.702f * gg);
                    }
                    u32x2 w; w.x = pk2(o[0], o[1]); w.y = pk2(o[2], o[3]);
                    *(u32x2*)(ACT + (size_t)(row0 + ai * 128 + m * 16) * D_EXP + j0) = w; } }
    }
};
struct EpiSwiglu8 {
    static constexpr bool PERM = false;
    unsigned char* ACT; const float* b1; const LAS int* texp;
#ifdef PROBE_M1
    int skip = 0;
#endif
    DI void operator()(const f32x4 (&acc)[2][2][4][2], const pg8::Unit& u, int wr, int wc, int fr, int fq) const {
#ifdef PROBE_M1
        if (skip == 2) {
#pragma unroll
            for (int ai = 0; ai < 2; ++ai)
#pragma unroll
                for (int bj = 0; bj < 2; ++bj)
#pragma unroll
                    for (int m = 0; m < 4; ++m)
#pragma unroll
                        for (int n = 0; n < 2; ++n) asm volatile("" :: "v"(acc[ai][bj][m][n][0]), "v"(acc[ai][bj][m][n][1]), "v"(acc[ai][bj][m][n][2]), "v"(acc[ai][bj][m][n][3]));
            return; }
#endif
        const int row0 = u.pm * 256 + wr * 64 + fr, e = texp[u.pm];
        const float* bb = b1 + (size_t)e * 2048;
#pragma unroll
        for (int bj = 0; bj < 2; ++bj) { const int j0 = u.pn * 128 + bj * 64 + wc * 16 + 4 * fq;
#ifdef PROBE_M1
            f32x4 ba, bc; if (skip == 3) { float z_ = 0.f; asm volatile("" : "+v"(z_)); ba = (f32x4){z_, z_, z_, z_}; bc = ba; } else { ba = *(const f32x4*)(bb + 2 * j0); bc = *(const f32x4*)(bb + 2 * j0 + 4); }
#else
            const f32x4 ba = *(const f32x4*)(bb + 2 * j0), bc = *(const f32x4*)(bb + 2 * j0 + 4);
#endif
            const f32x4 bgt = {ba[0], ba[2], bc[0], bc[2]}, bup = {ba[1], ba[3], bc[1], bc[3]};
#pragma unroll
            for (int ai = 0; ai < 2; ++ai) {
                unsigned w[4];
#pragma unroll
                for (int m = 0; m < 4; ++m) { const f32x4 g = acc[ai][bj][m][0] + bgt, up = acc[ai][bj][m][1] + bup; float o[4];
#pragma unroll
                    for (int i = 0; i < 4; ++i) { const float gg = fminf(g[i], 7.0f), uu = fminf(fmaxf(up[i], -7.0f), 7.0f);
                        o[i] = (uu + 1.0f) * gg * fast_sigmoid(1.702f * gg);
                    }
                    w[m] = pk4_fp8(o[0], o[1], o[2], o[3]); }
                { const auto r = __builtin_amdgcn_permlane16_swap(w[0], w[1], false, false); w[0] = r[0]; w[1] = r[1]; }
                { const auto r = __builtin_amdgcn_permlane16_swap(w[2], w[3], false, false); w[2] = r[0]; w[3] = r[1]; }
                { const auto r = __builtin_amdgcn_permlane32_swap(w[0], w[2], false, false); w[0] = r[0]; w[2] = r[1]; }
                { const auto r = __builtin_amdgcn_permlane32_swap(w[1], w[3], false, false); w[1] = r[0]; w[3] = r[1]; }
                u32x4 wv; wv.x = w[0]; wv.y = w[1]; wv.z = w[2]; wv.w = w[3];
#ifdef PROBE_M1
                if (skip == 1) { asm volatile("" :: "v"(wv.x), "v"(wv.y), "v"(wv.z), "v"(wv.w)); } else
#endif
                *(u32x4*)(ACT + (size_t)(row0 + ai * 128 + fq * 16) * D_EXP + (j0 - 4 * fq)) = wv; } }
    }
};
struct EpiMoeOut {
    static constexpr bool PERM = true;
    bf16_t* Y; const float* b2; const float* gate; const LAS int* texp;
    DI void operator()(const f32x4 (&acc)[2][2][4][2], const pg8::Unit& u, int wr, int wc, int fr, int fq) const {
        const int row0 = u.pm * 256 + wr * 64 + fr, col0 = u.pn * 256 + wc * 32 + 8 * fq, e = texp[u.pm];
        const float* bb = b2 + (size_t)e * D_MODEL + col0;
#if EPI_QT_ST
        const int lane = fr + 16 * fq, src4 = qt_src(lane), rowq = (lane >> 2) - fr, colq = 8 * ((lane & 3) - fq);
#endif
        f32x4 bv[2][2];
#pragma unroll
        for (int bj = 0; bj < 2; ++bj) { bv[bj][0] = *(const f32x4*)(bb + bj * 128); bv[bj][1] = *(const f32x4*)(bb + bj * 128 + 4); }
#pragma unroll
        for (int ai = 0; ai < 2; ++ai) {
            float gt[4];
#pragma unroll
            for (int m = 0; m < 4; ++m) gt[m] = gate[row0 + ai * 128 + m * 16];
            asm volatile("" ::: "memory");
#pragma unroll
            for (int m = 0; m < 4; ++m) { const int row = row0 + ai * 128 + m * 16; const float g = gt[m];
#pragma unroll
                for (int bj = 0; bj < 2; ++bj) { const f32x4 v0 = (acc[ai][bj][m][0] + bv[bj][0]) * g, v1 = (acc[ai][bj][m][1] + bv[bj][1]) * g;
                    u32x4 w; w.x = pk2(v0[0], v0[1]); w.y = pk2(v0[2], v0[3]); w.z = pk2(v1[0], v1[1]); w.w = pk2(v1[2], v1[3]);
#if EPI_QT_ST
                    *(u32x4*)(Y + (size_t)(row + rowq) * D_MODEL + col0 + colq + bj * 128) = qt4(src4, w); } }
#else
                    *(u32x4*)(Y + (size_t)row * D_MODEL + col0 + bj * 128) = w; } }
#endif
            asm volatile("" ::: "memory");
        }
    }
};

constexpr size_t MiB = 1u << 20;
constexpr size_t WS_CTL = 0, CTL_ZERO_BYTES = 1 * MiB;
constexpr size_t WS_MOD = 1 * MiB, WS_ROPE = 2 * MiB, WS_WIN = 8 * MiB, WS_WUQ = 33 * MiB, WS_WUKV = 34 * MiB, WS_WB = 35 * MiB, WS_WOUT = 41 * MiB, WS_W1 = 53 * MiB, WS_W2 = 309 * MiB,
                 WS_X1 = 437 * MiB, WS_H = 565 * MiB, WS_CQ = 629 * MiB, WS_CKV = 645 * MiB, WS_KPE = 661 * MiB, WS_QA = 663 * MiB, WS_KV = 711 * MiB, WS_O3 = 775 * MiB, WS_QC = 871 * MiB,
                 WS_KC = 903 * MiB, WS_VC = 907 * MiB, WS_QI = 911 * MiB, WS_KI = 943 * MiB, WS_IW = 947 * MiB, WS_ROUTE = 948 * MiB, WS_P = 952 * MiB, WS_GY = 1352 * MiB, WS_END = 1544 * MiB;
constexpr size_t WS_HG8 = WS_QA;
constexpr size_t WS_XB = WS_P, WS_ACT = WS_P + 272 * MiB, WS_Y = WS_P, WS_H8 = WS_H;
constexpr size_t RT_TOPE = 0, RT_TOPG = 512 * 1024, RT_RANK = 1 * MiB, RT_SLOTOF = 1 * MiB + 512 * 1024, RT_TOKOF = 2 * MiB, RT_GATEOF = 3 * MiB;
static_assert((size_t)NSLOT_MAX * 1024 * 2 <= 272 * MiB && WS_ACT + 272 * MiB <= WS_END, "MoE overlay: XB (fp8) and Y (bf16) share [P, P+272M) (XB is dead when Y is written); ACT in [P+272M, P+544M)");
static_assert((size_t)T_TOK * NP * 2 == 400 * MiB, "P size");
constexpr int CW_BAR = 4096, CW_CNT = 16384;
constexpr int LDS_BYTES = 163840, LDS_X = 131072, MISC_OFF = LDS_BYTES - 512;

struct Frame {
    LAS unsigned char* lds; int tid, lane, wave, G, bid; float zf;
    float* out; unsigned char* ws; unsigned* ctl;
};
extern __shared__ __attribute__((aligned(16))) unsigned char lds_raw[];
typedef __attribute__((address_space(4))) const char* kptr_t;
DI const void* kin(int i) {
#if defined(__HIP_DEVICE_COMPILE__)
    kptr_t ka = (kptr_t)__builtin_amdgcn_kernarg_segment_ptr(); asm volatile("" : "+s"(ka)); return (const void*)(GAS const void*)*(__attribute__((address_space(4))) const unsigned long long*)(ka + 8 * i);
#else
    (void)i; return nullptr;
#endif
}
#define KIN_x ((const float*)kin(0))
#define KIN_c ((const float*)kin(1))
#define KIN_pos ((const int*)kin(2))
#define KIN_norm1_g ((const float*)kin(3))
#define KIN_norm2_g ((const float*)kin(4))
#define KIN_w_ada ((const float*)kin(5))
#define KIN_b_ada ((const float*)kin(6))
#define KIN_w_in ((const float*)kin(7))
#define KIN_b_gate ((const float*)kin(8))
#define KIN_q_norm ((const float*)kin(9))
#define KIN_w_uq ((const float*)kin(10))
#define KIN_kv_norm ((const float*)kin(11))
#define KIN_w_ukv ((const float*)kin(12))
#define KIN_conv_w ((const float*)kin(13))
#define KIN_w_branch ((const float*)kin(14))
#define KIN_w_out ((const float*)kin(15))
#define KIN_router_w ((const float*)kin(16))
#define KIN_router_b ((const float*)kin(17))
#define KIN_w1 ((const float*)kin(18))
#define KIN_b1 ((const float*)kin(19))
#define KIN_w2 ((const float*)kin(20))
#define KIN_b2 ((const float*)kin(21))
#define KIN_final_g ((const float*)kin(22))
DI Frame make_frame(int wave0) {
    Frame F; unsigned z_ = 0u; asm volatile("" : "+v"(z_));
    F.lds = (LAS unsigned char*)lds_raw; F.lane = (int)__builtin_amdgcn_mbcnt_hi(~0u, __builtin_amdgcn_mbcnt_lo(~0u, z_)); F.wave = wave0; F.tid = wave0 * 64 + F.lane; F.G = gridDim.x; F.bid = blockIdx.x; F.zf = __uint_as_float(z_);
    F.out = (float*)kin(23); F.ws = (unsigned char*)kin(24); F.ctl = (unsigned*)F.ws;
    return F;
}
#define WSP(T, off) ((T*)(F.ws + (off)))
#ifndef STAG_MODE
#define STAG_MODE 1
#endif
#ifndef STAG_SCALE
#define STAG_SCALE 100
#endif
DI void stagger(const Frame& F, int spread_us) {
#if STAG_MODE == 0
    const unsigned ticks = (unsigned)(spread_us * STAG_SCALE) * (unsigned)F.bid / (unsigned)F.G;
#elif STAG_MODE == 1
    const unsigned ticks = (unsigned)(spread_us * STAG_SCALE) * (unsigned)(F.bid & 7) / 8u;
#else
    const unsigned ticks = (unsigned)(spread_us * STAG_SCALE) * (unsigned)((F.bid >> 3) & 3) / 4u;
#endif
    if (ticks == 0u) return;
    const unsigned long long t0 = __builtin_amdgcn_s_memrealtime();
    while ((unsigned)(__builtin_amdgcn_s_memrealtime() - t0) < ticks) __builtin_amdgcn_s_sleep(8);
}


#define XB_TMO      128
#define XB_XCNT(j)  (256  + 64 * (j))
#define XB_XSUB(j)  (1280 + 64 * (j))
#define XB_XGEN(j)  (2304 + 64 * (j))
#define XB_TOP      3328
#define XB_TOPGEN   3392
#define XCD_BAR_WORDS 3456
#define XB_SPIN_CAP (1u << 18)
DI unsigned xb_ld(unsigned* p)              { return __hip_atomic_load(p, __ATOMIC_RELAXED, __HIP_MEMORY_SCOPE_AGENT); }
DI unsigned xb_add(unsigned* p, unsigned v) { return __hip_atomic_fetch_add(p, v, __ATOMIC_RELAXED, __HIP_MEMORY_SCOPE_AGENT); }
DI unsigned xb_xcc_id() { return (unsigned)__builtin_amdgcn_s_getreg((3 << 11) | 20) & 0xFu; }
#define XB_SPIN(cond, bar) do { unsigned _sp = 0; while (cond) { __builtin_amdgcn_s_sleep(1); \
    if ((++_sp & 255u) == 0u) { if (xb_ld(&(bar)[XB_TMO])) break; if (_sp > XB_SPIN_CAP) { atomicAdd(&(bar)[XB_TMO], 1u); break; } } } } while (0)
struct XcdBarrier { unsigned* bar; unsigned x; volatile LAS unsigned* st; };
DI XcdBarrier xcd_barrier_post(unsigned* bar, volatile LAS unsigned* st, int tid) {
    XcdBarrier b; b.bar = bar; b.x = xb_xcc_id(); b.st = st;
    if (tid == 0) (void)xb_add(&bar[XB_XCNT(b.x)], 1u);
    return b;
}
DI void xcd_barrier_complete(unsigned* bar, unsigned x, unsigned& nloc, unsigned& nx) {
    const unsigned G = gridDim.x * gridDim.y * gridDim.z;
    unsigned sum, cnt, mine, sp = 0u;
    for (;;) {
        sum = 0u; cnt = 0u; mine = 0u;
#pragma unroll
        for (unsigned j = 0; j < 16; ++j) { const unsigned c = xb_ld(&bar[XB_XCNT(j)]); sum += c; cnt += (c > 0u) ? 1u : 0u; mine = (j == x) ? c : mine; }
        if (sum == G) break;
        __builtin_amdgcn_s_sleep(1);
        if ((++sp & 255u) == 0u) { if (xb_ld(&bar[XB_TMO])) break; if (sp > XB_SPIN_CAP) { atomicAdd(&bar[XB_TMO], 1u); break; } }
    }
    nloc = mine > 0u ? mine : 1u; nx = cnt > 0u ? cnt : 1u;
}
DI void xcd_barrier(const XcdBarrier& b, int tid) {
    asm volatile("s_waitcnt vmcnt(0)" ::: "memory");
    __syncthreads();
    if (tid == 0) {
        unsigned* bar = b.bar;
        __builtin_amdgcn_s_waitcnt(0);
        unsigned nloc = b.st[0], nx = b.st[1];
        if (nloc == 0u) { xcd_barrier_complete(bar, b.x, nloc, nx); b.st[0] = nloc; b.st[1] = nx; }
        const unsigned old = xb_add(&bar[XB_XSUB(b.x)], 1u);
        const unsigned gen = old / nloc;
        if (old + 1u == (gen + 1u) * nloc) {
            __builtin_amdgcn_fence(__ATOMIC_RELEASE, "agent");
            asm volatile("s_waitcnt vmcnt(0)" ::: "memory");
            const unsigned og = xb_add(&bar[XB_TOP], 1u);
            const unsigned tg = og / nx;
            if (og + 1u == (tg + 1u) * nx) xb_add(&bar[XB_TOPGEN], 1u);
            else XB_SPIN(xb_ld(&bar[XB_TOPGEN]) == tg, bar);
            __builtin_amdgcn_fence(__ATOMIC_ACQUIRE, "agent");
            xb_add(&bar[XB_XGEN(b.x)], 1u);
            asm volatile("s_waitcnt vmcnt(0)" ::: "memory");
        } else {
            XB_SPIN(xb_ld(&bar[XB_XGEN(b.x)]) == gen, bar);
            __builtin_amdgcn_fence(__ATOMIC_ACQUIRE, "agent");
            asm volatile("s_waitcnt vmcnt(0)" ::: "memory");
        }
    }
    __syncthreads();
}

#ifndef HG8_TILED
#define HG8_TILED 0
#endif
#ifndef G1_F8_COLS
#define G1_F8_COLS 3072
#endif
DI int rope_perm(int p, int half) { return (p < 2 * half) ? (p >> 1) + half * (p & 1) : p; }
DI int cmap_in(int r) {
    if (r < PC_CONV) return OC_GATE + r;
    if (r < PC_DQ) return OC_CONV + (r - PC_CONV);
    if (r < PC_IQ) { const int j = r - PC_DQ; return OC_DQ + (j & ~63) + rope_perm(j & 63, 8); }
    if (r < PC_QLAT) { const int j = r - PC_IQ; return OC_IQ + (j & ~63) + rope_perm(j & 63, 8); }
    if (r < PC_KVLAT) return OC_QLAT + (r - PC_QLAT);
    if (r < PC_DKV) { const int j = r - PC_KVLAT; return j < 128 ? OC_KVLAT + j : OC_KVLAT + 128 + rope_perm(j - 128, 16); }
    if (r < PC_IK) { const int j = r - PC_DKV; return j < 64 ? OC_DKV + rope_perm(j, 8) : OC_DKV + j; }
    if (r < PC_IW) return OC_IK + rope_perm(r - PC_IK, 8);
    if (r < IN_COLS) return OC_IW + (r - PC_IW);
    return -1;
}
DI int cmap_uq(int r) { const int h = r / 96, p = r % 96; return h * 96 + rope_perm(p, 16); }
DI int cmap_w1(int R) { const int pn = R >> 8, rem = R & 255, bj = rem >> 7, wc = (rem >> 5) & 3, n = (rem >> 4) & 1, f = rem & 15; return 2 * (pn * 128 + bj * 64 + wc * 16 + f) + n; }
DI void transpose_item(const float* W, int K, int N, bf16_t* WT, int ldk, int koff, LAS float* scr, int k0, int n0, int csrc, int lane) {
#pragma unroll 8
    for (int i = 0; i < 32; ++i) { const int kk = 2 * i + (lane >> 5); float v = 0.f; if (csrc >= 0 && k0 + kk < K) v = W[(size_t)(k0 + kk) * N + csrc]; scr[kk * 33 + (lane & 31)] = v; }
    LDS_WAIT(); asm volatile("" ::: "memory");
    const int c = lane & 7;
#pragma unroll
    for (int j = 0; j < 4; ++j) { const int n = (lane >> 3) + 8 * j; const LAS float* s = scr + (8 * c) * 33 + n;
        u32x4 o; o.x = pk2(s[0 * 33], s[1 * 33]); o.y = pk2(s[2 * 33], s[3 * 33]); o.z = pk2(s[4 * 33], s[5 * 33]); o.w = pk2(s[6 * 33], s[7 * 33]);
        *(u32x4*)(WT + (size_t)(n0 + n) * ldk + koff + k0 + 8 * c) = o; }
    LDS_WAIT(); asm volatile("" ::: "memory");
}
DI void transpose_item_f8(const float* W, int K, int N, unsigned char* WT, int ldk, LAS float* scr, int k0, int n0, int csrc, int lane, float qs) {
#pragma unroll 8
    for (int i = 0; i < 32; ++i) { const int kk = 2 * i + (lane >> 5); scr[kk * 33 + (lane & 31)] = W[(size_t)(k0 + kk) * N + csrc] * qs; }
    LDS_WAIT(); asm volatile("" ::: "memory");
    const int c = lane & 7;
#pragma unroll
    for (int j = 0; j < 4; ++j) { const int n = (lane >> 3) + 8 * j; const LAS float* s = scr + (8 * c) * 33 + n;
        u32x2 o; o.x = pk4_fp8(s[0 * 33], s[1 * 33], s[2 * 33], s[3 * 33]); o.y = pk4_fp8(s[4 * 33], s[5 * 33], s[6 * 33], s[7 * 33]);
        *(u32x2*)(WT + (size_t)(n0 + n) * ldk + k0 + 8 * c) = o; }
    LDS_WAIT(); asm volatile("" ::: "memory");
}
DI void titem_load(const float* W, int N, int k0, int csrc, int lane, float (&v)[32]) {
#pragma unroll
    for (int i = 0; i < 32; ++i) v[i] = W[(size_t)(k0 + 2 * i + (lane >> 5)) * N + csrc];
}
DI void titem_store_f8(const float (&v)[32], unsigned char* WT, int ldk, LAS float* scr, int k0, int n0, int lane, float qs) {
#pragma unroll
    for (int i = 0; i < 32; ++i) scr[(2 * i + (lane >> 5)) * 33 + (lane & 31)] = v[i] * qs;
    LDS_WAIT(); asm volatile("" ::: "memory");
    const int c = lane & 7;
#pragma unroll
    for (int j = 0; j < 4; ++j) { const int n = (lane >> 3) + 8 * j; const LAS float* s = scr + (8 * c) * 33 + n;
        u32x2 o; o.x = pk4_fp8(s[0 * 33], s[1 * 33], s[2 * 33], s[3 * 33]); o.y = pk4_fp8(s[4 * 33], s[5 * 33], s[6 * 33], s[7 * 33]);
        *(u32x2*)(WT + (size_t)(n0 + n) * ldk + k0 + 8 * c) = o; }
    LDS_WAIT(); asm volatile("" ::: "memory");
}
template <bool W1>
DI void convert_family_f8(const float* src, unsigned char* dst, int N, int nmat, LAS float* scr, int gw, int NGW, int lane) {
    const int nbn = N / 32, ipm = 16 * nbn, total = nmat * ipm;
    float va[32], vb[32];
#define TF_DECODE(it, j_, k0_, n0_, cs_) const int j_ = (it) / ipm, q_##j_ = (it) % ipm, k0_ = 64 * (q_##j_ / nbn), n0_ = 32 * (q_##j_ % nbn), cs_ = W1 ? cmap_w1(n0_ + (lane & 31)) : n0_ + (lane & 31)
    int it = gw;
    if (it < total) { TF_DECODE(it, j0, k00, n00, cs0); titem_load(src + (size_t)j0 * 1024 * N, N, k00, cs0, lane, va); }
    while (it < total) {
        const int it2 = it + NGW;
        if (it2 < total) { TF_DECODE(it2, j2, k02, n02, cs2); titem_load(src + (size_t)j2 * 1024 * N, N, k02, cs2, lane, vb); }
        { TF_DECODE(it, j1, k01, n01, cs1); (void)cs1; titem_store_f8(va, dst + (size_t)j1 * N * 1024, 1024, scr, k01, n01, lane, 64.0f); }
        const int it3 = it2 + NGW;
        if (it3 < total) { TF_DECODE(it3, j3, k03, n03, cs3); titem_load(src + (size_t)j3 * 1024 * N, N, k03, cs3, lane, va); }
        if (it2 < total) { TF_DECODE(it2, j4, k04, n04, cs4); (void)cs4; titem_store_f8(vb, dst + (size_t)j4 * N * 1024, 1024, scr, k04, n04, lane, 64.0f); }
        it = it3;
    }
#undef TF_DECODE
}
DI void sincos_d(double x, float& s, float& c) {
    const double kd = __builtin_rint(x * 0.6366197723675814); const int k = (int)kd;
    double r = __builtin_fma(-kd, 1.5707963267948966, x); r = __builtin_fma(-kd, 6.123233995736766e-17, r);
    const double r2 = r * r;
    const double sp = r * (1.0 + r2 * (-1.0 / 6 + r2 * (1.0 / 120 + r2 * (-1.0 / 5040 + r2 * (1.0 / 362880 + r2 * (-1.0 / 39916800 + r2 * (1.0 / 6227020800.0)))))));
    const double cp = 1.0 + r2 * (-0.5 + r2 * (1.0 / 24 + r2 * (-1.0 / 720 + r2 * (1.0 / 40320 + r2 * (-1.0 / 3628800 + r2 * (1.0 / 479001600.0 + r2 * (-1.0 / 87178291200.0)))))));
    const int q = k & 3;
    const double ss = (q == 0) ? sp : (q == 1) ? cp : (q == 2) ? -sp : -cp;
    const double cc = (q == 0) ? cp : (q == 1) ? -sp : (q == 2) ? -cp : sp;
    s = (float)ss; c = (float)cc;
}
DI void phase_prologue(const Frame& F) {
    const int tid = F.tid, lane = F.lane, wave = F.wave;
    __syncthreads();
    const float* in_c = KIN_c; const float* in_wada = KIN_w_ada; const float* in_bada = KIN_b_ada; const int* in_pos = KIN_pos;
    if (F.bid < 192) {
        LAS float* cact = (LAS float*)F.lds;
        LAS float* red = (LAS float*)(F.lds + 65536);
        for (int idx = tid; idx < 16 * 1024; idx += 512) { const int b = idx >> 10, k = idx & 1023; const float cv = in_c[idx]; cact[k * 16 + b] = cv * fast_sigmoid(cv); }
        __syncthreads();
        float* MOD = WSP(float, WS_MOD);
        for (int it = F.bid; it < 192; it += F.G) {
            const int l = it / 96, cb = it % 96, col = cb * 64 + lane;
            float acc[16];
#pragma unroll
            for (int b = 0; b < 16; ++b) acc[b] = 0.f;
            const float* wp = in_wada + ((size_t)l * 1024 + wave * 128) * 6144 + col;
#pragma unroll 4
            for (int kk = 0; kk < 128; ++kk) { const float wv = wp[(size_t)kk * 6144]; const LAS f32x4* cp = (const LAS f32x4*)(cact + (wave * 128 + kk) * 16);
#pragma unroll
                for (int q = 0; q < 4; ++q) { const f32x4 cv = cp[q]; acc[4 * q] += cv[0] * wv; acc[4 * q + 1] += cv[1] * wv; acc[4 * q + 2] += cv[2] * wv; acc[4 * q + 3] += cv[3] * wv; } }
#pragma unroll
            for (int b = 0; b < 16; ++b) red[(wave * 16 + b) * 64 + lane] = acc[b];
            __syncthreads();
            for (int o = tid; o < 1024; o += 512) { const int b = o >> 6, ln = o & 63; float s = in_bada[l * 6144 + cb * 64 + ln];
#pragma unroll
                for (int w = 0; w < 8; ++w) s += red[(w * 16 + b) * 64 + ln];
                MOD[((size_t)l * 16 + b) * 6144 + cb * 64 + ln] = s; }
            __syncthreads();
        }
    }
    __syncthreads();
    {
        float* ROPE = WSP(float, WS_ROPE);
        const double r16 = 0.44036660267178046;
        for (int idx = F.bid * 512 + tid; idx < T_TOK * 24; idx += F.G * 512) {
            const int t = idx / 24, i = idx % 24; const int e = (i < 16) ? i : 2 * (i - 16);
            double f = 1.0; for (int j = 0; j < e; ++j) f *= r16;
            float s, c; sincos_d((double)in_pos[t] * f, s, c);
            ROPE[(size_t)t * 48 + 2 * i] = c; ROPE[(size_t)t * 48 + 2 * i + 1] = s;
        }
    }
    {
        LAS float* scr = (LAS float*)(F.lds + wave * 16384);
        const int gw = F.bid * 8 + wave, NGW = F.G * 8;
        constexpr int I_IN = 16 * 200, I_UQ = 4 * 24, I_UKV = 4 * 32, I_WB = 8 * 32, I_WO = 16 * 32, I_W1 = 16 * 64, I_W2 = 16 * 32;
        constexpr int N_IN = 2 * I_IN, N_UQ = 2 * I_UQ, N_UKV = 2 * I_UKV, N_WB = 6 * I_WB, N_WO = 2 * I_WO, N_W1 = 64 * I_W1, N_W2 = 64 * I_W2;
        constexpr int NITEMS = N_IN + N_UQ + N_UKV + N_WB + N_WO;
        (void)N_W1; (void)N_W2;
        for (int it = gw; it < NITEMS; it += NGW) {
            int r = it;
            if (r < N_IN) { const int l = r / I_IN, q = r % I_IN, kb = q / 200, nb = q % 200;
                if (32 * nb < G1_F8_COLS) transpose_item_f8(KIN_w_in + (size_t)l * 1024 * IN_COLS, 1024, IN_COLS, WSP(unsigned char, WS_WIN) + (size_t)l * NP * 2048, 1024, scr, 64 * kb, 32 * nb, cmap_in(32 * nb + (lane & 31)), lane, 64.0f);
                else transpose_item(KIN_w_in + (size_t)l * 1024 * IN_COLS, 1024, IN_COLS, WSP(bf16_t, WS_WIN) + (size_t)l * NP * 1024, 1024, 0, scr, 64 * kb, 32 * nb, cmap_in(32 * nb + (lane & 31)), lane);
                continue; } r -= N_IN;
            if (r < N_UQ) { const int l = r / I_UQ, q = r % I_UQ, kb = q / 24, nb = q % 24;
                transpose_item(KIN_w_uq + (size_t)l * 256 * 768, 256, 768, WSP(bf16_t, WS_WUQ) + (size_t)l * 768 * 256, 256, 0, scr, 64 * kb, 32 * nb, cmap_uq(32 * nb + (lane & 31)), lane); continue; } r -= N_UQ;
            if (r < N_UKV) { const int l = r / I_UKV, q = r % I_UKV, kb = q / 32, nb = q % 32;
                transpose_item(KIN_w_ukv + (size_t)l * 128 * 1024, 128, 1024, WSP(bf16_t, WS_WUKV) + (size_t)l * 1024 * 256, 256, 0, scr, 64 * kb, 32 * nb, 32 * nb + (lane & 31), lane); continue; } r -= N_UKV;
            if (r < N_WB) { const int j = r / I_WB, q = r % I_WB, kb = q / 32, nb = q % 32;
                transpose_item(KIN_w_branch + (size_t)j * 512 * 1024, 512, 1024, WSP(bf16_t, WS_WB) + (size_t)j * 1024 * 512, 512, 0, scr, 64 * kb, 32 * nb, 32 * nb + (lane & 31), lane); continue; } r -= N_WB;
            if (r < N_WO) { const int l = r / I_WO, q = r % I_WO, kb = q / 32, nb = q % 32;
                transpose_item(KIN_w_out + (size_t)l * 1024 * 1024, 1024, 1024, WSP(bf16_t, WS_WOUT) + (size_t)l * 1024 * 1024, 1024, 0, scr, 64 * kb, 32 * nb, 32 * nb + (lane & 31), lane); continue; } r -= N_WO;
            (void)r;
        }
        convert_family_f8<true>(KIN_w1, WSP(unsigned char, WS_W1), 2048, 64, scr, gw, NGW, lane);
#if M2_F8
        convert_family_f8<false>(KIN_w2, WSP(unsigned char, WS_W2), 1024, 64, scr, gw, NGW, lane);
#else
        for (int it = gw; it < 64 * I_W2; it += NGW) { const int j = it / I_W2, q = it % I_W2, kb = q / 32, nb = q % 32;
            transpose_item(KIN_w2 + (size_t)j * 1024 * 1024, 1024, 1024, WSP(bf16_t, WS_W2) + (size_t)j * 1024 * 1024, 1024, 0, scr, 64 * kb, 32 * nb, 32 * nb + (lane & 31), lane); }
#endif
    }
}

DI void phase_norm(const Frame& F, const float* xin, float* xout, bool combine, bool write_x, bool final_, int lnext, int lcomb) {
    const int lane = F.lane, gw = F.bid * 8 + F.wave, NGW = F.G * 8;
    const float* in_fg = KIN_final_g; const float* in_n1 = KIN_norm1_g;
    const float* MOD = WSP(float, WS_MOD); const bf16_t* Y = WSP(bf16_t, WS_Y); const int* SLOTOF = (const int*)(F.ws + WS_ROUTE + RT_SLOTOF); bf16_t* H = WSP(bf16_t, WS_H);
    u32x4 slots = {0u, 0u, 0u, 0u};
    if (combine && gw < T_TOK) slots = *(const u32x4*)(SLOTOF + (size_t)gw * 4);
    for (int t = gw; t < T_TOK; t += NGW) {
        const int b = t >> 11; f32x4 v[4];
#pragma unroll
        for (int i = 0; i < 4; ++i) v[i] = *(const f32x4*)(xin + (size_t)t * 1024 + 4 * lane + 256 * i);
        if (combine) {
            const unsigned s0 = slots.x, s1 = slots.y, s2 = slots.z, s3 = slots.w;
            u32x2 ya[4], yb[4], yc[4], yd[4];
#pragma unroll
            for (int i = 0; i < 4; ++i) { const int co = 4 * lane + 256 * i;
                ya[i] = *(const u32x2*)(Y + (size_t)s0 * 1024 + co); yb[i] = *(const u32x2*)(Y + (size_t)s1 * 1024 + co); yc[i] = *(const u32x2*)(Y + (size_t)s2 * 1024 + co); yd[i] = *(const u32x2*)(Y + (size_t)s3 * 1024 + co); }
            if (t + NGW < T_TOK) slots = *(const u32x4*)(SLOTOF + (size_t)(t + NGW) * 4);
            const float* g2 = MOD + ((size_t)lcomb * 16 + b) * 6144 + 5 * 1024;
#pragma unroll
            for (int i = 0; i < 4; ++i) { const int co = 4 * lane + 256 * i; const u32x2 a = ya[i], bq = yb[i], cq = yc[i], dq = yd[i];
                f32x4 sum = {bf_lo(a.x) + bf_lo(bq.x) + bf_lo(cq.x) + bf_lo(dq.x), bf_hi(a.x) + bf_hi(bq.x) + bf_hi(cq.x) + bf_hi(dq.x),
                             bf_lo(a.y) + bf_lo(bq.y) + bf_lo(cq.y) + bf_lo(dq.y), bf_hi(a.y) + bf_hi(bq.y) + bf_hi(cq.y) + bf_hi(dq.y)};
                v[i] += *(const f32x4*)(g2 + co) * sum; }
            if (write_x) {
#pragma unroll
                for (int i = 0; i < 4; ++i) *(f32x4*)(xout + (size_t)t * 1024 + 4 * lane + 256 * i) = v[i]; }
        }
        float ss = 0.f;
#pragma unroll
        for (int i = 0; i < 4; ++i) ss += (v[i][0] * v[i][0] + v[i][1] * v[i][1]) + (v[i][2] * v[i][2] + v[i][3] * v[i][3]);
        ss = wave_sum(ss); const float r = 1.0f / sqrtf(ss * (1.0f / 1024.0f) + NORM_EPS);
        if (final_) {
#pragma unroll
            for (int i = 0; i < 4; ++i) { const int co = 4 * lane + 256 * i; *(f32x4*)(F.out + (size_t)t * 1024 + co) = v[i] * r * *(const f32x4*)(in_fg + co); }
        } else {
            const float* md = MOD + ((size_t)lnext * 16 + b) * 6144;
#pragma unroll
            for (int i = 0; i < 4; ++i) { const int co = 4 * lane + 256 * i;
                const f32x4 g = *(const f32x4*)(in_n1 + lnext * 1024 + co), sc = *(const f32x4*)(md + 1024 + co), sh = *(const f32x4*)(md + co);
                f32x4 h = v[i] * r * g * (sc + 1.0f) + sh;
                u32x2 w; w.x = pk2(h[0], h[1]); w.y = pk2(h[2], h[3]);
                *(u32x2*)(H + (size_t)t * 1024 + co) = w;
#if HG8_TILED
                *(unsigned*)(WSP(unsigned char, WS_HG8) + (size_t)(t >> 8) * 262144 + (size_t)(co >> 7) * 32768 + (t & 255) * 128 + (co & 127)) = pk4_fp8(h[0], h[1], h[2], h[3]);
#else
                *(unsigned*)(WSP(unsigned char, WS_HG8) + (size_t)t * 1024 + co) = pk4_fp8(h[0], h[1], h[2], h[3]);
#endif
                }
        }
    }
}
DI u32x4 rope8v(u32x4 a, f32x4 c0, f32x4 c1) {
    u32x4 o;
    { const float x1 = bf_lo(a.x), x2 = bf_hi(a.x); o.x = pk2(x1 * c0[0] - x2 * c0[1], x2 * c0[0] + x1 * c0[1]); }
    { const float x1 = bf_lo(a.y), x2 = bf_hi(a.y); o.y = pk2(x1 * c0[2] - x2 * c0[3], x2 * c0[2] + x1 * c0[3]); }
    { const float x1 = bf_lo(a.z), x2 = bf_hi(a.z); o.z = pk2(x1 * c1[0] - x2 * c1[1], x2 * c1[0] + x1 * c1[1]); }
    { const float x1 = bf_lo(a.w), x2 = bf_hi(a.w); o.w = pk2(x1 * c1[2] - x2 * c1[3], x2 * c1[2] + x1 * c1[3]); }
    return o;
}
DI u32x4 rope8(u32x4 a, const float* cs) { return rope8v(a, *(const f32x4*)cs, *(const f32x4*)(cs + 4)); }
DI void unpack8(u32x4 a, float (&v)[8]) { v[0] = bf_lo(a.x); v[1] = bf_hi(a.x); v[2] = bf_lo(a.y); v[3] = bf_hi(a.y); v[4] = bf_lo(a.z); v[5] = bf_hi(a.z); v[6] = bf_lo(a.w); v[7] = bf_hi(a.w); }
DI void phase_post(const Frame& F, int l) {
    const int lane = F.lane, gw = F.bid * 8 + F.wave, NGW = F.G * 8;
    const bf16_t* P = WSP(bf16_t, WS_P); const float* ROPE = WSP(float, WS_ROPE);
    bf16_t *CQ = WSP(bf16_t, WS_CQ), *CKV = WSP(bf16_t, WS_CKV), *KPE = WSP(bf16_t, WS_KPE), *OB = WSP(bf16_t, WS_O3) + (size_t)T_TOK * 512, *QC = WSP(bf16_t, WS_QC), *KC = WSP(bf16_t, WS_KC),
           *VC = WSP(bf16_t, WS_VC), *QI = WSP(bf16_t, WS_QI), *KI = WSP(bf16_t, WS_KI); float* IW = WSP(float, WS_IW);
    const float* cw = KIN_conv_w + (size_t)l * 3 * 512 + 8 * lane;
    f32x4 cwv[3][2];
#pragma unroll
    for (int d = 0; d < 3; ++d) { cwv[d][0] = *(const f32x4*)(cw + d * 512); cwv[d][1] = *(const f32x4*)(cw + d * 512 + 4); }
    const float* in_qn = KIN_q_norm + l * 256 + 8 * (lane & 31); const float* in_kn = KIN_kv_norm + l * 128 + 8 * (lane & 15);
    const f32x4 qn0 = *(const f32x4*)in_qn, qn1 = *(const f32x4*)(in_qn + 4), kn0 = *(const f32x4*)in_kn, kn1 = *(const f32x4*)(in_kn + 4);
    const u32x4 z4 = {0u, 0u, 0u, 0u};
    for (int t = gw; t < T_TOK; t += NGW) {
        const bf16_t* pr = P + (size_t)t * NP; const float* rp = ROPE + (size_t)t * 48; const int s = t & (SEQ - 1);
        const bf16_t* pc = pr + PC_CONV + 8 * lane;
        const u32x4 gbw = *(const u32x4*)pc;
        const u32x4 gc2 = *(const u32x4*)(pc + 512), hc2 = *(const u32x4*)(pc + 1024);
        const u32x4 gc1 = (s >= 1) ? *(const u32x4*)(pc - NP + 512) : z4, hc1 = (s >= 1) ? *(const u32x4*)(pc - NP + 1024) : z4;
        const u32x4 gc0 = (s >= 2) ? *(const u32x4*)(pc - 2 * NP + 512) : z4, hc0 = (s >= 2) ? *(const u32x4*)(pc - 2 * NP + 1024) : z4;
        u32x4 dqw = *(const u32x4*)(pr + PC_DQ + 8 * lane), iqw = *(const u32x4*)(pr + PC_IQ + 8 * lane);
        const u32x4 qlw = *(const u32x4*)(pr + PC_QLAT + 8 * (lane & 31));
        const u32x4 kvw = *(const u32x4*)(pr + PC_KVLAT + 8 * (lane < 20 ? lane : 0));
        u32x4 dkw = *(const u32x4*)(pr + PC_DKV + 8 * (lane & 15));
        u32x4 ikw = *(const u32x4*)(pr + PC_IK + 8 * (lane & 7));
        const u32x4 iww = *(const u32x4*)(pr + PC_IW);
        const f32x4 r16a = *(const f32x4*)(rp + 32 + 8 * (lane & 1)), r16b = *(const f32x4*)(rp + 32 + 8 * (lane & 1) + 4);
        const f32x4 r32a = *(const f32x4*)(rp + 8 * (lane & 3)), r32b = *(const f32x4*)(rp + 8 * (lane & 3) + 4);
        asm volatile("" ::: "memory");
        {
            float gb[8], a0[8], b0[8], a1[8], b1[8], a2[8], b2[8]; unpack8(gbw, gb); unpack8(gc0, a0); unpack8(hc0, b0); unpack8(gc1, a1); unpack8(hc1, b1); unpack8(gc2, a2); unpack8(hc2, b2);
            float o[8];
#pragma unroll
            for (int i = 0; i < 8; ++i) { const float w0 = cwv[0][i >> 2][i & 3], w1 = cwv[1][i >> 2][i & 3], w2 = cwv[2][i >> 2][i & 3]; o[i] = gb[i] * (w0 * (a0[i] * b0[i]) + w1 * (a1[i] * b1[i]) + w2 * (a2[i] * b2[i])); }
            u32x4 ow; ow.x = pk2(o[0], o[1]); ow.y = pk2(o[2], o[3]); ow.z = pk2(o[4], o[5]); ow.w = pk2(o[6], o[7]);
            *(u32x4*)(OB + (size_t)t * 512 + 8 * lane) = ow;
        }
        if ((lane & 7) < 2) { dqw = rope8v(dqw, r16a, r16b); iqw = rope8v(iqw, r16a, r16b); }
        *(u32x4*)(QC + (size_t)t * 512 + 8 * lane) = dqw; *(u32x4*)(QI + (size_t)t * 512 + 8 * lane) = iqw;
        float ql[8], kv[8]; unpack8(qlw, ql); unpack8(kvw, kv);
        float ss1 = 0.f, ss2 = 0.f;
        if (lane < 32) {
#pragma unroll
            for (int i = 0; i < 8; ++i) ss1 += ql[i] * ql[i]; }
        if (lane < 16) {
#pragma unroll
            for (int i = 0; i < 8; ++i) ss2 += kv[i] * kv[i]; }
#pragma unroll
        for (int o = 1; o < 64; o <<= 1) { ss1 += __shfl_xor(ss1, o); ss2 += __shfl_xor(ss2, o); }
        const float r1 = 1.0f / sqrtf(ss1 * (1.0f / 256.0f) + NORM_EPS), r2 = 1.0f / sqrtf(ss2 * (1.0f / 128.0f) + NORM_EPS);
        if (lane < 32) { u32x4 o; o.x = pk2(ql[0] * r1 * qn0[0], ql[1] * r1 * qn0[1]); o.y = pk2(ql[2] * r1 * qn0[2], ql[3] * r1 * qn0[3]); o.z = pk2(ql[4] * r1 * qn1[0], ql[5] * r1 * qn1[1]); o.w = pk2(ql[6] * r1 * qn1[2], ql[7] * r1 * qn1[3]);
            *(u32x4*)(CQ + (size_t)t * 256 + 8 * lane) = o;
            u32x4 k = z4; if (lane < 16) { k.x = pk2(kv[0] * r2 * kn0[0], kv[1] * r2 * kn0[1]); k.y = pk2(kv[2] * r2 * kn0[2], kv[3] * r2 * kn0[3]); k.z = pk2(kv[4] * r2 * kn1[0], kv[5] * r2 * kn1[1]); k.w = pk2(kv[6] * r2 * kn1[2], kv[7] * r2 * kn1[3]); }
            *(u32x4*)(CKV + (size_t)t * 256 + 8 * lane) = k; }
        if (lane >= 16 && lane < 20) *(u32x4*)(KPE + (size_t)t * 32 + 8 * (lane - 16)) = rope8v(kvw, r32a, r32b);
        if (lane < 16) { if (lane < 2) dkw = rope8v(dkw, r16a, r16b); if (lane < 8) *(u32x4*)(KC + (size_t)t * 64 + 8 * lane) = dkw; else *(u32x4*)(VC + (size_t)t * 64 + 8 * (lane - 8)) = dkw; }
        if (lane >= 16 && lane < 24) { const int c = lane - 16; if (c < 2) ikw = rope8v(ikw, r16a, r16b); *(u32x4*)(KI + (size_t)t * 64 + 8 * c) = ikw; }
        if (lane == 32) { float v[8]; unpack8(iww, v); *(f32x4*)(IW + (size_t)t * 8) = (f32x4){v[0], v[1], v[2], v[3]}; *(f32x4*)(IW + (size_t)t * 8 + 4) = (f32x4){v[4], v[5], v[6], v[7]}; }
    }
}

DI int crow(int r, int hi) { return (r & 3) + 8 * (r >> 2) + 4 * hi; }
DI float max3f(float a, float b, float c) { float r; asm("v_max3_f32 %0, %1, %2, %3" : "=v"(r) : "v"(a), "v"(b), "v"(c)); return r; }
template <int C> DI unsigned bit_mask(unsigned w) { unsigned r; asm("v_bfe_i32 %0, %1, %2, 1" : "=v"(r) : "v"(w), "n"(C)); return r; }
#define MFMA32(a, b, c) __builtin_amdgcn_mfma_f32_32x32x16_bf16((a), (b), (c), 0, 0, 0)
#define MFMA16(a, b, c) __builtin_amdgcn_mfma_f32_16x16x32_bf16((a), (b), (c), 0, 0, 0)
#define GLDS16(src, dst) __builtin_amdgcn_global_load_lds((const unsigned*)(src), (LAS unsigned*)(dst), 16, 0, 0)
typedef short v4i16_t __attribute__((ext_vector_type(4)));
DI s16x4 tr_read(const LAS unsigned char* p) { return __builtin_bit_cast(s16x4, __builtin_amdgcn_ds_read_tr16_b64_v4i16((LAS v4i16_t*)p)); }
DI bf16x8 pack8(float a0, float a1, float a2, float a3, float a4, float a5, float a6, float a7) { u32x4 w; w.x = pk2(a0, a1); w.y = pk2(a2, a3); w.z = pk2(a4, a5); w.w = pk2(a6, a7); return __builtin_bit_cast(bf16x8, w); }
DI bf16x8 cat4(s16x4 lo, s16x4 hi) { return (bf16x8){lo[0], lo[1], lo[2], lo[3], hi[0], hi[1], hi[2], hi[3]}; }

constexpr int MLA_K0 = 0, MLA_V0 = 24576, MLA_WS = 49152;
DI void mla_unit(const Frame& F, int b, int h, int qb) {
    const int lane = F.lane, wid = F.wave, r32 = lane & 31, hi = lane >> 5;
    const bf16_t* QA = WSP(bf16_t, WS_QA); const bf16_t* KPE = WSP(bf16_t, WS_KPE); const bf16_t* KV = WSP(bf16_t, WS_KV); bf16_t* OA = WSP(bf16_t, WS_O3);
    const size_t tb = (size_t)b * SEQ; const int q0 = qb * 256, qrow = q0 + 32 * wid + r32;
    const float C2 = 0.10206207261596577f * 1.4426950408889634f;
    LAS unsigned char* lds = F.lds; LAS float* wsf = (LAS float*)(lds + MLA_WS) + wid * 128;
    bf16x8 qr[6];
#pragma unroll
    for (int d0 = 0; d0 < 6; ++d0) qr[d0] = *(const bf16x8*)(QA + (tb + qrow) * 768 + h * 96 + d0 * 16 + hi * 8);
    {
        const float* rp = WSP(float, WS_ROPE) + (tb + qrow) * 48;
        qr[0] = __builtin_bit_cast(bf16x8, rope8(__builtin_bit_cast(u32x4, qr[0]), rp + 8 * hi));
        qr[1] = __builtin_bit_cast(bf16x8, rope8(__builtin_bit_cast(u32x4, qr[1]), rp + 16 + 8 * hi)); }
    const int NT = 4 * (qb + 1);
    const unsigned vo_pe = (unsigned)(lane * 32 + 8 * (wid & 3)) * 2u, vo_k0 = (unsigned)(lane * 1024 + 128 * h + 8 * ((wid + 4) & 7)) * 2u, vo_k1 = (unsigned)(lane * 1024 + 128 * h + 8 * (wid + 4)) * 2u,
                   vo_v = (unsigned)((16 * (wid & 3) + (lane >> 2)) * 1024 + 128 * h + 64 + 32 * (wid >> 2) + 8 * (lane & 3)) * 2u;
    const unsigned ldsb = (unsigned)(unsigned long long)lds;
    const char* pe_b = pg8::uni_ptr((const char*)(KPE + tb * 32)); const char* kv_b = pg8::uni_ptr((const char*)(KV + tb * 1024));
#define MLA_STAGE(kt, buf, vslot) do { const char* pe_ = pe_b + (size_t)(kt) * (64 * 32 * 2); const char* kv_ = kv_b + (size_t)(kt) * (64 * 1024 * 2); \
        if (wid < 4) { pg8::glds16_s(vo_pe, pe_, ldsb + MLA_K0 + (buf) * 12288 + wid * 1024); pg8::glds16_s(vo_k1, kv_, ldsb + MLA_K0 + (buf) * 12288 + (wid + 8) * 1024); } \
        else { pg8::glds16_s(vo_k0, kv_, ldsb + MLA_K0 + (buf) * 12288 + wid * 1024); } \
        pg8::glds16_s(vo_v, kv_, ldsb + MLA_V0 + (vslot) * 8192 + wid * 1024); } while (0)
    MLA_STAGE(0, 0, 0);
    float m = -1e30f, l = 0.f; f32x16 o[2];
#pragma unroll
    for (int r = 0; r < 16; ++r) { o[0][r] = 0.f; o[1][r] = 0.f; }
    const int vboff = ((lane >> 4) & 1) * 32 + (lane & 3) * 8 + (4 * hi + ((lane & 15) >> 2)) * 64;
    const bool upper = wid >= 4; bool have_prev = false; bf16x8 pa[4];
#define MLA_PV(vs) do { const LAS unsigned char* vb_ = lds + MLA_V0 + (vs) * 8192 + vboff; \
        _Pragma("unroll") for (int d0 = 0; d0 < 2; ++d0) _Pragma("unroll") for (int ks = 0; ks < 4; ++ks) { \
            const s16x4 lo_ = tr_read(vb_ + d0 * 4096 + ks * 1024), hh_ = tr_read(vb_ + d0 * 4096 + ks * 1024 + 512); o[d0] = MFMA32(pa[ks], cat4(lo_, hh_), o[d0]); } } while (0)
    int vs_cur = 0, vs_prev = 0;
    for (int kt = 0; kt < NT; ++kt) {
        const int buf = kt & 1; const int vs_next = (vs_cur == 2) ? 0 : vs_cur + 1;
        VM_WAIT(); __syncthreads();
        if (kt + 1 < NT) MLA_STAGE(kt + 1, buf ^ 1, vs_next);
        if (upper && have_prev) { MLA_PV(vs_prev); have_prev = false; }
        if (64 * kt <= q0 + 32 * wid + 31) {
            f32x16 p0, p1;
#pragma unroll
            for (int r = 0; r < 16; ++r) { p0[r] = 0.f; p1[r] = 0.f; }
            const LAS unsigned char* kb = lds + MLA_K0 + buf * 12288 + hi * 1024 + r32 * 16;
#pragma unroll
            for (int d0 = 0; d0 < 6; ++d0) { const bf16x8 b0 = *(const LAS bf16x8*)(kb + d0 * 2048), b1 = *(const LAS bf16x8*)(kb + d0 * 2048 + 512);
                p0 = MFMA32(b0, qr[d0], p0); p1 = MFMA32(b1, qr[d0], p1); }
            if (64 * kt + 63 > q0 + 32 * wid) {
#pragma unroll
                for (int r = 0; r < 16; ++r) { const int kv = 64 * kt + crow(r, hi); if (kv > qrow) p0[r] = -INFINITY; if (kv + 32 > qrow) p1[r] = -INFINITY; } }
            float rm = fmaxf(p0[0], p1[0]);
#pragma unroll
            for (int r = 1; r < 16; ++r) rm = max3f(rm, p0[r], p1[r]);
            rm = fmaxf(rm, __shfl_xor(rm, 32));
            const float mn = fmaxf(m, rm);
            if (__any(mn > m)) {
                const float alpha = __builtin_amdgcn_exp2f((m - mn) * C2); l *= alpha; m = mn;
                if (hi == 0) wsf[r32] = alpha;
                LDS_WAIT();
#pragma unroll
                for (int q = 0; q < 4; ++q) { const f32x4 a = *(const LAS f32x4*)(wsf + 8 * q + 4 * hi);
#pragma unroll
                    for (int j = 0; j < 4; ++j) { o[0][4 * q + j] *= a[j]; o[1][4 * q + j] *= a[j]; } }
            }
            const float mc = m * C2; float ls = 0.f;
#pragma unroll
            for (int r = 0; r < 16; ++r) { p0[r] = __builtin_amdgcn_exp2f(__builtin_fmaf(p0[r], C2, -mc)); p1[r] = __builtin_amdgcn_exp2f(__builtin_fmaf(p1[r], C2, -mc)); ls += p0[r] + p1[r]; }
            l += ls;
            pa[0] = pack8(p0[0], p0[1], p0[2], p0[3], p0[4], p0[5], p0[6], p0[7]); pa[1] = pack8(p0[8], p0[9], p0[10], p0[11], p0[12], p0[13], p0[14], p0[15]);
            pa[2] = pack8(p1[0], p1[1], p1[2], p1[3], p1[4], p1[5], p1[6], p1[7]); pa[3] = pack8(p1[8], p1[9], p1[10], p1[11], p1[12], p1[13], p1[14], p1[15]);
            if (upper) have_prev = true; else MLA_PV(vs_cur);
        }
        vs_prev = vs_cur; vs_cur = vs_next;
    }
    if (upper && have_prev) MLA_PV(vs_prev);
#undef MLA_PV
#undef MLA_STAGE
    l += __shfl_xor(l, 32);
    if (hi == 0) wsf[64 + r32] = 1.0f / l;
    LDS_WAIT();
    bf16_t* orow = OA + (tb + q0 + 32 * wid) * 512 + h * 64 + r32;
#pragma unroll
    for (int q = 0; q < 4; ++q) { const f32x4 a = *(const LAS f32x4*)(wsf + 64 + 8 * q + 4 * hi);
#pragma unroll
        for (int j = 0; j < 4; ++j) { const int r = 4 * q + j, rr = crow(r, hi);
            orow[(size_t)rr * 512] = (bf16_t)(pk2(o[0][r] * a[j], 0.f) & 0xffffu); orow[(size_t)rr * 512 + 32] = (bf16_t)(pk2(o[1][r] * a[j], 0.f) & 0xffffu); } }
    __syncthreads();
}

constexpr int DSA_SCW = 2052;
constexpr int DSA_SEL = 16 * DSA_SCW * 4;
constexpr int DSA_CAND = DSA_SEL + 4096;
template <int CTRL> DI float dpp_f(float x) { return __uint_as_float((unsigned)__builtin_amdgcn_update_dpp(0, (int)__float_as_uint(x), CTRL, 0xf, 0xf, false)); }
DI float rl_f(float x, int l) { return __uint_as_float((unsigned)__builtin_amdgcn_readlane((int)__float_as_uint(x), l)); }
DI float wave_sum_dpp(float x) { x += dpp_f<0x128>(x); x += dpp_f<0x124>(x); x += dpp_f<0x122>(x); x += dpp_f<0x121>(x); return (rl_f(x, 0) + rl_f(x, 16)) + (rl_f(x, 32) + rl_f(x, 48)); }
DI float wave_max_dpp(float x) { x = fmaxf(x, dpp_f<0x128>(x)); x = fmaxf(x, dpp_f<0x124>(x)); x = fmaxf(x, dpp_f<0x122>(x)); x = fmaxf(x, dpp_f<0x121>(x)); return fmaxf(fmaxf(rl_f(x, 0), rl_f(x, 16)), fmaxf(rl_f(x, 32), rl_f(x, 48))); }
DI int mbcnt64(unsigned long long m) { return (int)__builtin_amdgcn_mbcnt_hi((unsigned)(m >> 32), __builtin_amdgcn_mbcnt_lo((unsigned)m, 0u)); }
DI void dsa_unit(const Frame& F, int b, int qt) {
    const int tid = F.tid, lane = F.lane, wid = F.wave, fr = lane & 15, g = lane >> 4;
    const bf16_t *QI = WSP(bf16_t, WS_QI), *KI = WSP(bf16_t, WS_KI), *QC = WSP(bf16_t, WS_QC), *KC = WSP(bf16_t, WS_KC), *VC = WSP(bf16_t, WS_VC); const float* IW = WSP(float, WS_IW);
    bf16_t* OC = WSP(bf16_t, WS_O3) + (size_t)2 * T_TOK * 512;
    const size_t tb = (size_t)b * SEQ; const int t0 = 16 * qt;
    LAS unsigned char* lds = F.lds; LAS float* SC = (LAS float*)lds; LAS unsigned long long* BITS = (LAS unsigned long long*)(lds + DSA_SEL);
#ifdef PROBE_S1DUP
    for (int rep1_ = 0; rep1_ < PROBE_S1DUP; ++rep1_)
#endif
    {
        bf16x8 qf[8][2]; float wv[8];
        const bf16_t* qp = QI + (tb + t0 + fr) * 512 + 8 * g;
#pragma unroll
        for (int h = 0; h < 8; ++h) { qf[h][0] = *(const bf16x8*)(qp + h * 64); qf[h][1] = *(const bf16x8*)(qp + h * 64 + 32); }
        { const f32x4 w0 = *(const f32x4*)(IW + (tb + t0 + fr) * 8), w1 = *(const f32x4*)(IW + (tb + t0 + fr) * 8 + 4); wv[0] = w0[0]; wv[1] = w0[1]; wv[2] = w0[2]; wv[3] = w0[3]; wv[4] = w1[0]; wv[5] = w1[1]; wv[6] = w1[2]; wv[7] = w1[3]; }
        const bf16_t* kbase = KI + (tb + fr) * 64 + 8 * g;
        const bf16x8 z8 = {0, 0, 0, 0, 0, 0, 0, 0};
        bf16x8 a0 = z8, a1 = z8, b0 = z8, b1 = z8, c0 = z8, c1 = z8;
        if (wid <= qt) { a0 = *(const bf16x8*)(kbase + (size_t)wid * 1024); a1 = *(const bf16x8*)(kbase + (size_t)wid * 1024 + 32); }
        if (wid + 8 <= qt) { b0 = *(const bf16x8*)(kbase + (size_t)(wid + 8) * 1024); b1 = *(const bf16x8*)(kbase + (size_t)(wid + 8) * 1024 + 32); }
        if (wid + 16 <= qt) { c0 = *(const bf16x8*)(kbase + (size_t)(wid + 16) * 1024); c1 = *(const bf16x8*)(kbase + (size_t)(wid + 16) * 1024 + 32); }
        for (int kt = wid; kt <= qt; kt += 8) {
            bf16x8 n0 = z8, n1 = z8;
            if (kt + 24 <= qt) { n0 = *(const bf16x8*)(kbase + (size_t)(kt + 24) * 1024); n1 = *(const bf16x8*)(kbase + (size_t)(kt + 24) * 1024 + 32); }
            f32x4 s = {F.zf, F.zf, F.zf, F.zf};
#pragma unroll
            for (int h = 0; h < 8; ++h) { f32x4 acc = {F.zf, F.zf, F.zf, F.zf}; acc = MFMA16(a0, qf[h][0], acc); acc = MFMA16(a1, qf[h][1], acc);
#pragma unroll
                for (int r = 0; r < 4; ++r) s[r] += fmaxf(acc[r], 0.f) * wv[h]; }
#pragma unroll
            for (int r = 0; r < 4; ++r) if (16 * kt + 4 * g + r > t0 + fr) s[r] = -INFINITY;
            *(LAS f32x4*)(SC + fr * DSA_SCW + 16 * kt + 4 * g) = s;
            a0 = b0; a1 = b1; b0 = c0; b1 = c1; c0 = n0; c1 = n1;
        }
    }
    __syncthreads();
    for (int qi2 = 0; qi2 < 2; ++qi2) {
        const int qq = 2 * wid + qi2, t = t0 + qq, nvalid = t + 1;
        LAS unsigned long long* bits = BITS + qq * 32;
        if (nvalid <= 256) { if (lane < 32) { const int k0 = 64 * lane; bits[lane] = (k0 + 63 <= t) ? ~0ull : (k0 <= t) ? ((1ull << (t - k0 + 1)) - 1ull) : 0ull; } }
        else {
            const int nq = (nvalid + 511) >> 9;
            float v[32];
#pragma unroll
            for (int i = 0; i < 32; ++i) { const int key = i * 64 + lane; v[i] = (key <= t) ? SC[qq * DSA_SCW + key] : -INFINITY; }
#define DSA_CMP_ge(m_, x_, t_) asm("v_cmp_ge_f32_e64 %0, %1, %2" : "=s"(m_) : "v"(x_), "v"(t_))
#define DSA_CMP_gt(m_, x_, t_) asm("v_cmp_gt_f32_e64 %0, %1, %2" : "=s"(m_) : "v"(x_), "v"(t_))
#define DSA_COUNT(thr, OPN, out) do { int tot_ = 0; const float thr_ = (thr); _Pragma("unroll") for (int qd = 0; qd < 4; ++qd) { if (qd < nq) { unsigned long long m_[8]; \
                _Pragma("unroll") for (int i = 0; i < 8; ++i) DSA_CMP_##OPN(m_[i], v[8 * qd + i], thr_); __builtin_amdgcn_sched_barrier(0); _Pragma("unroll") for (int i = 0; i < 8; ++i) tot_ += __builtin_popcountll(m_[i]); __builtin_amdgcn_sched_barrier(0); } } out = tot_; } while (0)
            float lo = 0.f, hi = 0.f, K = 0.f; int cnt = 0, clo = nvalid, chi = 0; bool done = false, have_lo = false, have_hi = false;
            if (nvalid >= 512) {
                float a1 = -INFINITY, a2 = -INFINITY, a3 = -INFINITY, a4 = -INFINITY, a5 = -INFINITY;
#pragma unroll
                for (int qd = 0; qd < 4; ++qd) { if (qd < nq) {
#pragma unroll
                    for (int i = 0; i < 8; ++i) { const float x = v[8 * qd + i];
                        const float n5 = __builtin_amdgcn_fmed3f(a4, a5, x), n4 = __builtin_amdgcn_fmed3f(a3, a4, x), n3 = __builtin_amdgcn_fmed3f(a2, a3, x), n2 = __builtin_amdgcn_fmed3f(a1, a2, x);
                        a1 = fmaxf(a1, x); a2 = n2; a3 = n3; a4 = n4; a5 = n5; } } }
                const float m3 = wave_sum_dpp(a3) * (1.0f / 64.0f), m4 = wave_sum_dpp(a4) * (1.0f / 64.0f), m5 = wave_sum_dpp(a5) * (1.0f / 64.0f);
                int c5; DSA_COUNT(m5, ge, c5);
                if (c5 == 256) { K = m5; cnt = 256; done = true; }
                else if (c5 < 256) { hi = m5; chi = c5; have_hi = true; }
                else { lo = m5; clo = c5; have_lo = true;
                    int c4; DSA_COUNT(m4, ge, c4);
                    if (c4 == 256) { K = m4; cnt = 256; done = true; }
                    else if (c4 < 256) { hi = m4; chi = c4; have_hi = true; }
                    else { lo = m4; clo = c4;
                        int c3; DSA_COUNT(m3, ge, c3);
                        if (c3 == 256) { K = m3; cnt = 256; done = true; }
                        else if (c3 < 256) { hi = m3; chi = c3; have_hi = true; }
                        else { lo = m3; clo = c3; } } }
            }
            if (!done && !(have_lo && have_hi)) {
                float vmax = v[0], vmin = (v[0] == -INFINITY) ? INFINITY : v[0];
#pragma unroll
                for (int i = 1; i < 32; ++i) { vmax = fmaxf(vmax, v[i]); vmin = fminf(vmin, (v[i] == -INFINITY) ? INFINITY : v[i]); }
                vmax = wave_max_dpp(vmax); vmin = -wave_max_dpp(-vmin);
                if (!have_hi) { hi = vmax; DSA_COUNT(hi, ge, cnt); if (cnt >= 256) { K = hi; done = true; } else chi = cnt; }
                if (!have_lo) { lo = vmin; clo = nvalid; }
            }
            if (!done)
            for (int it = 0;; ++it) {
                if (clo - chi <= 64) {
                    LAS float* cand = (LAS float*)(lds + DSA_CAND) + wid * 64;
                    cand[lane] = -INFINITY;
                    int base = 0;
#pragma unroll
                    for (int qd = 0; qd < 4; ++qd) { if (qd < nq) {
#pragma unroll
                        for (int i = 0; i < 8; ++i) { const float x = v[8 * qd + i]; const bool c = (x >= lo) && (x < hi); const unsigned long long m = __ballot(c);
                            if (c) cand[base + mbcnt64(m)] = x;
                            base += __builtin_popcountll(m); } } }
                    const float cv = cand[lane]; const int need = 256 - chi; int ge = 0;
                    for (int k = 0; k < base; ++k) { const float ck = __uint_as_float((unsigned)__builtin_amdgcn_readlane((int)__float_as_uint(cv), k)); ge += (ck >= cv) ? 1 : 0; }
                    K = wave_max_dpp((ge >= need) ? cv : -INFINITY); DSA_COUNT(K, ge, cnt);
                    break;
                }
                float fr_ = 0.5f;
                if ((it & 1) == 0) { fr_ = ((float)(clo - 256) + 0.5f) * __builtin_amdgcn_rcpf((float)(clo - chi)); fr_ = fminf(fmaxf(fr_, 0.03125f), 0.96875f); }
                const float mid = lo + (hi - lo) * fr_;
                if (!(mid > lo && mid < hi)) {
                    const float mid2 = lo + (hi - lo) * 0.5f;
                    if (!(mid2 > lo && mid2 < hi)) { K = lo; cnt = clo; break; }
                    DSA_COUNT(mid2, ge, cnt);
                    if (cnt == 256) { K = mid2; break; }
                    if (cnt > 256) { lo = mid2; clo = cnt; } else { hi = mid2; chi = cnt; }
                    continue;
                }
                DSA_COUNT(mid, ge, cnt);
                if (cnt == 256) { K = mid; break; }
                if (cnt > 256) { lo = mid; clo = cnt; } else { hi = mid; chi = cnt; }
            }
            if (cnt == 256) {
#pragma unroll
                for (int qd = 0; qd < 4; ++qd) {
#pragma unroll
                    for (int i8 = 0; i8 < 8; ++i8) { const int i = 8 * qd + i8; const unsigned long long mt = (qd < nq) ? __ballot(v[i] >= K) : 0ull; if (lane == 0) bits[i] = mt; } }
            } else {
                int cgt; DSA_COUNT(K, gt, cgt);
                const int need = 256 - cgt; int eqb = 0;
#pragma unroll
                for (int qd = 0; qd < 4; ++qd) {
#pragma unroll
                    for (int i8 = 0; i8 < 8; ++i8) { const int i = 8 * qd + i8; unsigned long long mt = 0ull;
                        if (qd < nq) { const bool gt = v[i] > K, eq = v[i] == K; const unsigned long long me = __ballot(eq); const int erank = eqb + mbcnt64(me);
                            mt = __ballot(gt || (eq && erank < need)); eqb += __builtin_popcountll(me); }
                        if (lane == 0) bits[i] = mt; } }
            }
#undef DSA_COUNT
#undef DSA_CMP_ge
#undef DSA_CMP_gt
        }
    }
    __syncthreads();
#ifdef PROBE_S3DUP
    for (int rep3_ = 0; rep3_ < PROBE_S3DUP; ++rep3_) { if (rep3_) __syncthreads();
#endif
    {
        const float C2S = 0.125f * 1.4426950408889634f;
        int lane3 = lane; asm volatile("" : "+v"(lane3));
        const int r32 = lane3 & 31, hi = lane3 >> 5, cg = wid & 3, kp = wid >> 2;
        const int NT = (t0 + 16 + 63) >> 6, NS = (NT + 1) >> 1;
        const int qloc = 4 * cg + (r32 >> 3);
        LAS float* wsf = (LAS float*)(lds + 98304) + wid * 128;
        LAS float* OW = (LAS float*)lds; LAS float* ML2 = (LAS float*)(lds + 102400);
        bf16x8 qr[4];
#pragma unroll
        for (int d0 = 0; d0 < 4; ++d0) qr[d0] = *(const bf16x8*)(QC + (tb + t0 + qloc) * 512 + (r32 & 7) * 64 + d0 * 16 + hi * 8);
        const unsigned vo_kc = (unsigned)(lane3 * 64 + 8 * wid) * 2u, vo_vc = (unsigned)((16 * (wid & 3) + (lane3 >> 2)) * 64 + 32 * (wid >> 2) + 8 * (lane3 & 3)) * 2u, ldsb = (unsigned)(unsigned long long)lds;
        const char* kc_b = pg8::uni_ptr((const char*)(KC + tb * 64)); const char* vc_b = pg8::uni_ptr((const char*)(VC + tb * 64));
#define DSD_STAGE(j, buf) do { _Pragma("unroll") for (int par_ = 0; par_ < 2; ++par_) { int kt_ = 2 * (j) + par_; kt_ = kt_ < NT ? kt_ : NT - 1; \
            const unsigned d_ = ldsb + (buf) * 32768 + par_ * 16384; \
            pg8::glds16_s(vo_kc, kc_b + (size_t)kt_ * (64 * 64 * 2), d_ + wid * 1024); pg8::glds16_s(vo_vc, vc_b + (size_t)kt_ * (64 * 64 * 2), d_ + 8192 + wid * 1024); } } while (0)
        DSD_STAGE(0, 0);
        if (NS > 1) DSD_STAGE(1, 1);
        float m = -1e30f, l = 0.f; f32x16 o[2];
#pragma unroll
        for (int r = 0; r < 16; ++r) { o[0][r] = F.zf; o[1][r] = F.zf; }
        const int vboff = ((lane3 >> 4) & 1) * 32 + (lane3 & 3) * 8 + (4 * hi + ((lane3 & 15) >> 2)) * 64;
        int buf = 0, bufn = 2;
        for (int j = 0; j < NS; ++j) {
            const int kt = 2 * j + kp;
            if (j + 1 < NS) asm volatile("s_waitcnt vmcnt(4)" ::: "memory"); else VM_WAIT();
            __syncthreads();
            if (j + 2 < NS) DSD_STAGE(j + 2, bufn);
            if (kt < NT) {
                const LAS unsigned char* tile = lds + buf * 32768 + kp * 16384;
                f32x16 p0, p1;
#pragma unroll
                for (int r = 0; r < 16; ++r) { p0[r] = F.zf; p1[r] = F.zf; }
                const LAS unsigned char* kb = tile + hi * 1024 + r32 * 16;
#pragma unroll
                for (int d0 = 0; d0 < 4; ++d0) { const bf16x8 b0 = *(const LAS bf16x8*)(kb + d0 * 2048), b1 = *(const LAS bf16x8*)(kb + d0 * 2048 + 512);
                    p0 = MFMA32(b0, qr[d0], p0); p1 = MFMA32(b1, qr[d0], p1); }
                float rm = fmaxf(p0[0], p1[0]);
#pragma unroll
                for (int r = 1; r < 16; ++r) rm = max3f(rm, p0[r], p1[r]);
                rm = fmaxf(rm, __shfl_xor(rm, 32));
                const float mn = fmaxf(m, rm);
                if (__any(mn > m)) {
                    const float alpha = __builtin_amdgcn_exp2f((m - mn) * C2S); l *= alpha; m = mn;
                    if (hi == 0) wsf[r32] = alpha;
                    LDS_WAIT();
#pragma unroll
                    for (int q = 0; q < 4; ++q) { const f32x4 a = *(const LAS f32x4*)(wsf + 8 * q + 4 * hi);
#pragma unroll
                        for (int jj = 0; jj < 4; ++jj) { o[0][4 * q + jj] *= a[jj]; o[1][4 * q + jj] *= a[jj]; } }
                }
                const unsigned long long bw = BITS[qloc * 32 + kt];
                const unsigned wl = (unsigned)bw >> (4 * hi), wh = (unsigned)(bw >> 32) >> (4 * hi);
                const float mc = m * C2S; float ls = 0.f;
#pragma unroll
                for (int r = 0; r < 16; ++r) { constexpr int dummy_ = 0; (void)dummy_;
                    const unsigned m0 = (r == 0) ? bit_mask<0>(wl) : (r == 1) ? bit_mask<1>(wl) : (r == 2) ? bit_mask<2>(wl) : (r == 3) ? bit_mask<3>(wl) : (r == 4) ? bit_mask<8>(wl) : (r == 5) ? bit_mask<9>(wl) : (r == 6) ? bit_mask<10>(wl) : (r == 7) ? bit_mask<11>(wl)
                                      : (r == 8) ? bit_mask<16>(wl) : (r == 9) ? bit_mask<17>(wl) : (r == 10) ? bit_mask<18>(wl) : (r == 11) ? bit_mask<19>(wl) : (r == 12) ? bit_mask<24>(wl) : (r == 13) ? bit_mask<25>(wl) : (r == 14) ? bit_mask<26>(wl) : bit_mask<27>(wl);
                    const unsigned m1 = (r == 0) ? bit_mask<0>(wh) : (r == 1) ? bit_mask<1>(wh) : (r == 2) ? bit_mask<2>(wh) : (r == 3) ? bit_mask<3>(wh) : (r == 4) ? bit_mask<8>(wh) : (r == 5) ? bit_mask<9>(wh) : (r == 6) ? bit_mask<10>(wh) : (r == 7) ? bit_mask<11>(wh)
                                      : (r == 8) ? bit_mask<16>(wh) : (r == 9) ? bit_mask<17>(wh) : (r == 10) ? bit_mask<18>(wh) : (r == 11) ? bit_mask<19>(wh) : (r == 12) ? bit_mask<24>(wh) : (r == 13) ? bit_mask<25>(wh) : (r == 14) ? bit_mask<26>(wh) : bit_mask<27>(wh);
                    p0[r] = __uint_as_float(__float_as_uint(__builtin_amdgcn_exp2f(__builtin_fmaf(p0[r], C2S, -mc))) & m0);
                    p1[r] = __uint_as_float(__float_as_uint(__builtin_amdgcn_exp2f(__builtin_fmaf(p1[r], C2S, -mc))) & m1);
                    ls += p0[r] + p1[r]; }
                l += ls;
                bf16x8 pa[4];
                pa[0] = pack8(p0[0], p0[1], p0[2], p0[3], p0[4], p0[5], p0[6], p0[7]); pa[1] = pack8(p0[8], p0[9], p0[10], p0[11], p0[12], p0[13], p0[14], p0[15]);
                pa[2] = pack8(p1[0], p1[1], p1[2], p1[3], p1[4], p1[5], p1[6], p1[7]); pa[3] = pack8(p1[8], p1[9], p1[10], p1[11], p1[12], p1[13], p1[14], p1[15]);
                const LAS unsigned char* vb = tile + 8192 + vboff;
#pragma unroll
                for (int d0 = 0; d0 < 2; ++d0)
#pragma unroll
                    for (int ks = 0; ks < 4; ++ks) { const s16x4 lo = tr_read(vb + d0 * 4096 + ks * 1024), hh = tr_read(vb + d0 * 4096 + ks * 1024 + 512);
                        o[d0] = MFMA32(pa[ks], cat4(lo, hh), o[d0]); }
            }
            buf = (buf == 2) ? 0 : buf + 1; bufn = (bufn == 2) ? 0 : bufn + 1;
        }
#undef DSD_STAGE
        l += __shfl_xor(l, 32);
        __syncthreads();
        if (kp == 1) {
            LAS float* ow = OW + cg * 2048;
#pragma unroll
            for (int r = 0; r < 16; ++r) { const int row = crow(r, hi); ow[row * 64 + r32] = o[0][r]; ow[row * 64 + 32 + r32] = o[1][r]; }
            if (hi == 0) { ML2[cg * 64 + r32] = m; ML2[cg * 64 + 32 + r32] = l; }
        }
        __syncthreads();
        if (kp == 0) {
            const float m2 = ML2[cg * 64 + r32], l2 = ML2[cg * 64 + 32 + r32];
            const float M = fmaxf(m, m2), a1 = __builtin_amdgcn_exp2f((m - M) * C2S), a2 = __builtin_amdgcn_exp2f((m2 - M) * C2S);
            const float linv = 1.0f / (a1 * l + a2 * l2);
            if (hi == 0) { wsf[r32] = a1 * linv; wsf[32 + r32] = a2 * linv; }
            LDS_WAIT();
            const LAS float* ow = OW + cg * 2048;
            bf16_t* op = OC + (tb + t0 + 4 * cg) * 512 + r32;
#pragma unroll
            for (int q = 0; q < 4; ++q) { const f32x4 s1 = *(const LAS f32x4*)(wsf + 8 * q + 4 * hi), s2 = *(const LAS f32x4*)(wsf + 32 + 8 * q + 4 * hi);
#pragma unroll
                for (int jj = 0; jj < 4; ++jj) { const int r = 4 * q + jj, row = crow(r, hi);
                    const float v0 = o[0][r] * s1[jj] + ow[row * 64 + r32] * s2[jj], v1 = o[1][r] * s1[jj] + ow[row * 64 + 32 + r32] * s2[jj];
                    bf16_t* dst = op + (size_t)(row >> 3) * 512 + (row & 7) * 64;
                    dst[0] = (bf16_t)(pk2(v0, 0.f) & 0xffffu); dst[32] = (bf16_t)(pk2(v1, 0.f) & 0xffffu); } }
        }
    }
#ifdef PROBE_S3DUP
    }
#endif
    __syncthreads();
}
DI void attention_mla_units(const Frame& F, int rep_a) {
    for (int rep = 0; rep < rep_a; ++rep)
    for (int U = F.bid; U < 1024; U += F.G) { const int i = U >> 8, cp = U & 255, half = cp >> 7, rem = cp & 127; mla_unit(F, rem & 15, rem >> 4, 2 * i + (half ^ (i & 1))); }
}
DI void attention_dsa_units(const Frame& F, int rep_c) {
    for (int rep = 0; rep < rep_c; ++rep)
    for (int U = F.bid; U < 2048; U += F.G) { const int i = U >> 8, cp = U & 255; dsa_unit(F, cp & 15, 16 * i + (cp >> 4)); }
}
DI void phase_attention(const Frame& F, int rep_a, int rep_c) {
    if (F.bid & 1) { attention_dsa_units(F, rep_c); __syncthreads(); attention_mla_units(F, rep_a); }
    else { attention_mla_units(F, rep_a); __syncthreads(); attention_dsa_units(F, rep_c); }
}

constexpr int N2_WROW = 1032;
constexpr int N2_WH = 0, N2_WL = 32 * N2_WROW * 2, N2_CB = 2 * N2_WL, N2_PART = N2_CB + 128, N2_LGT = N2_PART + 2048, N2_RST = N2_LGT + 8 * 2304, N2_CNT = N2_RST + 512, N2_BASE = N2_CNT + 128, N2_TOK = N2_BASE + 128;
static_assert(N2_TOK + 2048 <= MISC_OFF, "router LDS map");
DI void phase_router(const Frame& F, int l, int cset) {
    const int tid = F.tid, lane = F.lane, wave = F.wave, fr = lane & 15, g = lane >> 4;
    LAS unsigned char* lds = F.lds;
    LAS bf16_t* WH = (LAS bf16_t*)(lds + N2_WH); LAS bf16_t* WL = (LAS bf16_t*)(lds + N2_WL); LAS float* CB = (LAS float*)(lds + N2_CB); LAS float* PART = (LAS float*)(lds + N2_PART);
    LAS float* LGT = (LAS float*)(lds + N2_LGT) + wave * 576; LAS float* RST = (LAS float*)(lds + N2_RST) + wave * 16;
    LAS int* CNT = (LAS int*)(lds + N2_CNT); LAS int* BASE = (LAS int*)(lds + N2_BASE); LAS int* TOKR = (LAS int*)(lds + N2_TOK);
    const float* X1 = WSP(float, WS_X1); const float* MOD = WSP(float, WS_MOD); unsigned char* H8 = WSP(unsigned char, WS_H8);
    const float* in_n2 = KIN_norm2_g + l * 1024; const float* in_rb = KIN_router_b + l * 32; const float* in_rw = KIN_router_w + (size_t)l * 32768;
    int* TOPE = (int*)(F.ws + WS_ROUTE + RT_TOPE); float* TOPG = (float*)(F.ws + WS_ROUTE + RT_TOPG); int* RANK = (int*)(F.ws + WS_ROUTE + RT_RANK);
    for (int chunk = F.bid; chunk < T_TOK / 128; chunk += F.G) {
        const int b = chunk >> 4; const float* md = MOD + ((size_t)l * 16 + b) * 6144;
        __syncthreads();
        { float cp = 0.f;
          for (int idx = tid; idx < 32 * 1024; idx += 512) { const int k = idx >> 5, e = idx & 31; const float w = in_rw[idx]; const float wp = w * (in_n2[k] * (1.0f + md[4 * 1024 + k]));
              const unsigned hw = pk2(wp, 0.f) & 0xffffu; const float lo = wp - __uint_as_float(hw << 16);
              WH[e * N2_WROW + k] = (bf16_t)hw; WL[e * N2_WROW + k] = (bf16_t)(pk2(lo, 0.f) & 0xffffu); cp += md[3 * 1024 + k] * w; }
          PART[(tid >> 5) * 32 + (tid & 31)] = cp; }
        if (tid < 32) CNT[tid] = 0;
        __syncthreads();
        if (tid < 32) { float c = in_rb[tid];
#pragma unroll
            for (int p = 0; p < 16; ++p) c += PART[p * 32 + tid];
            CB[tid] = c; }
        __syncthreads();
        const int t0w = chunk * 128 + wave * 16;
        {
            const float* xp = X1 + (size_t)(t0w + fr) * 1024 + 8 * g;
            f32x4 acc0 = {F.zf, F.zf, F.zf, F.zf}, acc1 = acc0; float ssq = 0.f;
            const LAS bf16_t* wh0 = WH + fr * N2_WROW + 8 * g; const LAS bf16_t* wl0 = WL + fr * N2_WROW + 8 * g;
#pragma unroll 8
            for (int ks = 0; ks < 32; ++ks) {
                const f32x4 xa = *(const f32x4*)(xp + 32 * ks), xb = *(const f32x4*)(xp + 32 * ks + 4);
                ssq += (xa[0] * xa[0] + xa[1] * xa[1]) + (xa[2] * xa[2] + xa[3] * xa[3]) + (xb[0] * xb[0] + xb[1] * xb[1]) + (xb[2] * xb[2] + xb[3] * xb[3]);
                u32x4 hw; hw.x = pk2(xa[0], xa[1]); hw.y = pk2(xa[2], xa[3]); hw.z = pk2(xb[0], xb[1]); hw.w = pk2(xb[2], xb[3]);
                u32x4 lw; lw.x = pk2(xa[0] - bf_lo(hw.x), xa[1] - bf_hi(hw.x)); lw.y = pk2(xa[2] - bf_lo(hw.y), xa[3] - bf_hi(hw.y)); lw.z = pk2(xb[0] - bf_lo(hw.z), xb[1] - bf_hi(hw.z)); lw.w = pk2(xb[2] - bf_lo(hw.w), xb[3] - bf_hi(hw.w));
                const bf16x8 ah = __builtin_bit_cast(bf16x8, hw), al = __builtin_bit_cast(bf16x8, lw);
                const bf16x8 bh0 = *(const LAS bf16x8*)(wh0 + 32 * ks), bh1 = *(const LAS bf16x8*)(wh0 + 16 * N2_WROW + 32 * ks), bl0 = *(const LAS bf16x8*)(wl0 + 32 * ks), bl1 = *(const LAS bf16x8*)(wl0 + 16 * N2_WROW + 32 * ks);
                acc0 = __builtin_amdgcn_mfma_f32_16x16x32_bf16(ah, bh0, acc0, 0, 0, 0); acc0 = __builtin_amdgcn_mfma_f32_16x16x32_bf16(ah, bl0, acc0, 0, 0, 0); acc0 = __builtin_amdgcn_mfma_f32_16x16x32_bf16(al, bh0, acc0, 0, 0, 0);
                acc1 = __builtin_amdgcn_mfma_f32_16x16x32_bf16(ah, bh1, acc1, 0, 0, 0); acc1 = __builtin_amdgcn_mfma_f32_16x16x32_bf16(ah, bl1, acc1, 0, 0, 0); acc1 = __builtin_amdgcn_mfma_f32_16x16x32_bf16(al, bh1, acc1, 0, 0, 0);
            }
            ssq += __shfl_xor(ssq, 16); ssq += __shfl_xor(ssq, 32);
            if (g == 0) RST[fr] = 1.0f / sqrtf(ssq * (1.0f / 1024.0f) + NORM_EPS);
#pragma unroll
            for (int r = 0; r < 4; ++r) { LGT[(4 * g + r) * 36 + fr] = acc0[r]; LGT[(4 * g + r) * 36 + 16 + fr] = acc1[r]; }
        }
        LDS_WAIT();
        if (lane < 16) {
            const int t = t0w + lane; const float rt = RST[lane];
            float a[32];
#pragma unroll
            for (int q = 0; q < 8; ++q) { const f32x4 w = *(const LAS f32x4*)(LGT + lane * 36 + 4 * q), c = *(const LAS f32x4*)(CB + 4 * q); a[4 * q] = w[0] * rt + c[0]; a[4 * q + 1] = w[1] * rt + c[1]; a[4 * q + 2] = w[2] * rt + c[2]; a[4 * q + 3] = w[3] * rt + c[3]; }
            float tv[4]; int te[4];
#pragma unroll
            for (int k = 0; k < 4; ++k) { float best = a[0]; int bi = 0;
#pragma unroll
                for (int e = 1; e < 32; ++e) if (a[e] > best) { best = a[e]; bi = e; }
                tv[k] = best; te[k] = bi;
#pragma unroll
                for (int e = 0; e < 32; ++e) if (e == bi) a[e] = -INFINITY; }
            const float e1 = __expf(tv[1] - tv[0]), e2 = __expf(tv[2] - tv[0]), e3 = __expf(tv[3] - tv[0]); const float inv = 1.0f / (1.0f + e1 + e2 + e3);
            const float gk[4] = {inv, e1 * inv, e2 * inv, e3 * inv};
#pragma unroll
            for (int k = 0; k < 4; ++k) { const int loc = __hip_atomic_fetch_add(&CNT[te[k]], 1, __ATOMIC_RELAXED, __HIP_MEMORY_SCOPE_WORKGROUP); TOKR[(wave * 16 + lane) * 4 + k] = te[k] | (loc << 8); }
            *(f32x4*)(TOPG + (size_t)t * 4) = (f32x4){gk[0], gk[1], gk[2], gk[3]};
        }
        { f32x4 gs[4], shv[4];
#pragma unroll
          for (int i = 0; i < 4; ++i) { const int co = 4 * lane + 256 * i; gs[i] = *(const f32x4*)(in_n2 + co) * (*(const f32x4*)(md + 4 * 1024 + co) + 1.0f); shv[i] = *(const f32x4*)(md + 3 * 1024 + co); }
          for (int j = 0; j < 16; j += 4) {
            f32x4 xv[4][4];
#pragma unroll
            for (int jj = 0; jj < 4; ++jj)
#pragma unroll
                for (int i = 0; i < 4; ++i) xv[jj][i] = *(const f32x4*)(X1 + (size_t)(t0w + j + jj) * 1024 + 4 * lane + 256 * i);
#pragma unroll
            for (int jj = 0; jj < 4; ++jj) { const float r = RST[j + jj];
#pragma unroll
                for (int i = 0; i < 4; ++i) { const f32x4 hv = xv[jj][i] * r * gs[i] + shv[i];
                    *(unsigned*)(H8 + (size_t)(t0w + j + jj) * 1024 + 4 * lane + 256 * i) = pk4_fp8(hv[0], hv[1], hv[2], hv[3]); } }
          } }
        __syncthreads();
        if (tid < 32) BASE[tid] = (int)__hip_atomic_fetch_add(F.ctl + CW_CNT + (cset * 32 + tid) * 64, (unsigned)CNT[tid], __ATOMIC_RELAXED, __HIP_MEMORY_SCOPE_AGENT);
        __syncthreads();
        { const int pr = TOKR[tid], e = pr & 255, loc = pr >> 8; const size_t o = (size_t)(chunk * 128) * 4 + tid; TOPE[o] = e; RANK[o] = BASE[e] + loc; }
    }
}
constexpr int MOE_OFF = LDS_X, MOE_CNTL = LDS_X + 256, MOE_TEXP = LDS_X + 512;
DI int moe_offsets(const Frame& F, int l) {
    LAS int* OFF = (LAS int*)(F.lds + MOE_OFF); LAS int* CNTL = (LAS int*)(F.lds + MOE_CNTL); LAS int* TEXP = (LAS int*)(F.lds + MOE_TEXP);
    __syncthreads();
    if (F.tid < 32) CNTL[F.tid] = (int)__hip_atomic_load(F.ctl + CW_CNT + (l * 32 + F.tid) * 64, __ATOMIC_RELAXED, __HIP_MEMORY_SCOPE_AGENT);
    __syncthreads();
    if (F.tid == 0) { int off = 0; for (int e = 0; e < 32; ++e) { OFF[e] = off; off += (CNTL[e] + 255) & ~255; } OFF[32] = off; }
    __syncthreads();
    const int ntiles = OFF[32] >> 8;
    for (int tl = F.tid; tl < ntiles; tl += 512) { int e = 0; for (int q = 0; q < 32; ++q) if (OFF[q] <= tl * 256 && tl * 256 < OFF[q + 1]) e = q; TEXP[tl] = e; }
    __syncthreads();
    return ntiles;
}
DI void phase_scatter(const Frame& F, int l) {
    const int lane = F.lane, wave = F.wave;
    (void)moe_offsets(F, l);
    const LAS int* OFF = (const LAS int*)(F.lds + MOE_OFF); const LAS int* CNTL = (const LAS int*)(F.lds + MOE_CNTL);
    const int* TOPE = (const int*)(F.ws + WS_ROUTE + RT_TOPE); const float* TOPG = (const float*)(F.ws + WS_ROUTE + RT_TOPG); const int* RANK = (const int*)(F.ws + WS_ROUTE + RT_RANK);
    int* SLOTOF = (int*)(F.ws + WS_ROUTE + RT_SLOTOF); int* TOKOF = (int*)(F.ws + WS_ROUTE + RT_TOKOF); float* GATEOF = (float*)(F.ws + WS_ROUTE + RT_GATEOF);
    const unsigned char* H8 = WSP(unsigned char, WS_H8); unsigned char* XB = WSP(unsigned char, WS_XB);
    for (int chunk = F.bid; chunk < T_TOK / 128; chunk += F.G) {
        const int pair = wave * 64 + lane, tl = chunk * 128 + (pair >> 2); const size_t o = (size_t)tl * 4 + (pair & 3);
        const int e = TOPE[o], slot = OFF[e] + RANK[o];
        SLOTOF[o] = slot; TOKOF[slot] = tl; GATEOF[slot] = TOPG[o];
#pragma unroll 4
        for (int p = 0; p < 64; ++p) {
            const int sp = __builtin_amdgcn_readlane(slot, p), tp = chunk * 128 + ((wave * 64 + p) >> 2);
            *(u32x4*)(XB + (size_t)sp * 1024 + 16 * lane) = *(const u32x4*)(H8 + (size_t)tp * 1024 + 16 * lane);
        }
    }
    for (int e = F.bid; e < 32; e += F.G) {
        const int s0 = OFF[e] + CNTL[e], s1 = OFF[e + 1];
        for (int s = s0 + wave; s < s1; s += 8) { if (lane == 0) { TOKOF[s] = 0; GATEOF[s] = 0.f; }
            *(u32x4*)(XB + (size_t)s * 1024 + 16 * lane) = (u32x4){0u, 0u, 0u, 0u}; }
    }
}

#ifndef MK_SPLIT
#define MK_SPLIT 0
#endif
constexpr int NPHASE = 2 + 11 * DEPTH;
struct Args { const void* in[23]; float* out; unsigned char* ws; int ph_lo, ph_hi; };
static_assert(sizeof(Args) == 25 * 8 + 8, "Args has no padding");


#ifndef PH_ENABLE
#define PH_ENABLE 0xFFFF
#endif
#define IN(k) (lo <= (k) && (k) < hi)
#define EN(j) (((PH_ENABLE) >> (j)) & 1)
#ifndef STAG_G1
#define STAG_G1 0
#endif
#ifndef STAG_G3
#define STAG_G3 0
#endif
#ifndef STAG_G4
#define STAG_G4 0
#endif
#ifndef STAG_M2
#define STAG_M2 0
#endif
#ifndef M1_SP2
#define M1_SP2 1
#endif
#ifndef DUP_MASK
#define DUP_MASK 0
#endif
#define NREP(j) ((((DUP_MASK) >> (j)) & 1) ? 2 : 1)
#ifndef PROBE_BARX
#define PROBE_BARX 1
#endif
#define SEAM(k) do { if (!MK_SPLIT && (k) + 1 < hi) { XcdBarrier bar_; bar_.bar = F.ctl + CW_BAR; bar_.x = xb_xcc_id(); bar_.st = (volatile LAS unsigned*)((LAS unsigned char*)lds_raw + MISC_OFF) + 8; _Pragma("unroll") for (int bx_ = 0; bx_ < PROBE_BARX; ++bx_) xcd_barrier(bar_, F.tid); } } while (0)
DI void layer_phases(const int l, const int lo, const int hi, const int wave0) {
        const int pb = 2 + 11 * l;
        if (EN(2) && IN(pb + 0)) { const Frame F = make_frame(wave0);
            stagger(F, STAG_G1);
            { int kb8 = 1024; asm volatile("" : "+s"(kb8));
              SchedPlain S; S.o.init(T_TOK / 256, G1_F8_COLS / 256, F.G, F.bid); S.A = (const char*)WSP(unsigned char, WS_HG8); S.B = (const char*)(WSP(unsigned char, WS_WIN) + (size_t)l * NP * 2048); S.tstep = (size_t)256 * 1024;
              EpiStoreBf16N E{WSP(bf16_t, WS_P), NP, 0};
#ifdef PROBE_NOSTORE
              _Pragma("unroll") for (int rep = 0; rep < NREP(2); ++rep) { E.skip = (rep + 1 < NREP(2)); pg8::gemm_phase_f8<EpiStoreBf16N, SchedPlain, true, true, HG8_TILED != 0>(F.lds, F.tid, kb8, S, E); } }
#else
              _Pragma("unroll") for (int rep = 0; rep < NREP(2) + NREP(14) - 1; ++rep) pg8::gemm_phase_f8<EpiStoreBf16N, SchedPlain, true, true, HG8_TILED != 0>(F.lds, F.tid, kb8, S, E); }
#endif
            { int tid2 = F.tid; asm volatile("" : "+v"(tid2));
              SchedPlain S; S.o.init(T_TOK / 256, (NP - G1_F8_COLS) / 256, F.G, F.bid); S.A = (const char*)WSP(bf16_t, WS_H); S.B = (const char*)(WSP(bf16_t, WS_WIN) + (size_t)l * NP * 1024 + (size_t)G1_F8_COLS * 1024); S.tstep = (size_t)256 * 1024 * 2;
              EpiStoreBf16 E{WSP(bf16_t, WS_P), NP, G1_F8_COLS};
#ifdef PROBE_NOSTORE
              _Pragma("unroll") for (int rep = 0; rep < NREP(2); ++rep) { E.skip = (rep + 1 < NREP(2)); pg8::gemm_phase<EpiStoreBf16, SchedPlain>(F.lds, tid2, 1024, S, E); } }
#else
              _Pragma("unroll") for (int rep = 0; rep < NREP(2) + NREP(15) - 1; ++rep) pg8::gemm_phase<EpiStoreBf16, SchedPlain>(F.lds, tid2, 1024, S, E); }
#endif
            SEAM(pb + 0);
        }
        if (EN(3) && IN(pb + 1)) { const Frame F = make_frame(wave0); _Pragma("unroll") for (int rep = 0; rep < NREP(3); ++rep) phase_post(F, l); SEAM(pb + 1); }
        if (EN(4) && IN(pb + 2)) { const Frame F = make_frame(wave0);
            int k256 = 256; asm volatile("" : "+s"(k256));
            { SchedPlain S; S.o.init(T_TOK / 256, 3, F.G, F.bid); S.A = (const char*)WSP(bf16_t, WS_CQ); S.B = (const char*)(WSP(bf16_t, WS_WUQ) + (size_t)l * 768 * 256); S.tstep = (size_t)256 * 256 * 2;
              EpiStoreBf16 E{WSP(bf16_t, WS_QA), 768};
              pg8::gemm_phase<EpiStoreBf16, SchedPlain>(F.lds, F.tid, k256, S, E); }
            { int tid2 = F.tid; asm volatile("" : "+v"(tid2));
              SchedPlain S; S.o.init(T_TOK / 256, 4, F.G, F.bid); S.A = (const char*)WSP(bf16_t, WS_CKV); S.B = (const char*)(WSP(bf16_t, WS_WUKV) + (size_t)l * 1024 * 256); S.tstep = (size_t)256 * 256 * 2;
              EpiStoreBf16 E{WSP(bf16_t, WS_KV), 1024};
              pg8::gemm_phase<EpiStoreBf16, SchedPlain>(F.lds, tid2, k256, S, E); }
            SEAM(pb + 2);
        }
        if (EN(5) && IN(pb + 3)) { const Frame F = make_frame(wave0); phase_attention(F, NREP(5), NREP(13)); SEAM(pb + 3); }
        if (EN(6) && IN(pb + 4)) { const Frame F = make_frame(wave0);
            stagger(F, STAG_G3);
            SchedBranch S; S.o.init(T_TOK / 256, 4, F.G, F.bid); S.A = (const char*)WSP(bf16_t, WS_O3); S.B = (const char*)(WSP(bf16_t, WS_WB) + (size_t)l * 3 * 1024 * 512); S.tstep = (size_t)256 * 512 * 2; S.aslab = (size_t)T_TOK * 512 * 2;
            EpiBranchGate E{WSP(bf16_t, WS_GY), WSP(bf16_t, WS_P), KIN_b_gate + l * 3072};
            _Pragma("unroll") for (int rep = 0; rep < NREP(6); ++rep) pg8::gemm_phase<EpiBranchGate, SchedBranch>(F.lds, F.tid, 512, S, E);
            SEAM(pb + 4);
        }
        if (EN(7) && IN(pb + 5)) { const Frame F = make_frame(wave0);
            stagger(F, STAG_G4);
            SchedPlain S; S.o.init(T_TOK / 256, 4, F.G, F.bid); S.A = (const char*)WSP(bf16_t, WS_GY); S.B = (const char*)(WSP(bf16_t, WS_WOUT) + (size_t)l * 1024 * 1024); S.tstep = (size_t)256 * 1024 * 2;
            EpiResidual E{l == 0 ? KIN_x : WSP(float, WS_X1), WSP(float, WS_X1), WSP(float, WS_MOD) + (size_t)l * 16 * 6144 + 2 * 1024};
            _Pragma("unroll") for (int rep = 0; rep < NREP(7); ++rep) if (rep == 0 || l == 0) pg8::gemm_phase<EpiResidual, SchedPlain>(F.lds, F.tid, 1024, S, E);
            SEAM(pb + 5);
        }
        if (EN(8) && IN(pb + 6)) { const Frame F = make_frame(wave0); phase_router(F, l, l); if (NREP(8) == 2) phase_router(F, l, l + 2); SEAM(pb + 6); }
        if (EN(9) && IN(pb + 7)) { const Frame F = make_frame(wave0); _Pragma("unroll") for (int rep = 0; rep < NREP(9); ++rep) phase_scatter(F, l); SEAM(pb + 7); }
        if (EN(10) && IN(pb + 8)) { const Frame F = make_frame(wave0);
            const int ntiles = moe_offsets(F, l); int kb8 = 1024; asm volatile("" : "+s"(kb8));
            SchedMoe S; S.o.init(ntiles, 8, F.G, F.bid); S.A = (const char*)WSP(unsigned char, WS_XB); S.B = (const char*)(WSP(unsigned char, WS_W1) + (size_t)l * 32 * 2048 * 1024); S.eslab = 2048u * 1024u;
            S.texp = (const LAS int*)(F.lds + MOE_TEXP);
#if M2_F8
            EpiSwiglu8 E{WSP(unsigned char, WS_ACT), KIN_b1 + (size_t)l * 32 * 2048, (const LAS int*)(F.lds + MOE_TEXP)};
#else
            EpiSwiglu E{WSP(bf16_t, WS_ACT), KIN_b1 + (size_t)l * 32 * 2048, (const LAS int*)(F.lds + MOE_TEXP)};
#endif
            _Pragma("unroll") for (int rep = 0; rep < NREP(10); ++rep)
#if M2_F8
#ifdef PROBE_M1
#ifdef PROBE_FIXAB
            { E.skip = (rep + 1 < NREP(10)) ? PROBE_M1 : 0; S.fix = (rep + 1 < NREP(10)) ? PROBE_FIXAB : 0;
#ifdef PROBE_KB
              const int kbp_ = (rep + 1 < NREP(10)) ? (kb8 >> 1) : kb8;
              pg8::gemm_phase_f8<EpiSwiglu8, SchedMoe, true, M1_SP2 != 0>(F.lds, F.tid, kbp_, S, E); }
#else
              pg8::gemm_phase_f8<EpiSwiglu8, SchedMoe, true, M1_SP2 != 0>(F.lds, F.tid, kb8, S, E); }
#endif
#else
            { E.skip = (rep + 1 < NREP(10)) ? PROBE_M1 : 0; pg8::gemm_phase_f8<EpiSwiglu8, SchedMoe, true, M1_SP2 != 0>(F.lds, F.tid, kb8, S, E); }
#endif
#else
            pg8::gemm_phase_f8<EpiSwiglu8, SchedMoe, true, M1_SP2 != 0>(F.lds, F.tid, kb8, S, E);
#endif
#else
            pg8::gemm_phase_f8<EpiSwiglu, SchedMoe>(F.lds, F.tid, kb8, S, E);
#endif

            SEAM(pb + 8);
        }
        if (EN(11) && IN(pb + 9)) { const Frame F = make_frame(wave0);
            const int ntiles = moe_offsets(F, l); int kb8 = 1024; asm volatile("" : "+s"(kb8));
            stagger(F, STAG_M2);
#if M2_F8
            SchedMoe S; S.o.init(ntiles, 4, F.G, F.bid); S.A = (const char*)WSP(unsigned char, WS_ACT); S.B = (const char*)(WSP(unsigned char, WS_W2) + (size_t)l * 32 * 1024 * 1024); S.eslab = 1024u * 1024u;
            S.texp = (const LAS int*)(F.lds + MOE_TEXP);
            EpiMoeOut E{WSP(bf16_t, WS_Y), KIN_b2 + (size_t)l * 32 * 1024, (const float*)(F.ws + WS_ROUTE + RT_GATEOF), (const LAS int*)(F.lds + MOE_TEXP)};
            _Pragma("unroll") for (int rep = 0; rep < NREP(11); ++rep) pg8::gemm_phase_f8<EpiMoeOut, SchedMoe>(F.lds, F.tid, kb8, S, E);
#else
            SchedMoeB S; S.o.init(ntiles, 4, F.G, F.bid); S.A = (const char*)WSP(bf16_t, WS_ACT); S.B = (const char*)(WSP(bf16_t, WS_W2) + (size_t)l * 32 * 1024 * 1024); S.eslab = 1024u * 1024u * 2u;
            S.texp = (const LAS int*)(F.lds + MOE_TEXP);
            EpiMoeOut E{WSP(bf16_t, WS_Y), KIN_b2 + (size_t)l * 32 * 1024, (const float*)(F.ws + WS_ROUTE + RT_GATEOF), (const LAS int*)(F.lds + MOE_TEXP)};
            _Pragma("unroll") for (int rep = 0; rep < NREP(11); ++rep) pg8::gemm_phase<EpiMoeOut, SchedMoeB>(F.lds, F.tid, kb8, S, E);
#endif
            SEAM(pb + 9);
        }
        if (EN(12) && IN(pb + 10)) { const Frame F = make_frame(wave0);
            const bool last = (l == DEPTH - 1);
            _Pragma("unroll") for (int rep = 0; rep < NREP(12); ++rep) if (rep == 0 || last) phase_norm(F, WSP(float, WS_X1), WSP(float, WS_X1), true, !last, last, l + 1 < DEPTH ? l + 1 : 0, l);
            SEAM(pb + 10);
        }
}
__global__ void __launch_bounds__(512, 2) fwd_kernel(Args args) {
    const int wave0 = __builtin_amdgcn_readfirstlane(threadIdx.x >> 6);
    {
        volatile LAS unsigned* MISC = (volatile LAS unsigned*)((LAS unsigned char*)lds_raw + MISC_OFF);
        if (threadIdx.x < 32) MISC[threadIdx.x] = 0u;
        __syncthreads();
        if (!MK_SPLIT) { const Frame F = make_frame(wave0); (void)xcd_barrier_post(F.ctl + CW_BAR, MISC + 8, F.tid); }
    }
    const int lo = args.ph_lo, hi = args.ph_hi;
#ifdef PROBE_CLK
    const unsigned long long pc0_ = __builtin_amdgcn_s_memtime(), pr0_ = __builtin_amdgcn_s_memrealtime();
#endif
    if (EN(0) && IN(0)) { const Frame F = make_frame(wave0); _Pragma("unroll") for (int rep = 0; rep < NREP(0); ++rep) phase_prologue(F); SEAM(0); }
    if (EN(1) && IN(1)) { const Frame F = make_frame(wave0); _Pragma("unroll") for (int rep = 0; rep < NREP(1); ++rep) phase_norm(F, KIN_x, nullptr, false, false, false, 0, 0); SEAM(1); }
    layer_phases(0, lo, hi, wave0);
    layer_phases(1, lo, hi, wave0);
    static_assert(DEPTH == 2, "two layers");
#ifdef PROBE_CLK
    {
        const unsigned long long pc1_ = __builtin_amdgcn_s_memtime(), pr1_ = __builtin_amdgcn_s_memrealtime();
        const unsigned cyc_per_us = (unsigned)((pc1_ - pc0_) * 100ull / (pr1_ - pr0_));
        const unsigned ticks = cyc_per_us * 10u;
        const unsigned long long t0 = __builtin_amdgcn_s_memrealtime();
        while ((unsigned)(__builtin_amdgcn_s_memrealtime() - t0) < ticks) __builtin_amdgcn_s_sleep(8);
    }
#endif
#undef IN
#undef SEAM
}

extern "C" void kernel_launch(void* const* d_in, const int* in_sizes, int n_in, void* d_out, int out_size, void* d_ws, size_t ws_size, hipStream_t stream) {
    static int grid = 0;
    if (grid == 0) {
        if (n_in != 23 || out_size != T_TOK * D_MODEL || ws_size < WS_END) { fprintf(stderr, "kernel_launch: unexpected problem (n_in %d, out %d, ws %zu)\n", n_in, out_size, ws_size); grid = -1; return; }
        int dev = 0, cus = 0;
        if (hipGetDevice(&dev) != hipSuccess || hipDeviceGetAttribute(&cus, hipDeviceAttributeMultiprocessorCount, dev) != hipSuccess) { grid = -1; return; }
        if (hipFuncSetAttribute((const void*)fwd_kernel, hipFuncAttributeMaxDynamicSharedMemorySize, LDS_BYTES) != hipSuccess) { fprintf(stderr, "kernel_launch: hipFuncSetAttribute failed\n"); grid = -1; return; }
        int per_cu = 0;
        if (hipOccupancyMaxActiveBlocksPerMultiprocessor(&per_cu, (const void*)fwd_kernel, 512, LDS_BYTES) != hipSuccess || per_cu < 1) fprintf(stderr, "kernel_launch: occupancy query says %d\n", per_cu);
        (void)hipGetLastError();
        grid = cus > 256 ? 256 : cus;
    }
    if (grid < 0) return;
    (void)in_sizes;
    if (hipMemsetAsync((char*)d_ws + WS_CTL, 0, CTL_ZERO_BYTES, stream) != hipSuccess) return;
    Args a{};
    for (int i = 0; i < 23; ++i) a.in[i] = d_in[i];
    a.out = (float*)d_out; a.ws = (unsigned char*)d_ws;
#if MK_SPLIT
    for (int p = 0; p < NPHASE; ++p) { a.ph_lo = p; a.ph_hi = p + 1; hipLaunchKernelGGL(fwd_kernel, dim3(grid), dim3(512), LDS_BYTES, stream, a); }
#else
    a.ph_lo = 0; a.ph_hi = NPHASE;
    hipLaunchKernelGGL(fwd_kernel, dim3(grid), dim3(512), LDS_BYTES, stream, a);
#endif
}
```

```cpp
#include <hip/hip_runtime.h>
#include <cstdio>
#include <cstdint>

#ifndef M2_F8
#define M2_F8 1
#endif
#define LAS __attribute__((address_space(3)))
#define GAS __attribute__((address_space(1)))
typedef unsigned short bf16_t;
typedef short bf16x8 __attribute__((ext_vector_type(8)));
typedef short s16x4 __attribute__((ext_vector_type(4)));
typedef float f32x2 __attribute__((ext_vector_type(2)));
typedef float f32x4 __attribute__((ext_vector_type(4)));
typedef float f32x16 __attribute__((ext_vector_type(16)));
typedef unsigned u32x2 __attribute__((ext_vector_type(2)));
typedef unsigned u32x4 __attribute__((ext_vector_type(4)));
#define DI __device__ __forceinline__

constexpr int D_MODEL = 1024, BATCH = 16, SEQ = 2048, T_TOK = BATCH * SEQ, DEPTH = 2;
constexpr float NORM_EPS = 1e-6f;
constexpr int IN_COLS = 6248, NP = 6400;
constexpr int N_EXP = 32, TOP_K = 4, D_EXP = 1024;
constexpr int NSLOT_MAX = T_TOK * TOP_K + N_EXP * 256;
constexpr int PC_GATE = 0, PC_CONV = 3072, PC_DQ = 4608, PC_IQ = 5120, PC_QLAT = 5632, PC_KVLAT = 5888, PC_DKV = 6048, PC_IK = 6176, PC_IW = 6240;
constexpr int OC_QLAT = 0, OC_KVLAT = 256, OC_CONV = 416, OC_DQ = 1952, OC_DKV = 2464, OC_IQ = 2592, OC_IK = 3104, OC_IW = 3168, OC_GATE = 3176;

DI unsigned pk2(float lo, float hi) { typedef __bf16 bf16x2_t __attribute__((ext_vector_type(2))); f32x2 v = {lo, hi}; bf16x2_t b = __builtin_convertvector(v, bf16x2_t); return __builtin_bit_cast(unsigned, b); }
DI float bf_lo(unsigned w) { return __uint_as_float(w << 16); }
DI float bf_hi(unsigned w) { return __uint_as_float(w & 0xffff0000u); }
DI float bf2f(bf16_t h) { return __uint_as_float((unsigned)h << 16); }
DI float wave_sum(float v) {
#pragma unroll
    for (int o = 1; o < 64; o <<= 1) v += __shfl_xor(v, o);
    return v;
}
DI float fast_sigmoid(float x) { return __builtin_amdgcn_rcpf(1.0f + __builtin_amdgcn_exp2f(-1.4426950408889634f * x)); }
DI unsigned pk4_fp8(float a, float b, float c, float d) { int w = __builtin_amdgcn_cvt_pk_fp8_f32(a, b, 0, false); w = __builtin_amdgcn_cvt_pk_fp8_f32(c, d, w, true); return (unsigned)w; }
#define LDS_WAIT() asm volatile("s_waitcnt lgkmcnt(0)" ::: "memory")
#define VM_WAIT() asm volatile("s_waitcnt vmcnt(0)" ::: "memory")

#ifndef PG8_F8_SPLITK
#define PG8_F8_SPLITK 0
#endif
#ifndef PG8_DMA_IN_MMA
#define PG8_DMA_IN_MMA 0
#endif
namespace pg8 {
DI void glds16_s(unsigned voff, const char* sbase, unsigned lds_dst) { unsigned keep; asm volatile("s_nop 4\n\ts_mov_b32 %0, m0\n\ts_mov_b32 m0, %3\n\ts_nop 0\n\tglobal_load_lds_dwordx4 %1, %2\n\ts_mov_b32 m0, %0" : "=&s"(keep) : "v"(voff), "s"(sbase), "s"(lds_dst) : "memory"); }
DI const char* uni_ptr(const char* p) { const unsigned long long v = (unsigned long long)p; const unsigned lo = __builtin_amdgcn_readfirstlane((unsigned)v), hi = __builtin_amdgcn_readfirstlane((unsigned)(v >> 32)); return (const char*)(GAS const char*)(((unsigned long long)hi << 32) | lo); }
constexpr int BM = 256, BK = 64, HALF = 128, HTB = HALF * BK * 2, STAGE_BYTES = 8 * HTB, NXCD = 8, WGM = 8;
__host__ __device__ __forceinline__ int lds_byte(int r, int c) { const int st = (r >> 4) * 2 + (c >> 5), rr = r & 15, cc = c & 31, ob = rr * 64 + cc * 2; return st * 1024 + (ob ^ (((ob >> 9) & 1) << 5)); }
__host__ __device__ __forceinline__ void stage_rc(int b, int& R, int& C) { const int st = b / 1024, sb = b % 1024, swz = sb ^ (((sb >> 9) & 1) << 5); R = (st >> 1) * 16 + swz / 64; C = (st & 1) * 32 + (swz % 64) / 2; }
__host__ __device__ __forceinline__ int perm32(int rho) { const int n = rho >> 4, i = rho & 15; return 8 * (i >> 2) + 4 * n + (i & 3); }
struct Unit { int pm, pn; };
struct StaticOrder {
    int nM, nN, nwg, G, c;
    DI void init(int nM_, int nN_, int G_, int c_) { nM = nM_; nN = nN_; nwg = nM * nN; G = G_; c = c_; }
    DI bool next(int i, Unit& u) const {
        const long L = (long)i * G + c; if (L >= nwg) return false;
        int wgid = (int)L; { const int q = nwg / NXCD, r = nwg % NXCD, xcd = wgid % NXCD, off = wgid / NXCD; wgid = (xcd < r ? xcd * (q + 1) : r * (q + 1) + (xcd - r) * q) + off; }
        const int nig = WGM * nN, gid = wgid / nig, fm = gid * WGM, gsz = (nM - fm) < WGM ? (nM - fm) : WGM;
        u.pm = fm + ((wgid % nig) % gsz); u.pn = (wgid % nig) / gsz; return true;
    }
};

template <class Epi, class Sched, bool ALIGN_EPI = true, bool SP2 = true>
DI void gemm_phase(LAS unsigned char* lds, const int tid, const int K, const Sched& S, const Epi& E) {
    const int wid = __builtin_amdgcn_readfirstlane(tid >> 6), lane = tid & 63, wr = wid >> 2, wc = wid & 3, fr = lane & 15, fq = lane >> 4;
    const int nt = K / BK;
    unsigned voffA[2], voffB[2];
#pragma unroll
    for (int i = 0; i < 2; ++i) { int R, C; stage_rc(tid * 16 + i * 8192, R, C); const int Rb = Epi::PERM ? ((R & ~31) + perm32(R & 31)) : R;
        voffA[i] = (unsigned)(R * K + C) * 2u; voffB[i] = (unsigned)(Rb * K + C) * 2u; }
    const size_t kstep = (size_t)(BK * 2);
    const size_t hstep = (size_t)HALF * K * 2;
    const unsigned ldsw = (unsigned)wid * 1024u; const unsigned ldsb = (unsigned)(unsigned long long)(lds);
    const int aoff = lds_byte(wr * 64 + fr, fq * 8), boff = lds_byte(wc * 32 + fr, fq * 8);
#define PG8_SA(b, h) (((b) * 2 + (h)) * HTB)
#define PG8_SB(b, h) ((4 + (b) * 2 + (h)) * HTB)
#define PG8_STAGE(bufoff, gbase, voff) do { _Pragma("unroll") for (int _i = 0; _i < 2; ++_i) \
        glds16_s((voff)[_i], (const char*)(gbase), ldsb + (unsigned)(bufoff) + ldsw + (unsigned)(_i * 8192)); } while (0)
#define PG8_LDA(dst, b, h) do { int a_ = aoff; asm volatile("" : "+v"(a_)); _Pragma("unroll") for (int m = 0; m < 4; ++m) _Pragma("unroll") for (int k = 0; k < 2; ++k) dst[m][k] = *(const LAS bf16x8*)(lds + PG8_SA(b, h) + a_ + m * 2048 + k * 1024); } while (0)
#define PG8_LDB(dst, b, h) do { int b_ = boff; asm volatile("" : "+v"(b_)); _Pragma("unroll") for (int n = 0; n < 2; ++n) _Pragma("unroll") for (int k = 0; k < 2; ++k) dst[n][k] = *(const LAS bf16x8*)(lds + PG8_SB(b, h) + b_ + n * 2048 + k * 1024); } while (0)
#define PG8_MMA(ai, bj, At, Bt) do { __builtin_amdgcn_s_setprio(1); _Pragma("unroll") for (int m = 0; m < 4; ++m) _Pragma("unroll") for (int n = 0; n < 2; ++n) _Pragma("unroll") for (int k = 0; k < 2; ++k) \
        acc[ai][bj][m][n] = __builtin_amdgcn_mfma_f32_16x16x32_bf16(Bt[n][k], At[m][k], acc[ai][bj][m][n], 0, 0, 0); __builtin_amdgcn_s_setprio(0); } while (0)
#define PG8_WAIT_V(n) asm volatile("s_waitcnt vmcnt(" #n ")" ::: "memory")
#define PG8_WAIT_L(n) asm volatile("s_waitcnt lgkmcnt(" #n ")" ::: "memory")
#define PG8_BAR __builtin_amdgcn_s_barrier()
#define PG8_SCHED __builtin_amdgcn_sched_barrier(0)
    Unit cur, nxt; int ui = 0;
    if (!S.next(0, cur)) return;
    float zf_ = 0.f; asm volatile("" : "+v"(zf_));
    f32x4 acc[2][2][4][2];
#pragma unroll
    for (int a = 0; a < 2; ++a)
#pragma unroll
        for (int b = 0; b < 2; ++b)
#pragma unroll
            for (int m = 0; m < 4; ++m)
#pragma unroll
                for (int n = 0; n < 2; ++n) acc[a][b][m][n] = (f32x4){zf_, zf_, zf_, zf_};
    bf16x8 At[4][2], B0[2][2], B1[2][2];
    const char* cA = uni_ptr(S.abase(cur)); const char* cB = uni_ptr(S.bbase(cur));
    if constexpr (SP2) {
        PG8_STAGE(PG8_SB(0, 0), cB, voffB); PG8_STAGE(PG8_SB(0, 1), cB + hstep, voffB); PG8_STAGE(PG8_SA(0, 0), cA, voffA); PG8_STAGE(PG8_SA(0, 1), cA + hstep, voffA);
        if (wr == 1) PG8_BAR;
        PG8_WAIT_V(2); PG8_BAR;
        PG8_STAGE(PG8_SB(1, 0), cB + kstep, voffB); PG8_STAGE(PG8_SA(1, 0), cA + kstep, voffA); PG8_STAGE(PG8_SB(1, 1), cB + hstep + kstep, voffB);
        PG8_WAIT_V(6); PG8_BAR;
    } else {
        PG8_STAGE(PG8_SB(0, 0), cB, voffB); PG8_STAGE(PG8_SA(0, 0), cA, voffA); PG8_STAGE(PG8_SB(0, 1), cB + hstep, voffB); PG8_STAGE(PG8_SA(0, 1), cA + hstep, voffA);
        if (wr == 1) PG8_BAR;
        PG8_WAIT_V(4); PG8_BAR;
        PG8_STAGE(PG8_SB(1, 0), cB + kstep, voffB); PG8_STAGE(PG8_SA(1, 0), cA + kstep, voffA); PG8_STAGE(PG8_SB(1, 1), cB + hstep + kstep, voffB);
        PG8_WAIT_V(6); PG8_BAR;
    }
    for (;;) {
        const bool has_next = S.next(ui + 1, nxt);
        const char* nA = has_next ? uni_ptr(S.abase(nxt)) : cA; const char* nB = has_next ? uni_ptr(S.bbase(nxt)) : cB;
        for (int t = 0; t < nt; t += 2) {
            const bool last = (t == nt - 2);
            const char* a1 = cA + (size_t)(t + 1) * kstep;
            const char* a2 = last ? nA : cA + (size_t)(t + 2) * kstep; const char* b2 = last ? nB : cB + (size_t)(t + 2) * kstep;
            const char* a3 = a2 + kstep; const char* b3 = b2 + kstep;
            if constexpr (SP2) {
            PG8_LDB(B0, 0, 0); PG8_LDB(B1, 0, 1); PG8_SCHED; PG8_LDA(At, 0, 0); PG8_STAGE(PG8_SA(1, 1), a1 + hstep, voffA);
            PG8_WAIT_V(8); PG8_WAIT_L(0); PG8_BAR; PG8_MMA(0, 0, At, B0); PG8_MMA(0, 1, At, B1); PG8_BAR; PG8_SCHED;
            PG8_LDA(At, 0, 1); PG8_STAGE(PG8_SB(0, 0), b2, voffB); PG8_STAGE(PG8_SB(0, 1), b2 + hstep, voffB); PG8_STAGE(PG8_SA(0, 0), a2, voffA);
            PG8_WAIT_V(8); PG8_WAIT_L(0); PG8_BAR; PG8_MMA(1, 0, At, B0); PG8_MMA(1, 1, At, B1); PG8_BAR; PG8_SCHED;
            PG8_LDB(B0, 1, 0); PG8_LDB(B1, 1, 1); PG8_SCHED; PG8_LDA(At, 1, 0); PG8_STAGE(PG8_SA(0, 1), a2 + hstep, voffA);
            PG8_WAIT_V(8); PG8_WAIT_L(0); PG8_BAR; PG8_MMA(0, 0, At, B0); PG8_MMA(0, 1, At, B1); PG8_BAR; PG8_SCHED;
            PG8_LDA(At, 1, 1); PG8_STAGE(PG8_SB(1, 0), b3, voffB); PG8_STAGE(PG8_SB(1, 1), b3 + hstep, voffB); PG8_STAGE(PG8_SA(1, 0), a3, voffA);
            PG8_WAIT_V(8); PG8_WAIT_L(0); PG8_BAR; PG8_MMA(1, 0, At, B0); PG8_MMA(1, 1, At, B1); PG8_BAR; PG8_SCHED;
            } else {
            PG8_LDB(B0, 0, 0); PG8_SCHED; PG8_LDA(At, 0, 0); PG8_STAGE(PG8_SA(1, 1), a1 + hstep, voffA);
            PG8_WAIT_L(8); PG8_BAR; PG8_WAIT_L(0); PG8_MMA(0, 0, At, B0); PG8_BAR; PG8_SCHED;
            PG8_LDB(B1, 0, 1); PG8_STAGE(PG8_SB(0, 0), b2, voffB);
            PG8_BAR; PG8_WAIT_L(0); PG8_MMA(0, 1, At, B1); PG8_BAR;
            PG8_LDA(At, 0, 1); PG8_STAGE(PG8_SA(0, 0), a2, voffA);
            PG8_BAR; PG8_WAIT_L(0); PG8_MMA(1, 0, At, B0); PG8_BAR; PG8_SCHED;
            PG8_STAGE(PG8_SB(0, 1), b2 + hstep, voffB);
            PG8_WAIT_V(6); PG8_BAR; PG8_MMA(1, 1, At, B1); PG8_BAR;
            PG8_LDB(B0, 1, 0); PG8_SCHED; PG8_LDA(At, 1, 0); PG8_STAGE(PG8_SA(0, 1), a2 + hstep, voffA);
            PG8_WAIT_L(8); PG8_BAR; PG8_WAIT_L(0); PG8_MMA(0, 0, At, B0); PG8_BAR; PG8_SCHED;
            PG8_LDB(B1, 1, 1); PG8_STAGE(PG8_SB(1, 0), b3, voffB);
            PG8_BAR; PG8_WAIT_L(0); PG8_MMA(0, 1, At, B1); PG8_BAR;
            PG8_LDA(At, 1, 1); PG8_STAGE(PG8_SA(1, 0), a3, voffA);
            PG8_BAR; PG8_WAIT_L(0); PG8_MMA(1, 0, At, B0); PG8_BAR; PG8_SCHED;
            PG8_STAGE(PG8_SB(1, 1), b3 + hstep, voffB);
            PG8_WAIT_V(6); PG8_BAR; PG8_MMA(1, 1, At, B1); PG8_BAR;
            }
        }
        if constexpr (ALIGN_EPI) { if (wr == 0) PG8_BAR; }
        E(acc, cur, wr, wc, fr, fq);
        if (!has_next) break;
#pragma unroll
        for (int a = 0; a < 2; ++a)
#pragma unroll
            for (int b = 0; b < 2; ++b)
#pragma unroll
                for (int m = 0; m < 4; ++m)
#pragma unroll
                    for (int n = 0; n < 2; ++n) acc[a][b][m][n] = (f32x4){zf_, zf_, zf_, zf_};
        cur = nxt; cA = nA; cB = nB; ++ui;
        if constexpr (ALIGN_EPI) { if (wr == 1) PG8_BAR; }
    }
    PG8_WAIT_V(0);
    if constexpr (!ALIGN_EPI) { if (wr == 0) PG8_BAR; }
    PG8_BAR;
#undef PG8_SA
#undef PG8_SB
#undef PG8_STAGE
#undef PG8_LDA
#undef PG8_LDB
#undef PG8_MMA
#undef PG8_WAIT_V
#undef PG8_WAIT_L
#undef PG8_BAR
#undef PG8_SCHED
}
typedef int v8i __attribute__((ext_vector_type(8)));
template <class Epi, class Sched, bool ALIGN_EPI = true, bool SP2 = true, bool TILEDA = false>
DI void gemm_phase_f8(LAS unsigned char* lds, const int tid, const int KB, const Sched& S, const Epi& E) {
    const int wid = __builtin_amdgcn_readfirstlane(tid >> 6), lane = tid & 63, wr = wid >> 2, wc = wid & 3, fr = lane & 15, fq = lane >> 4;
    const int nt = KB / 128;
    unsigned voffA[2], voffB[2];
#pragma unroll
    for (int i = 0; i < 2; ++i) { int R, C; stage_rc(tid * 16 + i * 8192, R, C); const int Rb = Epi::PERM ? ((R & ~31) + perm32(R & 31)) : R;
        voffA[i] = TILEDA ? (unsigned)(R * 128 + 2 * C) : (unsigned)(R * KB + 2 * C); voffB[i] = (unsigned)(Rb * KB + 2 * C); }
    const size_t kstep = (size_t)(BK * 2);
    const size_t hstep = (size_t)HALF * KB;
    const size_t kstepA = TILEDA ? (size_t)(256 * 128) : kstep, hstepA = TILEDA ? (size_t)(HALF * 128) : hstep;
    const unsigned ldsw = (unsigned)wid * 1024u; const unsigned ldsb = (unsigned)(unsigned long long)(lds);
#if PG8_F8_SPLITK
    const int aoff = lds_byte(wr * 64 + fr, fq * 8), boff = lds_byte(wc * 32 + fr, fq * 8);
#else
    const int aoff = lds_byte(wr * 64 + fr, fq * 16), boff = lds_byte(wc * 32 + fr, fq * 16);
#endif
#define PG8_SA(b, h) (((b) * 2 + (h)) * HTB)
#define PG8_SB(b, h) ((4 + (b) * 2 + (h)) * HTB)
#define PG8_STAGE(bufoff, gbase, voff) do { _Pragma("unroll") for (int _i = 0; _i < 2; ++_i) \
        glds16_s((voff)[_i], (const char*)(gbase), ldsb + (unsigned)(bufoff) + ldsw + (unsigned)(_i * 8192)); } while (0)
#if PG8_F8_SPLITK
#define PG8_LD32(p_) ([&]() { const u32x4 lo_ = *(const LAS u32x4*)(p_), hi_ = *(const LAS u32x4*)((p_) + 1024); return (v8i){(int)lo_.x, (int)lo_.y, (int)lo_.z, (int)lo_.w, (int)hi_.x, (int)hi_.y, (int)hi_.z, (int)hi_.w}; }())
#else
#define PG8_LD32(p_) (*(const LAS v8i*)(p_))
#endif
#define PG8_LDA(dst, b, h) do { int a_ = aoff; asm volatile("" : "+v"(a_)); _Pragma("unroll") for (int m = 0; m < 4; ++m) dst[m] = PG8_LD32(lds + PG8_SA(b, h) + a_ + m * 2048); } while (0)
#define PG8_LDB(dst, b, h) do { int b_ = boff; asm volatile("" : "+v"(b_)); _Pragma("unroll") for (int n = 0; n < 2; ++n) dst[n] = PG8_LD32(lds + PG8_SB(b, h) + b_ + n * 2048); } while (0)
#define PG8_MMA(ai, bj, At, Bt) do { __builtin_amdgcn_s_setprio(1); _Pragma("unroll") for (int m = 0; m < 4; ++m) _Pragma("unroll") for (int n = 0; n < 2; ++n) \
        acc[ai][bj][m][n] = __builtin_amdgcn_mfma_scale_f32_16x16x128_f8f6f4(Bt[n], At[m], acc[ai][bj][m][n], 0, 0, 0, sc8, 0, sc8); __builtin_amdgcn_s_setprio(0); } while (0)
#define PG8_PIECE(bufoff, gbase, voff, i) do { glds16_s((voff)[i], (const char*)(gbase), ldsb + (unsigned)(bufoff) + ldsw + (unsigned)((i) * 8192)); __builtin_amdgcn_sched_barrier(0); } while (0)
#define PG8_MMA_I(ai, bj, At, Bt, P1, P2, P3) do { __builtin_amdgcn_s_setprio(1); _Pragma("unroll") for (int m = 0; m < 4; ++m) _Pragma("unroll") for (int n = 0; n < 2; ++n) { \
        acc[ai][bj][m][n] = __builtin_amdgcn_mfma_scale_f32_16x16x128_f8f6f4(Bt[n], At[m], acc[ai][bj][m][n], 0, 0, 0, sc8, 0, sc8); \
        if (2 * m + n == 1) { __builtin_amdgcn_sched_barrier(0); P1; } if (2 * m + n == 3) { __builtin_amdgcn_sched_barrier(0); P2; } if (2 * m + n == 5) { __builtin_amdgcn_sched_barrier(0); P3; } } __builtin_amdgcn_s_setprio(0); } while (0)
#define PG8_WAIT_V(n) asm volatile("s_waitcnt vmcnt(" #n ")" ::: "memory")
#define PG8_WAIT_L(n) asm volatile("s_waitcnt lgkmcnt(" #n ")" ::: "memory")
#define PG8_BAR __builtin_amdgcn_s_barrier()
#define PG8_SCHED __builtin_amdgcn_sched_barrier(0)
    Unit cur, nxt; int ui = 0;
    if (!S.next(0, cur)) return;
    int sc8 = 0x7c7c7c7c; asm volatile("" : "+v"(sc8));
    float zf_ = 0.f; asm volatile("" : "+v"(zf_));
    f32x4 acc[2][2][4][2];
#pragma unroll
    for (int a = 0; a < 2; ++a)
#pragma unroll
        for (int b = 0; b < 2; ++b)
#pragma unroll
            for (int m = 0; m < 4; ++m)
#pragma unroll
                for (int n = 0; n < 2; ++n) acc[a][b][m][n] = (f32x4){zf_, zf_, zf_, zf_};
    v8i At[4], B0[2], B1[2];
    const char* cA = uni_ptr(S.abase(cur)); const char* cB = uni_ptr(S.bbase(cur));
    if constexpr (SP2) {
        PG8_STAGE(PG8_SB(0, 0), cB, voffB); PG8_STAGE(PG8_SB(0, 1), cB + hstep, voffB); PG8_STAGE(PG8_SA(0, 0), cA, voffA); PG8_STAGE(PG8_SA(0, 1), cA + hstepA, voffA);
        if (wr == 1) PG8_BAR;
        PG8_WAIT_V(2); PG8_BAR;
        PG8_STAGE(PG8_SB(1, 0), cB + kstep, voffB); PG8_STAGE(PG8_SA(1, 0), cA + kstepA, voffA); PG8_STAGE(PG8_SB(1, 1), cB + hstep + kstep, voffB);
        PG8_WAIT_V(6); PG8_BAR;
    } else {
        PG8_STAGE(PG8_SB(0, 0), cB, voffB); PG8_STAGE(PG8_SA(0, 0), cA, voffA); PG8_STAGE(PG8_SB(0, 1), cB + hstep, voffB); PG8_STAGE(PG8_SA(0, 1), cA + hstepA, voffA);
        if (wr == 1) PG8_BAR;
        PG8_WAIT_V(4); PG8_BAR;
        PG8_STAGE(PG8_SB(1, 0), cB + kstep, voffB); PG8_STAGE(PG8_SA(1, 0), cA + kstepA, voffA); PG8_STAGE(PG8_SB(1, 1), cB + hstep + kstep, voffB);
        PG8_WAIT_V(6); PG8_BAR;
    }
    for (;;) {
        const bool has_next = S.next(ui + 1, nxt);
        const char* nA = has_next ? uni_ptr(S.abase(nxt)) : cA; const char* nB = has_next ? uni_ptr(S.bbase(nxt)) : cB;
        for (int t = 0; t < nt; t += 2) {
            const bool last = (t == nt - 2);
            const char* a1 = cA + (size_t)(t + 1) * kstepA;
            const char* a2 = last ? nA : cA + (size_t)(t + 2) * kstepA; const char* b2 = last ? nB : cB + (size_t)(t + 2) * kstep;
            const char* a3 = a2 + kstepA; const char* b3 = b2 + kstep;
            if constexpr (SP2) {
#if PG8_DMA_IN_MMA
            PG8_LDB(B0, 0, 0); PG8_LDB(B1, 0, 1); PG8_SCHED; PG8_LDA(At, 0, 0);
            PG8_WAIT_V(6); PG8_WAIT_L(0); PG8_BAR; PG8_MMA_I(0, 0, At, B0, , PG8_PIECE(PG8_SA(1, 1), a1 + hstepA, voffA, 0), ); PG8_MMA_I(0, 1, At, B1, , PG8_PIECE(PG8_SA(1, 1), a1 + hstepA, voffA, 1), ); PG8_BAR; PG8_SCHED;
            PG8_LDA(At, 0, 1);
            PG8_WAIT_V(2); PG8_WAIT_L(0); PG8_BAR; PG8_MMA_I(1, 0, At, B0, PG8_PIECE(PG8_SB(0, 0), b2, voffB, 0), PG8_PIECE(PG8_SB(0, 0), b2, voffB, 1), PG8_PIECE(PG8_SB(0, 1), b2 + hstep, voffB, 0));
            PG8_MMA_I(1, 1, At, B1, PG8_PIECE(PG8_SB(0, 1), b2 + hstep, voffB, 1), PG8_PIECE(PG8_SA(0, 0), a2, voffA, 0), PG8_PIECE(PG8_SA(0, 0), a2, voffA, 1)); PG8_BAR; PG8_SCHED;
            PG8_LDB(B0, 1, 0); PG8_LDB(B1, 1, 1); PG8_SCHED; PG8_LDA(At, 1, 0);
            PG8_WAIT_V(6); PG8_WAIT_L(0); PG8_BAR; PG8_MMA_I(0, 0, At, B0, , PG8_PIECE(PG8_SA(0, 1), a2 + hstepA, voffA, 0), ); PG8_MMA_I(0, 1, At, B1, , PG8_PIECE(PG8_SA(0, 1), a2 + hstepA, voffA, 1), ); PG8_BAR; PG8_SCHED;
            PG8_LDA(At, 1, 1);
            PG8_WAIT_V(2); PG8_WAIT_L(0); PG8_BAR; PG8_MMA_I(1, 0, At, B0, PG8_PIECE(PG8_SB(1, 0), b3, voffB, 0), PG8_PIECE(PG8_SB(1, 0), b3, voffB, 1), PG8_PIECE(PG8_SB(1, 1), b3 + hstep, voffB, 0));
            PG8_MMA_I(1, 1, At, B1, PG8_PIECE(PG8_SB(1, 1), b3 + hstep, voffB, 1), PG8_PIECE(PG8_SA(1, 0), a3, voffA, 0), PG8_PIECE(PG8_SA(1, 0), a3, voffA, 1)); PG8_BAR; PG8_SCHED;
#else
            PG8_LDB(B0, 0, 0); PG8_LDB(B1, 0, 1); PG8_SCHED; PG8_LDA(At, 0, 0); PG8_STAGE(PG8_SA(1, 1), a1 + hstepA, voffA);
            PG8_WAIT_V(8); PG8_WAIT_L(0); PG8_BAR; PG8_MMA(0, 0, At, B0); PG8_MMA(0, 1, At, B1); PG8_BAR; PG8_SCHED;
            PG8_LDA(At, 0, 1); PG8_STAGE(PG8_SB(0, 0), b2, voffB); PG8_STAGE(PG8_SB(0, 1), b2 + hstep, voffB); PG8_STAGE(PG8_SA(0, 0), a2, voffA);
            PG8_WAIT_V(8); PG8_WAIT_L(0); PG8_BAR; PG8_MMA(1, 0, At, B0); PG8_MMA(1, 1, At, B1); PG8_BAR; PG8_SCHED;
            PG8_LDB(B0, 1, 0); PG8_LDB(B1, 1, 1); PG8_SCHED; PG8_LDA(At, 1, 0); PG8_STAGE(PG8_SA(0, 1), a2 + hstepA, voffA);
            PG8_WAIT_V(8); PG8_WAIT_L(0); PG8_BAR; PG8_MMA(0, 0, At, B0); PG8_MMA(0, 1, At, B1); PG8_BAR; PG8_SCHED;
            PG8_LDA(At, 1, 1); PG8_STAGE(PG8_SB(1, 0), b3, voffB); PG8_STAGE(PG8_SB(1, 1), b3 + hstep, voffB); PG8_STAGE(PG8_SA(1, 0), a3, voffA);
            PG8_WAIT_V(8); PG8_WAIT_L(0); PG8_BAR; PG8_MMA(1, 0, At, B0); PG8_MMA(1, 1, At, B1); PG8_BAR; PG8_SCHED;
#endif
            } else {
            PG8_LDB(B0, 0, 0); PG8_SCHED; PG8_LDA(At, 0, 0); PG8_STAGE(PG8_SA(1, 1), a1 + hstepA, voffA);
            PG8_WAIT_L(8); PG8_BAR; PG8_WAIT_L(0); PG8_MMA(0, 0, At, B0); PG8_BAR; PG8_SCHED;
            PG8_LDB(B1, 0, 1); PG8_STAGE(PG8_SB(0, 0), b2, voffB);
            PG8_BAR; PG8_WAIT_L(0); PG8_MMA(0, 1, At, B1); PG8_BAR;
            PG8_LDA(At, 0, 1); PG8_STAGE(PG8_SA(0, 0), a2, voffA);
            PG8_BAR; PG8_WAIT_L(0); PG8_MMA(1, 0, At, B0); PG8_BAR; PG8_SCHED;
            PG8_STAGE(PG8_SB(0, 1), b2 + hstep, voffB);
            PG8_WAIT_V(6); PG8_BAR; PG8_MMA(1, 1, At, B1); PG8_BAR;
            PG8_LDB(B0, 1, 0); PG8_SCHED; PG8_LDA(At, 1, 0); PG8_STAGE(PG8_SA(0, 1), a2 + hstepA, voffA);
            PG8_WAIT_L(8); PG8_BAR; PG8_WAIT_L(0); PG8_MMA(0, 0, At, B0); PG8_BAR; PG8_SCHED;
            PG8_LDB(B1, 1, 1); PG8_STAGE(PG8_SB(1, 0), b3, voffB);
            PG8_BAR; PG8_WAIT_L(0); PG8_MMA(0, 1, At, B1); PG8_BAR;
            PG8_LDA(At, 1, 1); PG8_STAGE(PG8_SA(1, 0), a3, voffA);
            PG8_BAR; PG8_WAIT_L(0); PG8_MMA(1, 0, At, B0); PG8_BAR; PG8_SCHED;
            PG8_STAGE(PG8_SB(1, 1), b3 + hstep, voffB);
            PG8_WAIT_V(6); PG8_BAR; PG8_MMA(1, 1, At, B1); PG8_BAR;
            }
        }
        if constexpr (ALIGN_EPI) { if (wr == 0) PG8_BAR; }
        asm volatile("" ::: "memory"); __builtin_amdgcn_sched_barrier(0);
        { int t2_ = tid; asm volatile("" : "+v"(t2_)); const int w2_ = __builtin_amdgcn_readfirstlane(t2_ >> 6), l2_ = t2_ & 63; E(acc, cur, w2_ >> 2, w2_ & 3, l2_ & 15, l2_ >> 4); }
        if (!has_next) break;
#pragma unroll
        for (int a = 0; a < 2; ++a)
#pragma unroll
            for (int b = 0; b < 2; ++b)
#pragma unroll
                for (int m = 0; m < 4; ++m)
#pragma unroll
                    for (int n = 0; n < 2; ++n) acc[a][b][m][n] = (f32x4){zf_, zf_, zf_, zf_};
        cur = nxt; cA = nA; cB = nB; ++ui;
        if constexpr (ALIGN_EPI) { if (wr == 1) PG8_BAR; }
    }
    PG8_WAIT_V(0);
    if constexpr (!ALIGN_EPI) { if (wr == 0) PG8_BAR; }
    PG8_BAR;
#undef PG8_SA
#undef PG8_SB
#undef PG8_STAGE
#undef PG8_LDA
#undef PG8_LD32
#undef PG8_LDB
#undef PG8_MMA
#undef PG8_MMA_I
#undef PG8_PIECE
#undef PG8_WAIT_V
#undef PG8_WAIT_L
#undef PG8_BAR
#undef PG8_SCHED
}
}

struct SchedPlain {
    pg8::StaticOrder o; const char* A; const char* B; size_t tstep;
    DI bool next(int i, pg8::Unit& u) const { return o.next(i, u); }
    DI const char* abase(const pg8::Unit& u) const { return A + (size_t)u.pm * tstep; }
    DI const char* bbase(const pg8::Unit& u) const { return B + (size_t)u.pn * tstep; }
};
struct SchedBranch {
    pg8::StaticOrder o; const char* A; const char* B; size_t tstep, aslab;
    DI bool next(int i, pg8::Unit& u) const { pg8::Unit t; if (!o.next(i / 3, t)) return false; u.pm = t.pm; u.pn = t.pn + 4 * (i % 3); return true; }
    DI const char* abase(const pg8::Unit& u) const { return A + (size_t)(u.pn >> 2) * aslab + (size_t)u.pm * tstep; }
    DI const char* bbase(const pg8::Unit& u) const { return B + (size_t)u.pn * tstep; }
};
struct SchedMoe {
    pg8::StaticOrder o; const char* A; const char* B; unsigned eslab; const LAS int* texp;
    DI bool next(int i, pg8::Unit& u) const { return o.next(i, u); }
#ifdef PROBE_FIXAB
    int fix = 0;
    DI const char* abase(const pg8::Unit& u) const { return A + ((fix & 1) ? (size_t)0 : (size_t)u.pm * (256u * 1024u)); }
    DI const char* bbase(const pg8::Unit& u) const { return B + ((fix & 2) ? (size_t)0 : (size_t)((unsigned)texp[u.pm] * eslab) + (size_t)u.pn * (256u * 1024u)); }
#else
    DI const char* abase(const pg8::Unit& u) const { return A + (size_t)u.pm * (256u * 1024u); }
    DI const char* bbase(const pg8::Unit& u) const { return B + (size_t)((unsigned)texp[u.pm] * eslab) + (size_t)u.pn * (256u * 1024u); }
#endif
};

struct SchedMoeB {
    pg8::StaticOrder o; const char* A; const char* B; unsigned eslab; const LAS int* texp;
    DI bool next(int i, pg8::Unit& u) const { return o.next(i, u); }
    DI const char* abase(const pg8::Unit& u) const { return A + (size_t)u.pm * (256u * 2048u); }
    DI const char* bbase(const pg8::Unit& u) const { return B + (size_t)((unsigned)texp[u.pm] * eslab) + (size_t)u.pn * (256u * 2048u); }
};

#ifndef EPI_QT
#define EPI_QT 1
#endif
#ifndef EPI_QT_ST
#define EPI_QT_ST 1
#endif
DI int qt_src(int lane) { return (((lane >> 2) + 16 * (lane & 3)) * 4); }
DI f32x4 qt4f(int src4, f32x4 v);
DI u32x4 qt4(int src4, u32x4 w) { u32x4 r; r.x = (unsigned)__builtin_amdgcn_ds_bpermute(src4, (int)w.x); r.y = (unsigned)__builtin_amdgcn_ds_bpermute(src4, (int)w.y); r.z = (unsigned)__builtin_amdgcn_ds_bpermute(src4, (int)w.z); r.w = (unsigned)__builtin_amdgcn_ds_bpermute(src4, (int)w.w); return r; }
DI f32x4 qt4f(int src4, f32x4 v) { return __builtin_bit_cast(f32x4, qt4(src4, __builtin_bit_cast(u32x4, v))); }
struct EpiStoreBf16 {
    static constexpr bool PERM = true;
    bf16_t* O; int ldc; int coff = 0;
#ifdef PROBE_NOSTORE
    bool skip = false;
#endif
    DI void operator()(const f32x4 (&acc)[2][2][4][2], const pg8::Unit& u, int wr, int wc, int fr, int fq) const {
#if EPI_QT_ST
        const int lane = fr + 16 * fq, src4 = qt_src(lane); fr = lane >> 2; fq = lane & 3;
#endif
        const int row0 = u.pm * 256 + wr * 64 + fr, col0 = coff + u.pn * 256 + wc * 32 + 8 * fq;
#pragma unroll
        for (int ai = 0; ai < 2; ++ai)
#pragma unroll
            for (int m = 0; m < 4; ++m) { bf16_t* rowp = O + (size_t)(row0 + ai * 128 + m * 16) * ldc + col0;
#pragma unroll
                for (int bj = 0; bj < 2; ++bj) { const f32x4 v0 = acc[ai][bj][m][0], v1 = acc[ai][bj][m][1];
                    u32x4 w; w.x = pk2(v0[0], v0[1]); w.y = pk2(v0[2], v0[3]); w.z = pk2(v1[0], v1[1]); w.w = pk2(v1[2], v1[3]);
#if EPI_QT_ST
                    w = qt4(src4, w);
#endif
#ifdef PROBE_NOSTORE
                    if (skip) { asm volatile("" :: "v"(w.x), "v"(w.y), "v"(w.z), "v"(w.w)); } else
#endif
                    *(u32x4*)(rowp + bj * 128) = w; } }
    }
};
struct EpiStoreBf16N {
    static constexpr bool PERM = false;
    bf16_t* O; int ldc; int coff = 0;
#ifdef PROBE_NOSTORE
    bool skip = false;
#endif
    DI void operator()(const f32x4 (&acc)[2][2][4][2], const pg8::Unit& u, int wr, int wc, int fr, int fq) const {
#if EPI_QT
#if EPI_QT_ST
        const int lane = fr + 16 * fq, a_ = lane >> 2, b_ = lane & 3, src4 = (a_ + 16 * (((b_ & 1) << 1) | (b_ >> 1))) * 4;
        const int row0 = u.pm * 256 + wr * 64 + a_, col0 = coff + u.pn * 256 + wc * 32 + 8 * b_;
#else
        const int row0 = u.pm * 256 + wr * 64 + fr, col0 = coff + u.pn * 256 + wc * 32 + 8 * (((fq & 1) << 1) | (fq >> 1));
#endif
#pragma unroll
        for (int ai = 0; ai < 2; ++ai)
#pragma unroll
            for (int m = 0; m < 4; ++m) { bf16_t* rowp = O + (size_t)(row0 + ai * 128 + m * 16) * ldc + col0;
#pragma unroll
                for (int bj = 0; bj < 2; ++bj) { const f32x4 v0 = acc[ai][bj][m][0], v1 = acc[ai][bj][m][1];
                    unsigned x0 = pk2(v0[0], v0[1]), y0 = pk2(v0[2], v0[3]), x1 = pk2(v1[0], v1[1]), y1 = pk2(v1[2], v1[3]);
                    { const auto r = __builtin_amdgcn_permlane16_swap(x0, x1, false, false); x0 = r[0]; x1 = r[1]; }
                    { const auto r = __builtin_amdgcn_permlane16_swap(y0, y1, false, false); y0 = r[0]; y1 = r[1]; }
                    u32x4 w; w.x = x0; w.y = y0; w.z = x1; w.w = y1;
#if EPI_QT_ST
                    w = qt4(src4, w);
#endif
#ifdef PROBE_NOSTORE
                    if (skip) { asm volatile("" :: "v"(w.x), "v"(w.y), "v"(w.z), "v"(w.w)); } else
#endif
                    *(u32x4*)(rowp + bj * 128) = w; } }
#else
        const int row0 = u.pm * 256 + wr * 64 + fr, col0 = coff + u.pn * 256 + wc * 32 + 4 * fq;
#pragma unroll
        for (int ai = 0; ai < 2; ++ai)
#pragma unroll
            for (int m = 0; m < 4; ++m) { bf16_t* rowp = O + (size_t)(row0 + ai * 128 + m * 16) * ldc + col0;
#pragma unroll
                for (int bj = 0; bj < 2; ++bj)
#pragma unroll
                    for (int n = 0; n < 2; ++n) { const f32x4 v = acc[ai][bj][m][n]; u32x2 w; w.x = pk2(v[0], v[1]); w.y = pk2(v[2], v[3]);
#ifdef PROBE_NOSTORE
                        if (skip) { asm volatile("" :: "v"(w.x), "v"(w.y)); } else
#endif
                        *(u32x2*)(rowp + bj * 128 + n * 16) = w; } }
#endif
    }
};
struct EpiQaRope {
    static constexpr bool PERM = true;
    bf16_t* O; const float* rope;
    DI void operator()(const f32x4 (&acc)[2][2][4][2], const pg8::Unit& u, int wr, int wc, int fr, int fq) const {
        const int row0 = u.pm * 256 + wr * 64 + fr, col0 = u.pn * 256 + wc * 32 + 8 * fq;
#pragma unroll
        for (int ai = 0; ai < 2; ++ai)
#pragma unroll
            for (int m = 0; m < 4; ++m) { const int row = row0 + ai * 128 + m * 16; bf16_t* rowp = O + (size_t)row * 768 + col0;
#pragma unroll
                for (int bj = 0; bj < 2; ++bj) { f32x4 v0 = acc[ai][bj][m][0], v1 = acc[ai][bj][m][1];
                    const int c8 = col0 + bj * 128, p0 = c8 % 96;
                    if (p0 < 32) { const f32x4* cs = (const f32x4*)(rope + (size_t)row * 48 + p0); const f32x4 a = cs[0], b = cs[1];
                        const f32x4 r0 = {v0[0] * a[0] - v0[1] * a[1], v0[1] * a[0] + v0[0] * a[1], v0[2] * a[2] - v0[3] * a[3], v0[3] * a[2] + v0[2] * a[3]};
                        const f32x4 r1 = {v1[0] * b[0] - v1[1] * b[1], v1[1] * b[0] + v1[0] * b[1], v1[2] * b[2] - v1[3] * b[3], v1[3] * b[2] + v1[2] * b[3]};
                        v0 = r0; v1 = r1; }
                    u32x4 w; w.x = pk2(v0[0], v0[1]); w.y = pk2(v0[2], v0[3]); w.z = pk2(v1[0], v1[1]); w.w = pk2(v1[2], v1[3]);
                    *(u32x4*)(rowp + bj * 128) = w; } }
    }
};
struct EpiBranchGate {
    static constexpr bool PERM = true;
    bf16_t* MG; const bf16_t* P; const float* bgate;
    DI void operator()(const f32x4 (&acc)[2][2][4][2], const pg8::Unit& u, int wr, int wc, int fr, int fq) const {
#if EPI_QT
        const int lane = fr + 16 * fq, src4 = qt_src(lane); fr = lane >> 2; fq = lane & 3;
#endif
        const int n = u.pn >> 2, row0 = u.pm * 256 + wr * 64 + fr, colg = u.pn * 256 + wc * 32 + 8 * fq, col0 = colg - n * 1024;
        f32x4 bg[2][2];
#pragma unroll
        for (int bj = 0; bj < 2; ++bj) { bg[bj][0] = *(const f32x4*)(bgate + colg + bj * 128); bg[bj][1] = *(const f32x4*)(bgate + colg + bj * 128 + 4); }
        u32x4 gl[2][2][2], pv[2][2][2];
#define EBG_LOAD(slot, grp) do { _Pragma("unroll") for (int m2 = 0; m2 < 2; ++m2) _Pragma("unroll") for (int bj = 0; bj < 2; ++bj) { const size_t row = (size_t)(row0 + ((grp) >> 1) * 128 + (2 * ((grp) & 1) + m2) * 16); \
            gl[slot][m2][bj] = *(const u32x4*)(P + row * NP + colg + bj * 128); pv[slot][m2][bj] = (n > 0) ? *(const u32x4*)(MG + row * D_MODEL + col0 + bj * 128) : (u32x4){0u, 0u, 0u, 0u}; } } while (0)
        EBG_LOAD(0, 0);
#pragma unroll
        for (int grp = 0; grp < 4; ++grp) {
            const int slot = grp & 1, ai = grp >> 1, mh = grp & 1;
            if (grp + 1 < 4) { if (slot == 0) EBG_LOAD(1, grp + 1); else EBG_LOAD(0, grp + 1); }
            asm volatile("" ::: "memory");
#pragma unroll
            for (int m2 = 0; m2 < 2; ++m2)
#pragma unroll
                for (int bj = 0; bj < 2; ++bj) { const int m = 2 * mh + m2; const size_t row = (size_t)(row0 + ai * 128 + m * 16);
#if EPI_QT
                    const f32x4 v0 = qt4f(src4, acc[ai][bj][m][0]), v1 = qt4f(src4, acc[ai][bj][m][1]);
#else
                    const f32x4 v0 = acc[ai][bj][m][0], v1 = acc[ai][bj][m][1];
#endif
                    const u32x4 g = gl[slot][m2][bj], q = pv[slot][m2][bj];
                    float o[8];
                    o[0] = v0[0] * fast_sigmoid(bf_lo(g.x) + bg[bj][0][0]) + bf_lo(q.x); o[1] = v0[1] * fast_sigmoid(bf_hi(g.x) + bg[bj][0][1]) + bf_hi(q.x);
                    o[2] = v0[2] * fast_sigmoid(bf_lo(g.y) + bg[bj][0][2]) + bf_lo(q.y); o[3] = v0[3] * fast_sigmoid(bf_hi(g.y) + bg[bj][0][3]) + bf_hi(q.y);
                    o[4] = v1[0] * fast_sigmoid(bf_lo(g.z) + bg[bj][1][0]) + bf_lo(q.z); o[5] = v1[1] * fast_sigmoid(bf_hi(g.z) + bg[bj][1][1]) + bf_hi(q.z);
                    o[6] = v1[2] * fast_sigmoid(bf_lo(g.w) + bg[bj][1][2]) + bf_lo(q.w); o[7] = v1[3] * fast_sigmoid(bf_hi(g.w) + bg[bj][1][3]) + bf_hi(q.w);
                    u32x4 w; w.x = pk2(o[0], o[1]); w.y = pk2(o[2], o[3]); w.z = pk2(o[4], o[5]); w.w = pk2(o[6], o[7]);
                    *(u32x4*)(MG + row * D_MODEL + col0 + bj * 128) = w; }
        }
#undef EBG_LOAD
    }
};
struct EpiResidual {
    static constexpr bool PERM = false;
    const float* xin; float* xout; const float* gmod;
    DI void operator()(const f32x4 (&acc)[2][2][4][2], const pg8::Unit& u, int wr, int wc, int fr, int fq) const {
#if EPI_QT
        const int lane = fr + 16 * fq, src4 = qt_src(lane); fr = lane >> 2; fq = lane & 3;
#endif
        const int row0 = u.pm * 256 + wr * 64 + fr, col0 = u.pn * 256 + wc * 32 + 4 * fq;
        const float* gm = gmod + (size_t)(u.pm >> 3) * 6144 + col0;
        f32x4 gv[2][2];
#pragma unroll
        for (int bj = 0; bj < 2; ++bj)
#pragma unroll
            for (int n = 0; n < 2; ++n) gv[bj][n] = *(const f32x4*)(gm + bj * 128 + n * 16);
        f32x4 xv[2][2][2][2];
#define ERS_LOAD(slot, grp) do { _Pragma("unroll") for (int m2 = 0; m2 < 2; ++m2) { const size_t off = (size_t)(row0 + ((grp) >> 1) * 128 + (2 * ((grp) & 1) + m2) * 16) * D_MODEL + col0; \
            _Pragma("unroll") for (int bj = 0; bj < 2; ++bj) _Pragma("unroll") for (int n = 0; n < 2; ++n) xv[slot][m2][bj][n] = *(const f32x4*)(xin + off + bj * 128 + n * 16); } } while (0)
        ERS_LOAD(0, 0);
#pragma unroll
        for (int grp = 0; grp < 4; ++grp) {
            const int slot = grp & 1, ai = grp >> 1, mh = grp & 1;
            if (grp + 1 < 4) { if (slot == 0) ERS_LOAD(1, grp + 1); else ERS_LOAD(0, grp + 1); }
            asm volatile("" ::: "memory");
#pragma unroll
            for (int m2 = 0; m2 < 2; ++m2) { const size_t off = (size_t)(row0 + ai * 128 + (2 * mh + m2) * 16) * D_MODEL + col0;
#pragma unroll
                for (int bj = 0; bj < 2; ++bj)
#pragma unroll
                    for (int n = 0; n < 2; ++n) {
#if EPI_QT
                        const f32x4 av = qt4f(src4, acc[ai][bj][2 * mh + m2][n]);
#else
                        const f32x4 av = acc[ai][bj][2 * mh + m2][n];
#endif
                        *(f32x4*)(xout + off + bj * 128 + n * 16) = xv[slot][m2][bj][n] + gv[bj][n] * av; } }
        }
#undef ERS_LOAD
    }
};
struct EpiSwiglu {
    static constexpr bool PERM = false;
    bf16_t* ACT; const float* b1; const LAS int* texp;
    DI void operator()(const f32x4 (&acc)[2][2][4][2], const pg8::Unit& u, int wr, int wc, int fr, int fq) const {
        const int row0 = u.pm * 256 + wr * 64 + fr, e = texp[u.pm];
        const float* bb = b1 + (size_t)e * 2048;
#pragma unroll
        for (int bj = 0; bj < 2; ++bj) { const int j0 = u.pn * 128 + bj * 64 + wc * 16 + 4 * fq;
            const f32x4 ba = *(const f32x4*)(bb + 2 * j0), bc = *(const f32x4*)(bb + 2 * j0 + 4);
            const f32x4 bgt = {ba[0], ba[2], bc[0], bc[2]}, bup = {ba[1], ba[3], bc[1], bc[3]};
#pragma unroll
            for (int ai = 0; ai < 2; ++ai)
#pragma unroll
                for (int m = 0; m < 4; ++m) { const f32x4 g = acc[ai][bj][m][0] + bgt, up = acc[ai][bj][m][1] + bup; float o[4];
#pragma unroll
                    for (int i = 0; i < 4; ++i) { const float gg = fminf(g[i], 7.0f), uu = fminf(fmaxf(up[i], -7.0f), 7.0f);
                        o[i] = (uu + 1.0f) * gg * fast_sigmoid(1.702f * gg);
                    }
                    u32x2 w; w.x = pk2(o[0], o[1]); w.y = pk2(o[2], o[3]);
                    *(u32x2*)(ACT + (size_t)(row0 + ai * 128 + m * 16) * D_EXP + j0) = w; } }
    }
};
struct EpiSwiglu8 {
    static constexpr bool PERM = false;
    unsigned char* ACT; const float* b1; const LAS int* texp;
#ifdef PROBE_M1
    int skip = 0;
#endif
    DI void operator()(const f32x4 (&acc)[2][2][4][2], const pg8::Unit& u, int wr, int wc, int fr, int fq) const {
#ifdef PROBE_M1
        if (skip == 2) {
#pragma unroll
            for (int ai = 0; ai < 2; ++ai)
#pragma unroll
                for (int bj = 0; bj < 2; ++bj)
#pragma unroll
                    for (int m = 0; m < 4; ++m)
#pragma unroll
                        for (int n = 0; n < 2; ++n) asm volatile("" :: "v"(acc[ai][bj][m][n][0]), "v"(acc[ai][bj][m][n][1]), "v"(acc[ai][bj][m][n][2]), "v"(acc[ai][bj][m][n][3]));
            return; }
#endif
        const int row0 = u.pm * 256 + wr * 64 + fr, e = texp[u.pm];
        const float* bb = b1 + (size_t)e * 2048;
#pragma unroll
        for (int bj = 0; bj < 2; ++bj) { const int j0 = u.pn * 128 + bj * 64 + wc * 16 + 4 * fq;
#ifdef PROBE_M1
            f32x4 ba, bc; if (skip == 3) { float z_ = 0.f; asm volatile("" : "+v"(z_)); ba = (f32x4){z_, z_, z_, z_}; bc = ba; } else { ba = *(const f32x4*)(bb + 2 * j0); bc = *(const f32x4*)(bb + 2 * j0 + 4); }
#else
            const f32x4 ba = *(const f32x4*)(bb + 2 * j0), bc = *(const f32x4*)(bb + 2 * j0 + 4);
#endif
            const f32x4 bgt = {ba[0], ba[2], bc[0], bc[2]}, bup = {ba[1], ba[3], bc[1], bc[3]};
#pragma unroll
            for (int ai = 0; ai < 2; ++ai) {
                unsigned w[4];
#pragma unroll
                for (int m = 0; m < 4; ++m) { const f32x4 g = acc[ai][bj][m][0] + bgt, up = acc[ai][bj][m][1] + bup; float o[4];
#pragma unroll
                    for (int i = 0; i < 4; ++i) { const float gg = fminf(g[i], 7.0f), uu = fminf(fmaxf(up[i], -7.0f), 7.0f);
                        o[i] = (uu + 1.0f) * gg * fast_sigmoid(1.702f * gg);
                    }
                    w[m] = pk4_fp8(o[0], o[1], o[2], o[3]); }
                { const auto r = __builtin_amdgcn_permlane16_swap(w[0], w[1], false, false); w[0] = r[0]; w[1] = r[1]; }
                { const auto r = __builtin_amdgcn_permlane16_swap(w[2], w[3], false, false); w[2] = r[0]; w[3] = r[1]; }
                { const auto r = __builtin_amdgcn_permlane32_swap(w[0], w[2], false, false); w[0] = r[0]; w[2] = r[1]; }
                { const auto r = __builtin_amdgcn_permlane32_swap(w[1], w[3], false, false); w[1] = r[0]; w[3] = r[1]; }
                u32x4 wv; wv.x = w[0]; wv.y = w[1]; wv.z = w[2]; wv.w = w[3];
#ifdef PROBE_M1
                if (skip == 1) { asm volatile("" :: "v"(wv.x), "v"(wv.y), "v"(wv.z), "v"(wv.w)); } else
#endif
                *(u32x4*)(ACT + (size_t)(row0 + ai * 128 + fq * 16) * D_EXP + (j0 - 4 * fq)) = wv; } }
    }
};
struct EpiMoeOut {
    static constexpr bool PERM = true;
    bf16_t* Y; const float* b2; const float* gate; const LAS int* texp;
    DI void operator()(const f32x4 (&acc)[2][2][4][2], const pg8::Unit& u, int wr, int wc, int fr, int fq) const {
        const int row0 = u.pm * 256 + wr * 64 + fr, col0 = u.pn * 256 + wc * 32 + 8 * fq, e = texp[u.pm];
        const float* bb = b2 + (size_t)e * D_MODEL + col0;
#if EPI_QT_ST
        const int lane = fr + 16 * fq, src4 = qt_src(lane), rowq = (lane >> 2) - fr, colq = 8 * ((lane & 3) - fq);
#endif
        f32x4 bv[2][2];
#pragma unroll
        for (int bj = 0; bj < 2; ++bj) { bv[bj][0] = *(const f32x4*)(bb + bj * 128); bv[bj][1] = *(const f32x4*)(bb + bj * 128 + 4); }
#pragma unroll
        for (int ai = 0; ai < 2; ++ai) {
            float gt[4];
#pragma unroll
            for (int m = 0; m < 4; ++m) gt[m] = gate[row0 + ai * 128 + m * 16];
            asm volatile("" ::: "memory");
#pragma unroll
            for (int m = 0; m < 4; ++m) { const int row = row0 + ai * 128 + m * 16; const float g = gt[m];
#pragma unroll
                for (int bj = 0; bj < 2; ++bj) { const f32x4 v0 = (acc[ai][bj][m][0] + bv[bj][0]) * g, v1 = (acc[ai][bj][m][1] + bv[bj][1]) * g;
                    u32x4 w; w.x = pk2(v0[0], v0[1]); w.y = pk2(v0[2], v0[3]); w.z = pk2(v1[0], v1[1]); w.w = pk2(v1[2], v1[3]);
#if EPI_QT_ST
                    *(u32x4*)(Y + (size_t)(row + rowq) * D_MODEL + col0 + colq + bj * 128) = qt4(src4, w); } }
#else
                    *(u32x4*)(Y + (size_t)row * D_MODEL + col0 + bj * 128) = w; } }
#endif
            asm volatile("" ::: "memory");
        }
    }
};

constexpr size_t MiB = 1u << 20;
constexpr size_t WS_CTL = 0, CTL_ZERO_BYTES = 1 * MiB;
constexpr size_t WS_MOD = 1 * MiB, WS_ROPE = 2 * MiB, WS_WIN = 8 * MiB, WS_WUQ = 33 * MiB, WS_WUKV = 34 * MiB, WS_WB = 35 * MiB, WS_WOUT = 41 * MiB, WS_W1 = 53 * MiB, WS_W2 = 309 * MiB,
                 WS_X1 = 437 * MiB, WS_H = 565 * MiB, WS_CQ = 629 * MiB, WS_CKV = 645 * MiB, WS_KPE = 661 * MiB, WS_QA = 663 * MiB, WS_KV = 711 * MiB, WS_O3 = 775 * MiB, WS_QC = 871 * MiB,
                 WS_KC = 903 * MiB, WS_VC = 907 * MiB, WS_QI = 911 * MiB, WS_KI = 943 * MiB, WS_IW = 947 * MiB, WS_ROUTE = 948 * MiB, WS_P = 952 * MiB, WS_GY = 1352 * MiB, WS_END = 1544 * MiB;
constexpr size_t WS_HG8 = WS_QA;
constexpr size_t WS_XB = WS_P, WS_ACT = WS_P + 272 * MiB, WS_Y = WS_P, WS_H8 = WS_H;
constexpr size_t RT_TOPE = 0, RT_TOPG = 512 * 1024, RT_RANK = 1 * MiB, RT_SLOTOF = 1 * MiB + 512 * 1024, RT_TOKOF = 2 * MiB, RT_GATEOF = 3 * MiB;
static_assert((size_t)NSLOT_MAX * 1024 * 2 <= 272 * MiB && WS_ACT + 272 * MiB <= WS_END, "MoE overlay: XB (fp8) and Y (bf16) share [P, P+272M) (XB is dead when Y is written); ACT in [P+272M, P+544M)");
static_assert((size_t)T_TOK * NP * 2 == 400 * MiB, "P size");
constexpr int CW_BAR = 4096, CW_CNT = 16384;
constexpr int LDS_BYTES = 163840, LDS_X = 131072, MISC_OFF = LDS_BYTES - 512;

struct Frame {
    LAS unsigned char* lds; int tid, lane, wave, G, bid; float zf;
    float* out; unsigned char* ws; unsigned* ctl;
};
extern __shared__ __attribute__((aligned(16))) unsigned char lds_raw[];
typedef __attribute__((address_space(4))) const char* kptr_t;
DI const void* kin(int i) {
#if defined(__HIP_DEVICE_COMPILE__)
    kptr_t ka = (kptr_t)__builtin_amdgcn_kernarg_segment_ptr(); asm volatile("" : "+s"(ka)); return (const void*)(GAS const void*)*(__attribute__((address_space(4))) const unsigned long long*)(ka + 8 * i);
#else
    (void)i; return nullptr;
#endif
}
#define KIN_x ((const float*)kin(0))
#define KIN_c ((const float*)kin(1))
#define KIN_pos ((const int*)kin(2))
#define KIN_norm1_g ((const float*)kin(3))
#define KIN_norm2_g ((const float*)kin(4))
#define KIN_w_ada ((const float*)kin(5))
#define KIN_b_ada ((const float*)kin(6))
#define KIN_w_in ((const float*)kin(7))
#define KIN_b_gate ((const float*)kin(8))
#define KIN_q_norm ((const float*)kin(9))
#define KIN_w_uq ((const float*)kin(10))
#define KIN_kv_norm ((const float*)kin(11))
#define KIN_w_ukv ((const float*)kin(12))
#define KIN_conv_w ((const float*)kin(13))
#define KIN_w_branch ((const float*)kin(14))
#define KIN_w_out ((const float*)kin(15))
#define KIN_router_w ((const float*)kin(16))
#define KIN_router_b ((const float*)kin(17))
#define KIN_w1 ((const float*)kin(18))
#define KIN_b1 ((const float*)kin(19))
#define KIN_w2 ((const float*)kin(20))
#define KIN_b2 ((const float*)kin(21))
#define KIN_final_g ((const float*)kin(22))
DI Frame make_frame(int wave0) {
    Frame F; unsigned z_ = 0u; asm volatile("" : "+v"(z_));
    F.lds = (LAS unsigned char*)lds_raw; F.lane = (int)__builtin_amdgcn_mbcnt_hi(~0u, __builtin_amdgcn_mbcnt_lo(~0u, z_)); F.wave = wave0; F.tid = wave0 * 64 + F.lane; F.G = gridDim.x; F.bid = blockIdx.x; F.zf = __uint_as_float(z_);
    F.out = (float*)kin(23); F.ws = (unsigned char*)kin(24); F.ctl = (unsigned*)F.ws;
    return F;
}
#define WSP(T, off) ((T*)(F.ws + (off)))
#ifndef STAG_MODE
#define STAG_MODE 1
#endif
#ifndef STAG_SCALE
#define STAG_SCALE 100
#endif
DI void stagger(const Frame& F, int spread_us) {
#if STAG_MODE == 0
    const unsigned ticks = (unsigned)(spread_us * STAG_SCALE) * (unsigned)F.bid / (unsigned)F.G;
#elif STAG_MODE == 1
    const unsigned ticks = (unsigned)(spread_us * STAG_SCALE) * (unsigned)(F.bid & 7) / 8u;
#else
    const unsigned ticks = (unsigned)(spread_us * STAG_SCALE) * (unsigned)((F.bid >> 3) & 3) / 4u;
#endif
    if (ticks == 0u) return;
    const unsigned long long t0 = __builtin_amdgcn_s_memrealtime();
    while ((unsigned)(__builtin_amdgcn_s_memrealtime() - t0) < ticks) __builtin_amdgcn_s_sleep(8);
}


#define XB_TMO      128
#define XB_XCNT(j)  (256  + 64 * (j))
#define XB_XSUB(j)  (1280 + 64 * (j))
#define XB_XGEN(j)  (2304 + 64 * (j))
#define XB_TOP      3328
#define XB_TOPGEN   3392
#define XCD_BAR_WORDS 3456
#define XB_SPIN_CAP (1u << 18)
DI unsigned xb_ld(unsigned* p)              { return __hip_atomic_load(p, __ATOMIC_RELAXED, __HIP_MEMORY_SCOPE_AGENT); }
DI unsigned xb_add(unsigned* p, unsigned v) { return __hip_atomic_fetch_add(p, v, __ATOMIC_RELAXED, __HIP_MEMORY_SCOPE_AGENT); }
DI unsigned xb_xcc_id() { return (unsigned)__builtin_amdgcn_s_getreg((3 << 11) | 20) & 0xFu; }
#define XB_SPIN(cond, bar) do { unsigned _sp = 0; while (cond) { __builtin_amdgcn_s_sleep(1); \
    if ((++_sp & 255u) == 0u) { if (xb_ld(&(bar)[XB_TMO])) break; if (_sp > XB_SPIN_CAP) { atomicAdd(&(bar)[XB_TMO], 1u); break; } } } } while (0)
struct XcdBarrier { unsigned* bar; unsigned x; volatile LAS unsigned* st; };
DI XcdBarrier xcd_barrier_post(unsigned* bar, volatile LAS unsigned* st, int tid) {
    XcdBarrier b; b.bar = bar; b.x = xb_xcc_id(); b.st = st;
    if (tid == 0) (void)xb_add(&bar[XB_XCNT(b.x)], 1u);
    return b;
}
DI void xcd_barrier_complete(unsigned* bar, unsigned x, unsigned& nloc, unsigned& nx) {
    const unsigned G = gridDim.x * gridDim.y * gridDim.z;
    unsigned sum, cnt, mine, sp = 0u;
    for (;;) {
        sum = 0u; cnt = 0u; mine = 0u;
#pragma unroll
        for (unsigned j = 0; j < 16; ++j) { const unsigned c = xb_ld(&bar[XB_XCNT(j)]); sum += c; cnt += (c > 0u) ? 1u : 0u; mine = (j == x) ? c : mine; }
        if (sum == G) break;
        __builtin_amdgcn_s_sleep(1);
        if ((++sp & 255u) == 0u) { if (xb_ld(&bar[XB_TMO])) break; if (sp > XB_SPIN_CAP) { atomicAdd(&bar[XB_TMO], 1u); break; } }
    }
    nloc = mine > 0u ? mine : 1u; nx = cnt > 0u ? cnt : 1u;
}
DI void xcd_barrier(const XcdBarrier& b, int tid) {
    asm volatile("s_waitcnt vmcnt(0)" ::: "memory");
    __syncthreads();
    if (tid == 0) {
        unsigned* bar = b.bar;
        __builtin_amdgcn_s_waitcnt(0);
        unsigned nloc = b.st[0], nx = b.st[1];
        if (nloc == 0u) { xcd_barrier_complete(bar, b.x, nloc, nx); b.st[0] = nloc; b.st[1] = nx; }
        const unsigned old = xb_add(&bar[XB_XSUB(b.x)], 1u);
        const unsigned gen = old / nloc;
        if (old + 1u == (gen + 1u) * nloc) {
            __builtin_amdgcn_fence(__ATOMIC_RELEASE, "agent");
            asm volatile("s_waitcnt vmcnt(0)" ::: "memory");
            const unsigned og = xb_add(&bar[XB_TOP], 1u);
            const unsigned tg = og / nx;
            if (og + 1u == (tg + 1u) * nx) xb_add(&bar[XB_TOPGEN], 1u);
            else XB_SPIN(xb_ld(&bar[XB_TOPGEN]) == tg, bar);
            __builtin_amdgcn_fence(__ATOMIC_ACQUIRE, "agent");
            xb_add(&bar[XB_XGEN(b.x)], 1u);
            asm volatile("s_waitcnt vmcnt(0)" ::: "memory");
        } else {
            XB_SPIN(xb_ld(&bar[XB_XGEN(b.x)]) == gen, bar);
            __builtin_amdgcn_fence(__ATOMIC_ACQUIRE, "agent");
            asm volatile("s_waitcnt vmcnt(0)" ::: "memory");
        }
    }
    __syncthreads();
}

#ifndef HG8_TILED
#define HG8_TILED 0
#endif
#ifndef G1_F8_COLS
#define G1_F8_COLS 3072
#endif
DI int rope_perm(int p, int half) { return (p < 2 * half) ? (p >> 1) + half * (p & 1) : p; }
DI int cmap_in(int r) {
    if (r < PC_CONV) return OC_GATE + r;
    if (r < PC_DQ) return OC_CONV + (r - PC_CONV);
    if (r < PC_IQ) { const int j = r - PC_DQ; return OC_DQ + (j & ~63) + rope_perm(j & 63, 8); }
    if (r < PC_QLAT) { const int j = r - PC_IQ; return OC_IQ + (j & ~63) + rope_perm(j & 63, 8); }
    if (r < PC_KVLAT) return OC_QLAT + (r - PC_QLAT);
    if (r < PC_DKV) { const int j = r - PC_KVLAT; return j < 128 ? OC_KVLAT + j : OC_KVLAT + 128 + rope_perm(j - 128, 16); }
    if (r < PC_IK) { const int j = r - PC_DKV; return j < 64 ? OC_DKV + rope_perm(j, 8) : OC_DKV + j; }
    if (r < PC_IW) return OC_IK + rope_perm(r - PC_IK, 8);
    if (r < IN_COLS) return OC_IW + (r - PC_IW);
    return -1;
}
DI int cmap_uq(int r) { const int h = r / 96, p = r % 96; return h * 96 + rope_perm(p, 16); }
DI int cmap_w1(int R) { const int pn = R >> 8, rem = R & 255, bj = rem >> 7, wc = (rem >> 5) & 3, n = (rem >> 4) & 1, f = rem & 15; return 2 * (pn * 128 + bj * 64 + wc * 16 + f) + n; }
DI void transpose_item(const float* W, int K, int N, bf16_t* WT, int ldk, int koff, LAS float* scr, int k0, int n0, int csrc, int lane) {
#pragma unroll 8
    for (int i = 0; i < 32; ++i) { const int kk = 2 * i + (lane >> 5); float v = 0.f; if (csrc >= 0 && k0 + kk < K) v = W[(size_t)(k0 + kk) * N + csrc]; scr[kk * 33 + (lane & 31)] = v; }
    LDS_WAIT(); asm volatile("" ::: "memory");
    const int c = lane & 7;
#pragma unroll
    for (int j = 0; j < 4; ++j) { const int n = (lane >> 3) + 8 * j; const LAS float* s = scr + (8 * c) * 33 + n;
        u32x4 o; o.x = pk2(s[0 * 33], s[1 * 33]); o.y = pk2(s[2 * 33], s[3 * 33]); o.z = pk2(s[4 * 33], s[5 * 33]); o.w = pk2(s[6 * 33], s[7 * 33]);
        *(u32x4*)(WT + (size_t)(n0 + n) * ldk + koff + k0 + 8 * c) = o; }
    LDS_WAIT(); asm volatile("" ::: "memory");
}
DI void transpose_item_f8(const float* W, int K, int N, unsigned char* WT, int ldk, LAS float* scr, int k0, int n0, int csrc, int lane, float qs) {
#pragma unroll 8
    for (int i = 0; i < 32; ++i) { const int kk = 2 * i + (lane >> 5); scr[kk * 33 + (lane & 31)] = W[(size_t)(k0 + kk) * N + csrc] * qs; }
    LDS_WAIT(); asm volatile("" ::: "memory");
    const int c = lane & 7;
#pragma unroll
    for (int j = 0; j < 4; ++j) { const int n = (lane >> 3) + 8 * j; const LAS float* s = scr + (8 * c) * 33 + n;
        u32x2 o; o.x = pk4_fp8(s[0 * 33], s[1 * 33], s[2 * 33], s[3 * 33]); o.y = pk4_fp8(s[4 * 33], s[5 * 33], s[6 * 33], s[7 * 33]);
        *(u32x2*)(WT + (size_t)(n0 + n) * ldk + k0 + 8 * c) = o; }
    LDS_WAIT(); asm volatile("" ::: "memory");
}
DI void titem_load(const float* W, int N, int k0, int csrc, int lane, float (&v)[32]) {
#pragma unroll
    for (int i = 0; i < 32; ++i) v[i] = W[(size_t)(k0 + 2 * i + (lane >> 5)) * N + csrc];
}
DI void titem_store_f8(const float (&v)[32], unsigned char* WT, int ldk, LAS float* scr, int k0, int n0, int lane, float qs) {
#pragma unroll
    for (int i = 0; i < 32; ++i) scr[(2 * i + (lane >> 5)) * 33 + (lane & 31)] = v[i] * qs;
    LDS_WAIT(); asm volatile("" ::: "memory");
    const int c = lane & 7;
#pragma unroll
    for (int j = 0; j < 4; ++j) { const int n = (lane >> 3) + 8 * j; const LAS float* s = scr + (8 * c) * 33 + n;
        u32x2 o; o.x = pk4_fp8(s[0 * 33], s[1 * 33], s[2 * 33], s[3 * 33]); o.y = pk4_fp8(s[4 * 33], s[5 * 33], s[6 * 33], s[7 * 33]);
        *(u32x2*)(WT + (size_t)(n0 + n) * ldk + k0 + 8 * c) = o; }
    LDS_WAIT(); asm volatile("" ::: "memory");
}
template <bool W1>
DI void convert_family_f8(const float* src, unsigned char* dst, int N, int nmat, LAS float* scr, int gw, int NGW, int lane) {
    const int nbn = N / 32, ipm = 16 * nbn, total = nmat * ipm;
    float va[32], vb[32];
#define TF_DECODE(it, j_, k0_, n0_, cs_) const int j_ = (it) / ipm, q_##j_ = (it) % ipm, k0_ = 64 * (q_##j_ / nbn), n0_ = 32 * (q_##j_ % nbn), cs_ = W1 ? cmap_w1(n0_ + (lane & 31)) : n0_ + (lane & 31)
    int it = gw;
    if (it < total) { TF_DECODE(it, j0, k00, n00, cs0); titem_load(src + (size_t)j0 * 1024 * N, N, k00, cs0, lane, va); }
    while (it < total) {
        const int it2 = it + NGW;
        if (it2 < total) { TF_DECODE(it2, j2, k02, n02, cs2); titem_load(src + (size_t)j2 * 1024 * N, N, k02, cs2, lane, vb); }
        { TF_DECODE(it, j1, k01, n01, cs1); (void)cs1; titem_store_f8(va, dst + (size_t)j1 * N * 1024, 1024, scr, k01, n01, lane, 64.0f); }
        const int it3 = it2 + NGW;
        if (it3 < total) { TF_DECODE(it3, j3, k03, n03, cs3); titem_load(src + (size_t)j3 * 1024 * N, N, k03, cs3, lane, va); }
        if (it2 < total) { TF_DECODE(it2, j4, k04, n04, cs4); (void)cs4; titem_store_f8(vb, dst + (size_t)j4 * N * 1024, 1024, scr, k04, n04, lane, 64.0f); }
        it = it3;
    }
#undef TF_DECODE
}
DI void sincos_d(double x, float& s, float& c) {
    const double kd = __builtin_rint(x * 0.6366197723675814); const int k = (int)kd;
    double r = __builtin_fma(-kd, 1.5707963267948966, x); r = __builtin_fma(-kd, 6.123233995736766e-17, r);
    const double r2 = r * r;
    const double sp = r * (1.0 + r2 * (-1.0 / 6 + r2 * (1.0 / 120 + r2 * (-1.0 / 5040 + r2 * (1.0 / 362880 + r2 * (-1.0 / 39916800 + r2 * (1.0 / 6227020800.0)))))));
    const double cp = 1.0 + r2 * (-0.5 + r2 * (1.0 / 24 + r2 * (-1.0 / 720 + r2 * (1.0 / 40320 + r2 * (-1.0 / 3628800 + r2 * (1.0 / 479001600.0 + r2 * (-1.0 / 87178291200.0)))))));
    const int q = k & 3;
    const double ss = (q == 0) ? sp : (q == 1) ? cp : (q == 2) ? -sp : -cp;
    const double cc = (q == 0) ? cp : (q == 1) ? -sp : (q == 2) ? -cp : sp;
    s = (float)ss; c = (float)cc;
}
DI void phase_prologue(const Frame& F) {
    const int tid = F.tid, lane = F.lane, wave = F.wave;
    __syncthreads();
    const float* in_c = KIN_c; const float* in_wada = KIN_w_ada; const float* in_bada = KIN_b_ada; const int* in_pos = KIN_pos;
    if (F.bid < 192) {
        LAS float* cact = (LAS float*)F.lds;
        LAS float* red = (LAS float*)(F.lds + 65536);
        for (int idx = tid; idx < 16 * 1024; idx += 512) { const int b = idx >> 10, k = idx & 1023; const float cv = in_c[idx]; cact[k * 16 + b] = cv * fast_sigmoid(cv); }
        __syncthreads();
        float* MOD = WSP(float, WS_MOD);
        for (int it = F.bid; it < 192; it += F.G) {
            const int l = it / 96, cb = it % 96, col = cb * 64 + lane;
            float acc[16];
#pragma unroll
            for (int b = 0; b < 16; ++b) acc[b] = 0.f;
            const float* wp = in_wada + ((size_t)l * 1024 + wave * 128) * 6144 + col;
#pragma unroll 4
            for (int kk = 0; kk < 128; ++kk) { const float wv = wp[(size_t)kk * 6144]; const LAS f32x4* cp = (const LAS f32x4*)(cact + (wave * 128 + kk) * 16);
#pragma unroll
                for (int q = 0; q < 4; ++q) { const f32x4 cv = cp[q]; acc[4 * q] += cv[0] * wv; acc[4 * q + 1] += cv[1] * wv; acc[4 * q + 2] += cv[2] * wv; acc[4 * q + 3] += cv[3] * wv; } }
#pragma unroll
            for (int b = 0; b < 16; ++b) red[(wave * 16 + b) * 64 + lane] = acc[b];
            __syncthreads();
            for (int o = tid; o < 1024; o += 512) { const int b = o >> 6, ln = o & 63; float s = in_bada[l * 6144 + cb * 64 + ln];
#pragma unroll
                for (int w = 0; w < 8; ++w) s += red[(w * 16 + b) * 64 + ln];
                MOD[((size_t)l * 16 + b) * 6144 + cb * 64 + ln] = s; }
            __syncthreads();
        }
    }
    __syncthreads();
    {
        float* ROPE = WSP(float, WS_ROPE);
        const double r16 = 0.44036660267178046;
        for (int idx = F.bid * 512 + tid; idx < T_TOK * 24; idx += F.G * 512) {
            const int t = idx / 24, i = idx % 24; const int e = (i < 16) ? i : 2 * (i - 16);
            double f = 1.0; for (int j = 0; j < e; ++j) f *= r16;
            float s, c; sincos_d((double)in_pos[t] * f, s, c);
            ROPE[(size_t)t * 48 + 2 * i] = c; ROPE[(size_t)t * 48 + 2 * i + 1] = s;
        }
    }
    {
        LAS float* scr = (LAS float*)(F.lds + wave * 16384);
        const int gw = F.bid * 8 + wave, NGW = F.G * 8;
        constexpr int I_IN = 16 * 200, I_UQ = 4 * 24, I_UKV = 4 * 32, I_WB = 8 * 32, I_WO = 16 * 32, I_W1 = 16 * 64, I_W2 = 16 * 32;
        constexpr int N_IN = 2 * I_IN, N_UQ = 2 * I_UQ, N_UKV = 2 * I_UKV, N_WB = 6 * I_WB, N_WO = 2 * I_WO, N_W1 = 64 * I_W1, N_W2 = 64 * I_W2;
        constexpr int NITEMS = N_IN + N_UQ + N_UKV + N_WB + N_WO;
        (void)N_W1; (void)N_W2;
        for (int it = gw; it < NITEMS; it += NGW) {
            int r = it;
            if (r < N_IN) { const int l = r / I_IN, q = r % I_IN, kb = q / 200, nb = q % 200;
                if (32 * nb < G1_F8_COLS) transpose_item_f8(KIN_w_in + (size_t)l * 1024 * IN_COLS, 1024, IN_COLS, WSP(unsigned char, WS_WIN) + (size_t)l * NP * 2048, 1024, scr, 64 * kb, 32 * nb, cmap_in(32 * nb + (lane & 31)), lane, 64.0f);
                else transpose_item(KIN_w_in + (size_t)l * 1024 * IN_COLS, 1024, IN_COLS, WSP(bf16_t, WS_WIN) + (size_t)l * NP * 1024, 1024, 0, scr, 64 * kb, 32 * nb, cmap_in(32 * nb + (lane & 31)), lane);
                continue; } r -= N_IN;
            if (r < N_UQ) { const int l = r / I_UQ, q = r % I_UQ, kb = q / 24, nb = q % 24;
                transpose_item(KIN_w_uq + (size_t)l * 256 * 768, 256, 768, WSP(bf16_t, WS_WUQ) + (size_t)l * 768 * 256, 256, 0, scr, 64 * kb, 32 * nb, cmap_uq(32 * nb + (lane & 31)), lane); continue; } r -= N_UQ;
            if (r < N_UKV) { const int l = r / I_UKV, q = r % I_UKV, kb = q / 32, nb = q % 32;
                transpose_item(KIN_w_ukv + (size_t)l * 128 * 1024, 128, 1024, WSP(bf16_t, WS_WUKV) + (size_t)l * 1024 * 256, 256, 0, scr, 64 * kb, 32 * nb, 32 * nb + (lane & 31), lane); continue; } r -= N_UKV;
            if (r < N_WB) { const int j = r / I_WB, q = r % I_WB, kb = q / 32, nb = q % 32;
                transpose_item(KIN_w_branch + (size_t)j * 512 * 1024, 512, 1024, WSP(bf16_t, WS_WB) + (size_t)j * 1024 * 512, 512, 0, scr, 64 * kb, 32 * nb, 32 * nb + (lane & 31), lane); continue; } r -= N_WB;
            if (r < N_WO) { const int l = r / I_WO, q = r % I_WO, kb = q / 32, nb = q % 32;
                transpose_item(KIN_w_out + (size_t)l * 1024 * 1024, 1024, 1024, WSP(bf16_t, WS_WOUT) + (size_t)l * 1024 * 1024, 1024, 0, scr, 64 * kb, 32 * nb, 32 * nb + (lane & 31), lane); continue; } r -= N_WO;
            (void)r;
        }
        convert_family_f8<true>(KIN_w1, WSP(unsigned char, WS_W1), 2048, 64, scr, gw, NGW, lane);
#if M2_F8
        convert_family_f8<false>(KIN_w2, WSP(unsigned char, WS_W2), 1024, 64, scr, gw, NGW, lane);
#else
        for (int it = gw; it < 64 * I_W2; it += NGW) { const int j = it / I_W2, q = it % I_W2, kb = q / 32, nb = q % 32;
            transpose_item(KIN_w2 + (size_t)j * 1024 * 1024, 1024, 1024, WSP(bf16_t, WS_W2) + (size_t)j * 1024 * 1024, 1024, 0, scr, 64 * kb, 32 * nb, 32 * nb + (lane & 31), lane); }
#endif
    }
}

DI void phase_norm(const Frame& F, const float* xin, float* xout, bool combine, bool write_x, bool final_, int lnext, int lcomb) {
    const int lane = F.lane, gw = F.bid * 8 + F.wave, NGW = F.G * 8;
    const float* in_fg = KIN_final_g; const float* in_n1 = KIN_norm1_g;
    const float* MOD = WSP(float, WS_MOD); const bf16_t* Y = WSP(bf16_t, WS_Y); const int* SLOTOF = (const int*)(F.ws + WS_ROUTE + RT_SLOTOF); bf16_t* H = WSP(bf16_t, WS_H);
    u32x4 slots = {0u, 0u, 0u, 0u};
    if (combine && gw < T_TOK) slots = *(const u32x4*)(SLOTOF + (size_t)gw * 4);
    for (int t = gw; t < T_TOK; t += NGW) {
        const int b = t >> 11; f32x4 v[4];
#pragma unroll
        for (int i = 0; i < 4; ++i) v[i] = *(const f32x4*)(xin + (size_t)t * 1024 + 4 * lane + 256 * i);
        if (combine) {
            const unsigned s0 = slots.x, s1 = slots.y, s2 = slots.z, s3 = slots.w;
            u32x2 ya[4], yb[4], yc[4], yd[4];
#pragma unroll
            for (int i = 0; i < 4; ++i) { const int co = 4 * lane + 256 * i;
                ya[i] = *(const u32x2*)(Y + (size_t)s0 * 1024 + co); yb[i] = *(const u32x2*)(Y + (size_t)s1 * 1024 + co); yc[i] = *(const u32x2*)(Y + (size_t)s2 * 1024 + co); yd[i] = *(const u32x2*)(Y + (size_t)s3 * 1024 + co); }
            if (t + NGW < T_TOK) slots = *(const u32x4*)(SLOTOF + (size_t)(t + NGW) * 4);
            const float* g2 = MOD + ((size_t)lcomb * 16 + b) * 6144 + 5 * 1024;
#pragma unroll
            for (int i = 0; i < 4; ++i) { const int co = 4 * lane + 256 * i; const u32x2 a = ya[i], bq = yb[i], cq = yc[i], dq = yd[i];
                f32x4 sum = {bf_lo(a.x) + bf_lo(bq.x) + bf_lo(cq.x) + bf_lo(dq.x), bf_hi(a.x) + bf_hi(bq.x) + bf_hi(cq.x) + bf_hi(dq.x),
                             bf_lo(a.y) + bf_lo(bq.y) + bf_lo(cq.y) + bf_lo(dq.y), bf_hi(a.y) + bf_hi(bq.y) + bf_hi(cq.y) + bf_hi(dq.y)};
                v[i] += *(const f32x4*)(g2 + co) * sum; }
            if (write_x) {
#pragma unroll
                for (int i = 0; i < 4; ++i) *(f32x4*)(xout + (size_t)t * 1024 + 4 * lane + 256 * i) = v[i]; }
        }
        float ss = 0.f;
#pragma unroll
        for (int i = 0; i < 4; ++i) ss += (v[i][0] * v[i][0] + v[i][1] * v[i][1]) + (v[i][2] * v[i][2] + v[i][3] * v[i][3]);
        ss = wave_sum(ss); const float r = 1.0f / sqrtf(ss * (1.0f / 1024.0f) + NORM_EPS);
        if (final_) {
#pragma unroll
            for (int i = 0; i < 4; ++i) { const int co = 4 * lane + 256 * i; *(f32x4*)(F.out + (size_t)t * 1024 + co) = v[i] * r * *(const f32x4*)(in_fg + co); }
        } else {
            const float* md = MOD + ((size_t)lnext * 16 + b) * 6144;
#pragma unroll
            for (int i = 0; i < 4; ++i) { const int co = 4 * lane + 256 * i;
                const f32x4 g = *(const f32x4*)(in_n1 + lnext * 1024 + co), sc = *(const f32x4*)(md + 1024 + co), sh = *(const f32x4*)(md + co);
                f32x4 h = v[i] * r * g * (sc + 1.0f) + sh;
                u32x2 w; w.x = pk2(h[0], h[1]); w.y = pk2(h[2], h[3]);
                *(u32x2*)(H + (size_t)t * 1024 + co) = w;
#if HG8_TILED
                *(unsigned*)(WSP(unsigned char, WS_HG8) + (size_t)(t >> 8) * 262144 + (size_t)(co >> 7) * 32768 + (t & 255) * 128 + (co & 127)) = pk4_fp8(h[0], h[1], h[2], h[3]);
#else
                *(unsigned*)(WSP(unsigned char, WS_HG8) + (size_t)t * 1024 + co) = pk4_fp8(h[0], h[1], h[2], h[3]);
#endif
                }
        }
    }
}
DI u32x4 rope8v(u32x4 a, f32x4 c0, f32x4 c1) {
    u32x4 o;
    { const float x1 = bf_lo(a.x), x2 = bf_hi(a.x); o.x = pk2(x1 * c0[0] - x2 * c0[1], x2 * c0[0] + x1 * c0[1]); }
    { const float x1 = bf_lo(a.y), x2 = bf_hi(a.y); o.y = pk2(x1 * c0[2] - x2 * c0[3], x2 * c0[2] + x1 * c0[3]); }
    { const float x1 = bf_lo(a.z), x2 = bf_hi(a.z); o.z = pk2(x1 * c1[0] - x2 * c1[1], x2 * c1[0] + x1 * c1[1]); }
    { const float x1 = bf_lo(a.w), x2 = bf_hi(a.w); o.w = pk2(x1 * c1[2] - x2 * c1[3], x2 * c1[2] + x1 * c1[3]); }
    return o;
}
DI u32x4 rope8(u32x4 a, const float* cs) { return rope8v(a, *(const f32x4*)cs, *(const f32x4*)(cs + 4)); }
DI void unpack8(u32x4 a, float (&v)[8]) { v[0] = bf_lo(a.x); v[1] = bf_hi(a.x); v[2] = bf_lo(a.y); v[3] = bf_hi(a.y); v[4] = bf_lo(a.z); v[5] = bf_hi(a.z); v[6] = bf_lo(a.w); v[7] = bf_hi(a.w); }
DI void phase_post(const Frame& F, int l) {
    const int lane = F.lane, gw = F.bid * 8 + F.wave, NGW = F.G * 8;
    const bf16_t* P = WSP(bf16_t, WS_P); const float* ROPE = WSP(float, WS_ROPE);
    bf16_t *CQ = WSP(bf16_t, WS_CQ), *CKV = WSP(bf16_t, WS_CKV), *KPE = WSP(bf16_t, WS_KPE), *OB = WSP(bf16_t, WS_O3) + (size_t)T_TOK * 512, *QC = WSP(bf16_t, WS_QC), *KC = WSP(bf16_t, WS_KC),
           *VC = WSP(bf16_t, WS_VC), *QI = WSP(bf16_t, WS_QI), *KI = WSP(bf16_t, WS_KI); float* IW = WSP(float, WS_IW);
    const float* cw = KIN_conv_w + (size_t)l * 3 * 512 + 8 * lane;
    f32x4 cwv[3][2];
#pragma unroll
    for (int d = 0; d < 3; ++d) { cwv[d][0] = *(const f32x4*)(cw + d * 512); cwv[d][1] = *(const f32x4*)(cw + d * 512 + 4); }
    const float* in_qn = KIN_q_norm + l * 256 + 8 * (lane & 31); const float* in_kn = KIN_kv_norm + l * 128 + 8 * (lane & 15);
    const f32x4 qn0 = *(const f32x4*)in_qn, qn1 = *(const f32x4*)(in_qn + 4), kn0 = *(const f32x4*)in_kn, kn1 = *(const f32x4*)(in_kn + 4);
    const u32x4 z4 = {0u, 0u, 0u, 0u};
    for (int t = gw; t < T_TOK; t += NGW) {
        const bf16_t* pr = P + (size_t)t * NP; const float* rp = ROPE + (size_t)t * 48; const int s = t & (SEQ - 1);
        const bf16_t* pc = pr + PC_CONV + 8 * lane;
        const u32x4 gbw = *(const u32x4*)pc;
        const u32x4 gc2 = *(const u32x4*)(pc + 512), hc2 = *(const u32x4*)(pc + 1024);
        const u32x4 gc1 = (s >= 1) ? *(const u32x4*)(pc - NP + 512) : z4, hc1 = (s >= 1) ? *(const u32x4*)(pc - NP + 1024) : z4;
        const u32x4 gc0 = (s >= 2) ? *(const u32x4*)(pc - 2 * NP + 512) : z4, hc0 = (s >= 2) ? *(const u32x4*)(pc - 2 * NP + 1024) : z4;
        u32x4 dqw = *(const u32x4*)(pr + PC_DQ + 8 * lane), iqw = *(const u32x4*)(pr + PC_IQ + 8 * lane);
        const u32x4 qlw = *(const u32x4*)(pr + PC_QLAT + 8 * (lane & 31));
        const u32x4 kvw = *(const u32x4*)(pr + PC_KVLAT + 8 * (lane < 20 ? lane : 0));
        u32x4 dkw = *(const u32x4*)(pr + PC_DKV + 8 * (lane & 15));
        u32x4 ikw = *(const u32x4*)(pr + PC_IK + 8 * (lane & 7));
        const u32x4 iww = *(const u32x4*)(pr + PC_IW);
        const f32x4 r16a = *(const f32x4*)(rp + 32 + 8 * (lane & 1)), r16b = *(const f32x4*)(rp + 32 + 8 * (lane & 1) + 4);
        const f32x4 r32a = *(const f32x4*)(rp + 8 * (lane & 3)), r32b = *(const f32x4*)(rp + 8 * (lane & 3) + 4);
        asm volatile("" ::: "memory");
        {
            float gb[8], a0[8], b0[8], a1[8], b1[8], a2[8], b2[8]; unpack8(gbw, gb); unpack8(gc0, a0); unpack8(hc0, b0); unpack8(gc1, a1); unpack8(hc1, b1); unpack8(gc2, a2); unpack8(hc2, b2);
            float o[8];
#pragma unroll
            for (int i = 0; i < 8; ++i) { const float w0 = cwv[0][i >> 2][i & 3], w1 = cwv[1][i >> 2][i & 3], w2 = cwv[2][i >> 2][i & 3]; o[i] = gb[i] * (w0 * (a0[i] * b0[i]) + w1 * (a1[i] * b1[i]) + w2 * (a2[i] * b2[i])); }
            u32x4 ow; ow.x = pk2(o[0], o[1]); ow.y = pk2(o[2], o[3]); ow.z = pk2(o[4], o[5]); ow.w = pk2(o[6], o[7]);
            *(u32x4*)(OB + (size_t)t * 512 + 8 * lane) = ow;
        }
        if ((lane & 7) < 2) { dqw = rope8v(dqw, r16a, r16b); iqw = rope8v(iqw, r16a, r16b); }
        *(u32x4*)(QC + (size_t)t * 512 + 8 * lane) = dqw; *(u32x4*)(QI + (size_t)t * 512 + 8 * lane) = iqw;
        float ql[8], kv[8]; unpack8(qlw, ql); unpack8(kvw, kv);
        float ss1 = 0.f, ss2 = 0.f;
        if (lane < 32) {
#pragma unroll
            for (int i = 0; i < 8; ++i) ss1 += ql[i] * ql[i]; }
        if (lane < 16) {
#pragma unroll
            for (int i = 0; i < 8; ++i) ss2 += kv[i] * kv[i]; }
#pragma unroll
        for (int o = 1; o < 64; o <<= 1) { ss1 += __shfl_xor(ss1, o); ss2 += __shfl_xor(ss2, o); }
        const float r1 = 1.0f / sqrtf(ss1 * (1.0f / 256.0f) + NORM_EPS), r2 = 1.0f / sqrtf(ss2 * (1.0f / 128.0f) + NORM_EPS);
        if (lane < 32) { u32x4 o; o.x = pk2(ql[0] * r1 * qn0[0], ql[1] * r1 * qn0[1]); o.y = pk2(ql[2] * r1 * qn0[2], ql[3] * r1 * qn0[3]); o.z = pk2(ql[4] * r1 * qn1[0], ql[5] * r1 * qn1[1]); o.w = pk2(ql[6] * r1 * qn1[2], ql[7] * r1 * qn1[3]);
            *(u32x4*)(CQ + (size_t)t * 256 + 8 * lane) = o;
            u32x4 k = z4; if (lane < 16) { k.x = pk2(kv[0] * r2 * kn0[0], kv[1] * r2 * kn0[1]); k.y = pk2(kv[2] * r2 * kn0[2], kv[3] * r2 * kn0[3]); k.z = pk2(kv[4] * r2 * kn1[0], kv[5] * r2 * kn1[1]); k.w = pk2(kv[6] * r2 * kn1[2], kv[7] * r2 * kn1[3]); }
            *(u32x4*)(CKV + (size_t)t * 256 + 8 * lane) = k; }
        if (lane >= 16 && lane < 20) *(u32x4*)(KPE + (size_t)t * 32 + 8 * (lane - 16)) = rope8v(kvw, r32a, r32b);
        if (lane < 16) { if (lane < 2) dkw = rope8v(dkw, r16a, r16b); if (lane < 8) *(u32x4*)(KC + (size_t)t * 64 + 8 * lane) = dkw; else *(u32x4*)(VC + (size_t)t * 64 + 8 * (lane - 8)) = dkw; }
        if (lane >= 16 && lane < 24) { const int c = lane - 16; if (c < 2) ikw = rope8v(ikw, r16a, r16b); *(u32x4*)(KI + (size_t)t * 64 + 8 * c) = ikw; }
        if (lane == 32) { float v[8]; unpack8(iww, v); *(f32x4*)(IW + (size_t)t * 8) = (f32x4){v[0], v[1], v[2], v[3]}; *(f32x4*)(IW + (size_t)t * 8 + 4) = (f32x4){v[4], v[5], v[6], v[7]}; }
    }
}

DI int crow(int r, int hi) { return (r & 3) + 8 * (r >> 2) + 4 * hi; }
DI float max3f(float a, float b, float c) { float r; asm("v_max3_f32 %0, %1, %2, %3" : "=v"(r) : "v"(a), "v"(b), "v"(c)); return r; }
template <int C> DI unsigned bit_mask(unsigned w) { unsigned r; asm("v_bfe_i32 %0, %1, %2, 1" : "=v"(r) : "v"(w), "n"(C)); return r; }
#define MFMA32(a, b, c) __builtin_amdgcn_mfma_f32_32x32x16_bf16((a), (b), (c), 0, 0, 0)
#define MFMA16(a, b, c) __builtin_amdgcn_mfma_f32_16x16x32_bf16((a), (b), (c), 0, 0, 0)
#define GLDS16(src, dst) __builtin_amdgcn_global_load_lds((const unsigned*)(src), (LAS unsigned*)(dst), 16, 0, 0)
typedef short v4i16_t __attribute__((ext_vector_type(4)));
DI s16x4 tr_read(const LAS unsigned char* p) { return __builtin_bit_cast(s16x4, __builtin_amdgcn_ds_read_tr16_b64_v4i16((LAS v4i16_t*)p)); }
DI bf16x8 pack8(float a0, float a1, float a2, float a3, float a4, float a5, float a6, float a7) { u32x4 w; w.x = pk2(a0, a1); w.y = pk2(a2, a3); w.z = pk2(a4, a5); w.w = pk2(a6, a7); return __builtin_bit_cast(bf16x8, w); }
DI bf16x8 cat4(s16x4 lo, s16x4 hi) { return (bf16x8){lo[0], lo[1], lo[2], lo[3], hi[0], hi[1], hi[2], hi[3]}; }

constexpr int MLA_K0 = 0, MLA_V0 = 24576, MLA_WS = 49152;
DI void mla_unit(const Frame& F, int b, int h, int qb) {
    const int lane = F.lane, wid = F.wave, r32 = lane & 31, hi = lane >> 5;
    const bf16_t* QA = WSP(bf16_t, WS_QA); const bf16_t* KPE = WSP(bf16_t, WS_KPE); const bf16_t* KV = WSP(bf16_t, WS_KV); bf16_t* OA = WSP(bf16_t, WS_O3);
    const size_t tb = (size_t)b * SEQ; const int q0 = qb * 256, qrow = q0 + 32 * wid + r32;
    const float C2 = 0.10206207261596577f * 1.4426950408889634f;
    LAS unsigned char* lds = F.lds; LAS float* wsf = (LAS float*)(lds + MLA_WS) + wid * 128;
    bf16x8 qr[6];
#pragma unroll
    for (int d0 = 0; d0 < 6; ++d0) qr[d0] = *(const bf16x8*)(QA + (tb + qrow) * 768 + h * 96 + d0 * 16 + hi * 8);
    {
        const float* rp = WSP(float, WS_ROPE) + (tb + qrow) * 48;
        qr[0] = __builtin_bit_cast(bf16x8, rope8(__builtin_bit_cast(u32x4, qr[0]), rp + 8 * hi));
        qr[1] = __builtin_bit_cast(bf16x8, rope8(__builtin_bit_cast(u32x4, qr[1]), rp + 16 + 8 * hi)); }
    const int NT = 4 * (qb + 1);
    const unsigned vo_pe = (unsigned)(lane * 32 + 8 * (wid & 3)) * 2u, vo_k0 = (unsigned)(lane * 1024 + 128 * h + 8 * ((wid + 4) & 7)) * 2u, vo_k1 = (unsigned)(lane * 1024 + 128 * h + 8 * (wid + 4)) * 2u,
                   vo_v = (unsigned)((16 * (wid & 3) + (lane >> 2)) * 1024 + 128 * h + 64 + 32 * (wid >> 2) + 8 * (lane & 3)) * 2u;
    const unsigned ldsb = (unsigned)(unsigned long long)lds;
    const char* pe_b = pg8::uni_ptr((const char*)(KPE + tb * 32)); const char* kv_b = pg8::uni_ptr((const char*)(KV + tb * 1024));
#define MLA_STAGE(kt, buf, vslot) do { const char* pe_ = pe_b + (size_t)(kt) * (64 * 32 * 2); const char* kv_ = kv_b + (size_t)(kt) * (64 * 1024 * 2); \
        if (wid < 4) { pg8::glds16_s(vo_pe, pe_, ldsb + MLA_K0 + (buf) * 12288 + wid * 1024); pg8::glds16_s(vo_k1, kv_, ldsb + MLA_K0 + (buf) * 12288 + (wid + 8) * 1024); } \
        else { pg8::glds16_s(vo_k0, kv_, ldsb + MLA_K0 + (buf) * 12288 + wid * 1024); } \
        pg8::glds16_s(vo_v, kv_, ldsb + MLA_V0 + (vslot) * 8192 + wid * 1024); } while (0)
    MLA_STAGE(0, 0, 0);
    float m = -1e30f; f32x16 o[2], lacc;
#pragma unroll
    for (int r = 0; r < 16; ++r) { o[0][r] = 0.f; o[1][r] = 0.f; lacc[r] = 0.f; }
    const bf16x8 ones8 = {(short)0x3f80, (short)0x3f80, (short)0x3f80, (short)0x3f80, (short)0x3f80, (short)0x3f80, (short)0x3f80, (short)0x3f80};
    const int vboff = ((lane >> 4) & 1) * 32 + (lane & 3) * 8 + (4 * hi + ((lane & 15) >> 2)) * 64;
    const bool upper = wid >= 4; bool have_prev = false; bf16x8 pa[4];
#define MLA_PV(vs) do { const LAS unsigned char* vb_ = lds + MLA_V0 + (vs) * 8192 + vboff; \
        _Pragma("unroll") for (int d0 = 0; d0 < 2; ++d0) _Pragma("unroll") for (int ks = 0; ks < 4; ++ks) { \
            const s16x4 lo_ = tr_read(vb_ + d0 * 4096 + ks * 1024), hh_ = tr_read(vb_ + d0 * 4096 + ks * 1024 + 512); o[d0] = MFMA32(pa[ks], cat4(lo_, hh_), o[d0]); } \
        _Pragma("unroll") for (int ks = 0; ks < 4; ++ks) lacc = MFMA32(pa[ks], ones8, lacc); } while (0)
    int vs_cur = 0, vs_prev = 0;
    for (int kt = 0; kt < NT; ++kt) {
        const int buf = kt & 1; const int vs_next = (vs_cur == 2) ? 0 : vs_cur + 1;
        VM_WAIT(); __syncthreads();
        if (kt + 1 < NT) MLA_STAGE(kt + 1, buf ^ 1, vs_next);
        if (upper && have_prev) { MLA_PV(vs_prev); have_prev = false; }
        if (64 * kt <= q0 + 32 * wid + 31) {
            f32x16 p0, p1;
#pragma unroll
            for (int r = 0; r < 16; ++r) { p0[r] = 0.f; p1[r] = 0.f; }
            const LAS unsigned char* kb = lds + MLA_K0 + buf * 12288 + hi * 1024 + r32 * 16;
#pragma unroll
            for (int d0 = 0; d0 < 6; ++d0) { const bf16x8 b0 = *(const LAS bf16x8*)(kb + d0 * 2048), b1 = *(const LAS bf16x8*)(kb + d0 * 2048 + 512);
                p0 = MFMA32(b0, qr[d0], p0); p1 = MFMA32(b1, qr[d0], p1); }
            if (64 * kt + 63 > q0 + 32 * wid) {
#pragma unroll
                for (int r = 0; r < 16; ++r) { const int kv = 64 * kt + crow(r, hi); if (kv > qrow) p0[r] = -INFINITY; if (kv + 32 > qrow) p1[r] = -INFINITY; } }
            float rm = fmaxf(p0[0], p1[0]);
#pragma unroll
            for (int r = 1; r < 16; ++r) rm = max3f(rm, p0[r], p1[r]);
            rm = fmaxf(rm, __shfl_xor(rm, 32));
            const float mn = fmaxf(m, rm);
            if (__any(mn > m)) {
                const float alpha = __builtin_amdgcn_exp2f((m - mn) * C2); m = mn;
                if (hi == 0) wsf[r32] = alpha;
                LDS_WAIT();
#pragma unroll
                for (int q = 0; q < 4; ++q) { const f32x4 a = *(const LAS f32x4*)(wsf + 8 * q + 4 * hi);
#pragma unroll
                    for (int j = 0; j < 4; ++j) { o[0][4 * q + j] *= a[j]; o[1][4 * q + j] *= a[j]; lacc[4 * q + j] *= a[j]; } }
            }
            const float mc = m * C2;
#pragma unroll
            for (int r = 0; r < 16; ++r) { p0[r] = __builtin_amdgcn_exp2f(__builtin_fmaf(p0[r], C2, -mc)); p1[r] = __builtin_amdgcn_exp2f(__builtin_fmaf(p1[r], C2, -mc)); }
            pa[0] = pack8(p0[0], p0[1], p0[2], p0[3], p0[4], p0[5], p0[6], p0[7]); pa[1] = pack8(p0[8], p0[9], p0[10], p0[11], p0[12], p0[13], p0[14], p0[15]);
            pa[2] = pack8(p1[0], p1[1], p1[2], p1[3], p1[4], p1[5], p1[6], p1[7]); pa[3] = pack8(p1[8], p1[9], p1[10], p1[11], p1[12], p1[13], p1[14], p1[15]);
            if (upper) have_prev = true; else MLA_PV(vs_cur);
        }
        vs_prev = vs_cur; vs_cur = vs_next;
    }
    if (upper && have_prev) MLA_PV(vs_prev);
#undef MLA_PV
#undef MLA_STAGE
    bf16_t* orow = OA + (tb + q0 + 32 * wid) * 512 + h * 64 + r32;
#pragma unroll
    for (int r = 0; r < 16; ++r) { const int rr = crow(r, hi); const float a = __builtin_amdgcn_rcpf(lacc[r]);
        orow[(size_t)rr * 512] = (bf16_t)(pk2(o[0][r] * a, 0.f) & 0xffffu); orow[(size_t)rr * 512 + 32] = (bf16_t)(pk2(o[1][r] * a, 0.f) & 0xffffu); }
    __syncthreads();
}

constexpr int DSA_SCW = 2052;
constexpr int DSA_SEL = 16 * DSA_SCW * 4;
constexpr int DSA_CAND = DSA_SEL + 4096;
template <int CTRL> DI float dpp_f(float x) { return __uint_as_float((unsigned)__builtin_amdgcn_update_dpp(0, (int)__float_as_uint(x), CTRL, 0xf, 0xf, false)); }
DI float rl_f(float x, int l) { return __uint_as_float((unsigned)__builtin_amdgcn_readlane((int)__float_as_uint(x), l)); }
DI float wave_sum_dpp(float x) { x += dpp_f<0x128>(x); x += dpp_f<0x124>(x); x += dpp_f<0x122>(x); x += dpp_f<0x121>(x); return (rl_f(x, 0) + rl_f(x, 16)) + (rl_f(x, 32) + rl_f(x, 48)); }
DI float wave_max_dpp(float x) { x = fmaxf(x, dpp_f<0x128>(x)); x = fmaxf(x, dpp_f<0x124>(x)); x = fmaxf(x, dpp_f<0x122>(x)); x = fmaxf(x, dpp_f<0x121>(x)); return fmaxf(fmaxf(rl_f(x, 0), rl_f(x, 16)), fmaxf(rl_f(x, 32), rl_f(x, 48))); }
DI int mbcnt64(unsigned long long m) { return (int)__builtin_amdgcn_mbcnt_hi((unsigned)(m >> 32), __builtin_amdgcn_mbcnt_lo((unsigned)m, 0u)); }
DI void dsa_unit(const Frame& F, int b, int qt) {
    const int tid = F.tid, lane = F.lane, wid = F.wave, fr = lane & 15, g = lane >> 4;
    const bf16_t *QI = WSP(bf16_t, WS_QI), *KI = WSP(bf16_t, WS_KI), *QC = WSP(bf16_t, WS_QC), *KC = WSP(bf16_t, WS_KC), *VC = WSP(bf16_t, WS_VC); const float* IW = WSP(float, WS_IW);
    bf16_t* OC = WSP(bf16_t, WS_O3) + (size_t)2 * T_TOK * 512;
    const size_t tb = (size_t)b * SEQ; const int t0 = 16 * qt;
    LAS unsigned char* lds = F.lds; LAS float* SC = (LAS float*)lds; LAS unsigned long long* BITS = (LAS unsigned long long*)(lds + DSA_SEL);
#ifdef PROBE_S1DUP
    for (int rep1_ = 0; rep1_ < PROBE_S1DUP; ++rep1_)
#endif
    {
        bf16x8 qf[8][2]; float wv[8];
        const bf16_t* qp = QI + (tb + t0 + fr) * 512 + 8 * g;
#pragma unroll
        for (int h = 0; h < 8; ++h) { qf[h][0] = *(const bf16x8*)(qp + h * 64); qf[h][1] = *(const bf16x8*)(qp + h * 64 + 32); }
        { const f32x4 w0 = *(const f32x4*)(IW + (tb + t0 + fr) * 8), w1 = *(const f32x4*)(IW + (tb + t0 + fr) * 8 + 4); wv[0] = w0[0]; wv[1] = w0[1]; wv[2] = w0[2]; wv[3] = w0[3]; wv[4] = w1[0]; wv[5] = w1[1]; wv[6] = w1[2]; wv[7] = w1[3]; }
        const bf16_t* kbase = KI + (tb + fr) * 64 + 8 * g;
        const bf16x8 z8 = {0, 0, 0, 0, 0, 0, 0, 0};
        bf16x8 a0 = z8, a1 = z8, b0 = z8, b1 = z8, c0 = z8, c1 = z8;
        if (wid <= qt) { a0 = *(const bf16x8*)(kbase + (size_t)wid * 1024); a1 = *(const bf16x8*)(kbase + (size_t)wid * 1024 + 32); }
        if (wid + 8 <= qt) { b0 = *(const bf16x8*)(kbase + (size_t)(wid + 8) * 1024); b1 = *(const bf16x8*)(kbase + (size_t)(wid + 8) * 1024 + 32); }
        if (wid + 16 <= qt) { c0 = *(const bf16x8*)(kbase + (size_t)(wid + 16) * 1024); c1 = *(const bf16x8*)(kbase + (size_t)(wid + 16) * 1024 + 32); }
        for (int kt = wid; kt <= qt; kt += 8) {
            bf16x8 n0 = z8, n1 = z8;
            if (kt + 24 <= qt) { n0 = *(const bf16x8*)(kbase + (size_t)(kt + 24) * 1024); n1 = *(const bf16x8*)(kbase + (size_t)(kt + 24) * 1024 + 32); }
            f32x4 s = {F.zf, F.zf, F.zf, F.zf};
#pragma unroll
            for (int h = 0; h < 8; ++h) { f32x4 acc = {F.zf, F.zf, F.zf, F.zf}; acc = MFMA16(a0, qf[h][0], acc); acc = MFMA16(a1, qf[h][1], acc);
#pragma unroll
                for (int r = 0; r < 4; ++r) s[r] += fmaxf(acc[r], 0.f) * wv[h]; }
#pragma unroll
            for (int r = 0; r < 4; ++r) if (16 * kt + 4 * g + r > t0 + fr) s[r] = -INFINITY;
            *(LAS f32x4*)(SC + fr * DSA_SCW + 16 * kt + 4 * g) = s;
            a0 = b0; a1 = b1; b0 = c0; b1 = c1; c0 = n0; c1 = n1;
        }
    }
    __syncthreads();
    for (int qi2 = 0; qi2 < 2; ++qi2) {
        const int qq = 2 * wid + qi2, t = t0 + qq, nvalid = t + 1;
        LAS unsigned long long* bits = BITS + qq * 32;
        if (nvalid <= 256) { if (lane < 32) { const int k0 = 64 * lane; bits[lane] = (k0 + 63 <= t) ? ~0ull : (k0 <= t) ? ((1ull << (t - k0 + 1)) - 1ull) : 0ull; } }
        else {
            const int nq = (nvalid + 511) >> 9;
            float v[32];
#pragma unroll
            for (int i = 0; i < 32; ++i) { const int key = i * 64 + lane; v[i] = (key <= t) ? SC[qq * DSA_SCW + key] : -INFINITY; }
#define DSA_CMP_ge(m_, x_, t_) asm("v_cmp_ge_f32_e64 %0, %1, %2" : "=s"(m_) : "v"(x_), "v"(t_))
#define DSA_CMP_gt(m_, x_, t_) asm("v_cmp_gt_f32_e64 %0, %1, %2" : "=s"(m_) : "v"(x_), "v"(t_))
#define DSA_COUNT(thr, OPN, out) do { int tot_ = 0; const float thr_ = (thr); _Pragma("unroll") for (int qd = 0; qd < 4; ++qd) { if (qd < nq) { unsigned long long m_[8]; \
                _Pragma("unroll") for (int i = 0; i < 8; ++i) DSA_CMP_##OPN(m_[i], v[8 * qd + i], thr_); __builtin_amdgcn_sched_barrier(0); _Pragma("unroll") for (int i = 0; i < 8; ++i) tot_ += __builtin_popcountll(m_[i]); __builtin_amdgcn_sched_barrier(0); } } out = tot_; } while (0)
            float lo = 0.f, hi = 0.f, K = 0.f; int cnt = 0, clo = nvalid, chi = 0; bool done = false, have_lo = false, have_hi = false;
            if (nvalid >= 512) {
                float a1 = -INFINITY, a2 = -INFINITY, a3 = -INFINITY, a4 = -INFINITY, a5 = -INFINITY;
#pragma unroll
                for (int qd = 0; qd < 4; ++qd) { if (qd < nq) {
#pragma unroll
                    for (int i = 0; i < 8; ++i) { const float x = v[8 * qd + i];
                        const float n5 = __builtin_amdgcn_fmed3f(a4, a5, x), n4 = __builtin_amdgcn_fmed3f(a3, a4, x), n3 = __builtin_amdgcn_fmed3f(a2, a3, x), n2 = __builtin_amdgcn_fmed3f(a1, a2, x);
                        a1 = fmaxf(a1, x); a2 = n2; a3 = n3; a4 = n4; a5 = n5; } } }
                const float m3 = wave_sum_dpp(a3) * (1.0f / 64.0f), m4 = wave_sum_dpp(a4) * (1.0f / 64.0f), m5 = wave_sum_dpp(a5) * (1.0f / 64.0f);
                int c5; DSA_COUNT(m5, ge, c5);
                if (c5 == 256) { K = m5; cnt = 256; done = true; }
                else if (c5 < 256) { hi = m5; chi = c5; have_hi = true; }
                else { lo = m5; clo = c5; have_lo = true;
                    int c4; DSA_COUNT(m4, ge, c4);
                    if (c4 == 256) { K = m4; cnt = 256; done = true; }
                    else if (c4 < 256) { hi = m4; chi = c4; have_hi = true; }
                    else { lo = m4; clo = c4;
                        int c3; DSA_COUNT(m3, ge, c3);
                        if (c3 == 256) { K = m3; cnt = 256; done = true; }
                        else if (c3 < 256) { hi = m3; chi = c3; have_hi = true; }
                        else { lo = m3; clo = c3; } } }
            }
            if (!done && !(have_lo && have_hi)) {
                float vmax = v[0], vmin = (v[0] == -INFINITY) ? INFINITY : v[0];
#pragma unroll
                for (int i = 1; i < 32; ++i) { vmax = fmaxf(vmax, v[i]); vmin = fminf(vmin, (v[i] == -INFINITY) ? INFINITY : v[i]); }
                vmax = wave_max_dpp(vmax); vmin = -wave_max_dpp(-vmin);
                if (!have_hi) { hi = vmax; DSA_COUNT(hi, ge, cnt); if (cnt >= 256) { K = hi; done = true; } else chi = cnt; }
                if (!have_lo) { lo = vmin; clo = nvalid; }
            }
            if (!done)
            for (int it = 0;; ++it) {
                if (clo - chi <= 64) {
                    LAS float* cand = (LAS float*)(lds + DSA_CAND) + wid * 64;
                    cand[lane] = -INFINITY;
                    int base = 0;
#pragma unroll
                    for (int qd = 0; qd < 4; ++qd) { if (qd < nq) {
#pragma unroll
                        for (int i = 0; i < 8; ++i) { const float x = v[8 * qd + i]; const bool c = (x >= lo) && (x < hi); const unsigned long long m = __ballot(c);
                            if (c) cand[base + mbcnt64(m)] = x;
                            base += __builtin_popcountll(m); } } }
                    const float cv = cand[lane]; const int need = 256 - chi; int ge = 0;
                    for (int k = 0; k < base; ++k) { const float ck = __uint_as_float((unsigned)__builtin_amdgcn_readlane((int)__float_as_uint(cv), k)); ge += (ck >= cv) ? 1 : 0; }
                    K = wave_max_dpp((ge >= need) ? cv : -INFINITY); DSA_COUNT(K, ge, cnt);
                    break;
                }
                float fr_ = 0.5f;
                if ((it & 1) == 0) { fr_ = ((float)(clo - 256) + 0.5f) * __builtin_amdgcn_rcpf((float)(clo - chi)); fr_ = fminf(fmaxf(fr_, 0.03125f), 0.96875f); }
                const float mid = lo + (hi - lo) * fr_;
                if (!(mid > lo && mid < hi)) {
                    const float mid2 = lo + (hi - lo) * 0.5f;
                    if (!(mid2 > lo && mid2 < hi)) { K = lo; cnt = clo; break; }
                    DSA_COUNT(mid2, ge, cnt);
                    if (cnt == 256) { K = mid2; break; }
                    if (cnt > 256) { lo = mid2; clo = cnt; } else { hi = mid2; chi = cnt; }
                    continue;
                }
                DSA_COUNT(mid, ge, cnt);
                if (cnt == 256) { K = mid; break; }
                if (cnt > 256) { lo = mid; clo = cnt; } else { hi = mid; chi = cnt; }
            }
            if (cnt == 256) {
#pragma unroll
                for (int qd = 0; qd < 4; ++qd) {
#pragma unroll
                    for (int i8 = 0; i8 < 8; ++i8) { const int i = 8 * qd + i8; const unsigned long long mt = (qd < nq) ? __ballot(v[i] >= K) : 0ull; if (lane == 0) bits[i] = mt; } }
            } else {
                int cgt; DSA_COUNT(K, gt, cgt);
                const int need = 256 - cgt; int eqb = 0;
#pragma unroll
                for (int qd = 0; qd < 4; ++qd) {
#pragma unroll
                    for (int i8 = 0; i8 < 8; ++i8) { const int i = 8 * qd + i8; unsigned long long mt = 0ull;
                        if (qd < nq) { const bool gt = v[i] > K, eq = v[i] == K; const unsigned long long me = __ballot(eq); const int erank = eqb + mbcnt64(me);
                            mt = __ballot(gt || (eq && erank < need)); eqb += __builtin_popcountll(me); }
                        if (lane == 0) bits[i] = mt; } }
            }
#undef DSA_COUNT
#undef DSA_CMP_ge
#undef DSA_CMP_gt
        }
    }
    __syncthreads();
#ifdef PROBE_S3DUP
    for (int rep3_ = 0; rep3_ < PROBE_S3DUP; ++rep3_) { if (rep3_) __syncthreads();
#endif
    {
        const float C2S = 0.125f * 1.4426950408889634f;
        int lane3 = lane; asm volatile("" : "+v"(lane3));
        const int r32 = lane3 & 31, hi = lane3 >> 5, cg = wid & 3, kp = wid >> 2;
        const int NT = (t0 + 16 + 63) >> 6, NS = (NT + 1) >> 1;
        const int qloc = 4 * cg + (r32 >> 3);
        LAS float* wsf = (LAS float*)(lds + 98304) + wid * 128;
        LAS float* OW = (LAS float*)lds; LAS float* ML2 = (LAS float*)(lds + 102400);
        bf16x8 qr[4];
#pragma unroll
        for (int d0 = 0; d0 < 4; ++d0) qr[d0] = *(const bf16x8*)(QC + (tb + t0 + qloc) * 512 + (r32 & 7) * 64 + d0 * 16 + hi * 8);
        const unsigned vo_kc = (unsigned)(lane3 * 64 + 8 * wid) * 2u, vo_vc = (unsigned)((16 * (wid & 3) + (lane3 >> 2)) * 64 + 32 * (wid >> 2) + 8 * (lane3 & 3)) * 2u, ldsb = (unsigned)(unsigned long long)lds;
        const char* kc_b = pg8::uni_ptr((const char*)(KC + tb * 64)); const char* vc_b = pg8::uni_ptr((const char*)(VC + tb * 64));
#define DSD_STAGE(j, buf) do { _Pragma("unroll") for (int par_ = 0; par_ < 2; ++par_) { int kt_ = 2 * (j) + par_; kt_ = kt_ < NT ? kt_ : NT - 1; \
            const unsigned d_ = ldsb + (buf) * 32768 + par_ * 16384; \
            pg8::glds16_s(vo_kc, kc_b + (size_t)kt_ * (64 * 64 * 2), d_ + wid * 1024); pg8::glds16_s(vo_vc, vc_b + (size_t)kt_ * (64 * 64 * 2), d_ + 8192 + wid * 1024); } } while (0)
        DSD_STAGE(0, 0);
        if (NS > 1) DSD_STAGE(1, 1);
        float m = -1e30f, l = 0.f; f32x16 o[2];
#pragma unroll
        for (int r = 0; r < 16; ++r) { o[0][r] = F.zf; o[1][r] = F.zf; }
        const int vboff = ((lane3 >> 4) & 1) * 32 + (lane3 & 3) * 8 + (4 * hi + ((lane3 & 15) >> 2)) * 64;
        int buf = 0, bufn = 2;
        for (int j = 0; j < NS; ++j) {
            const int kt = 2 * j + kp;
            if (j + 1 < NS) asm volatile("s_waitcnt vmcnt(4)" ::: "memory"); else VM_WAIT();
            __syncthreads();
            if (j + 2 < NS) DSD_STAGE(j + 2, bufn);
            if (kt < NT) {
                const LAS unsigned char* tile = lds + buf * 32768 + kp * 16384;
                f32x16 p0, p1;
#pragma unroll
                for (int r = 0; r < 16; ++r) { p0[r] = F.zf; p1[r] = F.zf; }
                const LAS unsigned char* kb = tile + hi * 1024 + r32 * 16;
#pragma unroll
                for (int d0 = 0; d0 < 4; ++d0) { const bf16x8 b0 = *(const LAS bf16x8*)(kb + d0 * 2048), b1 = *(const LAS bf16x8*)(kb + d0 * 2048 + 512);
                    p0 = MFMA32(b0, qr[d0], p0); p1 = MFMA32(b1, qr[d0], p1); }
                float rm = fmaxf(p0[0], p1[0]);
#pragma unroll
                for (int r = 1; r < 16; ++r) rm = max3f(rm, p0[r], p1[r]);
                rm = fmaxf(rm, __shfl_xor(rm, 32));
                const float mn = fmaxf(m, rm);
                if (__any(mn > m)) {
                    const float alpha = __builtin_amdgcn_exp2f((m - mn) * C2S); l *= alpha; m = mn;
                    if (hi == 0) wsf[r32] = alpha;
                    LDS_WAIT();
#pragma unroll
                    for (int q = 0; q < 4; ++q) { const f32x4 a = *(const LAS f32x4*)(wsf + 8 * q + 4 * hi);
#pragma unroll
                        for (int jj = 0; jj < 4; ++jj) { o[0][4 * q + jj] *= a[jj]; o[1][4 * q + jj] *= a[jj]; } }
                }
                const unsigned long long bw = BITS[qloc * 32 + kt];
                const unsigned wl = (unsigned)bw >> (4 * hi), wh = (unsigned)(bw >> 32) >> (4 * hi);
                const float mc = m * C2S; float ls = 0.f;
#pragma unroll
                for (int r = 0; r < 16; ++r) { constexpr int dummy_ = 0; (void)dummy_;
                    const unsigned m0 = (r == 0) ? bit_mask<0>(wl) : (r == 1) ? bit_mask<1>(wl) : (r == 2) ? bit_mask<2>(wl) : (r == 3) ? bit_mask<3>(wl) : (r == 4) ? bit_mask<8>(wl) : (r == 5) ? bit_mask<9>(wl) : (r == 6) ? bit_mask<10>(wl) : (r == 7) ? bit_mask<11>(wl)
                                      : (r == 8) ? bit_mask<16>(wl) : (r == 9) ? bit_mask<17>(wl) : (r == 10) ? bit_mask<18>(wl) : (r == 11) ? bit_mask<19>(wl) : (r == 12) ? bit_mask<24>(wl) : (r == 13) ? bit_mask<25>(wl) : (r == 14) ? bit_mask<26>(wl) : bit_mask<27>(wl);
                    const unsigned m1 = (r == 0) ? bit_mask<0>(wh) : (r == 1) ? bit_mask<1>(wh) : (r == 2) ? bit_mask<2>(wh) : (r == 3) ? bit_mask<3>(wh) : (r == 4) ? bit_mask<8>(wh) : (r == 5) ? bit_mask<9>(wh) : (r == 6) ? bit_mask<10>(wh) : (r == 7) ? bit_mask<11>(wh)
                                      : (r == 8) ? bit_mask<16>(wh) : (r == 9) ? bit_mask<17>(wh) : (r == 10) ? bit_mask<18>(wh) : (r == 11) ? bit_mask<19>(wh) : (r == 12) ? bit_mask<24>(wh) : (r == 13) ? bit_mask<25>(wh) : (r == 14) ? bit_mask<26>(wh) : bit_mask<27>(wh);
                    p0[r] = __uint_as_float(__float_as_uint(__builtin_amdgcn_exp2f(__builtin_fmaf(p0[r], C2S, -mc))) & m0);
                    p1[r] = __uint_as_float(__float_as_uint(__builtin_amdgcn_exp2f(__builtin_fmaf(p1[r], C2S, -mc))) & m1);
                    ls += p0[r] + p1[r]; }
                l += ls;
                bf16x8 pa[4];
                pa[0] = pack8(p0[0], p0[1], p0[2], p0[3], p0[4], p0[5], p0[6], p0[7]); pa[1] = pack8(p0[8], p0[9], p0[10], p0[11], p0[12], p0[13], p0[14], p0[15]);
                pa[2] = pack8(p1[0], p1[1], p1[2], p1[3], p1[4], p1[5], p1[6], p1[7]); pa[3] = pack8(p1[8], p1[9], p1[10], p1[11], p1[12], p1[13], p1[14], p1[15]);
                const LAS unsigned char* vb = tile + 8192 + vboff;
#pragma unroll
                for (int d0 = 0; d0 < 2; ++d0)
#pragma unroll
                    for (int ks = 0; ks < 4; ++ks) { const s16x4 lo = tr_read(vb + d0 * 4096 + ks * 1024), hh = tr_read(vb + d0 * 4096 + ks * 1024 + 512);
                        o[d0] = MFMA32(pa[ks], cat4(lo, hh), o[d0]); }
            }
            buf = (buf == 2) ? 0 : buf + 1; bufn = (bufn == 2) ? 0 : bufn + 1;
        }
#undef DSD_STAGE
        l += __shfl_xor(l, 32);
        __syncthreads();
        if (kp == 1) {
            LAS float* ow = OW + cg * 2048;
#pragma unroll
            for (int r = 0; r < 16; ++r) { const int row = crow(r, hi); ow[row * 64 + r32] = o[0][r]; ow[row * 64 + 32 + r32] = o[1][r]; }
            if (hi == 0) { ML2[cg * 64 + r32] = m; ML2[cg * 64 + 32 + r32] = l; }
        }
        __syncthreads();
        if (kp == 0) {
            const float m2 = ML2[cg * 64 + r32], l2 = ML2[cg * 64 + 32 + r32];
            const float M = fmaxf(m, m2), a1 = __builtin_amdgcn_exp2f((m - M) * C2S), a2 = __builtin_amdgcn_exp2f((m2 - M) * C2S);
            const float linv = 1.0f / (a1 * l + a2 * l2);
            if (hi == 0) { wsf[r32] = a1 * linv; wsf[32 + r32] = a2 * linv; }
            LDS_WAIT();
            const LAS float* ow = OW + cg * 2048;
            bf16_t* op = OC + (tb + t0 + 4 * cg) * 512 + r32;
#pragma unroll
            for (int q = 0; q < 4; ++q) { const f32x4 s1 = *(const LAS f32x4*)(wsf + 8 * q + 4 * hi), s2 = *(const LAS f32x4*)(wsf + 32 + 8 * q + 4 * hi);
#pragma unroll
                for (int jj = 0; jj < 4; ++jj) { const int r = 4 * q + jj, row = crow(r, hi);
                    const float v0 = o[0][r] * s1[jj] + ow[row * 64 + r32] * s2[jj], v1 = o[1][r] * s1[jj] + ow[row * 64 + 32 + r32] * s2[jj];
                    bf16_t* dst = op + (size_t)(row >> 3) * 512 + (row & 7) * 64;
                    dst[0] = (bf16_t)(pk2(v0, 0.f) & 0xffffu); dst[32] = (bf16_t)(pk2(v1, 0.f) & 0xffffu); } }
        }
    }
#ifdef PROBE_S3DUP
    }
#endif
    __syncthreads();
}
DI void attention_mla_units(const Frame& F, int rep_a) {
    for (int rep = 0; rep < rep_a; ++rep)
    for (int U = F.bid; U < 1024; U += F.G) { const int i = U >> 8, cp = U & 255, half = cp >> 7, rem = cp & 127; mla_unit(F, rem & 15, rem >> 4, 2 * i + (half ^ (i & 1))); }
}
DI void attention_dsa_units(const Frame& F, int rep_c) {
    for (int rep = 0; rep < rep_c; ++rep)
    for (int U = F.bid; U < 2048; U += F.G) { const int i = U >> 8, cp = U & 255; dsa_unit(F, cp & 15, 16 * i + (cp >> 4)); }
}
DI void phase_attention(const Frame& F, int rep_a, int rep_c) {
    if (F.bid & 1) { attention_dsa_units(F, rep_c); __syncthreads(); attention_mla_units(F, rep_a); }
    else { attention_mla_units(F, rep_a); __syncthreads(); attention_dsa_units(F, rep_c); }
}

constexpr int N2_WROW = 1032;
constexpr int N2_WH = 0, N2_WL = 32 * N2_WROW * 2, N2_CB = 2 * N2_WL, N2_PART = N2_CB + 128, N2_LGT = N2_PART + 2048, N2_RST = N2_LGT + 8 * 2304, N2_CNT = N2_RST + 512, N2_BASE = N2_CNT + 128, N2_TOK = N2_BASE + 128;
static_assert(N2_TOK + 2048 <= MISC_OFF, "router LDS map");
DI void phase_router(const Frame& F, int l, int cset) {
    const int tid = F.tid, lane = F.lane, wave = F.wave, fr = lane & 15, g = lane >> 4;
    LAS unsigned char* lds = F.lds;
    LAS bf16_t* WH = (LAS bf16_t*)(lds + N2_WH); LAS bf16_t* WL = (LAS bf16_t*)(lds + N2_WL); LAS float* CB = (LAS float*)(lds + N2_CB); LAS float* PART = (LAS float*)(lds + N2_PART);
    LAS float* LGT = (LAS float*)(lds + N2_LGT) + wave * 576; LAS float* RST = (LAS float*)(lds + N2_RST) + wave * 16;
    LAS int* CNT = (LAS int*)(lds + N2_CNT); LAS int* BASE = (LAS int*)(lds + N2_BASE); LAS int* TOKR = (LAS int*)(lds + N2_TOK);
    const float* X1 = WSP(float, WS_X1); const float* MOD = WSP(float, WS_MOD); unsigned char* H8 = WSP(unsigned char, WS_H8);
    const float* in_n2 = KIN_norm2_g + l * 1024; const float* in_rb = KIN_router_b + l * 32; const float* in_rw = KIN_router_w + (size_t)l * 32768;
    int* TOPE = (int*)(F.ws + WS_ROUTE + RT_TOPE); float* TOPG = (float*)(F.ws + WS_ROUTE + RT_TOPG); int* RANK = (int*)(F.ws + WS_ROUTE + RT_RANK);
    for (int chunk = F.bid; chunk < T_TOK / 128; chunk += F.G) {
        const int b = chunk >> 4; const float* md = MOD + ((size_t)l * 16 + b) * 6144;
        __syncthreads();
        { float cp = 0.f;
          for (int idx = tid; idx < 32 * 1024; idx += 512) { const int k = idx >> 5, e = idx & 31; const float w = in_rw[idx]; const float wp = w * (in_n2[k] * (1.0f + md[4 * 1024 + k]));
              const unsigned hw = pk2(wp, 0.f) & 0xffffu; const float lo = wp - __uint_as_float(hw << 16);
              WH[e * N2_WROW + k] = (bf16_t)hw; WL[e * N2_WROW + k] = (bf16_t)(pk2(lo, 0.f) & 0xffffu); cp += md[3 * 1024 + k] * w; }
          PART[(tid >> 5) * 32 + (tid & 31)] = cp; }
        if (tid < 32) CNT[tid] = 0;
        __syncthreads();
        if (tid < 32) { float c = in_rb[tid];
#pragma unroll
            for (int p = 0; p < 16; ++p) c += PART[p * 32 + tid];
            CB[tid] = c; }
        __syncthreads();
        const int t0w = chunk * 128 + wave * 16;
        {
            const float* xp = X1 + (size_t)(t0w + fr) * 1024 + 8 * g;
            f32x4 acc0 = {F.zf, F.zf, F.zf, F.zf}, acc1 = acc0; float ssq = 0.f;
            const LAS bf16_t* wh0 = WH + fr * N2_WROW + 8 * g; const LAS bf16_t* wl0 = WL + fr * N2_WROW + 8 * g;
#pragma unroll 8
            for (int ks = 0; ks < 32; ++ks) {
                const f32x4 xa = *(const f32x4*)(xp + 32 * ks), xb = *(const f32x4*)(xp + 32 * ks + 4);
                ssq += (xa[0] * xa[0] + xa[1] * xa[1]) + (xa[2] * xa[2] + xa[3] * xa[3]) + (xb[0] * xb[0] + xb[1] * xb[1]) + (xb[2] * xb[2] + xb[3] * xb[3]);
                u32x4 hw; hw.x = pk2(xa[0], xa[1]); hw.y = pk2(xa[2], xa[3]); hw.z = pk2(xb[0], xb[1]); hw.w = pk2(xb[2], xb[3]);
                u32x4 lw; lw.x = pk2(xa[0] - bf_lo(hw.x), xa[1] - bf_hi(hw.x)); lw.y = pk2(xa[2] - bf_lo(hw.y), xa[3] - bf_hi(hw.y)); lw.z = pk2(xb[0] - bf_lo(hw.z), xb[1] - bf_hi(hw.z)); lw.w = pk2(xb[2] - bf_lo(hw.w), xb[3] - bf_hi(hw.w));
                const bf16x8 ah = __builtin_bit_cast(bf16x8, hw), al = __builtin_bit_cast(bf16x8, lw);
                const bf16x8 bh0 = *(const LAS bf16x8*)(wh0 + 32 * ks), bh1 = *(const LAS bf16x8*)(wh0 + 16 * N2_WROW + 32 * ks), bl0 = *(const LAS bf16x8*)(wl0 + 32 * ks), bl1 = *(const LAS bf16x8*)(wl0 + 16 * N2_WROW + 32 * ks);
                acc0 = __builtin_amdgcn_mfma_f32_16x16x32_bf16(ah, bh0, acc0, 0, 0, 0); acc0 = __builtin_amdgcn_mfma_f32_16x16x32_bf16(ah, bl0, acc0, 0, 0, 0); acc0 = __builtin_amdgcn_mfma_f32_16x16x32_bf16(al, bh0, acc0, 0, 0, 0);
                acc1 = __builtin_amdgcn_mfma_f32_16x16x32_bf16(ah, bh1, acc1, 0, 0, 0); acc1 = __builtin_amdgcn_mfma_f32_16x16x32_bf16(ah, bl1, acc1, 0, 0, 0); acc1 = __builtin_amdgcn_mfma_f32_16x16x32_bf16(al, bh1, acc1, 0, 0, 0);
            }
            ssq += __shfl_xor(ssq, 16); ssq += __shfl_xor(ssq, 32);
            if (g == 0) RST[fr] = 1.0f / sqrtf(ssq * (1.0f / 1024.0f) + NORM_EPS);
#pragma unroll
            for (int r = 0; r < 4; ++r) { LGT[(4 * g + r) * 36 + fr] = acc0[r]; LGT[(4 * g + r) * 36 + 16 + fr] = acc1[r]; }
        }
        LDS_WAIT();
        if (lane < 16) {
            const int t = t0w + lane; const float rt = RST[lane];
            float a[32];
#pragma unroll
            for (int q = 0; q < 8; ++q) { const f32x4 w = *(const LAS f32x4*)(LGT + lane * 36 + 4 * q), c = *(const LAS f32x4*)(CB + 4 * q); a[4 * q] = w[0] * rt + c[0]; a[4 * q + 1] = w[1] * rt + c[1]; a[4 * q + 2] = w[2] * rt + c[2]; a[4 * q + 3] = w[3] * rt + c[3]; }
            float tv[4]; int te[4];
#pragma unroll
            for (int k = 0; k < 4; ++k) { float best = a[0]; int bi = 0;
#pragma unroll
                for (int e = 1; e < 32; ++e) if (a[e] > best) { best = a[e]; bi = e; }
                tv[k] = best; te[k] = bi;
#pragma unroll
                for (int e = 0; e < 32; ++e) if (e == bi) a[e] = -INFINITY; }
            const float e1 = __expf(tv[1] - tv[0]), e2 = __expf(tv[2] - tv[0]), e3 = __expf(tv[3] - tv[0]); const float inv = 1.0f / (1.0f + e1 + e2 + e3);
            const float gk[4] = {inv, e1 * inv, e2 * inv, e3 * inv};
#pragma unroll
            for (int k = 0; k < 4; ++k) { const int loc = __hip_atomic_fetch_add(&CNT[te[k]], 1, __ATOMIC_RELAXED, __HIP_MEMORY_SCOPE_WORKGROUP); TOKR[(wave * 16 + lane) * 4 + k] = te[k] | (loc << 8); }
            *(f32x4*)(TOPG + (size_t)t * 4) = (f32x4){gk[0], gk[1], gk[2], gk[3]};
        }
        { f32x4 gs[4], shv[4];
#pragma unroll
          for (int i = 0; i < 4; ++i) { const int co = 4 * lane + 256 * i; gs[i] = *(const f32x4*)(in_n2 + co) * (*(const f32x4*)(md + 4 * 1024 + co) + 1.0f); shv[i] = *(const f32x4*)(md + 3 * 1024 + co); }
          for (int j = 0; j < 16; j += 4) {
            f32x4 xv[4][4];
#pragma unroll
            for (int jj = 0; jj < 4; ++jj)
#pragma unroll
                for (int i = 0; i < 4; ++i) xv[jj][i] = *(const f32x4*)(X1 + (size_t)(t0w + j + jj) * 1024 + 4 * lane + 256 * i);
#pragma unroll
            for (int jj = 0; jj < 4; ++jj) { const float r = RST[j + jj];
#pragma unroll
                for (int i = 0; i < 4; ++i) { const f32x4 hv = xv[jj][i] * r * gs[i] + shv[i];
                    *(unsigned*)(H8 + (size_t)(t0w + j + jj) * 1024 + 4 * lane + 256 * i) = pk4_fp8(hv[0], hv[1], hv[2], hv[3]); } }
          } }
        __syncthreads();
        if (tid < 32) BASE[tid] = (int)__hip_atomic_fetch_add(F.ctl + CW_CNT + (cset * 32 + tid) * 64, (unsigned)CNT[tid], __ATOMIC_RELAXED, __HIP_MEMORY_SCOPE_AGENT);
        __syncthreads();
        { const int pr = TOKR[tid], e = pr & 255, loc = pr >> 8; const size_t o = (size_t)(chunk * 128) * 4 + tid; TOPE[o] = e; RANK[o] = BASE[e] + loc; }
    }
}
constexpr int MOE_OFF = LDS_X, MOE_CNTL = LDS_X + 256, MOE_TEXP = LDS_X + 512;
DI int moe_offsets(const Frame& F, int l) {
    LAS int* OFF = (LAS int*)(F.lds + MOE_OFF); LAS int* CNTL = (LAS int*)(F.lds + MOE_CNTL); LAS int* TEXP = (LAS int*)(F.lds + MOE_TEXP);
    __syncthreads();
    if (F.tid < 32) CNTL[F.tid] = (int)__hip_atomic_load(F.ctl + CW_CNT + (l * 32 + F.tid) * 64, __ATOMIC_RELAXED, __HIP_MEMORY_SCOPE_AGENT);
    __syncthreads();
    if (F.tid == 0) { int off = 0; for (int e = 0; e < 32; ++e) { OFF[e] = off; off += (CNTL[e] + 255) & ~255; } OFF[32] = off; }
    __syncthreads();
    const int ntiles = OFF[32] >> 8;
    for (int tl = F.tid; tl < ntiles; tl += 512) { int e = 0; for (int q = 0; q < 32; ++q) if (OFF[q] <= tl * 256 && tl * 256 < OFF[q + 1]) e = q; TEXP[tl] = e; }
    __syncthreads();
    return ntiles;
}
DI void phase_scatter(const Frame& F, int l) {
    const int lane = F.lane, wave = F.wave;
    (void)moe_offsets(F, l);
    const LAS int* OFF = (const LAS int*)(F.lds + MOE_OFF); const LAS int* CNTL = (const LAS int*)(F.lds + MOE_CNTL);
    const int* TOPE = (const int*)(F.ws + WS_ROUTE + RT_TOPE); const float* TOPG = (const float*)(F.ws + WS_ROUTE + RT_TOPG); const int* RANK = (const int*)(F.ws + WS_ROUTE + RT_RANK);
    int* SLOTOF = (int*)(F.ws + WS_ROUTE + RT_SLOTOF); int* TOKOF = (int*)(F.ws + WS_ROUTE + RT_TOKOF); float* GATEOF = (float*)(F.ws + WS_ROUTE + RT_GATEOF);
    const unsigned char* H8 = WSP(unsigned char, WS_H8); unsigned char* XB = WSP(unsigned char, WS_XB);
    for (int chunk = F.bid; chunk < T_TOK / 128; chunk += F.G) {
        const int pair = wave * 64 + lane, tl = chunk * 128 + (pair >> 2); const size_t o = (size_t)tl * 4 + (pair & 3);
        const int e = TOPE[o], slot = OFF[e] + RANK[o];
        SLOTOF[o] = slot; TOKOF[slot] = tl; GATEOF[slot] = TOPG[o];
#pragma unroll 4
        for (int p = 0; p < 64; ++p) {
            const int sp = __builtin_amdgcn_readlane(slot, p), tp = chunk * 128 + ((wave * 64 + p) >> 2);
            *(u32x4*)(XB + (size_t)sp * 1024 + 16 * lane) = *(const u32x4*)(H8 + (size_t)tp * 1024 + 16 * lane);
        }
    }
    for (int e = F.bid; e < 32; e += F.G) {
        const int s0 = OFF[e] + CNTL[e], s1 = OFF[e + 1];
        for (int s = s0 + wave; s < s1; s += 8) { if (lane == 0) { TOKOF[s] = 0; GATEOF[s] = 0.f; }
            *(u32x4*)(XB + (size_t)s * 1024 + 16 * lane) = (u32x4){0u, 0u, 0u, 0u}; }
    }
}

#ifndef MK_SPLIT
#define MK_SPLIT 0
#endif
constexpr int NPHASE = 2 + 11 * DEPTH;
struct Args { const void* in[23]; float* out; unsigned char* ws; int ph_lo, ph_hi; };
static_assert(sizeof(Args) == 25 * 8 + 8, "Args has no padding");


#ifndef PH_ENABLE
#define PH_ENABLE 0xFFFF
#endif
#define IN(k) (lo <= (k) && (k) < hi)
#define EN(j) (((PH_ENABLE) >> (j)) & 1)
#ifndef STAG_G1
#define STAG_G1 0
#endif
#ifndef STAG_G3
#define STAG_G3 0
#endif
#ifndef STAG_G4
#define STAG_G4 0
#endif
#ifndef STAG_M2
#define STAG_M2 0
#endif
#ifndef M1_SP2
#define M1_SP2 1
#endif
#ifndef DUP_MASK
#define DUP_MASK 0
#endif
#define NREP(j) ((((DUP_MASK) >> (j)) & 1) ? 2 : 1)
#ifndef PROBE_BARX
#define PROBE_BARX 1
#endif
#define SEAM(k) do { if (!MK_SPLIT && (k) + 1 < hi) { XcdBarrier bar_; bar_.bar = F.ctl + CW_BAR; bar_.x = xb_xcc_id(); bar_.st = (volatile LAS unsigned*)((LAS unsigned char*)lds_raw + MISC_OFF) + 8; _Pragma("unroll") for (int bx_ = 0; bx_ < PROBE_BARX; ++bx_) xcd_barrier(bar_, F.tid); } } while (0)
DI void layer_phases(const int l, const int lo, const int hi, const int wave0) {
        const int pb = 2 + 11 * l;
        if (EN(2) && IN(pb + 0)) { const Frame F = make_frame(wave0);
            stagger(F, STAG_G1);
            { int kb8 = 1024; asm volatile("" : "+s"(kb8));
              SchedPlain S; S.o.init(T_TOK / 256, G1_F8_COLS / 256, F.G, F.bid); S.A = (const char*)WSP(unsigned char, WS_HG8); S.B = (const char*)(WSP(unsigned char, WS_WIN) + (size_t)l * NP * 2048); S.tstep = (size_t)256 * 1024;
              EpiStoreBf16N E{WSP(bf16_t, WS_P), NP, 0};
#ifdef PROBE_NOSTORE
              _Pragma("unroll") for (int rep = 0; rep < NREP(2); ++rep) { E.skip = (rep + 1 < NREP(2)); pg8::gemm_phase_f8<EpiStoreBf16N, SchedPlain, true, true, HG8_TILED != 0>(F.lds, F.tid, kb8, S, E); } }
#else
              _Pragma("unroll") for (int rep = 0; rep < NREP(2) + NREP(14) - 1; ++rep) pg8::gemm_phase_f8<EpiStoreBf16N, SchedPlain, true, true, HG8_TILED != 0>(F.lds, F.tid, kb8, S, E); }
#endif
            { int tid2 = F.tid; asm volatile("" : "+v"(tid2));
              SchedPlain S; S.o.init(T_TOK / 256, (NP - G1_F8_COLS) / 256, F.G, F.bid); S.A = (const char*)WSP(bf16_t, WS_H); S.B = (const char*)(WSP(bf16_t, WS_WIN) + (size_t)l * NP * 1024 + (size_t)G1_F8_COLS * 1024); S.tstep = (size_t)256 * 1024 * 2;
              EpiStoreBf16 E{WSP(bf16_t, WS_P), NP, G1_F8_COLS};
#ifdef PROBE_NOSTORE
              _Pragma("unroll") for (int rep = 0; rep < NREP(2); ++rep) { E.skip = (rep + 1 < NREP(2)); pg8::gemm_phase<EpiStoreBf16, SchedPlain>(F.lds, tid2, 1024, S, E); } }
#else
              _Pragma("unroll") for (int rep = 0; rep < NREP(2) + NREP(15) - 1; ++rep) pg8::gemm_phase<EpiStoreBf16, SchedPlain>(F.lds, tid2, 1024, S, E); }
#endif
            SEAM(pb + 0);
        }
        if (EN(3) && IN(pb + 1)) { const Frame F = make_frame(wave0); _Pragma("unroll") for (int rep = 0; rep < NREP(3); ++rep) phase_post(F, l); SEAM(pb + 1); }
        if (EN(4) && IN(pb + 2)) { const Frame F = make_frame(wave0);
            int k256 = 256; asm volatile("" : "+s"(k256));
            { SchedPlain S; S.o.init(T_TOK / 256, 3, F.G, F.bid); S.A = (const char*)WSP(bf16_t, WS_CQ); S.B = (const char*)(WSP(bf16_t, WS_WUQ) + (size_t)l * 768 * 256); S.tstep = (size_t)256 * 256 * 2;
              EpiStoreBf16 E{WSP(bf16_t, WS_QA), 768};
              pg8::gemm_phase<EpiStoreBf16, SchedPlain>(F.lds, F.tid, k256, S, E); }
            { int tid2 = F.tid; asm volatile("" : "+v"(tid2));
              SchedPlain S; S.o.init(T_TOK / 256, 4, F.G, F.bid); S.A = (const char*)WSP(bf16_t, WS_CKV); S.B = (const char*)(WSP(bf16_t, WS_WUKV) + (size_t)l * 1024 * 256); S.tstep = (size_t)256 * 256 * 2;
              EpiStoreBf16 E{WSP(bf16_t, WS_KV), 1024};
              pg8::gemm_phase<EpiStoreBf16, SchedPlain>(F.lds, tid2, k256, S, E); }
            SEAM(pb + 2);
        }
        if (EN(5) && IN(pb + 3)) { const Frame F = make_frame(wave0); phase_attention(F, NREP(5), NREP(13)); SEAM(pb + 3); }
        if (EN(6) && IN(pb + 4)) { const Frame F = make_frame(wave0);
            stagger(F, STAG_G3);
            SchedBranch S; S.o.init(T_TOK / 256, 4, F.G, F.bid); S.A = (const char*)WSP(bf16_t, WS_O3); S.B = (const char*)(WSP(bf16_t, WS_WB) + (size_t)l * 3 * 1024 * 512); S.tstep = (size_t)256 * 512 * 2; S.aslab = (size_t)T_TOK * 512 * 2;
            EpiBranchGate E{WSP(bf16_t, WS_GY), WSP(bf16_t, WS_P), KIN_b_gate + l * 3072};
            _Pragma("unroll") for (int rep = 0; rep < NREP(6); ++rep) pg8::gemm_phase<EpiBranchGate, SchedBranch>(F.lds, F.tid, 512, S, E);
            SEAM(pb + 4);
        }
        if (EN(7) && IN(pb + 5)) { const Frame F = make_frame(wave0);
            stagger(F, STAG_G4);
            SchedPlain S; S.o.init(T_TOK / 256, 4, F.G, F.bid); S.A = (const char*)WSP(bf16_t, WS_GY); S.B = (const char*)(WSP(bf16_t, WS_WOUT) + (size_t)l * 1024 * 1024); S.tstep = (size_t)256 * 1024 * 2;
            EpiResidual E{l == 0 ? KIN_x : WSP(float, WS_X1), WSP(float, WS_X1), WSP(float, WS_MOD) + (size_t)l * 16 * 6144 + 2 * 1024};
            _Pragma("unroll") for (int rep = 0; rep < NREP(7); ++rep) if (rep == 0 || l == 0) pg8::gemm_phase<EpiResidual, SchedPlain>(F.lds, F.tid, 1024, S, E);
            SEAM(pb + 5);
        }
        if (EN(8) && IN(pb + 6)) { const Frame F = make_frame(wave0); phase_router(F, l, l); if (NREP(8) == 2) phase_router(F, l, l + 2); SEAM(pb + 6); }
        if (EN(9) && IN(pb + 7)) { const Frame F = make_frame(wave0); _Pragma("unroll") for (int rep = 0; rep < NREP(9); ++rep) phase_scatter(F, l); SEAM(pb + 7); }
        if (EN(10) && IN(pb + 8)) { const Frame F = make_frame(wave0);
            const int ntiles = moe_offsets(F, l); int kb8 = 1024; asm volatile("" : "+s"(kb8));
            SchedMoe S; S.o.init(ntiles, 8, F.G, F.bid); S.A = (const char*)WSP(unsigned char, WS_XB); S.B = (const char*)(WSP(unsigned char, WS_W1) + (size_t)l * 32 * 2048 * 1024); S.eslab = 2048u * 1024u;
            S.texp = (const LAS int*)(F.lds + MOE_TEXP);
#if M2_F8
            EpiSwiglu8 E{WSP(unsigned char, WS_ACT), KIN_b1 + (size_t)l * 32 * 2048, (const LAS int*)(F.lds + MOE_TEXP)};
#else
            EpiSwiglu E{WSP(bf16_t, WS_ACT), KIN_b1 + (size_t)l * 32 * 2048, (const LAS int*)(F.lds + MOE_TEXP)};
#endif
            _Pragma("unroll") for (int rep = 0; rep < NREP(10); ++rep)
#if M2_F8
#ifdef PROBE_M1
#ifdef PROBE_FIXAB
            { E.skip = (rep + 1 < NREP(10)) ? PROBE_M1 : 0; S.fix = (rep + 1 < NREP(10)) ? PROBE_FIXAB : 0;
#ifdef PROBE_KB
              const int kbp_ = (rep + 1 < NREP(10)) ? (kb8 >> 1) : kb8;
              pg8::gemm_phase_f8<EpiSwiglu8, SchedMoe, true, M1_SP2 != 0>(F.lds, F.tid, kbp_, S, E); }
#else
              pg8::gemm_phase_f8<EpiSwiglu8, SchedMoe, true, M1_SP2 != 0>(F.lds, F.tid, kb8, S, E); }
#endif
#else
            { E.skip = (rep + 1 < NREP(10)) ? PROBE_M1 : 0; pg8::gemm_phase_f8<EpiSwiglu8, SchedMoe, true, M1_SP2 != 0>(F.lds, F.tid, kb8, S, E); }
#endif
#else
            pg8::gemm_phase_f8<EpiSwiglu8, SchedMoe, true, M1_SP2 != 0>(F.lds, F.tid, kb8, S, E);
#endif
#else
            pg8::gemm_phase_f8<EpiSwiglu, SchedMoe>(F.lds, F.tid, kb8, S, E);
#endif

            SEAM(pb + 8);
        }
        if (EN(11) && IN(pb + 9)) { const Frame F = make_frame(wave0);
            const int ntiles = moe_offsets(F, l); int kb8 = 1024; asm volatile("" : "+s"(kb8));
            stagger(F, STAG_M2);
#if M2_F8
            SchedMoe S; S.o.init(ntiles, 4, F.G, F.bid); S.A = (const char*)WSP(unsigned char, WS_ACT); S.B = (const char*)(WSP(unsigned char, WS_W2) + (size_t)l * 32 * 1024 * 1024); S.eslab = 1024u * 1024u;
            S.texp = (const LAS int*)(F.lds + MOE_TEXP);
            EpiMoeOut E{WSP(bf16_t, WS_Y), KIN_b2 + (size_t)l * 32 * 1024, (const float*)(F.ws + WS_ROUTE + RT_GATEOF), (const LAS int*)(F.lds + MOE_TEXP)};
            _Pragma("unroll") for (int rep = 0; rep < NREP(11); ++rep) pg8::gemm_phase_f8<EpiMoeOut, SchedMoe>(F.lds, F.tid, kb8, S, E);
#else
            SchedMoeB S; S.o.init(ntiles, 4, F.G, F.bid); S.A = (const char*)WSP(bf16_t, WS_ACT); S.B = (const char*)(WSP(bf16_t, WS_W2) + (size_t)l * 32 * 1024 * 1024); S.eslab = 1024u * 1024u * 2u;
            S.texp = (const LAS int*)(F.lds + MOE_TEXP);
            EpiMoeOut E{WSP(bf16_t, WS_Y), KIN_b2 + (size_t)l * 32 * 1024, (const float*)(F.ws + WS_ROUTE + RT_GATEOF), (const LAS int*)(F.lds + MOE_TEXP)};
            _Pragma("unroll") for (int rep = 0; rep < NREP(11); ++rep) pg8::gemm_phase<EpiMoeOut, SchedMoeB>(F.lds, F.tid, kb8, S, E);
#endif
            SEAM(pb + 9);
        }
        if (EN(12) && IN(pb + 10)) { const Frame F = make_frame(wave0);
            const bool last = (l == DEPTH - 1);
            _Pragma("unroll") for (int rep = 0; rep < NREP(12); ++rep) if (rep == 0 || last) phase_norm(F, WSP(float, WS_X1), WSP(float, WS_X1), true, !last, last, l + 1 < DEPTH ? l + 1 : 0, l);
            SEAM(pb + 10);
        }
}
__global__ void __launch_bounds__(512, 2) fwd_kernel(Args args) {
    const int wave0 = __builtin_amdgcn_readfirstlane(threadIdx.x >> 6);
    {
        volatile LAS unsigned* MISC = (volatile LAS unsigned*)((LAS unsigned char*)lds_raw + MISC_OFF);
        if (threadIdx.x < 32) MISC[threadIdx.x] = 0u;
        __syncthreads();
        if (!MK_SPLIT) { const Frame F = make_frame(wave0); (void)xcd_barrier_post(F.ctl + CW_BAR, MISC + 8, F.tid); }
    }
    const int lo = args.ph_lo, hi = args.ph_hi;
#ifdef PROBE_CLK
    const unsigned long long pc0_ = __builtin_amdgcn_s_memtime(), pr0_ = __builtin_amdgcn_s_memrealtime();
#endif
    if (EN(0) && IN(0)) { const Frame F = make_frame(wave0); _Pragma("unroll") for (int rep = 0; rep < NREP(0); ++rep) phase_prologue(F); SEAM(0); }
    if (EN(1) && IN(1)) { const Frame F = make_frame(wave0); _Pragma("unroll") for (int rep = 0; rep < NREP(1); ++rep) phase_norm(F, KIN_x, nullptr, false, false, false, 0, 0); SEAM(1); }
    layer_phases(0, lo, hi, wave0);
    layer_phases(1, lo, hi, wave0);
    static_assert(DEPTH == 2, "two layers");
#ifdef PROBE_CLK
    {
        const unsigned long long pc1_ = __builtin_amdgcn_s_memtime(), pr1_ = __builtin_amdgcn_s_memrealtime();
        const unsigned cyc_per_us = (unsigned)((pc1_ - pc0_) * 100ull / (pr1_ - pr0_));
        const unsigned ticks = cyc_per_us * 10u;
        const unsigned long long t0 = __builtin_amdgcn_s_memrealtime();
        while ((unsigned)(__builtin_amdgcn_s_memrealtime() - t0) < ticks) __builtin_amdgcn_s_sleep(8);
    }
#endif
#undef IN
#undef SEAM
}

extern "C" void kernel_launch(void* const* d_in, const int* in_sizes, int n_in, void* d_out, int out_size, void* d_ws, size_t ws_size, hipStream_t stream) {
    static int grid = 0;
    if (grid == 0) {
        if (n_in != 23 || out_size != T_TOK * D_MODEL || ws_size < WS_END) { fprintf(stderr, "kernel_launch: unexpected problem (n_in %d, out %d, ws %zu)\n", n_in, out_size, ws_size); grid = -1; return; }
        int dev = 0, cus = 0;
        if (hipGetDevice(&dev) != hipSuccess || hipDeviceGetAttribute(&cus, hipDeviceAttributeMultiprocessorCount, dev) != hipSuccess) { grid = -1; return; }
        if (hipFuncSetAttribute((const void*)fwd_kernel, hipFuncAttributeMaxDynamicSharedMemorySize, LDS_BYTES) != hipSuccess) { fprintf(stderr, "kernel_launch: hipFuncSetAttribute failed\n"); grid = -1; return; }
        int per_cu = 0;
        if (hipOccupancyMaxActiveBlocksPerMultiprocessor(&per_cu, (const void*)fwd_kernel, 512, LDS_BYTES) != hipSuccess || per_cu < 1) fprintf(stderr, "kernel_launch: occupancy query says %d\n", per_cu);
        (void)hipGetLastError();
        grid = cus > 256 ? 256 : cus;
    }
    if (grid < 0) return;
    (void)in_sizes;
    if (hipMemsetAsync((char*)d_ws + WS_CTL, 0, CTL_ZERO_BYTES, stream) != hipSuccess) return;
    Args a{};
    for (int i = 0; i < 23; ++i) a.in[i] = d_in[i];
    a.out = (float*)d_out; a.ws = (unsigned char*)d_ws;
#if MK_SPLIT
    for (int p = 0; p < NPHASE; ++p) { a.ph_lo = p; a.ph_hi = p + 1; hipLaunchKernelGGL(fwd_kernel, dim3(grid), dim3(512), LDS_BYTES, stream, a); }
#else
    a.ph_lo = 0; a.ph_hi = NPHASE;
    hipLaunchKernelGGL(fwd_kernel, dim3(grid), dim3(512), LDS_BYTES, stream, a);
#endif
}
```

```cpp
#include <hip/hip_runtime.h>
#include <cstdio>
#include <cstdint>

#ifndef M2_F8
#define M2_F8 1
#endif
#define LAS __attribute__((address_space(3)))
#define GAS __attribute__((address_space(1)))
typedef unsigned short bf16_t;
typedef short bf16x8 __attribute__((ext_vector_type(8)));
typedef short s16x4 __attribute__((ext_vector_type(4)));
typedef float f32x2 __attribute__((ext_vector_type(2)));
typedef float f32x4 __attribute__((ext_vector_type(4)));
typedef float f32x16 __attribute__((ext_vector_type(16)));
typedef unsigned u32x2 __attribute__((ext_vector_type(2)));
typedef unsigned u32x4 __attribute__((ext_vector_type(4)));
#define DI __device__ __forceinline__

constexpr int D_MODEL = 1024, BATCH = 16, SEQ = 2048, T_TOK = BATCH * SEQ, DEPTH = 2;
constexpr float NORM_EPS = 1e-6f;
constexpr int IN_COLS = 6248, NP = 6400;
constexpr int N_EXP = 32, TOP_K = 4, D_EXP = 1024;
constexpr int NSLOT_MAX = T_TOK * TOP_K + N_EXP * 256;
constexpr int PC_GATE = 0, PC_CONV = 3072, PC_DQ = 4608, PC_IQ = 5120, PC_QLAT = 5632, PC_KVLAT = 5888, PC_DKV = 6048, PC_IK = 6176, PC_IW = 6240;
constexpr int OC_QLAT = 0, OC_KVLAT = 256, OC_CONV = 416, OC_DQ = 1952, OC_DKV = 2464, OC_IQ = 2592, OC_IK = 3104, OC_IW = 3168, OC_GATE = 3176;

DI unsigned pk2(float lo, float hi) { typedef __bf16 bf16x2_t __attribute__((ext_vector_type(2))); f32x2 v = {lo, hi}; bf16x2_t b = __builtin_convertvector(v, bf16x2_t); return __builtin_bit_cast(unsigned, b); }
DI float bf_lo(unsigned w) { return __uint_as_float(w << 16); }
DI float bf_hi(unsigned w) { return __uint_as_float(w & 0xffff0000u); }
DI float bf2f(bf16_t h) { return __uint_as_float((unsigned)h << 16); }
DI float wave_sum(float v) {
#pragma unroll
    for (int o = 1; o < 64; o <<= 1) v += __shfl_xor(v, o);
    return v;
}
DI float fast_sigmoid(float x) { return __builtin_amdgcn_rcpf(1.0f + __builtin_amdgcn_exp2f(-1.4426950408889634f * x)); }
DI unsigned pk4_fp8(float a, float b, float c, float d) { int w = __builtin_amdgcn_cvt_pk_fp8_f32(a, b, 0, false); w = __builtin_amdgcn_cvt_pk_fp8_f32(c, d, w, true); return (unsigned)w; }
#define LDS_WAIT() asm volatile("s_waitcnt lgkmcnt(0)" ::: "memory")
#define VM_WAIT() asm volatile("s_waitcnt vmcnt(0)" ::: "memory")

namespace pg8 {
DI void glds16_s(unsigned voff, const char* sbase, unsigned lds_dst) { unsigned keep; asm volatile("s_nop 4\n\ts_mov_b32 %0, m0\n\ts_mov_b32 m0, %3\n\ts_nop 0\n\tglobal_load_lds_dwordx4 %1, %2\n\ts_mov_b32 m0, %0" : "=&s"(keep) : "v"(voff), "s"(sbase), "s"(lds_dst) : "memory"); }
DI const char* uni_ptr(const char* p) { const unsigned long long v = (unsigned long long)p; const unsigned lo = __builtin_amdgcn_readfirstlane((unsigned)v), hi = __builtin_amdgcn_readfirstlane((unsigned)(v >> 32)); return (const char*)(GAS const char*)(((unsigned long long)hi << 32) | lo); }
constexpr int BM = 256, BK = 64, HALF = 128, HTB = HALF * BK * 2, STAGE_BYTES = 8 * HTB, NXCD = 8, WGM = 8;
__host__ __device__ __forceinline__ int lds_byte(int r, int c) { const int st = (r >> 4) * 2 + (c >> 5), rr = r & 15, cc = c & 31, ob = rr * 64 + cc * 2; return st * 1024 + (ob ^ (((ob >> 9) & 1) << 5)); }
__host__ __device__ __forceinline__ void stage_rc(int b, int& R, int& C) { const int st = b / 1024, sb = b % 1024, swz = sb ^ (((sb >> 9) & 1) << 5); R = (st >> 1) * 16 + swz / 64; C = (st & 1) * 32 + (swz % 64) / 2; }
__host__ __device__ __forceinline__ int perm32(int rho) { const int n = rho >> 4, i = rho & 15; return 8 * (i >> 2) + 4 * n + (i & 3); }
struct Unit { int pm, pn; };
struct StaticOrder {
    int nM, nN, nwg, G, c;
    DI void init(int nM_, int nN_, int G_, int c_) { nM = nM_; nN = nN_; nwg = nM * nN; G = G_; c = c_; }
    DI bool next(int i, Unit& u) const {
        const long L = (long)i * G + c; if (L >= nwg) return false;
        int wgid = (int)L; { const int q = nwg / NXCD, r = nwg % NXCD, xcd = wgid % NXCD, off = wgid / NXCD; wgid = (xcd < r ? xcd * (q + 1) : r * (q + 1) + (xcd - r) * q) + off; }
        const int nig = WGM * nN, gid = wgid / nig, fm = gid * WGM, gsz = (nM - fm) < WGM ? (nM - fm) : WGM;
        u.pm = fm + ((wgid % nig) % gsz); u.pn = (wgid % nig) / gsz; return true;
    }
};

template <class Epi, class Sched, bool ALIGN_EPI = true, bool SP2 = true>
DI void gemm_phase(LAS unsigned char* lds, const int tid, const int K, const Sched& S, const Epi& E) {
    const int wid = __builtin_amdgcn_readfirstlane(tid >> 6), lane = tid & 63, wr = wid >> 2, wc = wid & 3, fr = lane & 15, fq = lane >> 4;
    const int nt = K / BK;
    unsigned voffA[2], voffB[2];
#pragma unroll
    for (int i = 0; i < 2; ++i) { int R, C; stage_rc(tid * 16 + i * 8192, R, C); const int Rb = Epi::PERM ? ((R & ~31) + perm32(R & 31)) : R;
        voffA[i] = (unsigned)(R * K + C) * 2u; voffB[i] = (unsigned)(Rb * K + C) * 2u; }
    const size_t kstep = (size_t)(BK * 2);
    const size_t hstep = (size_t)HALF * K * 2;
    const unsigned ldsw = (unsigned)wid * 1024u; const unsigned ldsb = (unsigned)(unsigned long long)(lds);
    const int aoff = lds_byte(wr * 64 + fr, fq * 8), boff = lds_byte(wc * 32 + fr, fq * 8);
#define PG8_SA(b, h) (((b) * 2 + (h)) * HTB)
#define PG8_SB(b, h) ((4 + (b) * 2 + (h)) * HTB)
#define PG8_STAGE(bufoff, gbase, voff) do { _Pragma("unroll") for (int _i = 0; _i < 2; ++_i) \
        glds16_s((voff)[_i], (const char*)(gbase), ldsb + (unsigned)(bufoff) + ldsw + (unsigned)(_i * 8192)); } while (0)
#define PG8_LDA(dst, b, h) do { int a_ = aoff; asm volatile("" : "+v"(a_)); _Pragma("unroll") for (int m = 0; m < 4; ++m) _Pragma("unroll") for (int k = 0; k < 2; ++k) dst[m][k] = *(const LAS bf16x8*)(lds + PG8_SA(b, h) + a_ + m * 2048 + k * 1024); } while (0)
#define PG8_LDB(dst, b, h) do { int b_ = boff; asm volatile("" : "+v"(b_)); _Pragma("unroll") for (int n = 0; n < 2; ++n) _Pragma("unroll") for (int k = 0; k < 2; ++k) dst[n][k] = *(const LAS bf16x8*)(lds + PG8_SB(b, h) + b_ + n * 2048 + k * 1024); } while (0)
#define PG8_MMA(ai, bj, At, Bt) do { __builtin_amdgcn_s_setprio(1); _Pragma("unroll") for (int m = 0; m < 4; ++m) _Pragma("unroll") for (int n = 0; n < 2; ++n) _Pragma("unroll") for (int k = 0; k < 2; ++k) \
        acc[ai][bj][m][n] = __builtin_amdgcn_mfma_f32_16x16x32_bf16(Bt[n][k], At[m][k], acc[ai][bj][m][n], 0, 0, 0); __builtin_amdgcn_s_setprio(0); } while (0)
#define PG8_WAIT_V(n) asm volatile("s_waitcnt vmcnt(" #n ")" ::: "memory")
#define PG8_WAIT_L(n) asm volatile("s_waitcnt lgkmcnt(" #n ")" ::: "memory")
#define PG8_BAR __builtin_amdgcn_s_barrier()
#define PG8_SCHED __builtin_amdgcn_sched_barrier(0)
    Unit cur, nxt; int ui = 0;
    if (!S.next(0, cur)) return;
    float zf_ = 0.f; asm volatile("" : "+v"(zf_));
    f32x4 acc[2][2][4][2];
#pragma unroll
    for (int a = 0; a < 2; ++a)
#pragma unroll
        for (int b = 0; b < 2; ++b)
#pragma unroll
            for (int m = 0; m < 4; ++m)
#pragma unroll
                for (int n = 0; n < 2; ++n) acc[a][b][m][n] = (f32x4){zf_, zf_, zf_, zf_};
    bf16x8 At[4][2], B0[2][2], B1[2][2];
    const char* cA = uni_ptr(S.abase(cur)); const char* cB = uni_ptr(S.bbase(cur));
    if constexpr (SP2) {
        PG8_STAGE(PG8_SB(0, 0), cB, voffB); PG8_STAGE(PG8_SB(0, 1), cB + hstep, voffB); PG8_STAGE(PG8_SA(0, 0), cA, voffA); PG8_STAGE(PG8_SA(0, 1), cA + hstep, voffA);
        if (wr == 1) PG8_BAR;
        PG8_WAIT_V(2); PG8_BAR;
        PG8_STAGE(PG8_SB(1, 0), cB + kstep, voffB); PG8_STAGE(PG8_SA(1, 0), cA + kstep, voffA); PG8_STAGE(PG8_SB(1, 1), cB + hstep + kstep, voffB);
        PG8_WAIT_V(6); PG8_BAR;
    } else {
        PG8_STAGE(PG8_SB(0, 0), cB, voffB); PG8_STAGE(PG8_SA(0, 0), cA, voffA); PG8_STAGE(PG8_SB(0, 1), cB + hstep, voffB); PG8_STAGE(PG8_SA(0, 1), cA + hstep, voffA);
        if (wr == 1) PG8_BAR;
        PG8_WAIT_V(4); PG8_BAR;
        PG8_STAGE(PG8_SB(1, 0), cB + kstep, voffB); PG8_STAGE(PG8_SA(1, 0), cA + kstep, voffA); PG8_STAGE(PG8_SB(1, 1), cB + hstep + kstep, voffB);
        PG8_WAIT_V(6); PG8_BAR;
    }
    for (;;) {
        const bool has_next = S.next(ui + 1, nxt);
        const char* nA = has_next ? uni_ptr(S.abase(nxt)) : cA; const char* nB = has_next ? uni_ptr(S.bbase(nxt)) : cB;
        for (int t = 0; t < nt; t += 2) {
            const bool last = (t == nt - 2);
            const char* a1 = cA + (size_t)(t + 1) * kstep;
            const char* a2 = last ? nA : cA + (size_t)(t + 2) * kstep; const char* b2 = last ? nB : cB + (size_t)(t + 2) * kstep;
            const char* a3 = a2 + kstep; const char* b3 = b2 + kstep;
            if constexpr (SP2) {
            PG8_LDB(B0, 0, 0); PG8_LDB(B1, 0, 1); PG8_SCHED; PG8_LDA(At, 0, 0); PG8_STAGE(PG8_SA(1, 1), a1 + hstep, voffA);
            PG8_WAIT_V(8); PG8_WAIT_L(0); PG8_BAR; PG8_MMA(0, 0, At, B0); PG8_MMA(0, 1, At, B1); PG8_BAR; PG8_SCHED;
            PG8_LDA(At, 0, 1); PG8_STAGE(PG8_SB(0, 0), b2, voffB); PG8_STAGE(PG8_SB(0, 1), b2 + hstep, voffB); PG8_STAGE(PG8_SA(0, 0), a2, voffA);
            PG8_WAIT_V(8); PG8_WAIT_L(0); PG8_BAR; PG8_MMA(1, 0, At, B0); PG8_MMA(1, 1, At, B1); PG8_BAR; PG8_SCHED;
            PG8_LDB(B0, 1, 0); PG8_LDB(B1, 1, 1); PG8_SCHED; PG8_LDA(At, 1, 0); PG8_STAGE(PG8_SA(0, 1), a2 + hstep, voffA);
            PG8_WAIT_V(8); PG8_WAIT_L(0); PG8_BAR; PG8_MMA(0, 0, At, B0); PG8_MMA(0, 1, At, B1); PG8_BAR; PG8_SCHED;
            PG8_LDA(At, 1, 1); PG8_STAGE(PG8_SB(1, 0), b3, voffB); PG8_STAGE(PG8_SB(1, 1), b3 + hstep, voffB); PG8_STAGE(PG8_SA(1, 0), a3, voffA);
            PG8_WAIT_V(8); PG8_WAIT_L(0); PG8_BAR; PG8_MMA(1, 0, At, B0); PG8_MMA(1, 1, At, B1); PG8_BAR; PG8_SCHED;
            } else {
            PG8_LDB(B0, 0, 0); PG8_SCHED; PG8_LDA(At, 0, 0); PG8_STAGE(PG8_SA(1, 1), a1 + hstep, voffA);
            PG8_WAIT_L(8); PG8_BAR; PG8_WAIT_L(0); PG8_MMA(0, 0, At, B0); PG8_BAR; PG8_SCHED;
            PG8_LDB(B1, 0, 1); PG8_STAGE(PG8_SB(0, 0), b2, voffB);
            PG8_BAR; PG8_WAIT_L(0); PG8_MMA(0, 1, At, B1); PG8_BAR;
            PG8_LDA(At, 0, 1); PG8_STAGE(PG8_SA(0, 0), a2, voffA);
            PG8_BAR; PG8_WAIT_L(0); PG8_MMA(1, 0, At, B0); PG8_BAR; PG8_SCHED;
            PG8_STAGE(PG8_SB(0, 1), b2 + hstep, voffB);
            PG8_WAIT_V(6); PG8_BAR; PG8_MMA(1, 1, At, B1); PG8_BAR;
            PG8_LDB(B0, 1, 0); PG8_SCHED; PG8_LDA(At, 1, 0); PG8_STAGE(PG8_SA(0, 1), a2 + hstep, voffA);
            PG8_WAIT_L(8); PG8_BAR; PG8_WAIT_L(0); PG8_MMA(0, 0, At, B0); PG8_BAR; PG8_SCHED;
            PG8_LDB(B1, 1, 1); PG8_STAGE(PG8_SB(1, 0), b3, voffB);
            PG8_BAR; PG8_WAIT_L(0); PG8_MMA(0, 1, At, B1); PG8_BAR;
            PG8_LDA(At, 1, 1); PG8_STAGE(PG8_SA(1, 0), a3, voffA);
            PG8_BAR; PG8_WAIT_L(0); PG8_MMA(1, 0, At, B0); PG8_BAR; PG8_SCHED;
            PG8_STAGE(PG8_SB(1, 1), b3 + hstep, voffB);
            PG8_WAIT_V(6); PG8_BAR; PG8_MMA(1, 1, At, B1); PG8_BAR;
            }
        }
        if constexpr (ALIGN_EPI) { if (wr == 0) PG8_BAR; }
        E(acc, cur, wr, wc, fr, fq);
        if (!has_next) break;
#pragma unroll
        for (int a = 0; a < 2; ++a)
#pragma unroll
            for (int b = 0; b < 2; ++b)
#pragma unroll
                for (int m = 0; m < 4; ++m)
#pragma unroll
                    for (int n = 0; n < 2; ++n) acc[a][b][m][n] = (f32x4){zf_, zf_, zf_, zf_};
        cur = nxt; cA = nA; cB = nB; ++ui;
        if constexpr (ALIGN_EPI) { if (wr == 1) PG8_BAR; }
    }
    PG8_WAIT_V(0);
    if constexpr (!ALIGN_EPI) { if (wr == 0) PG8_BAR; }
    PG8_BAR;
#undef PG8_SA
#undef PG8_SB
#undef PG8_STAGE
#undef PG8_LDA
#undef PG8_LDB
#undef PG8_MMA
#undef PG8_WAIT_V
#undef PG8_WAIT_L
#undef PG8_BAR
#undef PG8_SCHED
}
typedef int v8i __attribute__((ext_vector_type(8)));
template <class Epi, class Sched, bool ALIGN_EPI = true, bool SP2 = true>
DI void gemm_phase_f8(LAS unsigned char* lds, const int tid, const int KB, const Sched& S, const Epi& E) {
    const int wid = __builtin_amdgcn_readfirstlane(tid >> 6), lane = tid & 63, wr = wid >> 2, wc = wid & 3, fr = lane & 15, fq = lane >> 4;
    const int nt = KB / 128;
    unsigned voffA[2], voffB[2];
#pragma unroll
    for (int i = 0; i < 2; ++i) { int R, C; stage_rc(tid * 16 + i * 8192, R, C); const int Rb = Epi::PERM ? ((R & ~31) + perm32(R & 31)) : R;
        voffA[i] = (unsigned)(R * KB + 2 * C); voffB[i] = (unsigned)(Rb * KB + 2 * C); }
    const size_t kstep = (size_t)(BK * 2);
    const size_t hstep = (size_t)HALF * KB;
    const unsigned ldsw = (unsigned)wid * 1024u; const unsigned ldsb = (unsigned)(unsigned long long)(lds);
    const int aoff = lds_byte(wr * 64 + fr, fq * 16), boff = lds_byte(wc * 32 + fr, fq * 16);
#define PG8_SA(b, h) (((b) * 2 + (h)) * HTB)
#define PG8_SB(b, h) ((4 + (b) * 2 + (h)) * HTB)
#define PG8_STAGE(bufoff, gbase, voff) do { _Pragma("unroll") for (int _i = 0; _i < 2; ++_i) \
        glds16_s((voff)[_i], (const char*)(gbase), ldsb + (unsigned)(bufoff) + ldsw + (unsigned)(_i * 8192)); } while (0)
#define PG8_LDA(dst, b, h) do { int a_ = aoff; asm volatile("" : "+v"(a_)); _Pragma("unroll") for (int m = 0; m < 4; ++m) dst[m] = *(const LAS v8i*)(lds + PG8_SA(b, h) + a_ + m * 2048); } while (0)
#define PG8_LDB(dst, b, h) do { int b_ = boff; asm volatile("" : "+v"(b_)); _Pragma("unroll") for (int n = 0; n < 2; ++n) dst[n] = *(const LAS v8i*)(lds + PG8_SB(b, h) + b_ + n * 2048); } while (0)
#define PG8_MMA(ai, bj, At, Bt) do { __builtin_amdgcn_s_setprio(1); _Pragma("unroll") for (int m = 0; m < 4; ++m) _Pragma("unroll") for (int n = 0; n < 2; ++n) \
        acc[ai][bj][m][n] = __builtin_amdgcn_mfma_scale_f32_16x16x128_f8f6f4(Bt[n], At[m], acc[ai][bj][m][n], 0, 0, 0, sc8, 0, sc8); __builtin_amdgcn_s_setprio(0); } while (0)
#define PG8_PIECE(bufoff, gbase, voff, i) do { glds16_s((voff)[i], (const char*)(gbase), ldsb + (unsigned)(bufoff) + ldsw + (unsigned)((i) * 8192)); __builtin_amdgcn_sched_barrier(0); } while (0)
#define PG8_MMA_I(ai, bj, At, Bt, P1, P2, P3) do { __builtin_amdgcn_s_setprio(1); _Pragma("unroll") for (int m = 0; m < 4; ++m) _Pragma("unroll") for (int n = 0; n < 2; ++n) { \
        acc[ai][bj][m][n] = __builtin_amdgcn_mfma_scale_f32_16x16x128_f8f6f4(Bt[n], At[m], acc[ai][bj][m][n], 0, 0, 0, sc8, 0, sc8); \
        if (2 * m + n == 1) { __builtin_amdgcn_sched_barrier(0); P1; } if (2 * m + n == 3) { __builtin_amdgcn_sched_barrier(0); P2; } if (2 * m + n == 5) { __builtin_amdgcn_sched_barrier(0); P3; } } __builtin_amdgcn_s_setprio(0); } while (0)
#define PG8_WAIT_V(n) asm volatile("s_waitcnt vmcnt(" #n ")" ::: "memory")
#define PG8_WAIT_L(n) asm volatile("s_waitcnt lgkmcnt(" #n ")" ::: "memory")
#define PG8_BAR __builtin_amdgcn_s_barrier()
#define PG8_SCHED __builtin_amdgcn_sched_barrier(0)
    Unit cur, nxt; int ui = 0;
    if (!S.next(0, cur)) return;
    int sc8 = 0x7c7c7c7c; asm volatile("" : "+v"(sc8));
    float zf_ = 0.f; asm volatile("" : "+v"(zf_));
    f32x4 acc[2][2][4][2];
#pragma unroll
    for (int a = 0; a < 2; ++a)
#pragma unroll
        for (int b = 0; b < 2; ++b)
#pragma unroll
            for (int m = 0; m < 4; ++m)
#pragma unroll
                for (int n = 0; n < 2; ++n) acc[a][b][m][n] = (f32x4){zf_, zf_, zf_, zf_};
    v8i At[4], B0[2], B1[2];
    const char* cA = uni_ptr(S.abase(cur)); const char* cB = uni_ptr(S.bbase(cur));
    if constexpr (SP2) {
        PG8_STAGE(PG8_SB(0, 0), cB, voffB); PG8_STAGE(PG8_SB(0, 1), cB + hstep, voffB); PG8_STAGE(PG8_SA(0, 0), cA, voffA); PG8_STAGE(PG8_SA(0, 1), cA + hstep, voffA);
        if (wr == 1) PG8_BAR;
        PG8_WAIT_V(2); PG8_BAR;
        PG8_STAGE(PG8_SB(1, 0), cB + kstep, voffB); PG8_STAGE(PG8_SA(1, 0), cA + kstep, voffA); PG8_STAGE(PG8_SB(1, 1), cB + hstep + kstep, voffB);
        PG8_WAIT_V(6); PG8_BAR;
    } else {
        PG8_STAGE(PG8_SB(0, 0), cB, voffB); PG8_STAGE(PG8_SA(0, 0), cA, voffA); PG8_STAGE(PG8_SB(0, 1), cB + hstep, voffB); PG8_STAGE(PG8_SA(0, 1), cA + hstep, voffA);
        if (wr == 1) PG8_BAR;
        PG8_WAIT_V(4); PG8_BAR;
        PG8_STAGE(PG8_SB(1, 0), cB + kstep, voffB); PG8_STAGE(PG8_SA(1, 0), cA + kstep, voffA); PG8_STAGE(PG8_SB(1, 1), cB + hstep + kstep, voffB);
        PG8_WAIT_V(6); PG8_BAR;
    }
    for (;;) {
        const bool has_next = S.next(ui + 1, nxt);
        const char* nA = has_next ? uni_ptr(S.abase(nxt)) : cA; const char* nB = has_next ? uni_ptr(S.bbase(nxt)) : cB;
        for (int t = 0; t < nt; t += 2) {
            const bool last = (t == nt - 2);
            const char* a1 = cA + (size_t)(t + 1) * kstep;
            const char* a2 = last ? nA : cA + (size_t)(t + 2) * kstep; const char* b2 = last ? nB : cB + (size_t)(t + 2) * kstep;
            const char* a3 = a2 + kstep; const char* b3 = b2 + kstep;
            if constexpr (SP2) {
            PG8_LDB(B0, 0, 0); PG8_LDB(B1, 0, 1); PG8_SCHED; PG8_LDA(At, 0, 0); PG8_STAGE(PG8_SA(1, 1), a1 + hstep, voffA);
            PG8_WAIT_V(8); PG8_WAIT_L(0); PG8_BAR; PG8_MMA(0, 0, At, B0); PG8_MMA(0, 1, At, B1); PG8_BAR; PG8_SCHED;
            PG8_LDA(At, 0, 1); PG8_STAGE(PG8_SB(0, 0), b2, voffB); PG8_STAGE(PG8_SB(0, 1), b2 + hstep, voffB); PG8_STAGE(PG8_SA(0, 0), a2, voffA);
            PG8_WAIT_V(8); PG8_WAIT_L(0); PG8_BAR; PG8_MMA(1, 0, At, B0); PG8_MMA(1, 1, At, B1); PG8_BAR; PG8_SCHED;
            PG8_LDB(B0, 1, 0); PG8_LDB(B1, 1, 1); PG8_SCHED; PG8_LDA(At, 1, 0); PG8_STAGE(PG8_SA(0, 1), a2 + hstep, voffA);
            PG8_WAIT_V(8); PG8_WAIT_L(0); PG8_BAR; PG8_MMA(0, 0, At, B0); PG8_MMA(0, 1, At, B1); PG8_BAR; PG8_SCHED;
            PG8_LDA(At, 1, 1); PG8_STAGE(PG8_SB(1, 0), b3, voffB); PG8_STAGE(PG8_SB(1, 1), b3 + hstep, voffB); PG8_STAGE(PG8_SA(1, 0), a3, voffA);
            PG8_WAIT_V(8); PG8_WAIT_L(0); PG8_BAR; PG8_MMA(1, 0, At, B0); PG8_MMA(1, 1, At, B1); PG8_BAR; PG8_SCHED;
            } else {
            PG8_LDB(B0, 0, 0); PG8_SCHED; PG8_LDA(At, 0, 0); PG8_STAGE(PG8_SA(1, 1), a1 + hstep, voffA);
            PG8_WAIT_L(8); PG8_BAR; PG8_WAIT_L(0); PG8_MMA(0, 0, At, B0); PG8_BAR; PG8_SCHED;
            PG8_LDB(B1, 0, 1); PG8_STAGE(PG8_SB(0, 0), b2, voffB);
            PG8_BAR; PG8_WAIT_L(0); PG8_MMA(0, 1, At, B1); PG8_BAR;
            PG8_LDA(At, 0, 1); PG8_STAGE(PG8_SA(0, 0), a2, voffA);
            PG8_BAR; PG8_WAIT_L(0); PG8_MMA(1, 0, At, B0); PG8_BAR; PG8_SCHED;
            PG8_STAGE(PG8_SB(0, 1), b2 + hstep, voffB);
            PG8_WAIT_V(6); PG8_BAR; PG8_MMA(1, 1, At, B1); PG8_BAR;
            PG8_LDB(B0, 1, 0); PG8_SCHED; PG8_LDA(At, 1, 0); PG8_STAGE(PG8_SA(0, 1), a2 + hstep, voffA);
            PG8_WAIT_L(8); PG8_BAR; PG8_WAIT_L(0); PG8_MMA(0, 0, At, B0); PG8_BAR; PG8_SCHED;
            PG8_LDB(B1, 1, 1); PG8_STAGE(PG8_SB(1, 0), b3, voffB);
            PG8_BAR; PG8_WAIT_L(0); PG8_MMA(0, 1, At, B1); PG8_BAR;
            PG8_LDA(At, 1, 1); PG8_STAGE(PG8_SA(1, 0), a3, voffA);
            PG8_BAR; PG8_WAIT_L(0); PG8_MMA(1, 0, At, B0); PG8_BAR; PG8_SCHED;
            PG8_STAGE(PG8_SB(1, 1), b3 + hstep, voffB);
            PG8_WAIT_V(6); PG8_BAR; PG8_MMA(1, 1, At, B1); PG8_BAR;
            }
        }
        if constexpr (ALIGN_EPI) { if (wr == 0) PG8_BAR; }
        asm volatile("" ::: "memory"); __builtin_amdgcn_sched_barrier(0);
        { int t2_ = tid; asm volatile("" : "+v"(t2_)); const int w2_ = __builtin_amdgcn_readfirstlane(t2_ >> 6), l2_ = t2_ & 63; E(acc, cur, w2_ >> 2, w2_ & 3, l2_ & 15, l2_ >> 4); }
        if (!has_next) break;
#pragma unroll
        for (int a = 0; a < 2; ++a)
#pragma unroll
            for (int b = 0; b < 2; ++b)
#pragma unroll
                for (int m = 0; m < 4; ++m)
#pragma unroll
                    for (int n = 0; n < 2; ++n) acc[a][b][m][n] = (f32x4){zf_, zf_, zf_, zf_};
        cur = nxt; cA = nA; cB = nB; ++ui;
        if constexpr (ALIGN_EPI) { if (wr == 1) PG8_BAR; }
    }
    PG8_WAIT_V(0);
    if constexpr (!ALIGN_EPI) { if (wr == 0) PG8_BAR; }
    PG8_BAR;
#undef PG8_SA
#undef PG8_SB
#undef PG8_STAGE
#undef PG8_LDA
#undef PG8_LDB
#undef PG8_MMA
#undef PG8_MMA_I
#undef PG8_PIECE
#undef PG8_WAIT_V
#undef PG8_WAIT_L
#undef PG8_BAR
#undef PG8_SCHED
}
}

struct SchedPlain {
    pg8::StaticOrder o; const char* A; const char* B; size_t tstep;
    DI bool next(int i, pg8::Unit& u) const { return o.next(i, u); }
    DI const char* abase(const pg8::Unit& u) const { return A + (size_t)u.pm * tstep; }
    DI const char* bbase(const pg8::Unit& u) const { return B + (size_t)u.pn * tstep; }
};
struct SchedBranch {
    pg8::StaticOrder o; const char* A; const char* B; size_t tstep, aslab;
    DI bool next(int i, pg8::Unit& u) const { pg8::Unit t; if (!o.next(i / 3, t)) return false; u.pm = t.pm; u.pn = t.pn + 4 * (i % 3); return true; }
    DI const char* abase(const pg8::Unit& u) const { return A + (size_t)(u.pn >> 2) * aslab + (size_t)u.pm * tstep; }
    DI const char* bbase(const pg8::Unit& u) const { return B + (size_t)u.pn * tstep; }
};
struct SchedMoe {
    pg8::StaticOrder o; const char* A; const char* B; unsigned eslab; const LAS int* texp;
    DI bool next(int i, pg8::Unit& u) const { return o.next(i, u); }
    DI const char* abase(const pg8::Unit& u) const { return A + (size_t)u.pm * (256u * 1024u); }
    DI const char* bbase(const pg8::Unit& u) const { return B + (size_t)((unsigned)texp[u.pm] * eslab) + (size_t)u.pn * (256u * 1024u); }
};

struct SchedMoeB {
    pg8::StaticOrder o; const char* A; const char* B; unsigned eslab; const LAS int* texp;
    DI bool next(int i, pg8::Unit& u) const { return o.next(i, u); }
    DI const char* abase(const pg8::Unit& u) const { return A + (size_t)u.pm * (256u * 2048u); }
    DI const char* bbase(const pg8::Unit& u) const { return B + (size_t)((unsigned)texp[u.pm] * eslab) + (size_t)u.pn * (256u * 2048u); }
};

DI int qt_src(int lane) { return (((lane >> 2) + 16 * (lane & 3)) * 4); }
DI f32x4 qt4f(int src4, f32x4 v);
DI u32x4 qt4(int src4, u32x4 w) { u32x4 r; r.x = (unsigned)__builtin_amdgcn_ds_bpermute(src4, (int)w.x); r.y = (unsigned)__builtin_amdgcn_ds_bpermute(src4, (int)w.y); r.z = (unsigned)__builtin_amdgcn_ds_bpermute(src4, (int)w.z); r.w = (unsigned)__builtin_amdgcn_ds_bpermute(src4, (int)w.w); return r; }
DI f32x4 qt4f(int src4, f32x4 v) { return __builtin_bit_cast(f32x4, qt4(src4, __builtin_bit_cast(u32x4, v))); }
struct EpiStoreBf16 {
    static constexpr bool PERM = true;
    bf16_t* O; int ldc; int coff = 0;
    DI void operator()(const f32x4 (&acc)[2][2][4][2], const pg8::Unit& u, int wr, int wc, int fr, int fq) const {
        const int lane = fr + 16 * fq, src4 = qt_src(lane); fr = lane >> 2; fq = lane & 3;
        const int row0 = u.pm * 256 + wr * 64 + fr, col0 = coff + u.pn * 256 + wc * 32 + 8 * fq;
#pragma unroll
        for (int ai = 0; ai < 2; ++ai)
#pragma unroll
            for (int m = 0; m < 4; ++m) { bf16_t* rowp = O + (size_t)(row0 + ai * 128 + m * 16) * ldc + col0;
#pragma unroll
                for (int bj = 0; bj < 2; ++bj) { const f32x4 v0 = acc[ai][bj][m][0], v1 = acc[ai][bj][m][1];
                    u32x4 w; w.x = pk2(v0[0], v0[1]); w.y = pk2(v0[2], v0[3]); w.z = pk2(v1[0], v1[1]); w.w = pk2(v1[2], v1[3]);
                    w = qt4(src4, w);
                    *(u32x4*)(rowp + bj * 128) = w; } }
    }
};
struct EpiStoreBf16N {
    static constexpr bool PERM = false;
    bf16_t* O; int ldc; int coff = 0;
    DI void operator()(const f32x4 (&acc)[2][2][4][2], const pg8::Unit& u, int wr, int wc, int fr, int fq) const {
        const int lane = fr + 16 * fq, a_ = lane >> 2, b_ = lane & 3, src4 = (a_ + 16 * (((b_ & 1) << 1) | (b_ >> 1))) * 4;
        const int row0 = u.pm * 256 + wr * 64 + a_, col0 = coff + u.pn * 256 + wc * 32 + 8 * b_;
#pragma unroll
        for (int ai = 0; ai < 2; ++ai)
#pragma unroll
            for (int m = 0; m < 4; ++m) { bf16_t* rowp = O + (size_t)(row0 + ai * 128 + m * 16) * ldc + col0;
#pragma unroll
                for (int bj = 0; bj < 2; ++bj) { const f32x4 v0 = acc[ai][bj][m][0], v1 = acc[ai][bj][m][1];
                    unsigned x0 = pk2(v0[0], v0[1]), y0 = pk2(v0[2], v0[3]), x1 = pk2(v1[0], v1[1]), y1 = pk2(v1[2], v1[3]);
                    { const auto r = __builtin_amdgcn_permlane16_swap(x0, x1, false, false); x0 = r[0]; x1 = r[1]; }
                    { const auto r = __builtin_amdgcn_permlane16_swap(y0, y1, false, false); y0 = r[0]; y1 = r[1]; }
                    u32x4 w; w.x = x0; w.y = y0; w.z = x1; w.w = y1;
                    w = qt4(src4, w);
                    *(u32x4*)(rowp + bj * 128) = w; } }
    }
};
struct EpiQaRope {
    static constexpr bool PERM = true;
    bf16_t* O; const float* rope;
    DI void operator()(const f32x4 (&acc)[2][2][4][2], const pg8::Unit& u, int wr, int wc, int fr, int fq) const {
        const int row0 = u.pm * 256 + wr * 64 + fr, col0 = u.pn * 256 + wc * 32 + 8 * fq;
#pragma unroll
        for (int ai = 0; ai < 2; ++ai)
#pragma unroll
            for (int m = 0; m < 4; ++m) { const int row = row0 + ai * 128 + m * 16; bf16_t* rowp = O + (size_t)row * 768 + col0;
#pragma unroll
                for (int bj = 0; bj < 2; ++bj) { f32x4 v0 = acc[ai][bj][m][0], v1 = acc[ai][bj][m][1];
                    const int c8 = col0 + bj * 128, p0 = c8 % 96;
                    if (p0 < 32) { const f32x4* cs = (const f32x4*)(rope + (size_t)row * 48 + p0); const f32x4 a = cs[0], b = cs[1];
                        const f32x4 r0 = {v0[0] * a[0] - v0[1] * a[1], v0[1] * a[0] + v0[0] * a[1], v0[2] * a[2] - v0[3] * a[3], v0[3] * a[2] + v0[2] * a[3]};
                        const f32x4 r1 = {v1[0] * b[0] - v1[1] * b[1], v1[1] * b[0] + v1[0] * b[1], v1[2] * b[2] - v1[3] * b[3], v1[3] * b[2] + v1[2] * b[3]};
                        v0 = r0; v1 = r1; }
                    u32x4 w; w.x = pk2(v0[0], v0[1]); w.y = pk2(v0[2], v0[3]); w.z = pk2(v1[0], v1[1]); w.w = pk2(v1[2], v1[3]);
                    *(u32x4*)(rowp + bj * 128) = w; } }
    }
};
struct EpiBranchGate {
    static constexpr bool PERM = true;
    bf16_t* MG; const bf16_t* P; const float* bgate;
    DI void operator()(const f32x4 (&acc)[2][2][4][2], const pg8::Unit& u, int wr, int wc, int fr, int fq) const {
        const int lane = fr + 16 * fq, src4 = qt_src(lane); fr = lane >> 2; fq = lane & 3;
        const int n = u.pn >> 2, row0 = u.pm * 256 + wr * 64 + fr, colg = u.pn * 256 + wc * 32 + 8 * fq, col0 = colg - n * 1024;
        f32x4 bg[2][2];
#pragma unroll
        for (int bj = 0; bj < 2; ++bj) { bg[bj][0] = *(const f32x4*)(bgate + colg + bj * 128) * -1.4426950408889634f; bg[bj][1] = *(const f32x4*)(bgate + colg + bj * 128 + 4) * -1.4426950408889634f; }
        u32x4 gl[2][2][2], pv[2][2][2];
#define EBG_LOAD(slot, grp) do { _Pragma("unroll") for (int m2 = 0; m2 < 2; ++m2) _Pragma("unroll") for (int bj = 0; bj < 2; ++bj) { const size_t row = (size_t)(row0 + ((grp) >> 1) * 128 + (2 * ((grp) & 1) + m2) * 16); \
            gl[slot][m2][bj] = *(const u32x4*)(P + row * NP + colg + bj * 128); pv[slot][m2][bj] = (n > 0) ? *(const u32x4*)(MG + row * D_MODEL + col0 + bj * 128) : (u32x4){0u, 0u, 0u, 0u}; } } while (0)
        EBG_LOAD(0, 0);
#pragma unroll
        for (int grp = 0; grp < 4; ++grp) {
            const int slot = grp & 1, ai = grp >> 1, mh = grp & 1;
            if (grp + 1 < 4) { if (slot == 0) EBG_LOAD(1, grp + 1); else EBG_LOAD(0, grp + 1); }
            asm volatile("" ::: "memory");
#pragma unroll
            for (int m2 = 0; m2 < 2; ++m2)
#pragma unroll
                for (int bj = 0; bj < 2; ++bj) { const int m = 2 * mh + m2; const size_t row = (size_t)(row0 + ai * 128 + m * 16);
                    const f32x4 v0 = qt4f(src4, acc[ai][bj][m][0]), v1 = qt4f(src4, acc[ai][bj][m][1]);
                    const u32x4 g = gl[slot][m2][bj], q = pv[slot][m2][bj];
                    float o[8];
#define EBG_SIG(gl_, b_) __builtin_amdgcn_rcpf(1.0f + __builtin_amdgcn_exp2f(__builtin_fmaf((gl_), -1.4426950408889634f, (b_))))
                    o[0] = v0[0] * EBG_SIG(bf_lo(g.x), bg[bj][0][0]) + bf_lo(q.x); o[1] = v0[1] * EBG_SIG(bf_hi(g.x), bg[bj][0][1]) + bf_hi(q.x);
                    o[2] = v0[2] * EBG_SIG(bf_lo(g.y), bg[bj][0][2]) + bf_lo(q.y); o[3] = v0[3] * EBG_SIG(bf_hi(g.y), bg[bj][0][3]) + bf_hi(q.y);
                    o[4] = v1[0] * EBG_SIG(bf_lo(g.z), bg[bj][1][0]) + bf_lo(q.z); o[5] = v1[1] * EBG_SIG(bf_hi(g.z), bg[bj][1][1]) + bf_hi(q.z);
                    o[6] = v1[2] * EBG_SIG(bf_lo(g.w), bg[bj][1][2]) + bf_lo(q.w); o[7] = v1[3] * EBG_SIG(bf_hi(g.w), bg[bj][1][3]) + bf_hi(q.w);
#undef EBG_SIG
                    u32x4 w; w.x = pk2(o[0], o[1]); w.y = pk2(o[2], o[3]); w.z = pk2(o[4], o[5]); w.w = pk2(o[6], o[7]);
                    *(u32x4*)(MG + row * D_MODEL + col0 + bj * 128) = w; }
        }
#undef EBG_LOAD
    }
};
struct EpiResidual {
    static constexpr bool PERM = false;
    const float* xin; float* xout; const float* gmod;
    DI void operator()(const f32x4 (&acc)[2][2][4][2], const pg8::Unit& u, int wr, int wc, int fr, int fq) const {
        const int lane = fr + 16 * fq, src4 = qt_src(lane); fr = lane >> 2; fq = lane & 3;
        const int row0 = u.pm * 256 + wr * 64 + fr, col0 = u.pn * 256 + wc * 32 + 4 * fq;
        const float* gm = gmod + (size_t)(u.pm >> 3) * 6144 + col0;
        f32x4 gv[2][2];
#pragma unroll
        for (int bj = 0; bj < 2; ++bj)
#pragma unroll
            for (int n = 0; n < 2; ++n) gv[bj][n] = *(const f32x4*)(gm + bj * 128 + n * 16);
        f32x4 xv[2][2][2][2];
#define ERS_LOAD(slot, grp) do { _Pragma("unroll") for (int m2 = 0; m2 < 2; ++m2) { const size_t off = (size_t)(row0 + ((grp) >> 1) * 128 + (2 * ((grp) & 1) + m2) * 16) * D_MODEL + col0; \
            _Pragma("unroll") for (int bj = 0; bj < 2; ++bj) _Pragma("unroll") for (int n = 0; n < 2; ++n) xv[slot][m2][bj][n] = *(const f32x4*)(xin + off + bj * 128 + n * 16); } } while (0)
        ERS_LOAD(0, 0);
#pragma unroll
        for (int grp = 0; grp < 4; ++grp) {
            const int slot = grp & 1, ai = grp >> 1, mh = grp & 1;
            if (grp + 1 < 4) { if (slot == 0) ERS_LOAD(1, grp + 1); else ERS_LOAD(0, grp + 1); }
            asm volatile("" ::: "memory");
#pragma unroll
            for (int m2 = 0; m2 < 2; ++m2) { const size_t off = (size_t)(row0 + ai * 128 + (2 * mh + m2) * 16) * D_MODEL + col0;
#pragma unroll
                for (int bj = 0; bj < 2; ++bj)
#pragma unroll
                    for (int n = 0; n < 2; ++n) {
                        const f32x4 av = qt4f(src4, acc[ai][bj][2 * mh + m2][n]);
                        *(f32x4*)(xout + off + bj * 128 + n * 16) = xv[slot][m2][bj][n] + gv[bj][n] * av; } }
        }
#undef ERS_LOAD
    }
};
struct EpiSwiglu {
    static constexpr bool PERM = false;
    bf16_t* ACT; const float* b1; const LAS int* texp;
    DI void operator()(const f32x4 (&acc)[2][2][4][2], const pg8::Unit& u, int wr, int wc, int fr, int fq) const {
        const int row0 = u.pm * 256 + wr * 64 + fr, e = texp[u.pm];
        const float* bb = b1 + (size_t)e * 2048;
#pragma unroll
        for (int bj = 0; bj < 2; ++bj) { const int j0 = u.pn * 128 + bj * 64 + wc * 16 + 4 * fq;
            const f32x4 ba = *(const f32x4*)(bb + 2 * j0), bc = *(const f32x4*)(bb + 2 * j0 + 4);
            const f32x4 bgt = {ba[0], ba[2], bc[0], bc[2]}, bup = {ba[1], ba[3], bc[1], bc[3]};
#pragma unroll
            for (int ai = 0; ai < 2; ++ai)
#pragma unroll
                for (int m = 0; m < 4; ++m) { const f32x4 g = acc[ai][bj][m][0] + bgt, up = acc[ai][bj][m][1] + bup; float o[4];
#pragma unroll
                    for (int i = 0; i < 4; ++i) { const float gg = fminf(g[i], 7.0f), uu = fminf(fmaxf(up[i], -7.0f), 7.0f);
                        o[i] = __builtin_fmaf(uu, gg, gg) * __builtin_amdgcn_rcpf(1.0f + __builtin_amdgcn_exp2f((-1.702f * 1.4426950408889634f) * gg));
                    }
                    u32x2 w; w.x = pk2(o[0], o[1]); w.y = pk2(o[2], o[3]);
                    *(u32x2*)(ACT + (size_t)(row0 + ai * 128 + m * 16) * D_EXP + j0) = w; } }
    }
};
struct EpiSwiglu8 {
    static constexpr bool PERM = false;
    unsigned char* ACT; const float* b1; const LAS int* texp;
    DI void operator()(const f32x4 (&acc)[2][2][4][2], const pg8::Unit& u, int wr, int wc, int fr, int fq) const {
        const int row0 = u.pm * 256 + wr * 64 + fr, e = texp[u.pm];
        const float* bb = b1 + (size_t)e * 2048;
#pragma unroll
        for (int bj = 0; bj < 2; ++bj) { const int j0 = u.pn * 128 + bj * 64 + wc * 16 + 4 * fq;
            const f32x4 ba = *(const f32x4*)(bb + 2 * j0), bc = *(const f32x4*)(bb + 2 * j0 + 4);
            const f32x4 bgt = {ba[0], ba[2], bc[0], bc[2]}, bup = {ba[1], ba[3], bc[1], bc[3]};
#pragma unroll
            for (int ai = 0; ai < 2; ++ai) {
                unsigned w[4];
#pragma unroll
                for (int m = 0; m < 4; ++m) { const f32x4 g = acc[ai][bj][m][0] + bgt, up = acc[ai][bj][m][1] + bup; float o[4];
#pragma unroll
                    for (int i = 0; i < 4; ++i) { const float gg = fminf(g[i], 7.0f), uu = fminf(fmaxf(up[i], -7.0f), 7.0f);
                        o[i] = __builtin_fmaf(uu, gg, gg) * __builtin_amdgcn_rcpf(1.0f + __builtin_amdgcn_exp2f((-1.702f * 1.4426950408889634f) * gg));
                    }
                    w[m] = pk4_fp8(o[0], o[1], o[2], o[3]); }
                { const auto r = __builtin_amdgcn_permlane16_swap(w[0], w[1], false, false); w[0] = r[0]; w[1] = r[1]; }
                { const auto r = __builtin_amdgcn_permlane16_swap(w[2], w[3], false, false); w[2] = r[0]; w[3] = r[1]; }
                { const auto r = __builtin_amdgcn_permlane32_swap(w[0], w[2], false, false); w[0] = r[0]; w[2] = r[1]; }
                { const auto r = __builtin_amdgcn_permlane32_swap(w[1], w[3], false, false); w[1] = r[0]; w[3] = r[1]; }
                u32x4 wv; wv.x = w[0]; wv.y = w[1]; wv.z = w[2]; wv.w = w[3];
                *(u32x4*)(ACT + (size_t)(row0 + ai * 128 + fq * 16) * D_EXP + (j0 - 4 * fq)) = wv; } }
    }
};
struct EpiMoeOut {
    static constexpr bool PERM = true;
    bf16_t* Y; const float* b2; const float* gate; const LAS int* texp;
    DI void operator()(const f32x4 (&acc)[2][2][4][2], const pg8::Unit& u, int wr, int wc, int fr, int fq) const {
        const int row0 = u.pm * 256 + wr * 64 + fr, col0 = u.pn * 256 + wc * 32 + 8 * fq, e = texp[u.pm];
        const float* bb = b2 + (size_t)e * D_MODEL + col0;
        const int lane = fr + 16 * fq, src4 = qt_src(lane), rowq = (lane >> 2) - fr, colq = 8 * ((lane & 3) - fq);
        f32x4 bv[2][2];
#pragma unroll
        for (int bj = 0; bj < 2; ++bj) { bv[bj][0] = *(const f32x4*)(bb + bj * 128); bv[bj][1] = *(const f32x4*)(bb + bj * 128 + 4); }
#pragma unroll
        for (int ai = 0; ai < 2; ++ai) {
            float gt[4];
#pragma unroll
            for (int m = 0; m < 4; ++m) gt[m] = gate[row0 + ai * 128 + m * 16];
            asm volatile("" ::: "memory");
#pragma unroll
            for (int m = 0; m < 4; ++m) { const int row = row0 + ai * 128 + m * 16; const float g = gt[m];
#pragma unroll
                for (int bj = 0; bj < 2; ++bj) { const f32x4 v0 = (acc[ai][bj][m][0] + bv[bj][0]) * g, v1 = (acc[ai][bj][m][1] + bv[bj][1]) * g;
                    u32x4 w; w.x = pk2(v0[0], v0[1]); w.y = pk2(v0[2], v0[3]); w.z = pk2(v1[0], v1[1]); w.w = pk2(v1[2], v1[3]);
                    *(u32x4*)(Y + (size_t)(row + rowq) * D_MODEL + col0 + colq + bj * 128) = qt4(src4, w); } }
            asm volatile("" ::: "memory");
        }
    }
};

constexpr size_t MiB = 1u << 20;
constexpr size_t WS_CTL = 0, CTL_ZERO_BYTES = 1 * MiB;
constexpr size_t WS_MOD = 1 * MiB, WS_ROPE = 2 * MiB, WS_WIN = 8 * MiB, WS_WUQ = 33 * MiB, WS_WUKV = 34 * MiB, WS_WB = 35 * MiB, WS_WOUT = 41 * MiB, WS_W1 = 53 * MiB, WS_W2 = 309 * MiB,
                 WS_X1 = 437 * MiB, WS_H = 565 * MiB, WS_CQ = 629 * MiB, WS_CKV = 645 * MiB, WS_KPE = 661 * MiB, WS_QA = 663 * MiB, WS_KV = 711 * MiB, WS_O3 = 775 * MiB, WS_QC = 871 * MiB,
                 WS_KC = 903 * MiB, WS_VC = 907 * MiB, WS_QI = 911 * MiB, WS_KI = 943 * MiB, WS_IW = 947 * MiB, WS_ROUTE = 948 * MiB, WS_P = 952 * MiB, WS_GY = 1352 * MiB, WS_END = 1544 * MiB;
constexpr size_t WS_HG8 = WS_QA;
constexpr size_t WS_XB = WS_P, WS_ACT = WS_P + 272 * MiB, WS_Y = WS_P, WS_H8 = WS_H;
constexpr size_t RT_TOPE = 0, RT_TOPG = 512 * 1024, RT_RANK = 1 * MiB, RT_SLOTOF = 1 * MiB + 512 * 1024, RT_TOKOF = 2 * MiB, RT_GATEOF = 3 * MiB;
static_assert((size_t)NSLOT_MAX * 1024 * 2 <= 272 * MiB && WS_ACT + 272 * MiB <= WS_END, "MoE overlay: XB (fp8) and Y (bf16) share [P, P+272M) (XB is dead when Y is written); ACT in [P+272M, P+544M)");
static_assert((size_t)T_TOK * NP * 2 == 400 * MiB, "P size");
constexpr int CW_BAR = 4096, CW_CNT = 16384;
constexpr int LDS_BYTES = 163840, LDS_X = 131072, MISC_OFF = LDS_BYTES - 512;

struct Frame {
    LAS unsigned char* lds; int tid, lane, wave, G, bid; float zf;
    float* out; unsigned char* ws; unsigned* ctl;
};
extern __shared__ __attribute__((aligned(16))) unsigned char lds_raw[];
typedef __attribute__((address_space(4))) const char* kptr_t;
DI const void* kin(int i) {
#if defined(__HIP_DEVICE_COMPILE__)
    kptr_t ka = (kptr_t)__builtin_amdgcn_kernarg_segment_ptr(); asm volatile("" : "+s"(ka)); return (const void*)(GAS const void*)*(__attribute__((address_space(4))) const unsigned long long*)(ka + 8 * i);
#else
    (void)i; return nullptr;
#endif
}
#define KIN_x ((const float*)kin(0))
#define KIN_c ((const float*)kin(1))
#define KIN_pos ((const int*)kin(2))
#define KIN_norm1_g ((const float*)kin(3))
#define KIN_norm2_g ((const float*)kin(4))
#define KIN_w_ada ((const float*)kin(5))
#define KIN_b_ada ((const float*)kin(6))
#define KIN_w_in ((const float*)kin(7))
#define KIN_b_gate ((const float*)kin(8))
#define KIN_q_norm ((const float*)kin(9))
#define KIN_w_uq ((const float*)kin(10))
#define KIN_kv_norm ((const float*)kin(11))
#define KIN_w_ukv ((const float*)kin(12))
#define KIN_conv_w ((const float*)kin(13))
#define KIN_w_branch ((const float*)kin(14))
#define KIN_w_out ((const float*)kin(15))
#define KIN_router_w ((const float*)kin(16))
#define KIN_router_b ((const float*)kin(17))
#define KIN_w1 ((const float*)kin(18))
#define KIN_b1 ((const float*)kin(19))
#define KIN_w2 ((const float*)kin(20))
#define KIN_b2 ((const float*)kin(21))
#define KIN_final_g ((const float*)kin(22))
DI Frame make_frame(int wave0) {
    Frame F; unsigned z_ = 0u; asm volatile("" : "+v"(z_));
    F.lds = (LAS unsigned char*)lds_raw; F.lane = (int)__builtin_amdgcn_mbcnt_hi(~0u, __builtin_amdgcn_mbcnt_lo(~0u, z_)); F.wave = wave0; F.tid = wave0 * 64 + F.lane; F.G = gridDim.x; F.bid = blockIdx.x; F.zf = __uint_as_float(z_);
    F.out = (float*)kin(23); F.ws = (unsigned char*)kin(24); F.ctl = (unsigned*)F.ws;
    return F;
}
#define WSP(T, off) ((T*)(F.ws + (off)))


#define XB_TMO      128
#define XB_XCNT(j)  (256  + 64 * (j))
#define XB_XSUB(j)  (1280 + 64 * (j))
#define XB_XGEN(j)  (2304 + 64 * (j))
#define XB_TOP      3328
#define XB_TOPGEN   3392
#define XCD_BAR_WORDS 3456
#define XB_SPIN_CAP (1u << 18)
DI unsigned xb_ld(unsigned* p)              { return __hip_atomic_load(p, __ATOMIC_RELAXED, __HIP_MEMORY_SCOPE_AGENT); }
DI unsigned xb_add(unsigned* p, unsigned v) { return __hip_atomic_fetch_add(p, v, __ATOMIC_RELAXED, __HIP_MEMORY_SCOPE_AGENT); }
DI unsigned xb_xcc_id() { return (unsigned)__builtin_amdgcn_s_getreg((3 << 11) | 20) & 0xFu; }
#define XB_SPIN(cond, bar) do { unsigned _sp = 0; while (cond) { __builtin_amdgcn_s_sleep(1); \
    if ((++_sp & 255u) == 0u) { if (xb_ld(&(bar)[XB_TMO])) break; if (_sp > XB_SPIN_CAP) { atomicAdd(&(bar)[XB_TMO], 1u); break; } } } } while (0)
struct XcdBarrier { unsigned* bar; unsigned x; volatile LAS unsigned* st; };
DI XcdBarrier xcd_barrier_post(unsigned* bar, volatile LAS unsigned* st, int tid) {
    XcdBarrier b; b.bar = bar; b.x = xb_xcc_id(); b.st = st;
    if (tid == 0) (void)xb_add(&bar[XB_XCNT(b.x)], 1u);
    return b;
}
DI void xcd_barrier_complete(unsigned* bar, unsigned x, unsigned& nloc, unsigned& nx) {
    const unsigned G = gridDim.x * gridDim.y * gridDim.z;
    unsigned sum, cnt, mine, sp = 0u;
    for (;;) {
        sum = 0u; cnt = 0u; mine = 0u;
#pragma unroll
        for (unsigned j = 0; j < 16; ++j) { const unsigned c = xb_ld(&bar[XB_XCNT(j)]); sum += c; cnt += (c > 0u) ? 1u : 0u; mine = (j == x) ? c : mine; }
        if (sum == G) break;
        __builtin_amdgcn_s_sleep(1);
        if ((++sp & 255u) == 0u) { if (xb_ld(&bar[XB_TMO])) break; if (sp > XB_SPIN_CAP) { atomicAdd(&bar[XB_TMO], 1u); break; } }
    }
    nloc = mine > 0u ? mine : 1u; nx = cnt > 0u ? cnt : 1u;
}
DI void xcd_barrier(const XcdBarrier& b, int tid) {
    asm volatile("s_waitcnt vmcnt(0)" ::: "memory");
    __syncthreads();
    if (tid == 0) {
        unsigned* bar = b.bar;
        __builtin_amdgcn_s_waitcnt(0);
        unsigned nloc = b.st[0], nx = b.st[1];
        if (nloc == 0u) { xcd_barrier_complete(bar, b.x, nloc, nx); b.st[0] = nloc; b.st[1] = nx; }
        const unsigned old = xb_add(&bar[XB_XSUB(b.x)], 1u);
        const unsigned gen = old / nloc;
        if (old + 1u == (gen + 1u) * nloc) {
            __builtin_amdgcn_fence(__ATOMIC_RELEASE, "agent");
            asm volatile("s_waitcnt vmcnt(0)" ::: "memory");
            const unsigned og = xb_add(&bar[XB_TOP], 1u);
            const unsigned tg = og / nx;
            if (og + 1u == (tg + 1u) * nx) xb_add(&bar[XB_TOPGEN], 1u);
            else XB_SPIN(xb_ld(&bar[XB_TOPGEN]) == tg, bar);
            __builtin_amdgcn_fence(__ATOMIC_ACQUIRE, "agent");
            xb_add(&bar[XB_XGEN(b.x)], 1u);
            asm volatile("s_waitcnt vmcnt(0)" ::: "memory");
        } else {
            XB_SPIN(xb_ld(&bar[XB_XGEN(b.x)]) == gen, bar);
            __builtin_amdgcn_fence(__ATOMIC_ACQUIRE, "agent");
            asm volatile("s_waitcnt vmcnt(0)" ::: "memory");
        }
    }
    __syncthreads();
}

constexpr float QSCALE_MLA = 0.10206207261596577f * 1.4426950408889634f;
constexpr float QSCALE_DSA = 0.125f * 1.4426950408889634f;
#ifndef G1_F8_COLS
#define G1_F8_COLS 3072
#endif
DI int rope_perm(int p, int half) { return (p < 2 * half) ? (p >> 1) + half * (p & 1) : p; }
DI int cmap_in(int r) {
    if (r < PC_CONV) return OC_GATE + r;
    if (r < PC_DQ) return OC_CONV + (r - PC_CONV);
    if (r < PC_IQ) { const int j = r - PC_DQ; return OC_DQ + (j & ~63) + rope_perm(j & 63, 8); }
    if (r < PC_QLAT) { const int j = r - PC_IQ; return OC_IQ + (j & ~63) + rope_perm(j & 63, 8); }
    if (r < PC_KVLAT) return OC_QLAT + (r - PC_QLAT);
    if (r < PC_DKV) { const int j = r - PC_KVLAT; return j < 128 ? OC_KVLAT + j : OC_KVLAT + 128 + rope_perm(j - 128, 16); }
    if (r < PC_IK) { const int j = r - PC_DKV; return j < 64 ? OC_DKV + rope_perm(j, 8) : OC_DKV + j; }
    if (r < PC_IW) return OC_IK + rope_perm(r - PC_IK, 8);
    if (r < IN_COLS) return OC_IW + (r - PC_IW);
    return -1;
}
DI int cmap_uq(int r) { const int h = r / 96, p = r % 96; return h * 96 + rope_perm(p, 16); }
DI int cmap_w1(int R) { const int pn = R >> 8, rem = R & 255, bj = rem >> 7, wc = (rem >> 5) & 3, n = (rem >> 4) & 1, f = rem & 15; return 2 * (pn * 128 + bj * 64 + wc * 16 + f) + n; }
DI void transpose_item(const float* W, int K, int N, bf16_t* WT, int ldk, int koff, LAS float* scr, int k0, int n0, int csrc, int lane, float qs = 1.0f) {
#pragma unroll 8
    for (int i = 0; i < 32; ++i) { const int kk = 2 * i + (lane >> 5); float v = 0.f; if (csrc >= 0 && k0 + kk < K) v = W[(size_t)(k0 + kk) * N + csrc] * qs; scr[kk * 33 + (lane & 31)] = v; }
    LDS_WAIT(); asm volatile("" ::: "memory");
    const int c = lane & 7;
#pragma unroll
    for (int j = 0; j < 4; ++j) { const int n = (lane >> 3) + 8 * j; const LAS float* s = scr + (8 * c) * 33 + n;
        u32x4 o; o.x = pk2(s[0 * 33], s[1 * 33]); o.y = pk2(s[2 * 33], s[3 * 33]); o.z = pk2(s[4 * 33], s[5 * 33]); o.w = pk2(s[6 * 33], s[7 * 33]);
        *(u32x4*)(WT + (size_t)(n0 + n) * ldk + koff + k0 + 8 * c) = o; }
    LDS_WAIT(); asm volatile("" ::: "memory");
}
DI void transpose_item_f8(const float* W, int K, int N, unsigned char* WT, int ldk, LAS float* scr, int k0, int n0, int csrc, int lane, float qs) {
#pragma unroll 8
    for (int i = 0; i < 32; ++i) { const int kk = 2 * i + (lane >> 5); scr[kk * 33 + (lane & 31)] = W[(size_t)(k0 + kk) * N + csrc] * qs; }
    LDS_WAIT(); asm volatile("" ::: "memory");
    const int c = lane & 7;
#pragma unroll
    for (int j = 0; j < 4; ++j) { const int n = (lane >> 3) + 8 * j; const LAS float* s = scr + (8 * c) * 33 + n;
        u32x2 o; o.x = pk4_fp8(s[0 * 33], s[1 * 33], s[2 * 33], s[3 * 33]); o.y = pk4_fp8(s[4 * 33], s[5 * 33], s[6 * 33], s[7 * 33]);
        *(u32x2*)(WT + (size_t)(n0 + n) * ldk + k0 + 8 * c) = o; }
    LDS_WAIT(); asm volatile("" ::: "memory");
}
DI void titem_load(const float* W, int N, int k0, int csrc, int lane, float (&v)[32]) {
#pragma unroll
    for (int i = 0; i < 32; ++i) v[i] = W[(size_t)(k0 + 2 * i + (lane >> 5)) * N + csrc];
}
DI void titem_store_f8(const float (&v)[32], unsigned char* WT, int ldk, LAS float* scr, int k0, int n0, int lane, float qs) {
#pragma unroll
    for (int i = 0; i < 32; ++i) scr[(2 * i + (lane >> 5)) * 33 + (lane & 31)] = v[i] * qs;
    LDS_WAIT(); asm volatile("" ::: "memory");
    const int c = lane & 7;
#pragma unroll
    for (int j = 0; j < 4; ++j) { const int n = (lane >> 3) + 8 * j; const LAS float* s = scr + (8 * c) * 33 + n;
        u32x2 o; o.x = pk4_fp8(s[0 * 33], s[1 * 33], s[2 * 33], s[3 * 33]); o.y = pk4_fp8(s[4 * 33], s[5 * 33], s[6 * 33], s[7 * 33]);
        *(u32x2*)(WT + (size_t)(n0 + n) * ldk + k0 + 8 * c) = o; }
    LDS_WAIT(); asm volatile("" ::: "memory");
}
template <bool W1>
DI void convert_family_f8(const float* src, unsigned char* dst, int N, int nmat, LAS float* scr, int gw, int NGW, int lane) {
    const int nbn = N / 32, ipm = 16 * nbn, total = nmat * ipm;
    float va[32], vb[32], vc[32];
#define TF_DECODE(it, j_, k0_, n0_, cs_) const int j_ = (it) / ipm, q_##j_ = (it) % ipm, k0_ = 64 * (q_##j_ / nbn), n0_ = 32 * (q_##j_ % nbn), cs_ = W1 ? cmap_w1(n0_ + (lane & 31)) : n0_ + (lane & 31)
#define TF_LOAD(itx, v_, T_) do { if ((itx) < total) { TF_DECODE(itx, j##T_, k##T_, n##T_, c##T_); (void)n##T_; titem_load(src + (size_t)j##T_ * 1024 * N, N, k##T_, c##T_, lane, v_); } } while (0)
#define TF_STORE(itx, v_, T_) do { if ((itx) < total) { TF_DECODE(itx, j##T_, k##T_, n##T_, c##T_); (void)c##T_; titem_store_f8(v_, dst + (size_t)j##T_ * N * 1024, 1024, scr, k##T_, n##T_, lane, 64.0f); } } while (0)
    int it = gw;
    TF_LOAD(it, va, a0); TF_LOAD(it + NGW, vb, b0);
    while (it < total) {
        TF_LOAD(it + 2 * NGW, vc, c1); TF_STORE(it, va, a1);
        TF_LOAD(it + 3 * NGW, va, a2); TF_STORE(it + NGW, vb, b2);
        TF_LOAD(it + 4 * NGW, vb, b3); TF_STORE(it + 2 * NGW, vc, c3);
        it += 3 * NGW;
    }
#undef TF_LOAD
#undef TF_STORE
#undef TF_DECODE
}
DI void sincos_d(double x, float& s, float& c) {
    const double kd = __builtin_rint(x * 0.6366197723675814); const int k = (int)kd;
    double r = __builtin_fma(-kd, 1.5707963267948966, x); r = __builtin_fma(-kd, 6.123233995736766e-17, r);
    const double r2 = r * r;
    const double sp = r * (1.0 + r2 * (-1.0 / 6 + r2 * (1.0 / 120 + r2 * (-1.0 / 5040 + r2 * (1.0 / 362880 + r2 * (-1.0 / 39916800 + r2 * (1.0 / 6227020800.0)))))));
    const double cp = 1.0 + r2 * (-0.5 + r2 * (1.0 / 24 + r2 * (-1.0 / 720 + r2 * (1.0 / 40320 + r2 * (-1.0 / 3628800 + r2 * (1.0 / 479001600.0 + r2 * (-1.0 / 87178291200.0)))))));
    const int q = k & 3;
    const double ss = (q == 0) ? sp : (q == 1) ? cp : (q == 2) ? -sp : -cp;
    const double cc = (q == 0) ? cp : (q == 1) ? -sp : (q == 2) ? -cp : sp;
    s = (float)ss; c = (float)cc;
}
DI void phase_prologue(const Frame& F) {
    const int tid = F.tid, lane = F.lane, wave = F.wave;
    __syncthreads();
    const float* in_c = KIN_c; const float* in_wada = KIN_w_ada; const float* in_bada = KIN_b_ada; const int* in_pos = KIN_pos;
    if (F.bid < 192) {
        LAS float* cact = (LAS float*)F.lds;
        LAS float* red = (LAS float*)(F.lds + 65536);
        for (int idx = tid; idx < 16 * 1024; idx += 512) { const int b = idx >> 10, k = idx & 1023; const float cv = in_c[idx]; cact[k * 16 + b] = cv * fast_sigmoid(cv); }
        __syncthreads();
        float* MOD = WSP(float, WS_MOD);
        for (int it = F.bid; it < 192; it += F.G) {
            const int l = it / 96, cb = it % 96, col = cb * 64 + lane;
            float acc[16];
#pragma unroll
            for (int b = 0; b < 16; ++b) acc[b] = 0.f;
            const float* wp = in_wada + ((size_t)l * 1024 + wave * 128) * 6144 + col;
#pragma unroll 32
            for (int kk = 0; kk < 128; ++kk) { const float wv = wp[(size_t)kk * 6144]; const LAS f32x4* cp = (const LAS f32x4*)(cact + (wave * 128 + kk) * 16);
#pragma unroll
                for (int q = 0; q < 4; ++q) { const f32x4 cv = cp[q]; acc[4 * q] += cv[0] * wv; acc[4 * q + 1] += cv[1] * wv; acc[4 * q + 2] += cv[2] * wv; acc[4 * q + 3] += cv[3] * wv; } }
#pragma unroll
            for (int b = 0; b < 16; ++b) red[(wave * 16 + b) * 64 + lane] = acc[b];
            __syncthreads();
            for (int o = tid; o < 1024; o += 512) { const int b = o >> 6, ln = o & 63; float s = in_bada[l * 6144 + cb * 64 + ln];
#pragma unroll
                for (int w = 0; w < 8; ++w) s += red[(w * 16 + b) * 64 + ln];
                MOD[((size_t)l * 16 + b) * 6144 + cb * 64 + ln] = s; }
            __syncthreads();
        }
    }
    __syncthreads();
    {
        float* ROPE = WSP(float, WS_ROPE);
        const double r16 = 0.44036660267178046;
        for (int idx = F.bid * 512 + tid; idx < T_TOK * 24; idx += F.G * 512) {
            const int t = idx / 24, i = idx % 24; const int e = (i < 16) ? i : 2 * (i - 16);
            double f = 1.0; for (int j = 0; j < e; ++j) f *= r16;
            float s, c; sincos_d((double)in_pos[t] * f, s, c);
            ROPE[(size_t)t * 48 + 2 * i] = c; ROPE[(size_t)t * 48 + 2 * i + 1] = s;
        }
    }
    {
        LAS float* scr = (LAS float*)(F.lds + wave * 16384);
        const int gw = F.bid * 8 + wave, NGW = F.G * 8;
        constexpr int I_IN = 16 * 200, I_UQ = 4 * 24, I_UKV = 4 * 32, I_WB = 8 * 32, I_WO = 16 * 32, I_W1 = 16 * 64, I_W2 = 16 * 32;
        constexpr int N_IN = 2 * I_IN, N_UQ = 2 * I_UQ, N_UKV = 2 * I_UKV, N_WB = 6 * I_WB, N_WO = 2 * I_WO, N_W1 = 64 * I_W1, N_W2 = 64 * I_W2;
        constexpr int NITEMS = N_IN + N_UQ + N_UKV + N_WB + N_WO;
        (void)N_W1; (void)N_W2;
        for (int it = gw; it < NITEMS; it += NGW) {
            int r = it;
            if (r < N_IN) { const int l = r / I_IN, q = r % I_IN, kb = q / 200, nb = q % 200;
                if (32 * nb < G1_F8_COLS) transpose_item_f8(KIN_w_in + (size_t)l * 1024 * IN_COLS, 1024, IN_COLS, WSP(unsigned char, WS_WIN) + (size_t)l * NP * 2048, 1024, scr, 64 * kb, 32 * nb, cmap_in(32 * nb + (lane & 31)), lane, 64.0f);
                else transpose_item(KIN_w_in + (size_t)l * 1024 * IN_COLS, 1024, IN_COLS, WSP(bf16_t, WS_WIN) + (size_t)l * NP * 1024, 1024, 0, scr, 64 * kb, 32 * nb, cmap_in(32 * nb + (lane & 31)), lane,
                                    (32 * nb >= PC_DQ && 32 * nb < PC_IQ) ? QSCALE_DSA : 1.0f);
                continue; } r -= N_IN;
            if (r < N_UQ) { const int l = r / I_UQ, q = r % I_UQ, kb = q / 24, nb = q % 24;
                transpose_item(KIN_w_uq + (size_t)l * 256 * 768, 256, 768, WSP(bf16_t, WS_WUQ) + (size_t)l * 768 * 256, 256, 0, scr, 64 * kb, 32 * nb, cmap_uq(32 * nb + (lane & 31)), lane, QSCALE_MLA); continue; } r -= N_UQ;
            if (r < N_UKV) { const int l = r / I_UKV, q = r % I_UKV, kb = q / 32, nb = q % 32;
                transpose_item(KIN_w_ukv + (size_t)l * 128 * 1024, 128, 1024, WSP(bf16_t, WS_WUKV) + (size_t)l * 1024 * 256, 256, 0, scr, 64 * kb, 32 * nb, 32 * nb + (lane & 31), lane); continue; } r -= N_UKV;
            if (r < N_WB) { const int j = r / I_WB, q = r % I_WB, kb = q / 32, nb = q % 32;
                transpose_item(KIN_w_branch + (size_t)j * 512 * 1024, 512, 1024, WSP(bf16_t, WS_WB) + (size_t)j * 1024 * 512, 512, 0, scr, 64 * kb, 32 * nb, 32 * nb + (lane & 31), lane); continue; } r -= N_WB;
            if (r < N_WO) { const int l = r / I_WO, q = r % I_WO, kb = q / 32, nb = q % 32;
                transpose_item(KIN_w_out + (size_t)l * 1024 * 1024, 1024, 1024, WSP(bf16_t, WS_WOUT) + (size_t)l * 1024 * 1024, 1024, 0, scr, 64 * kb, 32 * nb, 32 * nb + (lane & 31), lane); continue; } r -= N_WO;
            (void)r;
        }
        convert_family_f8<true>(KIN_w1, WSP(unsigned char, WS_W1), 2048, 64, scr, gw, NGW, lane);
#if M2_F8
        convert_family_f8<false>(KIN_w2, WSP(unsigned char, WS_W2), 1024, 64, scr, gw, NGW, lane);
#else
        for (int it = gw; it < 64 * I_W2; it += NGW) { const int j = it / I_W2, q = it % I_W2, kb = q / 32, nb = q % 32;
            transpose_item(KIN_w2 + (size_t)j * 1024 * 1024, 1024, 1024, WSP(bf16_t, WS_W2) + (size_t)j * 1024 * 1024, 1024, 0, scr, 64 * kb, 32 * nb, 32 * nb + (lane & 31), lane); }
#endif
    }
}

DI void phase_norm(const Frame& F, const float* xin, float* xout, bool combine, bool write_x, bool final_, int lnext, int lcomb) {
    const int lane = F.lane, gw = F.bid * 8 + F.wave, NGW = F.G * 8;
    const float* in_fg = KIN_final_g; const float* in_n1 = KIN_norm1_g;
    const float* MOD = WSP(float, WS_MOD); const bf16_t* Y = WSP(bf16_t, WS_Y); const int* SLOTOF = (const int*)(F.ws + WS_ROUTE + RT_SLOTOF); bf16_t* H = WSP(bf16_t, WS_H);
    u32x4 slots = {0u, 0u, 0u, 0u};
    if (combine && gw < T_TOK) slots = *(const u32x4*)(SLOTOF + (size_t)gw * 4);
    for (int t = gw; t < T_TOK; t += NGW) {
        const int b = t >> 11; f32x4 v[4];
#pragma unroll
        for (int i = 0; i < 4; ++i) v[i] = *(const f32x4*)(xin + (size_t)t * 1024 + 4 * lane + 256 * i);
        if (combine) {
            const unsigned s0 = slots.x, s1 = slots.y, s2 = slots.z, s3 = slots.w;
            u32x2 ya[4], yb[4], yc[4], yd[4];
#pragma unroll
            for (int i = 0; i < 4; ++i) { const int co = 4 * lane + 256 * i;
                ya[i] = *(const u32x2*)(Y + (size_t)s0 * 1024 + co); yb[i] = *(const u32x2*)(Y + (size_t)s1 * 1024 + co); yc[i] = *(const u32x2*)(Y + (size_t)s2 * 1024 + co); yd[i] = *(const u32x2*)(Y + (size_t)s3 * 1024 + co); }
            if (t + NGW < T_TOK) slots = *(const u32x4*)(SLOTOF + (size_t)(t + NGW) * 4);
            const float* g2 = MOD + ((size_t)lcomb * 16 + b) * 6144 + 5 * 1024;
#pragma unroll
            for (int i = 0; i < 4; ++i) { const int co = 4 * lane + 256 * i; const u32x2 a = ya[i], bq = yb[i], cq = yc[i], dq = yd[i];
                f32x4 sum = {bf_lo(a.x) + bf_lo(bq.x) + bf_lo(cq.x) + bf_lo(dq.x), bf_hi(a.x) + bf_hi(bq.x) + bf_hi(cq.x) + bf_hi(dq.x),
                             bf_lo(a.y) + bf_lo(bq.y) + bf_lo(cq.y) + bf_lo(dq.y), bf_hi(a.y) + bf_hi(bq.y) + bf_hi(cq.y) + bf_hi(dq.y)};
                v[i] += *(const f32x4*)(g2 + co) * sum; }
            if (write_x) {
#pragma unroll
                for (int i = 0; i < 4; ++i) *(f32x4*)(xout + (size_t)t * 1024 + 4 * lane + 256 * i) = v[i]; }
        }
        float ss = 0.f;
#pragma unroll
        for (int i = 0; i < 4; ++i) ss += (v[i][0] * v[i][0] + v[i][1] * v[i][1]) + (v[i][2] * v[i][2] + v[i][3] * v[i][3]);
        ss = wave_sum(ss); const float r = 1.0f / sqrtf(ss * (1.0f / 1024.0f) + NORM_EPS);
        if (final_) {
#pragma unroll
            for (int i = 0; i < 4; ++i) { const int co = 4 * lane + 256 * i; *(f32x4*)(F.out + (size_t)t * 1024 + co) = v[i] * r * *(const f32x4*)(in_fg + co); }
        } else {
            const float* md = MOD + ((size_t)lnext * 16 + b) * 6144;
#pragma unroll
            for (int i = 0; i < 4; ++i) { const int co = 4 * lane + 256 * i;
                const f32x4 g = *(const f32x4*)(in_n1 + lnext * 1024 + co), sc = *(const f32x4*)(md + 1024 + co), sh = *(const f32x4*)(md + co);
                f32x4 h = v[i] * r * g * (sc + 1.0f) + sh;
                u32x2 w; w.x = pk2(h[0], h[1]); w.y = pk2(h[2], h[3]);
                *(u32x2*)(H + (size_t)t * 1024 + co) = w;
                *(unsigned*)(WSP(unsigned char, WS_HG8) + (size_t)t * 1024 + co) = pk4_fp8(h[0], h[1], h[2], h[3]);
                }
        }
    }
}
DI u32x4 rope8v(u32x4 a, f32x4 c0, f32x4 c1) {
    u32x4 o;
    { const float x1 = bf_lo(a.x), x2 = bf_hi(a.x); o.x = pk2(x1 * c0[0] - x2 * c0[1], x2 * c0[0] + x1 * c0[1]); }
    { const float x1 = bf_lo(a.y), x2 = bf_hi(a.y); o.y = pk2(x1 * c0[2] - x2 * c0[3], x2 * c0[2] + x1 * c0[3]); }
    { const float x1 = bf_lo(a.z), x2 = bf_hi(a.z); o.z = pk2(x1 * c1[0] - x2 * c1[1], x2 * c1[0] + x1 * c1[1]); }
    { const float x1 = bf_lo(a.w), x2 = bf_hi(a.w); o.w = pk2(x1 * c1[2] - x2 * c1[3], x2 * c1[2] + x1 * c1[3]); }
    return o;
}
DI u32x4 rope8(u32x4 a, const float* cs) { return rope8v(a, *(const f32x4*)cs, *(const f32x4*)(cs + 4)); }
DI void unpack8(u32x4 a, float (&v)[8]) { v[0] = bf_lo(a.x); v[1] = bf_hi(a.x); v[2] = bf_lo(a.y); v[3] = bf_hi(a.y); v[4] = bf_lo(a.z); v[5] = bf_hi(a.z); v[6] = bf_lo(a.w); v[7] = bf_hi(a.w); }
DI void phase_post(const Frame& F, int l) {
    const int lane = F.lane, gw = F.bid * 8 + F.wave, NGW = F.G * 8;
    const bf16_t* P = WSP(bf16_t, WS_P); const float* ROPE = WSP(float, WS_ROPE);
    bf16_t *CQ = WSP(bf16_t, WS_CQ), *CKV = WSP(bf16_t, WS_CKV), *KPE = WSP(bf16_t, WS_KPE), *OB = WSP(bf16_t, WS_O3) + (size_t)T_TOK * 512, *QC = WSP(bf16_t, WS_QC), *KC = WSP(bf16_t, WS_KC),
           *VC = WSP(bf16_t, WS_VC), *QI = WSP(bf16_t, WS_QI), *KI = WSP(bf16_t, WS_KI); float* IW = WSP(float, WS_IW);
    const float* cw = KIN_conv_w + (size_t)l * 3 * 512 + 8 * lane;
    f32x4 cwv[3][2];
#pragma unroll
    for (int d = 0; d < 3; ++d) { cwv[d][0] = *(const f32x4*)(cw + d * 512); cwv[d][1] = *(const f32x4*)(cw + d * 512 + 4); }
    const float* in_qn = KIN_q_norm + l * 256 + 8 * (lane & 31); const float* in_kn = KIN_kv_norm + l * 128 + 8 * (lane & 15);
    const f32x4 qn0 = *(const f32x4*)in_qn, qn1 = *(const f32x4*)(in_qn + 4), kn0 = *(const f32x4*)in_kn, kn1 = *(const f32x4*)(in_kn + 4);
    const u32x4 z4 = {0u, 0u, 0u, 0u};
    for (int t = gw; t < T_TOK; t += NGW) {
        const bf16_t* pr = P + (size_t)t * NP; const float* rp = ROPE + (size_t)t * 48; const int s = t & (SEQ - 1);
        const bf16_t* pc = pr + PC_CONV + 8 * lane;
        const u32x4 gbw = *(const u32x4*)pc;
        const u32x4 gc2 = *(const u32x4*)(pc + 512), hc2 = *(const u32x4*)(pc + 1024);
        const u32x4 gc1 = (s >= 1) ? *(const u32x4*)(pc - NP + 512) : z4, hc1 = (s >= 1) ? *(const u32x4*)(pc - NP + 1024) : z4;
        const u32x4 gc0 = (s >= 2) ? *(const u32x4*)(pc - 2 * NP + 512) : z4, hc0 = (s >= 2) ? *(const u32x4*)(pc - 2 * NP + 1024) : z4;
        u32x4 dqw = *(const u32x4*)(pr + PC_DQ + 8 * lane), iqw = *(const u32x4*)(pr + PC_IQ + 8 * lane);
        const u32x4 qlw = *(const u32x4*)(pr + PC_QLAT + 8 * (lane & 31));
        const u32x4 kvw = *(const u32x4*)(pr + PC_KVLAT + 8 * (lane < 20 ? lane : 0));
        u32x4 dkw = *(const u32x4*)(pr + PC_DKV + 8 * (lane & 15));
        u32x4 ikw = *(const u32x4*)(pr + PC_IK + 8 * (lane & 7));
        const u32x4 iww = *(const u32x4*)(pr + PC_IW);
        const f32x4 r16a = *(const f32x4*)(rp + 32 + 8 * (lane & 1)), r16b = *(const f32x4*)(rp + 32 + 8 * (lane & 1) + 4);
        const f32x4 r32a = *(const f32x4*)(rp + 8 * (lane & 3)), r32b = *(const f32x4*)(rp + 8 * (lane & 3) + 4);
        asm volatile("" ::: "memory");
        {
            float gb[8], a0[8], b0[8], a1[8], b1[8], a2[8], b2[8]; unpack8(gbw, gb); unpack8(gc0, a0); unpack8(hc0, b0); unpack8(gc1, a1); unpack8(hc1, b1); unpack8(gc2, a2); unpack8(hc2, b2);
            float o[8];
#pragma unroll
            for (int i = 0; i < 8; ++i) { const float w0 = cwv[0][i >> 2][i & 3], w1 = cwv[1][i >> 2][i & 3], w2 = cwv[2][i >> 2][i & 3]; o[i] = gb[i] * (w0 * (a0[i] * b0[i]) + w1 * (a1[i] * b1[i]) + w2 * (a2[i] * b2[i])); }
            u32x4 ow; ow.x = pk2(o[0], o[1]); ow.y = pk2(o[2], o[3]); ow.z = pk2(o[4], o[5]); ow.w = pk2(o[6], o[7]);
            *(u32x4*)(OB + (size_t)t * 512 + 8 * lane) = ow;
        }
        if ((lane & 7) < 2) { dqw = rope8v(dqw, r16a, r16b); iqw = rope8v(iqw, r16a, r16b); }
        *(u32x4*)(QC + (size_t)t * 512 + 8 * lane) = dqw; *(u32x4*)(QI + (size_t)t * 512 + 8 * lane) = iqw;
        float ql[8], kv[8]; unpack8(qlw, ql); unpack8(kvw, kv);
        float ss1 = 0.f, ss2 = 0.f;
        if (lane < 32) {
#pragma unroll
            for (int i = 0; i < 8; ++i) ss1 += ql[i] * ql[i]; }
        if (lane < 16) {
#pragma unroll
            for (int i = 0; i < 8; ++i) ss2 += kv[i] * kv[i]; }
#pragma unroll
        for (int o = 1; o < 64; o <<= 1) { ss1 += __shfl_xor(ss1, o); ss2 += __shfl_xor(ss2, o); }
        const float r1 = 1.0f / sqrtf(ss1 * (1.0f / 256.0f) + NORM_EPS), r2 = 1.0f / sqrtf(ss2 * (1.0f / 128.0f) + NORM_EPS);
        if (lane < 32) { u32x4 o; o.x = pk2(ql[0] * r1 * qn0[0], ql[1] * r1 * qn0[1]); o.y = pk2(ql[2] * r1 * qn0[2], ql[3] * r1 * qn0[3]); o.z = pk2(ql[4] * r1 * qn1[0], ql[5] * r1 * qn1[1]); o.w = pk2(ql[6] * r1 * qn1[2], ql[7] * r1 * qn1[3]);
            *(u32x4*)(CQ + (size_t)t * 256 + 8 * lane) = o;
            u32x4 k = z4; if (lane < 16) { k.x = pk2(kv[0] * r2 * kn0[0], kv[1] * r2 * kn0[1]); k.y = pk2(kv[2] * r2 * kn0[2], kv[3] * r2 * kn0[3]); k.z = pk2(kv[4] * r2 * kn1[0], kv[5] * r2 * kn1[1]); k.w = pk2(kv[6] * r2 * kn1[2], kv[7] * r2 * kn1[3]); }
            *(u32x4*)(CKV + (size_t)t * 256 + 8 * lane) = k; }
        if (lane >= 16 && lane < 20) *(u32x4*)(KPE + (size_t)t * 32 + 8 * (lane - 16)) = rope8v(kvw, r32a, r32b);
        if (lane < 16) { if (lane < 2) dkw = rope8v(dkw, r16a, r16b); if (lane < 8) *(u32x4*)(KC + (size_t)t * 64 + 8 * lane) = dkw; else *(u32x4*)(VC + (size_t)t * 64 + 8 * (lane - 8)) = dkw; }
        if (lane >= 16 && lane < 24) { const int c = lane - 16; if (c < 2) ikw = rope8v(ikw, r16a, r16b); *(u32x4*)(KI + (size_t)t * 64 + 8 * c) = ikw; }
        if (lane == 32) { float v[8]; unpack8(iww, v); *(f32x4*)(IW + (size_t)t * 8) = (f32x4){v[0], v[1], v[2], v[3]}; *(f32x4*)(IW + (size_t)t * 8 + 4) = (f32x4){v[4], v[5], v[6], v[7]}; }
    }
}

DI int crow(int r, int hi) { return (r & 3) + 8 * (r >> 2) + 4 * hi; }
DI float max3f(float a, float b, float c) { float r; asm("v_max3_f32 %0, %1, %2, %3" : "=v"(r) : "v"(a), "v"(b), "v"(c)); return r; }
template <int C> DI unsigned bit_mask(unsigned w) { unsigned r; asm("v_bfe_i32 %0, %1, %2, 1" : "=v"(r) : "v"(w), "n"(C)); return r; }
#define MFMA32(a, b, c) __builtin_amdgcn_mfma_f32_32x32x16_bf16((a), (b), (c), 0, 0, 0)
#define MFMA16(a, b, c) __builtin_amdgcn_mfma_f32_16x16x32_bf16((a), (b), (c), 0, 0, 0)
#define GLDS16(src, dst) __builtin_amdgcn_global_load_lds((const unsigned*)(src), (LAS unsigned*)(dst), 16, 0, 0)
typedef short v4i16_t __attribute__((ext_vector_type(4)));
DI s16x4 tr_read(const LAS unsigned char* p) { return __builtin_bit_cast(s16x4, __builtin_amdgcn_ds_read_tr16_b64_v4i16((LAS v4i16_t*)p)); }
DI bf16x8 pack8(float a0, float a1, float a2, float a3, float a4, float a5, float a6, float a7) { u32x4 w; w.x = pk2(a0, a1); w.y = pk2(a2, a3); w.z = pk2(a4, a5); w.w = pk2(a6, a7); return __builtin_bit_cast(bf16x8, w); }
DI bf16x8 cat4(s16x4 lo, s16x4 hi) { return (bf16x8){lo[0], lo[1], lo[2], lo[3], hi[0], hi[1], hi[2], hi[3]}; }

constexpr int MLA_K0 = 0, MLA_V0 = 24576, MLA_WS = 49152;
DI void mla_unit(const Frame& F, int b, int h, int qb) {
    const int lane = F.lane, wid = F.wave, r32 = lane & 31, hi = lane >> 5;
    const bf16_t* QA = WSP(bf16_t, WS_QA); const bf16_t* KPE = WSP(bf16_t, WS_KPE); const bf16_t* KV = WSP(bf16_t, WS_KV); bf16_t* OA = WSP(bf16_t, WS_O3);
    const size_t tb = (size_t)b * SEQ; const int q0 = qb * 256, qrow = q0 + 32 * wid + r32;
    LAS unsigned char* lds = F.lds; LAS float* wsf = (LAS float*)(lds + MLA_WS) + wid * 128;
    const int NT = 4 * (qb + 1);
    const unsigned vo_pe = (unsigned)(lane * 32 + 8 * (wid & 3)) * 2u, vo_k0 = (unsigned)(lane * 1024 + 128 * h + 8 * ((wid + 4) & 7)) * 2u, vo_k1 = (unsigned)(lane * 1024 + 128 * h + 8 * (wid + 4)) * 2u,
                   vo_v = (unsigned)((16 * (wid & 3) + (lane >> 2)) * 1024 + 128 * h + 64 + 32 * (wid >> 2) + 8 * (lane & 3)) * 2u;
    const unsigned ldsb = (unsigned)(unsigned long long)lds;
    const char* pe_b = pg8::uni_ptr((const char*)(KPE + tb * 32)); const char* kv_b = pg8::uni_ptr((const char*)(KV + tb * 1024));
#define MLA_STAGE(kt, buf, vslot) do { const char* pe_ = pe_b + (size_t)(kt) * (64 * 32 * 2); const char* kv_ = kv_b + (size_t)(kt) * (64 * 1024 * 2); \
        if (wid < 4) { pg8::glds16_s(vo_pe, pe_, ldsb + MLA_K0 + (buf) * 12288 + wid * 1024); pg8::glds16_s(vo_k1, kv_, ldsb + MLA_K0 + (buf) * 12288 + (wid + 8) * 1024); } \
        else { pg8::glds16_s(vo_k0, kv_, ldsb + MLA_K0 + (buf) * 12288 + wid * 1024); } \
        pg8::glds16_s(vo_v, kv_, ldsb + MLA_V0 + (vslot) * 8192 + wid * 1024); } while (0)
    MLA_STAGE(0, 0, 0);
    bf16x8 qr[6];
#pragma unroll
    for (int d0 = 0; d0 < 6; ++d0) qr[d0] = *(const bf16x8*)(QA + (tb + qrow) * 768 + h * 96 + d0 * 16 + hi * 8);
    {
        const float* rp = WSP(float, WS_ROPE) + (tb + qrow) * 48;
        qr[0] = __builtin_bit_cast(bf16x8, rope8(__builtin_bit_cast(u32x4, qr[0]), rp + 8 * hi));
        qr[1] = __builtin_bit_cast(bf16x8, rope8(__builtin_bit_cast(u32x4, qr[1]), rp + 16 + 8 * hi)); }
#pragma unroll
    for (int d0 = 0; d0 < 6; ++d0) asm volatile("" : "+v"(qr[d0]));
    float m = -1e30f; f32x16 o[2], lacc;
#pragma unroll
    for (int r = 0; r < 16; ++r) { o[0][r] = 0.f; o[1][r] = 0.f; lacc[r] = 0.f; }
    const bf16x8 ones8 = {(short)0x3f80, (short)0x3f80, (short)0x3f80, (short)0x3f80, (short)0x3f80, (short)0x3f80, (short)0x3f80, (short)0x3f80};
    const int vboff = ((lane >> 4) & 1) * 32 + (lane & 3) * 8 + (4 * hi + ((lane & 15) >> 2)) * 64;
    const bool upper = wid >= 4; bool have_prev = false; bf16x8 pa[4];
#define MLA_PV(vs) do { const LAS unsigned char* vb_ = lds + MLA_V0 + (vs) * 8192 + vboff; \
        _Pragma("unroll") for (int d0 = 0; d0 < 2; ++d0) _Pragma("unroll") for (int ks = 0; ks < 4; ++ks) { \
            const s16x4 lo_ = tr_read(vb_ + d0 * 4096 + ks * 1024), hh_ = tr_read(vb_ + d0 * 4096 + ks * 1024 + 512); o[d0] = MFMA32(pa[ks], cat4(lo_, hh_), o[d0]); } \
        _Pragma("unroll") for (int ks = 0; ks < 4; ++ks) lacc = MFMA32(pa[ks], ones8, lacc); } while (0)
    int vs_cur = 0, vs_prev = 0;
    for (int kt = 0; kt < NT; ++kt) {
        const int buf = kt & 1; const int vs_next = (vs_cur == 2) ? 0 : vs_cur + 1;
        VM_WAIT(); __syncthreads();
        if (kt + 1 < NT) MLA_STAGE(kt + 1, buf ^ 1, vs_next);
        if (upper && have_prev) { MLA_PV(vs_prev); have_prev = false; }
        if (64 * kt <= q0 + 32 * wid + 31) {
            const float mref = (m < -1e29f) ? 0.f : m, cin = -mref;
            f32x16 p0, p1;
#pragma unroll
            for (int r = 0; r < 16; ++r) { p0[r] = cin; p1[r] = cin; }
            const LAS unsigned char* kb = lds + MLA_K0 + buf * 12288 + hi * 1024 + r32 * 16;
#pragma unroll
            for (int d0 = 0; d0 < 6; ++d0) { const bf16x8 b0 = *(const LAS bf16x8*)(kb + d0 * 2048), b1 = *(const LAS bf16x8*)(kb + d0 * 2048 + 512);
                p0 = MFMA32(b0, qr[d0], p0); p1 = MFMA32(b1, qr[d0], p1); }
            if (64 * kt + 63 > q0 + 32 * wid) {
#pragma unroll
                for (int r = 0; r < 16; ++r) { const int kv = 64 * kt + crow(r, hi); if (kv > qrow) p0[r] = -INFINITY; if (kv + 32 > qrow) p1[r] = -INFINITY; } }
            float rm = fmaxf(p0[0], p1[0]);
#pragma unroll
            for (int r = 1; r < 16; ++r) rm = max3f(rm, p0[r], p1[r]);
            rm = fmaxf(rm, __shfl_xor(rm, 32));
            const bool mv = rm + mref > m + 8.0f;
            if (__any(mv)) {
                const float mn = mv ? rm + mref : m, dl = mn - mref;
                const float alpha = __builtin_amdgcn_exp2f(m - mn); m = mn;
#pragma unroll
                for (int r = 0; r < 16; ++r) { p0[r] -= dl; p1[r] -= dl; }
                if (hi == 0) wsf[r32] = alpha;
                LDS_WAIT();
#pragma unroll
                for (int q = 0; q < 4; ++q) { const f32x4 a = *(const LAS f32x4*)(wsf + 8 * q + 4 * hi);
#pragma unroll
                    for (int j = 0; j < 4; ++j) { o[0][4 * q + j] *= a[j]; o[1][4 * q + j] *= a[j]; lacc[4 * q + j] *= a[j]; } }
            }
#pragma unroll
            for (int r = 0; r < 16; ++r) { p0[r] = __builtin_amdgcn_exp2f(p0[r]); p1[r] = __builtin_amdgcn_exp2f(p1[r]); }
            pa[0] = pack8(p0[0], p0[1], p0[2], p0[3], p0[4], p0[5], p0[6], p0[7]); pa[1] = pack8(p0[8], p0[9], p0[10], p0[11], p0[12], p0[13], p0[14], p0[15]);
            pa[2] = pack8(p1[0], p1[1], p1[2], p1[3], p1[4], p1[5], p1[6], p1[7]); pa[3] = pack8(p1[8], p1[9], p1[10], p1[11], p1[12], p1[13], p1[14], p1[15]);
            if (upper) have_prev = true; else MLA_PV(vs_cur);
        }
        vs_prev = vs_cur; vs_cur = vs_next;
    }
    if (upper && have_prev) MLA_PV(vs_prev);
#undef MLA_PV
#undef MLA_STAGE
    bf16_t* orow = OA + (tb + q0 + 32 * wid) * 512 + h * 64 + r32;
#pragma unroll
    for (int r = 0; r < 16; ++r) { const int rr = crow(r, hi); const float a = __builtin_amdgcn_rcpf(lacc[r]);
        orow[(size_t)rr * 512] = (bf16_t)(pk2(o[0][r] * a, 0.f) & 0xffffu); orow[(size_t)rr * 512 + 32] = (bf16_t)(pk2(o[1][r] * a, 0.f) & 0xffffu); }
    __syncthreads();
}

template <int R> DI void s3_init_elem(f32x16& p0, f32x16& p1, unsigned wl, unsigned wh, float cin) {
    constexpr int c = (R & 3) + 8 * (R >> 2);
    const unsigned m0 = bit_mask<c>(wl), m1 = bit_mask<c>(wh), ci = __float_as_uint(cin);
    p0[R] = __uint_as_float((ci & m0) | (0xff800000u & ~m0)); p1[R] = __uint_as_float((ci & m1) | (0xff800000u & ~m1));
}
template <int R> DI void s3_softmax_elem(f32x16& p0, f32x16& p1, float& ls) {
    p0[R] = __builtin_amdgcn_exp2f(p0[R]); p1[R] = __builtin_amdgcn_exp2f(p1[R]);
    ls += p0[R] + p1[R];
}
constexpr int DSA_SCW = 2052;
constexpr int DSA_SEL = 16 * DSA_SCW * 4;
constexpr int DSA_CAND = DSA_SEL + 4096;
template <int CTRL> DI float dpp_f(float x) { return __uint_as_float((unsigned)__builtin_amdgcn_update_dpp(0, (int)__float_as_uint(x), CTRL, 0xf, 0xf, false)); }
DI float rl_f(float x, int l) { return __uint_as_float((unsigned)__builtin_amdgcn_readlane((int)__float_as_uint(x), l)); }
DI float wave_sum_dpp(float x) { x += dpp_f<0x128>(x); x += dpp_f<0x124>(x); x += dpp_f<0x122>(x); x += dpp_f<0x121>(x); return (rl_f(x, 0) + rl_f(x, 16)) + (rl_f(x, 32) + rl_f(x, 48)); }
DI float wave_max_dpp(float x) { x = fmaxf(x, dpp_f<0x128>(x)); x = fmaxf(x, dpp_f<0x124>(x)); x = fmaxf(x, dpp_f<0x122>(x)); x = fmaxf(x, dpp_f<0x121>(x)); return fmaxf(fmaxf(rl_f(x, 0), rl_f(x, 16)), fmaxf(rl_f(x, 32), rl_f(x, 48))); }
DI int mbcnt64(unsigned long long m) { return (int)__builtin_amdgcn_mbcnt_hi((unsigned)(m >> 32), __builtin_amdgcn_mbcnt_lo((unsigned)m, 0u)); }
DI void dsa_unit(const Frame& F, int b, int qt) {
    const int tid = F.tid, lane = F.lane, wid = F.wave, fr = lane & 15, g = lane >> 4;
    const bf16_t *QI = WSP(bf16_t, WS_QI), *KI = WSP(bf16_t, WS_KI), *QC = WSP(bf16_t, WS_QC), *KC = WSP(bf16_t, WS_KC), *VC = WSP(bf16_t, WS_VC); const float* IW = WSP(float, WS_IW);
    bf16_t* OC = WSP(bf16_t, WS_O3) + (size_t)2 * T_TOK * 512;
    const size_t tb = (size_t)b * SEQ; const int t0 = 16 * qt;
    LAS unsigned char* lds = F.lds; LAS float* SC = (LAS float*)lds; LAS unsigned long long* BITS = (LAS unsigned long long*)(lds + DSA_SEL);
    {
        bf16x8 qf[8][2]; float wv[8];
        const bf16_t* qp = QI + (tb + t0 + fr) * 512 + 8 * g;
#pragma unroll
        for (int h = 0; h < 8; ++h) { qf[h][0] = *(const bf16x8*)(qp + h * 64); qf[h][1] = *(const bf16x8*)(qp + h * 64 + 32); }
        { const f32x4 w0 = *(const f32x4*)(IW + (tb + t0 + fr) * 8), w1 = *(const f32x4*)(IW + (tb + t0 + fr) * 8 + 4); wv[0] = w0[0]; wv[1] = w0[1]; wv[2] = w0[2]; wv[3] = w0[3]; wv[4] = w1[0]; wv[5] = w1[1]; wv[6] = w1[2]; wv[7] = w1[3]; }
        const bf16_t* kbase = KI + (tb + fr) * 64 + 8 * g;
#define S1_LD(r0_, r1_, kt_) do { const bf16_t* p_ = kbase + (size_t)(kt_) * 1024; \
            asm volatile("global_load_dwordx4 %0, %2, off\n\tglobal_load_dwordx4 %1, %2, off offset:64" : "=&v"(r0_), "=&v"(r1_) : "v"(p_) : "memory"); } while (0)
#define S1_TILE(a0_, a1_, kt_) do { asm volatile("s_waitcnt vmcnt(4)" : "+v"(a0_), "+v"(a1_) :: "memory"); \
            f32x4 s = {0.f, 0.f, 0.f, 0.f}; \
            _Pragma("unroll") for (int h = 0; h < 8; ++h) { f32x4 acc = {0.f, 0.f, 0.f, 0.f}; acc = MFMA16(a0_, qf[h][0], acc); acc = MFMA16(a1_, qf[h][1], acc); \
                _Pragma("unroll") for (int r = 0; r < 4; ++r) s[r] += fmaxf(acc[r], 0.f) * wv[h]; } \
            _Pragma("unroll") for (int r = 0; r < 4; ++r) if (16 * (kt_) + 4 * g + r > t0 + fr) s[r] = -INFINITY; \
            *(LAS f32x4*)(SC + fr * DSA_SCW + 16 * (kt_) + 4 * g) = s; } while (0)
        if (wid <= qt) {
            const int n = ((qt - wid) >> 3) + 1, klast = wid + 8 * (n - 1);
            bf16x8 A0, A1, B0, B1, C0, C1;
            S1_LD(A0, A1, wid); S1_LD(B0, B1, (wid + 8 < klast) ? wid + 8 : klast); S1_LD(C0, C1, (wid + 16 < klast) ? wid + 16 : klast);
#pragma unroll
            for (int h = 0; h < 8; ++h) { asm volatile("" : "+v"(qf[h][0]), "+v"(qf[h][1])); asm volatile("" : "+v"(wv[h])); }
            for (int i = 0; i < n; i += 3) {
                const int kt = wid + 8 * i;
                S1_TILE(A0, A1, kt);
                S1_LD(A0, A1, (kt + 24 < klast) ? kt + 24 : klast);
                if (i + 1 < n) S1_TILE(B0, B1, kt + 8);
                S1_LD(B0, B1, (kt + 32 < klast) ? kt + 32 : klast);
                if (i + 2 < n) S1_TILE(C0, C1, kt + 16);
                S1_LD(C0, C1, (kt + 40 < klast) ? kt + 40 : klast);
            }
            asm volatile("s_waitcnt vmcnt(0)" : "+v"(A0), "+v"(A1), "+v"(B0), "+v"(B1), "+v"(C0), "+v"(C1) :: "memory");
        }
#undef S1_TILE
#undef S1_LD
    }
    __syncthreads();
    bf16x8 qr[4];
    { const int r32q = lane & 31, hiq = lane >> 5;
#pragma unroll
      for (int d0 = 0; d0 < 4; ++d0) qr[d0] = *(const bf16x8*)(QC + (tb + t0 + 4 * (wid & 3) + (r32q >> 3)) * 512 + (r32q & 7) * 64 + d0 * 16 + hiq * 8); }
    for (int qi2 = 0; qi2 < 2; ++qi2) {
        const int qq = 2 * wid + qi2, t = t0 + qq, nvalid = t + 1;
        LAS unsigned long long* bits = BITS + qq * 32;
        if (nvalid <= 256) { if (lane < 32) { const int k0 = 64 * lane; bits[lane] = (k0 + 63 <= t) ? ~0ull : (k0 <= t) ? ((1ull << (t - k0 + 1)) - 1ull) : 0ull; } }
        else {
            const int nq = (nvalid + 511) >> 9;
            float v[32];
#pragma unroll
            for (int i = 0; i < 32; ++i) { const int key = i * 64 + lane; v[i] = (key <= t) ? SC[qq * DSA_SCW + key] : -INFINITY; }
#define DSA_CMP_ge(m_, x_, t_) asm("v_cmp_ge_f32_e64 %0, %1, %2" : "=s"(m_) : "v"(x_), "v"(t_))
#define DSA_CMP_gt(m_, x_, t_) asm("v_cmp_gt_f32_e64 %0, %1, %2" : "=s"(m_) : "v"(x_), "v"(t_))
#define DSA_COUNT(thr, OPN, out) do { int tot_ = 0; const float thr_ = (thr); _Pragma("unroll") for (int qd = 0; qd < 4; ++qd) { if (qd < nq) { unsigned long long m_[8]; \
                _Pragma("unroll") for (int i = 0; i < 8; ++i) DSA_CMP_##OPN(m_[i], v[8 * qd + i], thr_); __builtin_amdgcn_sched_barrier(0); _Pragma("unroll") for (int i = 0; i < 8; ++i) tot_ += __builtin_popcountll(m_[i]); __builtin_amdgcn_sched_barrier(0); } } out = tot_; } while (0)
            float lo = 0.f, hi = 0.f, K = 0.f; int cnt = 0, clo = nvalid, chi = 0; bool done = false, have_lo = false, have_hi = false;
            if (nvalid >= 512) {
                float a1 = -INFINITY, a2 = -INFINITY, a3 = -INFINITY, a4 = -INFINITY, a5 = -INFINITY;
#pragma unroll
                for (int qd = 0; qd < 4; ++qd) { if (qd < nq) {
#pragma unroll
                    for (int i = 0; i < 8; ++i) { const float x = v[8 * qd + i];
                        const float n5 = __builtin_amdgcn_fmed3f(a4, a5, x), n4 = __builtin_amdgcn_fmed3f(a3, a4, x), n3 = __builtin_amdgcn_fmed3f(a2, a3, x), n2 = __builtin_amdgcn_fmed3f(a1, a2, x);
                        a1 = fmaxf(a1, x); a2 = n2; a3 = n3; a4 = n4; a5 = n5; } } }
                const float m3 = wave_sum_dpp(a3) * (1.0f / 64.0f), m4 = wave_sum_dpp(a4) * (1.0f / 64.0f), m5 = wave_sum_dpp(a5) * (1.0f / 64.0f);
                int c5; DSA_COUNT(m5, ge, c5);
                if (c5 == 256) { K = m5; cnt = 256; done = true; }
                else if (c5 < 256) { hi = m5; chi = c5; have_hi = true; }
                else { lo = m5; clo = c5; have_lo = true;
                    int c4; DSA_COUNT(m4, ge, c4);
                    if (c4 == 256) { K = m4; cnt = 256; done = true; }
                    else if (c4 < 256) { hi = m4; chi = c4; have_hi = true; }
                    else { lo = m4; clo = c4;
                        int c3; DSA_COUNT(m3, ge, c3);
                        if (c3 == 256) { K = m3; cnt = 256; done = true; }
                        else if (c3 < 256) { hi = m3; chi = c3; have_hi = true; }
                        else { lo = m3; clo = c3; } } }
            }
            if (!done && !(have_lo && have_hi)) {
                float vmax = v[0], vmin = (v[0] == -INFINITY) ? INFINITY : v[0];
#pragma unroll
                for (int i = 1; i < 32; ++i) { vmax = fmaxf(vmax, v[i]); vmin = fminf(vmin, (v[i] == -INFINITY) ? INFINITY : v[i]); }
                vmax = wave_max_dpp(vmax); vmin = -wave_max_dpp(-vmin);
                if (!have_hi) { hi = vmax; DSA_COUNT(hi, ge, cnt); if (cnt >= 256) { K = hi; done = true; } else chi = cnt; }
                if (!have_lo) { lo = vmin; clo = nvalid; }
            }
            if (!done)
            for (int it = 0;; ++it) {
                if (clo - chi <= 64) {
                    LAS float* cand = (LAS float*)(lds + DSA_CAND) + wid * 64;
                    cand[lane] = -INFINITY;
                    int base = 0;
#pragma unroll
                    for (int qd = 0; qd < 4; ++qd) { if (qd < nq) {
#pragma unroll
                        for (int i = 0; i < 8; ++i) { const float x = v[8 * qd + i]; const bool c = (x >= lo) && (x < hi); const unsigned long long m = __ballot(c);
                            if (c) cand[base + mbcnt64(m)] = x;
                            base += __builtin_popcountll(m); } } }
                    const float cv = cand[lane]; const int need = 256 - chi; int ge = 0;
                    for (int k = 0; k < base; ++k) { const float ck = __uint_as_float((unsigned)__builtin_amdgcn_readlane((int)__float_as_uint(cv), k)); ge += (ck >= cv) ? 1 : 0; }
                    K = wave_max_dpp((ge >= need) ? cv : -INFINITY); DSA_COUNT(K, ge, cnt);
                    break;
                }
                float fr_ = 0.5f;
                if ((it & 1) == 0) { fr_ = ((float)(clo - 256) + 0.5f) * __builtin_amdgcn_rcpf((float)(clo - chi)); fr_ = fminf(fmaxf(fr_, 0.03125f), 0.96875f); }
                const float mid = lo + (hi - lo) * fr_;
                if (!(mid > lo && mid < hi)) {
                    const float mid2 = lo + (hi - lo) * 0.5f;
                    if (!(mid2 > lo && mid2 < hi)) { K = lo; cnt = clo; break; }
                    DSA_COUNT(mid2, ge, cnt);
                    if (cnt == 256) { K = mid2; break; }
                    if (cnt > 256) { lo = mid2; clo = cnt; } else { hi = mid2; chi = cnt; }
                    continue;
                }
                DSA_COUNT(mid, ge, cnt);
                if (cnt == 256) { K = mid; break; }
                if (cnt > 256) { lo = mid; clo = cnt; } else { hi = mid; chi = cnt; }
            }
            if (cnt == 256) {
#pragma unroll
                for (int qd = 0; qd < 4; ++qd) {
#pragma unroll
                    for (int i8 = 0; i8 < 8; ++i8) { const int i = 8 * qd + i8; const unsigned long long mt = (qd < nq) ? __ballot(v[i] >= K) : 0ull; if (lane == 0) bits[i] = mt; } }
            } else {
                int cgt; DSA_COUNT(K, gt, cgt);
                const int need = 256 - cgt; int eqb = 0;
#pragma unroll
                for (int qd = 0; qd < 4; ++qd) {
#pragma unroll
                    for (int i8 = 0; i8 < 8; ++i8) { const int i = 8 * qd + i8; unsigned long long mt = 0ull;
                        if (qd < nq) { const bool gt = v[i] > K, eq = v[i] == K; const unsigned long long me = __ballot(eq); const int erank = eqb + mbcnt64(me);
                            mt = __ballot(gt || (eq && erank < need)); eqb += __builtin_popcountll(me); }
                        if (lane == 0) bits[i] = mt; } }
            }
#undef DSA_COUNT
#undef DSA_CMP_ge
#undef DSA_CMP_gt
        }
    }
    __syncthreads();
    {
        int lane3 = lane; asm volatile("" : "+v"(lane3));
        const int r32 = lane3 & 31, hi = lane3 >> 5, cg = wid & 3, kp = wid >> 2;
        const int NT = (t0 + 16 + 63) >> 6, NS = (NT + 1) >> 1;
        const int qloc = 4 * cg + (r32 >> 3);
        LAS float* wsf = (LAS float*)(lds + 98304) + wid * 128;
        LAS float* OW = (LAS float*)lds; LAS float* ML2 = (LAS float*)(lds + 102400);
        const unsigned vo_kc = (unsigned)(lane3 * 64 + 8 * wid) * 2u, vo_vc = (unsigned)((16 * (wid & 3) + (lane3 >> 2)) * 64 + 32 * (wid >> 2) + 8 * (lane3 & 3)) * 2u, ldsb = (unsigned)(unsigned long long)lds;
        const char* kc_b = pg8::uni_ptr((const char*)(KC + tb * 64)); const char* vc_b = pg8::uni_ptr((const char*)(VC + tb * 64));
#define DSD_STAGE(j, buf) do { _Pragma("unroll") for (int par_ = 0; par_ < 2; ++par_) { int kt_ = 2 * (j) + par_; kt_ = kt_ < NT ? kt_ : NT - 1; \
            const unsigned d_ = ldsb + (buf) * 32768 + par_ * 16384; \
            pg8::glds16_s(vo_kc, kc_b + (size_t)kt_ * (64 * 64 * 2), d_ + wid * 1024); pg8::glds16_s(vo_vc, vc_b + (size_t)kt_ * (64 * 64 * 2), d_ + 8192 + wid * 1024); } } while (0)
        DSD_STAGE(0, 0);
        if (NS > 1) DSD_STAGE(1, 1);
#pragma unroll
        for (int d0 = 0; d0 < 4; ++d0) asm volatile("" : "+v"(qr[d0]));
        float m = -1e30f, l = 0.f; f32x16 o[2];
#pragma unroll
        for (int r = 0; r < 16; ++r) { o[0][r] = F.zf; o[1][r] = F.zf; }
        const int vboff = ((lane3 >> 4) & 1) * 32 + (lane3 & 3) * 8 + (4 * hi + ((lane3 & 15) >> 2)) * 64;
        int buf = 0, bufn = 2;
        for (int j = 0; j < NS; ++j) {
            const int kt = 2 * j + kp;
            if (j + 1 < NS) asm volatile("s_waitcnt vmcnt(4)" ::: "memory"); else VM_WAIT();
            __syncthreads();
            if (j + 2 < NS) DSD_STAGE(j + 2, bufn);
            if (kt < NT) {
                const LAS unsigned char* tile = lds + buf * 32768 + kp * 16384;
                const float mref = (m < -1e29f) ? 0.f : m, cin = -mref;
                const unsigned long long bw = BITS[qloc * 32 + kt];
                const unsigned wl = (unsigned)bw >> (4 * hi), wh = (unsigned)(bw >> 32) >> (4 * hi);
                f32x16 p0, p1;
#define S3_I(R) s3_init_elem<R>(p0, p1, wl, wh, cin);
                S3_I(0) S3_I(1) S3_I(2) S3_I(3) S3_I(4) S3_I(5) S3_I(6) S3_I(7) S3_I(8) S3_I(9) S3_I(10) S3_I(11) S3_I(12) S3_I(13) S3_I(14) S3_I(15)
#undef S3_I
                const LAS unsigned char* kb = tile + hi * 1024 + r32 * 16;
#pragma unroll
                for (int d0 = 0; d0 < 4; ++d0) { const bf16x8 b0 = *(const LAS bf16x8*)(kb + d0 * 2048), b1 = *(const LAS bf16x8*)(kb + d0 * 2048 + 512);
                    p0 = MFMA32(b0, qr[d0], p0); p1 = MFMA32(b1, qr[d0], p1); }
                float rm = fmaxf(p0[0], p1[0]);
#pragma unroll
                for (int r = 1; r < 16; ++r) rm = max3f(rm, p0[r], p1[r]);
                rm = fmaxf(rm, __shfl_xor(rm, 32));
                const bool mv = rm + mref > m + 8.0f;
                if (__any(mv)) {
                    const float mn = mv ? rm + mref : m, dl = mn - mref;
                    const float alpha = __builtin_amdgcn_exp2f(m - mn); l *= alpha; m = mn;
#pragma unroll
                    for (int r = 0; r < 16; ++r) { p0[r] -= dl; p1[r] -= dl; }
                    if (hi == 0) wsf[r32] = alpha;
                    LDS_WAIT();
#pragma unroll
                    for (int q = 0; q < 4; ++q) { const f32x4 a = *(const LAS f32x4*)(wsf + 8 * q + 4 * hi);
#pragma unroll
                        for (int jj = 0; jj < 4; ++jj) { o[0][4 * q + jj] *= a[jj]; o[1][4 * q + jj] *= a[jj]; } }
                }
                float ls = 0.f;
#define S3_E(R) s3_softmax_elem<R>(p0, p1, ls);
                S3_E(0) S3_E(1) S3_E(2) S3_E(3) S3_E(4) S3_E(5) S3_E(6) S3_E(7) S3_E(8) S3_E(9) S3_E(10) S3_E(11) S3_E(12) S3_E(13) S3_E(14) S3_E(15)
#undef S3_E
                l += ls;
                bf16x8 pa[4];
                pa[0] = pack8(p0[0], p0[1], p0[2], p0[3], p0[4], p0[5], p0[6], p0[7]); pa[1] = pack8(p0[8], p0[9], p0[10], p0[11], p0[12], p0[13], p0[14], p0[15]);
                pa[2] = pack8(p1[0], p1[1], p1[2], p1[3], p1[4], p1[5], p1[6], p1[7]); pa[3] = pack8(p1[8], p1[9], p1[10], p1[11], p1[12], p1[13], p1[14], p1[15]);
                const LAS unsigned char* vb = tile + 8192 + vboff;
#pragma unroll
                for (int d0 = 0; d0 < 2; ++d0)
#pragma unroll
                    for (int ks = 0; ks < 4; ++ks) { const s16x4 lo = tr_read(vb + d0 * 4096 + ks * 1024), hh = tr_read(vb + d0 * 4096 + ks * 1024 + 512);
                        o[d0] = MFMA32(pa[ks], cat4(lo, hh), o[d0]); }
            }
            buf = (buf == 2) ? 0 : buf + 1; bufn = (bufn == 2) ? 0 : bufn + 1;
        }
#undef DSD_STAGE
        l += __shfl_xor(l, 32);
        __syncthreads();
        if (kp == 1) {
            LAS float* ow = OW + cg * 2048;
#pragma unroll
            for (int r = 0; r < 16; ++r) { const int row = crow(r, hi); ow[row * 64 + r32] = o[0][r]; ow[row * 64 + 32 + r32] = o[1][r]; }
            if (hi == 0) { ML2[cg * 64 + r32] = m; ML2[cg * 64 + 32 + r32] = l; }
        }
        __syncthreads();
        if (kp == 0) {
            const float m2 = ML2[cg * 64 + r32], l2 = ML2[cg * 64 + 32 + r32];
            const float M = fmaxf(m, m2), a1 = __builtin_amdgcn_exp2f(m - M), a2 = __builtin_amdgcn_exp2f(m2 - M);
            const float linv = 1.0f / (a1 * l + a2 * l2);
            if (hi == 0) { wsf[r32] = a1 * linv; wsf[32 + r32] = a2 * linv; }
            LDS_WAIT();
            const LAS float* ow = OW + cg * 2048;
            bf16_t* op = OC + (tb + t0 + 4 * cg) * 512 + r32;
#pragma unroll
            for (int q = 0; q < 4; ++q) { const f32x4 s1 = *(const LAS f32x4*)(wsf + 8 * q + 4 * hi), s2 = *(const LAS f32x4*)(wsf + 32 + 8 * q + 4 * hi);
#pragma unroll
                for (int jj = 0; jj < 4; ++jj) { const int r = 4 * q + jj, row = crow(r, hi);
                    const float v0 = o[0][r] * s1[jj] + ow[row * 64 + r32] * s2[jj], v1 = o[1][r] * s1[jj] + ow[row * 64 + 32 + r32] * s2[jj];
                    bf16_t* dst = op + (size_t)(row >> 3) * 512 + (row & 7) * 64;
                    dst[0] = (bf16_t)(pk2(v0, 0.f) & 0xffffu); dst[32] = (bf16_t)(pk2(v1, 0.f) & 0xffffu); } }
        }
    }
    __syncthreads();
}
DI void attention_mla_units(const Frame& F, int rep_a) {
    for (int rep = 0; rep < rep_a; ++rep)
    for (int U = F.bid; U < 1024; U += F.G) { const int i = U >> 8, cp = U & 255, half = cp >> 7, rem = cp & 127; mla_unit(F, rem & 15, rem >> 4, 2 * i + (half ^ (i & 1))); }
}
DI void attention_dsa_units(const Frame& F, int rep_c) {
    for (int rep = 0; rep < rep_c; ++rep)
    for (int U = F.bid; U < 2048; U += F.G) { const int i = U >> 8, cp = U & 255; dsa_unit(F, cp & 15, 16 * i + ((i & 1) ? 15 - (cp >> 4) : (cp >> 4))); }
}
DI void phase_attention(const Frame& F, int rep_a, int rep_c) {
    if (F.bid & 1) { attention_dsa_units(F, rep_c); __syncthreads(); attention_mla_units(F, rep_a); }
    else { attention_mla_units(F, rep_a); __syncthreads(); attention_dsa_units(F, rep_c); }
}

constexpr int N2_WROW = 1032;
constexpr int N2_WH = 0, N2_WL = 32 * N2_WROW * 2, N2_CB = 2 * N2_WL, N2_PART = N2_CB + 128, N2_LGT = N2_PART + 2048, N2_RST = N2_LGT + 8 * 2304, N2_CNT = N2_RST + 512, N2_BASE = N2_CNT + 128, N2_TOK = N2_BASE + 128;
static_assert(N2_TOK + 2048 <= MISC_OFF, "router LDS map");
DI void phase_router(const Frame& F, int l, int cset) {
    const int tid = F.tid, lane = F.lane, wave = F.wave, fr = lane & 15, g = lane >> 4;
    LAS unsigned char* lds = F.lds;
    LAS bf16_t* WH = (LAS bf16_t*)(lds + N2_WH); LAS bf16_t* WL = (LAS bf16_t*)(lds + N2_WL); LAS float* CB = (LAS float*)(lds + N2_CB); LAS float* PART = (LAS float*)(lds + N2_PART);
    LAS float* LGT = (LAS float*)(lds + N2_LGT) + wave * 576; LAS float* RST = (LAS float*)(lds + N2_RST) + wave * 16;
    LAS int* CNT = (LAS int*)(lds + N2_CNT); LAS int* BASE = (LAS int*)(lds + N2_BASE); LAS int* TOKR = (LAS int*)(lds + N2_TOK);
    const float* X1 = WSP(float, WS_X1); const float* MOD = WSP(float, WS_MOD); unsigned char* H8 = WSP(unsigned char, WS_H8);
    const float* in_n2 = KIN_norm2_g + l * 1024; const float* in_rb = KIN_router_b + l * 32; const float* in_rw = KIN_router_w + (size_t)l * 32768;
    int* TOPE = (int*)(F.ws + WS_ROUTE + RT_TOPE); float* TOPG = (float*)(F.ws + WS_ROUTE + RT_TOPG); int* RANK = (int*)(F.ws + WS_ROUTE + RT_RANK);
    for (int chunk = F.bid; chunk < T_TOK / 128; chunk += F.G) {
        const int b = chunk >> 4; const float* md = MOD + ((size_t)l * 16 + b) * 6144;
        __syncthreads();
        { float cp = 0.f;
          for (int idx = tid; idx < 32 * 1024; idx += 512) { const int k = idx >> 5, e = idx & 31; const float w = in_rw[idx]; const float wp = w * (in_n2[k] * (1.0f + md[4 * 1024 + k]));
              const unsigned hw = pk2(wp, 0.f) & 0xffffu; const float lo = wp - __uint_as_float(hw << 16);
              WH[e * N2_WROW + k] = (bf16_t)hw; WL[e * N2_WROW + k] = (bf16_t)(pk2(lo, 0.f) & 0xffffu); cp += md[3 * 1024 + k] * w; }
          PART[(tid >> 5) * 32 + (tid & 31)] = cp; }
        if (tid < 32) CNT[tid] = 0;
        __syncthreads();
        if (tid < 32) { float c = in_rb[tid];
#pragma unroll
            for (int p = 0; p < 16; ++p) c += PART[p * 32 + tid];
            CB[tid] = c; }
        __syncthreads();
        const int t0w = chunk * 128 + wave * 16;
        {
            const float* xp = X1 + (size_t)(t0w + fr) * 1024 + 8 * g;
            f32x4 acc0 = {F.zf, F.zf, F.zf, F.zf}, acc1 = acc0; float ssq = 0.f;
            const LAS bf16_t* wh0 = WH + fr * N2_WROW + 8 * g; const LAS bf16_t* wl0 = WL + fr * N2_WROW + 8 * g;
#pragma unroll 8
            for (int ks = 0; ks < 32; ++ks) {
                const f32x4 xa = *(const f32x4*)(xp + 32 * ks), xb = *(const f32x4*)(xp + 32 * ks + 4);
                ssq += (xa[0] * xa[0] + xa[1] * xa[1]) + (xa[2] * xa[2] + xa[3] * xa[3]) + (xb[0] * xb[0] + xb[1] * xb[1]) + (xb[2] * xb[2] + xb[3] * xb[3]);
                u32x4 hw; hw.x = pk2(xa[0], xa[1]); hw.y = pk2(xa[2], xa[3]); hw.z = pk2(xb[0], xb[1]); hw.w = pk2(xb[2], xb[3]);
                u32x4 lw; lw.x = pk2(xa[0] - bf_lo(hw.x), xa[1] - bf_hi(hw.x)); lw.y = pk2(xa[2] - bf_lo(hw.y), xa[3] - bf_hi(hw.y)); lw.z = pk2(xb[0] - bf_lo(hw.z), xb[1] - bf_hi(hw.z)); lw.w = pk2(xb[2] - bf_lo(hw.w), xb[3] - bf_hi(hw.w));
                const bf16x8 ah = __builtin_bit_cast(bf16x8, hw), al = __builtin_bit_cast(bf16x8, lw);
                const bf16x8 bh0 = *(const LAS bf16x8*)(wh0 + 32 * ks), bh1 = *(const LAS bf16x8*)(wh0 + 16 * N2_WROW + 32 * ks), bl0 = *(const LAS bf16x8*)(wl0 + 32 * ks), bl1 = *(const LAS bf16x8*)(wl0 + 16 * N2_WROW + 32 * ks);
                acc0 = __builtin_amdgcn_mfma_f32_16x16x32_bf16(ah, bh0, acc0, 0, 0, 0); acc0 = __builtin_amdgcn_mfma_f32_16x16x32_bf16(ah, bl0, acc0, 0, 0, 0); acc0 = __builtin_amdgcn_mfma_f32_16x16x32_bf16(al, bh0, acc0, 0, 0, 0);
                acc1 = __builtin_amdgcn_mfma_f32_16x16x32_bf16(ah, bh1, acc1, 0, 0, 0); acc1 = __builtin_amdgcn_mfma_f32_16x16x32_bf16(ah, bl1, acc1, 0, 0, 0); acc1 = __builtin_amdgcn_mfma_f32_16x16x32_bf16(al, bh1, acc1, 0, 0, 0);
            }
            ssq += __shfl_xor(ssq, 16); ssq += __shfl_xor(ssq, 32);
            if (g == 0) RST[fr] = 1.0f / sqrtf(ssq * (1.0f / 1024.0f) + NORM_EPS);
#pragma unroll
            for (int r = 0; r < 4; ++r) { LGT[(4 * g + r) * 36 + fr] = acc0[r]; LGT[(4 * g + r) * 36 + 16 + fr] = acc1[r]; }
        }
        LDS_WAIT();
        if (lane < 16) {
            const int t = t0w + lane; const float rt = RST[lane];
            float a[32];
#pragma unroll
            for (int q = 0; q < 8; ++q) { const f32x4 w = *(const LAS f32x4*)(LGT + lane * 36 + 4 * q), c = *(const LAS f32x4*)(CB + 4 * q); a[4 * q] = w[0] * rt + c[0]; a[4 * q + 1] = w[1] * rt + c[1]; a[4 * q + 2] = w[2] * rt + c[2]; a[4 * q + 3] = w[3] * rt + c[3]; }
            float tv[4]; int te[4];
#pragma unroll
            for (int k = 0; k < 4; ++k) { float best = a[0]; int bi = 0;
#pragma unroll
                for (int e = 1; e < 32; ++e) if (a[e] > best) { best = a[e]; bi = e; }
                tv[k] = best; te[k] = bi;
#pragma unroll
                for (int e = 0; e < 32; ++e) if (e == bi) a[e] = -INFINITY; }
            const float e1 = __expf(tv[1] - tv[0]), e2 = __expf(tv[2] - tv[0]), e3 = __expf(tv[3] - tv[0]); const float inv = 1.0f / (1.0f + e1 + e2 + e3);
            const float gk[4] = {inv, e1 * inv, e2 * inv, e3 * inv};
#pragma unroll
            for (int k = 0; k < 4; ++k) { const int loc = __hip_atomic_fetch_add(&CNT[te[k]], 1, __ATOMIC_RELAXED, __HIP_MEMORY_SCOPE_WORKGROUP); TOKR[(wave * 16 + lane) * 4 + k] = te[k] | (loc << 8); }
            *(f32x4*)(TOPG + (size_t)t * 4) = (f32x4){gk[0], gk[1], gk[2], gk[3]};
        }
        { f32x4 gs[4], shv[4];
#pragma unroll
          for (int i = 0; i < 4; ++i) { const int co = 4 * lane + 256 * i; gs[i] = *(const f32x4*)(in_n2 + co) * (*(const f32x4*)(md + 4 * 1024 + co) + 1.0f); shv[i] = *(const f32x4*)(md + 3 * 1024 + co); }
          for (int j = 0; j < 16; j += 4) {
            f32x4 xv[4][4];
#pragma unroll
            for (int jj = 0; jj < 4; ++jj)
#pragma unroll
                for (int i = 0; i < 4; ++i) xv[jj][i] = *(const f32x4*)(X1 + (size_t)(t0w + j + jj) * 1024 + 4 * lane + 256 * i);
#pragma unroll
            for (int jj = 0; jj < 4; ++jj) { const float r = RST[j + jj];
#pragma unroll
                for (int i = 0; i < 4; ++i) { const f32x4 hv = xv[jj][i] * r * gs[i] + shv[i];
                    *(unsigned*)(H8 + (size_t)(t0w + j + jj) * 1024 + 4 * lane + 256 * i) = pk4_fp8(hv[0], hv[1], hv[2], hv[3]); } }
          } }
        __syncthreads();
        if (tid < 32) BASE[tid] = (int)__hip_atomic_fetch_add(F.ctl + CW_CNT + (cset * 32 + tid) * 64, (unsigned)CNT[tid], __ATOMIC_RELAXED, __HIP_MEMORY_SCOPE_AGENT);
        __syncthreads();
        { const int pr = TOKR[tid], e = pr & 255, loc = pr >> 8; const size_t o = (size_t)(chunk * 128) * 4 + tid; TOPE[o] = e; RANK[o] = BASE[e] + loc; }
    }
}
constexpr int MOE_OFF = LDS_X, MOE_CNTL = LDS_X + 256, MOE_TEXP = LDS_X + 512;
DI int moe_offsets(const Frame& F, int l) {
    LAS int* OFF = (LAS int*)(F.lds + MOE_OFF); LAS int* CNTL = (LAS int*)(F.lds + MOE_CNTL); LAS int* TEXP = (LAS int*)(F.lds + MOE_TEXP);
    __syncthreads();
    if (F.tid < 32) CNTL[F.tid] = (int)__hip_atomic_load(F.ctl + CW_CNT + (l * 32 + F.tid) * 64, __ATOMIC_RELAXED, __HIP_MEMORY_SCOPE_AGENT);
    __syncthreads();
    if (F.tid == 0) { int off = 0; for (int e = 0; e < 32; ++e) { OFF[e] = off; off += (CNTL[e] + 255) & ~255; } OFF[32] = off; }
    __syncthreads();
    const int ntiles = OFF[32] >> 8;
    for (int tl = F.tid; tl < ntiles; tl += 512) { int e = 0; for (int q = 0; q < 32; ++q) if (OFF[q] <= tl * 256 && tl * 256 < OFF[q + 1]) e = q; TEXP[tl] = e; }
    __syncthreads();
    return ntiles;
}
DI void phase_scatter(const Frame& F, int l) {
    const int lane = F.lane, wave = F.wave;
    (void)moe_offsets(F, l);
    const LAS int* OFF = (const LAS int*)(F.lds + MOE_OFF); const LAS int* CNTL = (const LAS int*)(F.lds + MOE_CNTL);
    const int* TOPE = (const int*)(F.ws + WS_ROUTE + RT_TOPE); const float* TOPG = (const float*)(F.ws + WS_ROUTE + RT_TOPG); const int* RANK = (const int*)(F.ws + WS_ROUTE + RT_RANK);
    int* SLOTOF = (int*)(F.ws + WS_ROUTE + RT_SLOTOF); int* TOKOF = (int*)(F.ws + WS_ROUTE + RT_TOKOF); float* GATEOF = (float*)(F.ws + WS_ROUTE + RT_GATEOF);
    const unsigned char* H8 = WSP(unsigned char, WS_H8); unsigned char* XB = WSP(unsigned char, WS_XB);
    for (int chunk = F.bid; chunk < T_TOK / 128; chunk += F.G) {
        const int pair = wave * 64 + lane, tl = chunk * 128 + (pair >> 2); const size_t o = (size_t)tl * 4 + (pair & 3);
        const int e = TOPE[o], slot = OFF[e] + RANK[o];
        SLOTOF[o] = slot; TOKOF[slot] = tl; GATEOF[slot] = TOPG[o];
#pragma unroll 4
        for (int p = 0; p < 64; ++p) {
            const int sp = __builtin_amdgcn_readlane(slot, p), tp = chunk * 128 + ((wave * 64 + p) >> 2);
            *(u32x4*)(XB + (size_t)sp * 1024 + 16 * lane) = *(const u32x4*)(H8 + (size_t)tp * 1024 + 16 * lane);
        }
    }
    for (int e = F.bid; e < 32; e += F.G) {
        const int s0 = OFF[e] + CNTL[e], s1 = OFF[e + 1];
        for (int s = s0 + wave; s < s1; s += 8) { if (lane == 0) { TOKOF[s] = 0; GATEOF[s] = 0.f; }
            *(u32x4*)(XB + (size_t)s * 1024 + 16 * lane) = (u32x4){0u, 0u, 0u, 0u}; }
    }
}

#ifndef MK_SPLIT
#define MK_SPLIT 0
#endif
constexpr int NPHASE = 2 + 11 * DEPTH;
struct Args { const void* in[23]; float* out; unsigned char* ws; int ph_lo, ph_hi; };
static_assert(sizeof(Args) == 25 * 8 + 8, "Args has no padding");


#ifndef PH_ENABLE
#define PH_ENABLE 0xFFFF
#endif
#define IN(k) (lo <= (k) && (k) < hi)
#define EN(j) (((PH_ENABLE) >> (j)) & 1)
#ifndef DUP_MASK
#define DUP_MASK 0
#endif
#define NREP(j) ((((DUP_MASK) >> (j)) & 1) ? 2 : 1)
#define SEAM(k) do { if (!MK_SPLIT && (k) + 1 < hi) { XcdBarrier bar_; bar_.bar = F.ctl + CW_BAR; bar_.x = xb_xcc_id(); bar_.st = (volatile LAS unsigned*)((LAS unsigned char*)lds_raw + MISC_OFF) + 8; xcd_barrier(bar_, F.tid); } } while (0)
DI void layer_phases(const int l, const int lo, const int hi, const int wave0) {
        const int pb = 2 + 11 * l;
        if (EN(2) && IN(pb + 0)) { const Frame F = make_frame(wave0);
            { int kb8 = 1024; asm volatile("" : "+s"(kb8));
              SchedPlain S; S.o.init(T_TOK / 256, G1_F8_COLS / 256, F.G, F.bid); S.A = (const char*)WSP(unsigned char, WS_HG8); S.B = (const char*)(WSP(unsigned char, WS_WIN) + (size_t)l * NP * 2048); S.tstep = (size_t)256 * 1024;
              EpiStoreBf16N E{WSP(bf16_t, WS_P), NP, 0};
              _Pragma("unroll") for (int rep = 0; rep < NREP(2); ++rep) pg8::gemm_phase_f8<EpiStoreBf16N, SchedPlain>(F.lds, F.tid, kb8, S, E); }
            { int tid2 = F.tid; asm volatile("" : "+v"(tid2));
              SchedPlain S; S.o.init(T_TOK / 256, (NP - G1_F8_COLS) / 256, F.G, F.bid); S.A = (const char*)WSP(bf16_t, WS_H); S.B = (const char*)(WSP(bf16_t, WS_WIN) + (size_t)l * NP * 1024 + (size_t)G1_F8_COLS * 1024); S.tstep = (size_t)256 * 1024 * 2;
              EpiStoreBf16 E{WSP(bf16_t, WS_P), NP, G1_F8_COLS};
              _Pragma("unroll") for (int rep = 0; rep < NREP(2); ++rep) pg8::gemm_phase<EpiStoreBf16, SchedPlain>(F.lds, tid2, 1024, S, E); }
            SEAM(pb + 0);
        }
        if (EN(3) && IN(pb + 1)) { const Frame F = make_frame(wave0); _Pragma("unroll") for (int rep = 0; rep < NREP(3); ++rep) phase_post(F, l); SEAM(pb + 1); }
        if (EN(4) && IN(pb + 2)) { const Frame F = make_frame(wave0);
            int k256 = 256; asm volatile("" : "+s"(k256));
            { SchedPlain S; S.o.init(T_TOK / 256, 3, F.G, F.bid); S.A = (const char*)WSP(bf16_t, WS_CQ); S.B = (const char*)(WSP(bf16_t, WS_WUQ) + (size_t)l * 768 * 256); S.tstep = (size_t)256 * 256 * 2;
              EpiStoreBf16 E{WSP(bf16_t, WS_QA), 768};
              pg8::gemm_phase<EpiStoreBf16, SchedPlain>(F.lds, F.tid, k256, S, E); }
            { int tid2 = F.tid; asm volatile("" : "+v"(tid2));
              SchedPlain S; S.o.init(T_TOK / 256, 4, F.G, F.bid); S.A = (const char*)WSP(bf16_t, WS_CKV); S.B = (const char*)(WSP(bf16_t, WS_WUKV) + (size_t)l * 1024 * 256); S.tstep = (size_t)256 * 256 * 2;
              EpiStoreBf16 E{WSP(bf16_t, WS_KV), 1024};
              pg8::gemm_phase<EpiStoreBf16, SchedPlain>(F.lds, tid2, k256, S, E); }
            SEAM(pb + 2);
        }
        if (EN(5) && IN(pb + 3)) { const Frame F = make_frame(wave0); phase_attention(F, NREP(5), NREP(13)); SEAM(pb + 3); }
        if (EN(6) && IN(pb + 4)) { const Frame F = make_frame(wave0);
            SchedBranch S; S.o.init(T_TOK / 256, 4, F.G, F.bid); S.A = (const char*)WSP(bf16_t, WS_O3); S.B = (const char*)(WSP(bf16_t, WS_WB) + (size_t)l * 3 * 1024 * 512); S.tstep = (size_t)256 * 512 * 2; S.aslab = (size_t)T_TOK * 512 * 2;
            EpiBranchGate E{WSP(bf16_t, WS_GY), WSP(bf16_t, WS_P), KIN_b_gate + l * 3072};
            _Pragma("unroll") for (int rep = 0; rep < NREP(6); ++rep) pg8::gemm_phase<EpiBranchGate, SchedBranch>(F.lds, F.tid, 512, S, E);
            SEAM(pb + 4);
        }
        if (EN(7) && IN(pb + 5)) { const Frame F = make_frame(wave0);
            SchedPlain S; S.o.init(T_TOK / 256, 4, F.G, F.bid); S.A = (const char*)WSP(bf16_t, WS_GY); S.B = (const char*)(WSP(bf16_t, WS_WOUT) + (size_t)l * 1024 * 1024); S.tstep = (size_t)256 * 1024 * 2;
            EpiResidual E{l == 0 ? KIN_x : WSP(float, WS_X1), WSP(float, WS_X1), WSP(float, WS_MOD) + (size_t)l * 16 * 6144 + 2 * 1024};
            _Pragma("unroll") for (int rep = 0; rep < NREP(7); ++rep) if (rep == 0 || l == 0) pg8::gemm_phase<EpiResidual, SchedPlain>(F.lds, F.tid, 1024, S, E);
            SEAM(pb + 5);
        }
        if (EN(8) && IN(pb + 6)) { const Frame F = make_frame(wave0); phase_router(F, l, l); if (NREP(8) == 2) phase_router(F, l, l + 2); SEAM(pb + 6); }
        if (EN(9) && IN(pb + 7)) { const Frame F = make_frame(wave0); _Pragma("unroll") for (int rep = 0; rep < NREP(9); ++rep) phase_scatter(F, l); SEAM(pb + 7); }
        if (EN(10) && IN(pb + 8)) { const Frame F = make_frame(wave0);
            const int ntiles = moe_offsets(F, l); int kb8 = 1024; asm volatile("" : "+s"(kb8));
            SchedMoe S; S.o.init(ntiles, 8, F.G, F.bid); S.A = (const char*)WSP(unsigned char, WS_XB); S.B = (const char*)(WSP(unsigned char, WS_W1) + (size_t)l * 32 * 2048 * 1024); S.eslab = 2048u * 1024u;
            S.texp = (const LAS int*)(F.lds + MOE_TEXP);
#if M2_F8
            EpiSwiglu8 E{WSP(unsigned char, WS_ACT), KIN_b1 + (size_t)l * 32 * 2048, (const LAS int*)(F.lds + MOE_TEXP)};
#else
            EpiSwiglu E{WSP(bf16_t, WS_ACT), KIN_b1 + (size_t)l * 32 * 2048, (const LAS int*)(F.lds + MOE_TEXP)};
#endif
            _Pragma("unroll") for (int rep = 0; rep < NREP(10); ++rep)
#if M2_F8
            pg8::gemm_phase_f8<EpiSwiglu8, SchedMoe>(F.lds, F.tid, kb8, S, E);
#else
            pg8::gemm_phase_f8<EpiSwiglu, SchedMoe>(F.lds, F.tid, kb8, S, E);
#endif

            SEAM(pb + 8);
        }
        if (EN(11) && IN(pb + 9)) { const Frame F = make_frame(wave0);
            const int ntiles = moe_offsets(F, l); int kb8 = 1024; asm volatile("" : "+s"(kb8));
#if M2_F8
            SchedMoe S; S.o.init(ntiles, 4, F.G, F.bid); S.A = (const char*)WSP(unsigned char, WS_ACT); S.B = (const char*)(WSP(unsigned char, WS_W2) + (size_t)l * 32 * 1024 * 1024); S.eslab = 1024u * 1024u;
            S.texp = (const LAS int*)(F.lds + MOE_TEXP);
            EpiMoeOut E{WSP(bf16_t, WS_Y), KIN_b2 + (size_t)l * 32 * 1024, (const float*)(F.ws + WS_ROUTE + RT_GATEOF), (const LAS int*)(F.lds + MOE_TEXP)};
            _Pragma("unroll") for (int rep = 0; rep < NREP(11); ++rep) pg8::gemm_phase_f8<EpiMoeOut, SchedMoe>(F.lds, F.tid, kb8, S, E);
#else
            SchedMoeB S; S.o.init(ntiles, 4, F.G, F.bid); S.A = (const char*)WSP(bf16_t, WS_ACT); S.B = (const char*)(WSP(bf16_t, WS_W2) + (size_t)l * 32 * 1024 * 1024); S.eslab = 1024u * 1024u * 2u;
            S.texp = (const LAS int*)(F.lds + MOE_TEXP);
            EpiMoeOut E{WSP(bf16_t, WS_Y), KIN_b2 + (size_t)l * 32 * 1024, (const float*)(F.ws + WS_ROUTE + RT_GATEOF), (const LAS int*)(F.lds + MOE_TEXP)};
            _Pragma("unroll") for (int rep = 0; rep < NREP(11); ++rep) pg8::gemm_phase<EpiMoeOut, SchedMoeB>(F.lds, F.tid, kb8, S, E);
#endif
            SEAM(pb + 9);
        }
        if (EN(12) && IN(pb + 10)) { const Frame F = make_frame(wave0);
            const bool last = (l == DEPTH - 1);
            _Pragma("unroll") for (int rep = 0; rep < NREP(12); ++rep) if (rep == 0 || last) phase_norm(F, WSP(float, WS_X1), WSP(float, WS_X1), true, !last, last, l + 1 < DEPTH ? l + 1 : 0, l);
            SEAM(pb + 10);
        }
}
__global__ void __launch_bounds__(512, 2) fwd_kernel(Args args) {
    const int wave0 = __builtin_amdgcn_readfirstlane(threadIdx.x >> 6);
    {
        volatile LAS unsigned* MISC = (volatile LAS unsigned*)((LAS unsigned char*)lds_raw + MISC_OFF);
        if (threadIdx.x < 32) MISC[threadIdx.x] = 0u;
        __syncthreads();
        if (!MK_SPLIT) { const Frame F = make_frame(wave0); (void)xcd_barrier_post(F.ctl + CW_BAR, MISC + 8, F.tid); }
    }
    const int lo = args.ph_lo, hi = args.ph_hi;
    if (EN(0) && IN(0)) { const Frame F = make_frame(wave0); _Pragma("unroll") for (int rep = 0; rep < NREP(0); ++rep) phase_prologue(F); SEAM(0); }
    if (EN(1) && IN(1)) { const Frame F = make_frame(wave0); _Pragma("unroll") for (int rep = 0; rep < NREP(1); ++rep) phase_norm(F, KIN_x, nullptr, false, false, false, 0, 0); SEAM(1); }
    layer_phases(0, lo, hi, wave0);
    layer_phases(1, lo, hi, wave0);
    static_assert(DEPTH == 2, "two layers");
#undef IN
#undef SEAM
}

extern "C" void kernel_launch(void* const* d_in, const int* in_sizes, int n_in, void* d_out, int out_size, void* d_ws, size_t ws_size, hipStream_t stream) {
    static int grid = 0;
    if (grid == 0) {
        if (n_in != 23 || out_size != T_TOK * D_MODEL || ws_size < WS_END) { fprintf(stderr, "kernel_launch: unexpected problem (n_in %d, out %d, ws %zu)\n", n_in, out_size, ws_size); grid = -1; return; }
        int dev = 0, cus = 0;
        if (hipGetDevice(&dev) != hipSuccess || hipDeviceGetAttribute(&cus, hipDeviceAttributeMultiprocessorCount, dev) != hipSuccess) { grid = -1; return; }
        if (hipFuncSetAttribute((const void*)fwd_kernel, hipFuncAttributeMaxDynamicSharedMemorySize, LDS_BYTES) != hipSuccess) { fprintf(stderr, "kernel_launch: hipFuncSetAttribute failed\n"); grid = -1; return; }
        int per_cu = 0;
        if (hipOccupancyMaxActiveBlocksPerMultiprocessor(&per_cu, (const void*)fwd_kernel, 512, LDS_BYTES) != hipSuccess || per_cu < 1) fprintf(stderr, "kernel_launch: occupancy query says %d\n", per_cu);
        (void)hipGetLastError();
        grid = cus > 256 ? 256 : cus;
    }
    if (grid < 0) return;
    (void)in_sizes;
    if (hipMemsetAsync((char*)d_ws + WS_CTL, 0, CTL_ZERO_BYTES, stream) != hipSuccess) return;
    Args a{};
    for (int i = 0; i < 23; ++i) a.in[i] = d_in[i];
    a.out = (float*)d_out; a.ws = (unsigned char*)d_ws;
#if MK_SPLIT
    for (int p = 0; p < NPHASE; ++p) { a.ph_lo = p; a.ph_hi = p + 1; hipLaunchKernelGGL(fwd_kernel, dim3(grid), dim3(512), LDS_BYTES, stream, a); }
#else
    a.ph_lo = 0; a.ph_hi = NPHASE;
    hipLaunchKernelGGL(fwd_kernel, dim3(grid), dim3(512), LDS_BYTES, stream, a);
#endif
}
```
